# Optimizing an MI355X kernel written in HIP

```python
import jax, jax.numpy as jnp
from jax import lax
import numpy as np

D_MODEL = 1024
BATCH = 8
SEQ = 2048
DEPTH = 2
DEC_BATCH = 8
DEC_SEQ = 16
PAST_LEN = 2048

CHUNK = 64
HEAD_DIM = 64
N_HEADS = D_MODEL // HEAD_DIM
N_HEADS_SB = N_HEADS // 2
N_HEADS_CB = N_HEADS - N_HEADS_SB
W_SB = N_HEADS_SB * HEAD_DIM
W_CB = N_HEADS_CB * HEAD_DIM
MIX_WIDTH = W_SB + W_CB
BAND_CHUNKS = 8
BAND = BAND_CHUNKS * CHUNK
REL_MAX = 128
D_FF = -(-8 * D_MODEL // (3 * 256)) * 256
PLE_DIM = 256
QBLOCK = 128
EPS = 1e-6

kernel_name = "hymba_stickbreak_chunkband_stream_step"


def rmsnorm(x, g):
    xf = x.astype(jnp.float32)
    y = xf * lax.rsqrt(jnp.mean(xf * xf, axis=-1, keepdims=True) + EPS)
    return y.astype(x.dtype) * g


def split_heads(h, w_in):
    qkv = h @ w_in
    cuts = [W_SB, 2 * W_SB, 3 * W_SB, 3 * W_SB + W_CB, 3 * W_SB + 2 * W_CB]
    parts = jnp.split(qkv, cuts, axis=-1)
    b, t = h.shape[0], h.shape[1]
    heads = [N_HEADS_SB] * 3 + [N_HEADS_CB] * 3
    return [pt.reshape(b, t, n, HEAD_DIM) for pt, n in zip(parts, heads)]


def stick_breaking(q, k, v, q_pos, k_pos):
    z = jnp.einsum('bqhd,bkhd->bhqk', q, k).astype(jnp.float32) * (HEAD_DIM ** -0.5)
    causal = k_pos[None, :] < q_pos[:, None]
    log_keep = jnp.where(causal, jax.nn.log_sigmoid(-z), 0.0)
    between = lax.cumsum(log_keep, axis=3, reverse=True) - log_keep
    w = jnp.where(causal, jnp.exp(jax.nn.log_sigmoid(z) + between), 0.0)
    return jnp.einsum('bhqk,bkhd->bqhd', w.astype(v.dtype), v)


def band_attention(q, k, v, dist, rel_table, valid=None):
    idx = jnp.clip(dist, -REL_MAX, REL_MAX) + REL_MAX
    bias = jnp.transpose(rel_table[idx], (2, 0, 1)).astype(jnp.float32)
    s = jnp.einsum('...qhd,...khd->...hqk', q, k).astype(jnp.float32) * (HEAD_DIM ** -0.5) + bias
    if valid is not None:
        s = jnp.where(valid, s, -jnp.inf)
    p = jax.nn.softmax(s, axis=-1)
    return jnp.einsum('...hqk,...khd->...qhd', p.astype(v.dtype), v)


def chunk_band_prompt(q, k, v, rel_table):
    b, s, h, d = q.shape
    nc = s // CHUNK
    kb_len = (BAND_CHUNKS + 1) * CHUNK
    qc = q.reshape(b, nc, CHUNK, h, d)

    def band(x):
        xc = x.reshape(b, nc, CHUNK, h, d)
        xp = jnp.pad(xc, ((0, 0), (BAND_CHUNKS, 0), (0, 0), (0, 0), (0, 0)))
        return jnp.concatenate([xp[:, i:i + nc] for i in range(BAND_CHUNKS + 1)], axis=2)

    kb, vb = band(k), band(v)
    dist = BAND + jnp.arange(CHUNK)[:, None] - jnp.arange(kb_len)[None, :]
    key_pos = (jnp.arange(nc)[:, None] - BAND_CHUNKS) * CHUNK + jnp.arange(kb_len)[None, :]
    valid = (key_pos >= 0)[:, None, None, :]
    out = band_attention(qc, kb, vb, dist, rel_table, valid)
    return out.reshape(b, s, h, d)


def trunk_layer(x, p, g_mix, w_in, rel_table, g_out_sb, g_out_cb, w_out, g_ffn, w_gate, w_up, w_down,
                g_ple, w_ple_gate, w_ple_proj, past_sb_k=None, past_sb_v=None, past_cb_k=None, past_cb_v=None):
    b, t = x.shape[0], x.shape[1]
    h = rmsnorm(x, g_mix)
    q_a, k_a, v_a, q_b, k_b, v_b = split_heads(h, w_in)
    if past_sb_k is None:
        nb = t // QBLOCK
        k_pos = jnp.arange(t)
        qb = jnp.moveaxis(q_a.reshape(b, nb, QBLOCK, N_HEADS_SB, HEAD_DIM), 1, 0)
        a = lax.map(lambda args: stick_breaking(args[0], k_a, v_a, args[1] * QBLOCK + jnp.arange(QBLOCK), k_pos),
                    (qb, jnp.arange(nb)))
        a = jnp.moveaxis(a, 0, 1).reshape(b, t, N_HEADS_SB, HEAD_DIM)
        o_b = chunk_band_prompt(q_b, k_b, v_b, rel_table)
        new = (k_a, v_a, k_b[:, -BAND:], v_b[:, -BAND:])
    else:
        past = past_sb_k.shape[1]
        q_pos = past + jnp.arange(t)
        ka = jnp.concatenate([past_sb_k, k_a.astype(past_sb_k.dtype)], axis=1)
        va = jnp.concatenate([past_sb_v, v_a.astype(past_sb_v.dtype)], axis=1)
        a = stick_breaking(q_a, ka, va, q_pos, jnp.arange(past + t))
        lb = past_cb_k.shape[1]
        kc = jnp.concatenate([past_cb_k, k_b.astype(past_cb_k.dtype)], axis=1)
        vc = jnp.concatenate([past_cb_v, v_b.astype(past_cb_v.dtype)], axis=1)
        kc_pos = jnp.concatenate([past - lb + jnp.arange(lb), q_pos])
        o_b = band_attention(q_b, kc, vc, q_pos[:, None] - kc_pos[None, :], rel_table)
        new = (k_a, v_a, k_b, v_b)
    a = rmsnorm(a, g_out_sb.reshape(N_HEADS_SB, HEAD_DIM))
    o_b = rmsnorm(o_b, g_out_cb.reshape(N_HEADS_CB, HEAD_DIM))
    mix = jnp.concatenate([a.reshape(b, t, W_SB), o_b.reshape(b, t, W_CB)], axis=-1)
    x = x + mix @ w_out
    h = rmsnorm(x, g_ffn)
    x = x + (jax.nn.silu(h @ w_gate) * (h @ w_up)) @ w_down
    gate = jax.nn.sigmoid(rmsnorm(x, g_ple) @ w_ple_gate)
    x = x + gate * (p @ w_ple_proj)
    return x, new


def setup_inputs(seed: int = 0) -> dict:
    key = jax.random.key(seed)
    ks = jax.random.split(key, 24)
    n = jax.random.normal
    f = jnp.float32
    lb = min(BAND, PAST_LEN)
    return {
        "x_prompt": n(ks[0], (BATCH, SEQ, D_MODEL), f),
        "x_sample": n(ks[1], (DEC_BATCH, DEC_SEQ, D_MODEL), f),
        "p_prompt": n(ks[2], (DEPTH, BATCH, SEQ, PLE_DIM), f),
        "p_sample": n(ks[3], (DEPTH, DEC_BATCH, DEC_SEQ, PLE_DIM), f),
        "cache_sb_k": n(ks[4], (DEPTH, DEC_BATCH, PAST_LEN, N_HEADS_SB, HEAD_DIM), f),
        "cache_sb_v": n(ks[5], (DEPTH, DEC_BATCH, PAST_LEN, N_HEADS_SB, HEAD_DIM), f),
        "cache_cb_k": n(ks[6], (DEPTH, DEC_BATCH, lb, N_HEADS_CB, HEAD_DIM), f),
        "cache_cb_v": n(ks[7], (DEPTH, DEC_BATCH, lb, N_HEADS_CB, HEAD_DIM), f),
        "g_mix": 1.0 + 0.05 * n(ks[8], (DEPTH, D_MODEL), f),
        "w_in": n(ks[9], (DEPTH, D_MODEL, 3 * MIX_WIDTH), f) * D_MODEL ** -0.5,
        "rel_table": 0.5 * n(ks[10], (DEPTH, 2 * REL_MAX + 1, N_HEADS_CB), f),
        "g_out_sb": 1.0 + 0.05 * n(ks[11], (DEPTH, W_SB), f),
        "g_out_cb": 1.0 + 0.05 * n(ks[12], (DEPTH, W_CB), f),
        "w_out": n(ks[13], (DEPTH, MIX_WIDTH, D_MODEL), f) * MIX_WIDTH ** -0.5,
        "g_ffn": 1.0 + 0.05 * n(ks[14], (DEPTH, D_MODEL), f),
        "w_gate": n(ks[15], (DEPTH, D_MODEL, D_FF), f) * D_MODEL ** -0.5,
        "w_up": n(ks[16], (DEPTH, D_MODEL, D_FF), f) * D_MODEL ** -0.5,
        "w_down": n(ks[17], (DEPTH, D_FF, D_MODEL), f) * D_FF ** -0.5,
        "g_ple": 1.0 + 0.05 * n(ks[18], (DEPTH, D_MODEL), f),
        "w_ple_gate": n(ks[19], (DEPTH, D_MODEL, D_MODEL), f) * D_MODEL ** -0.5,
        "w_ple_proj": n(ks[20], (DEPTH, PLE_DIM, D_MODEL), f) * PLE_DIM ** -0.5,
        "g_final": 1.0 + 0.05 * n(ks[21], (D_MODEL,), f),
    }


def reference(x_prompt, x_sample, p_prompt, p_sample, cache_sb_k, cache_sb_v, cache_cb_k, cache_cb_v,
              g_mix, w_in, rel_table, g_out_sb, g_out_cb, w_out, g_ffn, w_gate, w_up, w_down,
              g_ple, w_ple_gate, w_ple_proj, g_final):
    xp, xs = x_prompt, x_sample
    new_p, new_s = [], []
    for i in range(DEPTH):
        w = (g_mix[i], w_in[i], rel_table[i], g_out_sb[i], g_out_cb[i], w_out[i], g_ffn[i],
             w_gate[i], w_up[i], w_down[i], g_ple[i], w_ple_gate[i], w_ple_proj[i])
        xp, np_i = trunk_layer(xp, p_prompt[i], *w)
        xs, ns_i = trunk_layer(xs, p_sample[i], *w, cache_sb_k[i], cache_sb_v[i], cache_cb_k[i], cache_cb_v[i])
        new_p.append(np_i)
        new_s.append(ns_i)
    y_prompt = rmsnorm(xp, g_final)
    y_sample = rmsnorm(xs, g_final)
    return (y_prompt, y_sample,
            jnp.stack([e[0] for e in new_p]), jnp.stack([e[1] for e in new_p]),
            jnp.stack([e[2] for e in new_p]), jnp.stack([e[3] for e in new_p]),
            jnp.stack([e[0] for e in new_s]), jnp.stack([e[1] for e in new_s]),
            jnp.stack([e[2] for e in new_s]), jnp.stack([e[3] for e in new_s]))
```

```cpp
#include <hip/hip_runtime.h>
#include <hip/hip_cooperative_groups.h>
#include <cstdio>
#include <cstdint>
namespace cg = cooperative_groups;
__device__ __forceinline__ int fresh_tid() { int t = threadIdx.x; asm volatile("" : "+v"(t)); return t; }
namespace pg8 {
#define PG8_LAS __attribute__((address_space(3)))
typedef unsigned short bf16_t;
typedef short bf16x8 __attribute__((ext_vector_type(8)));
typedef float f32x4 __attribute__((ext_vector_type(4)));
typedef unsigned u32x4 __attribute__((ext_vector_type(4)));
constexpr int BM = 256, BK = 64, HALF = 128, HTB = HALF * BK * 2  , STAGE_BYTES = 8 * HTB, NXCD = 8, WGM = 8;

__host__ __device__ __forceinline__ int lds_byte(int r, int c) { const int st = (r >> 4) * 2 + (c >> 5), rr = r & 15, cc = c & 31, ob = rr * 64 + cc * 2; return st * 1024 + (ob ^ (((ob >> 9) & 1) << 5)); }
__host__ __device__ __forceinline__ void stage_rc(int b, int& R, int& C) { const int st = b / 1024, sb = b % 1024, swz = sb ^ (((sb >> 9) & 1) << 5); R = (st >> 1) * 16 + swz / 64; C = (st & 1) * 32 + (swz % 64) / 2; }
__host__ __device__ __forceinline__ int perm32(int rho) { const int n = rho >> 4, i = rho & 15; return 8 * (i >> 2) + 4 * n + (i & 3); }

struct Unit { int pm, pn; };
struct Gemm { const bf16_t* A; const bf16_t* Bt; int M, N, K; };

struct StaticOrder {
    int nM, nN, nwg, G, c;
    __host__ __device__ void init(int M, int N, int G_, int c_) { nM = M / BM; nN = N / BM; nwg = nM * nN; G = G_; c = c_; }
    __host__ __device__ bool next(int i, Unit& u) const {
        const long L = (long)i * G + c; if (L >= nwg) return false;
        int wgid = (int)L; { const int q = nwg / NXCD, r = nwg % NXCD, xcd = wgid % NXCD, off = wgid / NXCD; wgid = (xcd < r ? xcd * (q + 1) : r * (q + 1) + (xcd - r) * q) + off; }
        const int nig = WGM * nN, gid = wgid / nig, fm = gid * WGM, gsz = (nM - fm) < WGM ? (nM - fm) : WGM;
        u.pm = fm + ((wgid % nig) % gsz); u.pn = (wgid % nig) / gsz; return true;
    }
    __device__ __forceinline__ void a_ready(const Unit&) const {}
    __device__ __forceinline__ void done(const Unit&) const {}
};

template <class Epi, class Sched, bool ALIGN_EPI = false, bool SP2 = false>
__device__ __forceinline__ void gemm_phase(PG8_LAS unsigned char* lds, const Gemm g, const Sched& S, const Epi& E) {
    const int tid = fresh_tid(), wid = __builtin_amdgcn_readfirstlane(tid >> 6), lane = tid & 63, wr = wid >> 2, wc = wid & 3, fr = lane & 15, fq = lane >> 4;
    const int K = g.K, nt = K / BK;
    unsigned voffA[2], voffB[2];
#pragma unroll
    for (int i = 0; i < 2; ++i) { int R, C; stage_rc(tid * 16 + i * 8192, R, C); const int Rb = Epi::PERM ? ((R & ~31) + perm32(R & 31)) : R;
        voffA[i] = (unsigned)(R * K + C) * 2u; voffB[i] = (unsigned)(Rb * K + C) * 2u; }
    const size_t kstep = (size_t)(BK * 2);
    const size_t hstep = (size_t)HALF * K * 2;
    const size_t tstep = 2 * hstep;
    const unsigned ldsw = (unsigned)wid * 1024u;
    const int aoff = lds_byte(wr * 64 + fr, fq * 8), boff = lds_byte(wc * 32 + fr, fq * 8);
#define PG8_SA(b, h) (((b) * 2 + (h)) * HTB)
#define PG8_SB(b, h) ((4 + (b) * 2 + (h)) * HTB)
#define PG8_STAGE(bufoff, gbase, voff) do { _Pragma("unroll") for (int _i = 0; _i < 2; ++_i) \
        __builtin_amdgcn_global_load_lds((const unsigned*)((const char*)(gbase) + (voff)[_i]), (PG8_LAS unsigned*)(lds + (bufoff) + ldsw + _i * 8192), 16, 0, 0); } while (0)
#define PG8_LDA(dst, b, h) do { _Pragma("unroll") for (int m = 0; m < 4; ++m) _Pragma("unroll") for (int k = 0; k < 2; ++k) dst[m][k] = *(const PG8_LAS bf16x8*)(lds + PG8_SA(b, h) + aoff + m * 2048 + k * 1024); } while (0)
#define PG8_LDB(dst, b, h) do { _Pragma("unroll") for (int n = 0; n < 2; ++n) _Pragma("unroll") for (int k = 0; k < 2; ++k) dst[n][k] = *(const PG8_LAS bf16x8*)(lds + PG8_SB(b, h) + boff + n * 2048 + k * 1024); } while (0)
#define PG8_MMA(ai, bj, At, Bt) do { __builtin_amdgcn_s_setprio(1); _Pragma("unroll") for (int m = 0; m < 4; ++m) _Pragma("unroll") for (int n = 0; n < 2; ++n) _Pragma("unroll") for (int k = 0; k < 2; ++k) \
        acc[ai][bj][m][n] = __builtin_amdgcn_mfma_f32_16x16x32_bf16(Bt[n][k], At[m][k], acc[ai][bj][m][n], 0, 0, 0); __builtin_amdgcn_s_setprio(0); } while (0)
#define PG8_WAIT_V(n) asm volatile("s_waitcnt vmcnt(" #n ")" ::: "memory")
#define PG8_WAIT_L(n) asm volatile("s_waitcnt lgkmcnt(" #n ")" ::: "memory")
#define PG8_BAR __builtin_amdgcn_s_barrier()
#define PG8_SCHED __builtin_amdgcn_sched_barrier(0)
    Unit cur, nxt; int ui = 0;
    if (!S.next(0, cur)) return;
    f32x4 acc[2][2][4][2];
#pragma unroll
    for (int a = 0; a < 2; ++a)
#pragma unroll
        for (int b = 0; b < 2; ++b)
#pragma unroll
            for (int m = 0; m < 4; ++m)
#pragma unroll
                for (int n = 0; n < 2; ++n) acc[a][b][m][n] = (f32x4){0.f, 0.f, 0.f, 0.f};
    bf16x8 At[4][2], B0[2][2], B1[2][2];
    const char* cA = (const char*)g.A + (size_t)cur.pm * tstep; const char* cB = (const char*)g.Bt + (size_t)cur.pn * tstep;
    S.a_ready(cur);
    if constexpr (SP2) {
        PG8_STAGE(PG8_SB(0, 0), cB, voffB); PG8_STAGE(PG8_SB(0, 1), cB + hstep, voffB); PG8_STAGE(PG8_SA(0, 0), cA, voffA); PG8_STAGE(PG8_SA(0, 1), cA + hstep, voffA);
        if (wr == 1) PG8_BAR;
        PG8_WAIT_V(2); PG8_BAR;
        PG8_STAGE(PG8_SB(1, 0), cB + kstep, voffB); PG8_STAGE(PG8_SA(1, 0), cA + kstep, voffA); PG8_STAGE(PG8_SB(1, 1), cB + hstep + kstep, voffB);
        PG8_WAIT_V(6); PG8_BAR;
    } else {
        PG8_STAGE(PG8_SB(0, 0), cB, voffB); PG8_STAGE(PG8_SA(0, 0), cA, voffA); PG8_STAGE(PG8_SB(0, 1), cB + hstep, voffB); PG8_STAGE(PG8_SA(0, 1), cA + hstep, voffA);
        if (wr == 1) PG8_BAR;
        PG8_WAIT_V(4); PG8_BAR;
        PG8_STAGE(PG8_SB(1, 0), cB + kstep, voffB); PG8_STAGE(PG8_SA(1, 0), cA + kstep, voffA); PG8_STAGE(PG8_SB(1, 1), cB + hstep + kstep, voffB);
        PG8_WAIT_V(6); PG8_BAR;
    }
    for (;;) {
        const bool has_next = S.next(ui + 1, nxt);
        const char* nA = has_next ? (const char*)g.A + (size_t)nxt.pm * tstep : cA; const char* nB = has_next ? (const char*)g.Bt + (size_t)nxt.pn * tstep : cB;
        for (int t = 0; t < nt; t += 2) {
            const bool last = (t == nt - 2);
            const char* a1 = cA + (size_t)(t + 1) * kstep;
            const char* a2 = last ? nA : cA + (size_t)(t + 2) * kstep; const char* b2 = last ? nB : cB + (size_t)(t + 2) * kstep;
            const char* a3 = a2 + kstep; const char* b3 = b2 + kstep;
            if (last && has_next) S.a_ready(nxt);
            if constexpr (SP2) {
            PG8_LDB(B0, 0, 0); PG8_LDB(B1, 0, 1); PG8_SCHED; PG8_LDA(At, 0, 0); PG8_STAGE(PG8_SA(1, 1), a1 + hstep, voffA);
            PG8_WAIT_V(8); PG8_WAIT_L(0); PG8_BAR; PG8_MMA(0, 0, At, B0); PG8_MMA(0, 1, At, B1); PG8_BAR; PG8_SCHED;
            PG8_LDA(At, 0, 1); PG8_STAGE(PG8_SB(0, 0), b2, voffB); PG8_STAGE(PG8_SB(0, 1), b2 + hstep, voffB); PG8_STAGE(PG8_SA(0, 0), a2, voffA);
            PG8_WAIT_V(8); PG8_WAIT_L(0); PG8_BAR; PG8_MMA(1, 0, At, B0); PG8_MMA(1, 1, At, B1); PG8_BAR; PG8_SCHED;
            PG8_LDB(B0, 1, 0); PG8_LDB(B1, 1, 1); PG8_SCHED; PG8_LDA(At, 1, 0); PG8_STAGE(PG8_SA(0, 1), a2 + hstep, voffA);
            PG8_WAIT_V(8); PG8_WAIT_L(0); PG8_BAR; PG8_MMA(0, 0, At, B0); PG8_MMA(0, 1, At, B1); PG8_BAR; PG8_SCHED;
            PG8_LDA(At, 1, 1); PG8_STAGE(PG8_SB(1, 0), b3, voffB); PG8_STAGE(PG8_SB(1, 1), b3 + hstep, voffB); PG8_STAGE(PG8_SA(1, 0), a3, voffA);
            PG8_WAIT_V(8); PG8_WAIT_L(0); PG8_BAR; PG8_MMA(1, 0, At, B0); PG8_MMA(1, 1, At, B1); PG8_BAR; PG8_SCHED;
            } else {
            PG8_LDB(B0, 0, 0); PG8_SCHED; PG8_LDA(At, 0, 0); PG8_STAGE(PG8_SA(1, 1), a1 + hstep, voffA);
            PG8_WAIT_L(8); PG8_BAR; PG8_WAIT_L(0); PG8_MMA(0, 0, At, B0); PG8_BAR; PG8_SCHED;
            PG8_LDB(B1, 0, 1); PG8_STAGE(PG8_SB(0, 0), b2, voffB);
            PG8_BAR; PG8_WAIT_L(0); PG8_MMA(0, 1, At, B1); PG8_BAR;
            PG8_LDA(At, 0, 1); PG8_STAGE(PG8_SA(0, 0), a2, voffA);
            PG8_BAR; PG8_WAIT_L(0); PG8_MMA(1, 0, At, B0); PG8_BAR; PG8_SCHED;
            PG8_STAGE(PG8_SB(0, 1), b2 + hstep, voffB);
            PG8_WAIT_V(6); PG8_BAR; PG8_MMA(1, 1, At, B1); PG8_BAR;
            PG8_LDB(B0, 1, 0); PG8_SCHED; PG8_LDA(At, 1, 0); PG8_STAGE(PG8_SA(0, 1), a2 + hstep, voffA);
            PG8_WAIT_L(8); PG8_BAR; PG8_WAIT_L(0); PG8_MMA(0, 0, At, B0); PG8_BAR; PG8_SCHED;
            PG8_LDB(B1, 1, 1); PG8_STAGE(PG8_SB(1, 0), b3, voffB);
            PG8_BAR; PG8_WAIT_L(0); PG8_MMA(0, 1, At, B1); PG8_BAR;
            PG8_LDA(At, 1, 1); PG8_STAGE(PG8_SA(1, 0), a3, voffA);
            PG8_BAR; PG8_WAIT_L(0); PG8_MMA(1, 0, At, B0); PG8_BAR; PG8_SCHED;
            PG8_STAGE(PG8_SB(1, 1), b3 + hstep, voffB);
            PG8_WAIT_V(6); PG8_BAR; PG8_MMA(1, 1, At, B1); PG8_BAR;
            }
        }
        if constexpr (ALIGN_EPI) { if (wr == 0) PG8_BAR; }
        if constexpr (!Epi::AFTER_DRAIN) { E(acc, cur, wr, wc, fr, fq); S.done(cur); }
        if (!has_next) break;
#pragma unroll
        for (int a = 0; a < 2; ++a)
#pragma unroll
            for (int b = 0; b < 2; ++b)
#pragma unroll
                for (int m = 0; m < 4; ++m)
#pragma unroll
                    for (int n = 0; n < 2; ++n) acc[a][b][m][n] = (f32x4){0.f, 0.f, 0.f, 0.f};
        cur = nxt; cA = nA; cB = nB; ++ui;
        if constexpr (ALIGN_EPI) { if (wr == 1) PG8_BAR; }
    }
    PG8_WAIT_V(0);
    if constexpr (!ALIGN_EPI) { if (wr == 0) PG8_BAR; }
    PG8_BAR;
    if constexpr (Epi::AFTER_DRAIN) { E.fused(acc, cur, wr, wc, fr, fq, lds, wid, lane); S.done(cur); }
#undef PG8_SA
#undef PG8_SB
#undef PG8_STAGE
#undef PG8_LDA
#undef PG8_LDB
#undef PG8_MMA
#undef PG8_WAIT_V
#undef PG8_WAIT_L
#undef PG8_BAR
#undef PG8_SCHED
}
}

#define LAS __attribute__((address_space(3)))
using pg8::bf16_t; using pg8::bf16x8; using pg8::f32x4; using pg8::u32x4;
typedef short s16x4 __attribute__((ext_vector_type(4)));
typedef float f32x16 __attribute__((ext_vector_type(16)));
typedef unsigned u32x2 __attribute__((ext_vector_type(2)));
typedef float f32x2_t __attribute__((ext_vector_type(2)));
typedef __bf16 bf16x2_t __attribute__((ext_vector_type(2)));

constexpr int DM = 1024, SEQ = 2048, NBATCH = 8, MP = NBATCH * SEQ, DSEQ = 16, MS = NBATCH * DSEQ, MT = MP + MS;
constexpr int DFF = 2816, NQKV = 3072, PLED = 256, NLAYER = 2, PAST = 2048, BANDL = 512, HW = 512;
constexpr float EPS = 1e-6f, LOG2E = 1.4426950408889634f, QSCALE = 0.125f * LOG2E;
#ifndef SB_EARLY
#define SB_EARLY 0
#endif
constexpr float SB_THR = -160.0f;

constexpr size_t MiB = 1u << 20;
constexpr size_t WS_CTL = 0, WS_SS = 64 * 1024;
constexpr size_t WS_W = 2 * MiB, W_LSTRIDE = 28 * MiB, W_IN = 0, W_OUT = 6 * MiB, W_GU = 8 * MiB, W_DOWN = 19 * MiB, W_PG = 25 * MiB, W_PP = 27 * MiB;
constexpr size_t WS_PB = 58 * MiB, WS_X = 76 * MiB, WS_XB = 142 * MiB, WS_QKV = 176 * MiB, WS_MIX = 274 * MiB, WS_P = 308 * MiB, WS_END = 342 * MiB;
constexpr int LDS_BYTES = 131072 + 1024;
constexpr int NWAVES = 8, NTHREADS = 512;

constexpr size_t O_YP = 0, O_YS = (size_t)MP * DM, O_SBK_P = O_YS + (size_t)MS * DM, O_SBV_P = O_SBK_P + (size_t)NLAYER * MP * HW,
                 O_CBK_P = O_SBV_P + (size_t)NLAYER * MP * HW, O_CBV_P = O_CBK_P + (size_t)NLAYER * NBATCH * BANDL * HW,
                 O_SBK_S = O_CBV_P + (size_t)NLAYER * NBATCH * BANDL * HW, O_SBV_S = O_SBK_S + (size_t)NLAYER * MS * HW,
                 O_CBK_S = O_SBV_S + (size_t)NLAYER * MS * HW, O_CBV_S = O_CBK_S + (size_t)NLAYER * MS * HW;

__device__ __forceinline__ unsigned pk2(float lo, float hi) { f32x2_t v = {lo, hi}; bf16x2_t b = __builtin_convertvector(v, bf16x2_t); return __builtin_bit_cast(unsigned, b); }
__device__ __forceinline__ float bf_lo(unsigned w) { return __uint_as_float(w << 16); }
__device__ __forceinline__ float bf_hi(unsigned w) { return __uint_as_float(w & 0xffff0000u); }
__device__ __forceinline__ float partner32(float v) {
    auto rr = __builtin_amdgcn_permlane32_swap(__float_as_uint(v), __float_as_uint(v), false, false);
    return (threadIdx.x & 32) ? __uint_as_float(rr[0]) : __uint_as_float(rr[1]);
}
__device__ __forceinline__ float wave_sum(float v) {
#pragma unroll
    for (int o = 1; o < 64; o <<= 1) v += __shfl_xor(v, o);
    return v;
}
__device__ __forceinline__ float rstd_of(float ss) { return rsqrtf(ss * (1.0f / DM) + EPS); }

template <int I> __device__ __forceinline__ const float* argp() {
    unsigned long long v; const void* ka = (const void*)__builtin_amdgcn_kernarg_segment_ptr();
    asm volatile("s_load_dwordx2 %0, %1, %2\n\ts_waitcnt lgkmcnt(0)" : "=s"(v) : "s"(ka), "i"(I * 8) : "memory");
    return (const float*)v;
}
#define ARG(i) argp<i>()
#define ARG_OUT ((float*)argp<22>())
#define ARG_WS ((unsigned char*)argp<23>())
#define WS_PTR(T, off) ((T*)(ARG_WS + (off)))
#define SSB WS_PTR(float, WS_SS)
#define PB_ WS_PTR(bf16_t, WS_PB)
#define X_ WS_PTR(float, WS_X)
#define XB_ WS_PTR(bf16_t, WS_XB)
#define QKV_ WS_PTR(bf16_t, WS_QKV)
#define HB_ WS_PTR(bf16_t, WS_QKV)
#define MIX_ WS_PTR(bf16_t, WS_MIX)
#define PBUF_ WS_PTR(bf16_t, WS_P)
#define WPTR(L, off) ((const bf16_t*)(ARG_WS + WS_W + (size_t)(L) * W_LSTRIDE + (off)))

enum { EP_QKV = 0, EP_RES = 1, EP_GU = 2, EP_P = 3, EP_PLE = 4 };
struct EpiArgs {
    const float* ss_in; float* ss_out;
    const float* xbase; const float* xbase_s;
    float* X; bf16_t* XB; bf16_t* o0; const bf16_t* P;
    float *f_sbk, *f_sbv, *f_cbk, *f_cbv;
    float *s_sbk, *s_sbv, *s_cbk, *s_cbv;
};
template <int MODE> struct Epi {
    static constexpr bool PERM = false, AFTER_DRAIN = false;
    EpiArgs a;
    __device__ __forceinline__ void operator()(const f32x4 (&acc)[2][2][4][2], const pg8::Unit& u, int wr, int wc, int fr, int fq) const {
        if constexpr (MODE == EP_QKV) {
            const int part = u.pn >> 1, cb = (u.pn & 1) * 256 + wc * 32 + 4 * fq;
            bf16_t* ob = a.o0 + (size_t)part * ((size_t)MT * HW);
            float* fo = part == 1 ? a.f_sbk : part == 2 ? a.f_sbv : part == 4 ? a.f_cbk : part == 5 ? a.f_cbv : nullptr;
            const bool band = part >= 4; const float qs = (part == 0 || part == 3) ? QSCALE : 1.f;
#pragma unroll
            for (int ai = 0; ai < 2; ++ai)
#pragma unroll
                for (int m = 0; m < 4; ++m) {
                    const int row = u.pm * 256 + ai * 128 + wr * 64 + m * 16 + fr;
                    const float rs = rstd_of(a.ss_in[row]) * qs;
                    const int t = row & (SEQ - 1);
                    float* frow = nullptr;
                    if (fo) { if (!band) frow = fo + (size_t)row * HW; else if (t >= SEQ - BANDL) frow = fo + ((size_t)(row >> 11) * BANDL + (t - (SEQ - BANDL))) * HW; }
#pragma unroll
                    for (int bj = 0; bj < 2; ++bj)
#pragma unroll
                        for (int n = 0; n < 2; ++n) {
                            const int col = cb + bj * 128 + n * 16; const f32x4 v = acc[ai][bj][m][n] * rs;
                            u32x2 w; w.x = pk2(v[0], v[1]); w.y = pk2(v[2], v[3]);
                            *(u32x2*)(ob + (size_t)row * HW + col) = w;
                            if (frow) *(f32x4*)(frow + col) = v;
                        }
                }
        } else if constexpr (MODE == EP_RES || MODE == EP_PLE) {
#pragma unroll
            for (int ai = 0; ai < 2; ++ai)
#pragma unroll
                for (int m = 0; m < 4; ++m) {
                    const int row = u.pm * 256 + ai * 128 + wr * 64 + m * 16 + fr;
                    float rs = 0.f; if constexpr (MODE == EP_PLE) rs = rstd_of(a.ss_in[row]) * (-LOG2E);
                    float s = 0.f;
#pragma unroll
                    for (int bj = 0; bj < 2; ++bj)
#pragma unroll
                        for (int n = 0; n < 2; ++n) {
                            const size_t off = (size_t)row * DM + u.pn * 256 + bj * 128 + wc * 32 + n * 16 + 4 * fq;
                            f32x4 x = *(const f32x4*)(a.xbase + off); const f32x4 c = acc[ai][bj][m][n];
                            if constexpr (MODE == EP_RES) x += c;
                            else { const u32x2 pw = *(const u32x2*)(a.P + off);
                                   x[0] += bf_lo(pw.x) * __builtin_amdgcn_rcpf(1.f + __builtin_amdgcn_exp2f(c[0] * rs));
                                   x[1] += bf_hi(pw.x) * __builtin_amdgcn_rcpf(1.f + __builtin_amdgcn_exp2f(c[1] * rs));
                                   x[2] += bf_lo(pw.y) * __builtin_amdgcn_rcpf(1.f + __builtin_amdgcn_exp2f(c[2] * rs));
                                   x[3] += bf_hi(pw.y) * __builtin_amdgcn_rcpf(1.f + __builtin_amdgcn_exp2f(c[3] * rs)); }
                            *(f32x4*)(a.X + off) = x;
                            u32x2 w; w.x = pk2(x[0], x[1]); w.y = pk2(x[2], x[3]); *(u32x2*)(a.XB + off) = w;
                            s += (x[0] * x[0] + x[1] * x[1]) + (x[2] * x[2] + x[3] * x[3]);
                        }
                    s += __shfl_xor(s, 16); s += __shfl_xor(s, 32);
                    if (fq == 0) unsafeAtomicAdd(a.ss_out + row, s);
                }
        } else if constexpr (MODE == EP_GU) {
#pragma unroll
            for (int ai = 0; ai < 2; ++ai)
#pragma unroll
                for (int m = 0; m < 4; ++m) {
                    const int row = u.pm * 256 + ai * 128 + wr * 64 + m * 16 + fr;
                    const float rs = rstd_of(a.ss_in[row]);
#pragma unroll
                    for (int n = 0; n < 2; ++n) {
                        const int col = u.pn * 128 + wc * 32 + n * 16 + 4 * fq;
                        const f32x4 g = acc[ai][0][m][n] * rs, up = acc[ai][1][m][n] * rs; float h[4];
#pragma unroll
                        for (int e = 0; e < 4; ++e) h[e] = g[e] * up[e] * __builtin_amdgcn_rcpf(1.f + __builtin_amdgcn_exp2f(-LOG2E * g[e]));
                        u32x2 w; w.x = pk2(h[0], h[1]); w.y = pk2(h[2], h[3]);
                        *(u32x2*)(a.o0 + (size_t)row * DFF + col) = w;
                    }
                }
        } else {
#pragma unroll
            for (int ai = 0; ai < 2; ++ai)
#pragma unroll
                for (int m = 0; m < 4; ++m) {
                    const int row = u.pm * 256 + ai * 128 + wr * 64 + m * 16 + fr;
#pragma unroll
                    for (int bj = 0; bj < 2; ++bj)
#pragma unroll
                        for (int n = 0; n < 2; ++n) {
                            const size_t off = (size_t)row * DM + u.pn * 256 + bj * 128 + wc * 32 + n * 16 + 4 * fq; const f32x4 v = acc[ai][bj][m][n];
                            u32x2 w; w.x = pk2(v[0], v[1]); w.y = pk2(v[2], v[3]); *(u32x2*)(a.o0 + off) = w;
                        }
                }
        }
    }
};

template <int MODE>
__device__ __forceinline__ void sgemm(LAS unsigned char* lds, const bf16_t* A, int K, const bf16_t* Bt, int nunits, const EpiArgs& a) {
    const int tid = fresh_tid(), lane = tid & 63, wave = __builtin_amdgcn_readfirstlane(tid >> 6), rb = wave & 3, kh = wave >> 2, r = lane & 31, hh = lane >> 5;
    LAS float* red = (LAS float*)lds;
    const int G = gridDim.x, Kh = K >> 1;
    for (int j = G - 1 - (int)blockIdx.x; j < nunits; j += G) {
        const int c0 = 32 * j;
        const int brow0 = (MODE == EP_GU) ? ((c0 >> 7) * 256 + (c0 & 127)) : c0;
        const bf16_t* ap = A + (size_t)(32 * rb + r) * K + kh * Kh + 8 * hh;
        const bf16_t* bp = Bt + (size_t)(brow0 + r) * K + kh * Kh + 8 * hh;
        f32x16 acc0 = {}, acc1 = {};
#pragma unroll 4
        for (int k = 0; k < Kh; k += 16) {
            const bf16x8 af = *(const bf16x8*)(ap + k), bf = *(const bf16x8*)(bp + k);
            acc0 = __builtin_amdgcn_mfma_f32_32x32x16_bf16(af, bf, acc0, 0, 0, 0);
            if constexpr (MODE == EP_GU) { const bf16x8 bf2 = *(const bf16x8*)(bp + (size_t)128 * K + k); acc1 = __builtin_amdgcn_mfma_f32_32x32x16_bf16(af, bf2, acc1, 0, 0, 0); }
        }
        if (kh == 1) {
#pragma unroll
            for (int i = 0; i < 16; ++i) { red[(rb * 16 + i) * 64 + lane] = acc0[i]; if constexpr (MODE == EP_GU) red[4096 + (rb * 16 + i) * 64 + lane] = acc1[i]; }
        }
        __syncthreads();
        if (kh == 0) {
#pragma unroll
            for (int i = 0; i < 16; ++i) { acc0[i] += red[(rb * 16 + i) * 64 + lane]; if constexpr (MODE == EP_GU) acc1[i] += red[4096 + (rb * 16 + i) * 64 + lane]; }
            const int col = c0 + r;
#pragma unroll
            for (int i = 0; i < 16; ++i) {
                const int rs_ = 32 * rb + (i & 3) + 8 * (i >> 2) + 4 * hh, row = MP + rs_;
                if constexpr (MODE == EP_QKV) {
                    const int part = c0 >> 9, cc = col & 511;
                    const float v = acc0[i] * rstd_of(a.ss_in[row]);
                    const float qs = (part == 0 || part == 3) ? QSCALE : 1.f;
                    (a.o0 + (size_t)part * ((size_t)MT * HW))[(size_t)row * HW + cc] = (bf16_t)(pk2(v * qs, 0.f) & 0xffffu);
                    float* fo = part == 1 ? a.s_sbk : part == 2 ? a.s_sbv : part == 4 ? a.s_cbk : part == 5 ? a.s_cbv : nullptr;
                    if (fo) fo[(size_t)rs_ * HW + cc] = v;
                } else if constexpr (MODE == EP_RES || MODE == EP_PLE) {
                    const size_t off = (size_t)row * DM + col;
                    float x = a.xbase_s[(size_t)rs_ * DM + col];
                    if constexpr (MODE == EP_RES) x += acc0[i];
                    else { const float pv = __uint_as_float((unsigned)a.P[off] << 16); x += pv * __builtin_amdgcn_rcpf(1.f + __builtin_amdgcn_exp2f(-LOG2E * acc0[i] * rstd_of(a.ss_in[row]))); }
                    a.X[off] = x; a.XB[off] = (bf16_t)(pk2(x, 0.f) & 0xffffu);
                    float s = x * x;
                    s += __shfl_xor(s, 1); s += __shfl_xor(s, 2); s += __shfl_xor(s, 4); s += __shfl_xor(s, 8); s += __shfl_xor(s, 16);
                    if (r == 0) unsafeAtomicAdd(a.ss_out + row, s);
                } else if constexpr (MODE == EP_GU) {
                    const float rs = rstd_of(a.ss_in[row]); const float g = acc0[i] * rs, up = acc1[i] * rs;
                    const float h = g * up * __builtin_amdgcn_rcpf(1.f + __builtin_amdgcn_exp2f(-LOG2E * g));
                    a.o0[(size_t)row * DFF + col] = (bf16_t)(pk2(h, 0.f) & 0xffffu);
                } else {
                    a.o0[(size_t)row * DM + col] = (bf16_t)(pk2(acc0[i], 0.f) & 0xffffu);
                }
            }
        }
        __syncthreads();
    }
}

struct AttnArgs { int L; };
constexpr int AW_V = 0, AW_ST = 4096, AW_BIAS = 8704, AW_BYTES = 10240, ST_PITCH = 144;

template <bool F32> __device__ __forceinline__ void ld_k(bf16x8 (&kf)[4], const void* base, size_t off) {
    if constexpr (!F32) { const bf16_t* p = (const bf16_t*)base + off;
#pragma unroll
        for (int kk = 0; kk < 4; ++kk) kf[kk] = *(const bf16x8*)(p + 8 * kk);
    } else { const float* p = (const float*)base + off;
#pragma unroll
        for (int kk = 0; kk < 4; ++kk) { const f32x4 x = *(const f32x4*)(p + 8 * kk), y = *(const f32x4*)(p + 8 * kk + 4);
            u32x4 w; w.x = pk2(x[0], x[1]); w.y = pk2(x[2], x[3]); w.z = pk2(y[0], y[1]); w.w = pk2(y[2], y[3]); kf[kk] = __builtin_bit_cast(bf16x8, w); }
    }
}
template <bool F32> __device__ __forceinline__ void ld_v(u32x4 (&vr)[4], const void* base, size_t row0, int nvalid, int h, int lane) {
#pragma unroll
    for (int i = 0; i < 4; ++i) { int key = 8 * i + (lane >> 3); key = key < nvalid ? key : nvalid - 1;
        const size_t off = (row0 + key) * HW + h * 64 + (lane & 7) * 8;
        if constexpr (!F32) vr[i] = *(const u32x4*)((const bf16_t*)base + off);
        else { const float* p = (const float*)base + off; const f32x4 x = *(const f32x4*)p, y = *(const f32x4*)(p + 4);
            u32x4 w; w.x = pk2(x[0], x[1]); w.y = pk2(x[2], x[3]); w.z = pk2(y[0], y[1]); w.w = pk2(y[2], y[3]); vr[i] = w; }
    }
}
__device__ __forceinline__ void st_v(LAS unsigned char* vl, const u32x4 (&vr)[4], int lane) {
#pragma unroll
    for (int i = 0; i < 4; ++i) { const int key = 8 * i + (lane >> 3); *(LAS u32x4*)(vl + key * 128 + (((lane & 7) * 16) ^ (((key >> 1) & 1) << 6))) = vr[i]; }
}
typedef short v4i16_t __attribute__((ext_vector_type(4)));
__device__ __forceinline__ s16x4 vtr(LAS unsigned char* p) { return __builtin_bit_cast(s16x4, __builtin_amdgcn_ds_read_tr16_b64_v4i16((LAS v4i16_t*)p)); }
__device__ __forceinline__ void pv_block(f32x16 (&o)[2], LAS unsigned char* vl, const bf16x8 (&pf)[2], int lane) {
    const int q = (lane & 15) >> 2, p = lane & 3, c16 = (lane >> 4) & 1, hh = lane >> 5;
    const int va0 = (4 * hh + q) * 128 + ((32 * c16 + 8 * p) ^ ((q >> 1) << 6));
#pragma unroll
    for (int db = 0; db < 2; ++db)
#pragma unroll
        for (int s = 0; s < 2; ++s) {
            const s16x4 lo = vtr(vl + (va0 ^ (db * 64)) + s * 2048), hi = vtr(vl + (va0 ^ (db * 64)) + s * 2048 + 1024);
            const bf16x8 vf = {lo[0], lo[1], lo[2], lo[3], hi[0], hi[1], hi[2], hi[3]};
            o[db] = __builtin_amdgcn_mfma_f32_32x32x16_bf16(vf, pf[s], o[db], 0, 0, 0);
        }
}
__device__ __forceinline__ f32x16 qk_block(const bf16x8 (&kf)[4], const bf16x8 (&qf)[4]) {
    f32x16 S = {};
#pragma unroll
    for (int kk = 0; kk < 4; ++kk) S = __builtin_amdgcn_mfma_f32_32x32x16_bf16(kf[kk], qf[kk], S, 0, 0, 0);
    return S;
}
__device__ __forceinline__ void sb_block(const bf16x8 (&kf)[4], const bf16x8 (&qf)[4], LAS unsigned char* vl, int tq, int keypos0, float& carry, f32x16 (&o)[2], int lane) {
    const int hh = lane >> 5;
    const f32x16 S = qk_block(kf, qf);
    float L[16], e[16];
#pragma unroll
    for (int r = 0; r < 16; ++r) {
        const int kp = keypos0 + (r & 3) + 8 * (r >> 2) + 4 * hh; const bool valid = kp < tq;
        const float z = S[r];
        const float sp = fmaxf(z, 0.f) + __builtin_amdgcn_logf(1.f + __builtin_amdgcn_exp2f(-fabsf(z)));
        L[r] = valid ? -sp : 0.f; e[r] = valid ? z - sp : -INFINITY;
    }
    float T[4], Tp[4], U[4];
#pragma unroll
    for (int g = 0; g < 4; ++g) { T[g] = (L[4 * g] + L[4 * g + 1]) + (L[4 * g + 2] + L[4 * g + 3]); Tp[g] = partner32(T[g]); U[g] = T[g] + Tp[g]; }
    float R[4]; R[3] = 0.f; R[2] = U[3]; R[1] = U[3] + U[2]; R[0] = R[1] + U[1];
    const float tot = R[0] + U[0];
    float w[16];
#pragma unroll
    for (int g = 0; g < 4; ++g) {
        const float b3 = carry + R[g] + (hh == 0 ? Tp[g] : 0.f);
        const float b2 = b3 + L[4 * g + 3], b1 = b2 + L[4 * g + 2], b0 = b1 + L[4 * g + 1];
        w[4 * g + 3] = __builtin_amdgcn_exp2f(e[4 * g + 3] + b3);
        w[4 * g + 2] = __builtin_amdgcn_exp2f(e[4 * g + 2] + b2);
        w[4 * g + 1] = __builtin_amdgcn_exp2f(e[4 * g + 1] + b1);
        w[4 * g + 0] = __builtin_amdgcn_exp2f(e[4 * g + 0] + b0);
    }
    carry += tot;
    bf16x8 pf[2];
#pragma unroll
    for (int s = 0; s < 2; ++s) { u32x4 pw; pw.x = pk2(w[8 * s], w[8 * s + 1]); pw.y = pk2(w[8 * s + 2], w[8 * s + 3]); pw.z = pk2(w[8 * s + 4], w[8 * s + 5]); pw.w = pk2(w[8 * s + 6], w[8 * s + 7]); pf[s] = __builtin_bit_cast(bf16x8, pw); }
    pv_block(o, vl, pf, lane);
}
__device__ __forceinline__ void cb_block(const bf16x8 (&kf)[4], const bf16x8 (&qf)[4], LAS unsigned char* vl, const LAS float* bl, int tq, int keypos0, int nvalid, float& m, float& l, f32x16 (&o)[2], int lane) {
    const int hh = lane >> 5;
    const f32x16 S = qk_block(kf, qf);
    float s[16]; float bm = -INFINITY;
#pragma unroll
    for (int r = 0; r < 16; ++r) {
        const int kr = (r & 3) + 8 * (r >> 2) + 4 * hh; int d = tq - (keypos0 + kr); d = d < -128 ? -128 : (d > 128 ? 128 : d);
        s[r] = (kr < nvalid) ? S[r] + bl[d + 128] : -INFINITY; bm = fmaxf(bm, s[r]);
    }
    bm = fmaxf(bm, partner32(bm));
    const float mn = fmaxf(m, bm), f = __builtin_amdgcn_exp2f(m - mn); m = mn;
    float w[16], ls = 0.f;
#pragma unroll
    for (int r = 0; r < 16; ++r) { w[r] = __builtin_amdgcn_exp2f(s[r] - mn); ls += w[r]; }
    l = l * f + ls;
#pragma unroll
    for (int db = 0; db < 2; ++db)
#pragma unroll
        for (int r = 0; r < 16; ++r) o[db][r] *= f;
    bf16x8 pf[2];
#pragma unroll
    for (int s2 = 0; s2 < 2; ++s2) { u32x4 pw; pw.x = pk2(w[8 * s2], w[8 * s2 + 1]); pw.y = pk2(w[8 * s2 + 2], w[8 * s2 + 3]); pw.z = pk2(w[8 * s2 + 4], w[8 * s2 + 5]); pw.w = pk2(w[8 * s2 + 6], w[8 * s2 + 7]); pf[s2] = __builtin_bit_cast(bf16x8, pw); }
    pv_block(o, vl, pf, lane);
}
__device__ __forceinline__ void attn_store(f32x16 (&o)[2], float scale, const float* gain, bf16_t* mix, size_t row0, int col0, int nrows, LAS unsigned char* wl, int lane) {
    const int r = lane & 31, hh = lane >> 5;
    float ssq = 0.f;
#pragma unroll
    for (int db = 0; db < 2; ++db)
#pragma unroll
        for (int i = 0; i < 16; ++i) { o[db][i] *= scale; ssq += o[db][i] * o[db][i]; }
    ssq += partner32(ssq);
    const float rstd = rsqrtf(ssq * (1.0f / 64.0f) + EPS);
    LAS unsigned char* st = wl + AW_ST;
#pragma unroll
    for (int db = 0; db < 2; ++db)
#pragma unroll
        for (int g = 0; g < 4; ++g) { const int d0 = 32 * db + 8 * g + 4 * hh; const f32x4 gv = *(const f32x4*)(gain + d0);
            u32x2 w; w.x = pk2(o[db][4 * g] * rstd * gv[0], o[db][4 * g + 1] * rstd * gv[1]); w.y = pk2(o[db][4 * g + 2] * rstd * gv[2], o[db][4 * g + 3] * rstd * gv[3]);
            *(LAS u32x2*)(st + r * ST_PITCH + d0 * 2) = w; }
#pragma unroll
    for (int i = 0; i < 4; ++i) { const int row = 8 * i + (lane >> 3), ch = lane & 7; const u32x4 v = *(const LAS u32x4*)(st + row * ST_PITCH + ch * 16);
        if (row < nrows) *(u32x4*)(mix + (row0 + row) * DM + col0 + ch * 8) = v; }
}

template <bool F32> __device__ __forceinline__ void sb_loop(const void* kbase, const void* vbase, size_t rowbase, int jhi, int h, const bf16x8 (&qf)[4], int tq, float& carry, f32x16 (&o)[2], LAS unsigned char* wl, int lane) {
    const int r = lane & 31, hh = lane >> 5;
    bf16x8 kn[4]; u32x4 vn[4];
    ld_k<F32>(kn, kbase, (rowbase + 32 * jhi + r) * HW + h * 64 + 32 * hh); ld_v<F32>(vn, vbase, rowbase + 32 * jhi, 32, h, lane);
    for (int j = jhi; j >= 0; --j) {
        bf16x8 kf[4];
#pragma unroll
        for (int kk = 0; kk < 4; ++kk) kf[kk] = kn[kk];
        st_v(wl + AW_V, vn, lane);
        if (j > 0) { ld_k<F32>(kn, kbase, (rowbase + 32 * (j - 1) + r) * HW + h * 64 + 32 * hh); ld_v<F32>(vn, vbase, rowbase + 32 * (j - 1), 32, h, lane); }
        sb_block(kf, qf, wl + AW_V, tq, 32 * j, carry, o, lane);
#if SB_EARLY
        if (__all(carry < SB_THR)) break;
#endif
    }
}
template <bool SAMPLE> __device__ __forceinline__ void sb_unit(const AttnArgs& A, int b, int h, int qb, LAS unsigned char* wl, int lane) {
    const int r = lane & 31, hh = lane >> 5;
    const bf16_t* Qa = QKV_; const bf16_t* Ka = Qa + (size_t)1 * MT * HW; const bf16_t* Va = Qa + (size_t)2 * MT * HW;
    int tq; size_t qrow;
    if (SAMPLE) { tq = PAST + (r & 15); qrow = (size_t)MP + b * DSEQ + (r & 15); } else { tq = 32 * qb + r; qrow = (size_t)b * SEQ + tq; }
    bf16x8 qf[4]; ld_k<false>(qf, Qa, qrow * HW + h * 64 + 32 * hh);
    float carry = 0.f; f32x16 o[2]; o[0] = f32x16{}; o[1] = f32x16{};
    if (SAMPLE) {
        bf16x8 kf[4]; u32x4 vr[4]; const size_t row0 = (size_t)MP + b * DSEQ;
        ld_k<false>(kf, Ka, (row0 + (r & 15)) * HW + h * 64 + 32 * hh); ld_v<false>(vr, Va, row0, DSEQ, h, lane); st_v(wl + AW_V, vr, lane);
        sb_block(kf, qf, wl + AW_V, tq, PAST, carry, o, lane);
        sb_loop<true>(ARG(4) + (size_t)A.L * NBATCH * PAST * HW, ARG(5) + (size_t)A.L * NBATCH * PAST * HW, (size_t)b * PAST, PAST / 32 - 1, h, qf, tq, carry, o, wl, lane);
        attn_store(o, 1.f, ARG(11) + A.L * HW + h * 64, MIX_, row0, h * 64, DSEQ, wl, lane);
    } else {
        sb_loop<false>(Ka, Va, (size_t)b * SEQ, qb, h, qf, tq, carry, o, wl, lane);
        attn_store(o, 1.f, ARG(11) + A.L * HW + h * 64, MIX_, (size_t)b * SEQ + 32 * qb, h * 64, 32, wl, lane);
    }
}
template <bool F32> __device__ __forceinline__ void cb_loop(const void* kbase, const void* vbase, size_t rowbase, int jlo, int jhi, int pos0, int h, const bf16x8 (&qf)[4], int tq, float& m, float& l, f32x16 (&o)[2], LAS unsigned char* wl, int lane) {
    const int r = lane & 31, hh = lane >> 5;
    bf16x8 kn[4]; u32x4 vn[4];
    ld_k<F32>(kn, kbase, (rowbase + 32 * jlo + r) * HW + h * 64 + 32 * hh); ld_v<F32>(vn, vbase, rowbase + 32 * jlo, 32, h, lane);
    for (int j = jlo; j <= jhi; ++j) {
        bf16x8 kf[4];
#pragma unroll
        for (int kk = 0; kk < 4; ++kk) kf[kk] = kn[kk];
        st_v(wl + AW_V, vn, lane);
        if (j < jhi) { ld_k<F32>(kn, kbase, (rowbase + 32 * (j + 1) + r) * HW + h * 64 + 32 * hh); ld_v<F32>(vn, vbase, rowbase + 32 * (j + 1), 32, h, lane); }
        cb_block(kf, qf, wl + AW_V, (const LAS float*)(wl + AW_BIAS), tq, pos0 + 32 * j, 32, m, l, o, lane);
    }
}
template <bool SAMPLE> __device__ __forceinline__ void cb_unit(const AttnArgs& A, int b, int h, int qb, LAS unsigned char* wl, int lane) {
    const int r = lane & 31, hh = lane >> 5;
    const bf16_t* Qb = QKV_ + (size_t)3 * MT * HW; const bf16_t* Kb = Qb + (size_t)1 * MT * HW; const bf16_t* Vb = Qb + (size_t)2 * MT * HW;
    LAS float* bl = (LAS float*)(wl + AW_BIAS);
#pragma unroll
    for (int i = 0; i < 5; ++i) { const int idx = lane + 64 * i; if (idx < 257) bl[idx] = (ARG(10) + (size_t)A.L * 257 * 8)[idx * 8 + h] * LOG2E; }
    int tq; size_t qrow;
    if (SAMPLE) { tq = PAST + (r & 15); qrow = (size_t)MP + b * DSEQ + (r & 15); } else { tq = 32 * qb + r; qrow = (size_t)b * SEQ + tq; }
    bf16x8 qf[4]; ld_k<false>(qf, Qb, qrow * HW + h * 64 + 32 * hh);
    float m = -INFINITY, l = 0.f; f32x16 o[2]; o[0] = f32x16{}; o[1] = f32x16{};
    if (SAMPLE) {
        cb_loop<true>(ARG(6) + (size_t)A.L * NBATCH * BANDL * HW, ARG(7) + (size_t)A.L * NBATCH * BANDL * HW, (size_t)b * BANDL, 0, BANDL / 32 - 1, PAST - BANDL, h, qf, tq, m, l, o, wl, lane);
        bf16x8 kf[4]; u32x4 vr[4]; const size_t row0 = (size_t)MP + b * DSEQ;
        ld_k<false>(kf, Kb, (row0 + (r & 15)) * HW + h * 64 + 32 * hh); ld_v<false>(vr, Vb, row0, DSEQ, h, lane); st_v(wl + AW_V, vr, lane);
        cb_block(kf, qf, wl + AW_V, bl, tq, PAST, DSEQ, m, l, o, lane);
        l += partner32(l);
        attn_store(o, 1.0f / l, ARG(12) + A.L * HW + h * 64, MIX_, row0, HW + h * 64, DSEQ, wl, lane);
    } else {
        const int c = qb >> 1, clo = c - 8 < 0 ? 0 : c - 8;
        cb_loop<false>(Kb, Vb, (size_t)b * SEQ, 2 * clo, 2 * c + 1, 0, h, qf, tq, m, l, o, wl, lane);
        l += partner32(l);
        attn_store(o, 1.0f / l, ARG(12) + A.L * HW + h * 64, MIX_, (size_t)b * SEQ + 32 * qb, HW + h * 64, 32, wl, lane);
    }
}
constexpr unsigned AU_SSB = 64, AU_SCB = 128, AU_PSB = 128 + 4096, AU_ALL = 128 + 8192;
__device__ __forceinline__ void attn_phase(const AttnArgs& A, LAS unsigned char* lds) {
    const int tid_ = fresh_tid(), lane = tid_ & 63, wave = __builtin_amdgcn_readfirstlane(tid_ >> 6);
    LAS unsigned char* wl = lds + wave * AW_BYTES;
    for (;;) {
        unsigned u = 0; if (lane == 0) u = atomicAdd(WS_PTR(unsigned, WS_CTL) + A.L, 1u);
        u = __builtin_amdgcn_readfirstlane(u);
        if (u >= AU_ALL) break;
        if (u < AU_SSB) sb_unit<true>(A, u >> 3, u & 7, 0, wl, lane);
        else if (u < AU_SCB) { const unsigned v = u - AU_SSB; cb_unit<true>(A, v >> 3, v & 7, 0, wl, lane); }
        else if (u < AU_PSB) { const unsigned v = u - AU_SCB; const int bh = v >> 6; sb_unit<false>(A, bh >> 3, bh & 7, 63 - (int)(v & 63), wl, lane); }
        else { const unsigned v = u - AU_PSB; const int bh = v >> 6; cb_unit<false>(A, bh >> 3, bh & 7, (int)(v & 63), wl, lane); }
    }
}

__device__ __forceinline__ void p0_item(const float* W, int K, int N, const float* gain, bf16_t* WT, int kind, LAS float* scr, int item, int lane) {
    const int nblk = N / 32, kb = item / nblk, nb = item % nblk, k0 = 64 * kb, n0 = 32 * nb;
#pragma unroll 8
    for (int i = 0; i < 32; ++i) { const int kk = 2 * i + (lane >> 5); const float g = gain ? gain[k0 + kk] : 1.f; scr[kk * 33 + (lane & 31)] = W[(size_t)(k0 + kk) * N + n0 + (lane & 31)] * g; }
    asm volatile("s_waitcnt lgkmcnt(0)" ::: "memory");
    const int c = lane & 7;
#pragma unroll
    for (int j = 0; j < 4; ++j) { const int n = (lane >> 3) + 8 * j; const LAS float* s = scr + (8 * c) * 33 + n;
        u32x4 o; o.x = pk2(s[0 * 33], s[1 * 33]); o.y = pk2(s[2 * 33], s[3 * 33]); o.z = pk2(s[4 * 33], s[5 * 33]); o.w = pk2(s[6 * 33], s[7 * 33]);
        const int gn = n0 + n; const int drow = kind == 0 ? gn : ((gn >> 7) * 256 + (gn & 127) + (kind == 2 ? 128 : 0));
        *(u32x4*)(WT + (size_t)drow * K + k0 + 8 * c) = o; }
    asm volatile("s_waitcnt lgkmcnt(0)" ::: "memory");
}

#ifdef NO_SGEMM
#define SG(x)
#else
#define SG(x) x
#endif
#ifndef GP1
#define GP1(...) __VA_ARGS__
#endif
#ifndef GP2
#define GP2(...) __VA_ARGS__
#endif
#ifndef GP3
#define GP3(...) __VA_ARGS__
#endif
#ifndef GP4
#define GP4(...) __VA_ARGS__
#endif
#ifndef GP5
#define GP5(...) __VA_ARGS__
#endif
#ifndef GP6
#define GP6(...) __VA_ARGS__
#endif
#ifdef NO_SGEMM
#define SG(x)
#else
#define SG(x) x
#endif
#ifndef GP1
#define GP1(...) __VA_ARGS__
#endif
#ifndef GP2
#define GP2(...) __VA_ARGS__
#endif
#ifndef GP3
#define GP3(...) __VA_ARGS__
#endif
#ifndef GP4
#define GP4(...) __VA_ARGS__
#endif
#ifndef GP5
#define GP5(...) __VA_ARGS__
#endif
#ifndef GP6
#define GP6(...) __VA_ARGS__
#endif
struct Args { const float* in[22]; float* out; unsigned char* ws; };

__global__ void __launch_bounds__(NTHREADS, 2) hymba_fwd(Args args) {
    extern __shared__ __attribute__((aligned(16))) unsigned char lds_raw[];
    cg::grid_group grid = cg::this_grid();
    LAS unsigned char* lds = (LAS unsigned char*)lds_raw;
    const int G = gridDim.x;

    {
        const int tid = fresh_tid(), lane = tid & 63, wave = __builtin_amdgcn_readfirstlane(tid >> 6);
        const int gw = blockIdx.x * NWAVES + wave, NGW = G * NWAVES;
        { float* ssb = SSB; for (int i = blockIdx.x * NTHREADS + tid; i < 6 * MT; i += G * NTHREADS) ssb[MT + i] = 0.f;
          if (blockIdx.x == 0 && tid < 16) WS_PTR(unsigned, WS_CTL)[tid] = 0u; }
        LAS float* scr = (LAS float*)(lds + wave * 8704);
        constexpr int I_IN = 16 * 96, I_OUT = 16 * 32, I_G = 16 * 88, I_D = 44 * 32, I_PG = 16 * 32, I_PP = 4 * 32, I_L = I_IN + I_OUT + 2 * I_G + I_D + I_PG + I_PP;
        for (int it = gw; it < NLAYER * I_L; it += NGW) {
            const int L = it / I_L; int r = it % I_L;
            if (r < I_IN) { p0_item(ARG(9) + (size_t)L * DM * NQKV, DM, NQKV, ARG(8) + L * DM, (bf16_t*)WPTR(L, W_IN), 0, scr, r, lane); continue; } r -= I_IN;
            if (r < I_OUT) { p0_item(ARG(13) + (size_t)L * DM * DM, DM, DM, nullptr, (bf16_t*)WPTR(L, W_OUT), 0, scr, r, lane); continue; } r -= I_OUT;
            if (r < I_G) { p0_item(ARG(15) + (size_t)L * DM * DFF, DM, DFF, ARG(14) + L * DM, (bf16_t*)WPTR(L, W_GU), 1, scr, r, lane); continue; } r -= I_G;
            if (r < I_G) { p0_item(ARG(16) + (size_t)L * DM * DFF, DM, DFF, ARG(14) + L * DM, (bf16_t*)WPTR(L, W_GU), 2, scr, r, lane); continue; } r -= I_G;
            if (r < I_D) { p0_item(ARG(17) + (size_t)L * DFF * DM, DFF, DM, nullptr, (bf16_t*)WPTR(L, W_DOWN), 0, scr, r, lane); continue; } r -= I_D;
            if (r < I_PG) { p0_item(ARG(19) + (size_t)L * DM * DM, DM, DM, ARG(18) + L * DM, (bf16_t*)WPTR(L, W_PG), 0, scr, r, lane); continue; } r -= I_PG;
            p0_item(ARG(20) + (size_t)L * PLED * DM, PLED, DM, nullptr, (bf16_t*)WPTR(L, W_PP), 0, scr, r, lane);
        }
        { const float* pp = ARG(2); const float* ps = ARG(3); bf16_t* PB = PB_;
          for (int it = gw; it < NLAYER * MT; it += NGW) {
            const int L = it / MT, row = it % MT;
            const float* src = row < MP ? pp + ((size_t)L * MP + row) * PLED : ps + ((size_t)L * MS + (row - MP)) * PLED;
            const f32x4 v = *((const f32x4*)src + lane);
            u32x2 w; w.x = pk2(v[0], v[1]); w.y = pk2(v[2], v[3]);
            *((u32x2*)(PB + (size_t)it * PLED) + lane) = w;
          } }
        { const float* x_p = ARG(0); const float* x_s = ARG(1); bf16_t* XB = XB_; float* ssb = SSB;
          for (int row = gw; row < MT; row += NGW) {
            const float* src = row < MP ? x_p + (size_t)row * DM : x_s + (size_t)(row - MP) * DM;
            float s = 0.f;
#pragma unroll
            for (int j = 0; j < 4; ++j) { const f32x4 v = *((const f32x4*)src + lane + 64 * j); s += (v[0] * v[0] + v[1] * v[1]) + (v[2] * v[2] + v[3] * v[3]);
                u32x2 w; w.x = pk2(v[0], v[1]); w.y = pk2(v[2], v[3]); *((u32x2*)(XB + (size_t)row * DM) + lane + 64 * j) = w; }
            s = wave_sum(s);
            if (lane == 0) ssb[row] = s;
          } }
    }
    grid.sync();

    for (int L = 0; L < NLAYER; ++L) {
#define SS_MIX (SSB + (size_t)(3 * L) * MT)
#define SS_FFN (SSB + (size_t)(3 * L + 1) * MT)
#define SS_PLE (SSB + (size_t)(3 * L + 2) * MT)
#define SS_NEXT (SSB + (size_t)(3 * L + 3) * MT)
        { EpiArgs q{}; q.ss_in = SS_MIX; q.o0 = QKV_;
          q.f_sbk = ARG_OUT + O_SBK_P + (size_t)L * MP * HW; q.f_sbv = ARG_OUT + O_SBV_P + (size_t)L * MP * HW;
          q.f_cbk = ARG_OUT + O_CBK_P + (size_t)L * NBATCH * BANDL * HW; q.f_cbv = ARG_OUT + O_CBV_P + (size_t)L * NBATCH * BANDL * HW;
          pg8::Gemm g{XB_, WPTR(L, W_IN), MP, NQKV, DM}; pg8::StaticOrder S; S.init(MP, NQKV, G, (int)blockIdx.x);
          Epi<EP_QKV> E{q};
          GP1(pg8::gemm_phase<Epi<EP_QKV>, pg8::StaticOrder, true, true>(lds, g, S, E);) }
        { EpiArgs q{}; q.ss_in = SS_MIX; q.o0 = QKV_;
          q.s_sbk = ARG_OUT + O_SBK_S + (size_t)L * MS * HW; q.s_sbv = ARG_OUT + O_SBV_S + (size_t)L * MS * HW;
          q.s_cbk = ARG_OUT + O_CBK_S + (size_t)L * MS * HW; q.s_cbv = ARG_OUT + O_CBV_S + (size_t)L * MS * HW;
          SG(sgemm<EP_QKV>(lds, XB_ + (size_t)MP * DM, DM, WPTR(L, W_IN), NQKV / 32, q);) }
        grid.sync();
        { AttnArgs A{}; A.L = L;
#ifndef NO_ATTN
          attn_phase(A, lds);
#endif
        }
        grid.sync();
        { EpiArgs q{}; q.X = X_; q.XB = XB_; q.xbase = L == 0 ? ARG(0) : (const float*)X_; q.ss_out = SS_FFN;
          pg8::Gemm g{MIX_, WPTR(L, W_OUT), MP, DM, DM}; pg8::StaticOrder S; S.init(MP, DM, G, (int)blockIdx.x);
          Epi<EP_RES> E{q};
          GP2(pg8::gemm_phase<Epi<EP_RES>, pg8::StaticOrder, true, true>(lds, g, S, E);) }
        { EpiArgs q{}; q.X = X_; q.XB = XB_; q.xbase_s = L == 0 ? ARG(1) : (const float*)(X_ + (size_t)MP * DM); q.ss_out = SS_FFN;
          SG(sgemm<EP_RES>(lds, MIX_ + (size_t)MP * DM, DM, WPTR(L, W_OUT), DM / 32, q);) }
        { EpiArgs q2{}; q2.o0 = PBUF_;
          int kp = PLED; asm volatile("" : "+s"(kp));
          pg8::Gemm g2{PB_ + (size_t)L * MT * PLED, WPTR(L, W_PP), MP, DM, kp}; pg8::StaticOrder S; S.init(MP, DM, G, (int)blockIdx.x);
          Epi<EP_P> E2{q2};
          GP3(pg8::gemm_phase<Epi<EP_P>, pg8::StaticOrder, true, true>(lds, g2, S, E2);)
          SG(sgemm<EP_P>(lds, PB_ + ((size_t)L * MT + MP) * PLED, PLED, WPTR(L, W_PP), DM / 32, q2);) }
        grid.sync();
        { EpiArgs q{}; q.ss_in = SS_FFN; q.o0 = HB_;
          pg8::Gemm g{XB_, WPTR(L, W_GU), MP, 2 * DFF, DM}; pg8::StaticOrder S; S.init(MP, 2 * DFF, G, (int)blockIdx.x);
          Epi<EP_GU> E{q};
          GP4(pg8::gemm_phase<Epi<EP_GU>, pg8::StaticOrder, true, true>(lds, g, S, E);)
          SG(sgemm<EP_GU>(lds, XB_ + (size_t)MP * DM, DM, WPTR(L, W_GU), DFF / 32, q);) }
        grid.sync();
        { EpiArgs q{}; q.X = X_; q.XB = XB_; q.xbase = X_; q.xbase_s = X_ + (size_t)MP * DM; q.ss_out = SS_PLE;
          pg8::Gemm g{HB_, WPTR(L, W_DOWN), MP, DM, DFF}; pg8::StaticOrder S; S.init(MP, DM, G, (int)blockIdx.x);
          Epi<EP_RES> E{q};
          GP5(pg8::gemm_phase<Epi<EP_RES>, pg8::StaticOrder, true, true>(lds, g, S, E);)
          SG(sgemm<EP_RES>(lds, HB_ + (size_t)MP * DFF, DFF, WPTR(L, W_DOWN), DM / 32, q);) }
        grid.sync();
        { EpiArgs q{}; q.X = X_; q.XB = XB_; q.P = PBUF_; q.xbase = X_; q.xbase_s = X_ + (size_t)MP * DM; q.ss_in = SS_PLE; q.ss_out = SS_NEXT;
          pg8::Gemm g{XB_, WPTR(L, W_PG), MP, DM, DM}; pg8::StaticOrder S; S.init(MP, DM, G, (int)blockIdx.x);
          Epi<EP_PLE> E{q};
          GP6(pg8::gemm_phase<Epi<EP_PLE>, pg8::StaticOrder, true, true>(lds, g, S, E);)
          SG(sgemm<EP_PLE>(lds, XB_ + (size_t)MP * DM, DM, WPTR(L, W_PG), DM / 32, q);) }
        grid.sync();
    }
    {
        const int tid = fresh_tid(), lane = tid & 63, wave = __builtin_amdgcn_readfirstlane(tid >> 6);
        const int gw = blockIdx.x * NWAVES + wave, NGW = G * NWAVES;
        const float* ssf = SSB + (size_t)(3 * NLAYER) * MT; const float* gf = ARG(21); const float* X = X_; float* out = ARG_OUT;
        for (int row = gw; row < MT; row += NGW) {
            const float rs = rstd_of(ssf[row]);
            float* dst = row < MP ? out + O_YP + (size_t)row * DM : out + O_YS + (size_t)(row - MP) * DM;
#pragma unroll
            for (int j = 0; j < 4; ++j) { const f32x4 v = *((const f32x4*)(X + (size_t)row * DM) + lane + 64 * j); const f32x4 gv = *((const f32x4*)gf + lane + 64 * j);
                *((f32x4*)dst + lane + 64 * j) = v * rs * gv; }
        }
    }
}

extern "C" void kernel_launch(void* const* d_in, const int* in_sizes, int n_in, void* d_out, int out_size, void* d_ws, size_t ws_size, hipStream_t stream) {
    static int grid = 0;
    if (grid == 0) {
        int dev = 0, cus = 0, per_cu = 0;
        hipGetDevice(&dev);
        hipDeviceGetAttribute(&cus, hipDeviceAttributeMultiprocessorCount, dev);
        hipFuncSetAttribute((const void*)hymba_fwd, hipFuncAttributeMaxDynamicSharedMemorySize, LDS_BYTES);
        hipOccupancyMaxActiveBlocksPerMultiprocessor(&per_cu, (const void*)hymba_fwd, NTHREADS, LDS_BYTES);
        if (per_cu < 1) per_cu = 1;
        grid = cus * per_cu;
        if (n_in != 22 || ws_size < WS_END) { fprintf(stderr, "kernel_launch: unexpected n_in %d / ws_size %zu\n", n_in, ws_size); }
    }
    Args a{};
    for (int i = 0; i < 22; ++i) a.in[i] = (const float*)d_in[i];
    a.out = (float*)d_out; a.ws = (unsigned char*)d_ws;
    void* kargs[] = {&a};
    hipError_t e = hipLaunchCooperativeKernel((const void*)hymba_fwd, dim3(grid), dim3(NTHREADS), kargs, LDS_BYTES, stream);
    if (e != hipSuccess) fprintf(stderr, "cooperative launch failed: %s (grid %d)\n", hipGetErrorString(e), grid);
}
```

```cpp
#include <hip/hip_runtime.h>
#include <hip/hip_cooperative_groups.h>
#include <cstdio>
#include <cstdint>
namespace cg = cooperative_groups;
__device__ __forceinline__ int fresh_tid() { int t = threadIdx.x; asm volatile("" : "+v"(t)); return t; }
namespace pg8 {
#define PG8_LAS __attribute__((address_space(3)))
typedef unsigned short bf16_t;
typedef short bf16x8 __attribute__((ext_vector_type(8)));
typedef float f32x4 __attribute__((ext_vector_type(4)));
typedef unsigned u32x4 __attribute__((ext_vector_type(4)));
constexpr int BM = 256, BK = 64, HALF = 128, HTB = HALF * BK * 2  , STAGE_BYTES = 8 * HTB, NXCD = 8, WGM = 8;

__host__ __device__ __forceinline__ int lds_byte(int r, int c) { const int st = (r >> 4) * 2 + (c >> 5), rr = r & 15, cc = c & 31, ob = rr * 64 + cc * 2; return st * 1024 + (ob ^ (((ob >> 9) & 1) << 5)); }
__host__ __device__ __forceinline__ void stage_rc(int b, int& R, int& C) { const int st = b / 1024, sb = b % 1024, swz = sb ^ (((sb >> 9) & 1) << 5); R = (st >> 1) * 16 + swz / 64; C = (st & 1) * 32 + (swz % 64) / 2; }
__host__ __device__ __forceinline__ int perm32(int rho) { const int n = rho >> 4, i = rho & 15; return 8 * (i >> 2) + 4 * n + (i & 3); }

struct Unit { int pm, pn; };
struct Gemm { const bf16_t* A; const bf16_t* Bt; int M, N, K; };

struct StaticOrder {
    int nM, nN, nwg, G, c;
    __host__ __device__ void init(int M, int N, int G_, int c_) { nM = M / BM; nN = N / BM; nwg = nM * nN; G = G_; c = c_; }
    __host__ __device__ bool next(int i, Unit& u) const {
        const long L = (long)i * G + c; if (L >= nwg) return false;
        int wgid = (int)L; { const int q = nwg / NXCD, r = nwg % NXCD, xcd = wgid % NXCD, off = wgid / NXCD; wgid = (xcd < r ? xcd * (q + 1) : r * (q + 1) + (xcd - r) * q) + off; }
        const int nig = WGM * nN, gid = wgid / nig, fm = gid * WGM, gsz = (nM - fm) < WGM ? (nM - fm) : WGM;
        u.pm = fm + ((wgid % nig) % gsz); u.pn = (wgid % nig) / gsz; return true;
    }
    __device__ __forceinline__ void a_ready(const Unit&) const {}
    __device__ __forceinline__ void done(const Unit&) const {}
};

template <class Epi, class Sched, bool ALIGN_EPI = false, bool SP2 = false>
__device__ __forceinline__ void gemm_phase(PG8_LAS unsigned char* lds, const Gemm g, const Sched& S, const Epi& E) {
    const int tid = fresh_tid(), wid = __builtin_amdgcn_readfirstlane(tid >> 6), lane = tid & 63, wr = wid >> 2, wc = wid & 3, fr = lane & 15, fq = lane >> 4;
    const int K = g.K, nt = K / BK;
    unsigned voffA[2], voffB[2];
#pragma unroll
    for (int i = 0; i < 2; ++i) { int R, C; stage_rc(tid * 16 + i * 8192, R, C); const int Rb = Epi::PERM ? ((R & ~31) + perm32(R & 31)) : R;
        voffA[i] = (unsigned)(R * K + C) * 2u; voffB[i] = (unsigned)(Rb * K + C) * 2u; }
    const size_t kstep = (size_t)(BK * 2);
    const size_t hstep = (size_t)HALF * K * 2;
    const size_t tstep = 2 * hstep;
    const unsigned ldsw = (unsigned)wid * 1024u;
    const int aoff = lds_byte(wr * 64 + fr, fq * 8), boff = lds_byte(wc * 32 + fr, fq * 8);
#define PG8_SA(b, h) (((b) * 2 + (h)) * HTB)
#define PG8_SB(b, h) ((4 + (b) * 2 + (h)) * HTB)
#define PG8_STAGE(bufoff, gbase, voff) do { _Pragma("unroll") for (int _i = 0; _i < 2; ++_i) \
        __builtin_amdgcn_global_load_lds((const unsigned*)((const char*)(gbase) + (voff)[_i]), (PG8_LAS unsigned*)(lds + (bufoff) + ldsw + _i * 8192), 16, 0, 0); } while (0)
#define PG8_LDA(dst, b, h) do { _Pragma("unroll") for (int m = 0; m < 4; ++m) _Pragma("unroll") for (int k = 0; k < 2; ++k) dst[m][k] = *(const PG8_LAS bf16x8*)(lds + PG8_SA(b, h) + aoff + m * 2048 + k * 1024); } while (0)
#define PG8_LDB(dst, b, h) do { _Pragma("unroll") for (int n = 0; n < 2; ++n) _Pragma("unroll") for (int k = 0; k < 2; ++k) dst[n][k] = *(const PG8_LAS bf16x8*)(lds + PG8_SB(b, h) + boff + n * 2048 + k * 1024); } while (0)
#define PG8_MMA(ai, bj, At, Bt) do { __builtin_amdgcn_s_setprio(1); _Pragma("unroll") for (int m = 0; m < 4; ++m) _Pragma("unroll") for (int n = 0; n < 2; ++n) _Pragma("unroll") for (int k = 0; k < 2; ++k) \
        acc[ai][bj][m][n] = __builtin_amdgcn_mfma_f32_16x16x32_bf16(Bt[n][k], At[m][k], acc[ai][bj][m][n], 0, 0, 0); __builtin_amdgcn_s_setprio(0); } while (0)
#define PG8_WAIT_V(n) asm volatile("s_waitcnt vmcnt(" #n ")" ::: "memory")
#define PG8_WAIT_L(n) asm volatile("s_waitcnt lgkmcnt(" #n ")" ::: "memory")
#define PG8_BAR __builtin_amdgcn_s_barrier()
#define PG8_SCHED __builtin_amdgcn_sched_barrier(0)
    Unit cur, nxt; int ui = 0;
    if (!S.next(0, cur)) return;
    f32x4 acc[2][2][4][2];
#pragma unroll
    for (int a = 0; a < 2; ++a)
#pragma unroll
        for (int b = 0; b < 2; ++b)
#pragma unroll
            for (int m = 0; m < 4; ++m)
#pragma unroll
                for (int n = 0; n < 2; ++n) acc[a][b][m][n] = (f32x4){0.f, 0.f, 0.f, 0.f};
    bf16x8 At[4][2], B0[2][2], B1[2][2];
    const char* cA = (const char*)g.A + (size_t)cur.pm * tstep; const char* cB = (const char*)g.Bt + (size_t)cur.pn * tstep;
    S.a_ready(cur);
    if constexpr (SP2) {
        PG8_STAGE(PG8_SB(0, 0), cB, voffB); PG8_STAGE(PG8_SB(0, 1), cB + hstep, voffB); PG8_STAGE(PG8_SA(0, 0), cA, voffA); PG8_STAGE(PG8_SA(0, 1), cA + hstep, voffA);
        if (wr == 1) PG8_BAR;
        PG8_WAIT_V(2); PG8_BAR;
        PG8_STAGE(PG8_SB(1, 0), cB + kstep, voffB); PG8_STAGE(PG8_SA(1, 0), cA + kstep, voffA); PG8_STAGE(PG8_SB(1, 1), cB + hstep + kstep, voffB);
        PG8_WAIT_V(6); PG8_BAR;
    } else {
        PG8_STAGE(PG8_SB(0, 0), cB, voffB); PG8_STAGE(PG8_SA(0, 0), cA, voffA); PG8_STAGE(PG8_SB(0, 1), cB + hstep, voffB); PG8_STAGE(PG8_SA(0, 1), cA + hstep, voffA);
        if (wr == 1) PG8_BAR;
        PG8_WAIT_V(4); PG8_BAR;
        PG8_STAGE(PG8_SB(1, 0), cB + kstep, voffB); PG8_STAGE(PG8_SA(1, 0), cA + kstep, voffA); PG8_STAGE(PG8_SB(1, 1), cB + hstep + kstep, voffB);
        PG8_WAIT_V(6); PG8_BAR;
    }
    for (;;) {
        const bool has_next = S.next(ui + 1, nxt);
        const char* nA = has_next ? (const char*)g.A + (size_t)nxt.pm * tstep : cA; const char* nB = has_next ? (const char*)g.Bt + (size_t)nxt.pn * tstep : cB;
        for (int t = 0; t < nt; t += 2) {
            const bool last = (t == nt - 2);
            const char* a1 = cA + (size_t)(t + 1) * kstep;
            const char* a2 = last ? nA : cA + (size_t)(t + 2) * kstep; const char* b2 = last ? nB : cB + (size_t)(t + 2) * kstep;
            const char* a3 = a2 + kstep; const char* b3 = b2 + kstep;
            if (last && has_next) S.a_ready(nxt);
            if constexpr (SP2) {
            PG8_LDB(B0, 0, 0); PG8_LDB(B1, 0, 1); PG8_SCHED; PG8_LDA(At, 0, 0); PG8_STAGE(PG8_SA(1, 1), a1 + hstep, voffA);
            PG8_WAIT_V(8); PG8_WAIT_L(0); PG8_BAR; PG8_MMA(0, 0, At, B0); PG8_MMA(0, 1, At, B1); PG8_BAR; PG8_SCHED;
            PG8_LDA(At, 0, 1); PG8_STAGE(PG8_SB(0, 0), b2, voffB); PG8_STAGE(PG8_SB(0, 1), b2 + hstep, voffB); PG8_STAGE(PG8_SA(0, 0), a2, voffA);
            PG8_WAIT_V(8); PG8_WAIT_L(0); PG8_BAR; PG8_MMA(1, 0, At, B0); PG8_MMA(1, 1, At, B1); PG8_BAR; PG8_SCHED;
            PG8_LDB(B0, 1, 0); PG8_LDB(B1, 1, 1); PG8_SCHED; PG8_LDA(At, 1, 0); PG8_STAGE(PG8_SA(0, 1), a2 + hstep, voffA);
            PG8_WAIT_V(8); PG8_WAIT_L(0); PG8_BAR; PG8_MMA(0, 0, At, B0); PG8_MMA(0, 1, At, B1); PG8_BAR; PG8_SCHED;
            PG8_LDA(At, 1, 1); PG8_STAGE(PG8_SB(1, 0), b3, voffB); PG8_STAGE(PG8_SB(1, 1), b3 + hstep, voffB); PG8_STAGE(PG8_SA(1, 0), a3, voffA);
            PG8_WAIT_V(8); PG8_WAIT_L(0); PG8_BAR; PG8_MMA(1, 0, At, B0); PG8_MMA(1, 1, At, B1); PG8_BAR; PG8_SCHED;
            } else {
            PG8_LDB(B0, 0, 0); PG8_SCHED; PG8_LDA(At, 0, 0); PG8_STAGE(PG8_SA(1, 1), a1 + hstep, voffA);
            PG8_WAIT_L(8); PG8_BAR; PG8_WAIT_L(0); PG8_MMA(0, 0, At, B0); PG8_BAR; PG8_SCHED;
            PG8_LDB(B1, 0, 1); PG8_STAGE(PG8_SB(0, 0), b2, voffB);
            PG8_BAR; PG8_WAIT_L(0); PG8_MMA(0, 1, At, B1); PG8_BAR;
            PG8_LDA(At, 0, 1); PG8_STAGE(PG8_SA(0, 0), a2, voffA);
            PG8_BAR; PG8_WAIT_L(0); PG8_MMA(1, 0, At, B0); PG8_BAR; PG8_SCHED;
            PG8_STAGE(PG8_SB(0, 1), b2 + hstep, voffB);
            PG8_WAIT_V(6); PG8_BAR; PG8_MMA(1, 1, At, B1); PG8_BAR;
            PG8_LDB(B0, 1, 0); PG8_SCHED; PG8_LDA(At, 1, 0); PG8_STAGE(PG8_SA(0, 1), a2 + hstep, voffA);
            PG8_WAIT_L(8); PG8_BAR; PG8_WAIT_L(0); PG8_MMA(0, 0, At, B0); PG8_BAR; PG8_SCHED;
            PG8_LDB(B1, 1, 1); PG8_STAGE(PG8_SB(1, 0), b3, voffB);
            PG8_BAR; PG8_WAIT_L(0); PG8_MMA(0, 1, At, B1); PG8_BAR;
            PG8_LDA(At, 1, 1); PG8_STAGE(PG8_SA(1, 0), a3, voffA);
            PG8_BAR; PG8_WAIT_L(0); PG8_MMA(1, 0, At, B0); PG8_BAR; PG8_SCHED;
            PG8_STAGE(PG8_SB(1, 1), b3 + hstep, voffB);
            PG8_WAIT_V(6); PG8_BAR; PG8_MMA(1, 1, At, B1); PG8_BAR;
            }
        }
        if constexpr (ALIGN_EPI) { if (wr == 0) PG8_BAR; }
        if constexpr (!Epi::AFTER_DRAIN) { E(acc, cur, wr, wc, fr, fq); S.done(cur); }
        if (!has_next) break;
#pragma unroll
        for (int a = 0; a < 2; ++a)
#pragma unroll
            for (int b = 0; b < 2; ++b)
#pragma unroll
                for (int m = 0; m < 4; ++m)
#pragma unroll
                    for (int n = 0; n < 2; ++n) acc[a][b][m][n] = (f32x4){0.f, 0.f, 0.f, 0.f};
        cur = nxt; cA = nA; cB = nB; ++ui;
        if constexpr (ALIGN_EPI) { if (wr == 1) PG8_BAR; }
    }
    PG8_WAIT_V(0);
    if constexpr (!ALIGN_EPI) { if (wr == 0) PG8_BAR; }
    PG8_BAR;
    if constexpr (Epi::AFTER_DRAIN) { E.fused(acc, cur, wr, wc, fr, fq, lds, wid, lane); S.done(cur); }
#undef PG8_SA
#undef PG8_SB
#undef PG8_STAGE
#undef PG8_LDA
#undef PG8_LDB
#undef PG8_MMA
#undef PG8_WAIT_V
#undef PG8_WAIT_L
#undef PG8_BAR
#undef PG8_SCHED
}
}

#define LAS __attribute__((address_space(3)))
using pg8::bf16_t; using pg8::bf16x8; using pg8::f32x4; using pg8::u32x4;
typedef short s16x4 __attribute__((ext_vector_type(4)));
typedef float f32x16 __attribute__((ext_vector_type(16)));
typedef unsigned u32x2 __attribute__((ext_vector_type(2)));
typedef float f32x2_t __attribute__((ext_vector_type(2)));
typedef __bf16 bf16x2_t __attribute__((ext_vector_type(2)));

constexpr int DM = 1024, SEQ = 2048, NBATCH = 8, MP = NBATCH * SEQ, DSEQ = 16, MS = NBATCH * DSEQ, MT = MP + MS;
constexpr int DFF = 2816, NQKV = 3072, PLED = 256, NLAYER = 2, PAST = 2048, BANDL = 512, HW = 512;
constexpr float EPS = 1e-6f, LOG2E = 1.4426950408889634f, QSCALE = 0.125f * LOG2E;
#ifndef SB_EARLY
#define SB_EARLY 1
#endif
constexpr float SB_THR = -160.0f;

constexpr size_t MiB = 1u << 20;
constexpr size_t WS_CTL = 0, WS_SS = 64 * 1024;
constexpr size_t WS_W = 2 * MiB, W_LSTRIDE = 28 * MiB, W_IN = 0, W_OUT = 6 * MiB, W_GU = 8 * MiB, W_DOWN = 19 * MiB, W_PG = 25 * MiB, W_PP = 27 * MiB;
constexpr size_t WS_PB = 58 * MiB, WS_X = 76 * MiB, WS_XB = 142 * MiB, WS_QKV = 176 * MiB, WS_MIX = 274 * MiB, WS_P = 308 * MiB, WS_END = 342 * MiB;
constexpr int LDS_BYTES = 131072 + 1024;
constexpr int NWAVES = 8, NTHREADS = 512;

constexpr size_t O_YP = 0, O_YS = (size_t)MP * DM, O_SBK_P = O_YS + (size_t)MS * DM, O_SBV_P = O_SBK_P + (size_t)NLAYER * MP * HW,
                 O_CBK_P = O_SBV_P + (size_t)NLAYER * MP * HW, O_CBV_P = O_CBK_P + (size_t)NLAYER * NBATCH * BANDL * HW,
                 O_SBK_S = O_CBV_P + (size_t)NLAYER * NBATCH * BANDL * HW, O_SBV_S = O_SBK_S + (size_t)NLAYER * MS * HW,
                 O_CBK_S = O_SBV_S + (size_t)NLAYER * MS * HW, O_CBV_S = O_CBK_S + (size_t)NLAYER * MS * HW;

__device__ __forceinline__ unsigned pk2(float lo, float hi) { f32x2_t v = {lo, hi}; bf16x2_t b = __builtin_convertvector(v, bf16x2_t); return __builtin_bit_cast(unsigned, b); }
__device__ __forceinline__ float bf_lo(unsigned w) { return __uint_as_float(w << 16); }
__device__ __forceinline__ float bf_hi(unsigned w) { return __uint_as_float(w & 0xffff0000u); }
__device__ __forceinline__ float partner32(float v) {
    auto rr = __builtin_amdgcn_permlane32_swap(__float_as_uint(v), __float_as_uint(v), false, false);
    return (threadIdx.x & 32) ? __uint_as_float(rr[0]) : __uint_as_float(rr[1]);
}
__device__ __forceinline__ float wave_sum(float v) {
#pragma unroll
    for (int o = 1; o < 64; o <<= 1) v += __shfl_xor(v, o);
    return v;
}
__device__ __forceinline__ float rstd_of(float ss) { return rsqrtf(ss * (1.0f / DM) + EPS); }

template <int I> __device__ __forceinline__ const float* argp() {
    unsigned long long v; const void* ka = (const void*)__builtin_amdgcn_kernarg_segment_ptr();
    asm volatile("s_load_dwordx2 %0, %1, %2\n\ts_waitcnt lgkmcnt(0)" : "=s"(v) : "s"(ka), "i"(I * 8) : "memory");
    return (const float*)v;
}
#define ARG(i) argp<i>()
#define ARG_OUT ((float*)argp<22>())
#define ARG_WS ((unsigned char*)argp<23>())
#define WS_PTR(T, off) ((T*)(ARG_WS + (off)))
#define SSB WS_PTR(float, WS_SS)
#define PB_ WS_PTR(bf16_t, WS_PB)
#define X_ WS_PTR(float, WS_X)
#define XB_ WS_PTR(bf16_t, WS_XB)
#define QKV_ WS_PTR(bf16_t, WS_QKV)
#define HB_ WS_PTR(bf16_t, WS_QKV)
#define MIX_ WS_PTR(bf16_t, WS_MIX)
#define PBUF_ WS_PTR(bf16_t, WS_P)
#define WPTR(L, off) ((const bf16_t*)(ARG_WS + WS_W + (size_t)(L) * W_LSTRIDE + (off)))

enum { EP_QKV = 0, EP_RES = 1, EP_GU = 2, EP_P = 3, EP_PLE = 4 };
struct EpiArgs {
    const float* ss_in; float* ss_out;
    const float* xbase; const float* xbase_s;
    float* X; bf16_t* XB; bf16_t* o0; const bf16_t* P;
    float *f_sbk, *f_sbv, *f_cbk, *f_cbv;
    float *s_sbk, *s_sbv, *s_cbk, *s_cbv;
};
template <int MODE> struct Epi {
    static constexpr bool PERM = false, AFTER_DRAIN = false;
    EpiArgs a;
    __device__ __forceinline__ void operator()(const f32x4 (&acc)[2][2][4][2], const pg8::Unit& u, int wr, int wc, int fr, int fq) const {
        if constexpr (MODE == EP_QKV) {
            const int part = u.pn >> 1, cb = (u.pn & 1) * 256 + wc * 32 + 4 * fq;
            bf16_t* ob = a.o0 + (size_t)part * ((size_t)MT * HW);
            float* fo = part == 1 ? a.f_sbk : part == 2 ? a.f_sbv : part == 4 ? a.f_cbk : part == 5 ? a.f_cbv : nullptr;
            const bool band = part >= 4; const float qs = (part == 0 || part == 3) ? QSCALE : 1.f;
#pragma unroll
            for (int ai = 0; ai < 2; ++ai)
#pragma unroll
                for (int m = 0; m < 4; ++m) {
                    const int row = u.pm * 256 + ai * 128 + wr * 64 + m * 16 + fr;
                    const float rs = rstd_of(a.ss_in[row]) * qs;
                    const int t = row & (SEQ - 1);
                    float* frow = nullptr;
                    if (fo) { if (!band) frow = fo + (size_t)row * HW; else if (t >= SEQ - BANDL) frow = fo + ((size_t)(row >> 11) * BANDL + (t - (SEQ - BANDL))) * HW; }
#pragma unroll
                    for (int bj = 0; bj < 2; ++bj)
#pragma unroll
                        for (int n = 0; n < 2; ++n) {
                            const int col = cb + bj * 128 + n * 16; const f32x4 v = acc[ai][bj][m][n] * rs;
                            u32x2 w; w.x = pk2(v[0], v[1]); w.y = pk2(v[2], v[3]);
                            *(u32x2*)(ob + (size_t)row * HW + col) = w;
                            if (frow) *(f32x4*)(frow + col) = v;
                        }
                }
        } else if constexpr (MODE == EP_RES || MODE == EP_PLE) {
#pragma unroll
            for (int ai = 0; ai < 2; ++ai)
#pragma unroll
                for (int m = 0; m < 4; ++m) {
                    const int row = u.pm * 256 + ai * 128 + wr * 64 + m * 16 + fr;
                    float rs = 0.f; if constexpr (MODE == EP_PLE) rs = rstd_of(a.ss_in[row]) * (-LOG2E);
                    float s = 0.f;
#pragma unroll
                    for (int bj = 0; bj < 2; ++bj)
#pragma unroll
                        for (int n = 0; n < 2; ++n) {
                            const size_t off = (size_t)row * DM + u.pn * 256 + bj * 128 + wc * 32 + n * 16 + 4 * fq;
                            f32x4 x = *(const f32x4*)(a.xbase + off); const f32x4 c = acc[ai][bj][m][n];
                            if constexpr (MODE == EP_RES) x += c;
                            else { const u32x2 pw = *(const u32x2*)(a.P + off);
                                   x[0] += bf_lo(pw.x) * __builtin_amdgcn_rcpf(1.f + __builtin_amdgcn_exp2f(c[0] * rs));
                                   x[1] += bf_hi(pw.x) * __builtin_amdgcn_rcpf(1.f + __builtin_amdgcn_exp2f(c[1] * rs));
                                   x[2] += bf_lo(pw.y) * __builtin_amdgcn_rcpf(1.f + __builtin_amdgcn_exp2f(c[2] * rs));
                                   x[3] += bf_hi(pw.y) * __builtin_amdgcn_rcpf(1.f + __builtin_amdgcn_exp2f(c[3] * rs)); }
                            *(f32x4*)(a.X + off) = x;
                            u32x2 w; w.x = pk2(x[0], x[1]); w.y = pk2(x[2], x[3]); *(u32x2*)(a.XB + off) = w;
                            s += (x[0] * x[0] + x[1] * x[1]) + (x[2] * x[2] + x[3] * x[3]);
                        }
                    s += __shfl_xor(s, 16); s += __shfl_xor(s, 32);
                    if (fq == 0) unsafeAtomicAdd(a.ss_out + row, s);
                }
        } else if constexpr (MODE == EP_GU) {
#pragma unroll
            for (int ai = 0; ai < 2; ++ai)
#pragma unroll
                for (int m = 0; m < 4; ++m) {
                    const int row = u.pm * 256 + ai * 128 + wr * 64 + m * 16 + fr;
                    const float rs = rstd_of(a.ss_in[row]);
#pragma unroll
                    for (int n = 0; n < 2; ++n) {
                        const int col = u.pn * 128 + wc * 32 + n * 16 + 4 * fq;
                        const f32x4 g = acc[ai][0][m][n] * rs, up = acc[ai][1][m][n] * rs; float h[4];
#pragma unroll
                        for (int e = 0; e < 4; ++e) h[e] = g[e] * up[e] * __builtin_amdgcn_rcpf(1.f + __builtin_amdgcn_exp2f(-LOG2E * g[e]));
                        u32x2 w; w.x = pk2(h[0], h[1]); w.y = pk2(h[2], h[3]);
                        *(u32x2*)(a.o0 + (size_t)row * DFF + col) = w;
                    }
                }
        } else {
#pragma unroll
            for (int ai = 0; ai < 2; ++ai)
#pragma unroll
                for (int m = 0; m < 4; ++m) {
                    const int row = u.pm * 256 + ai * 128 + wr * 64 + m * 16 + fr;
#pragma unroll
                    for (int bj = 0; bj < 2; ++bj)
#pragma unroll
                        for (int n = 0; n < 2; ++n) {
                            const size_t off = (size_t)row * DM + u.pn * 256 + bj * 128 + wc * 32 + n * 16 + 4 * fq; const f32x4 v = acc[ai][bj][m][n];
                            u32x2 w; w.x = pk2(v[0], v[1]); w.y = pk2(v[2], v[3]); *(u32x2*)(a.o0 + off) = w;
                        }
                }
        }
    }
};

template <int MODE>
__device__ __forceinline__ void sgemm(LAS unsigned char* lds, const bf16_t* A, int K, const bf16_t* Bt, int ncol32, const EpiArgs& a) {
    const int tid = fresh_tid(), lane = tid & 63, wave = __builtin_amdgcn_readfirstlane(tid >> 6), r = lane & 31, hh = lane >> 5;
    LAS float* red = (LAS float*)lds;
    const int G = gridDim.x, K8 = K >> 3, nunits = 4 * ncol32;
    for (int j = G - 1 - (int)blockIdx.x; j < nunits; j += G) {
        const int rb = j & 3, c0 = 32 * (j >> 2);
        const int brow0 = (MODE == EP_GU) ? ((c0 >> 7) * 256 + (c0 & 127)) : c0;
        const bf16_t* ap = A + (size_t)(32 * rb + r) * K + wave * K8 + 8 * hh;
        const bf16_t* bp = Bt + (size_t)(brow0 + r) * K + wave * K8 + 8 * hh;
        f32x16 acc0 = {}, acc1 = {};
#pragma unroll 11
        for (int k = 0; k < K8; k += 16) {
            const bf16x8 af = *(const bf16x8*)(ap + k), bf = *(const bf16x8*)(bp + k);
            acc0 = __builtin_amdgcn_mfma_f32_32x32x16_bf16(af, bf, acc0, 0, 0, 0);
            if constexpr (MODE == EP_GU) { const bf16x8 bf2 = *(const bf16x8*)(bp + (size_t)128 * K + k); acc1 = __builtin_amdgcn_mfma_f32_32x32x16_bf16(af, bf2, acc1, 0, 0, 0); }
        }
#pragma unroll
        for (int i = 0; i < 16; ++i) { red[(wave * 16 + i) * 64 + lane] = acc0[i]; if constexpr (MODE == EP_GU) red[8192 + (wave * 16 + i) * 64 + lane] = acc1[i]; }
        __syncthreads();
        const int col = c0 + r;
#pragma unroll
        for (int ii = 0; ii < 2; ++ii) {
            const int i = 2 * wave + ii;
            float v0 = 0.f, v1 = 0.f;
#pragma unroll
            for (int w = 0; w < 8; ++w) { v0 += red[(w * 16 + i) * 64 + lane]; if constexpr (MODE == EP_GU) v1 += red[8192 + (w * 16 + i) * 64 + lane]; }
            const int rs_ = 32 * rb + (i & 3) + 8 * (i >> 2) + 4 * hh, row = MP + rs_;
            if constexpr (MODE == EP_QKV) {
                const int part = c0 >> 9, cc = col & 511;
                const float v = v0 * rstd_of(a.ss_in[row]);
                const float qs = (part == 0 || part == 3) ? QSCALE : 1.f;
                (a.o0 + (size_t)part * ((size_t)MT * HW))[(size_t)row * HW + cc] = (bf16_t)(pk2(v * qs, 0.f) & 0xffffu);
                float* fo = part == 1 ? a.s_sbk : part == 2 ? a.s_sbv : part == 4 ? a.s_cbk : part == 5 ? a.s_cbv : nullptr;
                if (fo) fo[(size_t)rs_ * HW + cc] = v;
            } else if constexpr (MODE == EP_RES || MODE == EP_PLE) {
                const size_t off = (size_t)row * DM + col;
                float x = a.xbase_s[(size_t)rs_ * DM + col];
                if constexpr (MODE == EP_RES) x += v0;
                else { const float pv = __uint_as_float((unsigned)a.P[off] << 16); x += pv * __builtin_amdgcn_rcpf(1.f + __builtin_amdgcn_exp2f(-LOG2E * v0 * rstd_of(a.ss_in[row]))); }
                a.X[off] = x; a.XB[off] = (bf16_t)(pk2(x, 0.f) & 0xffffu);
                float s = x * x;
                s += __shfl_xor(s, 1); s += __shfl_xor(s, 2); s += __shfl_xor(s, 4); s += __shfl_xor(s, 8); s += __shfl_xor(s, 16);
                if (r == 0) unsafeAtomicAdd(a.ss_out + row, s);
            } else if constexpr (MODE == EP_GU) {
                const float rs = rstd_of(a.ss_in[row]); const float g = v0 * rs, up = v1 * rs;
                const float h = g * up * __builtin_amdgcn_rcpf(1.f + __builtin_amdgcn_exp2f(-LOG2E * g));
                a.o0[(size_t)row * DFF + col] = (bf16_t)(pk2(h, 0.f) & 0xffffu);
            } else {
                a.o0[(size_t)row * DM + col] = (bf16_t)(pk2(v0, 0.f) & 0xffffu);
            }
        }
        __syncthreads();
    }
}
struct AttnArgs { int L; };
constexpr int AW_V = 0, AW_ST = 4096, AW_BIAS = 8704, AW_BYTES = 10240, ST_PITCH = 144;

template <bool F32> __device__ __forceinline__ void ld_k(bf16x8 (&kf)[4], const void* base, size_t off) {
    if constexpr (!F32) { const bf16_t* p = (const bf16_t*)base + off;
#pragma unroll
        for (int kk = 0; kk < 4; ++kk) kf[kk] = *(const bf16x8*)(p + 8 * kk);
    } else { const float* p = (const float*)base + off;
#pragma unroll
        for (int kk = 0; kk < 4; ++kk) { const f32x4 x = *(const f32x4*)(p + 8 * kk), y = *(const f32x4*)(p + 8 * kk + 4);
            u32x4 w; w.x = pk2(x[0], x[1]); w.y = pk2(x[2], x[3]); w.z = pk2(y[0], y[1]); w.w = pk2(y[2], y[3]); kf[kk] = __builtin_bit_cast(bf16x8, w); }
    }
}
template <bool F32> __device__ __forceinline__ void ld_v(u32x4 (&vr)[4], const void* base, size_t row0, int nvalid, int h, int lane) {
#pragma unroll
    for (int i = 0; i < 4; ++i) { int key = 8 * i + (lane >> 3); key = key < nvalid ? key : nvalid - 1;
        const size_t off = (row0 + key) * HW + h * 64 + (lane & 7) * 8;
        if constexpr (!F32) vr[i] = *(const u32x4*)((const bf16_t*)base + off);
        else { const float* p = (const float*)base + off; const f32x4 x = *(const f32x4*)p, y = *(const f32x4*)(p + 4);
            u32x4 w; w.x = pk2(x[0], x[1]); w.y = pk2(x[2], x[3]); w.z = pk2(y[0], y[1]); w.w = pk2(y[2], y[3]); vr[i] = w; }
    }
}
__device__ __forceinline__ void st_v(LAS unsigned char* vl, const u32x4 (&vr)[4], int lane) {
#pragma unroll
    for (int i = 0; i < 4; ++i) { const int key = 8 * i + (lane >> 3); *(LAS u32x4*)(vl + key * 128 + (((lane & 7) * 16) ^ (((key >> 1) & 1) << 6))) = vr[i]; }
}
typedef short v4i16_t __attribute__((ext_vector_type(4)));
__device__ __forceinline__ s16x4 vtr(LAS unsigned char* p) { return __builtin_bit_cast(s16x4, __builtin_amdgcn_ds_read_tr16_b64_v4i16((LAS v4i16_t*)p)); }
__device__ __forceinline__ void pv_block(f32x16 (&o)[2], LAS unsigned char* vl, const bf16x8 (&pf)[2], int lane) {
    const int q = (lane & 15) >> 2, p = lane & 3, c16 = (lane >> 4) & 1, hh = lane >> 5;
    const int va0 = (4 * hh + q) * 128 + ((32 * c16 + 8 * p) ^ ((q >> 1) << 6));
#pragma unroll
    for (int db = 0; db < 2; ++db)
#pragma unroll
        for (int s = 0; s < 2; ++s) {
            const s16x4 lo = vtr(vl + (va0 ^ (db * 64)) + s * 2048), hi = vtr(vl + (va0 ^ (db * 64)) + s * 2048 + 1024);
            const bf16x8 vf = {lo[0], lo[1], lo[2], lo[3], hi[0], hi[1], hi[2], hi[3]};
            o[db] = __builtin_amdgcn_mfma_f32_32x32x16_bf16(vf, pf[s], o[db], 0, 0, 0);
        }
}
__device__ __forceinline__ f32x16 qk_block(const bf16x8 (&kf)[4], const bf16x8 (&qf)[4]) {
    f32x16 S = {};
#pragma unroll
    for (int kk = 0; kk < 4; ++kk) S = __builtin_amdgcn_mfma_f32_32x32x16_bf16(kf[kk], qf[kk], S, 0, 0, 0);
    return S;
}
__device__ __forceinline__ void sb_block(const bf16x8 (&kf)[4], const bf16x8 (&qf)[4], LAS unsigned char* vl, int tq, int keypos0, float& carry, f32x16 (&o)[2], int lane) {
    const int hh = lane >> 5;
    const f32x16 S = qk_block(kf, qf);
    float L[16], e[16];
#pragma unroll
    for (int r = 0; r < 16; ++r) {
        const int kp = keypos0 + (r & 3) + 8 * (r >> 2) + 4 * hh; const bool valid = kp < tq;
        const float z = S[r];
        const float sp = fmaxf(z, 0.f) + __builtin_amdgcn_logf(1.f + __builtin_amdgcn_exp2f(-fabsf(z)));
        L[r] = valid ? -sp : 0.f; e[r] = valid ? z - sp : -INFINITY;
    }
    float T[4], Tp[4], U[4];
#pragma unroll
    for (int g = 0; g < 4; ++g) { T[g] = (L[4 * g] + L[4 * g + 1]) + (L[4 * g + 2] + L[4 * g + 3]); Tp[g] = partner32(T[g]); U[g] = T[g] + Tp[g]; }
    float R[4]; R[3] = 0.f; R[2] = U[3]; R[1] = U[3] + U[2]; R[0] = R[1] + U[1];
    const float tot = R[0] + U[0];
    float w[16];
#pragma unroll
    for (int g = 0; g < 4; ++g) {
        const float b3 = carry + R[g] + (hh == 0 ? Tp[g] : 0.f);
        const float b2 = b3 + L[4 * g + 3], b1 = b2 + L[4 * g + 2], b0 = b1 + L[4 * g + 1];
        w[4 * g + 3] = __builtin_amdgcn_exp2f(e[4 * g + 3] + b3);
        w[4 * g + 2] = __builtin_amdgcn_exp2f(e[4 * g + 2] + b2);
        w[4 * g + 1] = __builtin_amdgcn_exp2f(e[4 * g + 1] + b1);
        w[4 * g + 0] = __builtin_amdgcn_exp2f(e[4 * g + 0] + b0);
    }
    carry += tot;
    bf16x8 pf[2];
#pragma unroll
    for (int s = 0; s < 2; ++s) { u32x4 pw; pw.x = pk2(w[8 * s], w[8 * s + 1]); pw.y = pk2(w[8 * s + 2], w[8 * s + 3]); pw.z = pk2(w[8 * s + 4], w[8 * s + 5]); pw.w = pk2(w[8 * s + 6], w[8 * s + 7]); pf[s] = __builtin_bit_cast(bf16x8, pw); }
    pv_block(o, vl, pf, lane);
}
__device__ __forceinline__ void cb_block(const bf16x8 (&kf)[4], const bf16x8 (&qf)[4], LAS unsigned char* vl, const LAS float* bl, int tq, int keypos0, int nvalid, float& m, float& l, f32x16 (&o)[2], int lane) {
    const int hh = lane >> 5;
    const f32x16 S = qk_block(kf, qf);
    float s[16]; float bm = -INFINITY;
#pragma unroll
    for (int r = 0; r < 16; ++r) {
        const int kr = (r & 3) + 8 * (r >> 2) + 4 * hh; int d = tq - (keypos0 + kr); d = d < -128 ? -128 : (d > 128 ? 128 : d);
        s[r] = (kr < nvalid) ? S[r] + bl[d + 128] : -INFINITY; bm = fmaxf(bm, s[r]);
    }
    bm = fmaxf(bm, partner32(bm));
    const float mn = fmaxf(m, bm), f = __builtin_amdgcn_exp2f(m - mn); m = mn;
    float w[16], ls = 0.f;
#pragma unroll
    for (int r = 0; r < 16; ++r) { w[r] = __builtin_amdgcn_exp2f(s[r] - mn); ls += w[r]; }
    l = l * f + ls;
#pragma unroll
    for (int db = 0; db < 2; ++db)
#pragma unroll
        for (int r = 0; r < 16; ++r) o[db][r] *= f;
    bf16x8 pf[2];
#pragma unroll
    for (int s2 = 0; s2 < 2; ++s2) { u32x4 pw; pw.x = pk2(w[8 * s2], w[8 * s2 + 1]); pw.y = pk2(w[8 * s2 + 2], w[8 * s2 + 3]); pw.z = pk2(w[8 * s2 + 4], w[8 * s2 + 5]); pw.w = pk2(w[8 * s2 + 6], w[8 * s2 + 7]); pf[s2] = __builtin_bit_cast(bf16x8, pw); }
    pv_block(o, vl, pf, lane);
}
__device__ __forceinline__ void attn_store(f32x16 (&o)[2], float scale, const float* gain, bf16_t* mix, size_t row0, int col0, int nrows, LAS unsigned char* wl, int lane) {
    const int r = lane & 31, hh = lane >> 5;
    float ssq = 0.f;
#pragma unroll
    for (int db = 0; db < 2; ++db)
#pragma unroll
        for (int i = 0; i < 16; ++i) { o[db][i] *= scale; ssq += o[db][i] * o[db][i]; }
    ssq += partner32(ssq);
    const float rstd = rsqrtf(ssq * (1.0f / 64.0f) + EPS);
    LAS unsigned char* st = wl + AW_ST;
#pragma unroll
    for (int db = 0; db < 2; ++db)
#pragma unroll
        for (int g = 0; g < 4; ++g) { const int d0 = 32 * db + 8 * g + 4 * hh; const f32x4 gv = *(const f32x4*)(gain + d0);
            u32x2 w; w.x = pk2(o[db][4 * g] * rstd * gv[0], o[db][4 * g + 1] * rstd * gv[1]); w.y = pk2(o[db][4 * g + 2] * rstd * gv[2], o[db][4 * g + 3] * rstd * gv[3]);
            *(LAS u32x2*)(st + r * ST_PITCH + d0 * 2) = w; }
#pragma unroll
    for (int i = 0; i < 4; ++i) { const int row = 8 * i + (lane >> 3), ch = lane & 7; const u32x4 v = *(const LAS u32x4*)(st + row * ST_PITCH + ch * 16);
        if (row < nrows) *(u32x4*)(mix + (row0 + row) * DM + col0 + ch * 8) = v; }
}

template <bool F32> __device__ __forceinline__ void sb_loop(const void* kbase, const void* vbase, size_t rowbase, int jhi, int h, const bf16x8 (&qf)[4], int tq, float& carry, f32x16 (&o)[2], LAS unsigned char* wl, int lane) {
    const int r = lane & 31, hh = lane >> 5;
    bf16x8 kn[4]; u32x4 vn[4];
    ld_k<F32>(kn, kbase, (rowbase + 32 * jhi + r) * HW + h * 64 + 32 * hh); ld_v<F32>(vn, vbase, rowbase + 32 * jhi, 32, h, lane);
    for (int j = jhi; j >= 0; --j) {
        bf16x8 kf[4];
#pragma unroll
        for (int kk = 0; kk < 4; ++kk) kf[kk] = kn[kk];
        st_v(wl + AW_V, vn, lane);
        if (j > 0) { ld_k<F32>(kn, kbase, (rowbase + 32 * (j - 1) + r) * HW + h * 64 + 32 * hh); ld_v<F32>(vn, vbase, rowbase + 32 * (j - 1), 32, h, lane); }
        sb_block(kf, qf, wl + AW_V, tq, 32 * j, carry, o, lane);
#if SB_EARLY
        if (__all(carry < SB_THR)) break;
#endif
    }
}
template <bool SAMPLE> __device__ __forceinline__ void sb_unit(const AttnArgs& A, int b, int h, int qb, LAS unsigned char* wl, int lane) {
    const int r = lane & 31, hh = lane >> 5;
    const bf16_t* Qa = QKV_; const bf16_t* Ka = Qa + (size_t)1 * MT * HW; const bf16_t* Va = Qa + (size_t)2 * MT * HW;
    int tq; size_t qrow;
    if (SAMPLE) { tq = PAST + (r & 15); qrow = (size_t)MP + b * DSEQ + (r & 15); } else { tq = 32 * qb + r; qrow = (size_t)b * SEQ + tq; }
    bf16x8 qf[4]; ld_k<false>(qf, Qa, qrow * HW + h * 64 + 32 * hh);
    float carry = 0.f; f32x16 o[2]; o[0] = f32x16{}; o[1] = f32x16{};
    if (SAMPLE) {
        bf16x8 kf[4]; u32x4 vr[4]; const size_t row0 = (size_t)MP + b * DSEQ;
        ld_k<false>(kf, Ka, (row0 + (r & 15)) * HW + h * 64 + 32 * hh); ld_v<false>(vr, Va, row0, DSEQ, h, lane); st_v(wl + AW_V, vr, lane);
        sb_block(kf, qf, wl + AW_V, tq, PAST, carry, o, lane);
        sb_loop<true>(ARG(4) + (size_t)A.L * NBATCH * PAST * HW, ARG(5) + (size_t)A.L * NBATCH * PAST * HW, (size_t)b * PAST, PAST / 32 - 1, h, qf, tq, carry, o, wl, lane);
        attn_store(o, 1.f, ARG(11) + A.L * HW + h * 64, MIX_, row0, h * 64, DSEQ, wl, lane);
    } else {
        sb_loop<false>(Ka, Va, (size_t)b * SEQ, qb, h, qf, tq, carry, o, wl, lane);
        attn_store(o, 1.f, ARG(11) + A.L * HW + h * 64, MIX_, (size_t)b * SEQ + 32 * qb, h * 64, 32, wl, lane);
    }
}
template <bool F32> __device__ __forceinline__ void cb_loop(const void* kbase, const void* vbase, size_t rowbase, int jlo, int jhi, int pos0, int h, const bf16x8 (&qf)[4], int tq, float& m, float& l, f32x16 (&o)[2], LAS unsigned char* wl, int lane) {
    const int r = lane & 31, hh = lane >> 5;
    bf16x8 kn[4]; u32x4 vn[4];
    ld_k<F32>(kn, kbase, (rowbase + 32 * jlo + r) * HW + h * 64 + 32 * hh); ld_v<F32>(vn, vbase, rowbase + 32 * jlo, 32, h, lane);
    for (int j = jlo; j <= jhi; ++j) {
        bf16x8 kf[4];
#pragma unroll
        for (int kk = 0; kk < 4; ++kk) kf[kk] = kn[kk];
        st_v(wl + AW_V, vn, lane);
        if (j < jhi) { ld_k<F32>(kn, kbase, (rowbase + 32 * (j + 1) + r) * HW + h * 64 + 32 * hh); ld_v<F32>(vn, vbase, rowbase + 32 * (j + 1), 32, h, lane); }
        cb_block(kf, qf, wl + AW_V, (const LAS float*)(wl + AW_BIAS), tq, pos0 + 32 * j, 32, m, l, o, lane);
    }
}
template <bool SAMPLE> __device__ __forceinline__ void cb_unit(const AttnArgs& A, int b, int h, int qb, LAS unsigned char* wl, int lane) {
    const int r = lane & 31, hh = lane >> 5;
    const bf16_t* Qb = QKV_ + (size_t)3 * MT * HW; const bf16_t* Kb = Qb + (size_t)1 * MT * HW; const bf16_t* Vb = Qb + (size_t)2 * MT * HW;
    LAS float* bl = (LAS float*)(wl + AW_BIAS);
#pragma unroll
    for (int i = 0; i < 5; ++i) { const int idx = lane + 64 * i; if (idx < 257) bl[idx] = (ARG(10) + (size_t)A.L * 257 * 8)[idx * 8 + h] * LOG2E; }
    int tq; size_t qrow;
    if (SAMPLE) { tq = PAST + (r & 15); qrow = (size_t)MP + b * DSEQ + (r & 15); } else { tq = 32 * qb + r; qrow = (size_t)b * SEQ + tq; }
    bf16x8 qf[4]; ld_k<false>(qf, Qb, qrow * HW + h * 64 + 32 * hh);
    float m = -INFINITY, l = 0.f; f32x16 o[2]; o[0] = f32x16{}; o[1] = f32x16{};
    if (SAMPLE) {
        cb_loop<true>(ARG(6) + (size_t)A.L * NBATCH * BANDL * HW, ARG(7) + (size_t)A.L * NBATCH * BANDL * HW, (size_t)b * BANDL, 0, BANDL / 32 - 1, PAST - BANDL, h, qf, tq, m, l, o, wl, lane);
        bf16x8 kf[4]; u32x4 vr[4]; const size_t row0 = (size_t)MP + b * DSEQ;
        ld_k<false>(kf, Kb, (row0 + (r & 15)) * HW + h * 64 + 32 * hh); ld_v<false>(vr, Vb, row0, DSEQ, h, lane); st_v(wl + AW_V, vr, lane);
        cb_block(kf, qf, wl + AW_V, bl, tq, PAST, DSEQ, m, l, o, lane);
        l += partner32(l);
        attn_store(o, 1.0f / l, ARG(12) + A.L * HW + h * 64, MIX_, row0, HW + h * 64, DSEQ, wl, lane);
    } else {
        const int c = qb >> 1, clo = c - 8 < 0 ? 0 : c - 8;
        cb_loop<false>(Kb, Vb, (size_t)b * SEQ, 2 * clo, 2 * c + 1, 0, h, qf, tq, m, l, o, wl, lane);
        l += partner32(l);
        attn_store(o, 1.0f / l, ARG(12) + A.L * HW + h * 64, MIX_, (size_t)b * SEQ + 32 * qb, HW + h * 64, 32, wl, lane);
    }
}
constexpr unsigned AU_SSB = 64, AU_SCB = 128, AU_PSB = 128 + 4096, AU_ALL = 128 + 8192;
__device__ __forceinline__ void attn_phase(const AttnArgs& A, LAS unsigned char* lds) {
    const int tid_ = fresh_tid(), lane = tid_ & 63, wave = __builtin_amdgcn_readfirstlane(tid_ >> 6);
    LAS unsigned char* wl = lds + wave * AW_BYTES;
    for (;;) {
        unsigned u = 0; if (lane == 0) u = atomicAdd(WS_PTR(unsigned, WS_CTL) + A.L, 1u);
        u = __builtin_amdgcn_readfirstlane(u);
        if (u >= AU_ALL) break;
        if (u < AU_SSB) sb_unit<true>(A, u >> 3, u & 7, 0, wl, lane);
        else if (u < AU_SCB) { const unsigned v = u - AU_SSB; cb_unit<true>(A, v >> 3, v & 7, 0, wl, lane); }
        else if (u < AU_PSB) { const unsigned v = u - AU_SCB; const int bh = v >> 6; sb_unit<false>(A, bh >> 3, bh & 7, 63 - (int)(v & 63), wl, lane); }
        else { const unsigned v = u - AU_PSB; const int bh = v >> 6; cb_unit<false>(A, bh >> 3, bh & 7, (int)(v & 63), wl, lane); }
    }
}

__device__ __forceinline__ void p0_item(const float* W, int K, int N, const float* gain, bf16_t* WT, int kind, LAS float* scr, int item, int lane) {
    const int nblk = N / 32, kb = item / nblk, nb = item % nblk, k0 = 64 * kb, n0 = 32 * nb;
#pragma unroll 8
    for (int i = 0; i < 32; ++i) { const int kk = 2 * i + (lane >> 5); const float g = gain ? gain[k0 + kk] : 1.f; scr[kk * 33 + (lane & 31)] = W[(size_t)(k0 + kk) * N + n0 + (lane & 31)] * g; }
    asm volatile("s_waitcnt lgkmcnt(0)" ::: "memory");
    const int c = lane & 7;
#pragma unroll
    for (int j = 0; j < 4; ++j) { const int n = (lane >> 3) + 8 * j; const LAS float* s = scr + (8 * c) * 33 + n;
        u32x4 o; o.x = pk2(s[0 * 33], s[1 * 33]); o.y = pk2(s[2 * 33], s[3 * 33]); o.z = pk2(s[4 * 33], s[5 * 33]); o.w = pk2(s[6 * 33], s[7 * 33]);
        const int gn = n0 + n; const int drow = kind == 0 ? gn : ((gn >> 7) * 256 + (gn & 127) + (kind == 2 ? 128 : 0));
        *(u32x4*)(WT + (size_t)drow * K + k0 + 8 * c) = o; }
    asm volatile("s_waitcnt lgkmcnt(0)" ::: "memory");
}

#ifdef NO_SGEMM
#define SG(x)
#else
#define SG(x) x
#endif
#ifndef GP1
#define GP1(...) __VA_ARGS__
#endif
#ifndef GP2
#define GP2(...) __VA_ARGS__
#endif
#ifndef GP3
#define GP3(...) __VA_ARGS__
#endif
#ifndef GP4
#define GP4(...) __VA_ARGS__
#endif
#ifndef GP5
#define GP5(...) __VA_ARGS__
#endif
#ifndef GP6
#define GP6(...) __VA_ARGS__
#endif
#ifdef NO_SGEMM
#define SG(x)
#else
#define SG(x) x
#endif
#ifndef GP1
#define GP1(...) __VA_ARGS__
#endif
#ifndef GP2
#define GP2(...) __VA_ARGS__
#endif
#ifndef GP3
#define GP3(...) __VA_ARGS__
#endif
#ifndef GP4
#define GP4(...) __VA_ARGS__
#endif
#ifndef GP5
#define GP5(...) __VA_ARGS__
#endif
#ifndef GP6
#define GP6(...) __VA_ARGS__
#endif
struct Args { const float* in[22]; float* out; unsigned char* ws; };

#ifndef PROBE_SEL
#define PROBE_SEL -1
#endif
#if PROBE_SEL >= 0
#define TSTAMP(cat) do { if (blockIdx.x == 0 && fresh_tid() == 0) { const unsigned long long t_ = __builtin_amdgcn_s_memrealtime(); unsigned long long* tsb = WS_PTR(unsigned long long, WS_CTL + 4096); \
    tsb[16 + (cat)] += t_ - tsb[0]; tsb[0] = t_; } } while (0)
#else
#define TSTAMP(cat) do {} while (0)
#endif
__global__ void __launch_bounds__(NTHREADS, 2) hymba_fwd(Args args) {
    extern __shared__ __attribute__((aligned(16))) unsigned char lds_raw[];
    cg::grid_group grid = cg::this_grid();
    LAS unsigned char* lds = (LAS unsigned char*)lds_raw;
    const int G = gridDim.x;

#if PROBE_SEL >= 0
    if (blockIdx.x == 0 && fresh_tid() == 0) { unsigned long long* tsb = WS_PTR(unsigned long long, WS_CTL + 4096); for (int i = 0; i < 48; ++i) tsb[i] = 0; tsb[0] = __builtin_amdgcn_s_memrealtime(); }
#endif
    {
        const int tid = fresh_tid(), lane = tid & 63, wave = __builtin_amdgcn_readfirstlane(tid >> 6);
        const int gw = blockIdx.x * NWAVES + wave, NGW = G * NWAVES;
        { float* ssb = SSB; for (int i = blockIdx.x * NTHREADS + tid; i < 6 * MT; i += G * NTHREADS) ssb[MT + i] = 0.f;
          if (blockIdx.x == 0 && tid < 16) WS_PTR(unsigned, WS_CTL)[tid] = 0u; }
        LAS float* scr = (LAS float*)(lds + wave * 8704);
        constexpr int I_IN = 16 * 96, I_OUT = 16 * 32, I_G = 16 * 88, I_D = 44 * 32, I_PG = 16 * 32, I_PP = 4 * 32, I_L = I_IN + I_OUT + 2 * I_G + I_D + I_PG + I_PP;
        for (int it = gw; it < NLAYER * I_L; it += NGW) {
            const int L = it / I_L; int r = it % I_L;
            if (r < I_IN) { p0_item(ARG(9) + (size_t)L * DM * NQKV, DM, NQKV, ARG(8) + L * DM, (bf16_t*)WPTR(L, W_IN), 0, scr, r, lane); continue; } r -= I_IN;
            if (r < I_OUT) { p0_item(ARG(13) + (size_t)L * DM * DM, DM, DM, nullptr, (bf16_t*)WPTR(L, W_OUT), 0, scr, r, lane); continue; } r -= I_OUT;
            if (r < I_G) { p0_item(ARG(15) + (size_t)L * DM * DFF, DM, DFF, ARG(14) + L * DM, (bf16_t*)WPTR(L, W_GU), 1, scr, r, lane); continue; } r -= I_G;
            if (r < I_G) { p0_item(ARG(16) + (size_t)L * DM * DFF, DM, DFF, ARG(14) + L * DM, (bf16_t*)WPTR(L, W_GU), 2, scr, r, lane); continue; } r -= I_G;
            if (r < I_D) { p0_item(ARG(17) + (size_t)L * DFF * DM, DFF, DM, nullptr, (bf16_t*)WPTR(L, W_DOWN), 0, scr, r, lane); continue; } r -= I_D;
            if (r < I_PG) { p0_item(ARG(19) + (size_t)L * DM * DM, DM, DM, ARG(18) + L * DM, (bf16_t*)WPTR(L, W_PG), 0, scr, r, lane); continue; } r -= I_PG;
            p0_item(ARG(20) + (size_t)L * PLED * DM, PLED, DM, nullptr, (bf16_t*)WPTR(L, W_PP), 0, scr, r, lane);
        }
        { const float* pp = ARG(2); const float* ps = ARG(3); bf16_t* PB = PB_;
          for (int it = gw; it < NLAYER * MT; it += NGW) {
            const int L = it / MT, row = it % MT;
            const float* src = row < MP ? pp + ((size_t)L * MP + row) * PLED : ps + ((size_t)L * MS + (row - MP)) * PLED;
            const f32x4 v = *((const f32x4*)src + lane);
            u32x2 w; w.x = pk2(v[0], v[1]); w.y = pk2(v[2], v[3]);
            *((u32x2*)(PB + (size_t)it * PLED) + lane) = w;
          } }
        { const float* x_p = ARG(0); const float* x_s = ARG(1); bf16_t* XB = MIX_; float* ssb = SSB;
          for (int row = gw; row < MT; row += NGW) {
            const float* src = row < MP ? x_p + (size_t)row * DM : x_s + (size_t)(row - MP) * DM;
            float s = 0.f;
#pragma unroll
            for (int j = 0; j < 4; ++j) { const f32x4 v = *((const f32x4*)src + lane + 64 * j); s += (v[0] * v[0] + v[1] * v[1]) + (v[2] * v[2] + v[3] * v[3]);
                u32x2 w; w.x = pk2(v[0], v[1]); w.y = pk2(v[2], v[3]); *((u32x2*)(XB + (size_t)row * DM) + lane + 64 * j) = w; }
            s = wave_sum(s);
            if (lane == 0) ssb[row] = s;
          } }
    }
    TSTAMP(0); grid.sync(); TSTAMP(8);

    for (int L = 0; L < NLAYER; ++L) {
#define SS_MIX (SSB + (size_t)(3 * L) * MT)
#define SS_FFN (SSB + (size_t)(3 * L + 1) * MT)
#define SS_PLE (SSB + (size_t)(3 * L + 2) * MT)
#define SS_NEXT (SSB + (size_t)(3 * L + 3) * MT)
        { EpiArgs q{}; q.ss_in = SS_MIX; q.o0 = QKV_;
          q.f_sbk = ARG_OUT + O_SBK_P + (size_t)L * MP * HW; q.f_sbv = ARG_OUT + O_SBV_P + (size_t)L * MP * HW;
          q.f_cbk = ARG_OUT + O_CBK_P + (size_t)L * NBATCH * BANDL * HW; q.f_cbv = ARG_OUT + O_CBV_P + (size_t)L * NBATCH * BANDL * HW;
          pg8::Gemm g{MIX_, WPTR(L, W_IN), MP, NQKV, DM}; pg8::StaticOrder S; S.init(MP, NQKV, G, (int)blockIdx.x);
          Epi<EP_QKV> E{q};
          GP1(pg8::gemm_phase<Epi<EP_QKV>, pg8::StaticOrder, true, true>(lds, g, S, E);) TSTAMP(1); }
        { EpiArgs q{}; q.ss_in = SS_MIX; q.o0 = QKV_;
          q.s_sbk = ARG_OUT + O_SBK_S + (size_t)L * MS * HW; q.s_sbv = ARG_OUT + O_SBV_S + (size_t)L * MS * HW;
          q.s_cbk = ARG_OUT + O_CBK_S + (size_t)L * MS * HW; q.s_cbv = ARG_OUT + O_CBV_S + (size_t)L * MS * HW;
          SG(sgemm<EP_QKV>(lds, MIX_ + (size_t)MP * DM, DM, WPTR(L, W_IN), NQKV / 32, q);) TSTAMP(7); }
        grid.sync(); TSTAMP(8);
        { AttnArgs A{}; A.L = L;
#ifndef NO_ATTN
          attn_phase(A, lds);
#endif
          TSTAMP(2); }
        grid.sync(); TSTAMP(2);
        { EpiArgs q{}; q.X = X_; q.XB = XB_; q.xbase = L == 0 ? ARG(0) : (const float*)X_; q.ss_out = SS_FFN;
          pg8::Gemm g{MIX_, WPTR(L, W_OUT), MP, DM, DM}; pg8::StaticOrder S; S.init(MP, DM, G, (int)blockIdx.x);
          Epi<EP_RES> E{q};
          GP2(pg8::gemm_phase<Epi<EP_RES>, pg8::StaticOrder, true, true>(lds, g, S, E);) TSTAMP(3); }
        { EpiArgs q{}; q.X = X_; q.XB = XB_; q.xbase_s = L == 0 ? ARG(1) : (const float*)(X_ + (size_t)MP * DM); q.ss_out = SS_FFN;
          SG(sgemm<EP_RES>(lds, MIX_ + (size_t)MP * DM, DM, WPTR(L, W_OUT), DM / 32, q);) TSTAMP(7); }
        { EpiArgs q2{}; q2.o0 = PBUF_;
          int kp = PLED; asm volatile("" : "+s"(kp));
          pg8::Gemm g2{PB_ + (size_t)L * MT * PLED, WPTR(L, W_PP), MP, DM, kp}; pg8::StaticOrder S; S.init(MP, DM, G, (int)blockIdx.x);
          Epi<EP_P> E2{q2};
          GP3(pg8::gemm_phase<Epi<EP_P>, pg8::StaticOrder, true, true>(lds, g2, S, E2);) TSTAMP(10);
          SG(sgemm<EP_P>(lds, PB_ + ((size_t)L * MT + MP) * PLED, PLED, WPTR(L, W_PP), DM / 32, q2);) TSTAMP(7); }
        grid.sync(); TSTAMP(8);
        { EpiArgs q{}; q.ss_in = SS_FFN; q.o0 = HB_;
          pg8::Gemm g{XB_, WPTR(L, W_GU), MP, 2 * DFF, DM}; pg8::StaticOrder S; S.init(MP, 2 * DFF, G, (int)blockIdx.x);
          Epi<EP_GU> E{q};
          GP4(pg8::gemm_phase<Epi<EP_GU>, pg8::StaticOrder, true, true>(lds, g, S, E);) TSTAMP(4);
          SG(sgemm<EP_GU>(lds, XB_ + (size_t)MP * DM, DM, WPTR(L, W_GU), DFF / 32, q);) TSTAMP(7); }
        grid.sync(); TSTAMP(8);
        { EpiArgs q{}; q.X = X_; q.XB = XB_; q.xbase = X_; q.xbase_s = X_ + (size_t)MP * DM; q.ss_out = SS_PLE;
          pg8::Gemm g{HB_, WPTR(L, W_DOWN), MP, DM, DFF}; pg8::StaticOrder S; S.init(MP, DM, G, (int)blockIdx.x);
          Epi<EP_RES> E{q};
          GP5(pg8::gemm_phase<Epi<EP_RES>, pg8::StaticOrder, true, true>(lds, g, S, E);) TSTAMP(5);
          SG(sgemm<EP_RES>(lds, HB_ + (size_t)MP * DFF, DFF, WPTR(L, W_DOWN), DM / 32, q);) TSTAMP(7); }
        grid.sync(); TSTAMP(8);
        { EpiArgs q{}; q.X = X_; q.XB = MIX_  ; q.P = PBUF_; q.xbase = X_; q.xbase_s = X_ + (size_t)MP * DM; q.ss_in = SS_PLE; q.ss_out = SS_NEXT;
          pg8::Gemm g{XB_, WPTR(L, W_PG), MP, DM, DM}; pg8::StaticOrder S; S.init(MP, DM, G, (int)blockIdx.x);
          Epi<EP_PLE> E{q};
          GP6(pg8::gemm_phase<Epi<EP_PLE>, pg8::StaticOrder, true, true>(lds, g, S, E);) TSTAMP(6);
          SG(sgemm<EP_PLE>(lds, XB_ + (size_t)MP * DM, DM, WPTR(L, W_PG), DM / 32, q);) TSTAMP(7); }
        grid.sync(); TSTAMP(8);
    }
    {
        const int tid = fresh_tid(), lane = tid & 63, wave = __builtin_amdgcn_readfirstlane(tid >> 6);
        const int gw = blockIdx.x * NWAVES + wave, NGW = G * NWAVES;
        const float* ssf = SSB + (size_t)(3 * NLAYER) * MT; const float* gf = ARG(21); const float* X = X_; float* out = ARG_OUT;
        for (int row = gw; row < MT; row += NGW) {
            const float rs = rstd_of(ssf[row]);
            float* dst = row < MP ? out + O_YP + (size_t)row * DM : out + O_YS + (size_t)(row - MP) * DM;
#pragma unroll
            for (int j = 0; j < 4; ++j) { const f32x4 v = *((const f32x4*)(X + (size_t)row * DM) + lane + 64 * j); const f32x4 gv = *((const f32x4*)gf + lane + 64 * j);
                *((f32x4*)dst + lane + 64 * j) = v * rs * gv; }
        }
    }
#if PROBE_SEL >= 0
    TSTAMP(11); grid.sync();
    if (blockIdx.x == 0 && fresh_tid() == 0) { const unsigned long long* tsb = WS_PTR(unsigned long long, WS_CTL + 4096); float* o = ARG_OUT + O_YS; o[0] += (float)tsb[16 + PROBE_SEL] * 2.5e-5f; }
#endif
}

extern "C" void kernel_launch(void* const* d_in, const int* in_sizes, int n_in, void* d_out, int out_size, void* d_ws, size_t ws_size, hipStream_t stream) {
    static int grid = 0;
    if (grid == 0) {
        int dev = 0, cus = 0, per_cu = 0;
        hipGetDevice(&dev);
        hipDeviceGetAttribute(&cus, hipDeviceAttributeMultiprocessorCount, dev);
        hipFuncSetAttribute((const void*)hymba_fwd, hipFuncAttributeMaxDynamicSharedMemorySize, LDS_BYTES);
        hipOccupancyMaxActiveBlocksPerMultiprocessor(&per_cu, (const void*)hymba_fwd, NTHREADS, LDS_BYTES);
        if (per_cu < 1) per_cu = 1;
        grid = cus * per_cu;
        if (n_in != 22 || ws_size < WS_END) { fprintf(stderr, "kernel_launch: unexpected n_in %d / ws_size %zu\n", n_in, ws_size); }
    }
    Args a{};
    for (int i = 0; i < 22; ++i) a.in[i] = (const float*)d_in[i];
    a.out = (float*)d_out; a.ws = (unsigned char*)d_ws;
    void* kargs[] = {&a};
    hipError_t e = hipLaunchCooperativeKernel((const void*)hymba_fwd, dim3(grid), dim3(NTHREADS), kargs, LDS_BYTES, stream);
    if (e != hipSuccess) fprintf(stderr, "cooperative launch failed: %s (grid %d)\n", hipGetErrorString(e), grid);
}
```

```cpp
#include <hip/hip_runtime.h>
#include <hip/hip_cooperative_groups.h>
#include <cstdio>
#include <cstdint>
namespace cg = cooperative_groups;
__device__ __forceinline__ int fresh_tid() { int t = threadIdx.x; asm volatile("" : "+v"(t)); return t; }
namespace pg8 {
#define PG8_LAS __attribute__((address_space(3)))
typedef unsigned short bf16_t;
typedef short bf16x8 __attribute__((ext_vector_type(8)));
typedef float f32x4 __attribute__((ext_vector_type(4)));
typedef unsigned u32x4 __attribute__((ext_vector_type(4)));
constexpr int BM = 256, BK = 64, HALF = 128, HTB = HALF * BK * 2  , STAGE_BYTES = 8 * HTB, NXCD = 8, WGM = 8;

__host__ __device__ __forceinline__ int lds_byte(int r, int c) { const int st = (r >> 4) * 2 + (c >> 5), rr = r & 15, cc = c & 31, ob = rr * 64 + cc * 2; return st * 1024 + (ob ^ (((ob >> 9) & 1) << 5)); }
__host__ __device__ __forceinline__ void stage_rc(int b, int& R, int& C) { const int st = b / 1024, sb = b % 1024, swz = sb ^ (((sb >> 9) & 1) << 5); R = (st >> 1) * 16 + swz / 64; C = (st & 1) * 32 + (swz % 64) / 2; }
__host__ __device__ __forceinline__ int perm32(int rho) { const int n = rho >> 4, i = rho & 15; return 8 * (i >> 2) + 4 * n + (i & 3); }

struct Unit { int pm, pn; };
struct Gemm { const bf16_t* A; const bf16_t* Bt; int M, N, K; };

struct StaticOrder {
    int nM, nN, nwg, G, c;
    __host__ __device__ void init(int M, int N, int G_, int c_) { nM = M / BM; nN = N / BM; nwg = nM * nN; G = G_; c = c_; }
    __host__ __device__ bool next(int i, Unit& u) const {
        const long L = (long)i * G + c; if (L >= nwg) return false;
        int wgid = (int)L; { const int q = nwg / NXCD, r = nwg % NXCD, xcd = wgid % NXCD, off = wgid / NXCD; wgid = (xcd < r ? xcd * (q + 1) : r * (q + 1) + (xcd - r) * q) + off; }
        const int nig = WGM * nN, gid = wgid / nig, fm = gid * WGM, gsz = (nM - fm) < WGM ? (nM - fm) : WGM;
        u.pm = fm + ((wgid % nig) % gsz); u.pn = (wgid % nig) / gsz; return true;
    }
    __device__ __forceinline__ void a_ready(const Unit&) const {}
    __device__ __forceinline__ void done(const Unit&) const {}
};

template <class Epi, class Sched, bool ALIGN_EPI = false, bool SP2 = false>
__device__ __forceinline__ void gemm_phase(PG8_LAS unsigned char* lds, const Gemm g, const Sched& S, const Epi& E) {
    const int tid = fresh_tid(), wid = __builtin_amdgcn_readfirstlane(tid >> 6), lane = tid & 63, wr = wid >> 2, wc = wid & 3, fr = lane & 15, fq = lane >> 4;
    const int K = g.K, nt = K / BK;
    unsigned voffA[2], voffB[2];
#pragma unroll
    for (int i = 0; i < 2; ++i) { int R, C; stage_rc(tid * 16 + i * 8192, R, C); const int Rb = Epi::PERM ? ((R & ~31) + perm32(R & 31)) : R;
        voffA[i] = (unsigned)(R * K + C) * 2u; voffB[i] = (unsigned)(Rb * K + C) * 2u; }
    const size_t kstep = (size_t)(BK * 2);
    const size_t hstep = (size_t)HALF * K * 2;
    const size_t tstep = 2 * hstep;
    const unsigned ldsw = (unsigned)wid * 1024u;
    const int aoff = lds_byte(wr * 64 + fr, fq * 8), boff = lds_byte(wc * 32 + fr, fq * 8);
#define PG8_SA(b, h) (((b) * 2 + (h)) * HTB)
#define PG8_SB(b, h) ((4 + (b) * 2 + (h)) * HTB)
#define PG8_STAGE(bufoff, gbase, voff) do { _Pragma("unroll") for (int _i = 0; _i < 2; ++_i) \
        __builtin_amdgcn_global_load_lds((const unsigned*)((const char*)(gbase) + (voff)[_i]), (PG8_LAS unsigned*)(lds + (bufoff) + ldsw + _i * 8192), 16, 0, 0); } while (0)
#define PG8_LDA(dst, b, h) do { _Pragma("unroll") for (int m = 0; m < 4; ++m) _Pragma("unroll") for (int k = 0; k < 2; ++k) dst[m][k] = *(const PG8_LAS bf16x8*)(lds + PG8_SA(b, h) + aoff + m * 2048 + k * 1024); } while (0)
#define PG8_LDB(dst, b, h) do { _Pragma("unroll") for (int n = 0; n < 2; ++n) _Pragma("unroll") for (int k = 0; k < 2; ++k) dst[n][k] = *(const PG8_LAS bf16x8*)(lds + PG8_SB(b, h) + boff + n * 2048 + k * 1024); } while (0)
#define PG8_MMA(ai, bj, At, Bt) do { __builtin_amdgcn_s_setprio(1); _Pragma("unroll") for (int m = 0; m < 4; ++m) _Pragma("unroll") for (int n = 0; n < 2; ++n) _Pragma("unroll") for (int k = 0; k < 2; ++k) \
        acc[ai][bj][m][n] = __builtin_amdgcn_mfma_f32_16x16x32_bf16(Bt[n][k], At[m][k], acc[ai][bj][m][n], 0, 0, 0); __builtin_amdgcn_s_setprio(0); } while (0)
#define PG8_WAIT_V(n) asm volatile("s_waitcnt vmcnt(" #n ")" ::: "memory")
#define PG8_WAIT_L(n) asm volatile("s_waitcnt lgkmcnt(" #n ")" ::: "memory")
#define PG8_BAR __builtin_amdgcn_s_barrier()
#define PG8_SCHED __builtin_amdgcn_sched_barrier(0)
    Unit cur, nxt; int ui = 0;
    if (!S.next(0, cur)) return;
    f32x4 acc[2][2][4][2];
#pragma unroll
    for (int a = 0; a < 2; ++a)
#pragma unroll
        for (int b = 0; b < 2; ++b)
#pragma unroll
            for (int m = 0; m < 4; ++m)
#pragma unroll
                for (int n = 0; n < 2; ++n) acc[a][b][m][n] = (f32x4){0.f, 0.f, 0.f, 0.f};
    bf16x8 At[4][2], B0[2][2], B1[2][2];
    const char* cA = (const char*)g.A + (size_t)cur.pm * tstep; const char* cB = (const char*)g.Bt + (size_t)cur.pn * tstep;
    S.a_ready(cur);
    if constexpr (SP2) {
        PG8_STAGE(PG8_SB(0, 0), cB, voffB); PG8_STAGE(PG8_SB(0, 1), cB + hstep, voffB); PG8_STAGE(PG8_SA(0, 0), cA, voffA); PG8_STAGE(PG8_SA(0, 1), cA + hstep, voffA);
        if (wr == 1) PG8_BAR;
        PG8_WAIT_V(2); PG8_BAR;
        PG8_STAGE(PG8_SB(1, 0), cB + kstep, voffB); PG8_STAGE(PG8_SA(1, 0), cA + kstep, voffA); PG8_STAGE(PG8_SB(1, 1), cB + hstep + kstep, voffB);
        PG8_WAIT_V(6); PG8_BAR;
    } else {
        PG8_STAGE(PG8_SB(0, 0), cB, voffB); PG8_STAGE(PG8_SA(0, 0), cA, voffA); PG8_STAGE(PG8_SB(0, 1), cB + hstep, voffB); PG8_STAGE(PG8_SA(0, 1), cA + hstep, voffA);
        if (wr == 1) PG8_BAR;
        PG8_WAIT_V(4); PG8_BAR;
        PG8_STAGE(PG8_SB(1, 0), cB + kstep, voffB); PG8_STAGE(PG8_SA(1, 0), cA + kstep, voffA); PG8_STAGE(PG8_SB(1, 1), cB + hstep + kstep, voffB);
        PG8_WAIT_V(6); PG8_BAR;
    }
    for (;;) {
        const bool has_next = S.next(ui + 1, nxt);
        const char* nA = has_next ? (const char*)g.A + (size_t)nxt.pm * tstep : cA; const char* nB = has_next ? (const char*)g.Bt + (size_t)nxt.pn * tstep : cB;
        for (int t = 0; t < nt; t += 2) {
            const bool last = (t == nt - 2);
            const char* a1 = cA + (size_t)(t + 1) * kstep;
            const char* a2 = last ? nA : cA + (size_t)(t + 2) * kstep; const char* b2 = last ? nB : cB + (size_t)(t + 2) * kstep;
            const char* a3 = a2 + kstep; const char* b3 = b2 + kstep;
            if (last && has_next) S.a_ready(nxt);
            if constexpr (SP2) {
            PG8_LDB(B0, 0, 0); PG8_LDB(B1, 0, 1); PG8_SCHED; PG8_LDA(At, 0, 0); PG8_STAGE(PG8_SA(1, 1), a1 + hstep, voffA);
            PG8_WAIT_V(8); PG8_WAIT_L(0); PG8_BAR; PG8_MMA(0, 0, At, B0); PG8_MMA(0, 1, At, B1); PG8_BAR; PG8_SCHED;
            PG8_LDA(At, 0, 1); PG8_STAGE(PG8_SB(0, 0), b2, voffB); PG8_STAGE(PG8_SB(0, 1), b2 + hstep, voffB); PG8_STAGE(PG8_SA(0, 0), a2, voffA);
            PG8_WAIT_V(8); PG8_WAIT_L(0); PG8_BAR; PG8_MMA(1, 0, At, B0); PG8_MMA(1, 1, At, B1); PG8_BAR; PG8_SCHED;
            PG8_LDB(B0, 1, 0); PG8_LDB(B1, 1, 1); PG8_SCHED; PG8_LDA(At, 1, 0); PG8_STAGE(PG8_SA(0, 1), a2 + hstep, voffA);
            PG8_WAIT_V(8); PG8_WAIT_L(0); PG8_BAR; PG8_MMA(0, 0, At, B0); PG8_MMA(0, 1, At, B1); PG8_BAR; PG8_SCHED;
            PG8_LDA(At, 1, 1); PG8_STAGE(PG8_SB(1, 0), b3, voffB); PG8_STAGE(PG8_SB(1, 1), b3 + hstep, voffB); PG8_STAGE(PG8_SA(1, 0), a3, voffA);
            PG8_WAIT_V(8); PG8_WAIT_L(0); PG8_BAR; PG8_MMA(1, 0, At, B0); PG8_MMA(1, 1, At, B1); PG8_BAR; PG8_SCHED;
            } else {
            PG8_LDB(B0, 0, 0); PG8_SCHED; PG8_LDA(At, 0, 0); PG8_STAGE(PG8_SA(1, 1), a1 + hstep, voffA);
            PG8_WAIT_L(8); PG8_BAR; PG8_WAIT_L(0); PG8_MMA(0, 0, At, B0); PG8_BAR; PG8_SCHED;
            PG8_LDB(B1, 0, 1); PG8_STAGE(PG8_SB(0, 0), b2, voffB);
            PG8_BAR; PG8_WAIT_L(0); PG8_MMA(0, 1, At, B1); PG8_BAR;
            PG8_LDA(At, 0, 1); PG8_STAGE(PG8_SA(0, 0), a2, voffA);
            PG8_BAR; PG8_WAIT_L(0); PG8_MMA(1, 0, At, B0); PG8_BAR; PG8_SCHED;
            PG8_STAGE(PG8_SB(0, 1), b2 + hstep, voffB);
            PG8_WAIT_V(6); PG8_BAR; PG8_MMA(1, 1, At, B1); PG8_BAR;
            PG8_LDB(B0, 1, 0); PG8_SCHED; PG8_LDA(At, 1, 0); PG8_STAGE(PG8_SA(0, 1), a2 + hstep, voffA);
            PG8_WAIT_L(8); PG8_BAR; PG8_WAIT_L(0); PG8_MMA(0, 0, At, B0); PG8_BAR; PG8_SCHED;
            PG8_LDB(B1, 1, 1); PG8_STAGE(PG8_SB(1, 0), b3, voffB);
            PG8_BAR; PG8_WAIT_L(0); PG8_MMA(0, 1, At, B1); PG8_BAR;
            PG8_LDA(At, 1, 1); PG8_STAGE(PG8_SA(1, 0), a3, voffA);
            PG8_BAR; PG8_WAIT_L(0); PG8_MMA(1, 0, At, B0); PG8_BAR; PG8_SCHED;
            PG8_STAGE(PG8_SB(1, 1), b3 + hstep, voffB);
            PG8_WAIT_V(6); PG8_BAR; PG8_MMA(1, 1, At, B1); PG8_BAR;
            }
        }
        if constexpr (ALIGN_EPI) { if (wr == 0) PG8_BAR; }
        if constexpr (!Epi::AFTER_DRAIN) { E(acc, cur, wr, wc, fr, fq); S.done(cur); }
        if (!has_next) break;
#pragma unroll
        for (int a = 0; a < 2; ++a)
#pragma unroll
            for (int b = 0; b < 2; ++b)
#pragma unroll
                for (int m = 0; m < 4; ++m)
#pragma unroll
                    for (int n = 0; n < 2; ++n) acc[a][b][m][n] = (f32x4){0.f, 0.f, 0.f, 0.f};
        cur = nxt; cA = nA; cB = nB; ++ui;
        if constexpr (ALIGN_EPI) { if (wr == 1) PG8_BAR; }
    }
    PG8_WAIT_V(0);
    if constexpr (!ALIGN_EPI) { if (wr == 0) PG8_BAR; }
    PG8_BAR;
    if constexpr (Epi::AFTER_DRAIN) { E.fused(acc, cur, wr, wc, fr, fq, lds, wid, lane); S.done(cur); }
#undef PG8_SA
#undef PG8_SB
#undef PG8_STAGE
#undef PG8_LDA
#undef PG8_LDB
#undef PG8_MMA
#undef PG8_WAIT_V
#undef PG8_WAIT_L
#undef PG8_BAR
#undef PG8_SCHED
}
}

#define LAS __attribute__((address_space(3)))
using pg8::bf16_t; using pg8::bf16x8; using pg8::f32x4; using pg8::u32x4;
typedef short s16x4 __attribute__((ext_vector_type(4)));
typedef float f32x16 __attribute__((ext_vector_type(16)));
typedef unsigned u32x2 __attribute__((ext_vector_type(2)));
typedef float f32x2_t __attribute__((ext_vector_type(2)));
typedef __bf16 bf16x2_t __attribute__((ext_vector_type(2)));

constexpr int DM = 1024, SEQ = 2048, NBATCH = 8, MP = NBATCH * SEQ, DSEQ = 16, MS = NBATCH * DSEQ, MT = MP + MS;
constexpr int DFF = 2816, NQKV = 3072, PLED = 256, NLAYER = 2, PAST = 2048, BANDL = 512, HW = 512;
constexpr float EPS = 1e-6f, LOG2E = 1.4426950408889634f, QSCALE = 0.125f * LOG2E;
#ifndef SB_EARLY
#define SB_EARLY 1
#endif
constexpr float SB_THR = -160.0f;

constexpr size_t MiB = 1u << 20;
constexpr size_t WS_CTL = 0, WS_SS = 64 * 1024;
constexpr size_t WS_W = 2 * MiB, W_LSTRIDE = 28 * MiB, W_IN = 0, W_OUT = 6 * MiB, W_GU = 8 * MiB, W_DOWN = 19 * MiB, W_PG = 25 * MiB, W_PP = 27 * MiB;
constexpr size_t WS_PB = 58 * MiB, WS_X = 76 * MiB  , WS_XB = 142 * MiB, WS_QKV = 176 * MiB, WS_MIX = 274 * MiB, WS_P = 308 * MiB, WS_END = 342 * MiB;
constexpr int LDS_BYTES = 131072 + 1024;
constexpr int NWAVES = 8, NTHREADS = 512;

constexpr size_t O_YP = 0, O_YS = (size_t)MP * DM, O_SBK_P = O_YS + (size_t)MS * DM, O_SBV_P = O_SBK_P + (size_t)NLAYER * MP * HW,
                 O_CBK_P = O_SBV_P + (size_t)NLAYER * MP * HW, O_CBV_P = O_CBK_P + (size_t)NLAYER * NBATCH * BANDL * HW,
                 O_SBK_S = O_CBV_P + (size_t)NLAYER * NBATCH * BANDL * HW, O_SBV_S = O_SBK_S + (size_t)NLAYER * MS * HW,
                 O_CBK_S = O_SBV_S + (size_t)NLAYER * MS * HW, O_CBV_S = O_CBK_S + (size_t)NLAYER * MS * HW;

__device__ __forceinline__ unsigned pk2(float lo, float hi) { f32x2_t v = {lo, hi}; bf16x2_t b = __builtin_convertvector(v, bf16x2_t); return __builtin_bit_cast(unsigned, b); }
__device__ __forceinline__ float bf_lo(unsigned w) { return __uint_as_float(w << 16); }
__device__ __forceinline__ float bf_hi(unsigned w) { return __uint_as_float(w & 0xffff0000u); }
__device__ __forceinline__ float partner32(float v) {
    auto rr = __builtin_amdgcn_permlane32_swap(__float_as_uint(v), __float_as_uint(v), false, false);
    return (threadIdx.x & 32) ? __uint_as_float(rr[0]) : __uint_as_float(rr[1]);
}
__device__ __forceinline__ float wave_sum(float v) {
#pragma unroll
    for (int o = 1; o < 64; o <<= 1) v += __shfl_xor(v, o);
    return v;
}
__device__ __forceinline__ float rstd_of(float ss) { return rsqrtf(ss * (1.0f / DM) + EPS); }

template <int I> __device__ __forceinline__ const float* argp() {
    unsigned long long v; const void* ka = (const void*)__builtin_amdgcn_kernarg_segment_ptr();
    asm volatile("s_load_dwordx2 %0, %1, %2\n\ts_waitcnt lgkmcnt(0)" : "=s"(v) : "s"(ka), "i"(I * 8) : "memory");
    return (const float*)v;
}
#define ARG(i) argp<i>()
#define ARG_OUT ((float*)argp<22>())
#define ARG_WS ((unsigned char*)argp<23>())
#define WS_PTR(T, off) ((T*)(ARG_WS + (off)))
#define SSB WS_PTR(float, WS_SS)
#define PB_ WS_PTR(bf16_t, WS_PB)
#define XN_ WS_PTR(bf16_t, WS_X)
#define XB_ WS_PTR(bf16_t, WS_XB)
#define QKV_ WS_PTR(bf16_t, WS_QKV)
#define HB_ WS_PTR(bf16_t, WS_QKV)
#define MIX_ WS_PTR(bf16_t, WS_MIX)
#define PBUF_ WS_PTR(bf16_t, WS_P)
#define WPTR(L, off) ((const bf16_t*)(ARG_WS + WS_W + (size_t)(L) * W_LSTRIDE + (off)))

enum { EP_QKV = 0, EP_RES = 1, EP_GU = 2, EP_P = 3, EP_PLE = 4 };
struct EpiArgs {
    const float* ss_in; float* ss_out;
    const bf16_t* xbase;
    bf16_t* XB; bf16_t* o0; const bf16_t* P;
    float *f_sbk, *f_sbv, *f_cbk, *f_cbv;
    float *s_sbk, *s_sbv, *s_cbk, *s_cbv;
};
template <int MODE> struct Epi {
    static constexpr bool PERM = false, AFTER_DRAIN = false;
    EpiArgs a;
    __device__ __forceinline__ void operator()(const f32x4 (&acc)[2][2][4][2], const pg8::Unit& u, int wr, int wc, int fr, int fq) const {
        if constexpr (MODE == EP_QKV) {
            const int part = u.pn >> 1, cb = (u.pn & 1) * 256 + wc * 32 + 4 * fq;
            bf16_t* ob = a.o0 + (size_t)part * ((size_t)MT * HW);
            float* fo = part == 1 ? a.f_sbk : part == 2 ? a.f_sbv : part == 4 ? a.f_cbk : part == 5 ? a.f_cbv : nullptr;
            const bool band = part >= 4; const float qs = (part == 0 || part == 3) ? QSCALE : 1.f;
#pragma unroll
            for (int ai = 0; ai < 2; ++ai)
#pragma unroll
                for (int m = 0; m < 4; ++m) {
                    const int row = u.pm * 256 + ai * 128 + wr * 64 + m * 16 + fr;
                    const float rs = rstd_of(a.ss_in[row]) * qs;
                    const int t = row & (SEQ - 1);
                    float* frow = nullptr;
                    if (fo) { if (!band) frow = fo + (size_t)row * HW; else if (t >= SEQ - BANDL) frow = fo + ((size_t)(row >> 11) * BANDL + (t - (SEQ - BANDL))) * HW; }
#pragma unroll
                    for (int bj = 0; bj < 2; ++bj)
#pragma unroll
                        for (int n = 0; n < 2; ++n) {
                            const int col = cb + bj * 128 + n * 16; const f32x4 v = acc[ai][bj][m][n] * rs;
                            u32x2 w; w.x = pk2(v[0], v[1]); w.y = pk2(v[2], v[3]);
                            *(u32x2*)(ob + (size_t)row * HW + col) = w;
                            if (frow) *(f32x4*)(frow + col) = v;
                        }
                }
        } else if constexpr (MODE == EP_RES || MODE == EP_PLE) {
#pragma unroll
            for (int ai = 0; ai < 2; ++ai)
#pragma unroll
                for (int m = 0; m < 4; ++m) {
                    const int row = u.pm * 256 + ai * 128 + wr * 64 + m * 16 + fr;
                    float rs = 0.f; if constexpr (MODE == EP_PLE) rs = rstd_of(a.ss_in[row]) * (-LOG2E);
                    float s = 0.f;
#pragma unroll
                    for (int bj = 0; bj < 2; ++bj)
#pragma unroll
                        for (int n = 0; n < 2; ++n) {
                            const size_t off = (size_t)row * DM + u.pn * 256 + bj * 128 + wc * 32 + n * 16 + 4 * fq;
                            const u32x2 xw = *(const u32x2*)(a.xbase + off); f32x4 x = {bf_lo(xw.x), bf_hi(xw.x), bf_lo(xw.y), bf_hi(xw.y)}; const f32x4 c = acc[ai][bj][m][n];
                            if constexpr (MODE == EP_RES) x += c;
                            else { const u32x2 pw = *(const u32x2*)(a.P + off);
                                   x[0] += bf_lo(pw.x) * __builtin_amdgcn_rcpf(1.f + __builtin_amdgcn_exp2f(c[0] * rs));
                                   x[1] += bf_hi(pw.x) * __builtin_amdgcn_rcpf(1.f + __builtin_amdgcn_exp2f(c[1] * rs));
                                   x[2] += bf_lo(pw.y) * __builtin_amdgcn_rcpf(1.f + __builtin_amdgcn_exp2f(c[2] * rs));
                                   x[3] += bf_hi(pw.y) * __builtin_amdgcn_rcpf(1.f + __builtin_amdgcn_exp2f(c[3] * rs)); }
                            u32x2 w; w.x = pk2(x[0], x[1]); w.y = pk2(x[2], x[3]); *(u32x2*)(a.XB + off) = w;
                            s += (x[0] * x[0] + x[1] * x[1]) + (x[2] * x[2] + x[3] * x[3]);
                        }
                    s += __shfl_xor(s, 16); s += __shfl_xor(s, 32);
                    if (fq == 0) unsafeAtomicAdd(a.ss_out + row, s);
                }
        } else if constexpr (MODE == EP_GU) {
#pragma unroll
            for (int ai = 0; ai < 2; ++ai)
#pragma unroll
                for (int m = 0; m < 4; ++m) {
                    const int row = u.pm * 256 + ai * 128 + wr * 64 + m * 16 + fr;
                    const float rs = rstd_of(a.ss_in[row]);
#pragma unroll
                    for (int n = 0; n < 2; ++n) {
                        const int col = u.pn * 128 + wc * 32 + n * 16 + 4 * fq;
                        const f32x4 g = acc[ai][0][m][n] * rs, up = acc[ai][1][m][n] * rs; float h[4];
#pragma unroll
                        for (int e = 0; e < 4; ++e) h[e] = g[e] * up[e] * __builtin_amdgcn_rcpf(1.f + __builtin_amdgcn_exp2f(-LOG2E * g[e]));
                        u32x2 w; w.x = pk2(h[0], h[1]); w.y = pk2(h[2], h[3]);
                        *(u32x2*)(a.o0 + (size_t)row * DFF + col) = w;
                    }
                }
        } else {
#pragma unroll
            for (int ai = 0; ai < 2; ++ai)
#pragma unroll
                for (int m = 0; m < 4; ++m) {
                    const int row = u.pm * 256 + ai * 128 + wr * 64 + m * 16 + fr;
#pragma unroll
                    for (int bj = 0; bj < 2; ++bj)
#pragma unroll
                        for (int n = 0; n < 2; ++n) {
                            const size_t off = (size_t)row * DM + u.pn * 256 + bj * 128 + wc * 32 + n * 16 + 4 * fq; const f32x4 v = acc[ai][bj][m][n];
                            u32x2 w; w.x = pk2(v[0], v[1]); w.y = pk2(v[2], v[3]); *(u32x2*)(a.o0 + off) = w;
                        }
                }
        }
    }
};

template <int MODE>
__device__ __forceinline__ void sgemm(LAS unsigned char* lds, const bf16_t* A, int K, const bf16_t* Bt, int ncol32, const EpiArgs& a) {
    const int tid = fresh_tid(), lane = tid & 63, wave = __builtin_amdgcn_readfirstlane(tid >> 6), r = lane & 31, hh = lane >> 5;
    LAS float* red = (LAS float*)lds;
    const int G = gridDim.x, K8 = K >> 3, nunits = 4 * ncol32;
    for (int j = G - 1 - (int)blockIdx.x; j < nunits; j += G) {
        const int rb = j & 3, c0 = 32 * (j >> 2);
        const int brow0 = (MODE == EP_GU) ? ((c0 >> 7) * 256 + (c0 & 127)) : c0;
        const bf16_t* ap = A + (size_t)(32 * rb + r) * K + wave * K8 + 8 * hh;
        const bf16_t* bp = Bt + (size_t)(brow0 + r) * K + wave * K8 + 8 * hh;
        f32x16 acc0 = {}, acc1 = {};
#pragma unroll 11
        for (int k = 0; k < K8; k += 16) {
            const bf16x8 af = *(const bf16x8*)(ap + k), bf = *(const bf16x8*)(bp + k);
            acc0 = __builtin_amdgcn_mfma_f32_32x32x16_bf16(af, bf, acc0, 0, 0, 0);
            if constexpr (MODE == EP_GU) { const bf16x8 bf2 = *(const bf16x8*)(bp + (size_t)128 * K + k); acc1 = __builtin_amdgcn_mfma_f32_32x32x16_bf16(af, bf2, acc1, 0, 0, 0); }
        }
#pragma unroll
        for (int i = 0; i < 16; ++i) { red[(wave * 16 + i) * 64 + lane] = acc0[i]; if constexpr (MODE == EP_GU) red[8192 + (wave * 16 + i) * 64 + lane] = acc1[i]; }
        __syncthreads();
        const int col = c0 + r;
#pragma unroll
        for (int ii = 0; ii < 2; ++ii) {
            const int i = 2 * wave + ii;
            float v0 = 0.f, v1 = 0.f;
#pragma unroll
            for (int w = 0; w < 8; ++w) { v0 += red[(w * 16 + i) * 64 + lane]; if constexpr (MODE == EP_GU) v1 += red[8192 + (w * 16 + i) * 64 + lane]; }
            const int rs_ = 32 * rb + (i & 3) + 8 * (i >> 2) + 4 * hh, row = MP + rs_;
            if constexpr (MODE == EP_QKV) {
                const int part = c0 >> 9, cc = col & 511;
                const float v = v0 * rstd_of(a.ss_in[row]);
                const float qs = (part == 0 || part == 3) ? QSCALE : 1.f;
                (a.o0 + (size_t)part * ((size_t)MT * HW))[(size_t)row * HW + cc] = (bf16_t)(pk2(v * qs, 0.f) & 0xffffu);
                float* fo = part == 1 ? a.s_sbk : part == 2 ? a.s_sbv : part == 4 ? a.s_cbk : part == 5 ? a.s_cbv : nullptr;
                if (fo) fo[(size_t)rs_ * HW + cc] = v;
            } else if constexpr (MODE == EP_RES || MODE == EP_PLE) {
                const size_t off = (size_t)row * DM + col;
                float x = __uint_as_float((unsigned)a.xbase[off] << 16);
                if constexpr (MODE == EP_RES) x += v0;
                else { const float pv = __uint_as_float((unsigned)a.P[off] << 16); x += pv * __builtin_amdgcn_rcpf(1.f + __builtin_amdgcn_exp2f(-LOG2E * v0 * rstd_of(a.ss_in[row]))); }
                a.XB[off] = (bf16_t)(pk2(x, 0.f) & 0xffffu);
                float s = x * x;
                s += __shfl_xor(s, 1); s += __shfl_xor(s, 2); s += __shfl_xor(s, 4); s += __shfl_xor(s, 8); s += __shfl_xor(s, 16);
                if (r == 0) unsafeAtomicAdd(a.ss_out + row, s);
            } else if constexpr (MODE == EP_GU) {
                const float rs = rstd_of(a.ss_in[row]); const float g = v0 * rs, up = v1 * rs;
                const float h = g * up * __builtin_amdgcn_rcpf(1.f + __builtin_amdgcn_exp2f(-LOG2E * g));
                a.o0[(size_t)row * DFF + col] = (bf16_t)(pk2(h, 0.f) & 0xffffu);
            } else {
                a.o0[(size_t)row * DM + col] = (bf16_t)(pk2(v0, 0.f) & 0xffffu);
            }
        }
        __syncthreads();
    }
}
struct AttnArgs { int L; };
constexpr int AW_V = 0, AW_ST = 4096, AW_BIAS = 8704, AW_BYTES = 10240, ST_PITCH = 144;

template <bool F32> __device__ __forceinline__ void ld_k(bf16x8 (&kf)[4], const void* base, size_t off) {
    if constexpr (!F32) { const bf16_t* p = (const bf16_t*)base + off;
#pragma unroll
        for (int kk = 0; kk < 4; ++kk) kf[kk] = *(const bf16x8*)(p + 8 * kk);
    } else { const float* p = (const float*)base + off;
#pragma unroll
        for (int kk = 0; kk < 4; ++kk) { const f32x4 x = *(const f32x4*)(p + 8 * kk), y = *(const f32x4*)(p + 8 * kk + 4);
            u32x4 w; w.x = pk2(x[0], x[1]); w.y = pk2(x[2], x[3]); w.z = pk2(y[0], y[1]); w.w = pk2(y[2], y[3]); kf[kk] = __builtin_bit_cast(bf16x8, w); }
    }
}
template <bool F32> __device__ __forceinline__ void ld_v(u32x4 (&vr)[4], const void* base, size_t row0, int nvalid, int h, int lane) {
#pragma unroll
    for (int i = 0; i < 4; ++i) { int key = 8 * i + (lane >> 3); key = key < nvalid ? key : nvalid - 1;
        const size_t off = (row0 + key) * HW + h * 64 + (lane & 7) * 8;
        if constexpr (!F32) vr[i] = *(const u32x4*)((const bf16_t*)base + off);
        else { const float* p = (const float*)base + off; const f32x4 x = *(const f32x4*)p, y = *(const f32x4*)(p + 4);
            u32x4 w; w.x = pk2(x[0], x[1]); w.y = pk2(x[2], x[3]); w.z = pk2(y[0], y[1]); w.w = pk2(y[2], y[3]); vr[i] = w; }
    }
}
__device__ __forceinline__ void st_v(LAS unsigned char* vl, const u32x4 (&vr)[4], int lane) {
#pragma unroll
    for (int i = 0; i < 4; ++i) { const int key = 8 * i + (lane >> 3); *(LAS u32x4*)(vl + key * 128 + (((lane & 7) * 16) ^ (((key >> 1) & 1) << 6))) = vr[i]; }
}
typedef short v4i16_t __attribute__((ext_vector_type(4)));
__device__ __forceinline__ s16x4 vtr(LAS unsigned char* p) { return __builtin_bit_cast(s16x4, __builtin_amdgcn_ds_read_tr16_b64_v4i16((LAS v4i16_t*)p)); }
__device__ __forceinline__ void pv_block(f32x16 (&o)[2], LAS unsigned char* vl, const bf16x8 (&pf)[2], int lane) {
    const int q = (lane & 15) >> 2, p = lane & 3, c16 = (lane >> 4) & 1, hh = lane >> 5;
    const int va0 = (4 * hh + q) * 128 + ((32 * c16 + 8 * p) ^ ((q >> 1) << 6));
#pragma unroll
    for (int db = 0; db < 2; ++db)
#pragma unroll
        for (int s = 0; s < 2; ++s) {
            const s16x4 lo = vtr(vl + (va0 ^ (db * 64)) + s * 2048), hi = vtr(vl + (va0 ^ (db * 64)) + s * 2048 + 1024);
            const bf16x8 vf = {lo[0], lo[1], lo[2], lo[3], hi[0], hi[1], hi[2], hi[3]};
            o[db] = __builtin_amdgcn_mfma_f32_32x32x16_bf16(vf, pf[s], o[db], 0, 0, 0);
        }
}
__device__ __forceinline__ f32x16 qk_block(const bf16x8 (&kf)[4], const bf16x8 (&qf)[4]) {
    f32x16 S = {};
#pragma unroll
    for (int kk = 0; kk < 4; ++kk) S = __builtin_amdgcn_mfma_f32_32x32x16_bf16(kf[kk], qf[kk], S, 0, 0, 0);
    return S;
}
__device__ __forceinline__ void sb_block(const f32x16& S, LAS unsigned char* vl, int tq, int keypos0, float& carry, f32x16 (&o)[2], int lane) {
    const int hh = lane >> 5;
    float L[16], e[16];
#pragma unroll
    for (int r = 0; r < 16; ++r) {
        const int kp = keypos0 + (r & 3) + 8 * (r >> 2) + 4 * hh; const bool valid = kp < tq;
        const float z = S[r];
        const float sp = fmaxf(z, 0.f) + __builtin_amdgcn_logf(1.f + __builtin_amdgcn_exp2f(-fabsf(z)));
        L[r] = valid ? -sp : 0.f; e[r] = valid ? z - sp : -INFINITY;
    }
    float T[4], Tp[4], U[4];
#pragma unroll
    for (int g = 0; g < 4; ++g) { T[g] = (L[4 * g] + L[4 * g + 1]) + (L[4 * g + 2] + L[4 * g + 3]); Tp[g] = partner32(T[g]); U[g] = T[g] + Tp[g]; }
    float R[4]; R[3] = 0.f; R[2] = U[3]; R[1] = U[3] + U[2]; R[0] = R[1] + U[1];
    const float tot = R[0] + U[0];
    float w[16];
#pragma unroll
    for (int g = 0; g < 4; ++g) {
        const float b3 = carry + R[g] + (hh == 0 ? Tp[g] : 0.f);
        const float b2 = b3 + L[4 * g + 3], b1 = b2 + L[4 * g + 2], b0 = b1 + L[4 * g + 1];
        w[4 * g + 3] = __builtin_amdgcn_exp2f(e[4 * g + 3] + b3);
        w[4 * g + 2] = __builtin_amdgcn_exp2f(e[4 * g + 2] + b2);
        w[4 * g + 1] = __builtin_amdgcn_exp2f(e[4 * g + 1] + b1);
        w[4 * g + 0] = __builtin_amdgcn_exp2f(e[4 * g + 0] + b0);
    }
    carry += tot;
    bf16x8 pf[2];
#pragma unroll
    for (int s = 0; s < 2; ++s) { u32x4 pw; pw.x = pk2(w[8 * s], w[8 * s + 1]); pw.y = pk2(w[8 * s + 2], w[8 * s + 3]); pw.z = pk2(w[8 * s + 4], w[8 * s + 5]); pw.w = pk2(w[8 * s + 6], w[8 * s + 7]); pf[s] = __builtin_bit_cast(bf16x8, pw); }
    pv_block(o, vl, pf, lane);
}
__device__ __forceinline__ void cb_block(const f32x16& S, bool cbias, LAS unsigned char* vl, const LAS float* bl, int tq, int keypos0, int nvalid, float& m, float& l, f32x16 (&o)[2], int lane) {
    const int hh = lane >> 5;
    float s[16]; float bm = -INFINITY;
    if (cbias) {
        const float cb = bl[256];
#pragma unroll
        for (int r = 0; r < 16; ++r) { s[r] = S[r] + cb; bm = fmaxf(bm, s[r]); }
    } else {
#pragma unroll
        for (int r = 0; r < 16; ++r) {
            const int kr = (r & 3) + 8 * (r >> 2) + 4 * hh; int d = tq - (keypos0 + kr); d = d < -128 ? -128 : (d > 128 ? 128 : d);
            s[r] = (kr < nvalid) ? S[r] + bl[d + 128] : -INFINITY; bm = fmaxf(bm, s[r]);
        }
    }
    bm = fmaxf(bm, partner32(bm));
    const float mn = fmaxf(m, bm), f = __builtin_amdgcn_exp2f(m - mn); m = mn;
    float w[16], ls = 0.f;
#pragma unroll
    for (int r = 0; r < 16; ++r) { w[r] = __builtin_amdgcn_exp2f(s[r] - mn); ls += w[r]; }
    l = l * f + ls;
#pragma unroll
    for (int db = 0; db < 2; ++db)
#pragma unroll
        for (int r = 0; r < 16; ++r) o[db][r] *= f;
    bf16x8 pf[2];
#pragma unroll
    for (int s2 = 0; s2 < 2; ++s2) { u32x4 pw; pw.x = pk2(w[8 * s2], w[8 * s2 + 1]); pw.y = pk2(w[8 * s2 + 2], w[8 * s2 + 3]); pw.z = pk2(w[8 * s2 + 4], w[8 * s2 + 5]); pw.w = pk2(w[8 * s2 + 6], w[8 * s2 + 7]); pf[s2] = __builtin_bit_cast(bf16x8, pw); }
    pv_block(o, vl, pf, lane);
}
__device__ __forceinline__ void attn_store(f32x16 (&o)[2], float scale, const float* gain, bf16_t* mix, size_t row0, int col0, int nrows, LAS unsigned char* wl, int lane) {
    const int r = lane & 31, hh = lane >> 5;
    float ssq = 0.f;
#pragma unroll
    for (int db = 0; db < 2; ++db)
#pragma unroll
        for (int i = 0; i < 16; ++i) { o[db][i] *= scale; ssq += o[db][i] * o[db][i]; }
    ssq += partner32(ssq);
    const float rstd = rsqrtf(ssq * (1.0f / 64.0f) + EPS);
    LAS unsigned char* st = wl + AW_ST;
#pragma unroll
    for (int db = 0; db < 2; ++db)
#pragma unroll
        for (int g = 0; g < 4; ++g) { const int d0 = 32 * db + 8 * g + 4 * hh; const f32x4 gv = *(const f32x4*)(gain + d0);
            u32x2 w; w.x = pk2(o[db][4 * g] * rstd * gv[0], o[db][4 * g + 1] * rstd * gv[1]); w.y = pk2(o[db][4 * g + 2] * rstd * gv[2], o[db][4 * g + 3] * rstd * gv[3]);
            *(LAS u32x2*)(st + r * ST_PITCH + d0 * 2) = w; }
#pragma unroll
    for (int i = 0; i < 4; ++i) { const int row = 8 * i + (lane >> 3), ch = lane & 7; const u32x4 v = *(const LAS u32x4*)(st + row * ST_PITCH + ch * 16);
        if (row < nrows) *(u32x4*)(mix + (row0 + row) * DM + col0 + ch * 8) = v; }
}

template <bool F32> __device__ __forceinline__ void sb_loop(const void* kbase, const void* vbase, size_t rowbase, int jhi, int h, const bf16x8 (&qf)[4], int tq, float& carry, f32x16 (&o)[2], LAS unsigned char* wl, int lane) {
    const int r = lane & 31, hh = lane >> 5;
    bf16x8 kf[4]; u32x4 vn[4];
    ld_k<F32>(kf, kbase, (rowbase + 32 * jhi + r) * HW + h * 64 + 32 * hh); ld_v<F32>(vn, vbase, rowbase + 32 * jhi, 32, h, lane);
    for (int j = jhi; j >= 0; --j) {
        const f32x16 S = qk_block(kf, qf);
        st_v(wl + AW_V, vn, lane);
        if (j > 0) { ld_k<F32>(kf, kbase, (rowbase + 32 * (j - 1) + r) * HW + h * 64 + 32 * hh); ld_v<F32>(vn, vbase, rowbase + 32 * (j - 1), 32, h, lane); }
        sb_block(S, wl + AW_V, tq, 32 * j, carry, o, lane);
#if SB_EARLY
        if (__all(carry < SB_THR)) break;
#endif
    }
}
template <bool SAMPLE> __device__ __forceinline__ void sb_unit(const AttnArgs& A, int b, int h, int qb, LAS unsigned char* wl, int lane) {
    const int r = lane & 31, hh = lane >> 5;
    const bf16_t* Qa = QKV_; const bf16_t* Ka = Qa + (size_t)1 * MT * HW; const bf16_t* Va = Qa + (size_t)2 * MT * HW;
    int tq; size_t qrow;
    if (SAMPLE) { tq = PAST + (r & 15); qrow = (size_t)MP + b * DSEQ + (r & 15); } else { tq = 32 * qb + r; qrow = (size_t)b * SEQ + tq; }
    bf16x8 qf[4]; ld_k<false>(qf, Qa, qrow * HW + h * 64 + 32 * hh);
    float carry = 0.f; f32x16 o[2]; o[0] = f32x16{}; o[1] = f32x16{};
    if (SAMPLE) {
        bf16x8 kf[4]; u32x4 vr[4]; const size_t row0 = (size_t)MP + b * DSEQ;
        ld_k<false>(kf, Ka, (row0 + (r & 15)) * HW + h * 64 + 32 * hh); ld_v<false>(vr, Va, row0, DSEQ, h, lane); st_v(wl + AW_V, vr, lane);
        { const f32x16 S = qk_block(kf, qf); sb_block(S, wl + AW_V, tq, PAST, carry, o, lane); }
        sb_loop<true>(ARG(4) + (size_t)A.L * NBATCH * PAST * HW, ARG(5) + (size_t)A.L * NBATCH * PAST * HW, (size_t)b * PAST, PAST / 32 - 1, h, qf, tq, carry, o, wl, lane);
        attn_store(o, 1.f, ARG(11) + A.L * HW + h * 64, MIX_, row0, h * 64, DSEQ, wl, lane);
    } else {
        sb_loop<false>(Ka, Va, (size_t)b * SEQ, qb, h, qf, tq, carry, o, wl, lane);
        attn_store(o, 1.f, ARG(11) + A.L * HW + h * 64, MIX_, (size_t)b * SEQ + 32 * qb, h * 64, 32, wl, lane);
    }
}
template <bool F32> __device__ __forceinline__ void cb_loop(const void* kbase, const void* vbase, size_t rowbase, int jlo, int jhi, int pos0, int h, const bf16x8 (&qf)[4], int tq, float& m, float& l, f32x16 (&o)[2], LAS unsigned char* wl, int lane) {
    const int r = lane & 31, hh = lane >> 5;
    bf16x8 kf[4]; u32x4 vn[4];
    const int tqmin = tq - r;
    ld_k<F32>(kf, kbase, (rowbase + 32 * jlo + r) * HW + h * 64 + 32 * hh); ld_v<F32>(vn, vbase, rowbase + 32 * jlo, 32, h, lane);
    for (int j = jlo; j <= jhi; ++j) {
        const f32x16 S = qk_block(kf, qf);
        st_v(wl + AW_V, vn, lane);
        if (j < jhi) { ld_k<F32>(kf, kbase, (rowbase + 32 * (j + 1) + r) * HW + h * 64 + 32 * hh); ld_v<F32>(vn, vbase, rowbase + 32 * (j + 1), 32, h, lane); }
        const bool cbias = __builtin_amdgcn_readfirstlane(pos0 + 32 * j + 31 + 128 <= tqmin);
        cb_block(S, cbias, wl + AW_V, (const LAS float*)(wl + AW_BIAS), tq, pos0 + 32 * j, 32, m, l, o, lane);
    }
}
template <bool SAMPLE> __device__ __forceinline__ void cb_unit(const AttnArgs& A, int b, int h, int qb, LAS unsigned char* wl, int lane) {
    const int r = lane & 31, hh = lane >> 5;
    const bf16_t* Qb = QKV_ + (size_t)3 * MT * HW; const bf16_t* Kb = Qb + (size_t)1 * MT * HW; const bf16_t* Vb = Qb + (size_t)2 * MT * HW;
    LAS float* bl = (LAS float*)(wl + AW_BIAS);
#pragma unroll
    for (int i = 0; i < 5; ++i) { const int idx = lane + 64 * i; if (idx < 257) bl[idx] = (ARG(10) + (size_t)A.L * 257 * 8)[idx * 8 + h] * LOG2E; }
    int tq; size_t qrow;
    if (SAMPLE) { tq = PAST + (r & 15); qrow = (size_t)MP + b * DSEQ + (r & 15); } else { tq = 32 * qb + r; qrow = (size_t)b * SEQ + tq; }
    bf16x8 qf[4]; ld_k<false>(qf, Qb, qrow * HW + h * 64 + 32 * hh);
    float m = -INFINITY, l = 0.f; f32x16 o[2]; o[0] = f32x16{}; o[1] = f32x16{};
    if (SAMPLE) {
        cb_loop<true>(ARG(6) + (size_t)A.L * NBATCH * BANDL * HW, ARG(7) + (size_t)A.L * NBATCH * BANDL * HW, (size_t)b * BANDL, 0, BANDL / 32 - 1, PAST - BANDL, h, qf, tq, m, l, o, wl, lane);
        bf16x8 kf[4]; u32x4 vr[4]; const size_t row0 = (size_t)MP + b * DSEQ;
        ld_k<false>(kf, Kb, (row0 + (r & 15)) * HW + h * 64 + 32 * hh); ld_v<false>(vr, Vb, row0, DSEQ, h, lane); st_v(wl + AW_V, vr, lane);
        { const f32x16 S = qk_block(kf, qf); cb_block(S, false, wl + AW_V, bl, tq, PAST, DSEQ, m, l, o, lane); }
        l += partner32(l);
        attn_store(o, 1.0f / l, ARG(12) + A.L * HW + h * 64, MIX_, row0, HW + h * 64, DSEQ, wl, lane);
    } else {
        const int c = qb >> 1, clo = c - 8 < 0 ? 0 : c - 8;
        cb_loop<false>(Kb, Vb, (size_t)b * SEQ, 2 * clo, 2 * c + 1, 0, h, qf, tq, m, l, o, wl, lane);
        l += partner32(l);
        attn_store(o, 1.0f / l, ARG(12) + A.L * HW + h * 64, MIX_, (size_t)b * SEQ + 32 * qb, HW + h * 64, 32, wl, lane);
    }
}
constexpr unsigned AU_SSB = 64, AU_SCB = 128, AU_PSB = 128 + 4096, AU_ALL = 128 + 8192;
__device__ __forceinline__ void attn_phase(const AttnArgs& A, LAS unsigned char* lds) {
    const int tid_ = fresh_tid(), lane = tid_ & 63, wave = __builtin_amdgcn_readfirstlane(tid_ >> 6);
    LAS unsigned char* wl = lds + wave * AW_BYTES;
    unsigned u = 0; if (lane == 0) u = atomicAdd(WS_PTR(unsigned, WS_CTL) + A.L, 1u);
    u = __builtin_amdgcn_readfirstlane(u);
    for (;;) {
        if (u >= AU_ALL) break;
        unsigned un = 0; if (lane == 0) un = atomicAdd(WS_PTR(unsigned, WS_CTL) + A.L, 1u);
        if (u < AU_SSB) sb_unit<true>(A, u >> 3, u & 7, 0, wl, lane);
        else if (u < AU_SCB) { const unsigned v = u - AU_SSB; cb_unit<true>(A, v >> 3, v & 7, 0, wl, lane); }
        else if (u < AU_PSB) { const unsigned v = u - AU_SCB; const int bh = v >> 6; sb_unit<false>(A, bh >> 3, bh & 7, 63 - (int)(v & 63), wl, lane); }
        else { const unsigned v = u - AU_PSB; const int bh = v >> 6; cb_unit<false>(A, bh >> 3, bh & 7, (int)(v & 63), wl, lane); }
        u = __builtin_amdgcn_readfirstlane(un);
    }
}

__device__ __forceinline__ void p0_item(const float* W, int K, int N, const float* gain, bf16_t* WT, int kind, LAS float* scr, int item, int lane) {
    const int nblk = N / 32, kb = item / nblk, nb = item % nblk, k0 = 64 * kb, n0 = 32 * nb;
#pragma unroll
    for (int i = 0; i < 32; ++i) { const int kk = 2 * i + (lane >> 5); const float g = gain ? gain[k0 + kk] : 1.f; scr[kk * 33 + (lane & 31)] = W[(size_t)(k0 + kk) * N + n0 + (lane & 31)] * g; }
    asm volatile("s_waitcnt lgkmcnt(0)" ::: "memory");
    const int c = lane & 7;
#pragma unroll
    for (int j = 0; j < 4; ++j) { const int n = (lane >> 3) + 8 * j; const LAS float* s = scr + (8 * c) * 33 + n;
        u32x4 o; o.x = pk2(s[0 * 33], s[1 * 33]); o.y = pk2(s[2 * 33], s[3 * 33]); o.z = pk2(s[4 * 33], s[5 * 33]); o.w = pk2(s[6 * 33], s[7 * 33]);
        const int gn = n0 + n; const int drow = kind == 0 ? gn : ((gn >> 7) * 256 + (gn & 127) + (kind == 2 ? 128 : 0));
        *(u32x4*)(WT + (size_t)drow * K + k0 + 8 * c) = o; }
    asm volatile("s_waitcnt lgkmcnt(0)" ::: "memory");
}

#ifdef NO_SGEMM
#define SG(x)
#else
#define SG(x) x
#endif
#ifndef GP1
#define GP1(...) __VA_ARGS__
#endif
#ifndef GP2
#define GP2(...) __VA_ARGS__
#endif
#ifndef GP3
#define GP3(...) __VA_ARGS__
#endif
#ifndef GP4
#define GP4(...) __VA_ARGS__
#endif
#ifndef GP5
#define GP5(...) __VA_ARGS__
#endif
#ifndef GP6
#define GP6(...) __VA_ARGS__
#endif
#ifdef NO_SGEMM
#define SG(x)
#else
#define SG(x) x
#endif
#ifndef GP1
#define GP1(...) __VA_ARGS__
#endif
#ifndef GP2
#define GP2(...) __VA_ARGS__
#endif
#ifndef GP3
#define GP3(...) __VA_ARGS__
#endif
#ifndef GP4
#define GP4(...) __VA_ARGS__
#endif
#ifndef GP5
#define GP5(...) __VA_ARGS__
#endif
#ifndef GP6
#define GP6(...) __VA_ARGS__
#endif
struct Args { const float* in[22]; float* out; unsigned char* ws; };

#ifndef PROBE_SEL
#define PROBE_SEL -1
#endif
#if PROBE_SEL >= 0
#define TSTAMP(cat) do { if (blockIdx.x == 0 && fresh_tid() == 0) { const unsigned long long t_ = __builtin_amdgcn_s_memrealtime(); unsigned long long* tsb = WS_PTR(unsigned long long, WS_CTL + 4096); \
    tsb[16 + (cat)] += t_ - tsb[0]; tsb[0] = t_; } } while (0)
#else
#define TSTAMP(cat) do {} while (0)
#endif
__global__ void __launch_bounds__(NTHREADS, 2) hymba_fwd(Args args) {
    extern __shared__ __attribute__((aligned(16))) unsigned char lds_raw[];
    cg::grid_group grid = cg::this_grid();
    LAS unsigned char* lds = (LAS unsigned char*)lds_raw;
    const int G = gridDim.x;

#if PROBE_SEL >= 0
    if (blockIdx.x == 0 && fresh_tid() == 0) { unsigned long long* tsb = WS_PTR(unsigned long long, WS_CTL + 4096); for (int i = 0; i < 48; ++i) tsb[i] = 0; tsb[0] = __builtin_amdgcn_s_memrealtime(); }
#endif
    {
        const int tid = fresh_tid(), lane = tid & 63, wave = __builtin_amdgcn_readfirstlane(tid >> 6);
        const int gw = blockIdx.x * NWAVES + wave, NGW = G * NWAVES;
        { float* ssb = SSB; for (int i = blockIdx.x * NTHREADS + tid; i < 6 * MT; i += G * NTHREADS) ssb[MT + i] = 0.f;
          if (blockIdx.x == 0 && tid < 16) WS_PTR(unsigned, WS_CTL)[tid] = 0u; }
        LAS float* scr = (LAS float*)(lds + wave * 8704);
        constexpr int I_IN = 16 * 96, I_OUT = 16 * 32, I_G = 16 * 88, I_D = 44 * 32, I_PG = 16 * 32, I_PP = 4 * 32, I_L = I_IN + I_OUT + 2 * I_G + I_D + I_PG + I_PP;
        for (int it = gw; it < NLAYER * I_L; it += NGW) {
            const int L = it / I_L; int r = it % I_L;
            if (r < I_IN) { p0_item(ARG(9) + (size_t)L * DM * NQKV, DM, NQKV, ARG(8) + L * DM, (bf16_t*)WPTR(L, W_IN), 0, scr, r, lane); continue; } r -= I_IN;
            if (r < I_OUT) { p0_item(ARG(13) + (size_t)L * DM * DM, DM, DM, nullptr, (bf16_t*)WPTR(L, W_OUT), 0, scr, r, lane); continue; } r -= I_OUT;
            if (r < I_G) { p0_item(ARG(15) + (size_t)L * DM * DFF, DM, DFF, ARG(14) + L * DM, (bf16_t*)WPTR(L, W_GU), 1, scr, r, lane); continue; } r -= I_G;
            if (r < I_G) { p0_item(ARG(16) + (size_t)L * DM * DFF, DM, DFF, ARG(14) + L * DM, (bf16_t*)WPTR(L, W_GU), 2, scr, r, lane); continue; } r -= I_G;
            if (r < I_D) { p0_item(ARG(17) + (size_t)L * DFF * DM, DFF, DM, nullptr, (bf16_t*)WPTR(L, W_DOWN), 0, scr, r, lane); continue; } r -= I_D;
            if (r < I_PG) { p0_item(ARG(19) + (size_t)L * DM * DM, DM, DM, ARG(18) + L * DM, (bf16_t*)WPTR(L, W_PG), 0, scr, r, lane); continue; } r -= I_PG;
            p0_item(ARG(20) + (size_t)L * PLED * DM, PLED, DM, nullptr, (bf16_t*)WPTR(L, W_PP), 0, scr, r, lane);
        }
        { const float* pp = ARG(2); const float* ps = ARG(3); bf16_t* PB = PB_;
          for (int it0 = 4 * gw; it0 < NLAYER * MT; it0 += 4 * NGW) {
            f32x4 v[4];
#pragma unroll
            for (int rr = 0; rr < 4; ++rr) { const int it = it0 + rr, L = it / MT, row = it % MT;
                const float* src = row < MP ? pp + ((size_t)L * MP + row) * PLED : ps + ((size_t)L * MS + (row - MP)) * PLED;
                v[rr] = *((const f32x4*)src + lane); }
#pragma unroll
            for (int rr = 0; rr < 4; ++rr) { u32x2 w; w.x = pk2(v[rr][0], v[rr][1]); w.y = pk2(v[rr][2], v[rr][3]); *((u32x2*)(PB + (size_t)(it0 + rr) * PLED) + lane) = w; }
          } }
        { const float* x_p = ARG(0); const float* x_s = ARG(1); bf16_t* XB = XN_; float* ssb = SSB;
          for (int row0 = 2 * gw; row0 < MT; row0 += 2 * NGW) {
            f32x4 v[2][4];
#pragma unroll
            for (int rr = 0; rr < 2; ++rr) { const int row = row0 + rr; const float* src = row < MP ? x_p + (size_t)row * DM : x_s + (size_t)(row - MP) * DM;
#pragma unroll
                for (int j = 0; j < 4; ++j) v[rr][j] = *((const f32x4*)src + lane + 64 * j); }
#pragma unroll
            for (int rr = 0; rr < 2; ++rr) { float s2 = 0.f;
#pragma unroll
                for (int j = 0; j < 4; ++j) { const f32x4 t = v[rr][j]; s2 += (t[0] * t[0] + t[1] * t[1]) + (t[2] * t[2] + t[3] * t[3]);
                    u32x2 w; w.x = pk2(t[0], t[1]); w.y = pk2(t[2], t[3]); *((u32x2*)(XB + (size_t)(row0 + rr) * DM) + lane + 64 * j) = w; }
                s2 = wave_sum(s2);
                if (lane == 0) ssb[row0 + rr] = s2; }
          } }
    }
    TSTAMP(0); grid.sync(); TSTAMP(8);

    for (int L = 0; L < NLAYER; ++L) {
#define SS_MIX (SSB + (size_t)(3 * L) * MT)
#define SS_FFN (SSB + (size_t)(3 * L + 1) * MT)
#define SS_PLE (SSB + (size_t)(3 * L + 2) * MT)
#define SS_NEXT (SSB + (size_t)(3 * L + 3) * MT)
        { EpiArgs q{}; q.ss_in = SS_MIX; q.o0 = QKV_;
          q.f_sbk = ARG_OUT + O_SBK_P + (size_t)L * MP * HW; q.f_sbv = ARG_OUT + O_SBV_P + (size_t)L * MP * HW;
          q.f_cbk = ARG_OUT + O_CBK_P + (size_t)L * NBATCH * BANDL * HW; q.f_cbv = ARG_OUT + O_CBV_P + (size_t)L * NBATCH * BANDL * HW;
          pg8::Gemm g{XN_, WPTR(L, W_IN), MP, NQKV, DM}; pg8::StaticOrder S; S.init(MP, NQKV, G, (int)blockIdx.x);
          Epi<EP_QKV> E{q};
          GP1(pg8::gemm_phase<Epi<EP_QKV>, pg8::StaticOrder, true, true>(lds, g, S, E);) TSTAMP(1); }
        { EpiArgs q{}; q.ss_in = SS_MIX; q.o0 = QKV_;
          q.s_sbk = ARG_OUT + O_SBK_S + (size_t)L * MS * HW; q.s_sbv = ARG_OUT + O_SBV_S + (size_t)L * MS * HW;
          q.s_cbk = ARG_OUT + O_CBK_S + (size_t)L * MS * HW; q.s_cbv = ARG_OUT + O_CBV_S + (size_t)L * MS * HW;
          SG(sgemm<EP_QKV>(lds, XN_ + (size_t)MP * DM, DM, WPTR(L, W_IN), NQKV / 32, q);) TSTAMP(7); }
        grid.sync(); TSTAMP(8);
        { AttnArgs A{}; A.L = L;
#ifndef NO_ATTN
          attn_phase(A, lds);
#endif
          TSTAMP(2); }
        grid.sync(); TSTAMP(2);
        { EpiArgs q{}; q.XB = XB_; q.xbase = XN_; q.ss_out = SS_FFN;
          pg8::Gemm g{MIX_, WPTR(L, W_OUT), MP, DM, DM}; pg8::StaticOrder S; S.init(MP, DM, G, (int)blockIdx.x);
          Epi<EP_RES> E{q};
          GP2(pg8::gemm_phase<Epi<EP_RES>, pg8::StaticOrder, true, true>(lds, g, S, E);) TSTAMP(3); }
        { EpiArgs q{}; q.XB = XB_; q.xbase = XN_; q.ss_out = SS_FFN;
          SG(sgemm<EP_RES>(lds, MIX_ + (size_t)MP * DM, DM, WPTR(L, W_OUT), DM / 32, q);) TSTAMP(7); }
        { EpiArgs q2{}; q2.o0 = PBUF_;
          int kp = PLED; asm volatile("" : "+s"(kp));
          pg8::Gemm g2{PB_ + (size_t)L * MT * PLED, WPTR(L, W_PP), MP, DM, kp}; pg8::StaticOrder S; S.init(MP, DM, G, (int)blockIdx.x);
          Epi<EP_P> E2{q2};
          GP3(pg8::gemm_phase<Epi<EP_P>, pg8::StaticOrder, true, true>(lds, g2, S, E2);) TSTAMP(10);
          SG(sgemm<EP_P>(lds, PB_ + ((size_t)L * MT + MP) * PLED, PLED, WPTR(L, W_PP), DM / 32, q2);) TSTAMP(7); }
        grid.sync(); TSTAMP(8);
        { EpiArgs q{}; q.ss_in = SS_FFN; q.o0 = HB_;
          pg8::Gemm g{XB_, WPTR(L, W_GU), MP, 2 * DFF, DM}; pg8::StaticOrder S; S.init(MP, 2 * DFF, G, (int)blockIdx.x);
          Epi<EP_GU> E{q};
          GP4(pg8::gemm_phase<Epi<EP_GU>, pg8::StaticOrder, true, true>(lds, g, S, E);) TSTAMP(4);
          SG(sgemm<EP_GU>(lds, XB_ + (size_t)MP * DM, DM, WPTR(L, W_GU), DFF / 32, q);) TSTAMP(7); }
        grid.sync(); TSTAMP(8);
        { EpiArgs q{}; q.XB = XB_; q.xbase = XB_; q.ss_out = SS_PLE;
          pg8::Gemm g{HB_, WPTR(L, W_DOWN), MP, DM, DFF}; pg8::StaticOrder S; S.init(MP, DM, G, (int)blockIdx.x);
          Epi<EP_RES> E{q};
          GP5(pg8::gemm_phase<Epi<EP_RES>, pg8::StaticOrder, true, true>(lds, g, S, E);) TSTAMP(5);
          SG(sgemm<EP_RES>(lds, HB_ + (size_t)MP * DFF, DFF, WPTR(L, W_DOWN), DM / 32, q);) TSTAMP(7); }
        grid.sync(); TSTAMP(8);
        { EpiArgs q{}; q.XB = XN_  ; q.P = PBUF_; q.xbase = XB_; q.ss_in = SS_PLE; q.ss_out = SS_NEXT;
          pg8::Gemm g{XB_, WPTR(L, W_PG), MP, DM, DM}; pg8::StaticOrder S; S.init(MP, DM, G, (int)blockIdx.x);
          Epi<EP_PLE> E{q};
          GP6(pg8::gemm_phase<Epi<EP_PLE>, pg8::StaticOrder, true, true>(lds, g, S, E);) TSTAMP(6);
          SG(sgemm<EP_PLE>(lds, XB_ + (size_t)MP * DM, DM, WPTR(L, W_PG), DM / 32, q);) TSTAMP(7); }
        grid.sync(); TSTAMP(8);
    }
    {
        const int tid = fresh_tid(), lane = tid & 63, wave = __builtin_amdgcn_readfirstlane(tid >> 6);
        const int gw = blockIdx.x * NWAVES + wave, NGW = G * NWAVES;
        const float* ssf = SSB + (size_t)(3 * NLAYER) * MT; const float* gf = ARG(21); const bf16_t* XN = XN_; float* out = ARG_OUT;
        for (int row0 = 2 * gw; row0 < MT; row0 += 2 * NGW) {
            u32x2 xv[2][4];
#pragma unroll
            for (int rr = 0; rr < 2; ++rr)
#pragma unroll
                for (int j = 0; j < 4; ++j) xv[rr][j] = *((const u32x2*)(XN + (size_t)(row0 + rr) * DM) + lane + 64 * j);
#pragma unroll
            for (int rr = 0; rr < 2; ++rr) { const int row = row0 + rr; const float rs = rstd_of(ssf[row]);
                float* dst = row < MP ? out + O_YP + (size_t)row * DM : out + O_YS + (size_t)(row - MP) * DM;
#pragma unroll
                for (int j = 0; j < 4; ++j) { const f32x4 gv = *((const f32x4*)gf + lane + 64 * j); const u32x2 w = xv[rr][j];
                    const f32x4 v = {bf_lo(w.x), bf_hi(w.x), bf_lo(w.y), bf_hi(w.y)};
                    *((f32x4*)dst + lane + 64 * j) = v * rs * gv; } }
        }
    }
#if PROBE_SEL >= 0
    TSTAMP(11); grid.sync();
    if (blockIdx.x == 0 && fresh_tid() == 0) { const unsigned long long* tsb = WS_PTR(unsigned long long, WS_CTL + 4096); float* o = ARG_OUT + O_YS; unsigned long long tv = 0; if (PROBE_SEL == 20) tv = tsb[16+1] + tsb[16+3] + tsb[16+10] + tsb[16+4] + tsb[16+5] + tsb[16+6]; else if (PROBE_SEL == 21) tv = tsb[16+0] + tsb[16+11]; else if (PROBE_SEL < 16) tv = tsb[16 + PROBE_SEL]; o[0] += (float)tv * 2.5e-5f; }
#endif
}

extern "C" void kernel_launch(void* const* d_in, const int* in_sizes, int n_in, void* d_out, int out_size, void* d_ws, size_t ws_size, hipStream_t stream) {
    static int grid = 0;
    if (grid == 0) {
        int dev = 0, cus = 0, per_cu = 0;
        hipGetDevice(&dev);
        hipDeviceGetAttribute(&cus, hipDeviceAttributeMultiprocessorCount, dev);
        hipFuncSetAttribute((const void*)hymba_fwd, hipFuncAttributeMaxDynamicSharedMemorySize, LDS_BYTES);
        hipOccupancyMaxActiveBlocksPerMultiprocessor(&per_cu, (const void*)hymba_fwd, NTHREADS, LDS_BYTES);
        if (per_cu < 1) per_cu = 1;
        grid = cus * per_cu;
        if (n_in != 22 || ws_size < WS_END) { fprintf(stderr, "kernel_launch: unexpected n_in %d / ws_size %zu\n", n_in, ws_size); }
    }
    Args a{};
    for (int i = 0; i < 22; ++i) a.in[i] = (const float*)d_in[i];
    a.out = (float*)d_out; a.ws = (unsigned char*)d_ws;
    void* kargs[] = {&a};
    hipError_t e = hipLaunchCooperativeKernel((const void*)hymba_fwd, dim3(grid), dim3(NTHREADS), kargs, LDS_BYTES, stream);
    if (e != hipSuccess) fprintf(stderr, "cooperative launch failed: %s (grid %d)\n", hipGetErrorString(e), grid);
}
```

```cpp
#include <hip/hip_runtime.h>
#include <hip/hip_cooperative_groups.h>
#include <cstdio>
#include <cstdint>
namespace cg = cooperative_groups;
__device__ __forceinline__ int fresh_tid() { int t = threadIdx.x; asm volatile("" : "+v"(t)); return t; }
namespace pg8 {
#define PG8_LAS __attribute__((address_space(3)))
typedef unsigned short bf16_t;
typedef short bf16x8 __attribute__((ext_vector_type(8)));
typedef float f32x4 __attribute__((ext_vector_type(4)));
typedef unsigned u32x4 __attribute__((ext_vector_type(4)));
constexpr int BM = 256, BK = 64, HALF = 128, HTB = HALF * BK * 2  , STAGE_BYTES = 8 * HTB, NXCD = 8, WGM = 8;

__host__ __device__ __forceinline__ int lds_byte(int r, int c) { const int st = (r >> 4) * 2 + (c >> 5), rr = r & 15, cc = c & 31, ob = rr * 64 + cc * 2; return st * 1024 + (ob ^ (((ob >> 9) & 1) << 5)); }
__host__ __device__ __forceinline__ void stage_rc(int b, int& R, int& C) { const int st = b / 1024, sb = b % 1024, swz = sb ^ (((sb >> 9) & 1) << 5); R = (st >> 1) * 16 + swz / 64; C = (st & 1) * 32 + (swz % 64) / 2; }
__host__ __device__ __forceinline__ int perm32(int rho) { const int n = rho >> 4, i = rho & 15; return 8 * (i >> 2) + 4 * n + (i & 3); }

struct Unit { int pm, pn; };
struct Gemm { const bf16_t* A; const bf16_t* Bt; int M, N, K; };

struct StaticOrder {
    int nM, nN, nwg, G, c;
    __host__ __device__ void init(int M, int N, int G_, int c_) { nM = M / BM; nN = N / BM; nwg = nM * nN; G = G_; c = c_; }
    __host__ __device__ bool next(int i, Unit& u) const {
        const long L = (long)i * G + c; if (L >= nwg) return false;
        int wgid = (int)L; { const int q = nwg / NXCD, r = nwg % NXCD, xcd = wgid % NXCD, off = wgid / NXCD; wgid = (xcd < r ? xcd * (q + 1) : r * (q + 1) + (xcd - r) * q) + off; }
        const int nig = WGM * nN, gid = wgid / nig, fm = gid * WGM, gsz = (nM - fm) < WGM ? (nM - fm) : WGM;
        u.pm = fm + ((wgid % nig) % gsz); u.pn = (wgid % nig) / gsz; return true;
    }
    __device__ __forceinline__ void a_ready(const Unit&) const {}
    __device__ __forceinline__ void done(const Unit&) const {}
};

template <class Epi, class Sched, bool ALIGN_EPI = false, bool SP2 = false>
__device__ __forceinline__ void gemm_phase(PG8_LAS unsigned char* lds, const Gemm g, const Sched& S, const Epi& E) {
    const int tid = fresh_tid(), wid = __builtin_amdgcn_readfirstlane(tid >> 6), lane = tid & 63, wr = wid >> 2, wc = wid & 3, fr = lane & 15, fq = lane >> 4;
    const int K = g.K, nt = K / BK;
    unsigned voffA[2], voffB[2];
#pragma unroll
    for (int i = 0; i < 2; ++i) { int R, C; stage_rc(tid * 16 + i * 8192, R, C); const int Rb = Epi::PERM ? ((R & ~31) + perm32(R & 31)) : R;
        voffA[i] = (unsigned)(R * K + C) * 2u; voffB[i] = (unsigned)(Rb * K + C) * 2u; }
    const size_t kstep = (size_t)(BK * 2);
    const size_t hstep = (size_t)HALF * K * 2;
    const size_t tstep = 2 * hstep;
    const unsigned ldsw = (unsigned)wid * 1024u;
    const int aoff = lds_byte(wr * 64 + fr, fq * 8), boff = lds_byte(wc * 32 + fr, fq * 8);
#define PG8_SA(b, h) (((b) * 2 + (h)) * HTB)
#define PG8_SB(b, h) ((4 + (b) * 2 + (h)) * HTB)
#define PG8_STAGE(bufoff, gbase, voff) do { _Pragma("unroll") for (int _i = 0; _i < 2; ++_i) \
        __builtin_amdgcn_global_load_lds((const unsigned*)((const char*)(gbase) + (voff)[_i]), (PG8_LAS unsigned*)(lds + (bufoff) + ldsw + _i * 8192), 16, 0, 0); } while (0)
#define PG8_LDA(dst, b, h) do { _Pragma("unroll") for (int m = 0; m < 4; ++m) _Pragma("unroll") for (int k = 0; k < 2; ++k) dst[m][k] = *(const PG8_LAS bf16x8*)(lds + PG8_SA(b, h) + aoff + m * 2048 + k * 1024); } while (0)
#define PG8_LDB(dst, b, h) do { _Pragma("unroll") for (int n = 0; n < 2; ++n) _Pragma("unroll") for (int k = 0; k < 2; ++k) dst[n][k] = *(const PG8_LAS bf16x8*)(lds + PG8_SB(b, h) + boff + n * 2048 + k * 1024); } while (0)
#define PG8_MMA(ai, bj, At, Bt) do { __builtin_amdgcn_s_setprio(1); _Pragma("unroll") for (int m = 0; m < 4; ++m) _Pragma("unroll") for (int n = 0; n < 2; ++n) _Pragma("unroll") for (int k = 0; k < 2; ++k) \
        acc[ai][bj][m][n] = __builtin_amdgcn_mfma_f32_16x16x32_bf16(Bt[n][k], At[m][k], acc[ai][bj][m][n], 0, 0, 0); __builtin_amdgcn_s_setprio(0); } while (0)
#define PG8_WAIT_V(n) asm volatile("s_waitcnt vmcnt(" #n ")" ::: "memory")
#define PG8_WAIT_L(n) asm volatile("s_waitcnt lgkmcnt(" #n ")" ::: "memory")
#define PG8_BAR __builtin_amdgcn_s_barrier()
#define PG8_SCHED __builtin_amdgcn_sched_barrier(0)
    Unit cur, nxt; int ui = 0;
    if (!S.next(0, cur)) return;
    f32x4 acc[2][2][4][2];
#pragma unroll
    for (int a = 0; a < 2; ++a)
#pragma unroll
        for (int b = 0; b < 2; ++b)
#pragma unroll
            for (int m = 0; m < 4; ++m)
#pragma unroll
                for (int n = 0; n < 2; ++n) acc[a][b][m][n] = (f32x4){0.f, 0.f, 0.f, 0.f};
    bf16x8 At[4][2], B0[2][2], B1[2][2];
    const char* cA = (const char*)g.A + (size_t)cur.pm * tstep; const char* cB = (const char*)g.Bt + (size_t)cur.pn * tstep;
    S.a_ready(cur);
    if constexpr (SP2) {
        PG8_STAGE(PG8_SB(0, 0), cB, voffB); PG8_STAGE(PG8_SB(0, 1), cB + hstep, voffB); PG8_STAGE(PG8_SA(0, 0), cA, voffA); PG8_STAGE(PG8_SA(0, 1), cA + hstep, voffA);
        if (wr == 1) PG8_BAR;
        PG8_WAIT_V(2); PG8_BAR;
        PG8_STAGE(PG8_SB(1, 0), cB + kstep, voffB); PG8_STAGE(PG8_SA(1, 0), cA + kstep, voffA); PG8_STAGE(PG8_SB(1, 1), cB + hstep + kstep, voffB);
        PG8_WAIT_V(6); PG8_BAR;
    } else {
        PG8_STAGE(PG8_SB(0, 0), cB, voffB); PG8_STAGE(PG8_SA(0, 0), cA, voffA); PG8_STAGE(PG8_SB(0, 1), cB + hstep, voffB); PG8_STAGE(PG8_SA(0, 1), cA + hstep, voffA);
        if (wr == 1) PG8_BAR;
        PG8_WAIT_V(4); PG8_BAR;
        PG8_STAGE(PG8_SB(1, 0), cB + kstep, voffB); PG8_STAGE(PG8_SA(1, 0), cA + kstep, voffA); PG8_STAGE(PG8_SB(1, 1), cB + hstep + kstep, voffB);
        PG8_WAIT_V(6); PG8_BAR;
    }
    for (;;) {
        const bool has_next = S.next(ui + 1, nxt);
        const char* nA = has_next ? (const char*)g.A + (size_t)nxt.pm * tstep : cA; const char* nB = has_next ? (const char*)g.Bt + (size_t)nxt.pn * tstep : cB;
        for (int t = 0; t < nt; t += 2) {
            const bool last = (t == nt - 2);
            const char* a1 = cA + (size_t)(t + 1) * kstep;
            const char* a2 = last ? nA : cA + (size_t)(t + 2) * kstep; const char* b2 = last ? nB : cB + (size_t)(t + 2) * kstep;
            const char* a3 = a2 + kstep; const char* b3 = b2 + kstep;
            if (last && has_next) S.a_ready(nxt);
            if constexpr (SP2) {
            PG8_LDB(B0, 0, 0); PG8_LDB(B1, 0, 1); PG8_SCHED; PG8_LDA(At, 0, 0); PG8_STAGE(PG8_SA(1, 1), a1 + hstep, voffA);
            PG8_WAIT_V(8); PG8_WAIT_L(0); PG8_BAR; PG8_MMA(0, 0, At, B0); PG8_MMA(0, 1, At, B1); PG8_BAR; PG8_SCHED;
            PG8_LDA(At, 0, 1); PG8_STAGE(PG8_SB(0, 0), b2, voffB); PG8_STAGE(PG8_SB(0, 1), b2 + hstep, voffB); PG8_STAGE(PG8_SA(0, 0), a2, voffA);
            PG8_WAIT_V(8); PG8_WAIT_L(0); PG8_BAR; PG8_MMA(1, 0, At, B0); PG8_MMA(1, 1, At, B1); PG8_BAR; PG8_SCHED;
            PG8_LDB(B0, 1, 0); PG8_LDB(B1, 1, 1); PG8_SCHED; PG8_LDA(At, 1, 0); PG8_STAGE(PG8_SA(0, 1), a2 + hstep, voffA);
            PG8_WAIT_V(8); PG8_WAIT_L(0); PG8_BAR; PG8_MMA(0, 0, At, B0); PG8_MMA(0, 1, At, B1); PG8_BAR; PG8_SCHED;
            PG8_LDA(At, 1, 1); PG8_STAGE(PG8_SB(1, 0), b3, voffB); PG8_STAGE(PG8_SB(1, 1), b3 + hstep, voffB); PG8_STAGE(PG8_SA(1, 0), a3, voffA);
            PG8_WAIT_V(8); PG8_WAIT_L(0); PG8_BAR; PG8_MMA(1, 0, At, B0); PG8_MMA(1, 1, At, B1); PG8_BAR; PG8_SCHED;
            } else {
            PG8_LDB(B0, 0, 0); PG8_SCHED; PG8_LDA(At, 0, 0); PG8_STAGE(PG8_SA(1, 1), a1 + hstep, voffA);
            PG8_WAIT_L(8); PG8_BAR; PG8_WAIT_L(0); PG8_MMA(0, 0, At, B0); PG8_BAR; PG8_SCHED;
            PG8_LDB(B1, 0, 1); PG8_STAGE(PG8_SB(0, 0), b2, voffB);
            PG8_BAR; PG8_WAIT_L(0); PG8_MMA(0, 1, At, B1); PG8_BAR;
            PG8_LDA(At, 0, 1); PG8_STAGE(PG8_SA(0, 0), a2, voffA);
            PG8_BAR; PG8_WAIT_L(0); PG8_MMA(1, 0, At, B0); PG8_BAR; PG8_SCHED;
            PG8_STAGE(PG8_SB(0, 1), b2 + hstep, voffB);
            PG8_WAIT_V(6); PG8_BAR; PG8_MMA(1, 1, At, B1); PG8_BAR;
            PG8_LDB(B0, 1, 0); PG8_SCHED; PG8_LDA(At, 1, 0); PG8_STAGE(PG8_SA(0, 1), a2 + hstep, voffA);
            PG8_WAIT_L(8); PG8_BAR; PG8_WAIT_L(0); PG8_MMA(0, 0, At, B0); PG8_BAR; PG8_SCHED;
            PG8_LDB(B1, 1, 1); PG8_STAGE(PG8_SB(1, 0), b3, voffB);
            PG8_BAR; PG8_WAIT_L(0); PG8_MMA(0, 1, At, B1); PG8_BAR;
            PG8_LDA(At, 1, 1); PG8_STAGE(PG8_SA(1, 0), a3, voffA);
            PG8_BAR; PG8_WAIT_L(0); PG8_MMA(1, 0, At, B0); PG8_BAR; PG8_SCHED;
            PG8_STAGE(PG8_SB(1, 1), b3 + hstep, voffB);
            PG8_WAIT_V(6); PG8_BAR; PG8_MMA(1, 1, At, B1); PG8_BAR;
            }
        }
        if constexpr (ALIGN_EPI) { if (wr == 0) PG8_BAR; }
        if constexpr (!Epi::AFTER_DRAIN) { E(acc, cur, wr, wc, fr, fq); S.done(cur); }
        if (!has_next) break;
#pragma unroll
        for (int a = 0; a < 2; ++a)
#pragma unroll
            for (int b = 0; b < 2; ++b)
#pragma unroll
                for (int m = 0; m < 4; ++m)
#pragma unroll
                    for (int n = 0; n < 2; ++n) acc[a][b][m][n] = (f32x4){0.f, 0.f, 0.f, 0.f};
        cur = nxt; cA = nA; cB = nB; ++ui;
        if constexpr (ALIGN_EPI) { if (wr == 1) PG8_BAR; }
    }
    PG8_WAIT_V(0);
    if constexpr (!ALIGN_EPI) { if (wr == 0) PG8_BAR; }
    PG8_BAR;
    if constexpr (Epi::AFTER_DRAIN) { E.fused(acc, cur, wr, wc, fr, fq, lds, wid, lane); S.done(cur); }
#undef PG8_SA
#undef PG8_SB
#undef PG8_STAGE
#undef PG8_LDA
#undef PG8_LDB
#undef PG8_MMA
#undef PG8_WAIT_V
#undef PG8_WAIT_L
#undef PG8_BAR
#undef PG8_SCHED
}
}

#define LAS __attribute__((address_space(3)))
using pg8::bf16_t; using pg8::bf16x8; using pg8::f32x4; using pg8::u32x4;
typedef short s16x4 __attribute__((ext_vector_type(4)));
typedef float f32x16 __attribute__((ext_vector_type(16)));
typedef unsigned u32x2 __attribute__((ext_vector_type(2)));
typedef float f32x2_t __attribute__((ext_vector_type(2)));
typedef __bf16 bf16x2_t __attribute__((ext_vector_type(2)));

constexpr int DM = 1024, SEQ = 2048, NBATCH = 8, MP = NBATCH * SEQ, DSEQ = 16, MS = NBATCH * DSEQ, MT = MP + MS;
constexpr int DFF = 2816, NQKV = 3072, PLED = 256, NLAYER = 2, PAST = 2048, BANDL = 512, HW = 512;
constexpr float EPS = 1e-6f, LOG2E = 1.4426950408889634f, QSCALE = 0.125f * LOG2E;
#ifndef SB_EARLY
#define SB_EARLY 1
#endif
constexpr float SB_THR = -160.0f;

constexpr size_t MiB = 1u << 20;
constexpr size_t WS_CTL = 0, WS_SS = 64 * 1024;
constexpr size_t WS_W = 2 * MiB, W_LSTRIDE = 28 * MiB, W_IN = 0, W_OUT = 6 * MiB, W_GU = 8 * MiB, W_DOWN = 19 * MiB, W_PG = 25 * MiB, W_PP = 27 * MiB;
constexpr size_t WS_PB = 58 * MiB, WS_X = 76 * MiB  , WS_XB = 142 * MiB, WS_QKV = 176 * MiB, WS_MIX = 274 * MiB, WS_P = 308 * MiB, WS_END = 342 * MiB;
constexpr int LDS_BYTES = 131072 + 1024;
constexpr size_t WS_BAR = 8192;
constexpr int NWAVES = 8, NTHREADS = 512;

constexpr size_t O_YP = 0, O_YS = (size_t)MP * DM, O_SBK_P = O_YS + (size_t)MS * DM, O_SBV_P = O_SBK_P + (size_t)NLAYER * MP * HW,
                 O_CBK_P = O_SBV_P + (size_t)NLAYER * MP * HW, O_CBV_P = O_CBK_P + (size_t)NLAYER * NBATCH * BANDL * HW,
                 O_SBK_S = O_CBV_P + (size_t)NLAYER * NBATCH * BANDL * HW, O_SBV_S = O_SBK_S + (size_t)NLAYER * MS * HW,
                 O_CBK_S = O_SBV_S + (size_t)NLAYER * MS * HW, O_CBV_S = O_CBK_S + (size_t)NLAYER * MS * HW;

__device__ __forceinline__ unsigned pk2(float lo, float hi) { f32x2_t v = {lo, hi}; bf16x2_t b = __builtin_convertvector(v, bf16x2_t); return __builtin_bit_cast(unsigned, b); }
__device__ __forceinline__ float bf_lo(unsigned w) { return __uint_as_float(w << 16); }
__device__ __forceinline__ float bf_hi(unsigned w) { return __uint_as_float(w & 0xffff0000u); }
__device__ __forceinline__ float partner32(float v) {
    auto rr = __builtin_amdgcn_permlane32_swap(__float_as_uint(v), __float_as_uint(v), false, false);
    return (threadIdx.x & 32) ? __uint_as_float(rr[0]) : __uint_as_float(rr[1]);
}
__device__ __forceinline__ float wave_sum(float v) {
#pragma unroll
    for (int o = 1; o < 64; o <<= 1) v += __shfl_xor(v, o);
    return v;
}
__device__ __forceinline__ float rstd_of(float ss) { return rsqrtf(ss * (1.0f / DM) + EPS); }

template <int I> __device__ __forceinline__ const float* argp() {
    unsigned long long v; const void* ka = (const void*)__builtin_amdgcn_kernarg_segment_ptr();
    asm volatile("s_load_dwordx2 %0, %1, %2\n\ts_waitcnt lgkmcnt(0)" : "=s"(v) : "s"(ka), "i"(I * 8) : "memory");
    return (const float*)v;
}
#define ARG(i) argp<i>()
#define ARG_OUT ((float*)argp<22>())
#define ARG_WS ((unsigned char*)argp<23>())
#define WS_PTR(T, off) ((T*)(ARG_WS + (off)))
#define SSB WS_PTR(float, WS_SS)
#define PB_ WS_PTR(bf16_t, WS_PB)
#define XN_ WS_PTR(bf16_t, WS_X)
#define XB_ WS_PTR(bf16_t, WS_XB)
#define QKV_ WS_PTR(bf16_t, WS_QKV)
#define HB_ WS_PTR(bf16_t, WS_QKV)
#define MIX_ WS_PTR(bf16_t, WS_MIX)
#define PBUF_ WS_PTR(bf16_t, WS_P)
#define WPTR(L, off) ((const bf16_t*)(ARG_WS + WS_W + (size_t)(L) * W_LSTRIDE + (off)))

enum { EP_QKV = 0, EP_RES = 1, EP_GU = 2, EP_P = 3, EP_PLE = 4 };
struct EpiArgs {
    const float* ss_in; float* ss_out;
    const bf16_t* xbase;
    bf16_t* XB; bf16_t* o0; const bf16_t* P;
    float *f_sbk, *f_sbv, *f_cbk, *f_cbv;
    float *s_sbk, *s_sbv, *s_cbk, *s_cbv;
};
template <int MODE> struct Epi {
    static constexpr bool PERM = false, AFTER_DRAIN = false;
    EpiArgs a;
    __device__ __forceinline__ void operator()(const f32x4 (&acc)[2][2][4][2], const pg8::Unit& u, int wr, int wc, int fr, int fq) const {
        if constexpr (MODE == EP_QKV) {
            const int part = u.pn >> 1, cb = (u.pn & 1) * 256 + wc * 32 + 4 * fq;
            bf16_t* ob = a.o0 + (size_t)part * ((size_t)MT * HW);
            float* fo = part == 1 ? a.f_sbk : part == 2 ? a.f_sbv : part == 4 ? a.f_cbk : part == 5 ? a.f_cbv : nullptr;
            const bool band = part >= 4; const float qs = (part == 0 || part == 3) ? QSCALE : 1.f;
#pragma unroll
            for (int ai = 0; ai < 2; ++ai)
#pragma unroll
                for (int m = 0; m < 4; ++m) {
                    const int row = u.pm * 256 + ai * 128 + wr * 64 + m * 16 + fr;
                    const float rs = rstd_of(a.ss_in[row]) * qs;
                    const int t = row & (SEQ - 1);
                    float* frow = nullptr;
                    if (fo) { if (!band) frow = fo + (size_t)row * HW; else if (t >= SEQ - BANDL) frow = fo + ((size_t)(row >> 11) * BANDL + (t - (SEQ - BANDL))) * HW; }
#pragma unroll
                    for (int bj = 0; bj < 2; ++bj)
#pragma unroll
                        for (int n = 0; n < 2; ++n) {
                            const int col = cb + bj * 128 + n * 16; const f32x4 v = acc[ai][bj][m][n] * rs;
                            u32x2 w; w.x = pk2(v[0], v[1]); w.y = pk2(v[2], v[3]);
                            *(u32x2*)(ob + (size_t)row * HW + col) = w;
                            if (frow) *(f32x4*)(frow + col) = v;
                        }
                }
        } else if constexpr (MODE == EP_RES || MODE == EP_PLE) {
#pragma unroll
            for (int ai = 0; ai < 2; ++ai)
#pragma unroll
                for (int m = 0; m < 4; ++m) {
                    const int row = u.pm * 256 + ai * 128 + wr * 64 + m * 16 + fr;
                    float rs = 0.f; if constexpr (MODE == EP_PLE) rs = rstd_of(a.ss_in[row]) * (-LOG2E);
                    float s = 0.f;
#pragma unroll
                    for (int bj = 0; bj < 2; ++bj)
#pragma unroll
                        for (int n = 0; n < 2; ++n) {
                            const size_t off = (size_t)row * DM + u.pn * 256 + bj * 128 + wc * 32 + n * 16 + 4 * fq;
                            const u32x2 xw = *(const u32x2*)(a.xbase + off); f32x4 x = {bf_lo(xw.x), bf_hi(xw.x), bf_lo(xw.y), bf_hi(xw.y)}; const f32x4 c = acc[ai][bj][m][n];
                            if constexpr (MODE == EP_RES) x += c;
                            else { const u32x2 pw = *(const u32x2*)(a.P + off);
                                   x[0] += bf_lo(pw.x) * __builtin_amdgcn_rcpf(1.f + __builtin_amdgcn_exp2f(c[0] * rs));
                                   x[1] += bf_hi(pw.x) * __builtin_amdgcn_rcpf(1.f + __builtin_amdgcn_exp2f(c[1] * rs));
                                   x[2] += bf_lo(pw.y) * __builtin_amdgcn_rcpf(1.f + __builtin_amdgcn_exp2f(c[2] * rs));
                                   x[3] += bf_hi(pw.y) * __builtin_amdgcn_rcpf(1.f + __builtin_amdgcn_exp2f(c[3] * rs)); }
                            u32x2 w; w.x = pk2(x[0], x[1]); w.y = pk2(x[2], x[3]); *(u32x2*)(a.XB + off) = w;
                            s += (x[0] * x[0] + x[1] * x[1]) + (x[2] * x[2] + x[3] * x[3]);
                        }
                    s += __shfl_xor(s, 16); s += __shfl_xor(s, 32);
                    if (fq == 0) unsafeAtomicAdd(a.ss_out + row, s);
                }
        } else if constexpr (MODE == EP_GU) {
#pragma unroll
            for (int ai = 0; ai < 2; ++ai)
#pragma unroll
                for (int m = 0; m < 4; ++m) {
                    const int row = u.pm * 256 + ai * 128 + wr * 64 + m * 16 + fr;
                    const float rs = rstd_of(a.ss_in[row]);
#pragma unroll
                    for (int n = 0; n < 2; ++n) {
                        const int col = u.pn * 128 + wc * 32 + n * 16 + 4 * fq;
                        const f32x4 g = acc[ai][0][m][n] * rs, up = acc[ai][1][m][n] * rs; float h[4];
#pragma unroll
                        for (int e = 0; e < 4; ++e) h[e] = g[e] * up[e] * __builtin_amdgcn_rcpf(1.f + __builtin_amdgcn_exp2f(-LOG2E * g[e]));
                        u32x2 w; w.x = pk2(h[0], h[1]); w.y = pk2(h[2], h[3]);
                        *(u32x2*)(a.o0 + (size_t)row * DFF + col) = w;
                    }
                }
        } else {
#pragma unroll
            for (int ai = 0; ai < 2; ++ai)
#pragma unroll
                for (int m = 0; m < 4; ++m) {
                    const int row = u.pm * 256 + ai * 128 + wr * 64 + m * 16 + fr;
#pragma unroll
                    for (int bj = 0; bj < 2; ++bj)
#pragma unroll
                        for (int n = 0; n < 2; ++n) {
                            const size_t off = (size_t)row * DM + u.pn * 256 + bj * 128 + wc * 32 + n * 16 + 4 * fq; const f32x4 v = acc[ai][bj][m][n];
                            u32x2 w; w.x = pk2(v[0], v[1]); w.y = pk2(v[2], v[3]); *(u32x2*)(a.o0 + off) = w;
                        }
                }
        }
    }
};

template <int MODE, int K>
__device__ __forceinline__ void sgemm(LAS unsigned char* lds, const bf16_t* A, const bf16_t* Bt, int ncol32, const EpiArgs& a) {
    const int tid = fresh_tid(), lane = tid & 63, wave = __builtin_amdgcn_readfirstlane(tid >> 6), r = lane & 31, hh = lane >> 5;
    LAS float* red = (LAS float*)lds;
    constexpr int K8 = K >> 3, NK = K8 / 16, UB = NK > 11 ? 11 : NK;
    static_assert(NK % UB == 0, "sgemm: K split");
    const int G = gridDim.x, nunits = 4 * ncol32;
    for (int j = G - 1 - (int)blockIdx.x; j < nunits; j += G) {
        const int rb = j & 3, c0 = 32 * (j >> 2);
        const int brow0 = (MODE == EP_GU) ? ((c0 >> 7) * 256 + (c0 & 127)) : c0;
        const bf16_t* ap = A + (size_t)(32 * rb + r) * K + wave * K8 + 8 * hh;
        const bf16_t* bp = Bt + (size_t)(brow0 + r) * K + wave * K8 + 8 * hh;
        f32x16 acc0 = {}, acc1 = {};
#pragma unroll 1
        for (int kb = 0; kb < NK; kb += UB) {
            bf16x8 af[UB], bf[UB], bf2[MODE == EP_GU ? UB : 1];
#pragma unroll
            for (int i = 0; i < UB; ++i) { af[i] = *(const bf16x8*)(ap + (kb + i) * 16); bf[i] = *(const bf16x8*)(bp + (kb + i) * 16);
                if constexpr (MODE == EP_GU) bf2[i] = *(const bf16x8*)(bp + (size_t)128 * K + (kb + i) * 16); }
#pragma unroll
            for (int i = 0; i < UB; ++i) { acc0 = __builtin_amdgcn_mfma_f32_32x32x16_bf16(af[i], bf[i], acc0, 0, 0, 0);
                if constexpr (MODE == EP_GU) acc1 = __builtin_amdgcn_mfma_f32_32x32x16_bf16(af[i], bf2[i], acc1, 0, 0, 0); }
        }
#pragma unroll
        for (int i = 0; i < 16; ++i) { red[(wave * 16 + i) * 64 + lane] = acc0[i]; if constexpr (MODE == EP_GU) red[8192 + (wave * 16 + i) * 64 + lane] = acc1[i]; }
        __syncthreads();
        const int col = c0 + r;
#pragma unroll
        for (int ii = 0; ii < 2; ++ii) {
            const int i = 2 * wave + ii;
            float v0 = 0.f, v1 = 0.f;
#pragma unroll
            for (int w = 0; w < 8; ++w) { v0 += red[(w * 16 + i) * 64 + lane]; if constexpr (MODE == EP_GU) v1 += red[8192 + (w * 16 + i) * 64 + lane]; }
            const int rs_ = 32 * rb + (i & 3) + 8 * (i >> 2) + 4 * hh, row = MP + rs_;
            if constexpr (MODE == EP_QKV) {
                const int part = c0 >> 9, cc = col & 511;
                const float v = v0 * rstd_of(a.ss_in[row]);
                const float qs = (part == 0 || part == 3) ? QSCALE : 1.f;
                (a.o0 + (size_t)part * ((size_t)MT * HW))[(size_t)row * HW + cc] = (bf16_t)(pk2(v * qs, 0.f) & 0xffffu);
                float* fo = part == 1 ? a.s_sbk : part == 2 ? a.s_sbv : part == 4 ? a.s_cbk : part == 5 ? a.s_cbv : nullptr;
                if (fo) fo[(size_t)rs_ * HW + cc] = v;
            } else if constexpr (MODE == EP_RES || MODE == EP_PLE) {
                const size_t off = (size_t)row * DM + col;
                float x = __uint_as_float((unsigned)a.xbase[off] << 16);
                if constexpr (MODE == EP_RES) x += v0;
                else { const float pv = __uint_as_float((unsigned)a.P[off] << 16); x += pv * __builtin_amdgcn_rcpf(1.f + __builtin_amdgcn_exp2f(-LOG2E * v0 * rstd_of(a.ss_in[row]))); }
                a.XB[off] = (bf16_t)(pk2(x, 0.f) & 0xffffu);
                float s = x * x;
                s += __shfl_xor(s, 1); s += __shfl_xor(s, 2); s += __shfl_xor(s, 4); s += __shfl_xor(s, 8); s += __shfl_xor(s, 16);
                if (r == 0) unsafeAtomicAdd(a.ss_out + row, s);
            } else if constexpr (MODE == EP_GU) {
                const float rs = rstd_of(a.ss_in[row]); const float g = v0 * rs, up = v1 * rs;
                const float h = g * up * __builtin_amdgcn_rcpf(1.f + __builtin_amdgcn_exp2f(-LOG2E * g));
                a.o0[(size_t)row * DFF + col] = (bf16_t)(pk2(h, 0.f) & 0xffffu);
            } else {
                a.o0[(size_t)row * DM + col] = (bf16_t)(pk2(v0, 0.f) & 0xffffu);
            }
        }
        __syncthreads();
    }
}
struct AttnArgs { int L; };
constexpr int AW_V = 0, AW_ST = 4096, AW_BIAS = 8704, AW_BYTES = 10240, ST_PITCH = 144;

template <bool F32> __device__ __forceinline__ void ld_k(bf16x8 (&kf)[4], const void* base, size_t off) {
    if constexpr (!F32) { const bf16_t* p = (const bf16_t*)base + off;
#pragma unroll
        for (int kk = 0; kk < 4; ++kk) kf[kk] = *(const bf16x8*)(p + 8 * kk);
    } else { const float* p = (const float*)base + off;
#pragma unroll
        for (int kk = 0; kk < 4; ++kk) { const f32x4 x = *(const f32x4*)(p + 8 * kk), y = *(const f32x4*)(p + 8 * kk + 4);
            u32x4 w; w.x = pk2(x[0], x[1]); w.y = pk2(x[2], x[3]); w.z = pk2(y[0], y[1]); w.w = pk2(y[2], y[3]); kf[kk] = __builtin_bit_cast(bf16x8, w); }
    }
}
template <bool F32> __device__ __forceinline__ void ld_v(u32x4 (&vr)[4], const void* base, size_t row0, int nvalid, int h, int lane) {
#pragma unroll
    for (int i = 0; i < 4; ++i) { int key = 8 * i + (lane >> 3); key = key < nvalid ? key : nvalid - 1;
        const size_t off = (row0 + key) * HW + h * 64 + (lane & 7) * 8;
        if constexpr (!F32) vr[i] = *(const u32x4*)((const bf16_t*)base + off);
        else { const float* p = (const float*)base + off; const f32x4 x = *(const f32x4*)p, y = *(const f32x4*)(p + 4);
            u32x4 w; w.x = pk2(x[0], x[1]); w.y = pk2(x[2], x[3]); w.z = pk2(y[0], y[1]); w.w = pk2(y[2], y[3]); vr[i] = w; }
    }
}
__device__ __forceinline__ void st_v(LAS unsigned char* vl, const u32x4 (&vr)[4], int lane) {
#pragma unroll
    for (int i = 0; i < 4; ++i) { const int key = 8 * i + (lane >> 3); *(LAS u32x4*)(vl + key * 128 + (((lane & 7) * 16) ^ (((key >> 1) & 1) << 6))) = vr[i]; }
}
typedef short v4i16_t __attribute__((ext_vector_type(4)));
__device__ __forceinline__ s16x4 vtr(LAS unsigned char* p) { return __builtin_bit_cast(s16x4, __builtin_amdgcn_ds_read_tr16_b64_v4i16((LAS v4i16_t*)p)); }
__device__ __forceinline__ void pv_block(f32x16 (&o)[2], LAS unsigned char* vl, const bf16x8 (&pf)[2], int lane) {
    const int q = (lane & 15) >> 2, p = lane & 3, c16 = (lane >> 4) & 1, hh = lane >> 5;
    const int va0 = (4 * hh + q) * 128 + ((32 * c16 + 8 * p) ^ ((q >> 1) << 6));
#pragma unroll
    for (int db = 0; db < 2; ++db)
#pragma unroll
        for (int s = 0; s < 2; ++s) {
            const s16x4 lo = vtr(vl + (va0 ^ (db * 64)) + s * 2048), hi = vtr(vl + (va0 ^ (db * 64)) + s * 2048 + 1024);
            const bf16x8 vf = {lo[0], lo[1], lo[2], lo[3], hi[0], hi[1], hi[2], hi[3]};
            o[db] = __builtin_amdgcn_mfma_f32_32x32x16_bf16(vf, pf[s], o[db], 0, 0, 0);
        }
}
__device__ __forceinline__ f32x16 qk_block(const bf16x8 (&kf)[4], const bf16x8 (&qf)[4]) {
    f32x16 S = {};
#pragma unroll
    for (int kk = 0; kk < 4; ++kk) S = __builtin_amdgcn_mfma_f32_32x32x16_bf16(kf[kk], qf[kk], S, 0, 0, 0);
    return S;
}
__device__ __forceinline__ void sb_block(const f32x16& S, LAS unsigned char* vl, int tq, int keypos0, float& carry, f32x16 (&o)[2], int lane) {
    const int hh = lane >> 5;
    float L[16], e[16];
#pragma unroll
    for (int r = 0; r < 16; ++r) {
        const int kp = keypos0 + (r & 3) + 8 * (r >> 2) + 4 * hh; const bool valid = kp < tq;
        const float z = S[r];
        const float sp = fmaxf(z, 0.f) + __builtin_amdgcn_logf(1.f + __builtin_amdgcn_exp2f(-fabsf(z)));
        L[r] = valid ? -sp : 0.f; e[r] = valid ? z - sp : -INFINITY;
    }
    float T[4], Tp[4], U[4];
#pragma unroll
    for (int g = 0; g < 4; ++g) { T[g] = (L[4 * g] + L[4 * g + 1]) + (L[4 * g + 2] + L[4 * g + 3]); Tp[g] = partner32(T[g]); U[g] = T[g] + Tp[g]; }
    float R[4]; R[3] = 0.f; R[2] = U[3]; R[1] = U[3] + U[2]; R[0] = R[1] + U[1];
    const float tot = R[0] + U[0];
    float w[16];
#pragma unroll
    for (int g = 0; g < 4; ++g) {
        const float b3 = carry + R[g] + (hh == 0 ? Tp[g] : 0.f);
        const float b2 = b3 + L[4 * g + 3], b1 = b2 + L[4 * g + 2], b0 = b1 + L[4 * g + 1];
        w[4 * g + 3] = __builtin_amdgcn_exp2f(e[4 * g + 3] + b3);
        w[4 * g + 2] = __builtin_amdgcn_exp2f(e[4 * g + 2] + b2);
        w[4 * g + 1] = __builtin_amdgcn_exp2f(e[4 * g + 1] + b1);
        w[4 * g + 0] = __builtin_amdgcn_exp2f(e[4 * g + 0] + b0);
    }
    carry += tot;
    bf16x8 pf[2];
#pragma unroll
    for (int s = 0; s < 2; ++s) { u32x4 pw; pw.x = pk2(w[8 * s], w[8 * s + 1]); pw.y = pk2(w[8 * s + 2], w[8 * s + 3]); pw.z = pk2(w[8 * s + 4], w[8 * s + 5]); pw.w = pk2(w[8 * s + 6], w[8 * s + 7]); pf[s] = __builtin_bit_cast(bf16x8, pw); }
    pv_block(o, vl, pf, lane);
}
__device__ __forceinline__ void cb_block(const f32x16& S, bool cbias, LAS unsigned char* vl, const LAS float* bl, int tq, int keypos0, int nvalid, float& m, float& l, f32x16 (&o)[2], int lane) {
    const int hh = lane >> 5;
    float s[16]; float bm = -INFINITY;
    if (cbias) {
        const float cb = bl[256];
#pragma unroll
        for (int r = 0; r < 16; ++r) { s[r] = S[r] + cb; bm = fmaxf(bm, s[r]); }
    } else {
#pragma unroll
        for (int r = 0; r < 16; ++r) {
            const int kr = (r & 3) + 8 * (r >> 2) + 4 * hh; int d = tq - (keypos0 + kr); d = d < -128 ? -128 : (d > 128 ? 128 : d);
            s[r] = (kr < nvalid) ? S[r] + bl[d + 128] : -INFINITY; bm = fmaxf(bm, s[r]);
        }
    }
    bm = fmaxf(bm, partner32(bm));
    const float mn = fmaxf(m, bm), f = __builtin_amdgcn_exp2f(m - mn); m = mn;
    float w[16], ls = 0.f;
#pragma unroll
    for (int r = 0; r < 16; ++r) { w[r] = __builtin_amdgcn_exp2f(s[r] - mn); ls += w[r]; }
    l = l * f + ls;
#pragma unroll
    for (int db = 0; db < 2; ++db)
#pragma unroll
        for (int r = 0; r < 16; ++r) o[db][r] *= f;
    bf16x8 pf[2];
#pragma unroll
    for (int s2 = 0; s2 < 2; ++s2) { u32x4 pw; pw.x = pk2(w[8 * s2], w[8 * s2 + 1]); pw.y = pk2(w[8 * s2 + 2], w[8 * s2 + 3]); pw.z = pk2(w[8 * s2 + 4], w[8 * s2 + 5]); pw.w = pk2(w[8 * s2 + 6], w[8 * s2 + 7]); pf[s2] = __builtin_bit_cast(bf16x8, pw); }
    pv_block(o, vl, pf, lane);
}
__device__ __forceinline__ void attn_store(f32x16 (&o)[2], float scale, const float* gain, bf16_t* mix, size_t row0, int col0, int nrows, LAS unsigned char* wl, int lane) {
    const int r = lane & 31, hh = lane >> 5;
    float ssq = 0.f;
#pragma unroll
    for (int db = 0; db < 2; ++db)
#pragma unroll
        for (int i = 0; i < 16; ++i) { o[db][i] *= scale; ssq += o[db][i] * o[db][i]; }
    ssq += partner32(ssq);
    const float rstd = rsqrtf(ssq * (1.0f / 64.0f) + EPS);
    LAS unsigned char* st = wl + AW_ST;
#pragma unroll
    for (int db = 0; db < 2; ++db)
#pragma unroll
        for (int g = 0; g < 4; ++g) { const int d0 = 32 * db + 8 * g + 4 * hh; const f32x4 gv = *(const f32x4*)(gain + d0);
            u32x2 w; w.x = pk2(o[db][4 * g] * rstd * gv[0], o[db][4 * g + 1] * rstd * gv[1]); w.y = pk2(o[db][4 * g + 2] * rstd * gv[2], o[db][4 * g + 3] * rstd * gv[3]);
            *(LAS u32x2*)(st + r * ST_PITCH + d0 * 2) = w; }
#pragma unroll
    for (int i = 0; i < 4; ++i) { const int row = 8 * i + (lane >> 3), ch = lane & 7; const u32x4 v = *(const LAS u32x4*)(st + row * ST_PITCH + ch * 16);
        if (row < nrows) *(u32x4*)(mix + (row0 + row) * DM + col0 + ch * 8) = v; }
}

template <bool F32> __device__ __forceinline__ void sb_loop(const void* kbase, const void* vbase, size_t rowbase, int jhi, int h, const bf16x8 (&qf)[4], int tq, float& carry, f32x16 (&o)[2], LAS unsigned char* wl, int lane) {
    const int r = lane & 31, hh = lane >> 5;
    bf16x8 kf[4]; u32x4 vn[4];
    ld_k<F32>(kf, kbase, (rowbase + 32 * jhi + r) * HW + h * 64 + 32 * hh); ld_v<F32>(vn, vbase, rowbase + 32 * jhi, 32, h, lane);
    for (int j = jhi; j >= 0; --j) {
        const f32x16 S = qk_block(kf, qf);
        st_v(wl + AW_V, vn, lane);
        if (j > 0) { ld_k<F32>(kf, kbase, (rowbase + 32 * (j - 1) + r) * HW + h * 64 + 32 * hh); ld_v<F32>(vn, vbase, rowbase + 32 * (j - 1), 32, h, lane); }
        sb_block(S, wl + AW_V, tq, 32 * j, carry, o, lane);
#if SB_EARLY
        if (__all(carry < SB_THR)) break;
#endif
    }
}
template <bool SAMPLE> __device__ __forceinline__ void sb_unit(const AttnArgs& A, int b, int h, int qb, LAS unsigned char* wl, int lane) {
    const int r = lane & 31, hh = lane >> 5;
    const bf16_t* Qa = QKV_; const bf16_t* Ka = Qa + (size_t)1 * MT * HW; const bf16_t* Va = Qa + (size_t)2 * MT * HW;
    int tq; size_t qrow;
    if (SAMPLE) { tq = PAST + (r & 15); qrow = (size_t)MP + b * DSEQ + (r & 15); } else { tq = 32 * qb + r; qrow = (size_t)b * SEQ + tq; }
    bf16x8 qf[4]; ld_k<false>(qf, Qa, qrow * HW + h * 64 + 32 * hh);
    float carry = 0.f; f32x16 o[2]; o[0] = f32x16{}; o[1] = f32x16{};
    if (SAMPLE) {
        bf16x8 kf[4]; u32x4 vr[4]; const size_t row0 = (size_t)MP + b * DSEQ;
        ld_k<false>(kf, Ka, (row0 + (r & 15)) * HW + h * 64 + 32 * hh); ld_v<false>(vr, Va, row0, DSEQ, h, lane); st_v(wl + AW_V, vr, lane);
        { const f32x16 S = qk_block(kf, qf); sb_block(S, wl + AW_V, tq, PAST, carry, o, lane); }
        sb_loop<true>(ARG(4) + (size_t)A.L * NBATCH * PAST * HW, ARG(5) + (size_t)A.L * NBATCH * PAST * HW, (size_t)b * PAST, PAST / 32 - 1, h, qf, tq, carry, o, wl, lane);
        attn_store(o, 1.f, ARG(11) + A.L * HW + h * 64, MIX_, row0, h * 64, DSEQ, wl, lane);
    } else {
        sb_loop<false>(Ka, Va, (size_t)b * SEQ, qb, h, qf, tq, carry, o, wl, lane);
        attn_store(o, 1.f, ARG(11) + A.L * HW + h * 64, MIX_, (size_t)b * SEQ + 32 * qb, h * 64, 32, wl, lane);
    }
}
template <bool F32> __device__ __forceinline__ void cb_loop(const void* kbase, const void* vbase, size_t rowbase, int jlo, int jhi, int pos0, int h, const bf16x8 (&qf)[4], int tq, float& m, float& l, f32x16 (&o)[2], LAS unsigned char* wl, int lane) {
    const int r = lane & 31, hh = lane >> 5;
    bf16x8 kf[4]; u32x4 vn[4];
    const int tqmin = tq - r;
    ld_k<F32>(kf, kbase, (rowbase + 32 * jlo + r) * HW + h * 64 + 32 * hh); ld_v<F32>(vn, vbase, rowbase + 32 * jlo, 32, h, lane);
    for (int j = jlo; j <= jhi; ++j) {
        const f32x16 S = qk_block(kf, qf);
        st_v(wl + AW_V, vn, lane);
        if (j < jhi) { ld_k<F32>(kf, kbase, (rowbase + 32 * (j + 1) + r) * HW + h * 64 + 32 * hh); ld_v<F32>(vn, vbase, rowbase + 32 * (j + 1), 32, h, lane); }
        const bool cbias = __builtin_amdgcn_readfirstlane(pos0 + 32 * j + 31 + 128 <= tqmin);
        cb_block(S, cbias, wl + AW_V, (const LAS float*)(wl + AW_BIAS), tq, pos0 + 32 * j, 32, m, l, o, lane);
    }
}
template <bool SAMPLE> __device__ __forceinline__ void cb_unit(const AttnArgs& A, int b, int h, int qb, LAS unsigned char* wl, int lane) {
    const int r = lane & 31, hh = lane >> 5;
    const bf16_t* Qb = QKV_ + (size_t)3 * MT * HW; const bf16_t* Kb = Qb + (size_t)1 * MT * HW; const bf16_t* Vb = Qb + (size_t)2 * MT * HW;
    LAS float* bl = (LAS float*)(wl + AW_BIAS);
#pragma unroll
    for (int i = 0; i < 5; ++i) { const int idx = lane + 64 * i; if (idx < 257) bl[idx] = (ARG(10) + (size_t)A.L * 257 * 8)[idx * 8 + h] * LOG2E; }
    int tq; size_t qrow;
    if (SAMPLE) { tq = PAST + (r & 15); qrow = (size_t)MP + b * DSEQ + (r & 15); } else { tq = 32 * qb + r; qrow = (size_t)b * SEQ + tq; }
    bf16x8 qf[4]; ld_k<false>(qf, Qb, qrow * HW + h * 64 + 32 * hh);
    float m = -INFINITY, l = 0.f; f32x16 o[2]; o[0] = f32x16{}; o[1] = f32x16{};
    if (SAMPLE) {
        cb_loop<true>(ARG(6) + (size_t)A.L * NBATCH * BANDL * HW, ARG(7) + (size_t)A.L * NBATCH * BANDL * HW, (size_t)b * BANDL, 0, BANDL / 32 - 1, PAST - BANDL, h, qf, tq, m, l, o, wl, lane);
        bf16x8 kf[4]; u32x4 vr[4]; const size_t row0 = (size_t)MP + b * DSEQ;
        ld_k<false>(kf, Kb, (row0 + (r & 15)) * HW + h * 64 + 32 * hh); ld_v<false>(vr, Vb, row0, DSEQ, h, lane); st_v(wl + AW_V, vr, lane);
        { const f32x16 S = qk_block(kf, qf); cb_block(S, false, wl + AW_V, bl, tq, PAST, DSEQ, m, l, o, lane); }
        l += partner32(l);
        attn_store(o, 1.0f / l, ARG(12) + A.L * HW + h * 64, MIX_, row0, HW + h * 64, DSEQ, wl, lane);
    } else {
        const int c = qb >> 1, clo = c - 8 < 0 ? 0 : c - 8;
        cb_loop<false>(Kb, Vb, (size_t)b * SEQ, 2 * clo, 2 * c + 1, 0, h, qf, tq, m, l, o, wl, lane);
        l += partner32(l);
        attn_store(o, 1.0f / l, ARG(12) + A.L * HW + h * 64, MIX_, (size_t)b * SEQ + 32 * qb, HW + h * 64, 32, wl, lane);
    }
}
constexpr unsigned AU_SSB = 64, AU_SCB = 128, AU_PSB = 128 + 4096, AU_ALL = 128 + 8192;
__device__ __forceinline__ void attn_phase(const AttnArgs& A, LAS unsigned char* lds) {
    const int tid_ = fresh_tid(), lane = tid_ & 63, wave = __builtin_amdgcn_readfirstlane(tid_ >> 6);
    LAS unsigned char* wl = lds + wave * AW_BYTES;
    unsigned u = 0; if (lane == 0) u = atomicAdd(WS_PTR(unsigned, WS_CTL) + A.L, 1u);
    u = __builtin_amdgcn_readfirstlane(u);
    for (;;) {
        if (u >= AU_ALL) break;
        unsigned un = 0; if (lane == 0) un = atomicAdd(WS_PTR(unsigned, WS_CTL) + A.L, 1u);
        if (u < AU_SSB) sb_unit<true>(A, u >> 3, u & 7, 0, wl, lane);
        else if (u < AU_SCB) { const unsigned v = u - AU_SSB; cb_unit<true>(A, v >> 3, v & 7, 0, wl, lane); }
        else if (u < AU_PSB) { const unsigned v = u - AU_SCB; const int bh = v >> 6; sb_unit<false>(A, bh >> 3, bh & 7, 63 - (int)(v & 63), wl, lane); }
        else { const unsigned v = u - AU_PSB; const int bh = v >> 6; cb_unit<false>(A, bh >> 3, bh & 7, (int)(v & 63), wl, lane); }
        u = __builtin_amdgcn_readfirstlane(un);
    }
}

typedef unsigned gu32_plain;
#define XB_TMO      128
#define XB_XCNT(j)  (256  + 64 * (j))
#define XB_XSUB(j)  (1280 + 64 * (j))
#define XB_XGEN(j)  (2304 + 64 * (j))
#define XB_TOP      3328
#define XB_TOPGEN   3392
#define XCD_BAR_WORDS 3456
#define XB_SPIN_CAP (1u << 18)

__device__ __forceinline__ unsigned xb_ld(unsigned* p)              { return __hip_atomic_load(p, __ATOMIC_RELAXED, __HIP_MEMORY_SCOPE_AGENT); }
__device__ __forceinline__ unsigned xb_add(unsigned* p, unsigned v) { return __hip_atomic_fetch_add(p, v, __ATOMIC_RELAXED, __HIP_MEMORY_SCOPE_AGENT); }
__device__ __forceinline__ unsigned xb_xcc_id() { return (unsigned)__builtin_amdgcn_s_getreg((3 << 11) | 20) & 0xFu; }
#define XB_SPIN(cond, bar) do { unsigned _sp = 0; while (cond) { __builtin_amdgcn_s_sleep(1); \
    if ((++_sp & 255u) == 0u) { if (xb_ld(&(bar)[XB_TMO])) break; if (_sp > XB_SPIN_CAP) { atomicAdd(&(bar)[XB_TMO], 1u); break; } } } } while (0)

struct XcdBarrier {
    unsigned* bar; unsigned x;
    volatile LAS unsigned* st;
};

__device__ __forceinline__ XcdBarrier xcd_barrier_post(unsigned* bar, volatile LAS unsigned* st) {
    XcdBarrier b; b.bar = bar; b.x = xb_xcc_id(); b.st = st;
    if (threadIdx.x == 0) (void)xb_add(&bar[XB_XCNT(b.x)], 1u);
    return b;
}
__device__ __forceinline__ void xcd_barrier_complete(unsigned* bar, unsigned x, unsigned& nloc, unsigned& nx) {
    const unsigned G = gridDim.x * gridDim.y * gridDim.z;
    unsigned sum, cnt, mine, sp = 0u;
    for (;;) {
        sum = 0u; cnt = 0u; mine = 0u;
#pragma unroll
        for (unsigned j = 0; j < 16; ++j) { const unsigned c = xb_ld(&bar[XB_XCNT(j)]); sum += c; cnt += (c > 0u) ? 1u : 0u; mine = (j == x) ? c : mine; }
        if (sum == G) break;
        __builtin_amdgcn_s_sleep(1);
        if ((++sp & 255u) == 0u) { if (xb_ld(&bar[XB_TMO])) break; if (sp > XB_SPIN_CAP) { atomicAdd(&bar[XB_TMO], 1u); break; } }
    }
    nloc = mine > 0u ? mine : 1u; nx = cnt > 0u ? cnt : 1u;
}

__device__ __forceinline__ void xcd_barrier(const XcdBarrier& b) {
    asm volatile("s_waitcnt vmcnt(0)" ::: "memory");
    __syncthreads();
    if (threadIdx.x == 0) {
        unsigned* bar = b.bar;
        __builtin_amdgcn_s_waitcnt(0);
        unsigned nloc = b.st[0], nx = b.st[1];
        if (nloc == 0u) { xcd_barrier_complete(bar, b.x, nloc, nx); b.st[0] = nloc; b.st[1] = nx; }
        const unsigned old = xb_add(&bar[XB_XSUB(b.x)], 1u);
        const unsigned gen = old / nloc;
        if (old + 1u == (gen + 1u) * nloc) {
            __builtin_amdgcn_fence(__ATOMIC_RELEASE, "agent");
            asm volatile("s_waitcnt vmcnt(0)" ::: "memory");
            const unsigned og = xb_add(&bar[XB_TOP], 1u);
            const unsigned tg = og / nx;
            if (og + 1u == (tg + 1u) * nx) xb_add(&bar[XB_TOPGEN], 1u);
            else XB_SPIN(xb_ld(&bar[XB_TOPGEN]) == tg, bar);
            __builtin_amdgcn_fence(__ATOMIC_ACQUIRE, "agent");
            xb_add(&bar[XB_XGEN(b.x)], 1u);
            asm volatile("s_waitcnt vmcnt(0)" ::: "memory");
        } else {
            XB_SPIN(xb_ld(&bar[XB_XGEN(b.x)]) == gen, bar);
            __builtin_amdgcn_fence(__ATOMIC_ACQUIRE, "agent");
            asm volatile("s_waitcnt vmcnt(0)" ::: "memory");
        }
    }
    __syncthreads();
}

__device__ __forceinline__ void p0_item(const float* W, int K, int N, const float* gain, bf16_t* WT, int kind, LAS float* scr, int item, int lane) {
    const int nblk = N / 32, kb = item / nblk, nb = item % nblk, k0 = 64 * kb, n0 = 32 * nb;
#pragma unroll
    for (int i = 0; i < 32; ++i) { const int kk = 2 * i + (lane >> 5); const float g = gain ? gain[k0 + kk] : 1.f; scr[kk * 33 + (lane & 31)] = W[(size_t)(k0 + kk) * N + n0 + (lane & 31)] * g; }
    asm volatile("s_waitcnt lgkmcnt(0)" ::: "memory");
    const int c = lane & 7;
#pragma unroll
    for (int j = 0; j < 4; ++j) { const int n = (lane >> 3) + 8 * j; const LAS float* s = scr + (8 * c) * 33 + n;
        u32x4 o; o.x = pk2(s[0 * 33], s[1 * 33]); o.y = pk2(s[2 * 33], s[3 * 33]); o.z = pk2(s[4 * 33], s[5 * 33]); o.w = pk2(s[6 * 33], s[7 * 33]);
        const int gn = n0 + n; const int drow = kind == 0 ? gn : ((gn >> 7) * 256 + (gn & 127) + (kind == 2 ? 128 : 0));
        *(u32x4*)(WT + (size_t)drow * K + k0 + 8 * c) = o; }
    asm volatile("s_waitcnt lgkmcnt(0)" ::: "memory");
}

#ifdef NO_SGEMM
#define SG(...)
#else
#define SG(...) __VA_ARGS__
#endif
#ifndef GP1
#define GP1(...) __VA_ARGS__
#endif
#ifndef GP2
#define GP2(...) __VA_ARGS__
#endif
#ifndef GP3
#define GP3(...) __VA_ARGS__
#endif
#ifndef GP4
#define GP4(...) __VA_ARGS__
#endif
#ifndef GP5
#define GP5(...) __VA_ARGS__
#endif
#ifndef GP6
#define GP6(...) __VA_ARGS__
#endif
#ifdef NO_SGEMM
#define SG(...)
#else
#define SG(...) __VA_ARGS__
#endif
#ifndef GP1
#define GP1(...) __VA_ARGS__
#endif
#ifndef GP2
#define GP2(...) __VA_ARGS__
#endif
#ifndef GP3
#define GP3(...) __VA_ARGS__
#endif
#ifndef GP4
#define GP4(...) __VA_ARGS__
#endif
#ifndef GP5
#define GP5(...) __VA_ARGS__
#endif
#ifndef GP6
#define GP6(...) __VA_ARGS__
#endif
struct Args { const float* in[22]; float* out; unsigned char* ws; };

#ifndef PROBE_SEL
#define PROBE_SEL -1
#endif
#if PROBE_SEL >= 0
#define TSTAMP(cat) do { if (blockIdx.x == 0 && fresh_tid() == 0) { const unsigned long long t_ = __builtin_amdgcn_s_memrealtime(); unsigned long long* tsb = WS_PTR(unsigned long long, WS_CTL + 4096); \
    tsb[16 + (cat)] += t_ - tsb[0]; tsb[0] = t_; } } while (0)
#else
#define TSTAMP(cat) do {} while (0)
#endif
__global__ void __launch_bounds__(NTHREADS, 2) hymba_fwd(Args args) {
    extern __shared__ __attribute__((aligned(16))) unsigned char lds_raw[];
    cg::grid_group grid = cg::this_grid();
    LAS unsigned char* lds = (LAS unsigned char*)lds_raw;
    const int G = gridDim.x;

#if PROBE_SEL >= 0
    if (blockIdx.x == 0 && fresh_tid() == 0) { unsigned long long* tsb = WS_PTR(unsigned long long, WS_CTL + 4096); for (int i = 0; i < 48; ++i) tsb[i] = 0; tsb[0] = __builtin_amdgcn_s_memrealtime(); }
#endif
    {
        const int tid = fresh_tid(), lane = tid & 63, wave = __builtin_amdgcn_readfirstlane(tid >> 6);
        const int gw = blockIdx.x * NWAVES + wave, NGW = G * NWAVES;
        { float* ssb = SSB; for (int i = blockIdx.x * NTHREADS + tid; i < 6 * MT; i += G * NTHREADS) ssb[MT + i] = 0.f;
          if (blockIdx.x == 0 && tid < 16) WS_PTR(unsigned, WS_CTL)[tid] = 0u;
          if (blockIdx.x == 0) for (int i = tid; i < XCD_BAR_WORDS; i += NTHREADS) WS_PTR(unsigned, WS_BAR)[i] = 0u;
          if (tid < 2) ((LAS unsigned*)(lds + 131072))[tid] = 0u; }
        LAS float* scr = (LAS float*)(lds + wave * 8704);
        constexpr int I_IN = 16 * 96, I_OUT = 16 * 32, I_G = 16 * 88, I_D = 44 * 32, I_PG = 16 * 32, I_PP = 4 * 32, I_L = I_IN + I_OUT + 2 * I_G + I_D + I_PG + I_PP;
        for (int it = gw; it < NLAYER * I_L; it += NGW) {
            const int L = it / I_L; int r = it % I_L;
            if (r < I_IN) { p0_item(ARG(9) + (size_t)L * DM * NQKV, DM, NQKV, ARG(8) + L * DM, (bf16_t*)WPTR(L, W_IN), 0, scr, r, lane); continue; } r -= I_IN;
            if (r < I_OUT) { p0_item(ARG(13) + (size_t)L * DM * DM, DM, DM, nullptr, (bf16_t*)WPTR(L, W_OUT), 0, scr, r, lane); continue; } r -= I_OUT;
            if (r < I_G) { p0_item(ARG(15) + (size_t)L * DM * DFF, DM, DFF, ARG(14) + L * DM, (bf16_t*)WPTR(L, W_GU), 1, scr, r, lane); continue; } r -= I_G;
            if (r < I_G) { p0_item(ARG(16) + (size_t)L * DM * DFF, DM, DFF, ARG(14) + L * DM, (bf16_t*)WPTR(L, W_GU), 2, scr, r, lane); continue; } r -= I_G;
            if (r < I_D) { p0_item(ARG(17) + (size_t)L * DFF * DM, DFF, DM, nullptr, (bf16_t*)WPTR(L, W_DOWN), 0, scr, r, lane); continue; } r -= I_D;
            if (r < I_PG) { p0_item(ARG(19) + (size_t)L * DM * DM, DM, DM, ARG(18) + L * DM, (bf16_t*)WPTR(L, W_PG), 0, scr, r, lane); continue; } r -= I_PG;
            p0_item(ARG(20) + (size_t)L * PLED * DM, PLED, DM, nullptr, (bf16_t*)WPTR(L, W_PP), 0, scr, r, lane);
        }
        { const float* pp = ARG(2); const float* ps = ARG(3); bf16_t* PB = PB_;
          for (int it0 = 4 * gw; it0 < NLAYER * MT; it0 += 4 * NGW) {
            f32x4 v[4];
#pragma unroll
            for (int rr = 0; rr < 4; ++rr) { const int it = it0 + rr, L = it / MT, row = it % MT;
                const float* src = row < MP ? pp + ((size_t)L * MP + row) * PLED : ps + ((size_t)L * MS + (row - MP)) * PLED;
                v[rr] = *((const f32x4*)src + lane); }
#pragma unroll
            for (int rr = 0; rr < 4; ++rr) { u32x2 w; w.x = pk2(v[rr][0], v[rr][1]); w.y = pk2(v[rr][2], v[rr][3]); *((u32x2*)(PB + (size_t)(it0 + rr) * PLED) + lane) = w; }
          } }
        { const float* x_p = ARG(0); const float* x_s = ARG(1); bf16_t* XB = XN_; float* ssb = SSB;
          for (int row0 = 2 * gw; row0 < MT; row0 += 2 * NGW) {
            f32x4 v[2][4];
#pragma unroll
            for (int rr = 0; rr < 2; ++rr) { const int row = row0 + rr; const float* src = row < MP ? x_p + (size_t)row * DM : x_s + (size_t)(row - MP) * DM;
#pragma unroll
                for (int j = 0; j < 4; ++j) v[rr][j] = *((const f32x4*)src + lane + 64 * j); }
#pragma unroll
            for (int rr = 0; rr < 2; ++rr) { float s2 = 0.f;
#pragma unroll
                for (int j = 0; j < 4; ++j) { const f32x4 t = v[rr][j]; s2 += (t[0] * t[0] + t[1] * t[1]) + (t[2] * t[2] + t[3] * t[3]);
                    u32x2 w; w.x = pk2(t[0], t[1]); w.y = pk2(t[2], t[3]); *((u32x2*)(XB + (size_t)(row0 + rr) * DM) + lane + 64 * j) = w; }
                s2 = wave_sum(s2);
                if (lane == 0) ssb[row0 + rr] = s2; }
          } }
    }
    TSTAMP(0); grid.sync(); TSTAMP(8);
    const XcdBarrier xbar = xcd_barrier_post(WS_PTR(unsigned, WS_BAR), (volatile LAS unsigned*)(lds + 131072));
#define GSYNC() xcd_barrier(xbar)

    for (int L = 0; L < NLAYER; ++L) {
#define SS_MIX (SSB + (size_t)(3 * L) * MT)
#define SS_FFN (SSB + (size_t)(3 * L + 1) * MT)
#define SS_PLE (SSB + (size_t)(3 * L + 2) * MT)
#define SS_NEXT (SSB + (size_t)(3 * L + 3) * MT)
        { EpiArgs q{}; q.ss_in = SS_MIX; q.o0 = QKV_;
          q.f_sbk = ARG_OUT + O_SBK_P + (size_t)L * MP * HW; q.f_sbv = ARG_OUT + O_SBV_P + (size_t)L * MP * HW;
          q.f_cbk = ARG_OUT + O_CBK_P + (size_t)L * NBATCH * BANDL * HW; q.f_cbv = ARG_OUT + O_CBV_P + (size_t)L * NBATCH * BANDL * HW;
          pg8::Gemm g{XN_, WPTR(L, W_IN), MP, NQKV, DM}; pg8::StaticOrder S; S.init(MP, NQKV, G, (int)blockIdx.x);
          Epi<EP_QKV> E{q};
          GP1(pg8::gemm_phase<Epi<EP_QKV>, pg8::StaticOrder, true, true>(lds, g, S, E);) TSTAMP(1); }
        { EpiArgs q{}; q.ss_in = SS_MIX; q.o0 = QKV_;
          q.s_sbk = ARG_OUT + O_SBK_S + (size_t)L * MS * HW; q.s_sbv = ARG_OUT + O_SBV_S + (size_t)L * MS * HW;
          q.s_cbk = ARG_OUT + O_CBK_S + (size_t)L * MS * HW; q.s_cbv = ARG_OUT + O_CBV_S + (size_t)L * MS * HW;
          SG(sgemm<EP_QKV, DM>(lds, XN_ + (size_t)MP * DM, WPTR(L, W_IN), NQKV / 32, q);) TSTAMP(7); }
        GSYNC(); TSTAMP(8);
        { AttnArgs A{}; A.L = L;
#ifndef NO_ATTN
          attn_phase(A, lds);
#endif
          TSTAMP(2); }
        GSYNC(); TSTAMP(2);
        { EpiArgs q{}; q.XB = XB_; q.xbase = XN_; q.ss_out = SS_FFN;
          pg8::Gemm g{MIX_, WPTR(L, W_OUT), MP, DM, DM}; pg8::StaticOrder S; S.init(MP, DM, G, (int)blockIdx.x);
          Epi<EP_RES> E{q};
          GP2(pg8::gemm_phase<Epi<EP_RES>, pg8::StaticOrder, true, true>(lds, g, S, E);) TSTAMP(3); }
        { EpiArgs q{}; q.XB = XB_; q.xbase = XN_; q.ss_out = SS_FFN;
          SG(sgemm<EP_RES, DM>(lds, MIX_ + (size_t)MP * DM, WPTR(L, W_OUT), DM / 32, q);) TSTAMP(7); }
        GSYNC(); TSTAMP(8);
        { EpiArgs q{}; q.ss_in = SS_FFN; q.o0 = HB_;
          pg8::Gemm g{XB_, WPTR(L, W_GU), MP, 2 * DFF, DM}; pg8::StaticOrder S; S.init(MP, 2 * DFF, G, (int)blockIdx.x);
          Epi<EP_GU> E{q};
          GP4(pg8::gemm_phase<Epi<EP_GU>, pg8::StaticOrder, true, true>(lds, g, S, E);) TSTAMP(4);
          SG(sgemm<EP_GU, DM>(lds, XB_ + (size_t)MP * DM, WPTR(L, W_GU), DFF / 32, q);) TSTAMP(7); }
        { EpiArgs q2{}; q2.o0 = PBUF_;
          int kp = PLED; asm volatile("" : "+s"(kp));
          const int Gh = G >> 1;
          if ((int)blockIdx.x >= Gh) {
            pg8::Gemm g2{PB_ + (size_t)L * MT * PLED, WPTR(L, W_PP), MP, DM, kp}; pg8::StaticOrder S; S.init(MP, DM, G - Gh, (int)blockIdx.x - Gh);
            Epi<EP_P> E2{q2};
            GP3(pg8::gemm_phase<Epi<EP_P>, pg8::StaticOrder, true, true>(lds, g2, S, E2);) TSTAMP(10);
          }
          SG(sgemm<EP_P, PLED>(lds, PB_ + ((size_t)L * MT + MP) * PLED, WPTR(L, W_PP), DM / 32, q2);) TSTAMP(7); }
        GSYNC(); TSTAMP(8);
        { EpiArgs q{}; q.XB = XB_; q.xbase = XB_; q.ss_out = SS_PLE;
          pg8::Gemm g{HB_, WPTR(L, W_DOWN), MP, DM, DFF}; pg8::StaticOrder S; S.init(MP, DM, G, (int)blockIdx.x);
          Epi<EP_RES> E{q};
          GP5(pg8::gemm_phase<Epi<EP_RES>, pg8::StaticOrder, true, true>(lds, g, S, E);) TSTAMP(5);
          SG(sgemm<EP_RES, DFF>(lds, HB_ + (size_t)MP * DFF, WPTR(L, W_DOWN), DM / 32, q);) TSTAMP(7); }
        GSYNC(); TSTAMP(8);
        { EpiArgs q{}; q.XB = XN_  ; q.P = PBUF_; q.xbase = XB_; q.ss_in = SS_PLE; q.ss_out = SS_NEXT;
          pg8::Gemm g{XB_, WPTR(L, W_PG), MP, DM, DM}; pg8::StaticOrder S; S.init(MP, DM, G, (int)blockIdx.x);
          Epi<EP_PLE> E{q};
          GP6(pg8::gemm_phase<Epi<EP_PLE>, pg8::StaticOrder, true, true>(lds, g, S, E);) TSTAMP(6);
          SG(sgemm<EP_PLE, DM>(lds, XB_ + (size_t)MP * DM, WPTR(L, W_PG), DM / 32, q);) TSTAMP(7); }
        GSYNC(); TSTAMP(8);
    }
    {
        const int tid = fresh_tid(), lane = tid & 63, wave = __builtin_amdgcn_readfirstlane(tid >> 6);
        const int gw = blockIdx.x * NWAVES + wave, NGW = G * NWAVES;
        const float* ssf = SSB + (size_t)(3 * NLAYER) * MT; const float* gf = ARG(21); const bf16_t* XN = XN_; float* out = ARG_OUT;
        for (int row0 = 2 * gw; row0 < MT; row0 += 2 * NGW) {
            u32x2 xv[2][4];
#pragma unroll
            for (int rr = 0; rr < 2; ++rr)
#pragma unroll
                for (int j = 0; j < 4; ++j) xv[rr][j] = *((const u32x2*)(XN + (size_t)(row0 + rr) * DM) + lane + 64 * j);
#pragma unroll
            for (int rr = 0; rr < 2; ++rr) { const int row = row0 + rr; const float rs = rstd_of(ssf[row]);
                float* dst = row < MP ? out + O_YP + (size_t)row * DM : out + O_YS + (size_t)(row - MP) * DM;
#pragma unroll
                for (int j = 0; j < 4; ++j) { const f32x4 gv = *((const f32x4*)gf + lane + 64 * j); const u32x2 w = xv[rr][j];
                    const f32x4 v = {bf_lo(w.x), bf_hi(w.x), bf_lo(w.y), bf_hi(w.y)};
                    *((f32x4*)dst + lane + 64 * j) = v * rs * gv; } }
        }
    }
#if PROBE_SEL >= 0
    TSTAMP(11); grid.sync();
    if (blockIdx.x == 0 && fresh_tid() == 0) { const unsigned long long* tsb = WS_PTR(unsigned long long, WS_CTL + 4096); float* o = ARG_OUT + O_YS; unsigned long long tv = 0; if (PROBE_SEL == 20) tv = tsb[16+1] + tsb[16+3] + tsb[16+10] + tsb[16+4] + tsb[16+5] + tsb[16+6]; else if (PROBE_SEL == 21) tv = tsb[16+0] + tsb[16+11]; else if (PROBE_SEL < 16) tv = tsb[16 + PROBE_SEL]; o[0] += (float)tv * 2.5e-5f; }
#endif
}

extern "C" void kernel_launch(void* const* d_in, const int* in_sizes, int n_in, void* d_out, int out_size, void* d_ws, size_t ws_size, hipStream_t stream) {
    static int grid = 0;
    if (grid == 0) {
        int dev = 0, cus = 0, per_cu = 0;
        hipGetDevice(&dev);
        hipDeviceGetAttribute(&cus, hipDeviceAttributeMultiprocessorCount, dev);
        hipFuncSetAttribute((const void*)hymba_fwd, hipFuncAttributeMaxDynamicSharedMemorySize, LDS_BYTES);
        hipOccupancyMaxActiveBlocksPerMultiprocessor(&per_cu, (const void*)hymba_fwd, NTHREADS, LDS_BYTES);
        if (per_cu < 1) per_cu = 1;
        grid = cus * per_cu;
        if (n_in != 22 || ws_size < WS_END) { fprintf(stderr, "kernel_launch: unexpected n_in %d / ws_size %zu\n", n_in, ws_size); }
    }
    Args a{};
    for (int i = 0; i < 22; ++i) a.in[i] = (const float*)d_in[i];
    a.out = (float*)d_out; a.ws = (unsigned char*)d_ws;
    void* kargs[] = {&a};
    hipError_t e = hipLaunchCooperativeKernel((const void*)hymba_fwd, dim3(grid), dim3(NTHREADS), kargs, LDS_BYTES, stream);
    if (e != hipSuccess) fprintf(stderr, "cooperative launch failed: %s (grid %d)\n", hipGetErrorString(e), grid);
}
```

```cpp
#include <hip/hip_runtime.h>
#include <hip/hip_cooperative_groups.h>
#include <cstdio>
#include <cstdint>
namespace cg = cooperative_groups;
__device__ __forceinline__ int fresh_tid() { int t = threadIdx.x; asm volatile("" : "+v"(t)); return t; }
namespace pg8 {
#define PG8_LAS __attribute__((address_space(3)))
typedef unsigned short bf16_t;
typedef short bf16x8 __attribute__((ext_vector_type(8)));
typedef float f32x4 __attribute__((ext_vector_type(4)));
typedef unsigned u32x4 __attribute__((ext_vector_type(4)));
constexpr int BM = 256, BK = 64, HALF = 128, HTB = HALF * BK * 2  , STAGE_BYTES = 8 * HTB, NXCD = 8, WGM = 8;

__host__ __device__ __forceinline__ int lds_byte(int r, int c) { const int st = (r >> 4) * 2 + (c >> 5), rr = r & 15, cc = c & 31, ob = rr * 64 + cc * 2; return st * 1024 + (ob ^ (((ob >> 9) & 1) << 5)); }
__host__ __device__ __forceinline__ void stage_rc(int b, int& R, int& C) { const int st = b / 1024, sb = b % 1024, swz = sb ^ (((sb >> 9) & 1) << 5); R = (st >> 1) * 16 + swz / 64; C = (st & 1) * 32 + (swz % 64) / 2; }
__host__ __device__ __forceinline__ int perm32(int rho) { const int n = rho >> 4, i = rho & 15; return 8 * (i >> 2) + 4 * n + (i & 3); }

struct Unit { int pm, pn; };
struct Gemm { const bf16_t* A; const bf16_t* Bt; int M, N, K; };

struct StaticOrder {
    int nM, nN, nwg, G, c;
    __host__ __device__ void init(int M, int N, int G_, int c_) { nM = M / BM; nN = N / BM; nwg = nM * nN; G = G_; c = c_; }
    __host__ __device__ bool next(int i, Unit& u) const {
        const long L = (long)i * G + c; if (L >= nwg) return false;
        int wgid = (int)L; { const int q = nwg / NXCD, r = nwg % NXCD, xcd = wgid % NXCD, off = wgid / NXCD; wgid = (xcd < r ? xcd * (q + 1) : r * (q + 1) + (xcd - r) * q) + off; }
        const int nig = WGM * nN, gid = wgid / nig, fm = gid * WGM, gsz = (nM - fm) < WGM ? (nM - fm) : WGM;
        u.pm = fm + ((wgid % nig) % gsz); u.pn = (wgid % nig) / gsz; return true;
    }
    __device__ __forceinline__ void a_ready(const Unit&) const {}
    __device__ __forceinline__ void done(const Unit&) const {}
};

template <class Epi, class Sched, bool ALIGN_EPI = false, bool SP2 = false>
__device__ __forceinline__ void gemm_phase(PG8_LAS unsigned char* lds, const Gemm g, const Sched& S, const Epi& E) {
    const int tid = fresh_tid(), wid = __builtin_amdgcn_readfirstlane(tid >> 6), lane = tid & 63, wr = wid >> 2, wc = wid & 3, fr = lane & 15, fq = lane >> 4;
    const int K = g.K, nt = K / BK;
    unsigned voffA[2], voffB[2];
#pragma unroll
    for (int i = 0; i < 2; ++i) { int R, C; stage_rc(tid * 16 + i * 8192, R, C); const int Rb = Epi::PERM ? ((R & ~31) + perm32(R & 31)) : R;
        voffA[i] = (unsigned)(R * K + C) * 2u; voffB[i] = (unsigned)(Rb * K + C) * 2u; }
    const size_t kstep = (size_t)(BK * 2);
    const size_t hstep = (size_t)HALF * K * 2;
    const size_t tstep = 2 * hstep;
    const unsigned ldsw = (unsigned)wid * 1024u;
    const int aoff = lds_byte(wr * 64 + fr, fq * 8), boff = lds_byte(wc * 32 + fr, fq * 8);
#define PG8_SA(b, h) (((b) * 2 + (h)) * HTB)
#define PG8_SB(b, h) ((4 + (b) * 2 + (h)) * HTB)
#define PG8_STAGE(bufoff, gbase, voff) do { _Pragma("unroll") for (int _i = 0; _i < 2; ++_i) \
        __builtin_amdgcn_global_load_lds((const unsigned*)((const char*)(gbase) + (voff)[_i]), (PG8_LAS unsigned*)(lds + (bufoff) + ldsw + _i * 8192), 16, 0, 0); } while (0)
#define PG8_LDA(dst, b, h) do { _Pragma("unroll") for (int m = 0; m < 4; ++m) _Pragma("unroll") for (int k = 0; k < 2; ++k) dst[m][k] = *(const PG8_LAS bf16x8*)(lds + PG8_SA(b, h) + aoff + m * 2048 + k * 1024); } while (0)
#define PG8_LDB(dst, b, h) do { _Pragma("unroll") for (int n = 0; n < 2; ++n) _Pragma("unroll") for (int k = 0; k < 2; ++k) dst[n][k] = *(const PG8_LAS bf16x8*)(lds + PG8_SB(b, h) + boff + n * 2048 + k * 1024); } while (0)
#define PG8_MMA(ai, bj, At, Bt) do { __builtin_amdgcn_s_setprio(1); _Pragma("unroll") for (int m = 0; m < 4; ++m) _Pragma("unroll") for (int n = 0; n < 2; ++n) _Pragma("unroll") for (int k = 0; k < 2; ++k) \
        acc[ai][bj][m][n] = __builtin_amdgcn_mfma_f32_16x16x32_bf16(Bt[n][k], At[m][k], acc[ai][bj][m][n], 0, 0, 0); __builtin_amdgcn_s_setprio(0); } while (0)
#define PG8_WAIT_V(n) asm volatile("s_waitcnt vmcnt(" #n ")" ::: "memory")
#define PG8_WAIT_L(n) asm volatile("s_waitcnt lgkmcnt(" #n ")" ::: "memory")
#define PG8_BAR __builtin_amdgcn_s_barrier()
#define PG8_SCHED __builtin_amdgcn_sched_barrier(0)
    Unit cur, nxt; int ui = 0;
    if (!S.next(0, cur)) return;
    f32x4 acc[2][2][4][2];
#pragma unroll
    for (int a = 0; a < 2; ++a)
#pragma unroll
        for (int b = 0; b < 2; ++b)
#pragma unroll
            for (int m = 0; m < 4; ++m)
#pragma unroll
                for (int n = 0; n < 2; ++n) acc[a][b][m][n] = (f32x4){0.f, 0.f, 0.f, 0.f};
    bf16x8 At[4][2], B0[2][2], B1[2][2];
    const char* cA = (const char*)g.A + (size_t)cur.pm * tstep; const char* cB = (const char*)g.Bt + (size_t)cur.pn * tstep;
    S.a_ready(cur);
    if constexpr (SP2) {
        PG8_STAGE(PG8_SB(0, 0), cB, voffB); PG8_STAGE(PG8_SB(0, 1), cB + hstep, voffB); PG8_STAGE(PG8_SA(0, 0), cA, voffA); PG8_STAGE(PG8_SA(0, 1), cA + hstep, voffA);
        if (wr == 1) PG8_BAR;
        PG8_WAIT_V(2); PG8_BAR;
        PG8_STAGE(PG8_SB(1, 0), cB + kstep, voffB); PG8_STAGE(PG8_SA(1, 0), cA + kstep, voffA); PG8_STAGE(PG8_SB(1, 1), cB + hstep + kstep, voffB);
        PG8_WAIT_V(6); PG8_BAR;
    } else {
        PG8_STAGE(PG8_SB(0, 0), cB, voffB); PG8_STAGE(PG8_SA(0, 0), cA, voffA); PG8_STAGE(PG8_SB(0, 1), cB + hstep, voffB); PG8_STAGE(PG8_SA(0, 1), cA + hstep, voffA);
        if (wr == 1) PG8_BAR;
        PG8_WAIT_V(4); PG8_BAR;
        PG8_STAGE(PG8_SB(1, 0), cB + kstep, voffB); PG8_STAGE(PG8_SA(1, 0), cA + kstep, voffA); PG8_STAGE(PG8_SB(1, 1), cB + hstep + kstep, voffB);
        PG8_WAIT_V(6); PG8_BAR;
    }
    for (;;) {
        const bool has_next = S.next(ui + 1, nxt);
        const char* nA = has_next ? (const char*)g.A + (size_t)nxt.pm * tstep : cA; const char* nB = has_next ? (const char*)g.Bt + (size_t)nxt.pn * tstep : cB;
        for (int t = 0; t < nt; t += 2) {
            const bool last = (t == nt - 2);
            const char* a1 = cA + (size_t)(t + 1) * kstep;
            const char* a2 = last ? nA : cA + (size_t)(t + 2) * kstep; const char* b2 = last ? nB : cB + (size_t)(t + 2) * kstep;
            const char* a3 = a2 + kstep; const char* b3 = b2 + kstep;
            if (last && has_next) S.a_ready(nxt);
            if constexpr (SP2) {
            PG8_LDB(B0, 0, 0); PG8_LDB(B1, 0, 1); PG8_SCHED; PG8_LDA(At, 0, 0); PG8_STAGE(PG8_SA(1, 1), a1 + hstep, voffA);
            PG8_WAIT_V(8); PG8_WAIT_L(0); PG8_BAR; PG8_MMA(0, 0, At, B0); PG8_MMA(0, 1, At, B1); PG8_BAR; PG8_SCHED;
            PG8_LDA(At, 0, 1); PG8_STAGE(PG8_SB(0, 0), b2, voffB); PG8_STAGE(PG8_SB(0, 1), b2 + hstep, voffB); PG8_STAGE(PG8_SA(0, 0), a2, voffA);
            PG8_WAIT_V(8); PG8_WAIT_L(0); PG8_BAR; PG8_MMA(1, 0, At, B0); PG8_MMA(1, 1, At, B1); PG8_BAR; PG8_SCHED;
            PG8_LDB(B0, 1, 0); PG8_LDB(B1, 1, 1); PG8_SCHED; PG8_LDA(At, 1, 0); PG8_STAGE(PG8_SA(0, 1), a2 + hstep, voffA);
            PG8_WAIT_V(8); PG8_WAIT_L(0); PG8_BAR; PG8_MMA(0, 0, At, B0); PG8_MMA(0, 1, At, B1); PG8_BAR; PG8_SCHED;
            PG8_LDA(At, 1, 1); PG8_STAGE(PG8_SB(1, 0), b3, voffB); PG8_STAGE(PG8_SB(1, 1), b3 + hstep, voffB); PG8_STAGE(PG8_SA(1, 0), a3, voffA);
            PG8_WAIT_V(8); PG8_WAIT_L(0); PG8_BAR; PG8_MMA(1, 0, At, B0); PG8_MMA(1, 1, At, B1); PG8_BAR; PG8_SCHED;
            } else {
            PG8_LDB(B0, 0, 0); PG8_SCHED; PG8_LDA(At, 0, 0); PG8_STAGE(PG8_SA(1, 1), a1 + hstep, voffA);
            PG8_WAIT_L(8); PG8_BAR; PG8_WAIT_L(0); PG8_MMA(0, 0, At, B0); PG8_BAR; PG8_SCHED;
            PG8_LDB(B1, 0, 1); PG8_STAGE(PG8_SB(0, 0), b2, voffB);
            PG8_BAR; PG8_WAIT_L(0); PG8_MMA(0, 1, At, B1); PG8_BAR;
            PG8_LDA(At, 0, 1); PG8_STAGE(PG8_SA(0, 0), a2, voffA);
            PG8_BAR; PG8_WAIT_L(0); PG8_MMA(1, 0, At, B0); PG8_BAR; PG8_SCHED;
            PG8_STAGE(PG8_SB(0, 1), b2 + hstep, voffB);
            PG8_WAIT_V(6); PG8_BAR; PG8_MMA(1, 1, At, B1); PG8_BAR;
            PG8_LDB(B0, 1, 0); PG8_SCHED; PG8_LDA(At, 1, 0); PG8_STAGE(PG8_SA(0, 1), a2 + hstep, voffA);
            PG8_WAIT_L(8); PG8_BAR; PG8_WAIT_L(0); PG8_MMA(0, 0, At, B0); PG8_BAR; PG8_SCHED;
            PG8_LDB(B1, 1, 1); PG8_STAGE(PG8_SB(1, 0), b3, voffB);
            PG8_BAR; PG8_WAIT_L(0); PG8_MMA(0, 1, At, B1); PG8_BAR;
            PG8_LDA(At, 1, 1); PG8_STAGE(PG8_SA(1, 0), a3, voffA);
            PG8_BAR; PG8_WAIT_L(0); PG8_MMA(1, 0, At, B0); PG8_BAR; PG8_SCHED;
            PG8_STAGE(PG8_SB(1, 1), b3 + hstep, voffB);
            PG8_WAIT_V(6); PG8_BAR; PG8_MMA(1, 1, At, B1); PG8_BAR;
            }
        }
        if constexpr (ALIGN_EPI) { if (wr == 0) PG8_BAR; }
        if constexpr (!Epi::AFTER_DRAIN) { E(acc, cur, wr, wc, fr, fq); S.done(cur); }
        if (!has_next) break;
#pragma unroll
        for (int a = 0; a < 2; ++a)
#pragma unroll
            for (int b = 0; b < 2; ++b)
#pragma unroll
                for (int m = 0; m < 4; ++m)
#pragma unroll
                    for (int n = 0; n < 2; ++n) acc[a][b][m][n] = (f32x4){0.f, 0.f, 0.f, 0.f};
        cur = nxt; cA = nA; cB = nB; ++ui;
        if constexpr (ALIGN_EPI) { if (wr == 1) PG8_BAR; }
    }
    PG8_WAIT_V(0);
    if constexpr (!ALIGN_EPI) { if (wr == 0) PG8_BAR; }
    PG8_BAR;
    if constexpr (Epi::AFTER_DRAIN) { E.fused(acc, cur, wr, wc, fr, fq, lds, wid, lane); S.done(cur); }
#undef PG8_SA
#undef PG8_SB
#undef PG8_STAGE
#undef PG8_LDA
#undef PG8_LDB
#undef PG8_MMA
#undef PG8_WAIT_V
#undef PG8_WAIT_L
#undef PG8_BAR
#undef PG8_SCHED
}
}

#define LAS __attribute__((address_space(3)))
using pg8::bf16_t; using pg8::bf16x8; using pg8::f32x4; using pg8::u32x4;
typedef short s16x4 __attribute__((ext_vector_type(4)));
typedef float f32x16 __attribute__((ext_vector_type(16)));
typedef unsigned u32x2 __attribute__((ext_vector_type(2)));
typedef float f32x2_t __attribute__((ext_vector_type(2)));
typedef __bf16 bf16x2_t __attribute__((ext_vector_type(2)));

constexpr int DM = 1024, SEQ = 2048, NBATCH = 8, MP = NBATCH * SEQ, DSEQ = 16, MS = NBATCH * DSEQ, MT = MP + MS;
constexpr int DFF = 2816, NQKV = 3072, PLED = 256, NLAYER = 2, PAST = 2048, BANDL = 512, HW = 512;
constexpr float EPS = 1e-6f, LOG2E = 1.4426950408889634f, QSCALE = 0.125f * LOG2E;
#ifndef SB_EARLY
#define SB_EARLY 1
#endif
constexpr float SB_THR = 7.5e-37f;

constexpr size_t MiB = 1u << 20;
constexpr size_t WS_CTL = 0, WS_SS = 64 * 1024;
constexpr size_t WS_W = 2 * MiB, W_LSTRIDE = 28 * MiB, W_IN = 0, W_OUT = 6 * MiB, W_GU = 8 * MiB, W_DOWN = 19 * MiB, W_PG = 25 * MiB, W_PP = 27 * MiB;
constexpr size_t WS_PB = 58 * MiB, WS_X = 76 * MiB  , WS_XB = 142 * MiB, WS_QKV = 176 * MiB, WS_MIX = 274 * MiB, WS_P = 308 * MiB, WS_END = 342 * MiB;
constexpr int LDS_BYTES = 131072 + 1024;
constexpr size_t WS_BAR = 8192;
constexpr int NWAVES = 8, NTHREADS = 512;

constexpr size_t O_YP = 0, O_YS = (size_t)MP * DM, O_SBK_P = O_YS + (size_t)MS * DM, O_SBV_P = O_SBK_P + (size_t)NLAYER * MP * HW,
                 O_CBK_P = O_SBV_P + (size_t)NLAYER * MP * HW, O_CBV_P = O_CBK_P + (size_t)NLAYER * NBATCH * BANDL * HW,
                 O_SBK_S = O_CBV_P + (size_t)NLAYER * NBATCH * BANDL * HW, O_SBV_S = O_SBK_S + (size_t)NLAYER * MS * HW,
                 O_CBK_S = O_SBV_S + (size_t)NLAYER * MS * HW, O_CBV_S = O_CBK_S + (size_t)NLAYER * MS * HW;

__device__ __forceinline__ unsigned pk2(float lo, float hi) { f32x2_t v = {lo, hi}; bf16x2_t b = __builtin_convertvector(v, bf16x2_t); return __builtin_bit_cast(unsigned, b); }
__device__ __forceinline__ float bf_lo(unsigned w) { return __uint_as_float(w << 16); }
__device__ __forceinline__ float bf_hi(unsigned w) { return __uint_as_float(w & 0xffff0000u); }
__device__ __forceinline__ float partner32(float v) {
    auto rr = __builtin_amdgcn_permlane32_swap(__float_as_uint(v), __float_as_uint(v), false, false);
    return (threadIdx.x & 32) ? __uint_as_float(rr[0]) : __uint_as_float(rr[1]);
}
__device__ __forceinline__ float wave_sum(float v) {
#pragma unroll
    for (int o = 1; o < 64; o <<= 1) v += __shfl_xor(v, o);
    return v;
}
__device__ __forceinline__ float rstd_of(float ss) { return rsqrtf(ss * (1.0f / DM) + EPS); }

template <int I> __device__ __forceinline__ const float* argp() {
    unsigned long long v; const void* ka = (const void*)__builtin_amdgcn_kernarg_segment_ptr();
    asm volatile("s_load_dwordx2 %0, %1, %2\n\ts_waitcnt lgkmcnt(0)" : "=s"(v) : "s"(ka), "i"(I * 8) : "memory");
    return (const float*)(const __attribute__((address_space(1))) float*)v;
}
#define ARG(i) argp<i>()
#define ARG_OUT ((float*)argp<22>())
#define ARG_WS ((unsigned char*)argp<23>())
#define WS_PTR(T, off) ((T*)(ARG_WS + (off)))
#define SSB WS_PTR(float, WS_SS)
#define PB_ WS_PTR(bf16_t, WS_PB)
#define XN_ WS_PTR(bf16_t, WS_X)
#define XB_ WS_PTR(bf16_t, WS_XB)
#define QKV_ WS_PTR(bf16_t, WS_QKV)
#define HB_ WS_PTR(bf16_t, WS_QKV)
#define MIX_ WS_PTR(bf16_t, WS_MIX)
#define PBUF_ WS_PTR(bf16_t, WS_P)
#define WPTR(L, off) ((const bf16_t*)(ARG_WS + WS_W + (size_t)(L) * W_LSTRIDE + (off)))

enum { EP_QKV = 0, EP_RES = 1, EP_GU = 2, EP_P = 3, EP_PLE = 4 };
struct EpiArgs {
    const float* ss_in; float* ss_out;
    const bf16_t* xbase;
    bf16_t* XB; bf16_t* o0; const bf16_t* P;
    float *f_sbk, *f_sbv, *f_cbk, *f_cbv;
    float *s_sbk, *s_sbv, *s_cbk, *s_cbv;
};
template <int MODE> struct Epi {
    static constexpr bool PERM = false, AFTER_DRAIN = false;
    EpiArgs a;
    __device__ __forceinline__ void operator()(const f32x4 (&acc)[2][2][4][2], const pg8::Unit& u, int wr, int wc, int fr, int fq) const {
        if constexpr (MODE == EP_QKV) {
            const int part = u.pn >> 1, cb = (u.pn & 1) * 256 + wc * 32 + 4 * fq;
            bf16_t* ob = a.o0 + (size_t)part * ((size_t)MT * HW);
            float* fo = part == 1 ? a.f_sbk : part == 2 ? a.f_sbv : part == 4 ? a.f_cbk : part == 5 ? a.f_cbv : nullptr;
            const bool band = part >= 4; const float qs = (part == 0 || part == 3) ? QSCALE : 1.f;
#pragma unroll
            for (int ai = 0; ai < 2; ++ai)
#pragma unroll
                for (int m = 0; m < 4; ++m) {
                    const int row = u.pm * 256 + ai * 128 + wr * 64 + m * 16 + fr;
                    const float rs = rstd_of(a.ss_in[row]) * qs;
                    const int t = row & (SEQ - 1);
                    float* frow = nullptr;
                    if (fo) { if (!band) frow = fo + (size_t)row * HW; else if (t >= SEQ - BANDL) frow = fo + ((size_t)(row >> 11) * BANDL + (t - (SEQ - BANDL))) * HW; }
#pragma unroll
                    for (int bj = 0; bj < 2; ++bj)
#pragma unroll
                        for (int n = 0; n < 2; ++n) {
                            const int col = cb + bj * 128 + n * 16; const f32x4 v = acc[ai][bj][m][n] * rs;
                            u32x2 w; w.x = pk2(v[0], v[1]); w.y = pk2(v[2], v[3]);
                            *(u32x2*)(ob + (size_t)row * HW + col) = w;
                            if (frow) *(f32x4*)(frow + col) = v;
                        }
                }
        } else if constexpr (MODE == EP_RES || MODE == EP_PLE) {
#pragma unroll
            for (int ai = 0; ai < 2; ++ai)
#pragma unroll
                for (int m = 0; m < 4; ++m) {
                    const int row = u.pm * 256 + ai * 128 + wr * 64 + m * 16 + fr;
                    float rs = 0.f; if constexpr (MODE == EP_PLE) rs = rstd_of(a.ss_in[row]) * (-LOG2E);
                    float s = 0.f;
#pragma unroll
                    for (int bj = 0; bj < 2; ++bj)
#pragma unroll
                        for (int n = 0; n < 2; ++n) {
                            const size_t off = (size_t)row * DM + u.pn * 256 + bj * 128 + wc * 32 + n * 16 + 4 * fq;
                            const u32x2 xw = *(const u32x2*)(a.xbase + off); f32x4 x = {bf_lo(xw.x), bf_hi(xw.x), bf_lo(xw.y), bf_hi(xw.y)}; const f32x4 c = acc[ai][bj][m][n];
                            if constexpr (MODE == EP_RES) x += c;
                            else { const u32x2 pw = *(const u32x2*)(a.P + off);
                                   x[0] += bf_lo(pw.x) * __builtin_amdgcn_rcpf(1.f + __builtin_amdgcn_exp2f(c[0] * rs));
                                   x[1] += bf_hi(pw.x) * __builtin_amdgcn_rcpf(1.f + __builtin_amdgcn_exp2f(c[1] * rs));
                                   x[2] += bf_lo(pw.y) * __builtin_amdgcn_rcpf(1.f + __builtin_amdgcn_exp2f(c[2] * rs));
                                   x[3] += bf_hi(pw.y) * __builtin_amdgcn_rcpf(1.f + __builtin_amdgcn_exp2f(c[3] * rs)); }
                            u32x2 w; w.x = pk2(x[0], x[1]); w.y = pk2(x[2], x[3]); *(u32x2*)(a.XB + off) = w;
                            s += (x[0] * x[0] + x[1] * x[1]) + (x[2] * x[2] + x[3] * x[3]);
                        }
                    s += __shfl_xor(s, 16); s += __shfl_xor(s, 32);
                    if (fq == 0) unsafeAtomicAdd(a.ss_out + row, s);
                }
        } else if constexpr (MODE == EP_GU) {
#pragma unroll
            for (int ai = 0; ai < 2; ++ai)
#pragma unroll
                for (int m = 0; m < 4; ++m) {
                    const int row = u.pm * 256 + ai * 128 + wr * 64 + m * 16 + fr;
                    const float rs = rstd_of(a.ss_in[row]);
#pragma unroll
                    for (int n = 0; n < 2; ++n) {
                        const int col = u.pn * 128 + wc * 32 + n * 16 + 4 * fq;
                        const f32x4 g = acc[ai][0][m][n] * rs, up = acc[ai][1][m][n] * rs; float h[4];
#pragma unroll
                        for (int e = 0; e < 4; ++e) h[e] = g[e] * up[e] * __builtin_amdgcn_rcpf(1.f + __builtin_amdgcn_exp2f(-LOG2E * g[e]));
                        u32x2 w; w.x = pk2(h[0], h[1]); w.y = pk2(h[2], h[3]);
                        *(u32x2*)(a.o0 + (size_t)row * DFF + col) = w;
                    }
                }
        } else {
#pragma unroll
            for (int ai = 0; ai < 2; ++ai)
#pragma unroll
                for (int m = 0; m < 4; ++m) {
                    const int row = u.pm * 256 + ai * 128 + wr * 64 + m * 16 + fr;
#pragma unroll
                    for (int bj = 0; bj < 2; ++bj)
#pragma unroll
                        for (int n = 0; n < 2; ++n) {
                            const size_t off = (size_t)row * DM + u.pn * 256 + bj * 128 + wc * 32 + n * 16 + 4 * fq; const f32x4 v = acc[ai][bj][m][n];
                            u32x2 w; w.x = pk2(v[0], v[1]); w.y = pk2(v[2], v[3]); *(u32x2*)(a.o0 + off) = w;
                        }
                }
        }
    }
};

template <int MODE, int K>
__device__ __forceinline__ void sgemm(LAS unsigned char* lds, const bf16_t* A, const bf16_t* Bt, int ncol32, const EpiArgs& a) {
    const int tid = fresh_tid(), lane = tid & 63, wave = __builtin_amdgcn_readfirstlane(tid >> 6), r = lane & 31, hh = lane >> 5;
    LAS float* red = (LAS float*)lds;
    constexpr int K8 = K >> 3, NK = K8 / 16, UB = NK > 11 ? 11 : NK;
    static_assert(NK % UB == 0, "sgemm: K split");
    const int G = gridDim.x, nunits = 4 * ncol32;
    for (int j = G - 1 - (int)blockIdx.x; j < nunits; j += G) {
        const int rb = j & 3, c0 = 32 * (j >> 2);
        const int brow0 = (MODE == EP_GU) ? ((c0 >> 7) * 256 + (c0 & 127)) : c0;
        const bf16_t* ap = A + (size_t)(32 * rb + r) * K + wave * K8 + 8 * hh;
        const bf16_t* bp = Bt + (size_t)(brow0 + r) * K + wave * K8 + 8 * hh;
        f32x16 acc0 = {}, acc1 = {};
#pragma unroll 1
        for (int kb = 0; kb < NK; kb += UB) {
            bf16x8 af[UB], bf[UB], bf2[MODE == EP_GU ? UB : 1];
#pragma unroll
            for (int i = 0; i < UB; ++i) { af[i] = *(const bf16x8*)(ap + (kb + i) * 16); bf[i] = *(const bf16x8*)(bp + (kb + i) * 16);
                if constexpr (MODE == EP_GU) bf2[i] = *(const bf16x8*)(bp + (size_t)128 * K + (kb + i) * 16); }
#pragma unroll
            for (int i = 0; i < UB; ++i) { acc0 = __builtin_amdgcn_mfma_f32_32x32x16_bf16(af[i], bf[i], acc0, 0, 0, 0);
                if constexpr (MODE == EP_GU) acc1 = __builtin_amdgcn_mfma_f32_32x32x16_bf16(af[i], bf2[i], acc1, 0, 0, 0); }
        }
#pragma unroll
        for (int i = 0; i < 16; ++i) { red[(wave * 16 + i) * 64 + lane] = acc0[i]; if constexpr (MODE == EP_GU) red[8192 + (wave * 16 + i) * 64 + lane] = acc1[i]; }
        __syncthreads();
        const int col = c0 + r;
#pragma unroll
        for (int ii = 0; ii < 2; ++ii) {
            const int i = 2 * wave + ii;
            float v0 = 0.f, v1 = 0.f;
#pragma unroll
            for (int w = 0; w < 8; ++w) { v0 += red[(w * 16 + i) * 64 + lane]; if constexpr (MODE == EP_GU) v1 += red[8192 + (w * 16 + i) * 64 + lane]; }
            const int rs_ = 32 * rb + (i & 3) + 8 * (i >> 2) + 4 * hh, row = MP + rs_;
            if constexpr (MODE == EP_QKV) {
                const int part = c0 >> 9, cc = col & 511;
                const float v = v0 * rstd_of(a.ss_in[row]);
                const float qs = (part == 0 || part == 3) ? QSCALE : 1.f;
                (a.o0 + (size_t)part * ((size_t)MT * HW))[(size_t)row * HW + cc] = (bf16_t)(pk2(v * qs, 0.f) & 0xffffu);
                float* fo = part == 1 ? a.s_sbk : part == 2 ? a.s_sbv : part == 4 ? a.s_cbk : part == 5 ? a.s_cbv : nullptr;
                if (fo) fo[(size_t)rs_ * HW + cc] = v;
            } else if constexpr (MODE == EP_RES || MODE == EP_PLE) {
                const size_t off = (size_t)row * DM + col;
                float x = __uint_as_float((unsigned)a.xbase[off] << 16);
                if constexpr (MODE == EP_RES) x += v0;
                else { const float pv = __uint_as_float((unsigned)a.P[off] << 16); x += pv * __builtin_amdgcn_rcpf(1.f + __builtin_amdgcn_exp2f(-LOG2E * v0 * rstd_of(a.ss_in[row]))); }
                a.XB[off] = (bf16_t)(pk2(x, 0.f) & 0xffffu);
                float s = x * x;
                s += __shfl_xor(s, 1); s += __shfl_xor(s, 2); s += __shfl_xor(s, 4); s += __shfl_xor(s, 8); s += __shfl_xor(s, 16);
                if (r == 0) unsafeAtomicAdd(a.ss_out + row, s);
            } else if constexpr (MODE == EP_GU) {
                const float rs = rstd_of(a.ss_in[row]); const float g = v0 * rs, up = v1 * rs;
                const float h = g * up * __builtin_amdgcn_rcpf(1.f + __builtin_amdgcn_exp2f(-LOG2E * g));
                a.o0[(size_t)row * DFF + col] = (bf16_t)(pk2(h, 0.f) & 0xffffu);
            } else {
                a.o0[(size_t)row * DM + col] = (bf16_t)(pk2(v0, 0.f) & 0xffffu);
            }
        }
        __syncthreads();
    }
}
struct AttnArgs { int L; };
constexpr int AW_V = 0, AW_ST = 4096, AW_BIAS = 8704, AW_BYTES = 10240, ST_PITCH = 144;

template <bool F32> __device__ __forceinline__ void ld_k(bf16x8 (&kf)[4], const void* base, size_t off) {
    if constexpr (!F32) { const bf16_t* p = (const bf16_t*)base + off;
#pragma unroll
        for (int kk = 0; kk < 4; ++kk) kf[kk] = *(const bf16x8*)(p + 8 * kk);
    } else { const float* p = (const float*)base + off;
#pragma unroll
        for (int kk = 0; kk < 4; ++kk) { const f32x4 x = *(const f32x4*)(p + 8 * kk), y = *(const f32x4*)(p + 8 * kk + 4);
            u32x4 w; w.x = pk2(x[0], x[1]); w.y = pk2(x[2], x[3]); w.z = pk2(y[0], y[1]); w.w = pk2(y[2], y[3]); kf[kk] = __builtin_bit_cast(bf16x8, w); }
    }
}
template <bool F32> __device__ __forceinline__ void ld_v(u32x4 (&vr)[4], const void* base, size_t row0, int nvalid, int h, int lane) {
#pragma unroll
    for (int i = 0; i < 4; ++i) { int key = 8 * i + (lane >> 3); key = key < nvalid ? key : nvalid - 1;
        const size_t off = (row0 + key) * HW + h * 64 + (lane & 7) * 8;
        if constexpr (!F32) vr[i] = *(const u32x4*)((const bf16_t*)base + off);
        else { const float* p = (const float*)base + off; const f32x4 x = *(const f32x4*)p, y = *(const f32x4*)(p + 4);
            u32x4 w; w.x = pk2(x[0], x[1]); w.y = pk2(x[2], x[3]); w.z = pk2(y[0], y[1]); w.w = pk2(y[2], y[3]); vr[i] = w; }
    }
}
__device__ __forceinline__ void st_v(LAS unsigned char* vl, const u32x4 (&vr)[4], int lane) {
#pragma unroll
    for (int i = 0; i < 4; ++i) { const int key = 8 * i + (lane >> 3); *(LAS u32x4*)(vl + key * 128 + (((lane & 7) * 16) ^ (((key >> 1) & 1) << 6))) = vr[i]; }
}
typedef short v4i16_t __attribute__((ext_vector_type(4)));
__device__ __forceinline__ s16x4 vtr(LAS unsigned char* p) { return __builtin_bit_cast(s16x4, __builtin_amdgcn_ds_read_tr16_b64_v4i16((LAS v4i16_t*)p)); }
__device__ __forceinline__ void pv_block(f32x16 (&o)[2], LAS unsigned char* vl, const bf16x8 (&pf)[2], int lane) {
    const int q = (lane & 15) >> 2, p = lane & 3, c16 = (lane >> 4) & 1, hh = lane >> 5;
    const int va0 = (4 * hh + q) * 128 + ((32 * c16 + 8 * p) ^ ((q >> 1) << 6));
#pragma unroll
    for (int db = 0; db < 2; ++db)
#pragma unroll
        for (int s = 0; s < 2; ++s) {
            const s16x4 lo = vtr(vl + (va0 ^ (db * 64)) + s * 2048), hi = vtr(vl + (va0 ^ (db * 64)) + s * 2048 + 1024);
            const bf16x8 vf = {lo[0], lo[1], lo[2], lo[3], hi[0], hi[1], hi[2], hi[3]};
            o[db] = __builtin_amdgcn_mfma_f32_32x32x16_bf16(vf, pf[s], o[db], 0, 0, 0);
        }
}
__device__ __forceinline__ f32x16 qk_block(const bf16x8 (&kf)[4], const bf16x8 (&qf)[4]) {
    f32x16 S = {};
#pragma unroll
    for (int kk = 0; kk < 4; ++kk) S = __builtin_amdgcn_mfma_f32_32x32x16_bf16(kf[kk], qf[kk], S, 0, 0, 0);
    return S;
}
__device__ __forceinline__ void sb_block(const f32x16& S, LAS unsigned char* vl, int tq, int keypos0, float& carry, f32x16 (&o)[2], int lane) {
    const int hh = lane >> 5;
    float kp_[16], be[16];
#pragma unroll
    for (int r = 0; r < 16; ++r) {
        const int kp = keypos0 + (r & 3) + 8 * (r >> 2) + 4 * hh; const bool valid = kp < tq;
        const float z = __builtin_amdgcn_fmed3f(S[r], -126.f, 100.f);
        const float t = __builtin_amdgcn_exp2f(z), k = __builtin_amdgcn_rcpf(1.f + t);
        kp_[r] = valid ? k : 1.f; be[r] = valid ? t * k : 0.f;
    }
    float T[4], Tp[4], U[4];
#pragma unroll
    for (int g = 0; g < 4; ++g) { T[g] = (kp_[4 * g] * kp_[4 * g + 1]) * (kp_[4 * g + 2] * kp_[4 * g + 3]); Tp[g] = partner32(T[g]); U[g] = T[g] * Tp[g]; }
    float R[4]; R[3] = 1.f; R[2] = U[3]; R[1] = U[3] * U[2]; R[0] = R[1] * U[1];
    const float tot = R[0] * U[0];
    float w[16];
#pragma unroll
    for (int g = 0; g < 4; ++g) {
        const float b3 = carry * R[g] * (hh == 0 ? Tp[g] : 1.f);
        const float b2 = b3 * kp_[4 * g + 3], b1 = b2 * kp_[4 * g + 2], b0 = b1 * kp_[4 * g + 1];
        w[4 * g + 3] = be[4 * g + 3] * b3; w[4 * g + 2] = be[4 * g + 2] * b2; w[4 * g + 1] = be[4 * g + 1] * b1; w[4 * g + 0] = be[4 * g + 0] * b0;
    }
    carry *= tot;
    bf16x8 pf[2];
#pragma unroll
    for (int s = 0; s < 2; ++s) { u32x4 pw; pw.x = pk2(w[8 * s], w[8 * s + 1]); pw.y = pk2(w[8 * s + 2], w[8 * s + 3]); pw.z = pk2(w[8 * s + 4], w[8 * s + 5]); pw.w = pk2(w[8 * s + 6], w[8 * s + 7]); pf[s] = __builtin_bit_cast(bf16x8, pw); }
    pv_block(o, vl, pf, lane);
}
__device__ __forceinline__ void cb_block(const f32x16& S, bool cbias, LAS unsigned char* vl, const LAS float* bl, int tq, int keypos0, int nvalid, float& m, float& l, f32x16 (&o)[2], int lane) {
    const int hh = lane >> 5;
    float s[16]; float bm = -INFINITY;
    if (cbias) {
        const float cb = bl[256];
#pragma unroll
        for (int r = 0; r < 16; ++r) { s[r] = S[r] + cb; bm = fmaxf(bm, s[r]); }
    } else {
#pragma unroll
        for (int r = 0; r < 16; ++r) {
            const int kr = (r & 3) + 8 * (r >> 2) + 4 * hh; int d = tq - (keypos0 + kr); d = d < -128 ? -128 : (d > 128 ? 128 : d);
            s[r] = (kr < nvalid) ? S[r] + bl[d + 128] : -INFINITY; bm = fmaxf(bm, s[r]);
        }
    }
    bm = fmaxf(bm, partner32(bm));
    if (__any(bm > m + 8.f)) {
        const float mn = fmaxf(m, bm), f = __builtin_amdgcn_exp2f(m - mn); m = mn; l *= f;
#pragma unroll
        for (int db = 0; db < 2; ++db)
#pragma unroll
            for (int r = 0; r < 16; ++r) o[db][r] *= f;
    }
    float w[16], ls = 0.f;
#pragma unroll
    for (int r = 0; r < 16; ++r) { w[r] = __builtin_amdgcn_exp2f(s[r] - m); ls += w[r]; }
    l += ls;
    bf16x8 pf[2];
#pragma unroll
    for (int s2 = 0; s2 < 2; ++s2) { u32x4 pw; pw.x = pk2(w[8 * s2], w[8 * s2 + 1]); pw.y = pk2(w[8 * s2 + 2], w[8 * s2 + 3]); pw.z = pk2(w[8 * s2 + 4], w[8 * s2 + 5]); pw.w = pk2(w[8 * s2 + 6], w[8 * s2 + 7]); pf[s2] = __builtin_bit_cast(bf16x8, pw); }
    pv_block(o, vl, pf, lane);
}
__device__ __forceinline__ void attn_store(f32x16 (&o)[2], float scale, const float* gain, bf16_t* mix, size_t row0, int col0, int nrows, LAS unsigned char* wl, int lane) {
    const int r = lane & 31, hh = lane >> 5;
    f32x4 gvs[2][4];
#pragma unroll
    for (int db = 0; db < 2; ++db)
#pragma unroll
        for (int g = 0; g < 4; ++g) gvs[db][g] = *(const f32x4*)(gain + 32 * db + 8 * g + 4 * hh);
    float ssq = 0.f;
#pragma unroll
    for (int db = 0; db < 2; ++db)
#pragma unroll
        for (int i = 0; i < 16; ++i) { o[db][i] *= scale; ssq += o[db][i] * o[db][i]; }
    ssq += partner32(ssq);
    const float rstd = rsqrtf(ssq * (1.0f / 64.0f) + EPS);
    LAS unsigned char* st = wl + AW_ST;
#pragma unroll
    for (int db = 0; db < 2; ++db)
#pragma unroll
        for (int g = 0; g < 4; ++g) { const int d0 = 32 * db + 8 * g + 4 * hh; const f32x4 gv = gvs[db][g];
            u32x2 w; w.x = pk2(o[db][4 * g] * rstd * gv[0], o[db][4 * g + 1] * rstd * gv[1]); w.y = pk2(o[db][4 * g + 2] * rstd * gv[2], o[db][4 * g + 3] * rstd * gv[3]);
            *(LAS u32x2*)(st + r * ST_PITCH + d0 * 2) = w; }
#pragma unroll
    for (int i = 0; i < 4; ++i) { const int row = 8 * i + (lane >> 3), ch = lane & 7; const u32x4 v = *(const LAS u32x4*)(st + row * ST_PITCH + ch * 16);
        if (row < nrows) *(u32x4*)(mix + (row0 + row) * DM + col0 + ch * 8) = v; }
}

template <bool F32> __device__ __forceinline__ void sb_loop(const void* kbase, const void* vbase, size_t rowbase, int jhi, int h, const bf16x8 (&qf)[4], int tq, float& carry, f32x16 (&o)[2], LAS unsigned char* wl, int lane) {
    const int r = lane & 31, hh = lane >> 5;
    bf16x8 kA[4], kB[4]; u32x4 vA[4], vB[4];
#define SB_LD(KF, VN, jj) do { ld_k<F32>(KF, kbase, (rowbase + 32 * (jj) + r) * HW + h * 64 + 32 * hh); ld_v<F32>(VN, vbase, rowbase + 32 * (jj), 32, h, lane); } while (0)
    SB_LD(kA, vA, jhi); if (jhi >= 1) SB_LD(kB, vB, jhi - 1);
    for (int j = jhi; j >= 0; j -= 2) {
        { const f32x16 S = qk_block(kA, qf); st_v(wl + AW_V, vA, lane); if (j >= 2) SB_LD(kA, vA, j - 2);
          sb_block(S, wl + AW_V, tq, 32 * j, carry, o, lane); }
#if SB_EARLY
        if (__all(carry < SB_THR)) break;
#endif
        if (j < 1) break;
        { const f32x16 S = qk_block(kB, qf); st_v(wl + AW_V, vB, lane); if (j >= 3) SB_LD(kB, vB, j - 3);
          sb_block(S, wl + AW_V, tq, 32 * (j - 1), carry, o, lane); }
#if SB_EARLY
        if (__all(carry < SB_THR)) break;
#endif
    }
#undef SB_LD
}
template <bool SAMPLE> __device__ __forceinline__ void sb_unit(const AttnArgs& A, int b, int h, int qb, LAS unsigned char* wl, int lane) {
    const int r = lane & 31, hh = lane >> 5;
    const bf16_t* Qa = QKV_; const bf16_t* Ka = Qa + (size_t)1 * MT * HW; const bf16_t* Va = Qa + (size_t)2 * MT * HW;
    int tq; size_t qrow;
    if (SAMPLE) { tq = PAST + (r & 15); qrow = (size_t)MP + b * DSEQ + (r & 15); } else { tq = 32 * qb + r; qrow = (size_t)b * SEQ + tq; }
    bf16x8 qf[4]; ld_k<false>(qf, Qa, qrow * HW + h * 64 + 32 * hh);
    float carry = 1.f; f32x16 o[2]; o[0] = f32x16{}; o[1] = f32x16{};
    if (SAMPLE) {
        bf16x8 kf[4]; u32x4 vr[4]; const size_t row0 = (size_t)MP + b * DSEQ;
        ld_k<false>(kf, Ka, (row0 + (r & 15)) * HW + h * 64 + 32 * hh); ld_v<false>(vr, Va, row0, DSEQ, h, lane); st_v(wl + AW_V, vr, lane);
        { const f32x16 S = qk_block(kf, qf); sb_block(S, wl + AW_V, tq, PAST, carry, o, lane); }
        sb_loop<true>(ARG(4) + (size_t)A.L * NBATCH * PAST * HW, ARG(5) + (size_t)A.L * NBATCH * PAST * HW, (size_t)b * PAST, PAST / 32 - 1, h, qf, tq, carry, o, wl, lane);
        attn_store(o, 1.f, ARG(11) + A.L * HW + h * 64, MIX_, row0, h * 64, DSEQ, wl, lane);
    } else {
        sb_loop<false>(Ka, Va, (size_t)b * SEQ, qb, h, qf, tq, carry, o, wl, lane);
        attn_store(o, 1.f, ARG(11) + A.L * HW + h * 64, MIX_, (size_t)b * SEQ + 32 * qb, h * 64, 32, wl, lane);
    }
}
template <bool F32> __device__ __forceinline__ void cb_loop(const void* kbase, const void* vbase, size_t rowbase, int jlo, int jhi, int pos0, int h, const bf16x8 (&qf)[4], int tq, float& m, float& l, f32x16 (&o)[2], LAS unsigned char* wl, int lane) {
    const int r = lane & 31, hh = lane >> 5;
    bf16x8 kA[4], kB[4]; u32x4 vA[4], vB[4];
    const int tqmin = tq - r;
#define CB_LD(KF, VN, jj) do { ld_k<F32>(KF, kbase, (rowbase + 32 * (jj) + r) * HW + h * 64 + 32 * hh); ld_v<F32>(VN, vbase, rowbase + 32 * (jj), 32, h, lane); } while (0)
    CB_LD(kA, vA, jlo); if (jlo + 1 <= jhi) CB_LD(kB, vB, jlo + 1);
    for (int j = jlo; j <= jhi; j += 2) {
        { const f32x16 S = qk_block(kA, qf); st_v(wl + AW_V, vA, lane); if (j + 2 <= jhi) CB_LD(kA, vA, j + 2);
          const bool cbias = __builtin_amdgcn_readfirstlane(pos0 + 32 * j + 31 + 128 <= tqmin);
          cb_block(S, cbias, wl + AW_V, (const LAS float*)(wl + AW_BIAS), tq, pos0 + 32 * j, 32, m, l, o, lane); }
        if (j + 1 > jhi) break;
        { const f32x16 S = qk_block(kB, qf); st_v(wl + AW_V, vB, lane); if (j + 3 <= jhi) CB_LD(kB, vB, j + 3);
          const bool cbias = __builtin_amdgcn_readfirstlane(pos0 + 32 * (j + 1) + 31 + 128 <= tqmin);
          cb_block(S, cbias, wl + AW_V, (const LAS float*)(wl + AW_BIAS), tq, pos0 + 32 * (j + 1), 32, m, l, o, lane); }
    }
#undef CB_LD
}
template <bool SAMPLE> __device__ __forceinline__ void cb_unit(const AttnArgs& A, int b, int h, int qb, LAS unsigned char* wl, int lane) {
    const int r = lane & 31, hh = lane >> 5;
    const bf16_t* Qb = QKV_ + (size_t)3 * MT * HW; const bf16_t* Kb = Qb + (size_t)1 * MT * HW; const bf16_t* Vb = Qb + (size_t)2 * MT * HW;
    LAS float* bl = (LAS float*)(wl + AW_BIAS);
    { const float* relp = ARG(10) + (size_t)A.L * 257 * 8 + h; float bv[5];
#pragma unroll
      for (int i = 0; i < 5; ++i) { const int idx = lane + 64 * i; bv[i] = relp[(idx < 257 ? idx : 256) * 8]; }
#pragma unroll
      for (int i = 0; i < 5; ++i) { const int idx = lane + 64 * i; if (idx < 257) bl[idx] = bv[i] * LOG2E; } }
    int tq; size_t qrow;
    if (SAMPLE) { tq = PAST + (r & 15); qrow = (size_t)MP + b * DSEQ + (r & 15); } else { tq = 32 * qb + r; qrow = (size_t)b * SEQ + tq; }
    bf16x8 qf[4]; ld_k<false>(qf, Qb, qrow * HW + h * 64 + 32 * hh);
    float m = -INFINITY, l = 0.f; f32x16 o[2]; o[0] = f32x16{}; o[1] = f32x16{};
    if (SAMPLE) {
        cb_loop<true>(ARG(6) + (size_t)A.L * NBATCH * BANDL * HW, ARG(7) + (size_t)A.L * NBATCH * BANDL * HW, (size_t)b * BANDL, 0, BANDL / 32 - 1, PAST - BANDL, h, qf, tq, m, l, o, wl, lane);
        bf16x8 kf[4]; u32x4 vr[4]; const size_t row0 = (size_t)MP + b * DSEQ;
        ld_k<false>(kf, Kb, (row0 + (r & 15)) * HW + h * 64 + 32 * hh); ld_v<false>(vr, Vb, row0, DSEQ, h, lane); st_v(wl + AW_V, vr, lane);
        { const f32x16 S = qk_block(kf, qf); cb_block(S, false, wl + AW_V, bl, tq, PAST, DSEQ, m, l, o, lane); }
        l += partner32(l);
        attn_store(o, 1.0f / l, ARG(12) + A.L * HW + h * 64, MIX_, row0, HW + h * 64, DSEQ, wl, lane);
    } else {
        const int c = qb >> 1, clo = c - 8 < 0 ? 0 : c - 8;
        cb_loop<false>(Kb, Vb, (size_t)b * SEQ, 2 * clo, 2 * c + 1, 0, h, qf, tq, m, l, o, wl, lane);
        l += partner32(l);
        attn_store(o, 1.0f / l, ARG(12) + A.L * HW + h * 64, MIX_, (size_t)b * SEQ + 32 * qb, HW + h * 64, 32, wl, lane);
    }
}
__device__ __forceinline__ void cb_unit_p64(const AttnArgs& A, int b, int h, int c, LAS unsigned char* wl, int lane) {
    const int r = lane & 31, hh = lane >> 5;
    const bf16_t* Qb = QKV_ + (size_t)3 * MT * HW; const bf16_t* Kb = Qb + (size_t)1 * MT * HW; const bf16_t* Vb = Qb + (size_t)2 * MT * HW;
    LAS float* bl = (LAS float*)(wl + AW_BIAS);
    { const float* relp = ARG(10) + (size_t)A.L * 257 * 8 + h; float bv[5];
#pragma unroll
      for (int i = 0; i < 5; ++i) { const int idx = lane + 64 * i; bv[i] = relp[(idx < 257 ? idx : 256) * 8]; }
#pragma unroll
      for (int i = 0; i < 5; ++i) { const int idx = lane + 64 * i; if (idx < 257) bl[idx] = bv[i] * LOG2E; } }
    const int tq0 = 64 * c + r, tq1 = tq0 + 32; const size_t rowbase = (size_t)b * SEQ;
    bf16x8 qf0[4], qf1[4];
    ld_k<false>(qf0, Qb, (rowbase + tq0) * HW + h * 64 + 32 * hh); ld_k<false>(qf1, Qb, (rowbase + tq1) * HW + h * 64 + 32 * hh);
    float m0 = -INFINITY, l0 = 0.f, m1 = -INFINITY, l1 = 0.f;
    f32x16 o0[2], o1[2]; o0[0] = f32x16{}; o0[1] = f32x16{}; o1[0] = f32x16{}; o1[1] = f32x16{};
    const int clo = c - 8 < 0 ? 0 : c - 8, jlo = 2 * clo, jhi = 2 * c + 1;
    bf16x8 kf[4]; u32x4 vn[4];
    ld_k<false>(kf, Kb, (rowbase + 32 * jlo + r) * HW + h * 64 + 32 * hh); ld_v<false>(vn, Vb, rowbase + 32 * jlo, 32, h, lane);
    for (int j = jlo; j <= jhi; ++j) {
        const f32x16 S0 = qk_block(kf, qf0), S1 = qk_block(kf, qf1);
        st_v(wl + AW_V, vn, lane);
        if (j < jhi) { ld_k<false>(kf, Kb, (rowbase + 32 * (j + 1) + r) * HW + h * 64 + 32 * hh); ld_v<false>(vn, Vb, rowbase + 32 * (j + 1), 32, h, lane); }
        const bool cbias = (32 * j + 31 + 128 <= 64 * c);
        cb_block(S0, cbias, wl + AW_V, bl, tq0, 32 * j, 32, m0, l0, o0, lane);
        cb_block(S1, cbias, wl + AW_V, bl, tq1, 32 * j, 32, m1, l1, o1, lane);
    }
    l0 += partner32(l0); l1 += partner32(l1);
    attn_store(o0, 1.0f / l0, ARG(12) + A.L * HW + h * 64, MIX_, rowbase + 64 * c, HW + h * 64, 32, wl, lane);
    attn_store(o1, 1.0f / l1, ARG(12) + A.L * HW + h * 64, MIX_, rowbase + 64 * c + 32, HW + h * 64, 32, wl, lane);
}
constexpr unsigned AU_PCB = 2048, AU_SSB = AU_PCB + 64, AU_SCB = AU_SSB + 64, AU_ALL = AU_SCB + 4096;
__device__ __forceinline__ void attn_phase(const AttnArgs& A, LAS unsigned char* lds) {
    const int tid_ = fresh_tid(), lane = tid_ & 63, wave = __builtin_amdgcn_readfirstlane(tid_ >> 6);
    LAS unsigned char* wl = lds + wave * AW_BYTES;
    unsigned u = 0; if (lane == 0) u = atomicAdd(WS_PTR(unsigned, WS_CTL) + A.L, 1u);
    u = __builtin_amdgcn_readfirstlane(u);
    for (;;) {
        if (u >= AU_ALL) break;
        unsigned un = 0; if (lane == 0) un = atomicAdd(WS_PTR(unsigned, WS_CTL) + A.L, 1u);
        if (u < AU_PCB) { const int bh = u >> 5; cb_unit_p64(A, bh >> 3, bh & 7, 31 - (int)(u & 31), wl, lane); }
        else if (u < AU_SSB) { const unsigned v = u - AU_PCB; sb_unit<true>(A, v >> 3, v & 7, 0, wl, lane); }
        else if (u < AU_SCB) { const unsigned v = u - AU_SSB; cb_unit<true>(A, v >> 3, v & 7, 0, wl, lane); }
        else { const unsigned v = u - AU_SCB; const int bh = v >> 6; sb_unit<false>(A, bh >> 3, bh & 7, 63 - (int)(v & 63), wl, lane); }
        u = __builtin_amdgcn_readfirstlane(un);
    }
}

typedef unsigned gu32_plain;
#define XB_TMO      128
#define XB_XCNT(j)  (256  + 64 * (j))
#define XB_XSUB(j)  (1280 + 64 * (j))
#define XB_XGEN(j)  (2304 + 64 * (j))
#define XB_TOP      3328
#define XB_TOPGEN   3392
#define XCD_BAR_WORDS 3456
#define XB_SPIN_CAP (1u << 18)

__device__ __forceinline__ unsigned xb_ld(unsigned* p)              { return __hip_atomic_load(p, __ATOMIC_RELAXED, __HIP_MEMORY_SCOPE_AGENT); }
__device__ __forceinline__ unsigned xb_add(unsigned* p, unsigned v) { return __hip_atomic_fetch_add(p, v, __ATOMIC_RELAXED, __HIP_MEMORY_SCOPE_AGENT); }
__device__ __forceinline__ unsigned xb_xcc_id() { return (unsigned)__builtin_amdgcn_s_getreg((3 << 11) | 20) & 0xFu; }
#define XB_SPIN(cond, bar) do { unsigned _sp = 0; while (cond) { __builtin_amdgcn_s_sleep(1); \
    if ((++_sp & 255u) == 0u) { if (xb_ld(&(bar)[XB_TMO])) break; if (_sp > XB_SPIN_CAP) { atomicAdd(&(bar)[XB_TMO], 1u); break; } } } } while (0)

struct XcdBarrier {
    unsigned* bar; unsigned x;
    volatile LAS unsigned* st;
};

__device__ __forceinline__ XcdBarrier xcd_barrier_post(unsigned* bar, volatile LAS unsigned* st) {
    XcdBarrier b; b.bar = bar; b.x = xb_xcc_id(); b.st = st;
    if (threadIdx.x == 0) (void)xb_add(&bar[XB_XCNT(b.x)], 1u);
    return b;
}
__device__ __forceinline__ void xcd_barrier_complete(unsigned* bar, unsigned x, unsigned& nloc, unsigned& nx) {
    const unsigned G = gridDim.x * gridDim.y * gridDim.z;
    unsigned sum, cnt, mine, sp = 0u;
    for (;;) {
        sum = 0u; cnt = 0u; mine = 0u;
#pragma unroll
        for (unsigned j = 0; j < 16; ++j) { const unsigned c = xb_ld(&bar[XB_XCNT(j)]); sum += c; cnt += (c > 0u) ? 1u : 0u; mine = (j == x) ? c : mine; }
        if (sum == G) break;
        __builtin_amdgcn_s_sleep(1);
        if ((++sp & 255u) == 0u) { if (xb_ld(&bar[XB_TMO])) break; if (sp > XB_SPIN_CAP) { atomicAdd(&bar[XB_TMO], 1u); break; } }
    }
    nloc = mine > 0u ? mine : 1u; nx = cnt > 0u ? cnt : 1u;
}

__device__ __forceinline__ void xcd_barrier(const XcdBarrier& b) {
    asm volatile("s_waitcnt vmcnt(0)" ::: "memory");
    __syncthreads();
    if (threadIdx.x == 0) {
        unsigned* bar = b.bar;
        __builtin_amdgcn_s_waitcnt(0);
        unsigned nloc = b.st[0], nx = b.st[1];
        if (nloc == 0u) { xcd_barrier_complete(bar, b.x, nloc, nx); b.st[0] = nloc; b.st[1] = nx; }
        const unsigned old = xb_add(&bar[XB_XSUB(b.x)], 1u);
        const unsigned gen = old / nloc;
        if (old + 1u == (gen + 1u) * nloc) {
            __builtin_amdgcn_fence(__ATOMIC_RELEASE, "agent");
            asm volatile("s_waitcnt vmcnt(0)" ::: "memory");
            const unsigned og = xb_add(&bar[XB_TOP], 1u);
            const unsigned tg = og / nx;
            if (og + 1u == (tg + 1u) * nx) xb_add(&bar[XB_TOPGEN], 1u);
            else XB_SPIN(xb_ld(&bar[XB_TOPGEN]) == tg, bar);
            __builtin_amdgcn_fence(__ATOMIC_ACQUIRE, "agent");
            xb_add(&bar[XB_XGEN(b.x)], 1u);
            asm volatile("s_waitcnt vmcnt(0)" ::: "memory");
        } else {
            XB_SPIN(xb_ld(&bar[XB_XGEN(b.x)]) == gen, bar);
            __builtin_amdgcn_fence(__ATOMIC_ACQUIRE, "agent");
            asm volatile("s_waitcnt vmcnt(0)" ::: "memory");
        }
    }
    __syncthreads();
}

__device__ __forceinline__ void p0_item(const float* W, int K, int N, const float* gain, bf16_t* WT, int kind, LAS float* scr, int item, int lane) {
    const int nblk = N / 32, kb = item / nblk, nb = item % nblk, k0 = 64 * kb, n0 = 32 * nb;
#pragma unroll
    for (int i = 0; i < 32; ++i) { const int kk = 2 * i + (lane >> 5); const float g = gain ? gain[k0 + kk] : 1.f; scr[kk * 33 + (lane & 31)] = W[(size_t)(k0 + kk) * N + n0 + (lane & 31)] * g; }
    asm volatile("s_waitcnt lgkmcnt(0)" ::: "memory");
    const int c = lane & 7;
#pragma unroll
    for (int j = 0; j < 4; ++j) { const int n = (lane >> 3) + 8 * j; const LAS float* s = scr + (8 * c) * 33 + n;
        u32x4 o; o.x = pk2(s[0 * 33], s[1 * 33]); o.y = pk2(s[2 * 33], s[3 * 33]); o.z = pk2(s[4 * 33], s[5 * 33]); o.w = pk2(s[6 * 33], s[7 * 33]);
        const int gn = n0 + n; const int drow = kind == 0 ? gn : ((gn >> 7) * 256 + (gn & 127) + (kind == 2 ? 128 : 0));
        *(u32x4*)(WT + (size_t)drow * K + k0 + 8 * c) = o; }
    asm volatile("s_waitcnt lgkmcnt(0)" ::: "memory");
}

#ifdef NO_SGEMM
#define SG(...)
#else
#define SG(...) __VA_ARGS__
#endif
#ifndef GP1
#define GP1(...) __VA_ARGS__
#endif
#ifndef GP2
#define GP2(...) __VA_ARGS__
#endif
#ifndef GP3
#define GP3(...) __VA_ARGS__
#endif
#ifndef GP4
#define GP4(...) __VA_ARGS__
#endif
#ifndef GP5
#define GP5(...) __VA_ARGS__
#endif
#ifndef GP6
#define GP6(...) __VA_ARGS__
#endif
#ifdef NO_SGEMM
#define SG(...)
#else
#define SG(...) __VA_ARGS__
#endif
#ifndef GP1
#define GP1(...) __VA_ARGS__
#endif
#ifndef GP2
#define GP2(...) __VA_ARGS__
#endif
#ifndef GP3
#define GP3(...) __VA_ARGS__
#endif
#ifndef GP4
#define GP4(...) __VA_ARGS__
#endif
#ifndef GP5
#define GP5(...) __VA_ARGS__
#endif
#ifndef GP6
#define GP6(...) __VA_ARGS__
#endif
struct Args { const float* in[22]; float* out; unsigned char* ws; };

#ifndef PROBE_SEL
#define PROBE_SEL -1
#endif
#if PROBE_SEL >= 0
#define TSTAMP(cat) do { if (blockIdx.x == 0 && fresh_tid() == 0) { const unsigned long long t_ = __builtin_amdgcn_s_memrealtime(); unsigned long long* tsb = WS_PTR(unsigned long long, WS_CTL + 4096); \
    tsb[16 + (cat)] += t_ - tsb[0]; tsb[0] = t_; } } while (0)
#else
#define TSTAMP(cat) do {} while (0)
#endif
__global__ void __launch_bounds__(NTHREADS, 2) hymba_fwd(Args args) {
    extern __shared__ __attribute__((aligned(16))) unsigned char lds_raw[];
    cg::grid_group grid = cg::this_grid();
    LAS unsigned char* lds = (LAS unsigned char*)lds_raw;
    const int G = gridDim.x;

#if PROBE_SEL >= 0
    if (blockIdx.x == 0 && fresh_tid() == 0) { unsigned long long* tsb = WS_PTR(unsigned long long, WS_CTL + 4096); for (int i = 0; i < 48; ++i) tsb[i] = 0; tsb[0] = __builtin_amdgcn_s_memrealtime(); }
#endif
    {
        const int tid = fresh_tid(), lane = tid & 63, wave = __builtin_amdgcn_readfirstlane(tid >> 6);
        const int gw = blockIdx.x * NWAVES + wave, NGW = G * NWAVES;
        { float* ssb = SSB; for (int i = blockIdx.x * NTHREADS + tid; i < 6 * MT; i += G * NTHREADS) ssb[MT + i] = 0.f;
          if (blockIdx.x == 0 && tid < 16) WS_PTR(unsigned, WS_CTL)[tid] = 0u;
          if (blockIdx.x == 0) for (int i = tid; i < XCD_BAR_WORDS; i += NTHREADS) WS_PTR(unsigned, WS_BAR)[i] = 0u;
          if (tid < 2) ((LAS unsigned*)(lds + 131072))[tid] = 0u; }
        LAS float* scr = (LAS float*)(lds + wave * 8704);
        constexpr int I_IN = 16 * 96, I_OUT = 16 * 32, I_G = 16 * 88, I_D = 44 * 32, I_PG = 16 * 32, I_PP = 4 * 32, I_L = I_IN + I_OUT + 2 * I_G + I_D + I_PG + I_PP;
        for (int it = gw; it < NLAYER * I_L; it += NGW) {
            const int L = it / I_L; int r = it % I_L;
            if (r < I_IN) { p0_item(ARG(9) + (size_t)L * DM * NQKV, DM, NQKV, ARG(8) + L * DM, (bf16_t*)WPTR(L, W_IN), 0, scr, r, lane); continue; } r -= I_IN;
            if (r < I_OUT) { p0_item(ARG(13) + (size_t)L * DM * DM, DM, DM, nullptr, (bf16_t*)WPTR(L, W_OUT), 0, scr, r, lane); continue; } r -= I_OUT;
            if (r < I_G) { p0_item(ARG(15) + (size_t)L * DM * DFF, DM, DFF, ARG(14) + L * DM, (bf16_t*)WPTR(L, W_GU), 1, scr, r, lane); continue; } r -= I_G;
            if (r < I_G) { p0_item(ARG(16) + (size_t)L * DM * DFF, DM, DFF, ARG(14) + L * DM, (bf16_t*)WPTR(L, W_GU), 2, scr, r, lane); continue; } r -= I_G;
            if (r < I_D) { p0_item(ARG(17) + (size_t)L * DFF * DM, DFF, DM, nullptr, (bf16_t*)WPTR(L, W_DOWN), 0, scr, r, lane); continue; } r -= I_D;
            if (r < I_PG) { p0_item(ARG(19) + (size_t)L * DM * DM, DM, DM, ARG(18) + L * DM, (bf16_t*)WPTR(L, W_PG), 0, scr, r, lane); continue; } r -= I_PG;
            p0_item(ARG(20) + (size_t)L * PLED * DM, PLED, DM, nullptr, (bf16_t*)WPTR(L, W_PP), 0, scr, r, lane);
        }
        { const float* pp = ARG(2); const float* ps = ARG(3); bf16_t* PB = PB_;
          for (int it0 = 4 * gw; it0 < NLAYER * MT; it0 += 4 * NGW) {
            f32x4 v[4];
#pragma unroll
            for (int rr = 0; rr < 4; ++rr) { const int it = it0 + rr, L = it / MT, row = it % MT;
                const float* src = row < MP ? pp + ((size_t)L * MP + row) * PLED : ps + ((size_t)L * MS + (row - MP)) * PLED;
                v[rr] = *((const f32x4*)src + lane); }
#pragma unroll
            for (int rr = 0; rr < 4; ++rr) { u32x2 w; w.x = pk2(v[rr][0], v[rr][1]); w.y = pk2(v[rr][2], v[rr][3]); *((u32x2*)(PB + (size_t)(it0 + rr) * PLED) + lane) = w; }
          } }
        { const float* x_p = ARG(0); const float* x_s = ARG(1); bf16_t* XB = XN_; float* ssb = SSB;
          for (int row0 = 2 * gw; row0 < MT; row0 += 2 * NGW) {
            f32x4 v[2][4];
#pragma unroll
            for (int rr = 0; rr < 2; ++rr) { const int row = row0 + rr; const float* src = row < MP ? x_p + (size_t)row * DM : x_s + (size_t)(row - MP) * DM;
#pragma unroll
                for (int j = 0; j < 4; ++j) v[rr][j] = *((const f32x4*)src + lane + 64 * j); }
#pragma unroll
            for (int rr = 0; rr < 2; ++rr) { float s2 = 0.f;
#pragma unroll
                for (int j = 0; j < 4; ++j) { const f32x4 t = v[rr][j]; s2 += (t[0] * t[0] + t[1] * t[1]) + (t[2] * t[2] + t[3] * t[3]);
                    u32x2 w; w.x = pk2(t[0], t[1]); w.y = pk2(t[2], t[3]); *((u32x2*)(XB + (size_t)(row0 + rr) * DM) + lane + 64 * j) = w; }
                s2 = wave_sum(s2);
                if (lane == 0) ssb[row0 + rr] = s2; }
          } }
    }
    TSTAMP(0); grid.sync(); TSTAMP(8);
    const XcdBarrier xbar = xcd_barrier_post(WS_PTR(unsigned, WS_BAR), (volatile LAS unsigned*)(lds + 131072));
#define GSYNC() xcd_barrier(xbar)

    for (int L = 0; L < NLAYER; ++L) {
#define SS_MIX (SSB + (size_t)(3 * L) * MT)
#define SS_FFN (SSB + (size_t)(3 * L + 1) * MT)
#define SS_PLE (SSB + (size_t)(3 * L + 2) * MT)
#define SS_NEXT (SSB + (size_t)(3 * L + 3) * MT)
        { EpiArgs q{}; q.ss_in = SS_MIX; q.o0 = QKV_;
          q.f_sbk = ARG_OUT + O_SBK_P + (size_t)L * MP * HW; q.f_sbv = ARG_OUT + O_SBV_P + (size_t)L * MP * HW;
          q.f_cbk = ARG_OUT + O_CBK_P + (size_t)L * NBATCH * BANDL * HW; q.f_cbv = ARG_OUT + O_CBV_P + (size_t)L * NBATCH * BANDL * HW;
          pg8::Gemm g{XN_, WPTR(L, W_IN), MP, NQKV, DM}; pg8::StaticOrder S; S.init(MP, NQKV, G, (int)blockIdx.x);
          Epi<EP_QKV> E{q};
          GP1(pg8::gemm_phase<Epi<EP_QKV>, pg8::StaticOrder, true, true>(lds, g, S, E);) TSTAMP(1); }
        { EpiArgs q{}; q.ss_in = SS_MIX; q.o0 = QKV_;
          q.s_sbk = ARG_OUT + O_SBK_S + (size_t)L * MS * HW; q.s_sbv = ARG_OUT + O_SBV_S + (size_t)L * MS * HW;
          q.s_cbk = ARG_OUT + O_CBK_S + (size_t)L * MS * HW; q.s_cbv = ARG_OUT + O_CBV_S + (size_t)L * MS * HW;
          SG(sgemm<EP_QKV, DM>(lds, XN_ + (size_t)MP * DM, WPTR(L, W_IN), NQKV / 32, q);) TSTAMP(7); }
        GSYNC(); TSTAMP(8);
        { AttnArgs A{}; A.L = L;
#ifndef NO_ATTN
          attn_phase(A, lds);
#endif
          TSTAMP(2); }
        GSYNC(); TSTAMP(2);
        { EpiArgs q{}; q.XB = XB_; q.xbase = XN_; q.ss_out = SS_FFN;
          pg8::Gemm g{MIX_, WPTR(L, W_OUT), MP, DM, DM}; pg8::StaticOrder S; S.init(MP, DM, G, (int)blockIdx.x);
          Epi<EP_RES> E{q};
          GP2(pg8::gemm_phase<Epi<EP_RES>, pg8::StaticOrder, true, true>(lds, g, S, E);) TSTAMP(3); }
        { EpiArgs q{}; q.XB = XB_; q.xbase = XN_; q.ss_out = SS_FFN;
          SG(sgemm<EP_RES, DM>(lds, MIX_ + (size_t)MP * DM, WPTR(L, W_OUT), DM / 32, q);) TSTAMP(7); }
        GSYNC(); TSTAMP(8);
        { EpiArgs q{}; q.ss_in = SS_FFN; q.o0 = HB_;
          pg8::Gemm g{XB_, WPTR(L, W_GU), MP, 2 * DFF, DM}; pg8::StaticOrder S; S.init(MP, 2 * DFF, G, (int)blockIdx.x);
          Epi<EP_GU> E{q};
          GP4(pg8::gemm_phase<Epi<EP_GU>, pg8::StaticOrder, true, true>(lds, g, S, E);) TSTAMP(4);
          SG(sgemm<EP_GU, DM>(lds, XB_ + (size_t)MP * DM, WPTR(L, W_GU), DFF / 32, q);) TSTAMP(7); }
        { EpiArgs q2{}; q2.o0 = PBUF_;
          int kp = PLED; asm volatile("" : "+s"(kp));
          const int Gh = G >> 1;
          if ((int)blockIdx.x >= Gh) {
            pg8::Gemm g2{PB_ + (size_t)L * MT * PLED, WPTR(L, W_PP), MP, DM, kp}; pg8::StaticOrder S; S.init(MP, DM, G - Gh, (int)blockIdx.x - Gh);
            Epi<EP_P> E2{q2};
            GP3(pg8::gemm_phase<Epi<EP_P>, pg8::StaticOrder, true, true>(lds, g2, S, E2);) TSTAMP(10);
          }
          SG(sgemm<EP_P, PLED>(lds, PB_ + ((size_t)L * MT + MP) * PLED, WPTR(L, W_PP), DM / 32, q2);) TSTAMP(7); }
        GSYNC(); TSTAMP(8);
        { EpiArgs q{}; q.XB = XB_; q.xbase = XB_; q.ss_out = SS_PLE;
          pg8::Gemm g{HB_, WPTR(L, W_DOWN), MP, DM, DFF}; pg8::StaticOrder S; S.init(MP, DM, G, (int)blockIdx.x);
          Epi<EP_RES> E{q};
          GP5(pg8::gemm_phase<Epi<EP_RES>, pg8::StaticOrder, true, true>(lds, g, S, E);) TSTAMP(5);
          SG(sgemm<EP_RES, DFF>(lds, HB_ + (size_t)MP * DFF, WPTR(L, W_DOWN), DM / 32, q);) TSTAMP(7); }
        GSYNC(); TSTAMP(8);
        { EpiArgs q{}; q.XB = XN_  ; q.P = PBUF_; q.xbase = XB_; q.ss_in = SS_PLE; q.ss_out = SS_NEXT;
          pg8::Gemm g{XB_, WPTR(L, W_PG), MP, DM, DM}; pg8::StaticOrder S; S.init(MP, DM, G, (int)blockIdx.x);
          Epi<EP_PLE> E{q};
          GP6(pg8::gemm_phase<Epi<EP_PLE>, pg8::StaticOrder, true, true>(lds, g, S, E);) TSTAMP(6);
          SG(sgemm<EP_PLE, DM>(lds, XB_ + (size_t)MP * DM, WPTR(L, W_PG), DM / 32, q);) TSTAMP(7); }
        GSYNC(); TSTAMP(8);
    }
    {
        const int tid = fresh_tid(), lane = tid & 63, wave = __builtin_amdgcn_readfirstlane(tid >> 6);
        const int gw = blockIdx.x * NWAVES + wave, NGW = G * NWAVES;
        const float* ssf = SSB + (size_t)(3 * NLAYER) * MT; const float* gf = ARG(21); const bf16_t* XN = XN_; float* out = ARG_OUT;
        for (int row0 = 2 * gw; row0 < MT; row0 += 2 * NGW) {
            u32x2 xv[2][4];
#pragma unroll
            for (int rr = 0; rr < 2; ++rr)
#pragma unroll
                for (int j = 0; j < 4; ++j) xv[rr][j] = *((const u32x2*)(XN + (size_t)(row0 + rr) * DM) + lane + 64 * j);
#pragma unroll
            for (int rr = 0; rr < 2; ++rr) { const int row = row0 + rr; const float rs = rstd_of(ssf[row]);
                float* dst = row < MP ? out + O_YP + (size_t)row * DM : out + O_YS + (size_t)(row - MP) * DM;
#pragma unroll
                for (int j = 0; j < 4; ++j) { const f32x4 gv = *((const f32x4*)gf + lane + 64 * j); const u32x2 w = xv[rr][j];
                    const f32x4 v = {bf_lo(w.x), bf_hi(w.x), bf_lo(w.y), bf_hi(w.y)};
                    *((f32x4*)dst + lane + 64 * j) = v * rs * gv; } }
        }
    }
#if PROBE_SEL >= 0
    TSTAMP(11); grid.sync();
    if (blockIdx.x == 0 && fresh_tid() == 0) { const unsigned long long* tsb = WS_PTR(unsigned long long, WS_CTL + 4096); float* o = ARG_OUT + O_YS; unsigned long long tv = 0; if (PROBE_SEL == 20) tv = tsb[16+1] + tsb[16+3] + tsb[16+10] + tsb[16+4] + tsb[16+5] + tsb[16+6]; else if (PROBE_SEL == 21) tv = tsb[16+0] + tsb[16+11]; else if (PROBE_SEL < 16) tv = tsb[16 + PROBE_SEL]; o[0] += (float)tv * 2.5e-5f; }
#endif
}

extern "C" void kernel_launch(void* const* d_in, const int* in_sizes, int n_in, void* d_out, int out_size, void* d_ws, size_t ws_size, hipStream_t stream) {
    static int grid = 0;
    if (grid == 0) {
        int dev = 0, cus = 0, per_cu = 0;
        hipGetDevice(&dev);
        hipDeviceGetAttribute(&cus, hipDeviceAttributeMultiprocessorCount, dev);
        hipFuncSetAttribute((const void*)hymba_fwd, hipFuncAttributeMaxDynamicSharedMemorySize, LDS_BYTES);
        hipOccupancyMaxActiveBlocksPerMultiprocessor(&per_cu, (const void*)hymba_fwd, NTHREADS, LDS_BYTES);
        if (per_cu < 1) per_cu = 1;
        grid = cus * per_cu;
        if (n_in != 22 || ws_size < WS_END) { fprintf(stderr, "kernel_launch: unexpected n_in %d / ws_size %zu\n", n_in, ws_size); }
    }
    Args a{};
    for (int i = 0; i < 22; ++i) a.in[i] = (const float*)d_in[i];
    a.out = (float*)d_out; a.ws = (unsigned char*)d_ws;
    void* kargs[] = {&a};
    hipError_t e = hipLaunchCooperativeKernel((const void*)hymba_fwd, dim3(grid), dim3(NTHREADS), kargs, LDS_BYTES, stream);
    if (e != hipSuccess) fprintf(stderr, "cooperative launch failed: %s (grid %d)\n", hipGetErrorString(e), grid);
}
```

```cpp
#include <hip/hip_runtime.h>
#include <hip/hip_cooperative_groups.h>
#include <cstdio>
#include <cstdint>
namespace cg = cooperative_groups;
__device__ __forceinline__ int fresh_tid() { int t = threadIdx.x; asm volatile("" : "+v"(t)); return t; }
namespace pg8 {
#define PG8_LAS __attribute__((address_space(3)))
typedef unsigned short bf16_t;
typedef short bf16x8 __attribute__((ext_vector_type(8)));
typedef float f32x4 __attribute__((ext_vector_type(4)));
typedef unsigned u32x4 __attribute__((ext_vector_type(4)));
constexpr int BM = 256, BK = 64, HALF = 128, HTB = HALF * BK * 2  , STAGE_BYTES = 8 * HTB, NXCD = 8, WGM = 8;

__host__ __device__ __forceinline__ int lds_byte(int r, int c) { const int st = (r >> 4) * 2 + (c >> 5), rr = r & 15, cc = c & 31, ob = rr * 64 + cc * 2; return st * 1024 + (ob ^ (((ob >> 9) & 1) << 5)); }
__host__ __device__ __forceinline__ void stage_rc(int b, int& R, int& C) { const int st = b / 1024, sb = b % 1024, swz = sb ^ (((sb >> 9) & 1) << 5); R = (st >> 1) * 16 + swz / 64; C = (st & 1) * 32 + (swz % 64) / 2; }
__host__ __device__ __forceinline__ int perm32(int rho) { const int n = rho >> 4, i = rho & 15; return 8 * (i >> 2) + 4 * n + (i & 3); }

struct Unit { int pm, pn; };
struct Gemm { const bf16_t* A; const bf16_t* Bt; int M, N, K; };

struct StaticOrder {
    int nM, nN, nwg, G, c;
    __host__ __device__ void init(int M, int N, int G_, int c_) { nM = M / BM; nN = N / BM; nwg = nM * nN; G = G_; c = c_; }
    __host__ __device__ bool next(int i, Unit& u) const {
        const long L = (long)i * G + c; if (L >= nwg) return false;
        int wgid = (int)L; { const int q = nwg / NXCD, r = nwg % NXCD, xcd = wgid % NXCD, off = wgid / NXCD; wgid = (xcd < r ? xcd * (q + 1) : r * (q + 1) + (xcd - r) * q) + off; }
        const int nig = WGM * nN, gid = wgid / nig, fm = gid * WGM, gsz = (nM - fm) < WGM ? (nM - fm) : WGM;
        u.pm = fm + ((wgid % nig) % gsz); u.pn = (wgid % nig) / gsz; return true;
    }
    __device__ __forceinline__ void a_ready(const Unit&) const {}
    __device__ __forceinline__ void done(const Unit&) const {}
};

template <class Epi, class Sched, bool ALIGN_EPI = false, bool SP2 = false>
__device__ __forceinline__ void gemm_phase(PG8_LAS unsigned char* lds, const Gemm g, const Sched& S, const Epi& E) {
    const int tid = fresh_tid(), wid = __builtin_amdgcn_readfirstlane(tid >> 6), lane = tid & 63, wr = wid >> 2, wc = wid & 3, fr = lane & 15, fq = lane >> 4;
    const int K = g.K, nt = K / BK;
    unsigned voffA[2], voffB[2];
#pragma unroll
    for (int i = 0; i < 2; ++i) { int R, C; stage_rc(tid * 16 + i * 8192, R, C); const int Rb = Epi::PERM ? ((R & ~31) + perm32(R & 31)) : R;
        voffA[i] = (unsigned)(R * K + C) * 2u; voffB[i] = (unsigned)(Rb * K + C) * 2u; }
    const size_t kstep = (size_t)(BK * 2);
    const size_t hstep = (size_t)HALF * K * 2;
    const size_t tstep = 2 * hstep;
    const unsigned ldsw = (unsigned)wid * 1024u;
    const int aoff = lds_byte(wr * 64 + fr, fq * 8), boff = lds_byte(wc * 32 + fr, fq * 8);
#define PG8_SA(b, h) (((b) * 2 + (h)) * HTB)
#define PG8_SB(b, h) ((4 + (b) * 2 + (h)) * HTB)
#define PG8_STAGE(bufoff, gbase, voff) do { _Pragma("unroll") for (int _i = 0; _i < 2; ++_i) \
        __builtin_amdgcn_global_load_lds((const unsigned*)((const char*)(gbase) + (voff)[_i]), (PG8_LAS unsigned*)(lds + (bufoff) + ldsw + _i * 8192), 16, 0, 0); } while (0)
#define PG8_LDA(dst, b, h) do { _Pragma("unroll") for (int m = 0; m < 4; ++m) _Pragma("unroll") for (int k = 0; k < 2; ++k) dst[m][k] = *(const PG8_LAS bf16x8*)(lds + PG8_SA(b, h) + aoff + m * 2048 + k * 1024); } while (0)
#define PG8_LDB(dst, b, h) do { _Pragma("unroll") for (int n = 0; n < 2; ++n) _Pragma("unroll") for (int k = 0; k < 2; ++k) dst[n][k] = *(const PG8_LAS bf16x8*)(lds + PG8_SB(b, h) + boff + n * 2048 + k * 1024); } while (0)
#define PG8_MMA(ai, bj, At, Bt) do { __builtin_amdgcn_s_setprio(1); _Pragma("unroll") for (int m = 0; m < 4; ++m) _Pragma("unroll") for (int n = 0; n < 2; ++n) _Pragma("unroll") for (int k = 0; k < 2; ++k) \
        acc[ai][bj][m][n] = __builtin_amdgcn_mfma_f32_16x16x32_bf16(Bt[n][k], At[m][k], acc[ai][bj][m][n], 0, 0, 0); __builtin_amdgcn_s_setprio(0); } while (0)
#define PG8_WAIT_V(n) asm volatile("s_waitcnt vmcnt(" #n ")" ::: "memory")
#define PG8_WAIT_L(n) asm volatile("s_waitcnt lgkmcnt(" #n ")" ::: "memory")
#define PG8_BAR __builtin_amdgcn_s_barrier()
#define PG8_SCHED __builtin_amdgcn_sched_barrier(0)
    Unit cur, nxt; int ui = 0;
    if (!S.next(0, cur)) return;
    f32x4 acc[2][2][4][2];
#pragma unroll
    for (int a = 0; a < 2; ++a)
#pragma unroll
        for (int b = 0; b < 2; ++b)
#pragma unroll
            for (int m = 0; m < 4; ++m)
#pragma unroll
                for (int n = 0; n < 2; ++n) acc[a][b][m][n] = (f32x4){0.f, 0.f, 0.f, 0.f};
    bf16x8 At[4][2], B0[2][2], B1[2][2];
    const char* cA = (const char*)g.A + (size_t)cur.pm * tstep; const char* cB = (const char*)g.Bt + (size_t)cur.pn * tstep;
    S.a_ready(cur);
    if constexpr (SP2) {
        PG8_STAGE(PG8_SB(0, 0), cB, voffB); PG8_STAGE(PG8_SB(0, 1), cB + hstep, voffB); PG8_STAGE(PG8_SA(0, 0), cA, voffA); PG8_STAGE(PG8_SA(0, 1), cA + hstep, voffA);
        if (wr == 1) PG8_BAR;
        PG8_WAIT_V(2); PG8_BAR;
        PG8_STAGE(PG8_SB(1, 0), cB + kstep, voffB); PG8_STAGE(PG8_SA(1, 0), cA + kstep, voffA); PG8_STAGE(PG8_SB(1, 1), cB + hstep + kstep, voffB);
        PG8_WAIT_V(6); PG8_BAR;
    } else {
        PG8_STAGE(PG8_SB(0, 0), cB, voffB); PG8_STAGE(PG8_SA(0, 0), cA, voffA); PG8_STAGE(PG8_SB(0, 1), cB + hstep, voffB); PG8_STAGE(PG8_SA(0, 1), cA + hstep, voffA);
        if (wr == 1) PG8_BAR;
        PG8_WAIT_V(4); PG8_BAR;
        PG8_STAGE(PG8_SB(1, 0), cB + kstep, voffB); PG8_STAGE(PG8_SA(1, 0), cA + kstep, voffA); PG8_STAGE(PG8_SB(1, 1), cB + hstep + kstep, voffB);
        PG8_WAIT_V(6); PG8_BAR;
    }
    for (;;) {
        const bool has_next = S.next(ui + 1, nxt);
        const char* nA = has_next ? (const char*)g.A + (size_t)nxt.pm * tstep : cA; const char* nB = has_next ? (const char*)g.Bt + (size_t)nxt.pn * tstep : cB;
        for (int t = 0; t < nt; t += 2) {
            const bool last = (t == nt - 2);
            const char* a1 = cA + (size_t)(t + 1) * kstep;
            const char* a2 = last ? nA : cA + (size_t)(t + 2) * kstep; const char* b2 = last ? nB : cB + (size_t)(t + 2) * kstep;
            const char* a3 = a2 + kstep; const char* b3 = b2 + kstep;
            if (last && has_next) S.a_ready(nxt);
            if constexpr (SP2) {
            PG8_LDB(B0, 0, 0); PG8_LDB(B1, 0, 1); PG8_SCHED; PG8_LDA(At, 0, 0); PG8_STAGE(PG8_SA(1, 1), a1 + hstep, voffA);
            PG8_WAIT_V(8); PG8_WAIT_L(0); PG8_BAR; PG8_MMA(0, 0, At, B0); PG8_MMA(0, 1, At, B1); PG8_BAR; PG8_SCHED;
            PG8_LDA(At, 0, 1); PG8_STAGE(PG8_SB(0, 0), b2, voffB); PG8_STAGE(PG8_SB(0, 1), b2 + hstep, voffB); PG8_STAGE(PG8_SA(0, 0), a2, voffA);
            PG8_WAIT_V(8); PG8_WAIT_L(0); PG8_BAR; PG8_MMA(1, 0, At, B0); PG8_MMA(1, 1, At, B1); PG8_BAR; PG8_SCHED;
            PG8_LDB(B0, 1, 0); PG8_LDB(B1, 1, 1); PG8_SCHED; PG8_LDA(At, 1, 0); PG8_STAGE(PG8_SA(0, 1), a2 + hstep, voffA);
            PG8_WAIT_V(8); PG8_WAIT_L(0); PG8_BAR; PG8_MMA(0, 0, At, B0); PG8_MMA(0, 1, At, B1); PG8_BAR; PG8_SCHED;
            PG8_LDA(At, 1, 1); PG8_STAGE(PG8_SB(1, 0), b3, voffB); PG8_STAGE(PG8_SB(1, 1), b3 + hstep, voffB); PG8_STAGE(PG8_SA(1, 0), a3, voffA);
            PG8_WAIT_V(8); PG8_WAIT_L(0); PG8_BAR; PG8_MMA(1, 0, At, B0); PG8_MMA(1, 1, At, B1); PG8_BAR; PG8_SCHED;
            } else {
            PG8_LDB(B0, 0, 0); PG8_SCHED; PG8_LDA(At, 0, 0); PG8_STAGE(PG8_SA(1, 1), a1 + hstep, voffA);
            PG8_WAIT_L(8); PG8_BAR; PG8_WAIT_L(0); PG8_MMA(0, 0, At, B0); PG8_BAR; PG8_SCHED;
            PG8_LDB(B1, 0, 1); PG8_STAGE(PG8_SB(0, 0), b2, voffB);
            PG8_BAR; PG8_WAIT_L(0); PG8_MMA(0, 1, At, B1); PG8_BAR;
            PG8_LDA(At, 0, 1); PG8_STAGE(PG8_SA(0, 0), a2, voffA);
            PG8_BAR; PG8_WAIT_L(0); PG8_MMA(1, 0, At, B0); PG8_BAR; PG8_SCHED;
            PG8_STAGE(PG8_SB(0, 1), b2 + hstep, voffB);
            PG8_WAIT_V(6); PG8_BAR; PG8_MMA(1, 1, At, B1); PG8_BAR;
            PG8_LDB(B0, 1, 0); PG8_SCHED; PG8_LDA(At, 1, 0); PG8_STAGE(PG8_SA(0, 1), a2 + hstep, voffA);
            PG8_WAIT_L(8); PG8_BAR; PG8_WAIT_L(0); PG8_MMA(0, 0, At, B0); PG8_BAR; PG8_SCHED;
            PG8_LDB(B1, 1, 1); PG8_STAGE(PG8_SB(1, 0), b3, voffB);
            PG8_BAR; PG8_WAIT_L(0); PG8_MMA(0, 1, At, B1); PG8_BAR;
            PG8_LDA(At, 1, 1); PG8_STAGE(PG8_SA(1, 0), a3, voffA);
            PG8_BAR; PG8_WAIT_L(0); PG8_MMA(1, 0, At, B0); PG8_BAR; PG8_SCHED;
            PG8_STAGE(PG8_SB(1, 1), b3 + hstep, voffB);
            PG8_WAIT_V(6); PG8_BAR; PG8_MMA(1, 1, At, B1); PG8_BAR;
            }
        }
        if constexpr (ALIGN_EPI) { if (wr == 0) PG8_BAR; }
        if constexpr (!Epi::AFTER_DRAIN) { E(acc, cur, wr, wc, fr, fq); S.done(cur); }
        if (!has_next) break;
#pragma unroll
        for (int a = 0; a < 2; ++a)
#pragma unroll
            for (int b = 0; b < 2; ++b)
#pragma unroll
                for (int m = 0; m < 4; ++m)
#pragma unroll
                    for (int n = 0; n < 2; ++n) acc[a][b][m][n] = (f32x4){0.f, 0.f, 0.f, 0.f};
        cur = nxt; cA = nA; cB = nB; ++ui;
        if constexpr (ALIGN_EPI) { if (wr == 1) PG8_BAR; }
    }
    PG8_WAIT_V(0);
    if constexpr (!ALIGN_EPI) { if (wr == 0) PG8_BAR; }
    PG8_BAR;
    if constexpr (Epi::AFTER_DRAIN) { E.fused(acc, cur, wr, wc, fr, fq, lds, wid, lane); S.done(cur); }
#undef PG8_SA
#undef PG8_SB
#undef PG8_STAGE
#undef PG8_LDA
#undef PG8_LDB
#undef PG8_MMA
#undef PG8_WAIT_V
#undef PG8_WAIT_L
#undef PG8_BAR
#undef PG8_SCHED
}
}

#define LAS __attribute__((address_space(3)))
using pg8::bf16_t; using pg8::bf16x8; using pg8::f32x4; using pg8::u32x4;
typedef short s16x4 __attribute__((ext_vector_type(4)));
typedef float f32x16 __attribute__((ext_vector_type(16)));
typedef unsigned u32x2 __attribute__((ext_vector_type(2)));
typedef float f32x2_t __attribute__((ext_vector_type(2)));
typedef __bf16 bf16x2_t __attribute__((ext_vector_type(2)));

constexpr int DM = 1024, SEQ = 2048, NBATCH = 8, MP = NBATCH * SEQ, DSEQ = 16, MS = NBATCH * DSEQ, MT = MP + MS;
constexpr int DFF = 2816, NQKV = 3072, PLED = 256, NLAYER = 2, PAST = 2048, BANDL = 512, HW = 512;
constexpr float EPS = 1e-6f, LOG2E = 1.4426950408889634f, QSCALE = 0.125f * LOG2E;
#ifndef SB_EARLY
#define SB_EARLY 1
#endif
constexpr float SB_THR = 7.5e-37f;

constexpr size_t MiB = 1u << 20;
constexpr size_t WS_CTL = 0, WS_SS = 64 * 1024;
constexpr size_t WS_W = 2 * MiB, W_LSTRIDE = 28 * MiB, W_IN = 0, W_OUT = 6 * MiB, W_GU = 8 * MiB, W_DOWN = 19 * MiB, W_PG = 25 * MiB, W_PP = 27 * MiB;
constexpr size_t WS_PB = 58 * MiB, WS_X = 76 * MiB  , WS_XB = 142 * MiB, WS_QKV = 176 * MiB, WS_MIX = 274 * MiB, WS_P = 308 * MiB, WS_END = 342 * MiB;
constexpr int LDS_BYTES = 131072 + 1024;
constexpr size_t WS_BAR = 8192;
constexpr int NWAVES = 8, NTHREADS = 512;

constexpr size_t O_YP = 0, O_YS = (size_t)MP * DM, O_SBK_P = O_YS + (size_t)MS * DM, O_SBV_P = O_SBK_P + (size_t)NLAYER * MP * HW,
                 O_CBK_P = O_SBV_P + (size_t)NLAYER * MP * HW, O_CBV_P = O_CBK_P + (size_t)NLAYER * NBATCH * BANDL * HW,
                 O_SBK_S = O_CBV_P + (size_t)NLAYER * NBATCH * BANDL * HW, O_SBV_S = O_SBK_S + (size_t)NLAYER * MS * HW,
                 O_CBK_S = O_SBV_S + (size_t)NLAYER * MS * HW, O_CBV_S = O_CBK_S + (size_t)NLAYER * MS * HW;

__device__ __forceinline__ unsigned pk2(float lo, float hi) { f32x2_t v = {lo, hi}; bf16x2_t b = __builtin_convertvector(v, bf16x2_t); return __builtin_bit_cast(unsigned, b); }
__device__ __forceinline__ float bf_lo(unsigned w) { return __uint_as_float(w << 16); }
__device__ __forceinline__ float bf_hi(unsigned w) { return __uint_as_float(w & 0xffff0000u); }
__device__ __forceinline__ float partner32(float v) {
    auto rr = __builtin_amdgcn_permlane32_swap(__float_as_uint(v), __float_as_uint(v), false, false);
    return (threadIdx.x & 32) ? __uint_as_float(rr[0]) : __uint_as_float(rr[1]);
}
__device__ __forceinline__ float wave_sum(float v) {
#pragma unroll
    for (int o = 1; o < 64; o <<= 1) v += __shfl_xor(v, o);
    return v;
}
__device__ __forceinline__ float rstd_of(float ss) { return rsqrtf(ss * (1.0f / DM) + EPS); }

template <int I> __device__ __forceinline__ const float* argp() {
    unsigned long long v; const void* ka = (const void*)__builtin_amdgcn_kernarg_segment_ptr();
    asm volatile("s_load_dwordx2 %0, %1, %2\n\ts_waitcnt lgkmcnt(0)" : "=s"(v) : "s"(ka), "i"(I * 8) : "memory");
    return (const float*)(const __attribute__((address_space(1))) float*)v;
}
#define ARG(i) argp<i>()
#define ARG_OUT ((float*)argp<22>())
#define ARG_WS ((unsigned char*)argp<23>())
#define WS_PTR(T, off) ((T*)(ARG_WS + (off)))
#define SSB WS_PTR(float, WS_SS)
#define PB_ WS_PTR(bf16_t, WS_PB)
#define XN_ WS_PTR(bf16_t, WS_X)
#define XB_ WS_PTR(bf16_t, WS_XB)
#define QKV_ WS_PTR(bf16_t, WS_QKV)
#define HB_ WS_PTR(bf16_t, WS_QKV)
#define MIX_ WS_PTR(bf16_t, WS_MIX)
#define PBUF_ WS_PTR(bf16_t, WS_P)
#define WPTR(L, off) ((const bf16_t*)(ARG_WS + WS_W + (size_t)(L) * W_LSTRIDE + (off)))

enum { EP_QKV = 0, EP_RES = 1, EP_GU = 2, EP_P = 3, EP_PLE = 4 };
struct EpiArgs {
    const float* ss_in; float* ss_out;
    const bf16_t* xbase;
    bf16_t* XB; bf16_t* o0; const bf16_t* P;
    float *f_sbk, *f_sbv, *f_cbk, *f_cbv;
    float *s_sbk, *s_sbv, *s_cbk, *s_cbv;
};
template <int MODE> struct Epi {
    static constexpr bool PERM = false, AFTER_DRAIN = false;
    EpiArgs a;
    __device__ __forceinline__ void operator()(const f32x4 (&acc)[2][2][4][2], const pg8::Unit& u, int wr, int wc, int fr, int fq) const {
        if constexpr (MODE == EP_QKV) {
            const int part = u.pn >> 1, cb = (u.pn & 1) * 256 + wc * 32 + 4 * fq;
            bf16_t* ob = a.o0 + (size_t)part * ((size_t)MT * HW);
            float* fo = part == 1 ? a.f_sbk : part == 2 ? a.f_sbv : part == 4 ? a.f_cbk : part == 5 ? a.f_cbv : nullptr;
            const bool band = part >= 4; const float qs = (part == 0 || part == 3) ? QSCALE : 1.f;
#pragma unroll
            for (int ai = 0; ai < 2; ++ai)
#pragma unroll
                for (int m = 0; m < 4; ++m) {
                    const int row = u.pm * 256 + ai * 128 + wr * 64 + m * 16 + fr;
                    const float rs = rstd_of(a.ss_in[row]) * qs;
                    const int t = row & (SEQ - 1);
                    float* frow = nullptr;
                    if (fo) { if (!band) frow = fo + (size_t)row * HW; else if (t >= SEQ - BANDL) frow = fo + ((size_t)(row >> 11) * BANDL + (t - (SEQ - BANDL))) * HW; }
#pragma unroll
                    for (int bj = 0; bj < 2; ++bj)
#pragma unroll
                        for (int n = 0; n < 2; ++n) {
                            const int col = cb + bj * 128 + n * 16; const f32x4 v = acc[ai][bj][m][n] * rs;
                            u32x2 w; w.x = pk2(v[0], v[1]); w.y = pk2(v[2], v[3]);
                            *(u32x2*)(ob + (size_t)row * HW + col) = w;
                            if (frow) *(f32x4*)(frow + col) = v;
                        }
                }
        } else if constexpr (MODE == EP_RES || MODE == EP_PLE) {
#pragma unroll
            for (int ai = 0; ai < 2; ++ai)
#pragma unroll
                for (int m = 0; m < 4; ++m) {
                    const int row = u.pm * 256 + ai * 128 + wr * 64 + m * 16 + fr;
                    float rs = 0.f; if constexpr (MODE == EP_PLE) rs = rstd_of(a.ss_in[row]) * (-LOG2E);
                    float s = 0.f;
#pragma unroll
                    for (int bj = 0; bj < 2; ++bj)
#pragma unroll
                        for (int n = 0; n < 2; ++n) {
                            const size_t off = (size_t)row * DM + u.pn * 256 + bj * 128 + wc * 32 + n * 16 + 4 * fq;
                            const u32x2 xw = *(const u32x2*)(a.xbase + off); f32x4 x = {bf_lo(xw.x), bf_hi(xw.x), bf_lo(xw.y), bf_hi(xw.y)}; const f32x4 c = acc[ai][bj][m][n];
                            if constexpr (MODE == EP_RES) x += c;
                            else { const u32x2 pw = *(const u32x2*)(a.P + off);
                                   x[0] += bf_lo(pw.x) * __builtin_amdgcn_rcpf(1.f + __builtin_amdgcn_exp2f(c[0] * rs));
                                   x[1] += bf_hi(pw.x) * __builtin_amdgcn_rcpf(1.f + __builtin_amdgcn_exp2f(c[1] * rs));
                                   x[2] += bf_lo(pw.y) * __builtin_amdgcn_rcpf(1.f + __builtin_amdgcn_exp2f(c[2] * rs));
                                   x[3] += bf_hi(pw.y) * __builtin_amdgcn_rcpf(1.f + __builtin_amdgcn_exp2f(c[3] * rs)); }
                            u32x2 w; w.x = pk2(x[0], x[1]); w.y = pk2(x[2], x[3]); *(u32x2*)(a.XB + off) = w;
                            s += (x[0] * x[0] + x[1] * x[1]) + (x[2] * x[2] + x[3] * x[3]);
                        }
                    s += __shfl_xor(s, 16); s += __shfl_xor(s, 32);
                    if (fq == 0) unsafeAtomicAdd(a.ss_out + row, s);
                }
        } else if constexpr (MODE == EP_GU) {
#pragma unroll
            for (int ai = 0; ai < 2; ++ai)
#pragma unroll
                for (int m = 0; m < 4; ++m) {
                    const int row = u.pm * 256 + ai * 128 + wr * 64 + m * 16 + fr;
                    const float rs = rstd_of(a.ss_in[row]);
#pragma unroll
                    for (int n = 0; n < 2; ++n) {
                        const int col = u.pn * 128 + wc * 32 + n * 16 + 4 * fq;
                        const f32x4 g = acc[ai][0][m][n] * rs, up = acc[ai][1][m][n] * rs; float h[4];
#pragma unroll
                        for (int e = 0; e < 4; ++e) h[e] = g[e] * up[e] * __builtin_amdgcn_rcpf(1.f + __builtin_amdgcn_exp2f(-LOG2E * g[e]));
                        u32x2 w; w.x = pk2(h[0], h[1]); w.y = pk2(h[2], h[3]);
                        *(u32x2*)(a.o0 + (size_t)row * DFF + col) = w;
                    }
                }
        } else {
#pragma unroll
            for (int ai = 0; ai < 2; ++ai)
#pragma unroll
                for (int m = 0; m < 4; ++m) {
                    const int row = u.pm * 256 + ai * 128 + wr * 64 + m * 16 + fr;
#pragma unroll
                    for (int bj = 0; bj < 2; ++bj)
#pragma unroll
                        for (int n = 0; n < 2; ++n) {
                            const size_t off = (size_t)row * DM + u.pn * 256 + bj * 128 + wc * 32 + n * 16 + 4 * fq; const f32x4 v = acc[ai][bj][m][n];
                            u32x2 w; w.x = pk2(v[0], v[1]); w.y = pk2(v[2], v[3]); *(u32x2*)(a.o0 + off) = w;
                        }
                }
        }
    }
};

template <int MODE, int K>
__device__ __forceinline__ void sgemm(LAS unsigned char* lds, const bf16_t* A, const bf16_t* Bt, int ncol32, const EpiArgs& a) {
    const int tid = fresh_tid(), lane = tid & 63, wave = __builtin_amdgcn_readfirstlane(tid >> 6), r = lane & 31, hh = lane >> 5;
    LAS float* red = (LAS float*)lds;
    constexpr int K8 = K >> 3, NK = K8 / 16, UB = NK > 11 ? 11 : NK;
    static_assert(NK % UB == 0, "sgemm: K split");
    const int G = gridDim.x, nunits = 4 * ncol32;
    for (int j = G - 1 - (int)blockIdx.x; j < nunits; j += G) {
        const int rb = j & 3, c0 = 32 * (j >> 2);
        const int brow0 = (MODE == EP_GU) ? ((c0 >> 7) * 256 + (c0 & 127)) : c0;
        const bf16_t* ap = A + (size_t)(32 * rb + r) * K + wave * K8 + 8 * hh;
        const bf16_t* bp = Bt + (size_t)(brow0 + r) * K + wave * K8 + 8 * hh;
        f32x16 acc0 = {}, acc1 = {};
#pragma unroll 1
        for (int kb = 0; kb < NK; kb += UB) {
            bf16x8 af[UB], bf[UB], bf2[MODE == EP_GU ? UB : 1];
#pragma unroll
            for (int i = 0; i < UB; ++i) { af[i] = *(const bf16x8*)(ap + (kb + i) * 16); bf[i] = *(const bf16x8*)(bp + (kb + i) * 16);
                if constexpr (MODE == EP_GU) bf2[i] = *(const bf16x8*)(bp + (size_t)128 * K + (kb + i) * 16); }
#pragma unroll
            for (int i = 0; i < UB; ++i) { acc0 = __builtin_amdgcn_mfma_f32_32x32x16_bf16(af[i], bf[i], acc0, 0, 0, 0);
                if constexpr (MODE == EP_GU) acc1 = __builtin_amdgcn_mfma_f32_32x32x16_bf16(af[i], bf2[i], acc1, 0, 0, 0); }
        }
#pragma unroll
        for (int i = 0; i < 16; ++i) { red[(wave * 16 + i) * 64 + lane] = acc0[i]; if constexpr (MODE == EP_GU) red[8192 + (wave * 16 + i) * 64 + lane] = acc1[i]; }
        __syncthreads();
        const int col = c0 + r;
#pragma unroll
        for (int ii = 0; ii < 2; ++ii) {
            const int i = 2 * wave + ii;
            float v0 = 0.f, v1 = 0.f;
#pragma unroll
            for (int w = 0; w < 8; ++w) { v0 += red[(w * 16 + i) * 64 + lane]; if constexpr (MODE == EP_GU) v1 += red[8192 + (w * 16 + i) * 64 + lane]; }
            const int rs_ = 32 * rb + (i & 3) + 8 * (i >> 2) + 4 * hh, row = MP + rs_;
            if constexpr (MODE == EP_QKV) {
                const int part = c0 >> 9, cc = col & 511;
                const float v = v0 * rstd_of(a.ss_in[row]);
                const float qs = (part == 0 || part == 3) ? QSCALE : 1.f;
                (a.o0 + (size_t)part * ((size_t)MT * HW))[(size_t)row * HW + cc] = (bf16_t)(pk2(v * qs, 0.f) & 0xffffu);
                float* fo = part == 1 ? a.s_sbk : part == 2 ? a.s_sbv : part == 4 ? a.s_cbk : part == 5 ? a.s_cbv : nullptr;
                if (fo) fo[(size_t)rs_ * HW + cc] = v;
            } else if constexpr (MODE == EP_RES || MODE == EP_PLE) {
                const size_t off = (size_t)row * DM + col;
                float x = __uint_as_float((unsigned)a.xbase[off] << 16);
                if constexpr (MODE == EP_RES) x += v0;
                else { const float pv = __uint_as_float((unsigned)a.P[off] << 16); x += pv * __builtin_amdgcn_rcpf(1.f + __builtin_amdgcn_exp2f(-LOG2E * v0 * rstd_of(a.ss_in[row]))); }
                a.XB[off] = (bf16_t)(pk2(x, 0.f) & 0xffffu);
                float s = x * x;
                s += __shfl_xor(s, 1); s += __shfl_xor(s, 2); s += __shfl_xor(s, 4); s += __shfl_xor(s, 8); s += __shfl_xor(s, 16);
                if (r == 0) unsafeAtomicAdd(a.ss_out + row, s);
            } else if constexpr (MODE == EP_GU) {
                const float rs = rstd_of(a.ss_in[row]); const float g = v0 * rs, up = v1 * rs;
                const float h = g * up * __builtin_amdgcn_rcpf(1.f + __builtin_amdgcn_exp2f(-LOG2E * g));
                a.o0[(size_t)row * DFF + col] = (bf16_t)(pk2(h, 0.f) & 0xffffu);
            } else {
                a.o0[(size_t)row * DM + col] = (bf16_t)(pk2(v0, 0.f) & 0xffffu);
            }
        }
        __syncthreads();
    }
}
struct AttnArgs { int L; };
constexpr int AW_V = 0, AW_ST = 4096, AW_BIAS = 8704, AW_BYTES = 10240, ST_PITCH = 144;

template <bool F32> __device__ __forceinline__ void ld_k(bf16x8 (&kf)[4], const void* base, size_t off) {
    if constexpr (!F32) { const bf16_t* p = (const bf16_t*)base + off;
#pragma unroll
        for (int kk = 0; kk < 4; ++kk) kf[kk] = *(const bf16x8*)(p + 8 * kk);
    } else { const float* p = (const float*)base + off;
#pragma unroll
        for (int kk = 0; kk < 4; ++kk) { const f32x4 x = *(const f32x4*)(p + 8 * kk), y = *(const f32x4*)(p + 8 * kk + 4);
            u32x4 w; w.x = pk2(x[0], x[1]); w.y = pk2(x[2], x[3]); w.z = pk2(y[0], y[1]); w.w = pk2(y[2], y[3]); kf[kk] = __builtin_bit_cast(bf16x8, w); }
    }
}
template <bool F32> __device__ __forceinline__ void ld_v(u32x4 (&vr)[4], const void* base, size_t row0, int nvalid, int h, int lane) {
#pragma unroll
    for (int i = 0; i < 4; ++i) { int key = 8 * i + (lane >> 3); key = key < nvalid ? key : nvalid - 1;
        const size_t off = (row0 + key) * HW + h * 64 + (lane & 7) * 8;
        if constexpr (!F32) vr[i] = *(const u32x4*)((const bf16_t*)base + off);
        else { const float* p = (const float*)base + off; const f32x4 x = *(const f32x4*)p, y = *(const f32x4*)(p + 4);
            u32x4 w; w.x = pk2(x[0], x[1]); w.y = pk2(x[2], x[3]); w.z = pk2(y[0], y[1]); w.w = pk2(y[2], y[3]); vr[i] = w; }
    }
}
__device__ __forceinline__ void st_v(LAS unsigned char* vl, const u32x4 (&vr)[4], int lane) {
#pragma unroll
    for (int i = 0; i < 4; ++i) { const int key = 8 * i + (lane >> 3); *(LAS u32x4*)(vl + key * 128 + (((lane & 7) * 16) ^ (((key >> 1) & 1) << 6))) = vr[i]; }
}
typedef short v4i16_t __attribute__((ext_vector_type(4)));
__device__ __forceinline__ s16x4 vtr(LAS unsigned char* p) { return __builtin_bit_cast(s16x4, __builtin_amdgcn_ds_read_tr16_b64_v4i16((LAS v4i16_t*)p)); }
__device__ __forceinline__ void pv_block(f32x16 (&o)[2], LAS unsigned char* vl, const bf16x8 (&pf)[2], int lane) {
    const int q = (lane & 15) >> 2, p = lane & 3, c16 = (lane >> 4) & 1, hh = lane >> 5;
    const int va0 = (4 * hh + q) * 128 + ((32 * c16 + 8 * p) ^ ((q >> 1) << 6));
#pragma unroll
    for (int db = 0; db < 2; ++db)
#pragma unroll
        for (int s = 0; s < 2; ++s) {
            const s16x4 lo = vtr(vl + (va0 ^ (db * 64)) + s * 2048), hi = vtr(vl + (va0 ^ (db * 64)) + s * 2048 + 1024);
            const bf16x8 vf = {lo[0], lo[1], lo[2], lo[3], hi[0], hi[1], hi[2], hi[3]};
            o[db] = __builtin_amdgcn_mfma_f32_32x32x16_bf16(vf, pf[s], o[db], 0, 0, 0);
        }
}
__device__ __forceinline__ f32x16 qk_block(const bf16x8 (&kf)[4], const bf16x8 (&qf)[4]) {
    f32x16 S = {};
#pragma unroll
    for (int kk = 0; kk < 4; ++kk) S = __builtin_amdgcn_mfma_f32_32x32x16_bf16(kf[kk], qf[kk], S, 0, 0, 0);
    return S;
}
__device__ __forceinline__ void sb_block(const f32x16& S, LAS unsigned char* vl, int tq, int keypos0, float& carry, f32x16 (&o)[2], int lane) {
    const int hh = lane >> 5;
    float kp_[16], be[16];
#pragma unroll
    for (int r = 0; r < 16; ++r) {
        const int kp = keypos0 + (r & 3) + 8 * (r >> 2) + 4 * hh; const bool valid = kp < tq;
        const float z = __builtin_amdgcn_fmed3f(S[r], -126.f, 100.f);
        const float t = __builtin_amdgcn_exp2f(z), k = __builtin_amdgcn_rcpf(1.f + t);
        kp_[r] = valid ? k : 1.f; be[r] = valid ? t * k : 0.f;
    }
    float T[4], Tp[4], U[4];
#pragma unroll
    for (int g = 0; g < 4; ++g) { T[g] = (kp_[4 * g] * kp_[4 * g + 1]) * (kp_[4 * g + 2] * kp_[4 * g + 3]); Tp[g] = partner32(T[g]); U[g] = T[g] * Tp[g]; }
    float R[4]; R[3] = 1.f; R[2] = U[3]; R[1] = U[3] * U[2]; R[0] = R[1] * U[1];
    const float tot = R[0] * U[0];
    float w[16];
#pragma unroll
    for (int g = 0; g < 4; ++g) {
        const float b3 = carry * R[g] * (hh == 0 ? Tp[g] : 1.f);
        const float b2 = b3 * kp_[4 * g + 3], b1 = b2 * kp_[4 * g + 2], b0 = b1 * kp_[4 * g + 1];
        w[4 * g + 3] = be[4 * g + 3] * b3; w[4 * g + 2] = be[4 * g + 2] * b2; w[4 * g + 1] = be[4 * g + 1] * b1; w[4 * g + 0] = be[4 * g + 0] * b0;
    }
    carry *= tot;
    bf16x8 pf[2];
#pragma unroll
    for (int s = 0; s < 2; ++s) { u32x4 pw; pw.x = pk2(w[8 * s], w[8 * s + 1]); pw.y = pk2(w[8 * s + 2], w[8 * s + 3]); pw.z = pk2(w[8 * s + 4], w[8 * s + 5]); pw.w = pk2(w[8 * s + 6], w[8 * s + 7]); pf[s] = __builtin_bit_cast(bf16x8, pw); }
    pv_block(o, vl, pf, lane);
}
__device__ __forceinline__ void cb_block(const f32x16& S, bool cbias, LAS unsigned char* vl, const LAS float* bl, int tq, int keypos0, int nvalid, float& m, float& l, f32x16 (&o)[2], int lane) {
    const int hh = lane >> 5;
    float s[16]; float bm = -INFINITY;
    if (cbias) {
        const float cb = bl[256];
#pragma unroll
        for (int r = 0; r < 16; ++r) { s[r] = S[r] + cb; bm = fmaxf(bm, s[r]); }
    } else {
#pragma unroll
        for (int r = 0; r < 16; ++r) {
            const int kr = (r & 3) + 8 * (r >> 2) + 4 * hh; int d = tq - (keypos0 + kr); d = d < -128 ? -128 : (d > 128 ? 128 : d);
            s[r] = (kr < nvalid) ? S[r] + bl[d + 128] : -INFINITY; bm = fmaxf(bm, s[r]);
        }
    }
    bm = fmaxf(bm, partner32(bm));
    if (__any(bm > m + 8.f)) {
        const float mn = fmaxf(m, bm), f = __builtin_amdgcn_exp2f(m - mn); m = mn; l *= f;
#pragma unroll
        for (int db = 0; db < 2; ++db)
#pragma unroll
            for (int r = 0; r < 16; ++r) o[db][r] *= f;
    }
    float w[16], ls = 0.f;
#pragma unroll
    for (int r = 0; r < 16; ++r) { w[r] = __builtin_amdgcn_exp2f(s[r] - m); ls += w[r]; }
    l += ls;
    bf16x8 pf[2];
#pragma unroll
    for (int s2 = 0; s2 < 2; ++s2) { u32x4 pw; pw.x = pk2(w[8 * s2], w[8 * s2 + 1]); pw.y = pk2(w[8 * s2 + 2], w[8 * s2 + 3]); pw.z = pk2(w[8 * s2 + 4], w[8 * s2 + 5]); pw.w = pk2(w[8 * s2 + 6], w[8 * s2 + 7]); pf[s2] = __builtin_bit_cast(bf16x8, pw); }
    pv_block(o, vl, pf, lane);
}
__device__ __forceinline__ void attn_store(f32x16 (&o)[2], float scale, const float* gain, bf16_t* mix, size_t row0, int col0, int nrows, LAS unsigned char* wl, int lane) {
    const int r = lane & 31, hh = lane >> 5;
    f32x4 gvs[2][4];
#pragma unroll
    for (int db = 0; db < 2; ++db)
#pragma unroll
        for (int g = 0; g < 4; ++g) gvs[db][g] = *(const f32x4*)(gain + 32 * db + 8 * g + 4 * hh);
    float ssq = 0.f;
#pragma unroll
    for (int db = 0; db < 2; ++db)
#pragma unroll
        for (int i = 0; i < 16; ++i) { o[db][i] *= scale; ssq += o[db][i] * o[db][i]; }
    ssq += partner32(ssq);
    const float rstd = rsqrtf(ssq * (1.0f / 64.0f) + EPS);
    LAS unsigned char* st = wl + AW_ST;
#pragma unroll
    for (int db = 0; db < 2; ++db)
#pragma unroll
        for (int g = 0; g < 4; ++g) { const int d0 = 32 * db + 8 * g + 4 * hh; const f32x4 gv = gvs[db][g];
            u32x2 w; w.x = pk2(o[db][4 * g] * rstd * gv[0], o[db][4 * g + 1] * rstd * gv[1]); w.y = pk2(o[db][4 * g + 2] * rstd * gv[2], o[db][4 * g + 3] * rstd * gv[3]);
            *(LAS u32x2*)(st + r * ST_PITCH + d0 * 2) = w; }
#pragma unroll
    for (int i = 0; i < 4; ++i) { const int row = 8 * i + (lane >> 3), ch = lane & 7; const u32x4 v = *(const LAS u32x4*)(st + row * ST_PITCH + ch * 16);
        if (row < nrows) *(u32x4*)(mix + (row0 + row) * DM + col0 + ch * 8) = v; }
}

template <bool F32> __device__ __forceinline__ void sb_loop(const void* kbase, const void* vbase, size_t rowbase, int jhi, int h, const bf16x8 (&qf)[4], int tq, float& carry, f32x16 (&o)[2], LAS unsigned char* wl, int lane) {
    const int r = lane & 31, hh = lane >> 5;
    bf16x8 kA[4], kB[4]; u32x4 vA[4], vB[4];
#define SB_LD(KF, VN, jj) do { ld_k<F32>(KF, kbase, (rowbase + 32 * (jj) + r) * HW + h * 64 + 32 * hh); ld_v<F32>(VN, vbase, rowbase + 32 * (jj), 32, h, lane); } while (0)
    SB_LD(kA, vA, jhi); if (jhi >= 1) SB_LD(kB, vB, jhi - 1);
    for (int j = jhi; j >= 0; j -= 2) {
        { const f32x16 S = qk_block(kA, qf); st_v(wl + AW_V, vA, lane); if (j >= 2) SB_LD(kA, vA, j - 2);
          sb_block(S, wl + AW_V, tq, 32 * j, carry, o, lane); }
#if SB_EARLY
        if (__all(carry < SB_THR)) break;
#endif
        if (j < 1) break;
        { const f32x16 S = qk_block(kB, qf); st_v(wl + AW_V, vB, lane); if (j >= 3) SB_LD(kB, vB, j - 3);
          sb_block(S, wl + AW_V, tq, 32 * (j - 1), carry, o, lane); }
#if SB_EARLY
        if (__all(carry < SB_THR)) break;
#endif
    }
#undef SB_LD
}
template <bool SAMPLE> __device__ __forceinline__ void sb_unit(const AttnArgs& A, int b, int h, int qb, LAS unsigned char* wl, int lane) {
    const int r = lane & 31, hh = lane >> 5;
    const bf16_t* Qa = QKV_; const bf16_t* Ka = Qa + (size_t)1 * MT * HW; const bf16_t* Va = Qa + (size_t)2 * MT * HW;
    int tq; size_t qrow;
    if (SAMPLE) { tq = PAST + (r & 15); qrow = (size_t)MP + b * DSEQ + (r & 15); } else { tq = 32 * qb + r; qrow = (size_t)b * SEQ + tq; }
    bf16x8 qf[4]; ld_k<false>(qf, Qa, qrow * HW + h * 64 + 32 * hh);
    float carry = 1.f; f32x16 o[2]; o[0] = f32x16{}; o[1] = f32x16{};
    if (SAMPLE) {
        bf16x8 kf[4]; u32x4 vr[4]; const size_t row0 = (size_t)MP + b * DSEQ;
        ld_k<false>(kf, Ka, (row0 + (r & 15)) * HW + h * 64 + 32 * hh); ld_v<false>(vr, Va, row0, DSEQ, h, lane); st_v(wl + AW_V, vr, lane);
        { const f32x16 S = qk_block(kf, qf); sb_block(S, wl + AW_V, tq, PAST, carry, o, lane); }
        sb_loop<true>(ARG(4) + (size_t)A.L * NBATCH * PAST * HW, ARG(5) + (size_t)A.L * NBATCH * PAST * HW, (size_t)b * PAST, PAST / 32 - 1, h, qf, tq, carry, o, wl, lane);
        attn_store(o, 1.f, ARG(11) + A.L * HW + h * 64, MIX_, row0, h * 64, DSEQ, wl, lane);
    } else {
        sb_loop<false>(Ka, Va, (size_t)b * SEQ, qb, h, qf, tq, carry, o, wl, lane);
        attn_store(o, 1.f, ARG(11) + A.L * HW + h * 64, MIX_, (size_t)b * SEQ + 32 * qb, h * 64, 32, wl, lane);
    }
}
template <bool F32> __device__ __forceinline__ void cb_loop(const void* kbase, const void* vbase, size_t rowbase, int jlo, int jhi, int pos0, int h, const bf16x8 (&qf)[4], int tq, float& m, float& l, f32x16 (&o)[2], LAS unsigned char* wl, int lane) {
    const int r = lane & 31, hh = lane >> 5;
    bf16x8 kA[4], kB[4]; u32x4 vA[4], vB[4];
    const int tqmin = tq - r;
#define CB_LD(KF, VN, jj) do { ld_k<F32>(KF, kbase, (rowbase + 32 * (jj) + r) * HW + h * 64 + 32 * hh); ld_v<F32>(VN, vbase, rowbase + 32 * (jj), 32, h, lane); } while (0)
    CB_LD(kA, vA, jlo); if (jlo + 1 <= jhi) CB_LD(kB, vB, jlo + 1);
    for (int j = jlo; j <= jhi; j += 2) {
        { const f32x16 S = qk_block(kA, qf); st_v(wl + AW_V, vA, lane); if (j + 2 <= jhi) CB_LD(kA, vA, j + 2);
          const bool cbias = __builtin_amdgcn_readfirstlane(pos0 + 32 * j + 31 + 128 <= tqmin);
          cb_block(S, cbias, wl + AW_V, (const LAS float*)(wl + AW_BIAS), tq, pos0 + 32 * j, 32, m, l, o, lane); }
        if (j + 1 > jhi) break;
        { const f32x16 S = qk_block(kB, qf); st_v(wl + AW_V, vB, lane); if (j + 3 <= jhi) CB_LD(kB, vB, j + 3);
          const bool cbias = __builtin_amdgcn_readfirstlane(pos0 + 32 * (j + 1) + 31 + 128 <= tqmin);
          cb_block(S, cbias, wl + AW_V, (const LAS float*)(wl + AW_BIAS), tq, pos0 + 32 * (j + 1), 32, m, l, o, lane); }
    }
#undef CB_LD
}
template <bool SAMPLE> __device__ __forceinline__ void cb_unit(const AttnArgs& A, int b, int h, int qb, LAS unsigned char* wl, int lane) {
    const int r = lane & 31, hh = lane >> 5;
    const bf16_t* Qb = QKV_ + (size_t)3 * MT * HW; const bf16_t* Kb = Qb + (size_t)1 * MT * HW; const bf16_t* Vb = Qb + (size_t)2 * MT * HW;
    LAS float* bl = (LAS float*)(wl + AW_BIAS);
    { const float* relp = ARG(10) + (size_t)A.L * 257 * 8 + h; float bv[5];
#pragma unroll
      for (int i = 0; i < 5; ++i) { const int idx = lane + 64 * i; bv[i] = relp[(idx < 257 ? idx : 256) * 8]; }
#pragma unroll
      for (int i = 0; i < 5; ++i) { const int idx = lane + 64 * i; if (idx < 257) bl[idx] = bv[i] * LOG2E; } }
    int tq; size_t qrow;
    if (SAMPLE) { tq = PAST + (r & 15); qrow = (size_t)MP + b * DSEQ + (r & 15); } else { tq = 32 * qb + r; qrow = (size_t)b * SEQ + tq; }
    bf16x8 qf[4]; ld_k<false>(qf, Qb, qrow * HW + h * 64 + 32 * hh);
    float m = -INFINITY, l = 0.f; f32x16 o[2]; o[0] = f32x16{}; o[1] = f32x16{};
    if (SAMPLE) {
        cb_loop<true>(ARG(6) + (size_t)A.L * NBATCH * BANDL * HW, ARG(7) + (size_t)A.L * NBATCH * BANDL * HW, (size_t)b * BANDL, 0, BANDL / 32 - 1, PAST - BANDL, h, qf, tq, m, l, o, wl, lane);
        bf16x8 kf[4]; u32x4 vr[4]; const size_t row0 = (size_t)MP + b * DSEQ;
        ld_k<false>(kf, Kb, (row0 + (r & 15)) * HW + h * 64 + 32 * hh); ld_v<false>(vr, Vb, row0, DSEQ, h, lane); st_v(wl + AW_V, vr, lane);
        { const f32x16 S = qk_block(kf, qf); cb_block(S, false, wl + AW_V, bl, tq, PAST, DSEQ, m, l, o, lane); }
        l += partner32(l);
        attn_store(o, 1.0f / l, ARG(12) + A.L * HW + h * 64, MIX_, row0, HW + h * 64, DSEQ, wl, lane);
    } else {
        const int c = qb >> 1, clo = c - 8 < 0 ? 0 : c - 8;
        cb_loop<false>(Kb, Vb, (size_t)b * SEQ, 2 * clo, 2 * c + 1, 0, h, qf, tq, m, l, o, wl, lane);
        l += partner32(l);
        attn_store(o, 1.0f / l, ARG(12) + A.L * HW + h * 64, MIX_, (size_t)b * SEQ + 32 * qb, HW + h * 64, 32, wl, lane);
    }
}
__device__ __forceinline__ void cb_unit_p64(const AttnArgs& A, int b, int h, int c, LAS unsigned char* wl, int lane) {
    const int r = lane & 31, hh = lane >> 5;
    const bf16_t* Qb = QKV_ + (size_t)3 * MT * HW; const bf16_t* Kb = Qb + (size_t)1 * MT * HW; const bf16_t* Vb = Qb + (size_t)2 * MT * HW;
    LAS float* bl = (LAS float*)(wl + AW_BIAS);
    { const float* relp = ARG(10) + (size_t)A.L * 257 * 8 + h; float bv[5];
#pragma unroll
      for (int i = 0; i < 5; ++i) { const int idx = lane + 64 * i; bv[i] = relp[(idx < 257 ? idx : 256) * 8]; }
#pragma unroll
      for (int i = 0; i < 5; ++i) { const int idx = lane + 64 * i; if (idx < 257) bl[idx] = bv[i] * LOG2E; } }
    const int tq0 = 64 * c + r, tq1 = tq0 + 32; const size_t rowbase = (size_t)b * SEQ;
    bf16x8 qf0[4], qf1[4];
    ld_k<false>(qf0, Qb, (rowbase + tq0) * HW + h * 64 + 32 * hh); ld_k<false>(qf1, Qb, (rowbase + tq1) * HW + h * 64 + 32 * hh);
    float m0 = -INFINITY, l0 = 0.f, m1 = -INFINITY, l1 = 0.f;
    f32x16 o0[2], o1[2]; o0[0] = f32x16{}; o0[1] = f32x16{}; o1[0] = f32x16{}; o1[1] = f32x16{};
    const int clo = c - 8 < 0 ? 0 : c - 8, jlo = 2 * clo, jhi = 2 * c + 1;
    bf16x8 kf[4]; u32x4 vn[4];
    ld_k<false>(kf, Kb, (rowbase + 32 * jlo + r) * HW + h * 64 + 32 * hh); ld_v<false>(vn, Vb, rowbase + 32 * jlo, 32, h, lane);
    for (int j = jlo; j <= jhi; ++j) {
        const f32x16 S0 = qk_block(kf, qf0), S1 = qk_block(kf, qf1);
        st_v(wl + AW_V, vn, lane);
        if (j < jhi) { ld_k<false>(kf, Kb, (rowbase + 32 * (j + 1) + r) * HW + h * 64 + 32 * hh); ld_v<false>(vn, Vb, rowbase + 32 * (j + 1), 32, h, lane); }
        const bool cbias = (32 * j + 31 + 128 <= 64 * c);
        cb_block(S0, cbias, wl + AW_V, bl, tq0, 32 * j, 32, m0, l0, o0, lane);
        cb_block(S1, cbias, wl + AW_V, bl, tq1, 32 * j, 32, m1, l1, o1, lane);
    }
    l0 += partner32(l0); l1 += partner32(l1);
    attn_store(o0, 1.0f / l0, ARG(12) + A.L * HW + h * 64, MIX_, rowbase + 64 * c, HW + h * 64, 32, wl, lane);
    attn_store(o1, 1.0f / l1, ARG(12) + A.L * HW + h * 64, MIX_, rowbase + 64 * c + 32, HW + h * 64, 32, wl, lane);
}
constexpr unsigned AU_PCB = 2048, AU_SSB = AU_PCB + 64, AU_SCB = AU_SSB + 64, AU_ALL = AU_SCB + 4096;
__device__ __forceinline__ void attn_phase(const AttnArgs& A, LAS unsigned char* lds) {
    const int tid_ = fresh_tid(), lane = tid_ & 63, wave = __builtin_amdgcn_readfirstlane(tid_ >> 6);
    LAS unsigned char* wl = lds + wave * AW_BYTES;
    unsigned u = 0; if (lane == 0) u = atomicAdd(WS_PTR(unsigned, WS_CTL) + A.L, 1u);
    u = __builtin_amdgcn_readfirstlane(u);
    for (;;) {
        if (u >= AU_ALL) break;
        unsigned un = 0; if (lane == 0) un = atomicAdd(WS_PTR(unsigned, WS_CTL) + A.L, 1u);
        if (u < AU_PCB) { const int bh = u >> 5; cb_unit_p64(A, bh >> 3, bh & 7, 31 - (int)(u & 31), wl, lane); }
        else if (u < AU_SSB) { const unsigned v = u - AU_PCB; sb_unit<true>(A, v >> 3, v & 7, 0, wl, lane); }
        else if (u < AU_SCB) { const unsigned v = u - AU_SSB; cb_unit<true>(A, v >> 3, v & 7, 0, wl, lane); }
        else { const unsigned v = u - AU_SCB; const int bh = v >> 6; sb_unit<false>(A, bh >> 3, bh & 7, 63 - (int)(v & 63), wl, lane); }
        u = __builtin_amdgcn_readfirstlane(un);
    }
}

typedef unsigned gu32_plain;
#define XB_TMO      128
#define XB_XCNT(j)  (256  + 64 * (j))
#define XB_XSUB(j)  (1280 + 64 * (j))
#define XB_XGEN(j)  (2304 + 64 * (j))
#define XB_TOP      3328
#define XB_TOPGEN   3392
#define XCD_BAR_WORDS 3456
#define XB_SPIN_CAP (1u << 18)

__device__ __forceinline__ unsigned xb_ld(unsigned* p)              { return __hip_atomic_load(p, __ATOMIC_RELAXED, __HIP_MEMORY_SCOPE_AGENT); }
__device__ __forceinline__ unsigned xb_add(unsigned* p, unsigned v) { return __hip_atomic_fetch_add(p, v, __ATOMIC_RELAXED, __HIP_MEMORY_SCOPE_AGENT); }
__device__ __forceinline__ unsigned xb_xcc_id() { return (unsigned)__builtin_amdgcn_s_getreg((3 << 11) | 20) & 0xFu; }
#define XB_SPIN(cond, bar) do { unsigned _sp = 0; while (cond) { __builtin_amdgcn_s_sleep(1); \
    if ((++_sp & 255u) == 0u) { if (xb_ld(&(bar)[XB_TMO])) break; if (_sp > XB_SPIN_CAP) { atomicAdd(&(bar)[XB_TMO], 1u); break; } } } } while (0)

struct XcdBarrier {
    unsigned* bar; unsigned x;
    volatile LAS unsigned* st;
};

__device__ __forceinline__ XcdBarrier xcd_barrier_post(unsigned* bar, volatile LAS unsigned* st) {
    XcdBarrier b; b.bar = bar; b.x = xb_xcc_id(); b.st = st;
    if (threadIdx.x == 0) (void)xb_add(&bar[XB_XCNT(b.x)], 1u);
    return b;
}
__device__ __forceinline__ void xcd_barrier_complete(unsigned* bar, unsigned x, unsigned& nloc, unsigned& nx) {
    const unsigned G = gridDim.x * gridDim.y * gridDim.z;
    unsigned sum, cnt, mine, sp = 0u;
    for (;;) {
        sum = 0u; cnt = 0u; mine = 0u;
#pragma unroll
        for (unsigned j = 0; j < 16; ++j) { const unsigned c = xb_ld(&bar[XB_XCNT(j)]); sum += c; cnt += (c > 0u) ? 1u : 0u; mine = (j == x) ? c : mine; }
        if (sum == G) break;
        __builtin_amdgcn_s_sleep(1);
        if ((++sp & 255u) == 0u) { if (xb_ld(&bar[XB_TMO])) break; if (sp > XB_SPIN_CAP) { atomicAdd(&bar[XB_TMO], 1u); break; } }
    }
    nloc = mine > 0u ? mine : 1u; nx = cnt > 0u ? cnt : 1u;
}

__device__ __forceinline__ void xcd_barrier(const XcdBarrier& b) {
    asm volatile("s_waitcnt vmcnt(0)" ::: "memory");
    __syncthreads();
    if (threadIdx.x == 0) {
        unsigned* bar = b.bar;
        __builtin_amdgcn_s_waitcnt(0);
        unsigned nloc = b.st[0], nx = b.st[1];
        if (nloc == 0u) { xcd_barrier_complete(bar, b.x, nloc, nx); b.st[0] = nloc; b.st[1] = nx; }
        const unsigned old = xb_add(&bar[XB_XSUB(b.x)], 1u);
        const unsigned gen = old / nloc;
        if (old + 1u == (gen + 1u) * nloc) {
            __builtin_amdgcn_fence(__ATOMIC_RELEASE, "agent");
            asm volatile("s_waitcnt vmcnt(0)" ::: "memory");
            const unsigned og = xb_add(&bar[XB_TOP], 1u);
            const unsigned tg = og / nx;
            if (og + 1u == (tg + 1u) * nx) xb_add(&bar[XB_TOPGEN], 1u);
            else XB_SPIN(xb_ld(&bar[XB_TOPGEN]) == tg, bar);
            __builtin_amdgcn_fence(__ATOMIC_ACQUIRE, "agent");
            xb_add(&bar[XB_XGEN(b.x)], 1u);
            asm volatile("s_waitcnt vmcnt(0)" ::: "memory");
        } else {
            XB_SPIN(xb_ld(&bar[XB_XGEN(b.x)]) == gen, bar);
            __builtin_amdgcn_fence(__ATOMIC_ACQUIRE, "agent");
            asm volatile("s_waitcnt vmcnt(0)" ::: "memory");
        }
    }
    __syncthreads();
}

constexpr int CI_IN = 16 * 96, CI_OUT = 16 * 32, CI_G = 16 * 88, CI_D = 44 * 32, CI_PG = 16 * 32, CI_PP = 4 * 32, CI_L = CI_IN + CI_OUT + 2 * CI_G + CI_D + CI_PG + CI_PP;
struct ConvD { const float* W; const float* gain; bf16_t* WT; int K, N, kind, k0, n0; };
__device__ __forceinline__ ConvD conv_decode(int it) {
    const int L = it / CI_L; int r = it % CI_L; ConvD d;
    if (r < CI_IN) { d.W = ARG(9) + (size_t)L * DM * NQKV; d.gain = ARG(8) + L * DM; d.WT = (bf16_t*)WPTR(L, W_IN); d.K = DM; d.N = NQKV; d.kind = 0; }
    else if ((r -= CI_IN) < CI_OUT) { d.W = ARG(13) + (size_t)L * DM * DM; d.gain = nullptr; d.WT = (bf16_t*)WPTR(L, W_OUT); d.K = DM; d.N = DM; d.kind = 0; }
    else if ((r -= CI_OUT) < CI_G) { d.W = ARG(15) + (size_t)L * DM * DFF; d.gain = ARG(14) + L * DM; d.WT = (bf16_t*)WPTR(L, W_GU); d.K = DM; d.N = DFF; d.kind = 1; }
    else if ((r -= CI_G) < CI_G) { d.W = ARG(16) + (size_t)L * DM * DFF; d.gain = ARG(14) + L * DM; d.WT = (bf16_t*)WPTR(L, W_GU); d.K = DM; d.N = DFF; d.kind = 2; }
    else if ((r -= CI_G) < CI_D) { d.W = ARG(17) + (size_t)L * DFF * DM; d.gain = nullptr; d.WT = (bf16_t*)WPTR(L, W_DOWN); d.K = DFF; d.N = DM; d.kind = 0; }
    else if ((r -= CI_D) < CI_PG) { d.W = ARG(19) + (size_t)L * DM * DM; d.gain = ARG(18) + L * DM; d.WT = (bf16_t*)WPTR(L, W_PG); d.K = DM; d.N = DM; d.kind = 0; }
    else { r -= CI_PG; d.W = ARG(20) + (size_t)L * PLED * DM; d.gain = nullptr; d.WT = (bf16_t*)WPTR(L, W_PP); d.K = PLED; d.N = DM; d.kind = 0; }
    const int nblk = d.N / 32; d.k0 = 64 * (r / nblk); d.n0 = 32 * (r % nblk);
    return d;
}
__device__ __forceinline__ void conv_load(const ConvD& d, float (&v)[32], f32x4 (&g)[2], int lane) {
    const float* p = d.W + (size_t)(d.k0 + (lane >> 5)) * d.N + d.n0 + (lane & 31);
#pragma unroll
    for (int i = 0; i < 32; ++i) v[i] = p[(size_t)(2 * i) * d.N];
    if (d.gain) { g[0] = *(const f32x4*)(d.gain + d.k0 + 8 * (lane & 7)); g[1] = *(const f32x4*)(d.gain + d.k0 + 8 * (lane & 7) + 4); }
    else { g[0] = (f32x4){1.f, 1.f, 1.f, 1.f}; g[1] = g[0]; }
}
__device__ __forceinline__ void conv_proc(const ConvD& d, const float (&v)[32], const f32x4 (&g)[2], LAS float* scr, int lane) {
#pragma unroll
    for (int i = 0; i < 32; ++i) scr[(2 * i + (lane >> 5)) * 33 + (lane & 31)] = v[i];
    asm volatile("s_waitcnt lgkmcnt(0)" ::: "memory");
    const int c = lane & 7;
#pragma unroll
    for (int j = 0; j < 4; ++j) { const int n = (lane >> 3) + 8 * j; const LAS float* s = scr + (8 * c) * 33 + n;
        u32x4 o; o.x = pk2(s[0 * 33] * g[0][0], s[1 * 33] * g[0][1]); o.y = pk2(s[2 * 33] * g[0][2], s[3 * 33] * g[0][3]);
        o.z = pk2(s[4 * 33] * g[1][0], s[5 * 33] * g[1][1]); o.w = pk2(s[6 * 33] * g[1][2], s[7 * 33] * g[1][3]);
        const int gn = d.n0 + n; const int drow = d.kind == 0 ? gn : ((gn >> 7) * 256 + (gn & 127) + (d.kind == 2 ? 128 : 0));
        *(u32x4*)(d.WT + (size_t)drow * d.K + d.k0 + 8 * c) = o; }
    asm volatile("s_waitcnt lgkmcnt(0)" ::: "memory");
}

#ifdef NO_SGEMM
#define SG(...)
#else
#define SG(...) __VA_ARGS__
#endif
#ifndef GP1
#define GP1(...) __VA_ARGS__
#endif
#ifndef GP2
#define GP2(...) __VA_ARGS__
#endif
#ifndef GP3
#define GP3(...) __VA_ARGS__
#endif
#ifndef GP4
#define GP4(...) __VA_ARGS__
#endif
#ifndef GP5
#define GP5(...) __VA_ARGS__
#endif
#ifndef GP6
#define GP6(...) __VA_ARGS__
#endif
#ifdef NO_SGEMM
#define SG(...)
#else
#define SG(...) __VA_ARGS__
#endif
#ifndef GP1
#define GP1(...) __VA_ARGS__
#endif
#ifndef GP2
#define GP2(...) __VA_ARGS__
#endif
#ifndef GP3
#define GP3(...) __VA_ARGS__
#endif
#ifndef GP4
#define GP4(...) __VA_ARGS__
#endif
#ifndef GP5
#define GP5(...) __VA_ARGS__
#endif
#ifndef GP6
#define GP6(...) __VA_ARGS__
#endif
struct Args { const float* in[22]; float* out; unsigned char* ws; };

#ifndef PROBE_SEL
#define PROBE_SEL -1
#endif
#if PROBE_SEL >= 0
#define TSTAMP(cat) do { if (blockIdx.x == 0 && fresh_tid() == 0) { const unsigned long long t_ = __builtin_amdgcn_s_memrealtime(); unsigned long long* tsb = WS_PTR(unsigned long long, WS_CTL + 4096); \
    tsb[16 + (cat)] += t_ - tsb[0]; tsb[0] = t_; } } while (0)
#else
#define TSTAMP(cat) do {} while (0)
#endif
__global__ void __launch_bounds__(NTHREADS, 2) hymba_fwd(Args args) {
    extern __shared__ __attribute__((aligned(16))) unsigned char lds_raw[];
    cg::grid_group grid = cg::this_grid();
    LAS unsigned char* lds = (LAS unsigned char*)lds_raw;
    const int G = gridDim.x;

#if PROBE_SEL >= 0
    if (blockIdx.x == 0 && fresh_tid() == 0) { unsigned long long* tsb = WS_PTR(unsigned long long, WS_CTL + 4096); for (int i = 0; i < 48; ++i) tsb[i] = 0; tsb[0] = __builtin_amdgcn_s_memrealtime(); }
#endif
    {
        const int tid = fresh_tid(), lane = tid & 63, wave = __builtin_amdgcn_readfirstlane(tid >> 6);
        const int gw = blockIdx.x * NWAVES + wave, NGW = G * NWAVES;
        { float* ssb = SSB; for (int i = blockIdx.x * NTHREADS + tid; i < 6 * MT; i += G * NTHREADS) ssb[MT + i] = 0.f;
          if (blockIdx.x == 0 && tid < 16) WS_PTR(unsigned, WS_CTL)[tid] = 0u;
          if (blockIdx.x == 0) for (int i = tid; i < XCD_BAR_WORDS; i += NTHREADS) WS_PTR(unsigned, WS_BAR)[i] = 0u;
          if (tid < 2) ((LAS unsigned*)(lds + 131072))[tid] = 0u; }
        LAS float* scr = (LAS float*)(lds + wave * 8704);
        { constexpr int NIT = NLAYER * CI_L; int it = gw;
          float vA[32], vB[32]; f32x4 gA[2], gB[2]; ConvD dA, dB;
          if (it < NIT) { dA = conv_decode(it); conv_load(dA, vA, gA, lane); }
          while (it < NIT) {
            const int itn = it + NGW;
            if (itn < NIT) { dB = conv_decode(itn); conv_load(dB, vB, gB, lane); }
            conv_proc(dA, vA, gA, scr, lane);
            if (itn >= NIT) break;
            it = itn + NGW;
            if (it < NIT) { dA = conv_decode(it); conv_load(dA, vA, gA, lane); }
            conv_proc(dB, vB, gB, scr, lane);
          } }
        { const float* pp = ARG(2); const float* ps = ARG(3); bf16_t* PB = PB_;
          for (int it0 = 4 * gw; it0 < NLAYER * MT; it0 += 4 * NGW) {
            f32x4 v[4];
#pragma unroll
            for (int rr = 0; rr < 4; ++rr) { const int it = it0 + rr, L = it / MT, row = it % MT;
                const float* src = row < MP ? pp + ((size_t)L * MP + row) * PLED : ps + ((size_t)L * MS + (row - MP)) * PLED;
                v[rr] = *((const f32x4*)src + lane); }
#pragma unroll
            for (int rr = 0; rr < 4; ++rr) { u32x2 w; w.x = pk2(v[rr][0], v[rr][1]); w.y = pk2(v[rr][2], v[rr][3]); *((u32x2*)(PB + (size_t)(it0 + rr) * PLED) + lane) = w; }
          } }
        { const float* x_p = ARG(0); const float* x_s = ARG(1); bf16_t* XB = XN_; float* ssb = SSB;
          for (int row0 = 2 * gw; row0 < MT; row0 += 2 * NGW) {
            f32x4 v[2][4];
#pragma unroll
            for (int rr = 0; rr < 2; ++rr) { const int row = row0 + rr; const float* src = row < MP ? x_p + (size_t)row * DM : x_s + (size_t)(row - MP) * DM;
#pragma unroll
                for (int j = 0; j < 4; ++j) v[rr][j] = *((const f32x4*)src + lane + 64 * j); }
#pragma unroll
            for (int rr = 0; rr < 2; ++rr) { float s2 = 0.f;
#pragma unroll
                for (int j = 0; j < 4; ++j) { const f32x4 t = v[rr][j]; s2 += (t[0] * t[0] + t[1] * t[1]) + (t[2] * t[2] + t[3] * t[3]);
                    u32x2 w; w.x = pk2(t[0], t[1]); w.y = pk2(t[2], t[3]); *((u32x2*)(XB + (size_t)(row0 + rr) * DM) + lane + 64 * j) = w; }
                s2 = wave_sum(s2);
                if (lane == 0) ssb[row0 + rr] = s2; }
          } }
    }
    TSTAMP(0); grid.sync(); TSTAMP(8);
    const XcdBarrier xbar = xcd_barrier_post(WS_PTR(unsigned, WS_BAR), (volatile LAS unsigned*)(lds + 131072));
#define GSYNC() xcd_barrier(xbar)

    for (int L = 0; L < NLAYER; ++L) {
#define SS_MIX (SSB + (size_t)(3 * L) * MT)
#define SS_FFN (SSB + (size_t)(3 * L + 1) * MT)
#define SS_PLE (SSB + (size_t)(3 * L + 2) * MT)
#define SS_NEXT (SSB + (size_t)(3 * L + 3) * MT)
        { EpiArgs q{}; q.ss_in = SS_MIX; q.o0 = QKV_;
          q.f_sbk = ARG_OUT + O_SBK_P + (size_t)L * MP * HW; q.f_sbv = ARG_OUT + O_SBV_P + (size_t)L * MP * HW;
          q.f_cbk = ARG_OUT + O_CBK_P + (size_t)L * NBATCH * BANDL * HW; q.f_cbv = ARG_OUT + O_CBV_P + (size_t)L * NBATCH * BANDL * HW;
          pg8::Gemm g{XN_, WPTR(L, W_IN), MP, NQKV, DM}; pg8::StaticOrder S; S.init(MP, NQKV, G, (int)blockIdx.x);
          Epi<EP_QKV> E{q};
          GP1(pg8::gemm_phase<Epi<EP_QKV>, pg8::StaticOrder, true, true>(lds, g, S, E);) TSTAMP(1); }
        { EpiArgs q{}; q.ss_in = SS_MIX; q.o0 = QKV_;
          q.s_sbk = ARG_OUT + O_SBK_S + (size_t)L * MS * HW; q.s_sbv = ARG_OUT + O_SBV_S + (size_t)L * MS * HW;
          q.s_cbk = ARG_OUT + O_CBK_S + (size_t)L * MS * HW; q.s_cbv = ARG_OUT + O_CBV_S + (size_t)L * MS * HW;
          SG(sgemm<EP_QKV, DM>(lds, XN_ + (size_t)MP * DM, WPTR(L, W_IN), NQKV / 32, q);) TSTAMP(7); }
        GSYNC(); TSTAMP(8);
        { AttnArgs A{}; A.L = L;
#ifndef NO_ATTN
          attn_phase(A, lds);
#endif
          TSTAMP(2); }
        GSYNC(); TSTAMP(2);
        { EpiArgs q{}; q.XB = XB_; q.xbase = XN_; q.ss_out = SS_FFN;
          pg8::Gemm g{MIX_, WPTR(L, W_OUT), MP, DM, DM}; pg8::StaticOrder S; S.init(MP, DM, G, (int)blockIdx.x);
          Epi<EP_RES> E{q};
          GP2(pg8::gemm_phase<Epi<EP_RES>, pg8::StaticOrder, true, true>(lds, g, S, E);) TSTAMP(3); }
        { EpiArgs q{}; q.XB = XB_; q.xbase = XN_; q.ss_out = SS_FFN;
          SG(sgemm<EP_RES, DM>(lds, MIX_ + (size_t)MP * DM, WPTR(L, W_OUT), DM / 32, q);) TSTAMP(7); }
        GSYNC(); TSTAMP(8);
        { EpiArgs q{}; q.ss_in = SS_FFN; q.o0 = HB_;
          pg8::Gemm g{XB_, WPTR(L, W_GU), MP, 2 * DFF, DM}; pg8::StaticOrder S; S.init(MP, 2 * DFF, G, (int)blockIdx.x);
          Epi<EP_GU> E{q};
          GP4(pg8::gemm_phase<Epi<EP_GU>, pg8::StaticOrder, true, true>(lds, g, S, E);) TSTAMP(4);
          SG(sgemm<EP_GU, DM>(lds, XB_ + (size_t)MP * DM, WPTR(L, W_GU), DFF / 32, q);) TSTAMP(7); }
        { EpiArgs q2{}; q2.o0 = PBUF_;
          int kp = PLED; asm volatile("" : "+s"(kp));
          const int Gh = G >> 1;
          if ((int)blockIdx.x >= Gh) {
            pg8::Gemm g2{PB_ + (size_t)L * MT * PLED, WPTR(L, W_PP), MP, DM, kp}; pg8::StaticOrder S; S.init(MP, DM, G - Gh, (int)blockIdx.x - Gh);
            Epi<EP_P> E2{q2};
            GP3(pg8::gemm_phase<Epi<EP_P>, pg8::StaticOrder, true, true>(lds, g2, S, E2);) TSTAMP(10);
          }
          SG(sgemm<EP_P, PLED>(lds, PB_ + ((size_t)L * MT + MP) * PLED, WPTR(L, W_PP), DM / 32, q2);) TSTAMP(7); }
        GSYNC(); TSTAMP(8);
        { EpiArgs q{}; q.XB = XB_; q.xbase = XB_; q.ss_out = SS_PLE;
          pg8::Gemm g{HB_, WPTR(L, W_DOWN), MP, DM, DFF}; pg8::StaticOrder S; S.init(MP, DM, G, (int)blockIdx.x);
          Epi<EP_RES> E{q};
          GP5(pg8::gemm_phase<Epi<EP_RES>, pg8::StaticOrder, true, true>(lds, g, S, E);) TSTAMP(5);
          SG(sgemm<EP_RES, DFF>(lds, HB_ + (size_t)MP * DFF, WPTR(L, W_DOWN), DM / 32, q);) TSTAMP(7); }
        GSYNC(); TSTAMP(8);
        { EpiArgs q{}; q.XB = XN_  ; q.P = PBUF_; q.xbase = XB_; q.ss_in = SS_PLE; q.ss_out = SS_NEXT;
          pg8::Gemm g{XB_, WPTR(L, W_PG), MP, DM, DM}; pg8::StaticOrder S; S.init(MP, DM, G, (int)blockIdx.x);
          Epi<EP_PLE> E{q};
          GP6(pg8::gemm_phase<Epi<EP_PLE>, pg8::StaticOrder, true, true>(lds, g, S, E);) TSTAMP(6);
          SG(sgemm<EP_PLE, DM>(lds, XB_ + (size_t)MP * DM, WPTR(L, W_PG), DM / 32, q);) TSTAMP(7); }
        GSYNC(); TSTAMP(8);
    }
    {
        const int tid = fresh_tid(), lane = tid & 63, wave = __builtin_amdgcn_readfirstlane(tid >> 6);
        const int gw = blockIdx.x * NWAVES + wave, NGW = G * NWAVES;
        const float* ssf = SSB + (size_t)(3 * NLAYER) * MT; const float* gf = ARG(21); const bf16_t* XN = XN_; float* out = ARG_OUT;
        for (int row0 = 2 * gw; row0 < MT; row0 += 2 * NGW) {
            u32x2 xv[2][4];
#pragma unroll
            for (int rr = 0; rr < 2; ++rr)
#pragma unroll
                for (int j = 0; j < 4; ++j) xv[rr][j] = *((const u32x2*)(XN + (size_t)(row0 + rr) * DM) + lane + 64 * j);
#pragma unroll
            for (int rr = 0; rr < 2; ++rr) { const int row = row0 + rr; const float rs = rstd_of(ssf[row]);
                float* dst = row < MP ? out + O_YP + (size_t)row * DM : out + O_YS + (size_t)(row - MP) * DM;
#pragma unroll
                for (int j = 0; j < 4; ++j) { const f32x4 gv = *((const f32x4*)gf + lane + 64 * j); const u32x2 w = xv[rr][j];
                    const f32x4 v = {bf_lo(w.x), bf_hi(w.x), bf_lo(w.y), bf_hi(w.y)};
                    *((f32x4*)dst + lane + 64 * j) = v * rs * gv; } }
        }
    }
#if PROBE_SEL >= 0
    TSTAMP(11); grid.sync();
    if (blockIdx.x == 0 && fresh_tid() == 0) { const unsigned long long* tsb = WS_PTR(unsigned long long, WS_CTL + 4096); float* o = ARG_OUT + O_YS; unsigned long long tv = 0; if (PROBE_SEL == 20) tv = tsb[16+1] + tsb[16+3] + tsb[16+10] + tsb[16+4] + tsb[16+5] + tsb[16+6]; else if (PROBE_SEL == 21) tv = tsb[16+0] + tsb[16+11]; else if (PROBE_SEL < 16) tv = tsb[16 + PROBE_SEL]; o[0] += (float)tv * 2.5e-5f; }
#endif
}

extern "C" void kernel_launch(void* const* d_in, const int* in_sizes, int n_in, void* d_out, int out_size, void* d_ws, size_t ws_size, hipStream_t stream) {
    static int grid = 0;
    if (grid == 0) {
        int dev = 0, cus = 0, per_cu = 0;
        hipGetDevice(&dev);
        hipDeviceGetAttribute(&cus, hipDeviceAttributeMultiprocessorCount, dev);
        hipFuncSetAttribute((const void*)hymba_fwd, hipFuncAttributeMaxDynamicSharedMemorySize, LDS_BYTES);
        hipOccupancyMaxActiveBlocksPerMultiprocessor(&per_cu, (const void*)hymba_fwd, NTHREADS, LDS_BYTES);
        if (per_cu < 1) per_cu = 1;
        grid = cus * per_cu;
        if (n_in != 22 || ws_size < WS_END) { fprintf(stderr, "kernel_launch: unexpected n_in %d / ws_size %zu\n", n_in, ws_size); }
    }
    Args a{};
    for (int i = 0; i < 22; ++i) a.in[i] = (const float*)d_in[i];
    a.out = (float*)d_out; a.ws = (unsigned char*)d_ws;
    void* kargs[] = {&a};
    hipError_t e = hipLaunchCooperativeKernel((const void*)hymba_fwd, dim3(grid), dim3(NTHREADS), kargs, LDS_BYTES, stream);
    if (e != hipSuccess) fprintf(stderr, "cooperative launch failed: %s (grid %d)\n", hipGetErrorString(e), grid);
}
```

```cpp
#include <hip/hip_runtime.h>
#include <hip/hip_cooperative_groups.h>
#include <cstdio>
#include <cstdint>
namespace cg = cooperative_groups;
__device__ __forceinline__ int fresh_tid() { int t = threadIdx.x; asm volatile("" : "+v"(t)); return t; }
namespace pg8 {
#define PG8_LAS __attribute__((address_space(3)))
typedef unsigned short bf16_t;
typedef short bf16x8 __attribute__((ext_vector_type(8)));
typedef float f32x4 __attribute__((ext_vector_type(4)));
typedef unsigned u32x4 __attribute__((ext_vector_type(4)));
constexpr int BM = 256, BK = 64, HALF = 128, HTB = HALF * BK * 2  , STAGE_BYTES = 8 * HTB, NXCD = 8, WGM = 8;

__host__ __device__ __forceinline__ int lds_byte(int r, int c) { const int st = (r >> 4) * 2 + (c >> 5), rr = r & 15, cc = c & 31, ob = rr * 64 + cc * 2; return st * 1024 + (ob ^ (((ob >> 9) & 1) << 5)); }
__host__ __device__ __forceinline__ void stage_rc(int b, int& R, int& C) { const int st = b / 1024, sb = b % 1024, swz = sb ^ (((sb >> 9) & 1) << 5); R = (st >> 1) * 16 + swz / 64; C = (st & 1) * 32 + (swz % 64) / 2; }
__host__ __device__ __forceinline__ int perm32(int rho) { const int n = rho >> 4, i = rho & 15; return 8 * (i >> 2) + 4 * n + (i & 3); }

struct Unit { int pm, pn; };
struct Gemm { const bf16_t* A; const bf16_t* Bt; int M, N, K; };

struct StaticOrder {
    int nM, nN, nwg, G, c;
    __host__ __device__ void init(int M, int N, int G_, int c_) { nM = M / BM; nN = N / BM; nwg = nM * nN; G = G_; c = c_; }
    __host__ __device__ bool next(int i, Unit& u) const {
        const long L = (long)i * G + c; if (L >= nwg) return false;
        int wgid = (int)L; { const int q = nwg / NXCD, r = nwg % NXCD, xcd = wgid % NXCD, off = wgid / NXCD; wgid = (xcd < r ? xcd * (q + 1) : r * (q + 1) + (xcd - r) * q) + off; }
        const int nig = WGM * nN, gid = wgid / nig, fm = gid * WGM, gsz = (nM - fm) < WGM ? (nM - fm) : WGM;
        u.pm = fm + ((wgid % nig) % gsz); u.pn = (wgid % nig) / gsz; return true;
    }
    __device__ __forceinline__ void a_ready(const Unit&) const {}
    __device__ __forceinline__ void done(const Unit&) const {}
};

template <class Epi, class Sched, bool ALIGN_EPI = false, bool SP2 = false>
__device__ __forceinline__ void gemm_phase(PG8_LAS unsigned char* lds, const Gemm g, const Sched& S, const Epi& E) {
    const int tid = fresh_tid(), wid = __builtin_amdgcn_readfirstlane(tid >> 6), lane = tid & 63, wr = wid >> 2, wc = wid & 3, fr = lane & 15, fq = lane >> 4;
    const int K = g.K, nt = K / BK;
    unsigned voffA[2], voffB[2];
#pragma unroll
    for (int i = 0; i < 2; ++i) { int R, C; stage_rc(tid * 16 + i * 8192, R, C); const int Rb = Epi::PERM ? ((R & ~31) + perm32(R & 31)) : R;
        voffA[i] = (unsigned)(R * K + C) * 2u; voffB[i] = (unsigned)(Rb * K + C) * 2u; }
    const size_t kstep = (size_t)(BK * 2);
    const size_t hstep = (size_t)HALF * K * 2;
    const size_t tstep = 2 * hstep;
    const unsigned ldsw = (unsigned)wid * 1024u;
    const int aoff = lds_byte(wr * 64 + fr, fq * 8), boff = lds_byte(wc * 32 + fr, fq * 8);
#define PG8_SA(b, h) (((b) * 2 + (h)) * HTB)
#define PG8_SB(b, h) ((4 + (b) * 2 + (h)) * HTB)
#define PG8_STAGE(bufoff, gbase, voff) do { _Pragma("unroll") for (int _i = 0; _i < 2; ++_i) \
        __builtin_amdgcn_global_load_lds((const unsigned*)((const char*)(gbase) + (voff)[_i]), (PG8_LAS unsigned*)(lds + (bufoff) + ldsw + _i * 8192), 16, 0, 0); } while (0)
#define PG8_LDA(dst, b, h) do { _Pragma("unroll") for (int m = 0; m < 4; ++m) _Pragma("unroll") for (int k = 0; k < 2; ++k) dst[m][k] = *(const PG8_LAS bf16x8*)(lds + PG8_SA(b, h) + aoff + m * 2048 + k * 1024); } while (0)
#define PG8_LDB(dst, b, h) do { _Pragma("unroll") for (int n = 0; n < 2; ++n) _Pragma("unroll") for (int k = 0; k < 2; ++k) dst[n][k] = *(const PG8_LAS bf16x8*)(lds + PG8_SB(b, h) + boff + n * 2048 + k * 1024); } while (0)
#define PG8_MMA(ai, bj, At, Bt) do { __builtin_amdgcn_s_setprio(1); _Pragma("unroll") for (int m = 0; m < 4; ++m) _Pragma("unroll") for (int n = 0; n < 2; ++n) _Pragma("unroll") for (int k = 0; k < 2; ++k) \
        acc[ai][bj][m][n] = __builtin_amdgcn_mfma_f32_16x16x32_bf16(Bt[n][k], At[m][k], acc[ai][bj][m][n], 0, 0, 0); __builtin_amdgcn_s_setprio(0); } while (0)
#define PG8_WAIT_V(n) asm volatile("s_waitcnt vmcnt(" #n ")" ::: "memory")
#define PG8_WAIT_L(n) asm volatile("s_waitcnt lgkmcnt(" #n ")" ::: "memory")
#define PG8_BAR __builtin_amdgcn_s_barrier()
#define PG8_SCHED __builtin_amdgcn_sched_barrier(0)
    Unit cur, nxt; int ui = 0;
    if (!S.next(0, cur)) return;
    f32x4 acc[2][2][4][2];
#pragma unroll
    for (int a = 0; a < 2; ++a)
#pragma unroll
        for (int b = 0; b < 2; ++b)
#pragma unroll
            for (int m = 0; m < 4; ++m)
#pragma unroll
                for (int n = 0; n < 2; ++n) acc[a][b][m][n] = (f32x4){0.f, 0.f, 0.f, 0.f};
    bf16x8 At[4][2], B0[2][2], B1[2][2];
    const char* cA = (const char*)g.A + (size_t)cur.pm * tstep; const char* cB = (const char*)g.Bt + (size_t)cur.pn * tstep;
    S.a_ready(cur);
    if constexpr (SP2) {
        PG8_STAGE(PG8_SB(0, 0), cB, voffB); PG8_STAGE(PG8_SB(0, 1), cB + hstep, voffB); PG8_STAGE(PG8_SA(0, 0), cA, voffA); PG8_STAGE(PG8_SA(0, 1), cA + hstep, voffA);
        if (wr == 1) PG8_BAR;
        PG8_WAIT_V(2); PG8_BAR;
        PG8_STAGE(PG8_SB(1, 0), cB + kstep, voffB); PG8_STAGE(PG8_SA(1, 0), cA + kstep, voffA); PG8_STAGE(PG8_SB(1, 1), cB + hstep + kstep, voffB);
        PG8_WAIT_V(6); PG8_BAR;
    } else {
        PG8_STAGE(PG8_SB(0, 0), cB, voffB); PG8_STAGE(PG8_SA(0, 0), cA, voffA); PG8_STAGE(PG8_SB(0, 1), cB + hstep, voffB); PG8_STAGE(PG8_SA(0, 1), cA + hstep, voffA);
        if (wr == 1) PG8_BAR;
        PG8_WAIT_V(4); PG8_BAR;
        PG8_STAGE(PG8_SB(1, 0), cB + kstep, voffB); PG8_STAGE(PG8_SA(1, 0), cA + kstep, voffA); PG8_STAGE(PG8_SB(1, 1), cB + hstep + kstep, voffB);
        PG8_WAIT_V(6); PG8_BAR;
    }
    for (;;) {
        const bool has_next = S.next(ui + 1, nxt);
        const char* nA = has_next ? (const char*)g.A + (size_t)nxt.pm * tstep : cA; const char* nB = has_next ? (const char*)g.Bt + (size_t)nxt.pn * tstep : cB;
        for (int t = 0; t < nt; t += 2) {
            const bool last = (t == nt - 2);
            const char* a1 = cA + (size_t)(t + 1) * kstep;
            const char* a2 = last ? nA : cA + (size_t)(t + 2) * kstep; const char* b2 = last ? nB : cB + (size_t)(t + 2) * kstep;
            const char* a3 = a2 + kstep; const char* b3 = b2 + kstep;
            if (last && has_next) S.a_ready(nxt);
            if constexpr (SP2) {
            PG8_LDB(B0, 0, 0); PG8_LDB(B1, 0, 1); PG8_SCHED; PG8_LDA(At, 0, 0); PG8_STAGE(PG8_SA(1, 1), a1 + hstep, voffA);
            PG8_WAIT_V(8); PG8_WAIT_L(0); PG8_BAR; PG8_MMA(0, 0, At, B0); PG8_MMA(0, 1, At, B1); PG8_BAR; PG8_SCHED;
            PG8_LDA(At, 0, 1); PG8_STAGE(PG8_SB(0, 0), b2, voffB); PG8_STAGE(PG8_SB(0, 1), b2 + hstep, voffB); PG8_STAGE(PG8_SA(0, 0), a2, voffA);
            PG8_WAIT_V(8); PG8_WAIT_L(0); PG8_BAR; PG8_MMA(1, 0, At, B0); PG8_MMA(1, 1, At, B1); PG8_BAR; PG8_SCHED;
            PG8_LDB(B0, 1, 0); PG8_LDB(B1, 1, 1); PG8_SCHED; PG8_LDA(At, 1, 0); PG8_STAGE(PG8_SA(0, 1), a2 + hstep, voffA);
            PG8_WAIT_V(8); PG8_WAIT_L(0); PG8_BAR; PG8_MMA(0, 0, At, B0); PG8_MMA(0, 1, At, B1); PG8_BAR; PG8_SCHED;
            PG8_LDA(At, 1, 1); PG8_STAGE(PG8_SB(1, 0), b3, voffB); PG8_STAGE(PG8_SB(1, 1), b3 + hstep, voffB); PG8_STAGE(PG8_SA(1, 0), a3, voffA);
            PG8_WAIT_V(8); PG8_WAIT_L(0); PG8_BAR; PG8_MMA(1, 0, At, B0); PG8_MMA(1, 1, At, B1); PG8_BAR; PG8_SCHED;
            } else {
            PG8_LDB(B0, 0, 0); PG8_SCHED; PG8_LDA(At, 0, 0); PG8_STAGE(PG8_SA(1, 1), a1 + hstep, voffA);
            PG8_WAIT_L(8); PG8_BAR; PG8_WAIT_L(0); PG8_MMA(0, 0, At, B0); PG8_BAR; PG8_SCHED;
            PG8_LDB(B1, 0, 1); PG8_STAGE(PG8_SB(0, 0), b2, voffB);
            PG8_BAR; PG8_WAIT_L(0); PG8_MMA(0, 1, At, B1); PG8_BAR;
            PG8_LDA(At, 0, 1); PG8_STAGE(PG8_SA(0, 0), a2, voffA);
            PG8_BAR; PG8_WAIT_L(0); PG8_MMA(1, 0, At, B0); PG8_BAR; PG8_SCHED;
            PG8_STAGE(PG8_SB(0, 1), b2 + hstep, voffB);
            PG8_WAIT_V(6); PG8_BAR; PG8_MMA(1, 1, At, B1); PG8_BAR;
            PG8_LDB(B0, 1, 0); PG8_SCHED; PG8_LDA(At, 1, 0); PG8_STAGE(PG8_SA(0, 1), a2 + hstep, voffA);
            PG8_WAIT_L(8); PG8_BAR; PG8_WAIT_L(0); PG8_MMA(0, 0, At, B0); PG8_BAR; PG8_SCHED;
            PG8_LDB(B1, 1, 1); PG8_STAGE(PG8_SB(1, 0), b3, voffB);
            PG8_BAR; PG8_WAIT_L(0); PG8_MMA(0, 1, At, B1); PG8_BAR;
            PG8_LDA(At, 1, 1); PG8_STAGE(PG8_SA(1, 0), a3, voffA);
            PG8_BAR; PG8_WAIT_L(0); PG8_MMA(1, 0, At, B0); PG8_BAR; PG8_SCHED;
            PG8_STAGE(PG8_SB(1, 1), b3 + hstep, voffB);
            PG8_WAIT_V(6); PG8_BAR; PG8_MMA(1, 1, At, B1); PG8_BAR;
            }
        }
        if constexpr (ALIGN_EPI) { if (wr == 0) PG8_BAR; }
        if constexpr (!Epi::AFTER_DRAIN) { E(acc, cur, wr, wc, fr, fq); S.done(cur); }
        if (!has_next) break;
#pragma unroll
        for (int a = 0; a < 2; ++a)
#pragma unroll
            for (int b = 0; b < 2; ++b)
#pragma unroll
                for (int m = 0; m < 4; ++m)
#pragma unroll
                    for (int n = 0; n < 2; ++n) acc[a][b][m][n] = (f32x4){0.f, 0.f, 0.f, 0.f};
        cur = nxt; cA = nA; cB = nB; ++ui;
        if constexpr (ALIGN_EPI) { if (wr == 1) PG8_BAR; }
    }
    PG8_WAIT_V(0);
    if constexpr (!ALIGN_EPI) { if (wr == 0) PG8_BAR; }
    PG8_BAR;
    if constexpr (Epi::AFTER_DRAIN) { E.fused(acc, cur, wr, wc, fr, fq, lds, wid, lane); S.done(cur); }
#undef PG8_SA
#undef PG8_SB
#undef PG8_STAGE
#undef PG8_LDA
#undef PG8_LDB
#undef PG8_MMA
#undef PG8_WAIT_V
#undef PG8_WAIT_L
#undef PG8_BAR
#undef PG8_SCHED
}
}

#define LAS __attribute__((address_space(3)))
using pg8::bf16_t; using pg8::bf16x8; using pg8::f32x4; using pg8::u32x4;
typedef short s16x4 __attribute__((ext_vector_type(4)));
typedef float f32x16 __attribute__((ext_vector_type(16)));
typedef unsigned u32x2 __attribute__((ext_vector_type(2)));
typedef float f32x2_t __attribute__((ext_vector_type(2)));
typedef __bf16 bf16x2_t __attribute__((ext_vector_type(2)));

constexpr int DM = 1024, SEQ = 2048, NBATCH = 8, MP = NBATCH * SEQ, DSEQ = 16, MS = NBATCH * DSEQ, MT = MP + MS;
constexpr int DFF = 2816, NQKV = 3072, PLED = 256, NLAYER = 2, PAST = 2048, BANDL = 512, HW = 512;
constexpr float EPS = 1e-6f, LOG2E = 1.4426950408889634f, QSCALE = 0.125f * LOG2E;
#ifndef SB_EARLY
#define SB_EARLY 1
#endif
constexpr float SB_THR = 7.5e-37f;

constexpr size_t MiB = 1u << 20;
constexpr size_t WS_CTL = 0, WS_SS = 64 * 1024;
constexpr size_t WS_W = 2 * MiB, W_LSTRIDE = 28 * MiB, W_IN = 0, W_OUT = 6 * MiB, W_GU = 8 * MiB, W_DOWN = 19 * MiB, W_PG = 25 * MiB, W_PP = 27 * MiB;
constexpr size_t WS_PB = 58 * MiB, WS_X = 76 * MiB  , WS_XB = 142 * MiB, WS_QKV = 176 * MiB, WS_MIX = 274 * MiB, WS_P = 308 * MiB, WS_END = 342 * MiB;
constexpr int LDS_BYTES = 131072 + 1024;
constexpr size_t WS_BAR = 8192;
constexpr int NWAVES = 8, NTHREADS = 512;

constexpr size_t O_YP = 0, O_YS = (size_t)MP * DM, O_SBK_P = O_YS + (size_t)MS * DM, O_SBV_P = O_SBK_P + (size_t)NLAYER * MP * HW,
                 O_CBK_P = O_SBV_P + (size_t)NLAYER * MP * HW, O_CBV_P = O_CBK_P + (size_t)NLAYER * NBATCH * BANDL * HW,
                 O_SBK_S = O_CBV_P + (size_t)NLAYER * NBATCH * BANDL * HW, O_SBV_S = O_SBK_S + (size_t)NLAYER * MS * HW,
                 O_CBK_S = O_SBV_S + (size_t)NLAYER * MS * HW, O_CBV_S = O_CBK_S + (size_t)NLAYER * MS * HW;

__device__ __forceinline__ unsigned pk2(float lo, float hi) { f32x2_t v = {lo, hi}; bf16x2_t b = __builtin_convertvector(v, bf16x2_t); return __builtin_bit_cast(unsigned, b); }
__device__ __forceinline__ float bf_lo(unsigned w) { return __uint_as_float(w << 16); }
__device__ __forceinline__ float bf_hi(unsigned w) { return __uint_as_float(w & 0xffff0000u); }
__device__ __forceinline__ float partner32(float v) {
    auto rr = __builtin_amdgcn_permlane32_swap(__float_as_uint(v), __float_as_uint(v), false, false);
    return (threadIdx.x & 32) ? __uint_as_float(rr[0]) : __uint_as_float(rr[1]);
}
__device__ __forceinline__ float wave_sum(float v) {
#pragma unroll
    for (int o = 1; o < 64; o <<= 1) v += __shfl_xor(v, o);
    return v;
}
__device__ __forceinline__ float rstd_of(float ss) { return rsqrtf(ss * (1.0f / DM) + EPS); }

template <int I> __device__ __forceinline__ const float* argp() {
    unsigned long long v; const void* ka = (const void*)__builtin_amdgcn_kernarg_segment_ptr();
    asm volatile("s_load_dwordx2 %0, %1, %2\n\ts_waitcnt lgkmcnt(0)" : "=s"(v) : "s"(ka), "i"(I * 8) : "memory");
    return (const float*)(const __attribute__((address_space(1))) float*)v;
}
#define ARG(i) argp<i>()
#define ARG_OUT ((float*)argp<22>())
#define ARG_WS ((unsigned char*)argp<23>())
#define WS_PTR(T, off) ((T*)(ARG_WS + (off)))
#define SSB WS_PTR(float, WS_SS)
#define PB_ WS_PTR(bf16_t, WS_PB)
#define XN_ WS_PTR(bf16_t, WS_X)
#define XB_ WS_PTR(bf16_t, WS_XB)
#define QKV_ WS_PTR(bf16_t, WS_QKV)
#define HB_ WS_PTR(bf16_t, WS_QKV)
#define MIX_ WS_PTR(bf16_t, WS_MIX)
#define PBUF_ WS_PTR(bf16_t, WS_P)
#define WPTR(L, off) ((const bf16_t*)(ARG_WS + WS_W + (size_t)(L) * W_LSTRIDE + (off)))

enum { EP_QKV = 0, EP_RES = 1, EP_GU = 2, EP_P = 3, EP_PLE = 4 };
struct EpiArgs {
    const float* ss_in; float* ss_out;
    const bf16_t* xbase;
    bf16_t* XB; bf16_t* o0; const bf16_t* P;
    float *f_sbk, *f_sbv, *f_cbk, *f_cbv;
    float *s_sbk, *s_sbv, *s_cbk, *s_cbv;
};
template <int MODE> struct Epi {
    static constexpr bool PERM = false, AFTER_DRAIN = false;
    EpiArgs a;
    __device__ __forceinline__ void operator()(const f32x4 (&acc)[2][2][4][2], const pg8::Unit& u, int wr, int wc, int fr, int fq) const {
        if constexpr (MODE == EP_QKV) {
            const int part = u.pn >> 1, cb = (u.pn & 1) * 256 + wc * 32 + 4 * fq;
            bf16_t* ob = a.o0 + (size_t)part * ((size_t)MT * HW);
            float* fo = part == 1 ? a.f_sbk : part == 2 ? a.f_sbv : part == 4 ? a.f_cbk : part == 5 ? a.f_cbv : nullptr;
            const bool band = part >= 4; const float qs = (part == 0 || part == 3) ? QSCALE : 1.f;
#pragma unroll
            for (int ai = 0; ai < 2; ++ai)
#pragma unroll
                for (int m = 0; m < 4; ++m) {
                    const int row = u.pm * 256 + ai * 128 + wr * 64 + m * 16 + fr;
                    const float rs = rstd_of(a.ss_in[row]) * qs;
                    const int t = row & (SEQ - 1);
                    float* frow = nullptr;
                    if (fo) { if (!band) frow = fo + (size_t)row * HW; else if (t >= SEQ - BANDL) frow = fo + ((size_t)(row >> 11) * BANDL + (t - (SEQ - BANDL))) * HW; }
#pragma unroll
                    for (int bj = 0; bj < 2; ++bj)
#pragma unroll
                        for (int n = 0; n < 2; ++n) {
                            const int col = cb + bj * 128 + n * 16; const f32x4 v = acc[ai][bj][m][n] * rs;
                            u32x2 w; w.x = pk2(v[0], v[1]); w.y = pk2(v[2], v[3]);
                            *(u32x2*)(ob + (size_t)row * HW + col) = w;
                            if (frow) *(f32x4*)(frow + col) = v;
                        }
                }
        } else if constexpr (MODE == EP_RES || MODE == EP_PLE) {
#pragma unroll
            for (int ai = 0; ai < 2; ++ai)
#pragma unroll
                for (int m = 0; m < 4; ++m) {
                    const int row = u.pm * 256 + ai * 128 + wr * 64 + m * 16 + fr;
                    float rs = 0.f; if constexpr (MODE == EP_PLE) rs = rstd_of(a.ss_in[row]) * (-LOG2E);
                    float s = 0.f;
#pragma unroll
                    for (int bj = 0; bj < 2; ++bj)
#pragma unroll
                        for (int n = 0; n < 2; ++n) {
                            const size_t off = (size_t)row * DM + u.pn * 256 + bj * 128 + wc * 32 + n * 16 + 4 * fq;
                            const u32x2 xw = *(const u32x2*)(a.xbase + off); f32x4 x = {bf_lo(xw.x), bf_hi(xw.x), bf_lo(xw.y), bf_hi(xw.y)}; const f32x4 c = acc[ai][bj][m][n];
                            if constexpr (MODE == EP_RES) x += c;
                            else { const u32x2 pw = *(const u32x2*)(a.P + off);
                                   x[0] += bf_lo(pw.x) * __builtin_amdgcn_rcpf(1.f + __builtin_amdgcn_exp2f(c[0] * rs));
                                   x[1] += bf_hi(pw.x) * __builtin_amdgcn_rcpf(1.f + __builtin_amdgcn_exp2f(c[1] * rs));
                                   x[2] += bf_lo(pw.y) * __builtin_amdgcn_rcpf(1.f + __builtin_amdgcn_exp2f(c[2] * rs));
                                   x[3] += bf_hi(pw.y) * __builtin_amdgcn_rcpf(1.f + __builtin_amdgcn_exp2f(c[3] * rs)); }
                            u32x2 w; w.x = pk2(x[0], x[1]); w.y = pk2(x[2], x[3]); *(u32x2*)(a.XB + off) = w;
                            s += (x[0] * x[0] + x[1] * x[1]) + (x[2] * x[2] + x[3] * x[3]);
                        }
                    s += __shfl_xor(s, 16); s += __shfl_xor(s, 32);
                    if (fq == 0) unsafeAtomicAdd(a.ss_out + row, s);
                }
        } else if constexpr (MODE == EP_GU) {
#pragma unroll
            for (int ai = 0; ai < 2; ++ai)
#pragma unroll
                for (int m = 0; m < 4; ++m) {
                    const int row = u.pm * 256 + ai * 128 + wr * 64 + m * 16 + fr;
                    const float rs = rstd_of(a.ss_in[row]);
#pragma unroll
                    for (int n = 0; n < 2; ++n) {
                        const int col = u.pn * 128 + wc * 32 + n * 16 + 4 * fq;
                        const f32x4 g = acc[ai][0][m][n] * rs, up = acc[ai][1][m][n] * rs; float h[4];
#pragma unroll
                        for (int e = 0; e < 4; ++e) h[e] = g[e] * up[e] * __builtin_amdgcn_rcpf(1.f + __builtin_amdgcn_exp2f(-LOG2E * g[e]));
                        u32x2 w; w.x = pk2(h[0], h[1]); w.y = pk2(h[2], h[3]);
                        *(u32x2*)(a.o0 + (size_t)row * DFF + col) = w;
                    }
                }
        } else {
#pragma unroll
            for (int ai = 0; ai < 2; ++ai)
#pragma unroll
                for (int m = 0; m < 4; ++m) {
                    const int row = u.pm * 256 + ai * 128 + wr * 64 + m * 16 + fr;
#pragma unroll
                    for (int bj = 0; bj < 2; ++bj)
#pragma unroll
                        for (int n = 0; n < 2; ++n) {
                            const size_t off = (size_t)row * DM + u.pn * 256 + bj * 128 + wc * 32 + n * 16 + 4 * fq; const f32x4 v = acc[ai][bj][m][n];
                            u32x2 w; w.x = pk2(v[0], v[1]); w.y = pk2(v[2], v[3]); *(u32x2*)(a.o0 + off) = w;
                        }
                }
        }
    }
};

template <int MODE, int K>
__device__ __forceinline__ void sgemm(LAS unsigned char* lds, const bf16_t* A, const bf16_t* Bt, int ncol32, const EpiArgs& a) {
    const int tid = fresh_tid(), lane = tid & 63, wave = __builtin_amdgcn_readfirstlane(tid >> 6), r = lane & 31, hh = lane >> 5;
    LAS float* red = (LAS float*)lds;
    constexpr int K8 = K >> 3, NK = K8 / 16, UB = NK > 11 ? 11 : NK;
    static_assert(NK % UB == 0, "sgemm: K split");
    const int G = gridDim.x, nunits = 4 * ncol32;
    for (int j = G - 1 - (int)blockIdx.x; j < nunits; j += G) {
        const int rb = j & 3, c0 = 32 * (j >> 2);
        const int brow0 = (MODE == EP_GU) ? ((c0 >> 7) * 256 + (c0 & 127)) : c0;
        const bf16_t* ap = A + (size_t)(32 * rb + r) * K + wave * K8 + 8 * hh;
        const bf16_t* bp = Bt + (size_t)(brow0 + r) * K + wave * K8 + 8 * hh;
        f32x16 acc0 = {}, acc1 = {};
#pragma unroll 1
        for (int kb = 0; kb < NK; kb += UB) {
            bf16x8 af[UB], bf[UB], bf2[MODE == EP_GU ? UB : 1];
#pragma unroll
            for (int i = 0; i < UB; ++i) { af[i] = *(const bf16x8*)(ap + (kb + i) * 16); bf[i] = *(const bf16x8*)(bp + (kb + i) * 16);
                if constexpr (MODE == EP_GU) bf2[i] = *(const bf16x8*)(bp + (size_t)128 * K + (kb + i) * 16); }
#pragma unroll
            for (int i = 0; i < UB; ++i) { acc0 = __builtin_amdgcn_mfma_f32_32x32x16_bf16(af[i], bf[i], acc0, 0, 0, 0);
                if constexpr (MODE == EP_GU) acc1 = __builtin_amdgcn_mfma_f32_32x32x16_bf16(af[i], bf2[i], acc1, 0, 0, 0); }
        }
#pragma unroll
        for (int i = 0; i < 16; ++i) { red[(wave * 16 + i) * 64 + lane] = acc0[i]; if constexpr (MODE == EP_GU) red[8192 + (wave * 16 + i) * 64 + lane] = acc1[i]; }
        __syncthreads();
        const int col = c0 + r;
#pragma unroll
        for (int ii = 0; ii < 2; ++ii) {
            const int i = 2 * wave + ii;
            float v0 = 0.f, v1 = 0.f;
#pragma unroll
            for (int w = 0; w < 8; ++w) { v0 += red[(w * 16 + i) * 64 + lane]; if constexpr (MODE == EP_GU) v1 += red[8192 + (w * 16 + i) * 64 + lane]; }
            const int rs_ = 32 * rb + (i & 3) + 8 * (i >> 2) + 4 * hh, row = MP + rs_;
            if constexpr (MODE == EP_QKV) {
                const int part = c0 >> 9, cc = col & 511;
                const float v = v0 * rstd_of(a.ss_in[row]);
                const float qs = (part == 0 || part == 3) ? QSCALE : 1.f;
                (a.o0 + (size_t)part * ((size_t)MT * HW))[(size_t)row * HW + cc] = (bf16_t)(pk2(v * qs, 0.f) & 0xffffu);
                float* fo = part == 1 ? a.s_sbk : part == 2 ? a.s_sbv : part == 4 ? a.s_cbk : part == 5 ? a.s_cbv : nullptr;
                if (fo) fo[(size_t)rs_ * HW + cc] = v;
            } else if constexpr (MODE == EP_RES || MODE == EP_PLE) {
                const size_t off = (size_t)row * DM + col;
                float x = __uint_as_float((unsigned)a.xbase[off] << 16);
                if constexpr (MODE == EP_RES) x += v0;
                else { const float pv = __uint_as_float((unsigned)a.P[off] << 16); x += pv * __builtin_amdgcn_rcpf(1.f + __builtin_amdgcn_exp2f(-LOG2E * v0 * rstd_of(a.ss_in[row]))); }
                a.XB[off] = (bf16_t)(pk2(x, 0.f) & 0xffffu);
                float s = x * x;
                s += __shfl_xor(s, 1); s += __shfl_xor(s, 2); s += __shfl_xor(s, 4); s += __shfl_xor(s, 8); s += __shfl_xor(s, 16);
                if (r == 0) unsafeAtomicAdd(a.ss_out + row, s);
            } else if constexpr (MODE == EP_GU) {
                const float rs = rstd_of(a.ss_in[row]); const float g = v0 * rs, up = v1 * rs;
                const float h = g * up * __builtin_amdgcn_rcpf(1.f + __builtin_amdgcn_exp2f(-LOG2E * g));
                a.o0[(size_t)row * DFF + col] = (bf16_t)(pk2(h, 0.f) & 0xffffu);
            } else {
                a.o0[(size_t)row * DM + col] = (bf16_t)(pk2(v0, 0.f) & 0xffffu);
            }
        }
        __syncthreads();
    }
}
struct AttnArgs { int L; };
constexpr int AW_V = 0, AW_ST = 4096, AW_BIAS = 8704, AW_BYTES = 10240, ST_PITCH = 144;

template <bool F32> __device__ __forceinline__ void ld_k(bf16x8 (&kf)[4], const void* base, size_t off) {
    if constexpr (!F32) { const bf16_t* p = (const bf16_t*)base + off;
#pragma unroll
        for (int kk = 0; kk < 4; ++kk) kf[kk] = *(const bf16x8*)(p + 8 * kk);
    } else { const float* p = (const float*)base + off;
#pragma unroll
        for (int kk = 0; kk < 4; ++kk) { const f32x4 x = *(const f32x4*)(p + 8 * kk), y = *(const f32x4*)(p + 8 * kk + 4);
            u32x4 w; w.x = pk2(x[0], x[1]); w.y = pk2(x[2], x[3]); w.z = pk2(y[0], y[1]); w.w = pk2(y[2], y[3]); kf[kk] = __builtin_bit_cast(bf16x8, w); }
    }
}
template <bool F32> __device__ __forceinline__ void ld_v(u32x4 (&vr)[4], const void* base, size_t row0, int nvalid, int h, int lane) {
#pragma unroll
    for (int i = 0; i < 4; ++i) { int key = 8 * i + (lane >> 3); key = key < nvalid ? key : nvalid - 1;
        const size_t off = (row0 + key) * HW + h * 64 + (lane & 7) * 8;
        if constexpr (!F32) vr[i] = *(const u32x4*)((const bf16_t*)base + off);
        else { const float* p = (const float*)base + off; const f32x4 x = *(const f32x4*)p, y = *(const f32x4*)(p + 4);
            u32x4 w; w.x = pk2(x[0], x[1]); w.y = pk2(x[2], x[3]); w.z = pk2(y[0], y[1]); w.w = pk2(y[2], y[3]); vr[i] = w; }
    }
}
__device__ __forceinline__ void st_v(LAS unsigned char* vl, const u32x4 (&vr)[4], int lane) {
#pragma unroll
    for (int i = 0; i < 4; ++i) { const int key = 8 * i + (lane >> 3); *(LAS u32x4*)(vl + key * 128 + (((lane & 7) * 16) ^ (((key >> 1) & 1) << 6))) = vr[i]; }
}
typedef short v4i16_t __attribute__((ext_vector_type(4)));
__device__ __forceinline__ s16x4 vtr(LAS unsigned char* p) { return __builtin_bit_cast(s16x4, __builtin_amdgcn_ds_read_tr16_b64_v4i16((LAS v4i16_t*)p)); }
__device__ __forceinline__ void pv_block(f32x16 (&o)[2], LAS unsigned char* vl, const bf16x8 (&pf)[2], int lane) {
    const int q = (lane & 15) >> 2, p = lane & 3, c16 = (lane >> 4) & 1, hh = lane >> 5;
    const int va0 = (4 * hh + q) * 128 + ((32 * c16 + 8 * p) ^ ((q >> 1) << 6));
#pragma unroll
    for (int db = 0; db < 2; ++db)
#pragma unroll
        for (int s = 0; s < 2; ++s) {
            const s16x4 lo = vtr(vl + (va0 ^ (db * 64)) + s * 2048), hi = vtr(vl + (va0 ^ (db * 64)) + s * 2048 + 1024);
            const bf16x8 vf = {lo[0], lo[1], lo[2], lo[3], hi[0], hi[1], hi[2], hi[3]};
            o[db] = __builtin_amdgcn_mfma_f32_32x32x16_bf16(vf, pf[s], o[db], 0, 0, 0);
        }
}
__device__ __forceinline__ f32x16 qk_block(const bf16x8 (&kf)[4], const bf16x8 (&qf)[4]) {
    f32x16 S = {};
#pragma unroll
    for (int kk = 0; kk < 4; ++kk) S = __builtin_amdgcn_mfma_f32_32x32x16_bf16(kf[kk], qf[kk], S, 0, 0, 0);
    return S;
}
__device__ __forceinline__ void sb_block(const f32x16& S, LAS unsigned char* vl, int tq, int keypos0, float& carry, f32x16 (&o)[2], int lane) {
    const int hh = lane >> 5;
    float kp_[16], be[16];
#pragma unroll
    for (int r = 0; r < 16; ++r) {
        const int kp = keypos0 + (r & 3) + 8 * (r >> 2) + 4 * hh; const bool valid = kp < tq;
        const float z = __builtin_amdgcn_fmed3f(S[r], -126.f, 100.f);
        const float t = __builtin_amdgcn_exp2f(z), k = __builtin_amdgcn_rcpf(1.f + t);
        kp_[r] = valid ? k : 1.f; be[r] = valid ? t * k : 0.f;
    }
    float T[4], Tp[4], U[4];
#pragma unroll
    for (int g = 0; g < 4; ++g) { T[g] = (kp_[4 * g] * kp_[4 * g + 1]) * (kp_[4 * g + 2] * kp_[4 * g + 3]); Tp[g] = partner32(T[g]); U[g] = T[g] * Tp[g]; }
    float R[4]; R[3] = 1.f; R[2] = U[3]; R[1] = U[3] * U[2]; R[0] = R[1] * U[1];
    const float tot = R[0] * U[0];
    float w[16];
#pragma unroll
    for (int g = 0; g < 4; ++g) {
        const float b3 = carry * R[g] * (hh == 0 ? Tp[g] : 1.f);
        const float b2 = b3 * kp_[4 * g + 3], b1 = b2 * kp_[4 * g + 2], b0 = b1 * kp_[4 * g + 1];
        w[4 * g + 3] = be[4 * g + 3] * b3; w[4 * g + 2] = be[4 * g + 2] * b2; w[4 * g + 1] = be[4 * g + 1] * b1; w[4 * g + 0] = be[4 * g + 0] * b0;
    }
    carry *= tot;
    bf16x8 pf[2];
#pragma unroll
    for (int s = 0; s < 2; ++s) { u32x4 pw; pw.x = pk2(w[8 * s], w[8 * s + 1]); pw.y = pk2(w[8 * s + 2], w[8 * s + 3]); pw.z = pk2(w[8 * s + 4], w[8 * s + 5]); pw.w = pk2(w[8 * s + 6], w[8 * s + 7]); pf[s] = __builtin_bit_cast(bf16x8, pw); }
    pv_block(o, vl, pf, lane);
}
__device__ __forceinline__ void cb_block(const f32x16& S, bool cbias, LAS unsigned char* vl, const LAS float* bl, int tq, int keypos0, int nvalid, float& m, float& l, f32x16 (&o)[2], int lane) {
    const int hh = lane >> 5;
    float s[16]; float bm = -INFINITY;
    if (cbias) {
        const float cb = bl[256];
#pragma unroll
        for (int r = 0; r < 16; ++r) { s[r] = S[r] + cb; bm = fmaxf(bm, s[r]); }
    } else {
#pragma unroll
        for (int r = 0; r < 16; ++r) {
            const int kr = (r & 3) + 8 * (r >> 2) + 4 * hh; int d = tq - (keypos0 + kr); d = d < -128 ? -128 : (d > 128 ? 128 : d);
            s[r] = (kr < nvalid) ? S[r] + bl[d + 128] : -INFINITY; bm = fmaxf(bm, s[r]);
        }
    }
    bm = fmaxf(bm, partner32(bm));
    if (__any(bm > m + 8.f)) {
        const float mn = fmaxf(m, bm), f = __builtin_amdgcn_exp2f(m - mn); m = mn; l *= f;
#pragma unroll
        for (int db = 0; db < 2; ++db)
#pragma unroll
            for (int r = 0; r < 16; ++r) o[db][r] *= f;
    }
    float w[16], ls = 0.f;
#pragma unroll
    for (int r = 0; r < 16; ++r) { w[r] = __builtin_amdgcn_exp2f(s[r] - m); ls += w[r]; }
    l += ls;
    bf16x8 pf[2];
#pragma unroll
    for (int s2 = 0; s2 < 2; ++s2) { u32x4 pw; pw.x = pk2(w[8 * s2], w[8 * s2 + 1]); pw.y = pk2(w[8 * s2 + 2], w[8 * s2 + 3]); pw.z = pk2(w[8 * s2 + 4], w[8 * s2 + 5]); pw.w = pk2(w[8 * s2 + 6], w[8 * s2 + 7]); pf[s2] = __builtin_bit_cast(bf16x8, pw); }
    pv_block(o, vl, pf, lane);
}
__device__ __forceinline__ void attn_store(f32x16 (&o)[2], float scale, const float* gain, bf16_t* mix, size_t row0, int col0, int nrows, LAS unsigned char* wl, int lane) {
    const int r = lane & 31, hh = lane >> 5;
    f32x4 gvs[2][4];
#pragma unroll
    for (int db = 0; db < 2; ++db)
#pragma unroll
        for (int g = 0; g < 4; ++g) gvs[db][g] = *(const f32x4*)(gain + 32 * db + 8 * g + 4 * hh);
    float ssq = 0.f;
#pragma unroll
    for (int db = 0; db < 2; ++db)
#pragma unroll
        for (int i = 0; i < 16; ++i) { o[db][i] *= scale; ssq += o[db][i] * o[db][i]; }
    ssq += partner32(ssq);
    const float rstd = rsqrtf(ssq * (1.0f / 64.0f) + EPS);
    LAS unsigned char* st = wl + AW_ST;
#pragma unroll
    for (int db = 0; db < 2; ++db)
#pragma unroll
        for (int g = 0; g < 4; ++g) { const int d0 = 32 * db + 8 * g + 4 * hh; const f32x4 gv = gvs[db][g];
            u32x2 w; w.x = pk2(o[db][4 * g] * rstd * gv[0], o[db][4 * g + 1] * rstd * gv[1]); w.y = pk2(o[db][4 * g + 2] * rstd * gv[2], o[db][4 * g + 3] * rstd * gv[3]);
            *(LAS u32x2*)(st + r * ST_PITCH + d0 * 2) = w; }
#pragma unroll
    for (int i = 0; i < 4; ++i) { const int row = 8 * i + (lane >> 3), ch = lane & 7; const u32x4 v = *(const LAS u32x4*)(st + row * ST_PITCH + ch * 16);
        if (row < nrows) *(u32x4*)(mix + (row0 + row) * DM + col0 + ch * 8) = v; }
}

template <bool F32> __device__ __forceinline__ void sb_loop(const void* kbase, const void* vbase, size_t rowbase, int jhi, int h, const bf16x8 (&qf)[4], int tq, float& carry, f32x16 (&o)[2], LAS unsigned char* wl, int lane) {
    const int r = lane & 31, hh = lane >> 5;
    bf16x8 kA[4], kB[4]; u32x4 vA[4], vB[4];
#define SB_LD(KF, VN, jj) do { ld_k<F32>(KF, kbase, (rowbase + 32 * (jj) + r) * HW + h * 64 + 32 * hh); ld_v<F32>(VN, vbase, rowbase + 32 * (jj), 32, h, lane); } while (0)
    SB_LD(kA, vA, jhi); if (jhi >= 1) SB_LD(kB, vB, jhi - 1);
    for (int j = jhi; j >= 0; j -= 2) {
        { const f32x16 S = qk_block(kA, qf); st_v(wl + AW_V, vA, lane); if (j >= 2) SB_LD(kA, vA, j - 2);
          sb_block(S, wl + AW_V, tq, 32 * j, carry, o, lane); }
#if SB_EARLY
        if (__all(carry < SB_THR)) break;
#endif
        if (j < 1) break;
        { const f32x16 S = qk_block(kB, qf); st_v(wl + AW_V, vB, lane); if (j >= 3) SB_LD(kB, vB, j - 3);
          sb_block(S, wl + AW_V, tq, 32 * (j - 1), carry, o, lane); }
#if SB_EARLY
        if (__all(carry < SB_THR)) break;
#endif
    }
#undef SB_LD
}
template <bool SAMPLE> __device__ __forceinline__ void sb_unit(const AttnArgs& A, int b, int h, int qb, LAS unsigned char* wl, int lane) {
    const int r = lane & 31, hh = lane >> 5;
    const bf16_t* Qa = QKV_; const bf16_t* Ka = Qa + (size_t)1 * MT * HW; const bf16_t* Va = Qa + (size_t)2 * MT * HW;
    int tq; size_t qrow;
    if (SAMPLE) { tq = PAST + (r & 15); qrow = (size_t)MP + b * DSEQ + (r & 15); } else { tq = 32 * qb + r; qrow = (size_t)b * SEQ + tq; }
    bf16x8 qf[4]; ld_k<false>(qf, Qa, qrow * HW + h * 64 + 32 * hh);
    float carry = 1.f; f32x16 o[2]; o[0] = f32x16{}; o[1] = f32x16{};
    if (SAMPLE) {
        bf16x8 kf[4]; u32x4 vr[4]; const size_t row0 = (size_t)MP + b * DSEQ;
        ld_k<false>(kf, Ka, (row0 + (r & 15)) * HW + h * 64 + 32 * hh); ld_v<false>(vr, Va, row0, DSEQ, h, lane); st_v(wl + AW_V, vr, lane);
        { const f32x16 S = qk_block(kf, qf); sb_block(S, wl + AW_V, tq, PAST, carry, o, lane); }
        sb_loop<true>(ARG(4) + (size_t)A.L * NBATCH * PAST * HW, ARG(5) + (size_t)A.L * NBATCH * PAST * HW, (size_t)b * PAST, PAST / 32 - 1, h, qf, tq, carry, o, wl, lane);
        attn_store(o, 1.f, ARG(11) + A.L * HW + h * 64, MIX_, row0, h * 64, DSEQ, wl, lane);
    } else {
        sb_loop<false>(Ka, Va, (size_t)b * SEQ, qb, h, qf, tq, carry, o, wl, lane);
        attn_store(o, 1.f, ARG(11) + A.L * HW + h * 64, MIX_, (size_t)b * SEQ + 32 * qb, h * 64, 32, wl, lane);
    }
}
template <bool F32> __device__ __forceinline__ void cb_loop(const void* kbase, const void* vbase, size_t rowbase, int jlo, int jhi, int pos0, int h, const bf16x8 (&qf)[4], int tq, float& m, float& l, f32x16 (&o)[2], LAS unsigned char* wl, int lane) {
    const int r = lane & 31, hh = lane >> 5;
    bf16x8 kA[4], kB[4]; u32x4 vA[4], vB[4];
    const int tqmin = tq - r;
#define CB_LD(KF, VN, jj) do { ld_k<F32>(KF, kbase, (rowbase + 32 * (jj) + r) * HW + h * 64 + 32 * hh); ld_v<F32>(VN, vbase, rowbase + 32 * (jj), 32, h, lane); } while (0)
    CB_LD(kA, vA, jlo); if (jlo + 1 <= jhi) CB_LD(kB, vB, jlo + 1);
    for (int j = jlo; j <= jhi; j += 2) {
        { const f32x16 S = qk_block(kA, qf); st_v(wl + AW_V, vA, lane); if (j + 2 <= jhi) CB_LD(kA, vA, j + 2);
          const bool cbias = __builtin_amdgcn_readfirstlane(pos0 + 32 * j + 31 + 128 <= tqmin);
          cb_block(S, cbias, wl + AW_V, (const LAS float*)(wl + AW_BIAS), tq, pos0 + 32 * j, 32, m, l, o, lane); }
        if (j + 1 > jhi) break;
        { const f32x16 S = qk_block(kB, qf); st_v(wl + AW_V, vB, lane); if (j + 3 <= jhi) CB_LD(kB, vB, j + 3);
          const bool cbias = __builtin_amdgcn_readfirstlane(pos0 + 32 * (j + 1) + 31 + 128 <= tqmin);
          cb_block(S, cbias, wl + AW_V, (const LAS float*)(wl + AW_BIAS), tq, pos0 + 32 * (j + 1), 32, m, l, o, lane); }
    }
#undef CB_LD
}
template <bool SAMPLE> __device__ __forceinline__ void cb_unit(const AttnArgs& A, int b, int h, int qb, LAS unsigned char* wl, int lane) {
    const int r = lane & 31, hh = lane >> 5;
    const bf16_t* Qb = QKV_ + (size_t)3 * MT * HW; const bf16_t* Kb = Qb + (size_t)1 * MT * HW; const bf16_t* Vb = Qb + (size_t)2 * MT * HW;
    LAS float* bl = (LAS float*)(wl + AW_BIAS);
    { const float* relp = ARG(10) + (size_t)A.L * 257 * 8 + h; float bv[5];
#pragma unroll
      for (int i = 0; i < 5; ++i) { const int idx = lane + 64 * i; bv[i] = relp[(idx < 257 ? idx : 256) * 8]; }
#pragma unroll
      for (int i = 0; i < 5; ++i) { const int idx = lane + 64 * i; if (idx < 257) bl[idx] = bv[i] * LOG2E; } }
    int tq; size_t qrow;
    if (SAMPLE) { tq = PAST + (r & 15); qrow = (size_t)MP + b * DSEQ + (r & 15); } else { tq = 32 * qb + r; qrow = (size_t)b * SEQ + tq; }
    bf16x8 qf[4]; ld_k<false>(qf, Qb, qrow * HW + h * 64 + 32 * hh);
    float m = -INFINITY, l = 0.f; f32x16 o[2]; o[0] = f32x16{}; o[1] = f32x16{};
    if (SAMPLE) {
        cb_loop<true>(ARG(6) + (size_t)A.L * NBATCH * BANDL * HW, ARG(7) + (size_t)A.L * NBATCH * BANDL * HW, (size_t)b * BANDL, 0, BANDL / 32 - 1, PAST - BANDL, h, qf, tq, m, l, o, wl, lane);
        bf16x8 kf[4]; u32x4 vr[4]; const size_t row0 = (size_t)MP + b * DSEQ;
        ld_k<false>(kf, Kb, (row0 + (r & 15)) * HW + h * 64 + 32 * hh); ld_v<false>(vr, Vb, row0, DSEQ, h, lane); st_v(wl + AW_V, vr, lane);
        { const f32x16 S = qk_block(kf, qf); cb_block(S, false, wl + AW_V, bl, tq, PAST, DSEQ, m, l, o, lane); }
        l += partner32(l);
        attn_store(o, 1.0f / l, ARG(12) + A.L * HW + h * 64, MIX_, row0, HW + h * 64, DSEQ, wl, lane);
    } else {
        const int c = qb >> 1, clo = c - 8 < 0 ? 0 : c - 8;
        cb_loop<false>(Kb, Vb, (size_t)b * SEQ, 2 * clo, 2 * c + 1, 0, h, qf, tq, m, l, o, wl, lane);
        l += partner32(l);
        attn_store(o, 1.0f / l, ARG(12) + A.L * HW + h * 64, MIX_, (size_t)b * SEQ + 32 * qb, HW + h * 64, 32, wl, lane);
    }
}
__device__ __forceinline__ void cb_unit_p64(const AttnArgs& A, int b, int h, int c, LAS unsigned char* wl, int lane) {
    const int r = lane & 31, hh = lane >> 5;
    const bf16_t* Qb = QKV_ + (size_t)3 * MT * HW; const bf16_t* Kb = Qb + (size_t)1 * MT * HW; const bf16_t* Vb = Qb + (size_t)2 * MT * HW;
    LAS float* bl = (LAS float*)(wl + AW_BIAS);
    { const float* relp = ARG(10) + (size_t)A.L * 257 * 8 + h; float bv[5];
#pragma unroll
      for (int i = 0; i < 5; ++i) { const int idx = lane + 64 * i; bv[i] = relp[(idx < 257 ? idx : 256) * 8]; }
#pragma unroll
      for (int i = 0; i < 5; ++i) { const int idx = lane + 64 * i; if (idx < 257) bl[idx] = bv[i] * LOG2E; } }
    const int tq0 = 64 * c + r, tq1 = tq0 + 32; const size_t rowbase = (size_t)b * SEQ;
    bf16x8 qf0[4], qf1[4];
    ld_k<false>(qf0, Qb, (rowbase + tq0) * HW + h * 64 + 32 * hh); ld_k<false>(qf1, Qb, (rowbase + tq1) * HW + h * 64 + 32 * hh);
    float m0 = -INFINITY, l0 = 0.f, m1 = -INFINITY, l1 = 0.f;
    f32x16 o0[2], o1[2]; o0[0] = f32x16{}; o0[1] = f32x16{}; o1[0] = f32x16{}; o1[1] = f32x16{};
    const int clo = c - 8 < 0 ? 0 : c - 8, jlo = 2 * clo, jhi = 2 * c + 1;
    bf16x8 kf[4]; u32x4 vn[4];
    ld_k<false>(kf, Kb, (rowbase + 32 * jlo + r) * HW + h * 64 + 32 * hh); ld_v<false>(vn, Vb, rowbase + 32 * jlo, 32, h, lane);
    for (int j = jlo; j <= jhi; ++j) {
        const f32x16 S0 = qk_block(kf, qf0), S1 = qk_block(kf, qf1);
        st_v(wl + AW_V, vn, lane);
        if (j < jhi) { ld_k<false>(kf, Kb, (rowbase + 32 * (j + 1) + r) * HW + h * 64 + 32 * hh); ld_v<false>(vn, Vb, rowbase + 32 * (j + 1), 32, h, lane); }
        const bool cbias = (32 * j + 31 + 128 <= 64 * c);
        cb_block(S0, cbias, wl + AW_V, bl, tq0, 32 * j, 32, m0, l0, o0, lane);
        cb_block(S1, cbias, wl + AW_V, bl, tq1, 32 * j, 32, m1, l1, o1, lane);
    }
    l0 += partner32(l0); l1 += partner32(l1);
    attn_store(o0, 1.0f / l0, ARG(12) + A.L * HW + h * 64, MIX_, rowbase + 64 * c, HW + h * 64, 32, wl, lane);
    attn_store(o1, 1.0f / l1, ARG(12) + A.L * HW + h * 64, MIX_, rowbase + 64 * c + 32, HW + h * 64, 32, wl, lane);
}
constexpr unsigned AU_PCB = 2048, AU_SSB = 64, AU_SCB = 128, AU_ALL = 128 + 2048;
__device__ __forceinline__ void attn_phase(const AttnArgs& A, LAS unsigned char* lds) {
    const int tid_ = fresh_tid(), lane = tid_ & 63, wave = __builtin_amdgcn_readfirstlane(tid_ >> 6);
    LAS unsigned char* wl = lds + wave * AW_BYTES;
    unsigned u = 0; if (lane == 0) u = atomicAdd(WS_PTR(unsigned, WS_CTL) + A.L, 1u);
    for (int cu = (int)blockIdx.x * NWAVES + wave; cu < (int)AU_PCB; cu += (int)gridDim.x * NWAVES) { const int bh = cu >> 5; cb_unit_p64(A, bh >> 3, bh & 7, 31 - (cu & 31), wl, lane); }
    u = __builtin_amdgcn_readfirstlane(u);
    for (;;) {
        if (u >= AU_ALL) break;
        unsigned un = 0; if (lane == 0) un = atomicAdd(WS_PTR(unsigned, WS_CTL) + A.L, 1u);
        if (u < AU_SSB) sb_unit<true>(A, u >> 3, u & 7, 0, wl, lane);
        else if (u < AU_SCB) { const unsigned v = u - AU_SSB; cb_unit<true>(A, v >> 3, v & 7, 0, wl, lane); }
        else { const unsigned v = u - AU_SCB; const int bh = v >> 5, qb = 63 - 2 * (int)(v & 31);
#pragma unroll 1
               for (int t = 0; t < 2; ++t) sb_unit<false>(A, bh >> 3, bh & 7, qb - t, wl, lane); }
        u = __builtin_amdgcn_readfirstlane(un);
    }
}
typedef unsigned gu32_plain;
#define XB_TMO      128
#define XB_XCNT(j)  (256  + 64 * (j))
#define XB_XSUB(j)  (1280 + 64 * (j))
#define XB_XGEN(j)  (2304 + 64 * (j))
#define XB_TOP      3328
#define XB_TOPGEN   3392
#define XCD_BAR_WORDS 3456
#define XB_SPIN_CAP (1u << 18)

__device__ __forceinline__ unsigned xb_ld(unsigned* p)              { return __hip_atomic_load(p, __ATOMIC_RELAXED, __HIP_MEMORY_SCOPE_AGENT); }
__device__ __forceinline__ unsigned xb_add(unsigned* p, unsigned v) { return __hip_atomic_fetch_add(p, v, __ATOMIC_RELAXED, __HIP_MEMORY_SCOPE_AGENT); }
__device__ __forceinline__ unsigned xb_xcc_id() { return (unsigned)__builtin_amdgcn_s_getreg((3 << 11) | 20) & 0xFu; }
#define XB_SPIN(cond, bar) do { unsigned _sp = 0; while (cond) { __builtin_amdgcn_s_sleep(1); \
    if ((++_sp & 255u) == 0u) { if (xb_ld(&(bar)[XB_TMO])) break; if (_sp > XB_SPIN_CAP) { atomicAdd(&(bar)[XB_TMO], 1u); break; } } } } while (0)

struct XcdBarrier {
    unsigned* bar; unsigned x;
    volatile LAS unsigned* st;
};

__device__ __forceinline__ XcdBarrier xcd_barrier_post(unsigned* bar, volatile LAS unsigned* st) {
    XcdBarrier b; b.bar = bar; b.x = xb_xcc_id(); b.st = st;
    if (threadIdx.x == 0) (void)xb_add(&bar[XB_XCNT(b.x)], 1u);
    return b;
}
__device__ __forceinline__ void xcd_barrier_complete(unsigned* bar, unsigned x, unsigned& nloc, unsigned& nx) {
    const unsigned G = gridDim.x * gridDim.y * gridDim.z;
    unsigned sum, cnt, mine, sp = 0u;
    for (;;) {
        sum = 0u; cnt = 0u; mine = 0u;
#pragma unroll
        for (unsigned j = 0; j < 16; ++j) { const unsigned c = xb_ld(&bar[XB_XCNT(j)]); sum += c; cnt += (c > 0u) ? 1u : 0u; mine = (j == x) ? c : mine; }
        if (sum == G) break;
        __builtin_amdgcn_s_sleep(1);
        if ((++sp & 255u) == 0u) { if (xb_ld(&bar[XB_TMO])) break; if (sp > XB_SPIN_CAP) { atomicAdd(&bar[XB_TMO], 1u); break; } }
    }
    nloc = mine > 0u ? mine : 1u; nx = cnt > 0u ? cnt : 1u;
}

__device__ __forceinline__ void xcd_barrier(const XcdBarrier& b) {
    asm volatile("s_waitcnt vmcnt(0)" ::: "memory");
    __syncthreads();
    if (threadIdx.x == 0) {
        unsigned* bar = b.bar;
        __builtin_amdgcn_s_waitcnt(0);
        unsigned nloc = b.st[0], nx = b.st[1];
        if (nloc == 0u) { xcd_barrier_complete(bar, b.x, nloc, nx); b.st[0] = nloc; b.st[1] = nx; }
        const unsigned old = xb_add(&bar[XB_XSUB(b.x)], 1u);
        const unsigned gen = old / nloc;
        if (old + 1u == (gen + 1u) * nloc) {
            __builtin_amdgcn_fence(__ATOMIC_RELEASE, "agent");
            asm volatile("s_waitcnt vmcnt(0)" ::: "memory");
            const unsigned og = xb_add(&bar[XB_TOP], 1u);
            const unsigned tg = og / nx;
            if (og + 1u == (tg + 1u) * nx) xb_add(&bar[XB_TOPGEN], 1u);
            else XB_SPIN(xb_ld(&bar[XB_TOPGEN]) == tg, bar);
            __builtin_amdgcn_fence(__ATOMIC_ACQUIRE, "agent");
            xb_add(&bar[XB_XGEN(b.x)], 1u);
            asm volatile("s_waitcnt vmcnt(0)" ::: "memory");
        } else {
            XB_SPIN(xb_ld(&bar[XB_XGEN(b.x)]) == gen, bar);
            __builtin_amdgcn_fence(__ATOMIC_ACQUIRE, "agent");
            asm volatile("s_waitcnt vmcnt(0)" ::: "memory");
        }
    }
    __syncthreads();
}

constexpr int CI_IN = 16 * 96, CI_OUT = 16 * 32, CI_G = 16 * 88, CI_D = 44 * 32, CI_PG = 16 * 32, CI_PP = 4 * 32, CI_L = CI_IN + CI_OUT + 2 * CI_G + CI_D + CI_PG + CI_PP;
struct ConvD { const float* W; const float* gain; bf16_t* WT; int K, N, kind, k0, n0; };
__device__ __forceinline__ ConvD conv_decode(int it) {
    const int L = it / CI_L; int r = it % CI_L; ConvD d;
    if (r < CI_IN) { d.W = ARG(9) + (size_t)L * DM * NQKV; d.gain = ARG(8) + L * DM; d.WT = (bf16_t*)WPTR(L, W_IN); d.K = DM; d.N = NQKV; d.kind = 0; }
    else if ((r -= CI_IN) < CI_OUT) { d.W = ARG(13) + (size_t)L * DM * DM; d.gain = nullptr; d.WT = (bf16_t*)WPTR(L, W_OUT); d.K = DM; d.N = DM; d.kind = 0; }
    else if ((r -= CI_OUT) < CI_G) { d.W = ARG(15) + (size_t)L * DM * DFF; d.gain = ARG(14) + L * DM; d.WT = (bf16_t*)WPTR(L, W_GU); d.K = DM; d.N = DFF; d.kind = 1; }
    else if ((r -= CI_G) < CI_G) { d.W = ARG(16) + (size_t)L * DM * DFF; d.gain = ARG(14) + L * DM; d.WT = (bf16_t*)WPTR(L, W_GU); d.K = DM; d.N = DFF; d.kind = 2; }
    else if ((r -= CI_G) < CI_D) { d.W = ARG(17) + (size_t)L * DFF * DM; d.gain = nullptr; d.WT = (bf16_t*)WPTR(L, W_DOWN); d.K = DFF; d.N = DM; d.kind = 0; }
    else if ((r -= CI_D) < CI_PG) { d.W = ARG(19) + (size_t)L * DM * DM; d.gain = ARG(18) + L * DM; d.WT = (bf16_t*)WPTR(L, W_PG); d.K = DM; d.N = DM; d.kind = 0; }
    else { r -= CI_PG; d.W = ARG(20) + (size_t)L * PLED * DM; d.gain = nullptr; d.WT = (bf16_t*)WPTR(L, W_PP); d.K = PLED; d.N = DM; d.kind = 0; }
    const int nblk = d.N / 32; d.k0 = 64 * (r / nblk); d.n0 = 32 * (r % nblk);
    return d;
}
__device__ __forceinline__ void conv_load(const ConvD& d, float (&v)[32], f32x4 (&g)[2], int lane) {
    const float* p = d.W + (size_t)(d.k0 + (lane >> 5)) * d.N + d.n0 + (lane & 31);
#pragma unroll
    for (int i = 0; i < 32; ++i) v[i] = p[(size_t)(2 * i) * d.N];
    if (d.gain) { g[0] = *(const f32x4*)(d.gain + d.k0 + 8 * (lane & 7)); g[1] = *(const f32x4*)(d.gain + d.k0 + 8 * (lane & 7) + 4); }
    else { g[0] = (f32x4){1.f, 1.f, 1.f, 1.f}; g[1] = g[0]; }
}
__device__ __forceinline__ void conv_proc(const ConvD& d, const float (&v)[32], const f32x4 (&g)[2], LAS float* scr, int lane) {
#pragma unroll
    for (int i = 0; i < 32; ++i) scr[(2 * i + (lane >> 5)) * 33 + (lane & 31)] = v[i];
    asm volatile("s_waitcnt lgkmcnt(0)" ::: "memory");
    const int c = lane & 7;
#pragma unroll
    for (int j = 0; j < 4; ++j) { const int n = (lane >> 3) + 8 * j; const LAS float* s = scr + (8 * c) * 33 + n;
        u32x4 o; o.x = pk2(s[0 * 33] * g[0][0], s[1 * 33] * g[0][1]); o.y = pk2(s[2 * 33] * g[0][2], s[3 * 33] * g[0][3]);
        o.z = pk2(s[4 * 33] * g[1][0], s[5 * 33] * g[1][1]); o.w = pk2(s[6 * 33] * g[1][2], s[7 * 33] * g[1][3]);
        const int gn = d.n0 + n; const int drow = d.kind == 0 ? gn : ((gn >> 7) * 256 + (gn & 127) + (d.kind == 2 ? 128 : 0));
        *(u32x4*)(d.WT + (size_t)drow * d.K + d.k0 + 8 * c) = o; }
    asm volatile("s_waitcnt lgkmcnt(0)" ::: "memory");
}

#ifdef NO_SGEMM
#define SG(...)
#else
#define SG(...) __VA_ARGS__
#endif
#ifndef GP1
#define GP1(...) __VA_ARGS__
#endif
#ifndef GP2
#define GP2(...) __VA_ARGS__
#endif
#ifndef GP3
#define GP3(...) __VA_ARGS__
#endif
#ifndef GP4
#define GP4(...) __VA_ARGS__
#endif
#ifndef GP5
#define GP5(...) __VA_ARGS__
#endif
#ifndef GP6
#define GP6(...) __VA_ARGS__
#endif
#ifdef NO_SGEMM
#define SG(...)
#else
#define SG(...) __VA_ARGS__
#endif
#ifndef GP1
#define GP1(...) __VA_ARGS__
#endif
#ifndef GP2
#define GP2(...) __VA_ARGS__
#endif
#ifndef GP3
#define GP3(...) __VA_ARGS__
#endif
#ifndef GP4
#define GP4(...) __VA_ARGS__
#endif
#ifndef GP5
#define GP5(...) __VA_ARGS__
#endif
#ifndef GP6
#define GP6(...) __VA_ARGS__
#endif
struct Args { const float* in[22]; float* out; unsigned char* ws; };

#ifndef PROBE_SEL
#define PROBE_SEL -1
#endif
#if PROBE_SEL >= 0
#define TSTAMP(cat) do { if (blockIdx.x == 0 && fresh_tid() == 0) { const unsigned long long t_ = __builtin_amdgcn_s_memrealtime(); unsigned long long* tsb = WS_PTR(unsigned long long, WS_CTL + 4096); \
    tsb[16 + (cat)] += t_ - tsb[0]; tsb[0] = t_; } } while (0)
#else
#define TSTAMP(cat) do {} while (0)
#endif
__global__ void __launch_bounds__(NTHREADS, 2) hymba_fwd(Args args) {
    extern __shared__ __attribute__((aligned(16))) unsigned char lds_raw[];
    cg::grid_group grid = cg::this_grid();
    LAS unsigned char* lds = (LAS unsigned char*)lds_raw;
    const int G = gridDim.x;

#if PROBE_SEL >= 0
    if (blockIdx.x == 0 && fresh_tid() == 0) { unsigned long long* tsb = WS_PTR(unsigned long long, WS_CTL + 4096); for (int i = 0; i < 48; ++i) tsb[i] = 0; tsb[0] = __builtin_amdgcn_s_memrealtime(); }
#endif
    {
        const int tid = fresh_tid(), lane = tid & 63, wave = __builtin_amdgcn_readfirstlane(tid >> 6);
        const int gw = blockIdx.x * NWAVES + wave, NGW = G * NWAVES;
        { float* ssb = SSB; for (int i = blockIdx.x * NTHREADS + tid; i < 6 * MT; i += G * NTHREADS) ssb[MT + i] = 0.f;
          if (blockIdx.x == 0 && tid < 16) WS_PTR(unsigned, WS_CTL)[tid] = 0u;
          if (blockIdx.x == 0) for (int i = tid; i < XCD_BAR_WORDS; i += NTHREADS) WS_PTR(unsigned, WS_BAR)[i] = 0u;
          if (tid < 2) ((LAS unsigned*)(lds + 131072))[tid] = 0u; }
        LAS float* scr = (LAS float*)(lds + wave * 8704);
        { constexpr int NIT = NLAYER * CI_L; int it = gw;
          float vA[32], vB[32]; f32x4 gA[2], gB[2]; ConvD dA, dB;
          if (it < NIT) { dA = conv_decode(it); conv_load(dA, vA, gA, lane); }
          while (it < NIT) {
            const int itn = it + NGW;
            if (itn < NIT) { dB = conv_decode(itn); conv_load(dB, vB, gB, lane); }
            conv_proc(dA, vA, gA, scr, lane);
            if (itn >= NIT) break;
            it = itn + NGW;
            if (it < NIT) { dA = conv_decode(it); conv_load(dA, vA, gA, lane); }
            conv_proc(dB, vB, gB, scr, lane);
          } }
        { const float* pp = ARG(2); const float* ps = ARG(3); bf16_t* PB = PB_;
          for (int it0 = 4 * gw; it0 < NLAYER * MT; it0 += 4 * NGW) {
            f32x4 v[4];
#pragma unroll
            for (int rr = 0; rr < 4; ++rr) { const int it = it0 + rr, L = it / MT, row = it % MT;
                const float* src = row < MP ? pp + ((size_t)L * MP + row) * PLED : ps + ((size_t)L * MS + (row - MP)) * PLED;
                v[rr] = *((const f32x4*)src + lane); }
#pragma unroll
            for (int rr = 0; rr < 4; ++rr) { u32x2 w; w.x = pk2(v[rr][0], v[rr][1]); w.y = pk2(v[rr][2], v[rr][3]); *((u32x2*)(PB + (size_t)(it0 + rr) * PLED) + lane) = w; }
          } }
        { const float* x_p = ARG(0); const float* x_s = ARG(1); bf16_t* XB = XN_; float* ssb = SSB;
          for (int row0 = 2 * gw; row0 < MT; row0 += 2 * NGW) {
            f32x4 v[2][4];
#pragma unroll
            for (int rr = 0; rr < 2; ++rr) { const int row = row0 + rr; const float* src = row < MP ? x_p + (size_t)row * DM : x_s + (size_t)(row - MP) * DM;
#pragma unroll
                for (int j = 0; j < 4; ++j) v[rr][j] = *((const f32x4*)src + lane + 64 * j); }
#pragma unroll
            for (int rr = 0; rr < 2; ++rr) { float s2 = 0.f;
#pragma unroll
                for (int j = 0; j < 4; ++j) { const f32x4 t = v[rr][j]; s2 += (t[0] * t[0] + t[1] * t[1]) + (t[2] * t[2] + t[3] * t[3]);
                    u32x2 w; w.x = pk2(t[0], t[1]); w.y = pk2(t[2], t[3]); *((u32x2*)(XB + (size_t)(row0 + rr) * DM) + lane + 64 * j) = w; }
                s2 = wave_sum(s2);
                if (lane == 0) ssb[row0 + rr] = s2; }
          } }
    }
    TSTAMP(0); grid.sync(); TSTAMP(8);
    const XcdBarrier xbar = xcd_barrier_post(WS_PTR(unsigned, WS_BAR), (volatile LAS unsigned*)(lds + 131072));
#define GSYNC() xcd_barrier(xbar)

    for (int L = 0; L < NLAYER; ++L) {
#define SS_MIX (SSB + (size_t)(3 * L) * MT)
#define SS_FFN (SSB + (size_t)(3 * L + 1) * MT)
#define SS_PLE (SSB + (size_t)(3 * L + 2) * MT)
#define SS_NEXT (SSB + (size_t)(3 * L + 3) * MT)
        { EpiArgs q{}; q.ss_in = SS_MIX; q.o0 = QKV_;
          q.f_sbk = ARG_OUT + O_SBK_P + (size_t)L * MP * HW; q.f_sbv = ARG_OUT + O_SBV_P + (size_t)L * MP * HW;
          q.f_cbk = ARG_OUT + O_CBK_P + (size_t)L * NBATCH * BANDL * HW; q.f_cbv = ARG_OUT + O_CBV_P + (size_t)L * NBATCH * BANDL * HW;
          pg8::Gemm g{XN_, WPTR(L, W_IN), MP, NQKV, DM}; pg8::StaticOrder S; S.init(MP, NQKV, G, (int)blockIdx.x);
          Epi<EP_QKV> E{q};
          GP1(pg8::gemm_phase<Epi<EP_QKV>, pg8::StaticOrder, true, true>(lds, g, S, E);) TSTAMP(1); }
        { EpiArgs q{}; q.ss_in = SS_MIX; q.o0 = QKV_;
          q.s_sbk = ARG_OUT + O_SBK_S + (size_t)L * MS * HW; q.s_sbv = ARG_OUT + O_SBV_S + (size_t)L * MS * HW;
          q.s_cbk = ARG_OUT + O_CBK_S + (size_t)L * MS * HW; q.s_cbv = ARG_OUT + O_CBV_S + (size_t)L * MS * HW;
          SG(sgemm<EP_QKV, DM>(lds, XN_ + (size_t)MP * DM, WPTR(L, W_IN), NQKV / 32, q);) TSTAMP(7); }
        GSYNC(); TSTAMP(8);
        { AttnArgs A{}; A.L = L;
#ifndef NO_ATTN
          attn_phase(A, lds);
#endif
          TSTAMP(2); }
        GSYNC(); TSTAMP(2);
        { EpiArgs q{}; q.XB = XB_; q.xbase = XN_; q.ss_out = SS_FFN;
          pg8::Gemm g{MIX_, WPTR(L, W_OUT), MP, DM, DM}; pg8::StaticOrder S; S.init(MP, DM, G, (int)blockIdx.x);
          Epi<EP_RES> E{q};
          GP2(pg8::gemm_phase<Epi<EP_RES>, pg8::StaticOrder, true, true>(lds, g, S, E);) TSTAMP(3); }
        { EpiArgs q{}; q.XB = XB_; q.xbase = XN_; q.ss_out = SS_FFN;
          SG(sgemm<EP_RES, DM>(lds, MIX_ + (size_t)MP * DM, WPTR(L, W_OUT), DM / 32, q);) TSTAMP(7); }
        GSYNC(); TSTAMP(8);
        { EpiArgs q{}; q.ss_in = SS_FFN; q.o0 = HB_;
          pg8::Gemm g{XB_, WPTR(L, W_GU), MP, 2 * DFF, DM}; pg8::StaticOrder S; S.init(MP, 2 * DFF, G, (int)blockIdx.x);
          Epi<EP_GU> E{q};
          GP4(pg8::gemm_phase<Epi<EP_GU>, pg8::StaticOrder, true, true>(lds, g, S, E);) TSTAMP(4);
          SG(sgemm<EP_GU, DM>(lds, XB_ + (size_t)MP * DM, WPTR(L, W_GU), DFF / 32, q);) TSTAMP(7); }
        { EpiArgs q2{}; q2.o0 = PBUF_;
          int kp = PLED; asm volatile("" : "+s"(kp));
          const int Gh = G >> 1;
          if ((int)blockIdx.x >= Gh) {
            pg8::Gemm g2{PB_ + (size_t)L * MT * PLED, WPTR(L, W_PP), MP, DM, kp}; pg8::StaticOrder S; S.init(MP, DM, G - Gh, (int)blockIdx.x - Gh);
            Epi<EP_P> E2{q2};
            GP3(pg8::gemm_phase<Epi<EP_P>, pg8::StaticOrder, true, true>(lds, g2, S, E2);) TSTAMP(10);
          }
          SG(sgemm<EP_P, PLED>(lds, PB_ + ((size_t)L * MT + MP) * PLED, WPTR(L, W_PP), DM / 32, q2);) TSTAMP(7); }
        GSYNC(); TSTAMP(8);
        { EpiArgs q{}; q.XB = XB_; q.xbase = XB_; q.ss_out = SS_PLE;
          pg8::Gemm g{HB_, WPTR(L, W_DOWN), MP, DM, DFF}; pg8::StaticOrder S; S.init(MP, DM, G, (int)blockIdx.x);
          Epi<EP_RES> E{q};
          GP5(pg8::gemm_phase<Epi<EP_RES>, pg8::StaticOrder, true, true>(lds, g, S, E);) TSTAMP(5);
          SG(sgemm<EP_RES, DFF>(lds, HB_ + (size_t)MP * DFF, WPTR(L, W_DOWN), DM / 32, q);) TSTAMP(7); }
        GSYNC(); TSTAMP(8);
        { EpiArgs q{}; q.XB = XN_  ; q.P = PBUF_; q.xbase = XB_; q.ss_in = SS_PLE; q.ss_out = SS_NEXT;
          pg8::Gemm g{XB_, WPTR(L, W_PG), MP, DM, DM}; pg8::StaticOrder S; S.init(MP, DM, G, (int)blockIdx.x);
          Epi<EP_PLE> E{q};
          GP6(pg8::gemm_phase<Epi<EP_PLE>, pg8::StaticOrder, true, true>(lds, g, S, E);) TSTAMP(6);
          SG(sgemm<EP_PLE, DM>(lds, XB_ + (size_t)MP * DM, WPTR(L, W_PG), DM / 32, q);) TSTAMP(7); }
        GSYNC(); TSTAMP(8);
    }
    {
        const int tid = fresh_tid(), lane = tid & 63, wave = __builtin_amdgcn_readfirstlane(tid >> 6);
        const int gw = blockIdx.x * NWAVES + wave, NGW = G * NWAVES;
        const float* ssf = SSB + (size_t)(3 * NLAYER) * MT; const float* gf = ARG(21); const bf16_t* XN = XN_; float* out = ARG_OUT;
        for (int row0 = 2 * gw; row0 < MT; row0 += 2 * NGW) {
            u32x2 xv[2][4];
#pragma unroll
            for (int rr = 0; rr < 2; ++rr)
#pragma unroll
                for (int j = 0; j < 4; ++j) xv[rr][j] = *((const u32x2*)(XN + (size_t)(row0 + rr) * DM) + lane + 64 * j);
#pragma unroll
            for (int rr = 0; rr < 2; ++rr) { const int row = row0 + rr; const float rs = rstd_of(ssf[row]);
                float* dst = row < MP ? out + O_YP + (size_t)row * DM : out + O_YS + (size_t)(row - MP) * DM;
#pragma unroll
                for (int j = 0; j < 4; ++j) { const f32x4 gv = *((const f32x4*)gf + lane + 64 * j); const u32x2 w = xv[rr][j];
                    const f32x4 v = {bf_lo(w.x), bf_hi(w.x), bf_lo(w.y), bf_hi(w.y)};
                    *((f32x4*)dst + lane + 64 * j) = v * rs * gv; } }
        }
    }
#if PROBE_SEL >= 0
    TSTAMP(11); grid.sync();
    if (blockIdx.x == 0 && fresh_tid() == 0) { const unsigned long long* tsb = WS_PTR(unsigned long long, WS_CTL + 4096); float* o = ARG_OUT + O_YS; unsigned long long tv = 0; if (PROBE_SEL == 20) tv = tsb[16+1] + tsb[16+3] + tsb[16+10] + tsb[16+4] + tsb[16+5] + tsb[16+6]; else if (PROBE_SEL == 21) tv = tsb[16+0] + tsb[16+11]; else if (PROBE_SEL < 16) tv = tsb[16 + PROBE_SEL]; o[0] += (float)tv * 2.5e-5f; }
#endif
}

extern "C" void kernel_launch(void* const* d_in, const int* in_sizes, int n_in, void* d_out, int out_size, void* d_ws, size_t ws_size, hipStream_t stream) {
    static int grid = 0;
    if (grid == 0) {
        int dev = 0, cus = 0, per_cu = 0;
        hipGetDevice(&dev);
        hipDeviceGetAttribute(&cus, hipDeviceAttributeMultiprocessorCount, dev);
        hipFuncSetAttribute((const void*)hymba_fwd, hipFuncAttributeMaxDynamicSharedMemorySize, LDS_BYTES);
        hipOccupancyMaxActiveBlocksPerMultiprocessor(&per_cu, (const void*)hymba_fwd, NTHREADS, LDS_BYTES);
        if (per_cu < 1) per_cu = 1;
        grid = cus * per_cu;
        if (n_in != 22 || ws_size < WS_END) { fprintf(stderr, "kernel_launch: unexpected n_in %d / ws_size %zu\n", n_in, ws_size); }
    }
    Args a{};
    for (int i = 0; i < 22; ++i) a.in[i] = (const float*)d_in[i];
    a.out = (float*)d_out; a.ws = (unsigned char*)d_ws;
    void* kargs[] = {&a};
    hipError_t e = hipLaunchCooperativeKernel((const void*)hymba_fwd, dim3(grid), dim3(NTHREADS), kargs, LDS_BYTES, stream);
    if (e != hipSuccess) fprintf(stderr, "cooperative launch failed: %s (grid %d)\n", hipGetErrorString(e), grid);
}
```

```cpp
#include <hip/hip_runtime.h>
#include <hip/hip_cooperative_groups.h>
#include <cstdio>
#include <cstdint>
namespace cg = cooperative_groups;
__device__ __forceinline__ int fresh_tid() { int t = threadIdx.x; asm volatile("" : "+v"(t)); return t; }
namespace pg8 {
#define PG8_LAS __attribute__((address_space(3)))
typedef unsigned short bf16_t;
typedef short bf16x8 __attribute__((ext_vector_type(8)));
typedef float f32x4 __attribute__((ext_vector_type(4)));
typedef unsigned u32x4 __attribute__((ext_vector_type(4)));
constexpr int BM = 256, BK = 64, HALF = 128, HTB = HALF * BK * 2  , STAGE_BYTES = 8 * HTB, NXCD = 8, WGM = 8;

__host__ __device__ __forceinline__ int lds_byte(int r, int c) { const int st = (r >> 4) * 2 + (c >> 5), rr = r & 15, cc = c & 31, ob = rr * 64 + cc * 2; return st * 1024 + (ob ^ (((ob >> 9) & 1) << 5)); }
__host__ __device__ __forceinline__ void stage_rc(int b, int& R, int& C) { const int st = b / 1024, sb = b % 1024, swz = sb ^ (((sb >> 9) & 1) << 5); R = (st >> 1) * 16 + swz / 64; C = (st & 1) * 32 + (swz % 64) / 2; }
__host__ __device__ __forceinline__ int perm32(int rho) { const int n = rho >> 4, i = rho & 15; return 8 * (i >> 2) + 4 * n + (i & 3); }

struct Unit { int pm, pn; };
struct Gemm { const bf16_t* A; const bf16_t* Bt; int M, N, K; };

struct StaticOrder {
    int nM, nN, nwg, G, c;
    __host__ __device__ void init(int M, int N, int G_, int c_) { nM = M / BM; nN = N / BM; nwg = nM * nN; G = G_; c = c_; }
    __host__ __device__ bool next(int i, Unit& u) const {
        const long L = (long)i * G + c; if (L >= nwg) return false;
        int wgid = (int)L; { const int q = nwg / NXCD, r = nwg % NXCD, xcd = wgid % NXCD, off = wgid / NXCD; wgid = (xcd < r ? xcd * (q + 1) : r * (q + 1) + (xcd - r) * q) + off; }
        const int nig = WGM * nN, gid = wgid / nig, fm = gid * WGM, gsz = (nM - fm) < WGM ? (nM - fm) : WGM;
        u.pm = fm + ((wgid % nig) % gsz); u.pn = (wgid % nig) / gsz; return true;
    }
    __device__ __forceinline__ void a_ready(const Unit&) const {}
    __device__ __forceinline__ void done(const Unit&) const {}
};

template <class Epi, class Sched, bool ALIGN_EPI = false, bool SP2 = false>
__device__ __forceinline__ void gemm_phase(PG8_LAS unsigned char* lds, const Gemm g, const Sched& S, const Epi& E) {
    const int tid = fresh_tid(), wid = __builtin_amdgcn_readfirstlane(tid >> 6), lane = tid & 63, wr = wid >> 2, wc = wid & 3, fr = lane & 15, fq = lane >> 4;
    const int K = g.K, nt = K / BK;
    unsigned voffA[2], voffB[2];
#pragma unroll
    for (int i = 0; i < 2; ++i) { int R, C; stage_rc(tid * 16 + i * 8192, R, C); const int Rb = Epi::PERM ? ((R & ~31) + perm32(R & 31)) : R;
        voffA[i] = (unsigned)(R * K + C) * 2u; voffB[i] = (unsigned)(Rb * K + C) * 2u; }
    const size_t kstep = (size_t)(BK * 2);
    const size_t hstep = (size_t)HALF * K * 2;
    const size_t tstep = 2 * hstep;
    const unsigned ldsw = (unsigned)wid * 1024u;
    const int aoff = lds_byte(wr * 64 + fr, fq * 8), boff = lds_byte(wc * 32 + fr, fq * 8);
#define PG8_SA(b, h) (((b) * 2 + (h)) * HTB)
#define PG8_SB(b, h) ((4 + (b) * 2 + (h)) * HTB)
#define PG8_STAGE(bufoff, gbase, voff) do { _Pragma("unroll") for (int _i = 0; _i < 2; ++_i) \
        __builtin_amdgcn_global_load_lds((const unsigned*)((const char*)(gbase) + (voff)[_i]), (PG8_LAS unsigned*)(lds + (bufoff) + ldsw + _i * 8192), 16, 0, 0); } while (0)
#define PG8_LDA(dst, b, h) do { _Pragma("unroll") for (int m = 0; m < 4; ++m) _Pragma("unroll") for (int k = 0; k < 2; ++k) dst[m][k] = *(const PG8_LAS bf16x8*)(lds + PG8_SA(b, h) + aoff + m * 2048 + k * 1024); } while (0)
#define PG8_LDB(dst, b, h) do { _Pragma("unroll") for (int n = 0; n < 2; ++n) _Pragma("unroll") for (int k = 0; k < 2; ++k) dst[n][k] = *(const PG8_LAS bf16x8*)(lds + PG8_SB(b, h) + boff + n * 2048 + k * 1024); } while (0)
#define PG8_MMA(ai, bj, At, Bt) do { __builtin_amdgcn_s_setprio(1); _Pragma("unroll") for (int m = 0; m < 4; ++m) _Pragma("unroll") for (int n = 0; n < 2; ++n) _Pragma("unroll") for (int k = 0; k < 2; ++k) \
        acc[ai][bj][m][n] = __builtin_amdgcn_mfma_f32_16x16x32_bf16(Bt[n][k], At[m][k], acc[ai][bj][m][n], 0, 0, 0); __builtin_amdgcn_s_setprio(0); } while (0)
#define PG8_WAIT_V(n) asm volatile("s_waitcnt vmcnt(" #n ")" ::: "memory")
#define PG8_WAIT_L(n) asm volatile("s_waitcnt lgkmcnt(" #n ")" ::: "memory")
#define PG8_BAR __builtin_amdgcn_s_barrier()
#define PG8_SCHED __builtin_amdgcn_sched_barrier(0)
    Unit cur, nxt; int ui = 0;
    if (!S.next(0, cur)) return;
    f32x4 acc[2][2][4][2];
#pragma unroll
    for (int a = 0; a < 2; ++a)
#pragma unroll
        for (int b = 0; b < 2; ++b)
#pragma unroll
            for (int m = 0; m < 4; ++m)
#pragma unroll
                for (int n = 0; n < 2; ++n) acc[a][b][m][n] = (f32x4){0.f, 0.f, 0.f, 0.f};
    bf16x8 At[4][2], B0[2][2], B1[2][2];
    const char* cA = (const char*)g.A + (size_t)cur.pm * tstep; const char* cB = (const char*)g.Bt + (size_t)cur.pn * tstep;
    S.a_ready(cur);
    if constexpr (SP2) {
        PG8_STAGE(PG8_SB(0, 0), cB, voffB); PG8_STAGE(PG8_SB(0, 1), cB + hstep, voffB); PG8_STAGE(PG8_SA(0, 0), cA, voffA); PG8_STAGE(PG8_SA(0, 1), cA + hstep, voffA);
        if (wr == 1) PG8_BAR;
        PG8_WAIT_V(2); PG8_BAR;
        PG8_STAGE(PG8_SB(1, 0), cB + kstep, voffB); PG8_STAGE(PG8_SA(1, 0), cA + kstep, voffA); PG8_STAGE(PG8_SB(1, 1), cB + hstep + kstep, voffB);
        PG8_WAIT_V(6); PG8_BAR;
    } else {
        PG8_STAGE(PG8_SB(0, 0), cB, voffB); PG8_STAGE(PG8_SA(0, 0), cA, voffA); PG8_STAGE(PG8_SB(0, 1), cB + hstep, voffB); PG8_STAGE(PG8_SA(0, 1), cA + hstep, voffA);
        if (wr == 1) PG8_BAR;
        PG8_WAIT_V(4); PG8_BAR;
        PG8_STAGE(PG8_SB(1, 0), cB + kstep, voffB); PG8_STAGE(PG8_SA(1, 0), cA + kstep, voffA); PG8_STAGE(PG8_SB(1, 1), cB + hstep + kstep, voffB);
        PG8_WAIT_V(6); PG8_BAR;
    }
    for (;;) {
        const bool has_next = S.next(ui + 1, nxt);
        const char* nA = has_next ? (const char*)g.A + (size_t)nxt.pm * tstep : cA; const char* nB = has_next ? (const char*)g.Bt + (size_t)nxt.pn * tstep : cB;
        for (int t = 0; t < nt; t += 2) {
            const bool last = (t == nt - 2);
            const char* a1 = cA + (size_t)(t + 1) * kstep;
            const char* a2 = last ? nA : cA + (size_t)(t + 2) * kstep; const char* b2 = last ? nB : cB + (size_t)(t + 2) * kstep;
            const char* a3 = a2 + kstep; const char* b3 = b2 + kstep;
            if (last && has_next) S.a_ready(nxt);
            if constexpr (SP2) {
            PG8_LDB(B0, 0, 0); PG8_LDB(B1, 0, 1); PG8_SCHED; PG8_LDA(At, 0, 0); PG8_STAGE(PG8_SA(1, 1), a1 + hstep, voffA);
            PG8_WAIT_V(8); PG8_WAIT_L(0); PG8_BAR; PG8_MMA(0, 0, At, B0); PG8_MMA(0, 1, At, B1); PG8_BAR; PG8_SCHED;
            PG8_LDA(At, 0, 1); PG8_STAGE(PG8_SB(0, 0), b2, voffB); PG8_STAGE(PG8_SB(0, 1), b2 + hstep, voffB); PG8_STAGE(PG8_SA(0, 0), a2, voffA);
            PG8_WAIT_V(8); PG8_WAIT_L(0); PG8_BAR; PG8_MMA(1, 0, At, B0); PG8_MMA(1, 1, At, B1); PG8_BAR; PG8_SCHED;
            PG8_LDB(B0, 1, 0); PG8_LDB(B1, 1, 1); PG8_SCHED; PG8_LDA(At, 1, 0); PG8_STAGE(PG8_SA(0, 1), a2 + hstep, voffA);
            PG8_WAIT_V(8); PG8_WAIT_L(0); PG8_BAR; PG8_MMA(0, 0, At, B0); PG8_MMA(0, 1, At, B1); PG8_BAR; PG8_SCHED;
            PG8_LDA(At, 1, 1); PG8_STAGE(PG8_SB(1, 0), b3, voffB); PG8_STAGE(PG8_SB(1, 1), b3 + hstep, voffB); PG8_STAGE(PG8_SA(1, 0), a3, voffA);
            PG8_WAIT_V(8); PG8_WAIT_L(0); PG8_BAR; PG8_MMA(1, 0, At, B0); PG8_MMA(1, 1, At, B1); PG8_BAR; PG8_SCHED;
            } else {
            PG8_LDB(B0, 0, 0); PG8_SCHED; PG8_LDA(At, 0, 0); PG8_STAGE(PG8_SA(1, 1), a1 + hstep, voffA);
            PG8_WAIT_L(8); PG8_BAR; PG8_WAIT_L(0); PG8_MMA(0, 0, At, B0); PG8_BAR; PG8_SCHED;
            PG8_LDB(B1, 0, 1); PG8_STAGE(PG8_SB(0, 0), b2, voffB);
            PG8_BAR; PG8_WAIT_L(0); PG8_MMA(0, 1, At, B1); PG8_BAR;
            PG8_LDA(At, 0, 1); PG8_STAGE(PG8_SA(0, 0), a2, voffA);
            PG8_BAR; PG8_WAIT_L(0); PG8_MMA(1, 0, At, B0); PG8_BAR; PG8_SCHED;
            PG8_STAGE(PG8_SB(0, 1), b2 + hstep, voffB);
            PG8_WAIT_V(6); PG8_BAR; PG8_MMA(1, 1, At, B1); PG8_BAR;
            PG8_LDB(B0, 1, 0); PG8_SCHED; PG8_LDA(At, 1, 0); PG8_STAGE(PG8_SA(0, 1), a2 + hstep, voffA);
            PG8_WAIT_L(8); PG8_BAR; PG8_WAIT_L(0); PG8_MMA(0, 0, At, B0); PG8_BAR; PG8_SCHED;
            PG8_LDB(B1, 1, 1); PG8_STAGE(PG8_SB(1, 0), b3, voffB);
            PG8_BAR; PG8_WAIT_L(0); PG8_MMA(0, 1, At, B1); PG8_BAR;
            PG8_LDA(At, 1, 1); PG8_STAGE(PG8_SA(1, 0), a3, voffA);
            PG8_BAR; PG8_WAIT_L(0); PG8_MMA(1, 0, At, B0); PG8_BAR; PG8_SCHED;
            PG8_STAGE(PG8_SB(1, 1), b3 + hstep, voffB);
            PG8_WAIT_V(6); PG8_BAR; PG8_MMA(1, 1, At, B1); PG8_BAR;
            }
        }
        if constexpr (ALIGN_EPI) { if (wr == 0) PG8_BAR; }
        if constexpr (!Epi::AFTER_DRAIN) { E(acc, cur, wr, wc, fr, fq); S.done(cur); }
        if (!has_next) break;
#pragma unroll
        for (int a = 0; a < 2; ++a)
#pragma unroll
            for (int b = 0; b < 2; ++b)
#pragma unroll
                for (int m = 0; m < 4; ++m)
#pragma unroll
                    for (int n = 0; n < 2; ++n) acc[a][b][m][n] = (f32x4){0.f, 0.f, 0.f, 0.f};
        cur = nxt; cA = nA; cB = nB; ++ui;
        if constexpr (ALIGN_EPI) { if (wr == 1) PG8_BAR; }
    }
    PG8_WAIT_V(0);
    if constexpr (!ALIGN_EPI) { if (wr == 0) PG8_BAR; }
    PG8_BAR;
    if constexpr (Epi::AFTER_DRAIN) { E.fused(acc, cur, wr, wc, fr, fq, lds, wid, lane); S.done(cur); }
#undef PG8_SA
#undef PG8_SB
#undef PG8_STAGE
#undef PG8_LDA
#undef PG8_LDB
#undef PG8_MMA
#undef PG8_WAIT_V
#undef PG8_WAIT_L
#undef PG8_BAR
#undef PG8_SCHED
}
}

#define LAS __attribute__((address_space(3)))
using pg8::bf16_t; using pg8::bf16x8; using pg8::f32x4; using pg8::u32x4;
typedef short s16x4 __attribute__((ext_vector_type(4)));
typedef float f32x16 __attribute__((ext_vector_type(16)));
typedef unsigned u32x2 __attribute__((ext_vector_type(2)));
typedef float f32x2_t __attribute__((ext_vector_type(2)));
typedef __bf16 bf16x2_t __attribute__((ext_vector_type(2)));

constexpr int DM = 1024, SEQ = 2048, NBATCH = 8, MP = NBATCH * SEQ, DSEQ = 16, MS = NBATCH * DSEQ, MT = MP + MS;
constexpr int DFF = 2816, NQKV = 3072, PLED = 256, NLAYER = 2, PAST = 2048, BANDL = 512, HW = 512;
constexpr float EPS = 1e-6f, LOG2E = 1.4426950408889634f, QSCALE = 0.125f * LOG2E;
#ifndef SB_EARLY
#define SB_EARLY 1
#endif
constexpr float SB_THR = 7.5e-37f;

constexpr size_t MiB = 1u << 20;
constexpr size_t WS_CTL = 0, WS_SS = 64 * 1024;
constexpr size_t WS_W = 2 * MiB, W_LSTRIDE = 28 * MiB, W_IN = 0, W_OUT = 6 * MiB, W_GU = 8 * MiB, W_DOWN = 19 * MiB, W_PG = 25 * MiB, W_PP = 27 * MiB;
constexpr size_t WS_PB = 58 * MiB, WS_X = 76 * MiB  , WS_XB = 142 * MiB, WS_QKV = 176 * MiB, WS_MIX = 274 * MiB, WS_P = 308 * MiB, WS_END = 342 * MiB;
constexpr int LDS_BYTES = 131072 + 1024;
constexpr size_t WS_BAR = 8192;
constexpr int NWAVES = 8, NTHREADS = 512;

constexpr size_t O_YP = 0, O_YS = (size_t)MP * DM, O_SBK_P = O_YS + (size_t)MS * DM, O_SBV_P = O_SBK_P + (size_t)NLAYER * MP * HW,
                 O_CBK_P = O_SBV_P + (size_t)NLAYER * MP * HW, O_CBV_P = O_CBK_P + (size_t)NLAYER * NBATCH * BANDL * HW,
                 O_SBK_S = O_CBV_P + (size_t)NLAYER * NBATCH * BANDL * HW, O_SBV_S = O_SBK_S + (size_t)NLAYER * MS * HW,
                 O_CBK_S = O_SBV_S + (size_t)NLAYER * MS * HW, O_CBV_S = O_CBK_S + (size_t)NLAYER * MS * HW;

__device__ __forceinline__ unsigned pk2(float lo, float hi) { f32x2_t v = {lo, hi}; bf16x2_t b = __builtin_convertvector(v, bf16x2_t); return __builtin_bit_cast(unsigned, b); }
__device__ __forceinline__ float bf_lo(unsigned w) { return __uint_as_float(w << 16); }
__device__ __forceinline__ float bf_hi(unsigned w) { return __uint_as_float(w & 0xffff0000u); }
__device__ __forceinline__ float partner32(float v) {
    auto rr = __builtin_amdgcn_permlane32_swap(__float_as_uint(v), __float_as_uint(v), false, false);
    return (threadIdx.x & 32) ? __uint_as_float(rr[0]) : __uint_as_float(rr[1]);
}
__device__ __forceinline__ float wave_sum(float v) {
#pragma unroll
    for (int o = 1; o < 64; o <<= 1) v += __shfl_xor(v, o);
    return v;
}
__device__ __forceinline__ float rstd_of(float ss) { return rsqrtf(ss * (1.0f / DM) + EPS); }

template <int I> __device__ __forceinline__ const float* argp() {
    unsigned long long v; const void* ka = (const void*)__builtin_amdgcn_kernarg_segment_ptr();
    asm volatile("s_load_dwordx2 %0, %1, %2\n\ts_waitcnt lgkmcnt(0)" : "=s"(v) : "s"(ka), "i"(I * 8) : "memory");
    return (const float*)(const __attribute__((address_space(1))) float*)v;
}
#define ARG(i) argp<i>()
#define ARG_OUT ((float*)argp<22>())
#define ARG_WS ((unsigned char*)argp<23>())
#define WS_PTR(T, off) ((T*)(ARG_WS + (off)))
#define SSB WS_PTR(float, WS_SS)
#define PB_ WS_PTR(bf16_t, WS_PB)
#define XN_ WS_PTR(bf16_t, WS_X)
#define XB_ WS_PTR(bf16_t, WS_XB)
#define QKV_ WS_PTR(bf16_t, WS_QKV)
#define HB_ WS_PTR(bf16_t, WS_QKV)
#define MIX_ WS_PTR(bf16_t, WS_MIX)
#define PBUF_ WS_PTR(bf16_t, WS_P)
#define WPTR(L, off) ((const bf16_t*)(ARG_WS + WS_W + (size_t)(L) * W_LSTRIDE + (off)))

enum { EP_QKV = 0, EP_RES = 1, EP_GU = 2, EP_P = 3, EP_PLE = 4 };
struct EpiArgs {
    const float* ss_in; float* ss_out;
    const bf16_t* xbase;
    bf16_t* XB; bf16_t* o0; const bf16_t* P;
    float *f_sbk, *f_sbv, *f_cbk, *f_cbv;
    float *s_sbk, *s_sbv, *s_cbk, *s_cbv;
};
template <int MODE> struct Epi {
    static constexpr bool PERM = false, AFTER_DRAIN = false;
    EpiArgs a;
    __device__ __forceinline__ void operator()(const f32x4 (&acc)[2][2][4][2], const pg8::Unit& u, int wr, int wc, int fr, int fq) const {
        if constexpr (MODE == EP_QKV) {
            const int part = u.pn >> 1, cb = (u.pn & 1) * 256 + wc * 32 + 4 * fq;
            bf16_t* ob = a.o0 + (size_t)part * ((size_t)MT * HW);
            float* fo = part == 1 ? a.f_sbk : part == 2 ? a.f_sbv : part == 4 ? a.f_cbk : part == 5 ? a.f_cbv : nullptr;
            const bool band = part >= 4; const float qs = (part == 0 || part == 3) ? QSCALE : 1.f;
#pragma unroll
            for (int ai = 0; ai < 2; ++ai)
#pragma unroll
                for (int m = 0; m < 4; ++m) {
                    const int row = u.pm * 256 + ai * 128 + wr * 64 + m * 16 + fr;
                    const float rs = rstd_of(a.ss_in[row]) * qs;
                    const int t = row & (SEQ - 1);
                    float* frow = nullptr;
                    if (fo) { if (!band) frow = fo + (size_t)row * HW; else if (t >= SEQ - BANDL) frow = fo + ((size_t)(row >> 11) * BANDL + (t - (SEQ - BANDL))) * HW; }
#pragma unroll
                    for (int bj = 0; bj < 2; ++bj)
#pragma unroll
                        for (int n = 0; n < 2; ++n) {
                            const int col = cb + bj * 128 + n * 16; const f32x4 v = acc[ai][bj][m][n] * rs;
                            u32x2 w; w.x = pk2(v[0], v[1]); w.y = pk2(v[2], v[3]);
                            *(u32x2*)(ob + (size_t)row * HW + col) = w;
                            if (frow) *(f32x4*)(frow + col) = v;
                        }
                }
        } else if constexpr (MODE == EP_RES || MODE == EP_PLE) {
#pragma unroll
            for (int ai = 0; ai < 2; ++ai)
#pragma unroll
                for (int m = 0; m < 4; ++m) {
                    const int row = u.pm * 256 + ai * 128 + wr * 64 + m * 16 + fr;
                    float rs = 0.f; if constexpr (MODE == EP_PLE) rs = rstd_of(a.ss_in[row]) * (-LOG2E);
                    float s = 0.f;
#pragma unroll
                    for (int bj = 0; bj < 2; ++bj)
#pragma unroll
                        for (int n = 0; n < 2; ++n) {
                            const size_t off = (size_t)row * DM + u.pn * 256 + bj * 128 + wc * 32 + n * 16 + 4 * fq;
                            const u32x2 xw = *(const u32x2*)(a.xbase + off); f32x4 x = {bf_lo(xw.x), bf_hi(xw.x), bf_lo(xw.y), bf_hi(xw.y)}; const f32x4 c = acc[ai][bj][m][n];
                            if constexpr (MODE == EP_RES) x += c;
                            else { const u32x2 pw = *(const u32x2*)(a.P + off);
                                   x[0] += bf_lo(pw.x) * __builtin_amdgcn_rcpf(1.f + __builtin_amdgcn_exp2f(c[0] * rs));
                                   x[1] += bf_hi(pw.x) * __builtin_amdgcn_rcpf(1.f + __builtin_amdgcn_exp2f(c[1] * rs));
                                   x[2] += bf_lo(pw.y) * __builtin_amdgcn_rcpf(1.f + __builtin_amdgcn_exp2f(c[2] * rs));
                                   x[3] += bf_hi(pw.y) * __builtin_amdgcn_rcpf(1.f + __builtin_amdgcn_exp2f(c[3] * rs)); }
                            u32x2 w; w.x = pk2(x[0], x[1]); w.y = pk2(x[2], x[3]); *(u32x2*)(a.XB + off) = w;
                            s += (x[0] * x[0] + x[1] * x[1]) + (x[2] * x[2] + x[3] * x[3]);
                        }
                    s += __shfl_xor(s, 16); s += __shfl_xor(s, 32);
                    if (fq == 0) unsafeAtomicAdd(a.ss_out + row, s);
                }
        } else if constexpr (MODE == EP_GU) {
#pragma unroll
            for (int ai = 0; ai < 2; ++ai)
#pragma unroll
                for (int m = 0; m < 4; ++m) {
                    const int row = u.pm * 256 + ai * 128 + wr * 64 + m * 16 + fr;
                    const float rs = rstd_of(a.ss_in[row]);
#pragma unroll
                    for (int n = 0; n < 2; ++n) {
                        const int col = u.pn * 128 + wc * 32 + n * 16 + 4 * fq;
                        const f32x4 g = acc[ai][0][m][n] * rs, up = acc[ai][1][m][n] * rs; float h[4];
#pragma unroll
                        for (int e = 0; e < 4; ++e) h[e] = g[e] * up[e] * __builtin_amdgcn_rcpf(1.f + __builtin_amdgcn_exp2f(-LOG2E * g[e]));
                        u32x2 w; w.x = pk2(h[0], h[1]); w.y = pk2(h[2], h[3]);
                        *(u32x2*)(a.o0 + (size_t)row * DFF + col) = w;
                    }
                }
        } else {
#pragma unroll
            for (int ai = 0; ai < 2; ++ai)
#pragma unroll
                for (int m = 0; m < 4; ++m) {
                    const int row = u.pm * 256 + ai * 128 + wr * 64 + m * 16 + fr;
#pragma unroll
                    for (int bj = 0; bj < 2; ++bj)
#pragma unroll
                        for (int n = 0; n < 2; ++n) {
                            const size_t off = (size_t)row * DM + u.pn * 256 + bj * 128 + wc * 32 + n * 16 + 4 * fq; const f32x4 v = acc[ai][bj][m][n];
                            u32x2 w; w.x = pk2(v[0], v[1]); w.y = pk2(v[2], v[3]); *(u32x2*)(a.o0 + off) = w;
                        }
                }
        }
    }
};

template <int MODE, int K>
__device__ __forceinline__ void sgemm(LAS unsigned char* lds, const bf16_t* A, const bf16_t* Bt, int ncol32, const EpiArgs& a) {
    const int tid = fresh_tid(), lane = tid & 63, wave = __builtin_amdgcn_readfirstlane(tid >> 6), r = lane & 31, hh = lane >> 5;
    LAS float* red = (LAS float*)lds;
    constexpr int K8 = K >> 3, NK = K8 / 16, UB = NK > 11 ? 11 : NK;
    static_assert(NK % UB == 0, "sgemm: K split");
    const int G = gridDim.x, nunits = 4 * ncol32;
    for (int j = G - 1 - (int)blockIdx.x; j < nunits; j += G) {
        const int rb = j & 3, c0 = 32 * (j >> 2);
        const int brow0 = (MODE == EP_GU) ? ((c0 >> 7) * 256 + (c0 & 127)) : c0;
        const bf16_t* ap = A + (size_t)(32 * rb + r) * K + wave * K8 + 8 * hh;
        const bf16_t* bp = Bt + (size_t)(brow0 + r) * K + wave * K8 + 8 * hh;
        f32x16 acc0 = {}, acc1 = {};
#pragma unroll 1
        for (int kb = 0; kb < NK; kb += UB) {
            bf16x8 af[UB], bf[UB], bf2[MODE == EP_GU ? UB : 1];
#pragma unroll
            for (int i = 0; i < UB; ++i) { af[i] = *(const bf16x8*)(ap + (kb + i) * 16); bf[i] = *(const bf16x8*)(bp + (kb + i) * 16);
                if constexpr (MODE == EP_GU) bf2[i] = *(const bf16x8*)(bp + (size_t)128 * K + (kb + i) * 16); }
#pragma unroll
            for (int i = 0; i < UB; ++i) { acc0 = __builtin_amdgcn_mfma_f32_32x32x16_bf16(af[i], bf[i], acc0, 0, 0, 0);
                if constexpr (MODE == EP_GU) acc1 = __builtin_amdgcn_mfma_f32_32x32x16_bf16(af[i], bf2[i], acc1, 0, 0, 0); }
        }
#pragma unroll
        for (int i = 0; i < 16; ++i) { red[(wave * 16 + i) * 64 + lane] = acc0[i]; if constexpr (MODE == EP_GU) red[8192 + (wave * 16 + i) * 64 + lane] = acc1[i]; }
        __syncthreads();
        const int col = c0 + r;
#pragma unroll
        for (int ii = 0; ii < 2; ++ii) {
            const int i = 2 * wave + ii;
            float v0 = 0.f, v1 = 0.f;
#pragma unroll
            for (int w = 0; w < 8; ++w) { v0 += red[(w * 16 + i) * 64 + lane]; if constexpr (MODE == EP_GU) v1 += red[8192 + (w * 16 + i) * 64 + lane]; }
            const int rs_ = 32 * rb + (i & 3) + 8 * (i >> 2) + 4 * hh, row = MP + rs_;
            if constexpr (MODE == EP_QKV) {
                const int part = c0 >> 9, cc = col & 511;
                const float v = v0 * rstd_of(a.ss_in[row]);
                const float qs = (part == 0 || part == 3) ? QSCALE : 1.f;
                (a.o0 + (size_t)part * ((size_t)MT * HW))[(size_t)row * HW + cc] = (bf16_t)(pk2(v * qs, 0.f) & 0xffffu);
                float* fo = part == 1 ? a.s_sbk : part == 2 ? a.s_sbv : part == 4 ? a.s_cbk : part == 5 ? a.s_cbv : nullptr;
                if (fo) fo[(size_t)rs_ * HW + cc] = v;
            } else if constexpr (MODE == EP_RES || MODE == EP_PLE) {
                const size_t off = (size_t)row * DM + col;
                float x = __uint_as_float((unsigned)a.xbase[off] << 16);
                if constexpr (MODE == EP_RES) x += v0;
                else { const float pv = __uint_as_float((unsigned)a.P[off] << 16); x += pv * __builtin_amdgcn_rcpf(1.f + __builtin_amdgcn_exp2f(-LOG2E * v0 * rstd_of(a.ss_in[row]))); }
                a.XB[off] = (bf16_t)(pk2(x, 0.f) & 0xffffu);
                float s = x * x;
                s += __shfl_xor(s, 1); s += __shfl_xor(s, 2); s += __shfl_xor(s, 4); s += __shfl_xor(s, 8); s += __shfl_xor(s, 16);
                if (r == 0) unsafeAtomicAdd(a.ss_out + row, s);
            } else if constexpr (MODE == EP_GU) {
                const float rs = rstd_of(a.ss_in[row]); const float g = v0 * rs, up = v1 * rs;
                const float h = g * up * __builtin_amdgcn_rcpf(1.f + __builtin_amdgcn_exp2f(-LOG2E * g));
                a.o0[(size_t)row * DFF + col] = (bf16_t)(pk2(h, 0.f) & 0xffffu);
            } else {
                a.o0[(size_t)row * DM + col] = (bf16_t)(pk2(v0, 0.f) & 0xffffu);
            }
        }
        __syncthreads();
    }
}
struct AttnArgs { int L; };
constexpr int AW_V = 0, AW_ST = 4096, AW_BIAS = 8704, AW_BYTES = 10240, ST_PITCH = 144;

template <bool F32> __device__ __forceinline__ void ld_k(bf16x8 (&kf)[4], const void* base, size_t off) {
    if constexpr (!F32) { const bf16_t* p = (const bf16_t*)base + off;
#pragma unroll
        for (int kk = 0; kk < 4; ++kk) kf[kk] = *(const bf16x8*)(p + 8 * kk);
    } else { const float* p = (const float*)base + off;
#pragma unroll
        for (int kk = 0; kk < 4; ++kk) { const f32x4 x = *(const f32x4*)(p + 8 * kk), y = *(const f32x4*)(p + 8 * kk + 4);
            u32x4 w; w.x = pk2(x[0], x[1]); w.y = pk2(x[2], x[3]); w.z = pk2(y[0], y[1]); w.w = pk2(y[2], y[3]); kf[kk] = __builtin_bit_cast(bf16x8, w); }
    }
}
template <bool F32> __device__ __forceinline__ void ld_v(u32x4 (&vr)[4], const void* base, size_t row0, int nvalid, int h, int lane) {
#pragma unroll
    for (int i = 0; i < 4; ++i) { int key = 8 * i + (lane >> 3); key = key < nvalid ? key : nvalid - 1;
        const size_t off = (row0 + key) * HW + h * 64 + (lane & 7) * 8;
        if constexpr (!F32) vr[i] = *(const u32x4*)((const bf16_t*)base + off);
        else { const float* p = (const float*)base + off; const f32x4 x = *(const f32x4*)p, y = *(const f32x4*)(p + 4);
            u32x4 w; w.x = pk2(x[0], x[1]); w.y = pk2(x[2], x[3]); w.z = pk2(y[0], y[1]); w.w = pk2(y[2], y[3]); vr[i] = w; }
    }
}
__device__ __forceinline__ void st_v(LAS unsigned char* vl, const u32x4 (&vr)[4], int lane) {
#pragma unroll
    for (int i = 0; i < 4; ++i) { const int key = 8 * i + (lane >> 3); *(LAS u32x4*)(vl + key * 128 + (((lane & 7) * 16) ^ (((key >> 1) & 1) << 6))) = vr[i]; }
}
typedef short v4i16_t __attribute__((ext_vector_type(4)));
__device__ __forceinline__ s16x4 vtr(LAS unsigned char* p) { return __builtin_bit_cast(s16x4, __builtin_amdgcn_ds_read_tr16_b64_v4i16((LAS v4i16_t*)p)); }
__device__ __forceinline__ void pv_block(f32x16 (&o)[2], LAS unsigned char* vl, const bf16x8 (&pf)[2], int lane) {
    const int q = (lane & 15) >> 2, p = lane & 3, c16 = (lane >> 4) & 1, hh = lane >> 5;
    const int va0 = (4 * hh + q) * 128 + ((32 * c16 + 8 * p) ^ ((q >> 1) << 6));
#pragma unroll
    for (int db = 0; db < 2; ++db)
#pragma unroll
        for (int s = 0; s < 2; ++s) {
            const s16x4 lo = vtr(vl + (va0 ^ (db * 64)) + s * 2048), hi = vtr(vl + (va0 ^ (db * 64)) + s * 2048 + 1024);
            const bf16x8 vf = {lo[0], lo[1], lo[2], lo[3], hi[0], hi[1], hi[2], hi[3]};
            o[db] = __builtin_amdgcn_mfma_f32_32x32x16_bf16(vf, pf[s], o[db], 0, 0, 0);
        }
}
__device__ __forceinline__ f32x16 qk_block(const bf16x8 (&kf)[4], const bf16x8 (&qf)[4]) {
    f32x16 S = {};
#pragma unroll
    for (int kk = 0; kk < 4; ++kk) S = __builtin_amdgcn_mfma_f32_32x32x16_bf16(kf[kk], qf[kk], S, 0, 0, 0);
    return S;
}
__device__ __forceinline__ void sb_block(const f32x16& S, LAS unsigned char* vl, int tq, int keypos0, float& carry, f32x16 (&o)[2], int lane) {
    const int hh = lane >> 5;
    float kp_[16], be[16];
#pragma unroll
    for (int r = 0; r < 16; ++r) {
        const int kp = keypos0 + (r & 3) + 8 * (r >> 2) + 4 * hh; const bool valid = kp < tq;
        const float z = __builtin_amdgcn_fmed3f(S[r], -126.f, 100.f);
        const float t = __builtin_amdgcn_exp2f(z), k = __builtin_amdgcn_rcpf(1.f + t);
        kp_[r] = valid ? k : 1.f; be[r] = valid ? t * k : 0.f;
    }
    float T[4], Tp[4], U[4];
#pragma unroll
    for (int g = 0; g < 4; ++g) { T[g] = (kp_[4 * g] * kp_[4 * g + 1]) * (kp_[4 * g + 2] * kp_[4 * g + 3]); Tp[g] = partner32(T[g]); U[g] = T[g] * Tp[g]; }
    float R[4]; R[3] = 1.f; R[2] = U[3]; R[1] = U[3] * U[2]; R[0] = R[1] * U[1];
    const float tot = R[0] * U[0];
    float w[16];
#pragma unroll
    for (int g = 0; g < 4; ++g) {
        const float b3 = carry * R[g] * (hh == 0 ? Tp[g] : 1.f);
        const float b2 = b3 * kp_[4 * g + 3], b1 = b2 * kp_[4 * g + 2], b0 = b1 * kp_[4 * g + 1];
        w[4 * g + 3] = be[4 * g + 3] * b3; w[4 * g + 2] = be[4 * g + 2] * b2; w[4 * g + 1] = be[4 * g + 1] * b1; w[4 * g + 0] = be[4 * g + 0] * b0;
    }
    carry *= tot;
    bf16x8 pf[2];
#pragma unroll
    for (int s = 0; s < 2; ++s) { u32x4 pw; pw.x = pk2(w[8 * s], w[8 * s + 1]); pw.y = pk2(w[8 * s + 2], w[8 * s + 3]); pw.z = pk2(w[8 * s + 4], w[8 * s + 5]); pw.w = pk2(w[8 * s + 6], w[8 * s + 7]); pf[s] = __builtin_bit_cast(bf16x8, pw); }
    pv_block(o, vl, pf, lane);
}
__device__ __forceinline__ void cb_block(const f32x16& S, bool cbias, LAS unsigned char* vl, const LAS float* bl, int tq, int keypos0, int nvalid, float& m, float& l, f32x16 (&o)[2], int lane) {
    const int hh = lane >> 5;
    float s[16]; float bm = -INFINITY;
    if (cbias) {
        const float cb = bl[256];
#pragma unroll
        for (int r = 0; r < 16; ++r) { s[r] = S[r] + cb; bm = fmaxf(bm, s[r]); }
    } else {
#pragma unroll
        for (int r = 0; r < 16; ++r) {
            const int kr = (r & 3) + 8 * (r >> 2) + 4 * hh; int d = tq - (keypos0 + kr); d = d < -128 ? -128 : (d > 128 ? 128 : d);
            s[r] = (kr < nvalid) ? S[r] + bl[d + 128] : -INFINITY; bm = fmaxf(bm, s[r]);
        }
    }
    bm = fmaxf(bm, partner32(bm));
    if (__any(bm > m + 8.f)) {
        const float mn = fmaxf(m, bm), f = __builtin_amdgcn_exp2f(m - mn); m = mn; l *= f;
#pragma unroll
        for (int db = 0; db < 2; ++db)
#pragma unroll
            for (int r = 0; r < 16; ++r) o[db][r] *= f;
    }
    float w[16], ls = 0.f;
#pragma unroll
    for (int r = 0; r < 16; ++r) { w[r] = __builtin_amdgcn_exp2f(s[r] - m); ls += w[r]; }
    l += ls;
    bf16x8 pf[2];
#pragma unroll
    for (int s2 = 0; s2 < 2; ++s2) { u32x4 pw; pw.x = pk2(w[8 * s2], w[8 * s2 + 1]); pw.y = pk2(w[8 * s2 + 2], w[8 * s2 + 3]); pw.z = pk2(w[8 * s2 + 4], w[8 * s2 + 5]); pw.w = pk2(w[8 * s2 + 6], w[8 * s2 + 7]); pf[s2] = __builtin_bit_cast(bf16x8, pw); }
    pv_block(o, vl, pf, lane);
}
__device__ __forceinline__ void attn_store(f32x16 (&o)[2], float scale, const float* gain, bf16_t* mix, size_t row0, int col0, int nrows, LAS unsigned char* wl, int lane) {
    const int r = lane & 31, hh = lane >> 5;
    f32x4 gvs[2][4];
#pragma unroll
    for (int db = 0; db < 2; ++db)
#pragma unroll
        for (int g = 0; g < 4; ++g) gvs[db][g] = *(const f32x4*)(gain + 32 * db + 8 * g + 4 * hh);
    float ssq = 0.f;
#pragma unroll
    for (int db = 0; db < 2; ++db)
#pragma unroll
        for (int i = 0; i < 16; ++i) { o[db][i] *= scale; ssq += o[db][i] * o[db][i]; }
    ssq += partner32(ssq);
    const float rstd = rsqrtf(ssq * (1.0f / 64.0f) + EPS);
    LAS unsigned char* st = wl + AW_ST;
#pragma unroll
    for (int db = 0; db < 2; ++db)
#pragma unroll
        for (int g = 0; g < 4; ++g) { const int d0 = 32 * db + 8 * g + 4 * hh; const f32x4 gv = gvs[db][g];
            u32x2 w; w.x = pk2(o[db][4 * g] * rstd * gv[0], o[db][4 * g + 1] * rstd * gv[1]); w.y = pk2(o[db][4 * g + 2] * rstd * gv[2], o[db][4 * g + 3] * rstd * gv[3]);
            *(LAS u32x2*)(st + r * ST_PITCH + d0 * 2) = w; }
#pragma unroll
    for (int i = 0; i < 4; ++i) { const int row = 8 * i + (lane >> 3), ch = lane & 7; const u32x4 v = *(const LAS u32x4*)(st + row * ST_PITCH + ch * 16);
        if (row < nrows) *(u32x4*)(mix + (row0 + row) * DM + col0 + ch * 8) = v; }
}

template <bool F32> __device__ __forceinline__ void sb_loop(const void* kbase, const void* vbase, size_t rowbase, int jhi, int h, const bf16x8 (&qf)[4], int tq, float& carry, f32x16 (&o)[2], LAS unsigned char* wl, int lane) {
    const int r = lane & 31, hh = lane >> 5;
    bf16x8 kA[4], kB[4]; u32x4 vA[4], vB[4];
#define SB_LD(KF, VN, jj) do { ld_k<F32>(KF, kbase, (rowbase + 32 * (jj) + r) * HW + h * 64 + 32 * hh); ld_v<F32>(VN, vbase, rowbase + 32 * (jj), 32, h, lane); } while (0)
    SB_LD(kA, vA, jhi); if (jhi >= 1) SB_LD(kB, vB, jhi - 1);
    for (int j = jhi; j >= 0; j -= 2) {
        { const f32x16 S = qk_block(kA, qf); st_v(wl + AW_V, vA, lane); if (j >= 2) SB_LD(kA, vA, j - 2);
          sb_block(S, wl + AW_V, tq, 32 * j, carry, o, lane); }
#if SB_EARLY
        if (__all(carry < SB_THR)) break;
#endif
        if (j < 1) break;
        { const f32x16 S = qk_block(kB, qf); st_v(wl + AW_V, vB, lane); if (j >= 3) SB_LD(kB, vB, j - 3);
          sb_block(S, wl + AW_V, tq, 32 * (j - 1), carry, o, lane); }
#if SB_EARLY
        if (__all(carry < SB_THR)) break;
#endif
    }
#undef SB_LD
}
template <bool SAMPLE> __device__ __forceinline__ void sb_unit(const AttnArgs& A, int b, int h, int qb, LAS unsigned char* wl, int lane) {
    const int r = lane & 31, hh = lane >> 5;
    const bf16_t* Qa = QKV_; const bf16_t* Ka = Qa + (size_t)1 * MT * HW; const bf16_t* Va = Qa + (size_t)2 * MT * HW;
    int tq; size_t qrow;
    if (SAMPLE) { tq = PAST + (r & 15); qrow = (size_t)MP + b * DSEQ + (r & 15); } else { tq = 32 * qb + r; qrow = (size_t)b * SEQ + tq; }
    bf16x8 qf[4]; ld_k<false>(qf, Qa, qrow * HW + h * 64 + 32 * hh);
    float carry = 1.f; f32x16 o[2]; o[0] = f32x16{}; o[1] = f32x16{};
    if (SAMPLE) {
        bf16x8 kf[4]; u32x4 vr[4]; const size_t row0 = (size_t)MP + b * DSEQ;
        ld_k<false>(kf, Ka, (row0 + (r & 15)) * HW + h * 64 + 32 * hh); ld_v<false>(vr, Va, row0, DSEQ, h, lane); st_v(wl + AW_V, vr, lane);
        { const f32x16 S = qk_block(kf, qf); sb_block(S, wl + AW_V, tq, PAST, carry, o, lane); }
        sb_loop<true>(ARG(4) + (size_t)A.L * NBATCH * PAST * HW, ARG(5) + (size_t)A.L * NBATCH * PAST * HW, (size_t)b * PAST, PAST / 32 - 1, h, qf, tq, carry, o, wl, lane);
        attn_store(o, 1.f, ARG(11) + A.L * HW + h * 64, MIX_, row0, h * 64, DSEQ, wl, lane);
    } else {
        sb_loop<false>(Ka, Va, (size_t)b * SEQ, qb, h, qf, tq, carry, o, wl, lane);
        attn_store(o, 1.f, ARG(11) + A.L * HW + h * 64, MIX_, (size_t)b * SEQ + 32 * qb, h * 64, 32, wl, lane);
    }
}
template <bool F32> __device__ __forceinline__ void cb_loop(const void* kbase, const void* vbase, size_t rowbase, int jlo, int jhi, int pos0, int h, const bf16x8 (&qf)[4], int tq, float& m, float& l, f32x16 (&o)[2], LAS unsigned char* wl, int lane) {
    const int r = lane & 31, hh = lane >> 5;
    bf16x8 kA[4], kB[4]; u32x4 vA[4], vB[4];
    const int tqmin = tq - r;
#define CB_LD(KF, VN, jj) do { ld_k<F32>(KF, kbase, (rowbase + 32 * (jj) + r) * HW + h * 64 + 32 * hh); ld_v<F32>(VN, vbase, rowbase + 32 * (jj), 32, h, lane); } while (0)
    CB_LD(kA, vA, jlo); if (jlo + 1 <= jhi) CB_LD(kB, vB, jlo + 1);
    for (int j = jlo; j <= jhi; j += 2) {
        { const f32x16 S = qk_block(kA, qf); st_v(wl + AW_V, vA, lane); if (j + 2 <= jhi) CB_LD(kA, vA, j + 2);
          const bool cbias = __builtin_amdgcn_readfirstlane(pos0 + 32 * j + 31 + 128 <= tqmin);
          cb_block(S, cbias, wl + AW_V, (const LAS float*)(wl + AW_BIAS), tq, pos0 + 32 * j, 32, m, l, o, lane); }
        if (j + 1 > jhi) break;
        { const f32x16 S = qk_block(kB, qf); st_v(wl + AW_V, vB, lane); if (j + 3 <= jhi) CB_LD(kB, vB, j + 3);
          const bool cbias = __builtin_amdgcn_readfirstlane(pos0 + 32 * (j + 1) + 31 + 128 <= tqmin);
          cb_block(S, cbias, wl + AW_V, (const LAS float*)(wl + AW_BIAS), tq, pos0 + 32 * (j + 1), 32, m, l, o, lane); }
    }
#undef CB_LD
}
template <bool SAMPLE> __device__ __forceinline__ void cb_unit(const AttnArgs& A, int b, int h, int qb, LAS unsigned char* wl, int lane) {
    const int r = lane & 31, hh = lane >> 5;
    const bf16_t* Qb = QKV_ + (size_t)3 * MT * HW; const bf16_t* Kb = Qb + (size_t)1 * MT * HW; const bf16_t* Vb = Qb + (size_t)2 * MT * HW;
    LAS float* bl = (LAS float*)(wl + AW_BIAS);
    { const float* relp = ARG(10) + (size_t)A.L * 257 * 8 + h; float bv[5];
#pragma unroll
      for (int i = 0; i < 5; ++i) { const int idx = lane + 64 * i; bv[i] = relp[(idx < 257 ? idx : 256) * 8]; }
#pragma unroll
      for (int i = 0; i < 5; ++i) { const int idx = lane + 64 * i; if (idx < 257) bl[idx] = bv[i] * LOG2E; } }
    int tq; size_t qrow;
    if (SAMPLE) { tq = PAST + (r & 15); qrow = (size_t)MP + b * DSEQ + (r & 15); } else { tq = 32 * qb + r; qrow = (size_t)b * SEQ + tq; }
    bf16x8 qf[4]; ld_k<false>(qf, Qb, qrow * HW + h * 64 + 32 * hh);
    float m = -INFINITY, l = 0.f; f32x16 o[2]; o[0] = f32x16{}; o[1] = f32x16{};
    if (SAMPLE) {
        cb_loop<true>(ARG(6) + (size_t)A.L * NBATCH * BANDL * HW, ARG(7) + (size_t)A.L * NBATCH * BANDL * HW, (size_t)b * BANDL, 0, BANDL / 32 - 1, PAST - BANDL, h, qf, tq, m, l, o, wl, lane);
        bf16x8 kf[4]; u32x4 vr[4]; const size_t row0 = (size_t)MP + b * DSEQ;
        ld_k<false>(kf, Kb, (row0 + (r & 15)) * HW + h * 64 + 32 * hh); ld_v<false>(vr, Vb, row0, DSEQ, h, lane); st_v(wl + AW_V, vr, lane);
        { const f32x16 S = qk_block(kf, qf); cb_block(S, false, wl + AW_V, bl, tq, PAST, DSEQ, m, l, o, lane); }
        l += partner32(l);
        attn_store(o, 1.0f / l, ARG(12) + A.L * HW + h * 64, MIX_, row0, HW + h * 64, DSEQ, wl, lane);
    } else {
        const int c = qb >> 1, clo = c - 8 < 0 ? 0 : c - 8;
        cb_loop<false>(Kb, Vb, (size_t)b * SEQ, 2 * clo, 2 * c + 1, 0, h, qf, tq, m, l, o, wl, lane);
        l += partner32(l);
        attn_store(o, 1.0f / l, ARG(12) + A.L * HW + h * 64, MIX_, (size_t)b * SEQ + 32 * qb, HW + h * 64, 32, wl, lane);
    }
}
__device__ __forceinline__ void cb_unit_p64(const AttnArgs& A, int b, int h, int c, LAS unsigned char* wl, int lane) {
    const int r = lane & 31, hh = lane >> 5;
    const bf16_t* Qb = QKV_ + (size_t)3 * MT * HW; const bf16_t* Kb = Qb + (size_t)1 * MT * HW; const bf16_t* Vb = Qb + (size_t)2 * MT * HW;
    LAS float* bl = (LAS float*)(wl + AW_BIAS);
    { const float* relp = ARG(10) + (size_t)A.L * 257 * 8 + h; float bv[5];
#pragma unroll
      for (int i = 0; i < 5; ++i) { const int idx = lane + 64 * i; bv[i] = relp[(idx < 257 ? idx : 256) * 8]; }
#pragma unroll
      for (int i = 0; i < 5; ++i) { const int idx = lane + 64 * i; if (idx < 257) bl[idx] = bv[i] * LOG2E; } }
    const int tq0 = 64 * c + r, tq1 = tq0 + 32; const size_t rowbase = (size_t)b * SEQ;
    bf16x8 qf0[4], qf1[4];
    ld_k<false>(qf0, Qb, (rowbase + tq0) * HW + h * 64 + 32 * hh); ld_k<false>(qf1, Qb, (rowbase + tq1) * HW + h * 64 + 32 * hh);
    float m0 = -INFINITY, l0 = 0.f, m1 = -INFINITY, l1 = 0.f;
    f32x16 o0[2], o1[2]; o0[0] = f32x16{}; o0[1] = f32x16{}; o1[0] = f32x16{}; o1[1] = f32x16{};
    const int clo = c - 8 < 0 ? 0 : c - 8, jlo = 2 * clo, jhi = 2 * c + 1;
    bf16x8 kf[4]; u32x4 vn[4];
    ld_k<false>(kf, Kb, (rowbase + 32 * jlo + r) * HW + h * 64 + 32 * hh); ld_v<false>(vn, Vb, rowbase + 32 * jlo, 32, h, lane);
    for (int j = jlo; j <= jhi; ++j) {
        const f32x16 S0 = qk_block(kf, qf0), S1 = qk_block(kf, qf1);
        st_v(wl + AW_V, vn, lane);
        if (j < jhi) { ld_k<false>(kf, Kb, (rowbase + 32 * (j + 1) + r) * HW + h * 64 + 32 * hh); ld_v<false>(vn, Vb, rowbase + 32 * (j + 1), 32, h, lane); }
        const bool cbias = (32 * j + 31 + 128 <= 64 * c);
        cb_block(S0, cbias, wl + AW_V, bl, tq0, 32 * j, 32, m0, l0, o0, lane);
        cb_block(S1, cbias, wl + AW_V, bl, tq1, 32 * j, 32, m1, l1, o1, lane);
    }
    l0 += partner32(l0); l1 += partner32(l1);
    attn_store(o0, 1.0f / l0, ARG(12) + A.L * HW + h * 64, MIX_, rowbase + 64 * c, HW + h * 64, 32, wl, lane);
    attn_store(o1, 1.0f / l1, ARG(12) + A.L * HW + h * 64, MIX_, rowbase + 64 * c + 32, HW + h * 64, 32, wl, lane);
}
constexpr int AU_ITEMS = 2048;
__device__ __forceinline__ void attn_phase(const AttnArgs& A, LAS unsigned char* lds) {
    const int tid_ = fresh_tid(), lane = tid_ & 63, wave = __builtin_amdgcn_readfirstlane(tid_ >> 6);
    LAS unsigned char* wl = lds + wave * AW_BYTES;
#pragma unroll 1
    for (int cu = (int)blockIdx.x * NWAVES + wave; cu < AU_ITEMS; cu += (int)gridDim.x * NWAVES) {
        const int bh = cu >> 5, p = cu & 31;
        cb_unit_p64(A, bh >> 3, bh & 7, 31 - p, wl, lane);
#pragma unroll 1
        for (int t = 0; t < 2; ++t) sb_unit<false>(A, bh >> 3, bh & 7, 63 - 2 * p - t, wl, lane);
        if (p >= 24) { const int li = bh * 8 + (p - 24);
            if (li < 64) sb_unit<true>(A, li >> 3, li & 7, 0, wl, lane);
            else if (li < 128) cb_unit<true>(A, (li - 64) >> 3, (li - 64) & 7, 0, wl, lane); }
    }
}
typedef unsigned gu32_plain;
#define XB_TMO      128
#define XB_XCNT(j)  (256  + 64 * (j))
#define XB_XSUB(j)  (1280 + 64 * (j))
#define XB_XGEN(j)  (2304 + 64 * (j))
#define XB_TOP      3328
#define XB_TOPGEN   3392
#define XCD_BAR_WORDS 3456
#define XB_SPIN_CAP (1u << 18)

__device__ __forceinline__ unsigned xb_ld(unsigned* p)              { return __hip_atomic_load(p, __ATOMIC_RELAXED, __HIP_MEMORY_SCOPE_AGENT); }
__device__ __forceinline__ unsigned xb_add(unsigned* p, unsigned v) { return __hip_atomic_fetch_add(p, v, __ATOMIC_RELAXED, __HIP_MEMORY_SCOPE_AGENT); }
__device__ __forceinline__ unsigned xb_xcc_id() { return (unsigned)__builtin_amdgcn_s_getreg((3 << 11) | 20) & 0xFu; }
#define XB_SPIN(cond, bar) do { unsigned _sp = 0; while (cond) { __builtin_amdgcn_s_sleep(1); \
    if ((++_sp & 255u) == 0u) { if (xb_ld(&(bar)[XB_TMO])) break; if (_sp > XB_SPIN_CAP) { atomicAdd(&(bar)[XB_TMO], 1u); break; } } } } while (0)

struct XcdBarrier {
    unsigned* bar; unsigned x;
    volatile LAS unsigned* st;
};

__device__ __forceinline__ XcdBarrier xcd_barrier_post(unsigned* bar, volatile LAS unsigned* st) {
    XcdBarrier b; b.bar = bar; b.x = xb_xcc_id(); b.st = st;
    if (threadIdx.x == 0) (void)xb_add(&bar[XB_XCNT(b.x)], 1u);
    return b;
}
__device__ __forceinline__ void xcd_barrier_complete(unsigned* bar, unsigned x, unsigned& nloc, unsigned& nx) {
    const unsigned G = gridDim.x * gridDim.y * gridDim.z;
    unsigned sum, cnt, mine, sp = 0u;
    for (;;) {
        sum = 0u; cnt = 0u; mine = 0u;
#pragma unroll
        for (unsigned j = 0; j < 16; ++j) { const unsigned c = xb_ld(&bar[XB_XCNT(j)]); sum += c; cnt += (c > 0u) ? 1u : 0u; mine = (j == x) ? c : mine; }
        if (sum == G) break;
        __builtin_amdgcn_s_sleep(1);
        if ((++sp & 255u) == 0u) { if (xb_ld(&bar[XB_TMO])) break; if (sp > XB_SPIN_CAP) { atomicAdd(&bar[XB_TMO], 1u); break; } }
    }
    nloc = mine > 0u ? mine : 1u; nx = cnt > 0u ? cnt : 1u;
}

__device__ __forceinline__ void xcd_barrier(const XcdBarrier& b) {
    asm volatile("s_waitcnt vmcnt(0)" ::: "memory");
    __syncthreads();
    if (threadIdx.x == 0) {
        unsigned* bar = b.bar;
        __builtin_amdgcn_s_waitcnt(0);
        unsigned nloc = b.st[0], nx = b.st[1];
        if (nloc == 0u) { xcd_barrier_complete(bar, b.x, nloc, nx); b.st[0] = nloc; b.st[1] = nx; }
        const unsigned old = xb_add(&bar[XB_XSUB(b.x)], 1u);
        const unsigned gen = old / nloc;
        if (old + 1u == (gen + 1u) * nloc) {
            __builtin_amdgcn_fence(__ATOMIC_RELEASE, "agent");
            asm volatile("s_waitcnt vmcnt(0)" ::: "memory");
            const unsigned og = xb_add(&bar[XB_TOP], 1u);
            const unsigned tg = og / nx;
            if (og + 1u == (tg + 1u) * nx) xb_add(&bar[XB_TOPGEN], 1u);
            else XB_SPIN(xb_ld(&bar[XB_TOPGEN]) == tg, bar);
            __builtin_amdgcn_fence(__ATOMIC_ACQUIRE, "agent");
            xb_add(&bar[XB_XGEN(b.x)], 1u);
            asm volatile("s_waitcnt vmcnt(0)" ::: "memory");
        } else {
            XB_SPIN(xb_ld(&bar[XB_XGEN(b.x)]) == gen, bar);
            __builtin_amdgcn_fence(__ATOMIC_ACQUIRE, "agent");
            asm volatile("s_waitcnt vmcnt(0)" ::: "memory");
        }
    }
    __syncthreads();
}

constexpr int CI_IN = 16 * 96, CI_OUT = 16 * 32, CI_G = 16 * 88, CI_D = 44 * 32, CI_PG = 16 * 32, CI_PP = 4 * 32, CI_L = CI_IN + CI_OUT + 2 * CI_G + CI_D + CI_PG + CI_PP;
struct ConvD { const float* W; const float* gain; bf16_t* WT; int K, N, kind, k0, n0; };
__device__ __forceinline__ ConvD conv_decode(int it) {
    const int L = it / CI_L; int r = it % CI_L; ConvD d;
    if (r < CI_IN) { d.W = ARG(9) + (size_t)L * DM * NQKV; d.gain = ARG(8) + L * DM; d.WT = (bf16_t*)WPTR(L, W_IN); d.K = DM; d.N = NQKV; d.kind = 0; }
    else if ((r -= CI_IN) < CI_OUT) { d.W = ARG(13) + (size_t)L * DM * DM; d.gain = nullptr; d.WT = (bf16_t*)WPTR(L, W_OUT); d.K = DM; d.N = DM; d.kind = 0; }
    else if ((r -= CI_OUT) < CI_G) { d.W = ARG(15) + (size_t)L * DM * DFF; d.gain = ARG(14) + L * DM; d.WT = (bf16_t*)WPTR(L, W_GU); d.K = DM; d.N = DFF; d.kind = 1; }
    else if ((r -= CI_G) < CI_G) { d.W = ARG(16) + (size_t)L * DM * DFF; d.gain = ARG(14) + L * DM; d.WT = (bf16_t*)WPTR(L, W_GU); d.K = DM; d.N = DFF; d.kind = 2; }
    else if ((r -= CI_G) < CI_D) { d.W = ARG(17) + (size_t)L * DFF * DM; d.gain = nullptr; d.WT = (bf16_t*)WPTR(L, W_DOWN); d.K = DFF; d.N = DM; d.kind = 0; }
    else if ((r -= CI_D) < CI_PG) { d.W = ARG(19) + (size_t)L * DM * DM; d.gain = ARG(18) + L * DM; d.WT = (bf16_t*)WPTR(L, W_PG); d.K = DM; d.N = DM; d.kind = 0; }
    else { r -= CI_PG; d.W = ARG(20) + (size_t)L * PLED * DM; d.gain = nullptr; d.WT = (bf16_t*)WPTR(L, W_PP); d.K = PLED; d.N = DM; d.kind = 0; }
    const int nblk = d.N / 32; d.k0 = 64 * (r / nblk); d.n0 = 32 * (r % nblk);
    return d;
}
__device__ __forceinline__ void conv_load(const ConvD& d, float (&v)[32], f32x4 (&g)[2], int lane) {
    const float* p = d.W + (size_t)(d.k0 + (lane >> 5)) * d.N + d.n0 + (lane & 31);
#pragma unroll
    for (int i = 0; i < 32; ++i) v[i] = p[(size_t)(2 * i) * d.N];
    if (d.gain) { g[0] = *(const f32x4*)(d.gain + d.k0 + 8 * (lane & 7)); g[1] = *(const f32x4*)(d.gain + d.k0 + 8 * (lane & 7) + 4); }
    else { g[0] = (f32x4){1.f, 1.f, 1.f, 1.f}; g[1] = g[0]; }
}
__device__ __forceinline__ void conv_proc(const ConvD& d, const float (&v)[32], const f32x4 (&g)[2], LAS float* scr, int lane) {
#pragma unroll
    for (int i = 0; i < 32; ++i) scr[(2 * i + (lane >> 5)) * 33 + (lane & 31)] = v[i];
    asm volatile("s_waitcnt lgkmcnt(0)" ::: "memory");
    const int c = lane & 7;
#pragma unroll
    for (int j = 0; j < 4; ++j) { const int n = (lane >> 3) + 8 * j; const LAS float* s = scr + (8 * c) * 33 + n;
        u32x4 o; o.x = pk2(s[0 * 33] * g[0][0], s[1 * 33] * g[0][1]); o.y = pk2(s[2 * 33] * g[0][2], s[3 * 33] * g[0][3]);
        o.z = pk2(s[4 * 33] * g[1][0], s[5 * 33] * g[1][1]); o.w = pk2(s[6 * 33] * g[1][2], s[7 * 33] * g[1][3]);
        const int gn = d.n0 + n; const int drow = d.kind == 0 ? gn : ((gn >> 7) * 256 + (gn & 127) + (d.kind == 2 ? 128 : 0));
        *(u32x4*)(d.WT + (size_t)drow * d.K + d.k0 + 8 * c) = o; }
    asm volatile("s_waitcnt lgkmcnt(0)" ::: "memory");
}

#ifdef NO_SGEMM
#define SG(...)
#else
#define SG(...) __VA_ARGS__
#endif
#ifndef GP1
#define GP1(...) __VA_ARGS__
#endif
#ifndef GP2
#define GP2(...) __VA_ARGS__
#endif
#ifndef GP3
#define GP3(...) __VA_ARGS__
#endif
#ifndef GP4
#define GP4(...) __VA_ARGS__
#endif
#ifndef GP5
#define GP5(...) __VA_ARGS__
#endif
#ifndef GP6
#define GP6(...) __VA_ARGS__
#endif
#ifdef NO_SGEMM
#define SG(...)
#else
#define SG(...) __VA_ARGS__
#endif
#ifndef GP1
#define GP1(...) __VA_ARGS__
#endif
#ifndef GP2
#define GP2(...) __VA_ARGS__
#endif
#ifndef GP3
#define GP3(...) __VA_ARGS__
#endif
#ifndef GP4
#define GP4(...) __VA_ARGS__
#endif
#ifndef GP5
#define GP5(...) __VA_ARGS__
#endif
#ifndef GP6
#define GP6(...) __VA_ARGS__
#endif
struct Args { const float* in[22]; float* out; unsigned char* ws; };

#ifndef PROBE_SEL
#define PROBE_SEL -1
#endif
#if PROBE_SEL >= 0
#define TSTAMP(cat) do { if (blockIdx.x == 0 && fresh_tid() == 0) { const unsigned long long t_ = __builtin_amdgcn_s_memrealtime(); unsigned long long* tsb = WS_PTR(unsigned long long, WS_CTL + 4096); \
    tsb[16 + (cat)] += t_ - tsb[0]; tsb[0] = t_; } } while (0)
#else
#define TSTAMP(cat) do {} while (0)
#endif
__global__ void __launch_bounds__(NTHREADS, 2) hymba_fwd(Args args) {
    extern __shared__ __attribute__((aligned(16))) unsigned char lds_raw[];
    cg::grid_group grid = cg::this_grid();
    LAS unsigned char* lds = (LAS unsigned char*)lds_raw;
    const int G = gridDim.x;

#if PROBE_SEL >= 0
    if (blockIdx.x == 0 && fresh_tid() == 0) { unsigned long long* tsb = WS_PTR(unsigned long long, WS_CTL + 4096); for (int i = 0; i < 48; ++i) tsb[i] = 0; tsb[0] = __builtin_amdgcn_s_memrealtime(); }
#endif
    {
        const int tid = fresh_tid(), lane = tid & 63, wave = __builtin_amdgcn_readfirstlane(tid >> 6);
        const int gw = blockIdx.x * NWAVES + wave, NGW = G * NWAVES;
        { float* ssb = SSB; for (int i = blockIdx.x * NTHREADS + tid; i < 6 * MT; i += G * NTHREADS) ssb[MT + i] = 0.f;
          if (blockIdx.x == 0 && tid < 16) WS_PTR(unsigned, WS_CTL)[tid] = 0u;
          if (blockIdx.x == 0) for (int i = tid; i < XCD_BAR_WORDS; i += NTHREADS) WS_PTR(unsigned, WS_BAR)[i] = 0u;
          if (tid < 2) ((LAS unsigned*)(lds + 131072))[tid] = 0u; }
        LAS float* scr = (LAS float*)(lds + wave * 8704);
        { constexpr int NIT = NLAYER * CI_L; int it = gw;
          float vA[32], vB[32]; f32x4 gA[2], gB[2]; ConvD dA, dB;
          if (it < NIT) { dA = conv_decode(it); conv_load(dA, vA, gA, lane); }
          while (it < NIT) {
            const int itn = it + NGW;
            if (itn < NIT) { dB = conv_decode(itn); conv_load(dB, vB, gB, lane); }
            conv_proc(dA, vA, gA, scr, lane);
            if (itn >= NIT) break;
            it = itn + NGW;
            if (it < NIT) { dA = conv_decode(it); conv_load(dA, vA, gA, lane); }
            conv_proc(dB, vB, gB, scr, lane);
          } }
        { const float* pp = ARG(2); const float* ps = ARG(3); bf16_t* PB = PB_;
          for (int it0 = 4 * gw; it0 < NLAYER * MT; it0 += 4 * NGW) {
            f32x4 v[4];
#pragma unroll
            for (int rr = 0; rr < 4; ++rr) { const int it = it0 + rr, L = it / MT, row = it % MT;
                const float* src = row < MP ? pp + ((size_t)L * MP + row) * PLED : ps + ((size_t)L * MS + (row - MP)) * PLED;
                v[rr] = *((const f32x4*)src + lane); }
#pragma unroll
            for (int rr = 0; rr < 4; ++rr) { u32x2 w; w.x = pk2(v[rr][0], v[rr][1]); w.y = pk2(v[rr][2], v[rr][3]); *((u32x2*)(PB + (size_t)(it0 + rr) * PLED) + lane) = w; }
          } }
        { const float* x_p = ARG(0); const float* x_s = ARG(1); bf16_t* XB = XN_; float* ssb = SSB;
          for (int row0 = 2 * gw; row0 < MT; row0 += 2 * NGW) {
            f32x4 v[2][4];
#pragma unroll
            for (int rr = 0; rr < 2; ++rr) { const int row = row0 + rr; const float* src = row < MP ? x_p + (size_t)row * DM : x_s + (size_t)(row - MP) * DM;
#pragma unroll
                for (int j = 0; j < 4; ++j) v[rr][j] = *((const f32x4*)src + lane + 64 * j); }
#pragma unroll
            for (int rr = 0; rr < 2; ++rr) { float s2 = 0.f;
#pragma unroll
                for (int j = 0; j < 4; ++j) { const f32x4 t = v[rr][j]; s2 += (t[0] * t[0] + t[1] * t[1]) + (t[2] * t[2] + t[3] * t[3]);
                    u32x2 w; w.x = pk2(t[0], t[1]); w.y = pk2(t[2], t[3]); *((u32x2*)(XB + (size_t)(row0 + rr) * DM) + lane + 64 * j) = w; }
                s2 = wave_sum(s2);
                if (lane == 0) ssb[row0 + rr] = s2; }
          } }
    }
    TSTAMP(0); grid.sync(); TSTAMP(8);
    const XcdBarrier xbar = xcd_barrier_post(WS_PTR(unsigned, WS_BAR), (volatile LAS unsigned*)(lds + 131072));
#define GSYNC() xcd_barrier(xbar)

    for (int L = 0; L < NLAYER; ++L) {
#define SS_MIX (SSB + (size_t)(3 * L) * MT)
#define SS_FFN (SSB + (size_t)(3 * L + 1) * MT)
#define SS_PLE (SSB + (size_t)(3 * L + 2) * MT)
#define SS_NEXT (SSB + (size_t)(3 * L + 3) * MT)
        { EpiArgs q{}; q.ss_in = SS_MIX; q.o0 = QKV_;
          q.f_sbk = ARG_OUT + O_SBK_P + (size_t)L * MP * HW; q.f_sbv = ARG_OUT + O_SBV_P + (size_t)L * MP * HW;
          q.f_cbk = ARG_OUT + O_CBK_P + (size_t)L * NBATCH * BANDL * HW; q.f_cbv = ARG_OUT + O_CBV_P + (size_t)L * NBATCH * BANDL * HW;
          pg8::Gemm g{XN_, WPTR(L, W_IN), MP, NQKV, DM}; pg8::StaticOrder S; S.init(MP, NQKV, G, (int)blockIdx.x);
          Epi<EP_QKV> E{q};
          GP1(pg8::gemm_phase<Epi<EP_QKV>, pg8::StaticOrder, true, true>(lds, g, S, E);) TSTAMP(1); }
        { EpiArgs q{}; q.ss_in = SS_MIX; q.o0 = QKV_;
          q.s_sbk = ARG_OUT + O_SBK_S + (size_t)L * MS * HW; q.s_sbv = ARG_OUT + O_SBV_S + (size_t)L * MS * HW;
          q.s_cbk = ARG_OUT + O_CBK_S + (size_t)L * MS * HW; q.s_cbv = ARG_OUT + O_CBV_S + (size_t)L * MS * HW;
          SG(sgemm<EP_QKV, DM>(lds, XN_ + (size_t)MP * DM, WPTR(L, W_IN), NQKV / 32, q);) TSTAMP(7); }
        GSYNC(); TSTAMP(8);
        { AttnArgs A{}; A.L = L;
#ifndef NO_ATTN
          attn_phase(A, lds);
#endif
          TSTAMP(2); }
        GSYNC(); TSTAMP(2);
        { EpiArgs q{}; q.XB = XB_; q.xbase = XN_; q.ss_out = SS_FFN;
          pg8::Gemm g{MIX_, WPTR(L, W_OUT), MP, DM, DM}; pg8::StaticOrder S; S.init(MP, DM, G, (int)blockIdx.x);
          Epi<EP_RES> E{q};
          GP2(pg8::gemm_phase<Epi<EP_RES>, pg8::StaticOrder, true, true>(lds, g, S, E);) TSTAMP(3); }
        { EpiArgs q{}; q.XB = XB_; q.xbase = XN_; q.ss_out = SS_FFN;
          SG(sgemm<EP_RES, DM>(lds, MIX_ + (size_t)MP * DM, WPTR(L, W_OUT), DM / 32, q);) TSTAMP(7); }
        GSYNC(); TSTAMP(8);
        { EpiArgs q{}; q.ss_in = SS_FFN; q.o0 = HB_;
          pg8::Gemm g{XB_, WPTR(L, W_GU), MP, 2 * DFF, DM}; pg8::StaticOrder S; S.init(MP, 2 * DFF, G, (int)blockIdx.x);
          Epi<EP_GU> E{q};
          GP4(pg8::gemm_phase<Epi<EP_GU>, pg8::StaticOrder, true, true>(lds, g, S, E);) TSTAMP(4);
          SG(sgemm<EP_GU, DM>(lds, XB_ + (size_t)MP * DM, WPTR(L, W_GU), DFF / 32, q);) TSTAMP(7); }
        { EpiArgs q2{}; q2.o0 = PBUF_;
          int kp = PLED; asm volatile("" : "+s"(kp));
          const int Gh = G >> 1;
          if ((int)blockIdx.x >= Gh) {
            pg8::Gemm g2{PB_ + (size_t)L * MT * PLED, WPTR(L, W_PP), MP, DM, kp}; pg8::StaticOrder S; S.init(MP, DM, G - Gh, (int)blockIdx.x - Gh);
            Epi<EP_P> E2{q2};
            GP3(pg8::gemm_phase<Epi<EP_P>, pg8::StaticOrder, true, true>(lds, g2, S, E2);) TSTAMP(10);
          }
          SG(sgemm<EP_P, PLED>(lds, PB_ + ((size_t)L * MT + MP) * PLED, WPTR(L, W_PP), DM / 32, q2);) TSTAMP(7); }
        GSYNC(); TSTAMP(8);
        { EpiArgs q{}; q.XB = XB_; q.xbase = XB_; q.ss_out = SS_PLE;
          pg8::Gemm g{HB_, WPTR(L, W_DOWN), MP, DM, DFF}; pg8::StaticOrder S; S.init(MP, DM, G, (int)blockIdx.x);
          Epi<EP_RES> E{q};
          GP5(pg8::gemm_phase<Epi<EP_RES>, pg8::StaticOrder, true, true>(lds, g, S, E);) TSTAMP(5);
          SG(sgemm<EP_RES, DFF>(lds, HB_ + (size_t)MP * DFF, WPTR(L, W_DOWN), DM / 32, q);) TSTAMP(7); }
        GSYNC(); TSTAMP(8);
        { EpiArgs q{}; q.XB = XN_  ; q.P = PBUF_; q.xbase = XB_; q.ss_in = SS_PLE; q.ss_out = SS_NEXT;
          pg8::Gemm g{XB_, WPTR(L, W_PG), MP, DM, DM}; pg8::StaticOrder S; S.init(MP, DM, G, (int)blockIdx.x);
          Epi<EP_PLE> E{q};
          GP6(pg8::gemm_phase<Epi<EP_PLE>, pg8::StaticOrder, true, true>(lds, g, S, E);) TSTAMP(6);
          SG(sgemm<EP_PLE, DM>(lds, XB_ + (size_t)MP * DM, WPTR(L, W_PG), DM / 32, q);) TSTAMP(7); }
        GSYNC(); TSTAMP(8);
    }
    {
        const int tid = fresh_tid(), lane = tid & 63, wave = __builtin_amdgcn_readfirstlane(tid >> 6);
        const int gw = blockIdx.x * NWAVES + wave, NGW = G * NWAVES;
        const float* ssf = SSB + (size_t)(3 * NLAYER) * MT; const float* gf = ARG(21); const bf16_t* XN = XN_; float* out = ARG_OUT;
        for (int row0 = 2 * gw; row0 < MT; row0 += 2 * NGW) {
            u32x2 xv[2][4];
#pragma unroll
            for (int rr = 0; rr < 2; ++rr)
#pragma unroll
                for (int j = 0; j < 4; ++j) xv[rr][j] = *((const u32x2*)(XN + (size_t)(row0 + rr) * DM) + lane + 64 * j);
#pragma unroll
            for (int rr = 0; rr < 2; ++rr) { const int row = row0 + rr; const float rs = rstd_of(ssf[row]);
                float* dst = row < MP ? out + O_YP + (size_t)row * DM : out + O_YS + (size_t)(row - MP) * DM;
#pragma unroll
                for (int j = 0; j < 4; ++j) { const f32x4 gv = *((const f32x4*)gf + lane + 64 * j); const u32x2 w = xv[rr][j];
                    const f32x4 v = {bf_lo(w.x), bf_hi(w.x), bf_lo(w.y), bf_hi(w.y)};
                    *((f32x4*)dst + lane + 64 * j) = v * rs * gv; } }
        }
    }
#if PROBE_SEL >= 0
    TSTAMP(11); grid.sync();
    if (blockIdx.x == 0 && fresh_tid() == 0) { const unsigned long long* tsb = WS_PTR(unsigned long long, WS_CTL + 4096); float* o = ARG_OUT + O_YS; unsigned long long tv = 0; if (PROBE_SEL == 20) tv = tsb[16+1] + tsb[16+3] + tsb[16+10] + tsb[16+4] + tsb[16+5] + tsb[16+6]; else if (PROBE_SEL == 21) tv = tsb[16+0] + tsb[16+11]; else if (PROBE_SEL < 16) tv = tsb[16 + PROBE_SEL]; o[0] += (float)tv * 2.5e-5f; }
#endif
}

extern "C" void kernel_launch(void* const* d_in, const int* in_sizes, int n_in, void* d_out, int out_size, void* d_ws, size_t ws_size, hipStream_t stream) {
    static int grid = 0;
    if (grid == 0) {
        int dev = 0, cus = 0, per_cu = 0;
        hipGetDevice(&dev);
        hipDeviceGetAttribute(&cus, hipDeviceAttributeMultiprocessorCount, dev);
        hipFuncSetAttribute((const void*)hymba_fwd, hipFuncAttributeMaxDynamicSharedMemorySize, LDS_BYTES);
        hipOccupancyMaxActiveBlocksPerMultiprocessor(&per_cu, (const void*)hymba_fwd, NTHREADS, LDS_BYTES);
        if (per_cu < 1) per_cu = 1;
        grid = cus * per_cu;
        if (n_in != 22 || ws_size < WS_END) { fprintf(stderr, "kernel_launch: unexpected n_in %d / ws_size %zu\n", n_in, ws_size); }
    }
    Args a{};
    for (int i = 0; i < 22; ++i) a.in[i] = (const float*)d_in[i];
    a.out = (float*)d_out; a.ws = (unsigned char*)d_ws;
    void* kargs[] = {&a};
    hipError_t e = hipLaunchCooperativeKernel((const void*)hymba_fwd, dim3(grid), dim3(NTHREADS), kargs, LDS_BYTES, stream);
    if (e != hipSuccess) fprintf(stderr, "cooperative launch failed: %s (grid %d)\n", hipGetErrorString(e), grid);
}
```

```cpp
#include <hip/hip_runtime.h>
#include <hip/hip_cooperative_groups.h>
#include <cstdio>
#include <cstdint>
namespace cg = cooperative_groups;
__device__ __forceinline__ int fresh_tid() { int t = threadIdx.x; asm volatile("" : "+v"(t)); return t; }
namespace pg8 {
#define PG8_LAS __attribute__((address_space(3)))
typedef unsigned short bf16_t;
typedef short bf16x8 __attribute__((ext_vector_type(8)));
typedef float f32x4 __attribute__((ext_vector_type(4)));
typedef unsigned u32x4 __attribute__((ext_vector_type(4)));
constexpr int BM = 256, BK = 64, HALF = 128, HTB = HALF * BK * 2  , STAGE_BYTES = 8 * HTB, NXCD = 8, WGM = 8;

__host__ __device__ __forceinline__ int lds_byte(int r, int c) { const int st = (r >> 4) * 2 + (c >> 5), rr = r & 15, cc = c & 31, ob = rr * 64 + cc * 2; return st * 1024 + (ob ^ (((ob >> 9) & 1) << 5)); }
__host__ __device__ __forceinline__ void stage_rc(int b, int& R, int& C) { const int st = b / 1024, sb = b % 1024, swz = sb ^ (((sb >> 9) & 1) << 5); R = (st >> 1) * 16 + swz / 64; C = (st & 1) * 32 + (swz % 64) / 2; }
__host__ __device__ __forceinline__ int perm32(int rho) { const int n = rho >> 4, i = rho & 15; return 8 * (i >> 2) + 4 * n + (i & 3); }

struct Unit { int pm, pn; };
struct Gemm { const bf16_t* A; const bf16_t* Bt; int M, N, K; };

struct StaticOrder {
    int nM, nN, nwg, G, c;
    __host__ __device__ void init(int M, int N, int G_, int c_) { nM = M / BM; nN = N / BM; nwg = nM * nN; G = G_; c = c_; }
    __host__ __device__ bool next(int i, Unit& u) const {
        const long L = (long)i * G + c; if (L >= nwg) return false;
        int wgid = (int)L; { const int q = nwg / NXCD, r = nwg % NXCD, xcd = wgid % NXCD, off = wgid / NXCD; wgid = (xcd < r ? xcd * (q + 1) : r * (q + 1) + (xcd - r) * q) + off; }
        const int nig = WGM * nN, gid = wgid / nig, fm = gid * WGM, gsz = (nM - fm) < WGM ? (nM - fm) : WGM;
        u.pm = fm + ((wgid % nig) % gsz); u.pn = (wgid % nig) / gsz; return true;
    }
    __device__ __forceinline__ void a_ready(const Unit&) const {}
    __device__ __forceinline__ void done(const Unit&) const {}
};

template <class Epi, class Sched, bool ALIGN_EPI = false, bool SP2 = false>
__device__ __forceinline__ void gemm_phase(PG8_LAS unsigned char* lds, const Gemm g, const Sched& S, const Epi& E) {
    const int tid = fresh_tid(), wid = __builtin_amdgcn_readfirstlane(tid >> 6), lane = tid & 63, wr = wid >> 2, wc = wid & 3, fr = lane & 15, fq = lane >> 4;
    const int K = g.K, nt = K / BK;
    unsigned voffA[2], voffB[2];
#pragma unroll
    for (int i = 0; i < 2; ++i) { int R, C; stage_rc(tid * 16 + i * 8192, R, C); const int Rb = Epi::PERM ? ((R & ~31) + perm32(R & 31)) : R;
        voffA[i] = (unsigned)(R * K + C) * 2u; voffB[i] = (unsigned)(Rb * K + C) * 2u; }
    const size_t kstep = (size_t)(BK * 2);
    const size_t hstep = (size_t)HALF * K * 2;
    const size_t tstep = 2 * hstep;
    const unsigned ldsw = (unsigned)wid * 1024u;
    const int aoff = lds_byte(wr * 64 + fr, fq * 8), boff = lds_byte(wc * 32 + fr, fq * 8);
#define PG8_SA(b, h) (((b) * 2 + (h)) * HTB)
#define PG8_SB(b, h) ((4 + (b) * 2 + (h)) * HTB)
#define PG8_STAGE(bufoff, gbase, voff) do { _Pragma("unroll") for (int _i = 0; _i < 2; ++_i) \
        __builtin_amdgcn_global_load_lds((const unsigned*)((const char*)(gbase) + (voff)[_i]), (PG8_LAS unsigned*)(lds + (bufoff) + ldsw + _i * 8192), 16, 0, 0); } while (0)
#define PG8_LDA(dst, b, h) do { _Pragma("unroll") for (int m = 0; m < 4; ++m) _Pragma("unroll") for (int k = 0; k < 2; ++k) dst[m][k] = *(const PG8_LAS bf16x8*)(lds + PG8_SA(b, h) + aoff + m * 2048 + k * 1024); } while (0)
#define PG8_LDB(dst, b, h) do { _Pragma("unroll") for (int n = 0; n < 2; ++n) _Pragma("unroll") for (int k = 0; k < 2; ++k) dst[n][k] = *(const PG8_LAS bf16x8*)(lds + PG8_SB(b, h) + boff + n * 2048 + k * 1024); } while (0)
#define PG8_MMA(ai, bj, At, Bt) do { __builtin_amdgcn_s_setprio(1); _Pragma("unroll") for (int m = 0; m < 4; ++m) _Pragma("unroll") for (int n = 0; n < 2; ++n) _Pragma("unroll") for (int k = 0; k < 2; ++k) \
        acc[ai][bj][m][n] = __builtin_amdgcn_mfma_f32_16x16x32_bf16(Bt[n][k], At[m][k], acc[ai][bj][m][n], 0, 0, 0); __builtin_amdgcn_s_setprio(0); } while (0)
#define PG8_WAIT_V(n) asm volatile("s_waitcnt vmcnt(" #n ")" ::: "memory")
#define PG8_WAIT_L(n) asm volatile("s_waitcnt lgkmcnt(" #n ")" ::: "memory")
#define PG8_BAR __builtin_amdgcn_s_barrier()
#define PG8_SCHED __builtin_amdgcn_sched_barrier(0)
    Unit cur, nxt; int ui = 0;
    if (!S.next(0, cur)) return;
    f32x4 acc[2][2][4][2];
#pragma unroll
    for (int a = 0; a < 2; ++a)
#pragma unroll
        for (int b = 0; b < 2; ++b)
#pragma unroll
            for (int m = 0; m < 4; ++m)
#pragma unroll
                for (int n = 0; n < 2; ++n) acc[a][b][m][n] = (f32x4){0.f, 0.f, 0.f, 0.f};
    bf16x8 At[4][2], B0[2][2], B1[2][2];
    const char* cA = (const char*)g.A + (size_t)cur.pm * tstep; const char* cB = (const char*)g.Bt + (size_t)cur.pn * tstep;
    S.a_ready(cur);
    if constexpr (SP2) {
        PG8_STAGE(PG8_SB(0, 0), cB, voffB); PG8_STAGE(PG8_SB(0, 1), cB + hstep, voffB); PG8_STAGE(PG8_SA(0, 0), cA, voffA); PG8_STAGE(PG8_SA(0, 1), cA + hstep, voffA);
        if (wr == 1) PG8_BAR;
        PG8_WAIT_V(2); PG8_BAR;
        PG8_STAGE(PG8_SB(1, 0), cB + kstep, voffB); PG8_STAGE(PG8_SA(1, 0), cA + kstep, voffA); PG8_STAGE(PG8_SB(1, 1), cB + hstep + kstep, voffB);
        PG8_WAIT_V(6); PG8_BAR;
    } else {
        PG8_STAGE(PG8_SB(0, 0), cB, voffB); PG8_STAGE(PG8_SA(0, 0), cA, voffA); PG8_STAGE(PG8_SB(0, 1), cB + hstep, voffB); PG8_STAGE(PG8_SA(0, 1), cA + hstep, voffA);
        if (wr == 1) PG8_BAR;
        PG8_WAIT_V(4); PG8_BAR;
        PG8_STAGE(PG8_SB(1, 0), cB + kstep, voffB); PG8_STAGE(PG8_SA(1, 0), cA + kstep, voffA); PG8_STAGE(PG8_SB(1, 1), cB + hstep + kstep, voffB);
        PG8_WAIT_V(6); PG8_BAR;
    }
    for (;;) {
        const bool has_next = S.next(ui + 1, nxt);
        const char* nA = has_next ? (const char*)g.A + (size_t)nxt.pm * tstep : cA; const char* nB = has_next ? (const char*)g.Bt + (size_t)nxt.pn * tstep : cB;
        for (int t = 0; t < nt; t += 2) {
            const bool last = (t == nt - 2);
            const char* a1 = cA + (size_t)(t + 1) * kstep;
            const char* a2 = last ? nA : cA + (size_t)(t + 2) * kstep; const char* b2 = last ? nB : cB + (size_t)(t + 2) * kstep;
            const char* a3 = a2 + kstep; const char* b3 = b2 + kstep;
            if (last && has_next) S.a_ready(nxt);
            if constexpr (SP2) {
            PG8_LDB(B0, 0, 0); PG8_LDB(B1, 0, 1); PG8_SCHED; PG8_LDA(At, 0, 0); PG8_STAGE(PG8_SA(1, 1), a1 + hstep, voffA);
            PG8_WAIT_V(8); PG8_WAIT_L(0); PG8_BAR; PG8_MMA(0, 0, At, B0); PG8_MMA(0, 1, At, B1); PG8_BAR; PG8_SCHED;
            PG8_LDA(At, 0, 1); PG8_STAGE(PG8_SB(0, 0), b2, voffB); PG8_STAGE(PG8_SB(0, 1), b2 + hstep, voffB); PG8_STAGE(PG8_SA(0, 0), a2, voffA);
            PG8_WAIT_V(8); PG8_WAIT_L(0); PG8_BAR; PG8_MMA(1, 0, At, B0); PG8_MMA(1, 1, At, B1); PG8_BAR; PG8_SCHED;
            PG8_LDB(B0, 1, 0); PG8_LDB(B1, 1, 1); PG8_SCHED; PG8_LDA(At, 1, 0); PG8_STAGE(PG8_SA(0, 1), a2 + hstep, voffA);
            PG8_WAIT_V(8); PG8_WAIT_L(0); PG8_BAR; PG8_MMA(0, 0, At, B0); PG8_MMA(0, 1, At, B1); PG8_BAR; PG8_SCHED;
            PG8_LDA(At, 1, 1); PG8_STAGE(PG8_SB(1, 0), b3, voffB); PG8_STAGE(PG8_SB(1, 1), b3 + hstep, voffB); PG8_STAGE(PG8_SA(1, 0), a3, voffA);
            PG8_WAIT_V(8); PG8_WAIT_L(0); PG8_BAR; PG8_MMA(1, 0, At, B0); PG8_MMA(1, 1, At, B1); PG8_BAR; PG8_SCHED;
            } else {
            PG8_LDB(B0, 0, 0); PG8_SCHED; PG8_LDA(At, 0, 0); PG8_STAGE(PG8_SA(1, 1), a1 + hstep, voffA);
            PG8_WAIT_L(8); PG8_BAR; PG8_WAIT_L(0); PG8_MMA(0, 0, At, B0); PG8_BAR; PG8_SCHED;
            PG8_LDB(B1, 0, 1); PG8_STAGE(PG8_SB(0, 0), b2, voffB);
            PG8_BAR; PG8_WAIT_L(0); PG8_MMA(0, 1, At, B1); PG8_BAR;
            PG8_LDA(At, 0, 1); PG8_STAGE(PG8_SA(0, 0), a2, voffA);
            PG8_BAR; PG8_WAIT_L(0); PG8_MMA(1, 0, At, B0); PG8_BAR; PG8_SCHED;
            PG8_STAGE(PG8_SB(0, 1), b2 + hstep, voffB);
            PG8_WAIT_V(6); PG8_BAR; PG8_MMA(1, 1, At, B1); PG8_BAR;
            PG8_LDB(B0, 1, 0); PG8_SCHED; PG8_LDA(At, 1, 0); PG8_STAGE(PG8_SA(0, 1), a2 + hstep, voffA);
            PG8_WAIT_L(8); PG8_BAR; PG8_WAIT_L(0); PG8_MMA(0, 0, At, B0); PG8_BAR; PG8_SCHED;
            PG8_LDB(B1, 1, 1); PG8_STAGE(PG8_SB(1, 0), b3, voffB);
            PG8_BAR; PG8_WAIT_L(0); PG8_MMA(0, 1, At, B1); PG8_BAR;
            PG8_LDA(At, 1, 1); PG8_STAGE(PG8_SA(1, 0), a3, voffA);
            PG8_BAR; PG8_WAIT_L(0); PG8_MMA(1, 0, At, B0); PG8_BAR; PG8_SCHED;
            PG8_STAGE(PG8_SB(1, 1), b3 + hstep, voffB);
            PG8_WAIT_V(6); PG8_BAR; PG8_MMA(1, 1, At, B1); PG8_BAR;
            }
        }
        if constexpr (ALIGN_EPI) { if (wr == 0) PG8_BAR; }
        if constexpr (!Epi::AFTER_DRAIN) { E(acc, cur, wr, wc, fr, fq); S.done(cur); }
        if (!has_next) break;
#pragma unroll
        for (int a = 0; a < 2; ++a)
#pragma unroll
            for (int b = 0; b < 2; ++b)
#pragma unroll
                for (int m = 0; m < 4; ++m)
#pragma unroll
                    for (int n = 0; n < 2; ++n) acc[a][b][m][n] = (f32x4){0.f, 0.f, 0.f, 0.f};
        cur = nxt; cA = nA; cB = nB; ++ui;
        if constexpr (ALIGN_EPI) { if (wr == 1) PG8_BAR; }
    }
    PG8_WAIT_V(0);
    if constexpr (!ALIGN_EPI) { if (wr == 0) PG8_BAR; }
    PG8_BAR;
    if constexpr (Epi::AFTER_DRAIN) { E.fused(acc, cur, wr, wc, fr, fq, lds, wid, lane); S.done(cur); }
#undef PG8_SA
#undef PG8_SB
#undef PG8_STAGE
#undef PG8_LDA
#undef PG8_LDB
#undef PG8_MMA
#undef PG8_WAIT_V
#undef PG8_WAIT_L
#undef PG8_BAR
#undef PG8_SCHED
}
}

#define LAS __attribute__((address_space(3)))
using pg8::bf16_t; using pg8::bf16x8; using pg8::f32x4; using pg8::u32x4;
typedef short s16x4 __attribute__((ext_vector_type(4)));
typedef float f32x16 __attribute__((ext_vector_type(16)));
typedef unsigned u32x2 __attribute__((ext_vector_type(2)));
typedef float f32x2_t __attribute__((ext_vector_type(2)));
typedef __bf16 bf16x2_t __attribute__((ext_vector_type(2)));

constexpr int DM = 1024, SEQ = 2048, NBATCH = 8, MP = NBATCH * SEQ, DSEQ = 16, MS = NBATCH * DSEQ, MT = MP + MS;
constexpr int DFF = 2816, NQKV = 3072, PLED = 256, NLAYER = 2, PAST = 2048, BANDL = 512, HW = 512;
constexpr float EPS = 1e-6f, LOG2E = 1.4426950408889634f, QSCALE = 0.125f * LOG2E;
#ifndef SB_EARLY
#define SB_EARLY 1
#endif
constexpr float SB_THR = 7.5e-37f;

constexpr size_t MiB = 1u << 20;
constexpr size_t WS_CTL = 0, WS_SS = 64 * 1024;
constexpr size_t WS_W = 2 * MiB, W_LSTRIDE = 28 * MiB, W_IN = 0, W_OUT = 6 * MiB, W_GU = 8 * MiB, W_DOWN = 19 * MiB, W_PG = 25 * MiB, W_PP = 27 * MiB;
constexpr size_t WS_PB = 58 * MiB, WS_X = 76 * MiB  , WS_XB = 142 * MiB, WS_QKV = 176 * MiB, WS_MIX = 274 * MiB, WS_P = 308 * MiB, WS_END = 342 * MiB;
constexpr int LDS_BYTES = 131072 + 1024;
constexpr size_t WS_BAR = 8192;
constexpr int NWAVES = 8, NTHREADS = 512;

constexpr size_t O_YP = 0, O_YS = (size_t)MP * DM, O_SBK_P = O_YS + (size_t)MS * DM, O_SBV_P = O_SBK_P + (size_t)NLAYER * MP * HW,
                 O_CBK_P = O_SBV_P + (size_t)NLAYER * MP * HW, O_CBV_P = O_CBK_P + (size_t)NLAYER * NBATCH * BANDL * HW,
                 O_SBK_S = O_CBV_P + (size_t)NLAYER * NBATCH * BANDL * HW, O_SBV_S = O_SBK_S + (size_t)NLAYER * MS * HW,
                 O_CBK_S = O_SBV_S + (size_t)NLAYER * MS * HW, O_CBV_S = O_CBK_S + (size_t)NLAYER * MS * HW;

__device__ __forceinline__ unsigned pk2(float lo, float hi) { f32x2_t v = {lo, hi}; bf16x2_t b = __builtin_convertvector(v, bf16x2_t); return __builtin_bit_cast(unsigned, b); }
__device__ __forceinline__ float bf_lo(unsigned w) { return __uint_as_float(w << 16); }
__device__ __forceinline__ float bf_hi(unsigned w) { return __uint_as_float(w & 0xffff0000u); }
__device__ __forceinline__ float partner32(float v) {
    auto rr = __builtin_amdgcn_permlane32_swap(__float_as_uint(v), __float_as_uint(v), false, false);
    return (threadIdx.x & 32) ? __uint_as_float(rr[0]) : __uint_as_float(rr[1]);
}
__device__ __forceinline__ float wave_sum(float v) {
#pragma unroll
    for (int o = 1; o < 64; o <<= 1) v += __shfl_xor(v, o);
    return v;
}
__device__ __forceinline__ float rstd_of(float ss) { return rsqrtf(ss * (1.0f / DM) + EPS); }

template <int I> __device__ __forceinline__ const float* argp() {
    unsigned long long v; const void* ka = (const void*)__builtin_amdgcn_kernarg_segment_ptr();
    asm volatile("s_load_dwordx2 %0, %1, %2\n\ts_waitcnt lgkmcnt(0)" : "=s"(v) : "s"(ka), "i"(I * 8) : "memory");
    return (const float*)(const __attribute__((address_space(1))) float*)v;
}
#define ARG(i) argp<i>()
#define ARG_OUT ((float*)argp<22>())
#define ARG_WS ((unsigned char*)argp<23>())
#define WS_PTR(T, off) ((T*)(ARG_WS + (off)))
#define SSB WS_PTR(float, WS_SS)
#define PB_ WS_PTR(bf16_t, WS_PB)
#define XN_ WS_PTR(bf16_t, WS_X)
#define XB_ WS_PTR(bf16_t, WS_XB)
#define QKV_ WS_PTR(bf16_t, WS_QKV)
#define HB_ WS_PTR(bf16_t, WS_QKV)
#define MIX_ WS_PTR(bf16_t, WS_MIX)
#define PBUF_ WS_PTR(bf16_t, WS_P)
#define WPTR(L, off) ((const bf16_t*)(ARG_WS + WS_W + (size_t)(L) * W_LSTRIDE + (off)))

enum { EP_QKV = 0, EP_RES = 1, EP_GU = 2, EP_P = 3, EP_PLE = 4 };
struct EpiArgs {
    const float* ss_in; float* ss_out;
    const bf16_t* xbase;
    bf16_t* XB; bf16_t* o0; const bf16_t* P;
    float *f_sbk, *f_sbv, *f_cbk, *f_cbv;
    float *s_sbk, *s_sbv, *s_cbk, *s_cbv;
};
template <int MODE> struct Epi {
    static constexpr bool PERM = false, AFTER_DRAIN = false;
    EpiArgs a;
    __device__ __forceinline__ void operator()(const f32x4 (&acc)[2][2][4][2], const pg8::Unit& u, int wr, int wc, int fr, int fq) const {
        if constexpr (MODE == EP_QKV) {
            const int part = u.pn >> 1, cb = (u.pn & 1) * 256 + wc * 32 + 4 * fq;
            bf16_t* ob = a.o0 + (size_t)part * ((size_t)MT * HW);
            float* fo = part == 1 ? a.f_sbk : part == 2 ? a.f_sbv : part == 4 ? a.f_cbk : part == 5 ? a.f_cbv : nullptr;
            const bool band = part >= 4; const float qs = (part == 0 || part == 3) ? QSCALE : 1.f;
#pragma unroll
            for (int ai = 0; ai < 2; ++ai)
#pragma unroll
                for (int m = 0; m < 4; ++m) {
                    const int row = u.pm * 256 + ai * 128 + wr * 64 + m * 16 + fr;
                    const float rs = rstd_of(a.ss_in[row]) * qs;
                    const int t = row & (SEQ - 1);
                    float* frow = nullptr;
                    if (fo) { if (!band) frow = fo + (size_t)row * HW; else if (t >= SEQ - BANDL) frow = fo + ((size_t)(row >> 11) * BANDL + (t - (SEQ - BANDL))) * HW; }
#pragma unroll
                    for (int bj = 0; bj < 2; ++bj)
#pragma unroll
                        for (int n = 0; n < 2; ++n) {
                            const int col = cb + bj * 128 + n * 16; const f32x4 v = acc[ai][bj][m][n] * rs;
                            u32x2 w; w.x = pk2(v[0], v[1]); w.y = pk2(v[2], v[3]);
                            *(u32x2*)(ob + (size_t)row * HW + col) = w;
                            if (frow) __builtin_nontemporal_store(v, (f32x4*)(frow + col));
                        }
                }
        } else if constexpr (MODE == EP_RES || MODE == EP_PLE) {
#pragma unroll
            for (int ai = 0; ai < 2; ++ai)
#pragma unroll
                for (int m = 0; m < 4; ++m) {
                    const int row = u.pm * 256 + ai * 128 + wr * 64 + m * 16 + fr;
                    float rs = 0.f; if constexpr (MODE == EP_PLE) rs = rstd_of(a.ss_in[row]) * (-LOG2E);
                    float s = 0.f;
#pragma unroll
                    for (int bj = 0; bj < 2; ++bj)
#pragma unroll
                        for (int n = 0; n < 2; ++n) {
                            const size_t off = (size_t)row * DM + u.pn * 256 + bj * 128 + wc * 32 + n * 16 + 4 * fq;
                            const u32x2 xw = *(const u32x2*)(a.xbase + off); f32x4 x = {bf_lo(xw.x), bf_hi(xw.x), bf_lo(xw.y), bf_hi(xw.y)}; const f32x4 c = acc[ai][bj][m][n];
                            if constexpr (MODE == EP_RES) x += c;
                            else { const u32x2 pw = *(const u32x2*)(a.P + off);
                                   x[0] += bf_lo(pw.x) * __builtin_amdgcn_rcpf(1.f + __builtin_amdgcn_exp2f(c[0] * rs));
                                   x[1] += bf_hi(pw.x) * __builtin_amdgcn_rcpf(1.f + __builtin_amdgcn_exp2f(c[1] * rs));
                                   x[2] += bf_lo(pw.y) * __builtin_amdgcn_rcpf(1.f + __builtin_amdgcn_exp2f(c[2] * rs));
                                   x[3] += bf_hi(pw.y) * __builtin_amdgcn_rcpf(1.f + __builtin_amdgcn_exp2f(c[3] * rs)); }
                            u32x2 w; w.x = pk2(x[0], x[1]); w.y = pk2(x[2], x[3]); *(u32x2*)(a.XB + off) = w;
                            s += (x[0] * x[0] + x[1] * x[1]) + (x[2] * x[2] + x[3] * x[3]);
                        }
                    s += __shfl_xor(s, 16); s += __shfl_xor(s, 32);
                    if (fq == 0) unsafeAtomicAdd(a.ss_out + row, s);
                }
        } else if constexpr (MODE == EP_GU) {
#pragma unroll
            for (int ai = 0; ai < 2; ++ai)
#pragma unroll
                for (int m = 0; m < 4; ++m) {
                    const int row = u.pm * 256 + ai * 128 + wr * 64 + m * 16 + fr;
                    const float rs = rstd_of(a.ss_in[row]);
#pragma unroll
                    for (int n = 0; n < 2; ++n) {
                        const int col = u.pn * 128 + wc * 32 + n * 16 + 4 * fq;
                        const f32x4 g = acc[ai][0][m][n] * rs, up = acc[ai][1][m][n] * rs; float h[4];
#pragma unroll
                        for (int e = 0; e < 4; ++e) h[e] = g[e] * up[e] * __builtin_amdgcn_rcpf(1.f + __builtin_amdgcn_exp2f(-LOG2E * g[e]));
                        u32x2 w; w.x = pk2(h[0], h[1]); w.y = pk2(h[2], h[3]);
                        *(u32x2*)(a.o0 + (size_t)row * DFF + col) = w;
                    }
                }
        } else {
#pragma unroll
            for (int ai = 0; ai < 2; ++ai)
#pragma unroll
                for (int m = 0; m < 4; ++m) {
                    const int row = u.pm * 256 + ai * 128 + wr * 64 + m * 16 + fr;
#pragma unroll
                    for (int bj = 0; bj < 2; ++bj)
#pragma unroll
                        for (int n = 0; n < 2; ++n) {
                            const size_t off = (size_t)row * DM + u.pn * 256 + bj * 128 + wc * 32 + n * 16 + 4 * fq; const f32x4 v = acc[ai][bj][m][n];
                            u32x2 w; w.x = pk2(v[0], v[1]); w.y = pk2(v[2], v[3]); *(u32x2*)(a.o0 + off) = w;
                        }
                }
        }
    }
};

template <int MODE, int K>
__device__ __forceinline__ void sgemm(LAS unsigned char* lds, const bf16_t* A, const bf16_t* Bt, int ncol32, const EpiArgs& a) {
    const int tid = fresh_tid(), lane = tid & 63, wave = __builtin_amdgcn_readfirstlane(tid >> 6), r = lane & 31, hh = lane >> 5;
    LAS float* red = (LAS float*)lds;
    constexpr int K8 = K >> 3, NK = K8 / 16, UB = NK > 11 ? 11 : NK;
    static_assert(NK % UB == 0, "sgemm: K split");
    const int G = gridDim.x, nunits = 4 * ncol32;
    for (int j = G - 1 - (int)blockIdx.x; j < nunits; j += G) {
        const int rb = j & 3, c0 = 32 * (j >> 2);
        const int brow0 = (MODE == EP_GU) ? ((c0 >> 7) * 256 + (c0 & 127)) : c0;
        const bf16_t* ap = A + (size_t)(32 * rb + r) * K + wave * K8 + 8 * hh;
        const bf16_t* bp = Bt + (size_t)(brow0 + r) * K + wave * K8 + 8 * hh;
        f32x16 acc0 = {}, acc1 = {};
#pragma unroll 1
        for (int kb = 0; kb < NK; kb += UB) {
            bf16x8 af[UB], bf[UB], bf2[MODE == EP_GU ? UB : 1];
#pragma unroll
            for (int i = 0; i < UB; ++i) { af[i] = *(const bf16x8*)(ap + (kb + i) * 16); bf[i] = *(const bf16x8*)(bp + (kb + i) * 16);
                if constexpr (MODE == EP_GU) bf2[i] = *(const bf16x8*)(bp + (size_t)128 * K + (kb + i) * 16); }
#pragma unroll
            for (int i = 0; i < UB; ++i) { acc0 = __builtin_amdgcn_mfma_f32_32x32x16_bf16(af[i], bf[i], acc0, 0, 0, 0);
                if constexpr (MODE == EP_GU) acc1 = __builtin_amdgcn_mfma_f32_32x32x16_bf16(af[i], bf2[i], acc1, 0, 0, 0); }
        }
#pragma unroll
        for (int i = 0; i < 16; ++i) { red[(wave * 16 + i) * 64 + lane] = acc0[i]; if constexpr (MODE == EP_GU) red[8192 + (wave * 16 + i) * 64 + lane] = acc1[i]; }
        __syncthreads();
        const int col = c0 + r;
#pragma unroll
        for (int ii = 0; ii < 2; ++ii) {
            const int i = 2 * wave + ii;
            float v0 = 0.f, v1 = 0.f;
#pragma unroll
            for (int w = 0; w < 8; ++w) { v0 += red[(w * 16 + i) * 64 + lane]; if constexpr (MODE == EP_GU) v1 += red[8192 + (w * 16 + i) * 64 + lane]; }
            const int rs_ = 32 * rb + (i & 3) + 8 * (i >> 2) + 4 * hh, row = MP + rs_;
            if constexpr (MODE == EP_QKV) {
                const int part = c0 >> 9, cc = col & 511;
                const float v = v0 * rstd_of(a.ss_in[row]);
                const float qs = (part == 0 || part == 3) ? QSCALE : 1.f;
                (a.o0 + (size_t)part * ((size_t)MT * HW))[(size_t)row * HW + cc] = (bf16_t)(pk2(v * qs, 0.f) & 0xffffu);
                float* fo = part == 1 ? a.s_sbk : part == 2 ? a.s_sbv : part == 4 ? a.s_cbk : part == 5 ? a.s_cbv : nullptr;
                if (fo) fo[(size_t)rs_ * HW + cc] = v;
            } else if constexpr (MODE == EP_RES || MODE == EP_PLE) {
                const size_t off = (size_t)row * DM + col;
                float x = __uint_as_float((unsigned)a.xbase[off] << 16);
                if constexpr (MODE == EP_RES) x += v0;
                else { const float pv = __uint_as_float((unsigned)a.P[off] << 16); x += pv * __builtin_amdgcn_rcpf(1.f + __builtin_amdgcn_exp2f(-LOG2E * v0 * rstd_of(a.ss_in[row]))); }
                a.XB[off] = (bf16_t)(pk2(x, 0.f) & 0xffffu);
                float s = x * x;
                s += __shfl_xor(s, 1); s += __shfl_xor(s, 2); s += __shfl_xor(s, 4); s += __shfl_xor(s, 8); s += __shfl_xor(s, 16);
                if (r == 0) unsafeAtomicAdd(a.ss_out + row, s);
            } else if constexpr (MODE == EP_GU) {
                const float rs = rstd_of(a.ss_in[row]); const float g = v0 * rs, up = v1 * rs;
                const float h = g * up * __builtin_amdgcn_rcpf(1.f + __builtin_amdgcn_exp2f(-LOG2E * g));
                a.o0[(size_t)row * DFF + col] = (bf16_t)(pk2(h, 0.f) & 0xffffu);
            } else {
                a.o0[(size_t)row * DM + col] = (bf16_t)(pk2(v0, 0.f) & 0xffffu);
            }
        }
        __syncthreads();
    }
}
struct AttnArgs { int L; };
constexpr int AW_V = 0, AW_ST = 4096, AW_BIAS = 8704, AW_BYTES = 10240, ST_PITCH = 144;

template <bool F32> __device__ __forceinline__ void ld_k(bf16x8 (&kf)[4], const void* base, size_t off) {
    if constexpr (!F32) { const bf16_t* p = (const bf16_t*)base + off;
#pragma unroll
        for (int kk = 0; kk < 4; ++kk) kf[kk] = *(const bf16x8*)(p + 8 * kk);
    } else { const float* p = (const float*)base + off;
#pragma unroll
        for (int kk = 0; kk < 4; ++kk) { const f32x4 x = *(const f32x4*)(p + 8 * kk), y = *(const f32x4*)(p + 8 * kk + 4);
            u32x4 w; w.x = pk2(x[0], x[1]); w.y = pk2(x[2], x[3]); w.z = pk2(y[0], y[1]); w.w = pk2(y[2], y[3]); kf[kk] = __builtin_bit_cast(bf16x8, w); }
    }
}
template <bool F32> __device__ __forceinline__ void ld_v(u32x4 (&vr)[4], const void* base, size_t row0, int nvalid, int h, int lane) {
#pragma unroll
    for (int i = 0; i < 4; ++i) { int key = 8 * i + (lane >> 3); key = key < nvalid ? key : nvalid - 1;
        const size_t off = (row0 + key) * HW + h * 64 + (lane & 7) * 8;
        if constexpr (!F32) vr[i] = *(const u32x4*)((const bf16_t*)base + off);
        else { const float* p = (const float*)base + off; const f32x4 x = *(const f32x4*)p, y = *(const f32x4*)(p + 4);
            u32x4 w; w.x = pk2(x[0], x[1]); w.y = pk2(x[2], x[3]); w.z = pk2(y[0], y[1]); w.w = pk2(y[2], y[3]); vr[i] = w; }
    }
}
__device__ __forceinline__ void st_v(LAS unsigned char* vl, const u32x4 (&vr)[4], int lane) {
#pragma unroll
    for (int i = 0; i < 4; ++i) { const int key = 8 * i + (lane >> 3); *(LAS u32x4*)(vl + key * 128 + (((lane & 7) * 16) ^ (((key >> 1) & 1) << 6))) = vr[i]; }
}
typedef short v4i16_t __attribute__((ext_vector_type(4)));
__device__ __forceinline__ s16x4 vtr(LAS unsigned char* p) { return __builtin_bit_cast(s16x4, __builtin_amdgcn_ds_read_tr16_b64_v4i16((LAS v4i16_t*)p)); }
__device__ __forceinline__ void pv_block(f32x16 (&o)[2], LAS unsigned char* vl, const bf16x8 (&pf)[2], int lane) {
    const int q = (lane & 15) >> 2, p = lane & 3, c16 = (lane >> 4) & 1, hh = lane >> 5;
    const int va0 = (4 * hh + q) * 128 + ((32 * c16 + 8 * p) ^ ((q >> 1) << 6));
#pragma unroll
    for (int db = 0; db < 2; ++db)
#pragma unroll
        for (int s = 0; s < 2; ++s) {
            const s16x4 lo = vtr(vl + (va0 ^ (db * 64)) + s * 2048), hi = vtr(vl + (va0 ^ (db * 64)) + s * 2048 + 1024);
            const bf16x8 vf = {lo[0], lo[1], lo[2], lo[3], hi[0], hi[1], hi[2], hi[3]};
            o[db] = __builtin_amdgcn_mfma_f32_32x32x16_bf16(vf, pf[s], o[db], 0, 0, 0);
        }
}
__device__ __forceinline__ f32x16 qk_block(const bf16x8 (&kf)[4], const bf16x8 (&qf)[4]) {
    f32x16 S = {};
#pragma unroll
    for (int kk = 0; kk < 4; ++kk) S = __builtin_amdgcn_mfma_f32_32x32x16_bf16(kf[kk], qf[kk], S, 0, 0, 0);
    return S;
}
__device__ __forceinline__ void sb_block(const f32x16& S, LAS unsigned char* vl, int tq, int keypos0, float& carry, f32x16 (&o)[2], int lane) {
    const int hh = lane >> 5;
    float kp_[16], be[16];
#pragma unroll
    for (int r = 0; r < 16; ++r) {
        const int kp = keypos0 + (r & 3) + 8 * (r >> 2) + 4 * hh; const bool valid = kp < tq;
        const float z = __builtin_amdgcn_fmed3f(S[r], -126.f, 100.f);
        const float t = __builtin_amdgcn_exp2f(z), k = __builtin_amdgcn_rcpf(1.f + t);
        kp_[r] = valid ? k : 1.f; be[r] = valid ? t * k : 0.f;
    }
    float T[4], Tp[4], U[4];
#pragma unroll
    for (int g = 0; g < 4; ++g) { T[g] = (kp_[4 * g] * kp_[4 * g + 1]) * (kp_[4 * g + 2] * kp_[4 * g + 3]); Tp[g] = partner32(T[g]); U[g] = T[g] * Tp[g]; }
    float R[4]; R[3] = 1.f; R[2] = U[3]; R[1] = U[3] * U[2]; R[0] = R[1] * U[1];
    const float tot = R[0] * U[0];
    float w[16];
#pragma unroll
    for (int g = 0; g < 4; ++g) {
        const float b3 = carry * R[g] * (hh == 0 ? Tp[g] : 1.f);
        const float b2 = b3 * kp_[4 * g + 3], b1 = b2 * kp_[4 * g + 2], b0 = b1 * kp_[4 * g + 1];
        w[4 * g + 3] = be[4 * g + 3] * b3; w[4 * g + 2] = be[4 * g + 2] * b2; w[4 * g + 1] = be[4 * g + 1] * b1; w[4 * g + 0] = be[4 * g + 0] * b0;
    }
    carry *= tot;
    bf16x8 pf[2];
#pragma unroll
    for (int s = 0; s < 2; ++s) { u32x4 pw; pw.x = pk2(w[8 * s], w[8 * s + 1]); pw.y = pk2(w[8 * s + 2], w[8 * s + 3]); pw.z = pk2(w[8 * s + 4], w[8 * s + 5]); pw.w = pk2(w[8 * s + 6], w[8 * s + 7]); pf[s] = __builtin_bit_cast(bf16x8, pw); }
    pv_block(o, vl, pf, lane);
}
__device__ __forceinline__ void cb_block(const f32x16& S, bool cbias, LAS unsigned char* vl, const LAS float* bl, int tq, int keypos0, int nvalid, float& m, float& l, f32x16 (&o)[2], int lane) {
    const int hh = lane >> 5;
    float s[16]; float bm = -INFINITY;
    if (cbias) {
        const float cb = bl[256];
#pragma unroll
        for (int r = 0; r < 16; ++r) { s[r] = S[r] + cb; bm = fmaxf(bm, s[r]); }
    } else {
#pragma unroll
        for (int r = 0; r < 16; ++r) {
            const int kr = (r & 3) + 8 * (r >> 2) + 4 * hh; int d = tq - (keypos0 + kr); d = d < -128 ? -128 : (d > 128 ? 128 : d);
            s[r] = (kr < nvalid) ? S[r] + bl[d + 128] : -INFINITY; bm = fmaxf(bm, s[r]);
        }
    }
    bm = fmaxf(bm, partner32(bm));
    if (__any(bm > m + 8.f)) {
        const float mn = fmaxf(m, bm), f = __builtin_amdgcn_exp2f(m - mn); m = mn; l *= f;
#pragma unroll
        for (int db = 0; db < 2; ++db)
#pragma unroll
            for (int r = 0; r < 16; ++r) o[db][r] *= f;
    }
    float w[16], ls = 0.f;
#pragma unroll
    for (int r = 0; r < 16; ++r) { w[r] = __builtin_amdgcn_exp2f(s[r] - m); ls += w[r]; }
    l += ls;
    bf16x8 pf[2];
#pragma unroll
    for (int s2 = 0; s2 < 2; ++s2) { u32x4 pw; pw.x = pk2(w[8 * s2], w[8 * s2 + 1]); pw.y = pk2(w[8 * s2 + 2], w[8 * s2 + 3]); pw.z = pk2(w[8 * s2 + 4], w[8 * s2 + 5]); pw.w = pk2(w[8 * s2 + 6], w[8 * s2 + 7]); pf[s2] = __builtin_bit_cast(bf16x8, pw); }
    pv_block(o, vl, pf, lane);
}
__device__ __forceinline__ void attn_store(f32x16 (&o)[2], float scale, const float* gain, bf16_t* mix, size_t row0, int col0, int nrows, LAS unsigned char* wl, int lane) {
    const int r = lane & 31, hh = lane >> 5;
    f32x4 gvs[2][4];
#pragma unroll
    for (int db = 0; db < 2; ++db)
#pragma unroll
        for (int g = 0; g < 4; ++g) gvs[db][g] = *(const f32x4*)(gain + 32 * db + 8 * g + 4 * hh);
    float ssq = 0.f;
#pragma unroll
    for (int db = 0; db < 2; ++db)
#pragma unroll
        for (int i = 0; i < 16; ++i) { o[db][i] *= scale; ssq += o[db][i] * o[db][i]; }
    ssq += partner32(ssq);
    const float rstd = rsqrtf(ssq * (1.0f / 64.0f) + EPS);
    LAS unsigned char* st = wl + AW_ST;
#pragma unroll
    for (int db = 0; db < 2; ++db)
#pragma unroll
        for (int g = 0; g < 4; ++g) { const int d0 = 32 * db + 8 * g + 4 * hh; const f32x4 gv = gvs[db][g];
            u32x2 w; w.x = pk2(o[db][4 * g] * rstd * gv[0], o[db][4 * g + 1] * rstd * gv[1]); w.y = pk2(o[db][4 * g + 2] * rstd * gv[2], o[db][4 * g + 3] * rstd * gv[3]);
            *(LAS u32x2*)(st + r * ST_PITCH + d0 * 2) = w; }
#pragma unroll
    for (int i = 0; i < 4; ++i) { const int row = 8 * i + (lane >> 3), ch = lane & 7; const u32x4 v = *(const LAS u32x4*)(st + row * ST_PITCH + ch * 16);
        if (row < nrows) *(u32x4*)(mix + (row0 + row) * DM + col0 + ch * 8) = v; }
}

template <bool F32> __device__ __forceinline__ void sb_loop(const void* kbase, const void* vbase, size_t rowbase, int jhi, int h, const bf16x8 (&qf)[4], int tq, float& carry, f32x16 (&o)[2], LAS unsigned char* wl, int lane) {
    const int r = lane & 31, hh = lane >> 5;
    bf16x8 kA[4], kB[4]; u32x4 vA[4], vB[4];
#define SB_LD(KF, VN, jj) do { ld_k<F32>(KF, kbase, (rowbase + 32 * (jj) + r) * HW + h * 64 + 32 * hh); ld_v<F32>(VN, vbase, rowbase + 32 * (jj), 32, h, lane); } while (0)
    SB_LD(kA, vA, jhi); if (jhi >= 1) SB_LD(kB, vB, jhi - 1);
    for (int j = jhi; j >= 0; j -= 2) {
        { const f32x16 S = qk_block(kA, qf); st_v(wl + AW_V, vA, lane); if (j >= 2) SB_LD(kA, vA, j - 2);
          sb_block(S, wl + AW_V, tq, 32 * j, carry, o, lane); }
#if SB_EARLY
        if (__all(carry < SB_THR)) break;
#endif
        if (j < 1) break;
        { const f32x16 S = qk_block(kB, qf); st_v(wl + AW_V, vB, lane); if (j >= 3) SB_LD(kB, vB, j - 3);
          sb_block(S, wl + AW_V, tq, 32 * (j - 1), carry, o, lane); }
#if SB_EARLY
        if (__all(carry < SB_THR)) break;
#endif
    }
#undef SB_LD
}
template <bool SAMPLE> __device__ __forceinline__ void sb_unit(const AttnArgs& A, int b, int h, int qb, LAS unsigned char* wl, int lane) {
    const int r = lane & 31, hh = lane >> 5;
    const bf16_t* Qa = QKV_; const bf16_t* Ka = Qa + (size_t)1 * MT * HW; const bf16_t* Va = Qa + (size_t)2 * MT * HW;
    int tq; size_t qrow;
    if (SAMPLE) { tq = PAST + (r & 15); qrow = (size_t)MP + b * DSEQ + (r & 15); } else { tq = 32 * qb + r; qrow = (size_t)b * SEQ + tq; }
    bf16x8 qf[4]; ld_k<false>(qf, Qa, qrow * HW + h * 64 + 32 * hh);
    float carry = 1.f; f32x16 o[2]; o[0] = f32x16{}; o[1] = f32x16{};
    if (SAMPLE) {
        bf16x8 kf[4]; u32x4 vr[4]; const size_t row0 = (size_t)MP + b * DSEQ;
        ld_k<false>(kf, Ka, (row0 + (r & 15)) * HW + h * 64 + 32 * hh); ld_v<false>(vr, Va, row0, DSEQ, h, lane); st_v(wl + AW_V, vr, lane);
        { const f32x16 S = qk_block(kf, qf); sb_block(S, wl + AW_V, tq, PAST, carry, o, lane); }
        sb_loop<true>(ARG(4) + (size_t)A.L * NBATCH * PAST * HW, ARG(5) + (size_t)A.L * NBATCH * PAST * HW, (size_t)b * PAST, PAST / 32 - 1, h, qf, tq, carry, o, wl, lane);
        attn_store(o, 1.f, ARG(11) + A.L * HW + h * 64, MIX_, row0, h * 64, DSEQ, wl, lane);
    } else {
        sb_loop<false>(Ka, Va, (size_t)b * SEQ, qb, h, qf, tq, carry, o, wl, lane);
        attn_store(o, 1.f, ARG(11) + A.L * HW + h * 64, MIX_, (size_t)b * SEQ + 32 * qb, h * 64, 32, wl, lane);
    }
}
template <bool F32> __device__ __forceinline__ void cb_loop(const void* kbase, const void* vbase, size_t rowbase, int jlo, int jhi, int pos0, int h, const bf16x8 (&qf)[4], int tq, float& m, float& l, f32x16 (&o)[2], LAS unsigned char* wl, int lane) {
    const int r = lane & 31, hh = lane >> 5;
    bf16x8 kA[4], kB[4]; u32x4 vA[4], vB[4];
    const int tqmin = tq - r;
#define CB_LD(KF, VN, jj) do { ld_k<F32>(KF, kbase, (rowbase + 32 * (jj) + r) * HW + h * 64 + 32 * hh); ld_v<F32>(VN, vbase, rowbase + 32 * (jj), 32, h, lane); } while (0)
    CB_LD(kA, vA, jlo); if (jlo + 1 <= jhi) CB_LD(kB, vB, jlo + 1);
    for (int j = jlo; j <= jhi; j += 2) {
        { const f32x16 S = qk_block(kA, qf); st_v(wl + AW_V, vA, lane); if (j + 2 <= jhi) CB_LD(kA, vA, j + 2);
          const bool cbias = __builtin_amdgcn_readfirstlane(pos0 + 32 * j + 31 + 128 <= tqmin);
          cb_block(S, cbias, wl + AW_V, (const LAS float*)(wl + AW_BIAS), tq, pos0 + 32 * j, 32, m, l, o, lane); }
        if (j + 1 > jhi) break;
        { const f32x16 S = qk_block(kB, qf); st_v(wl + AW_V, vB, lane); if (j + 3 <= jhi) CB_LD(kB, vB, j + 3);
          const bool cbias = __builtin_amdgcn_readfirstlane(pos0 + 32 * (j + 1) + 31 + 128 <= tqmin);
          cb_block(S, cbias, wl + AW_V, (const LAS float*)(wl + AW_BIAS), tq, pos0 + 32 * (j + 1), 32, m, l, o, lane); }
    }
#undef CB_LD
}
template <bool SAMPLE> __device__ __forceinline__ void cb_unit(const AttnArgs& A, int b, int h, int qb, LAS unsigned char* wl, int lane) {
    const int r = lane & 31, hh = lane >> 5;
    const bf16_t* Qb = QKV_ + (size_t)3 * MT * HW; const bf16_t* Kb = Qb + (size_t)1 * MT * HW; const bf16_t* Vb = Qb + (size_t)2 * MT * HW;
    LAS float* bl = (LAS float*)(wl + AW_BIAS);
    { const float* relp = ARG(10) + (size_t)A.L * 257 * 8 + h; float bv[5];
#pragma unroll
      for (int i = 0; i < 5; ++i) { const int idx = lane + 64 * i; bv[i] = relp[(idx < 257 ? idx : 256) * 8]; }
#pragma unroll
      for (int i = 0; i < 5; ++i) { const int idx = lane + 64 * i; if (idx < 257) bl[idx] = bv[i] * LOG2E; } }
    int tq; size_t qrow;
    if (SAMPLE) { tq = PAST + (r & 15); qrow = (size_t)MP + b * DSEQ + (r & 15); } else { tq = 32 * qb + r; qrow = (size_t)b * SEQ + tq; }
    bf16x8 qf[4]; ld_k<false>(qf, Qb, qrow * HW + h * 64 + 32 * hh);
    float m = -INFINITY, l = 0.f; f32x16 o[2]; o[0] = f32x16{}; o[1] = f32x16{};
    if (SAMPLE) {
        cb_loop<true>(ARG(6) + (size_t)A.L * NBATCH * BANDL * HW, ARG(7) + (size_t)A.L * NBATCH * BANDL * HW, (size_t)b * BANDL, 0, BANDL / 32 - 1, PAST - BANDL, h, qf, tq, m, l, o, wl, lane);
        bf16x8 kf[4]; u32x4 vr[4]; const size_t row0 = (size_t)MP + b * DSEQ;
        ld_k<false>(kf, Kb, (row0 + (r & 15)) * HW + h * 64 + 32 * hh); ld_v<false>(vr, Vb, row0, DSEQ, h, lane); st_v(wl + AW_V, vr, lane);
        { const f32x16 S = qk_block(kf, qf); cb_block(S, false, wl + AW_V, bl, tq, PAST, DSEQ, m, l, o, lane); }
        l += partner32(l);
        attn_store(o, 1.0f / l, ARG(12) + A.L * HW + h * 64, MIX_, row0, HW + h * 64, DSEQ, wl, lane);
    } else {
        const int c = qb >> 1, clo = c - 8 < 0 ? 0 : c - 8;
        cb_loop<false>(Kb, Vb, (size_t)b * SEQ, 2 * clo, 2 * c + 1, 0, h, qf, tq, m, l, o, wl, lane);
        l += partner32(l);
        attn_store(o, 1.0f / l, ARG(12) + A.L * HW + h * 64, MIX_, (size_t)b * SEQ + 32 * qb, HW + h * 64, 32, wl, lane);
    }
}
__device__ __forceinline__ void cb_unit_p64(const AttnArgs& A, int b, int h, int c, LAS unsigned char* wl, int lane) {
    const int r = lane & 31, hh = lane >> 5;
    const bf16_t* Qb = QKV_ + (size_t)3 * MT * HW; const bf16_t* Kb = Qb + (size_t)1 * MT * HW; const bf16_t* Vb = Qb + (size_t)2 * MT * HW;
    LAS float* bl = (LAS float*)(wl + AW_BIAS);
    { const float* relp = ARG(10) + (size_t)A.L * 257 * 8 + h; float bv[5];
#pragma unroll
      for (int i = 0; i < 5; ++i) { const int idx = lane + 64 * i; bv[i] = relp[(idx < 257 ? idx : 256) * 8]; }
#pragma unroll
      for (int i = 0; i < 5; ++i) { const int idx = lane + 64 * i; if (idx < 257) bl[idx] = bv[i] * LOG2E; } }
    const int tq0 = 64 * c + r, tq1 = tq0 + 32; const size_t rowbase = (size_t)b * SEQ;
    bf16x8 qf0[4], qf1[4];
    ld_k<false>(qf0, Qb, (rowbase + tq0) * HW + h * 64 + 32 * hh); ld_k<false>(qf1, Qb, (rowbase + tq1) * HW + h * 64 + 32 * hh);
    float m0 = -INFINITY, l0 = 0.f, m1 = -INFINITY, l1 = 0.f;
    f32x16 o0[2], o1[2]; o0[0] = f32x16{}; o0[1] = f32x16{}; o1[0] = f32x16{}; o1[1] = f32x16{};
    const int clo = c - 8 < 0 ? 0 : c - 8, jlo = 2 * clo, jhi = 2 * c + 1;
    bf16x8 kf[4]; u32x4 vn[4];
    ld_k<false>(kf, Kb, (rowbase + 32 * jlo + r) * HW + h * 64 + 32 * hh); ld_v<false>(vn, Vb, rowbase + 32 * jlo, 32, h, lane);
    for (int j = jlo; j <= jhi; ++j) {
        const f32x16 S0 = qk_block(kf, qf0), S1 = qk_block(kf, qf1);
        st_v(wl + AW_V, vn, lane);
        if (j < jhi) { ld_k<false>(kf, Kb, (rowbase + 32 * (j + 1) + r) * HW + h * 64 + 32 * hh); ld_v<false>(vn, Vb, rowbase + 32 * (j + 1), 32, h, lane); }
        const bool cbias = (32 * j + 31 + 128 <= 64 * c);
        cb_block(S0, cbias, wl + AW_V, bl, tq0, 32 * j, 32, m0, l0, o0, lane);
        cb_block(S1, cbias, wl + AW_V, bl, tq1, 32 * j, 32, m1, l1, o1, lane);
    }
    l0 += partner32(l0); l1 += partner32(l1);
    attn_store(o0, 1.0f / l0, ARG(12) + A.L * HW + h * 64, MIX_, rowbase + 64 * c, HW + h * 64, 32, wl, lane);
    attn_store(o1, 1.0f / l1, ARG(12) + A.L * HW + h * 64, MIX_, rowbase + 64 * c + 32, HW + h * 64, 32, wl, lane);
}
constexpr int AU_ITEMS = 2048;
__device__ __forceinline__ void attn_phase(const AttnArgs& A, LAS unsigned char* lds) {
    const int tid_ = fresh_tid(), lane = tid_ & 63, wave = __builtin_amdgcn_readfirstlane(tid_ >> 6);
    LAS unsigned char* wl = lds + wave * AW_BYTES;
#pragma unroll 1
    for (int cu = (int)blockIdx.x * NWAVES + wave; cu < AU_ITEMS; cu += (int)gridDim.x * NWAVES) {
        const int bh = cu >> 5, p = cu & 31;
        cb_unit_p64(A, bh >> 3, bh & 7, 31 - p, wl, lane);
#pragma unroll 1
        for (int t = 0; t < 2; ++t) sb_unit<false>(A, bh >> 3, bh & 7, 63 - 2 * p - t, wl, lane);
        if (p >= 24) { const int li = bh * 8 + (p - 24);
            if (li < 64) sb_unit<true>(A, li >> 3, li & 7, 0, wl, lane);
            else if (li < 128) cb_unit<true>(A, (li - 64) >> 3, (li - 64) & 7, 0, wl, lane); }
    }
}
typedef unsigned gu32_plain;
#define XB_TMO      128
#define XB_XCNT(j)  (256  + 64 * (j))
#define XB_XSUB(j)  (1280 + 64 * (j))
#define XB_XGEN(j)  (2304 + 64 * (j))
#define XB_TOP      3328
#define XB_TOPGEN   3392
#define XCD_BAR_WORDS 3456
#define XB_SPIN_CAP (1u << 18)

__device__ __forceinline__ unsigned xb_ld(unsigned* p)              { return __hip_atomic_load(p, __ATOMIC_RELAXED, __HIP_MEMORY_SCOPE_AGENT); }
__device__ __forceinline__ unsigned xb_add(unsigned* p, unsigned v) { return __hip_atomic_fetch_add(p, v, __ATOMIC_RELAXED, __HIP_MEMORY_SCOPE_AGENT); }
__device__ __forceinline__ unsigned xb_xcc_id() { return (unsigned)__builtin_amdgcn_s_getreg((3 << 11) | 20) & 0xFu; }
#define XB_SPIN(cond, bar) do { unsigned _sp = 0; while (cond) { __builtin_amdgcn_s_sleep(1); \
    if ((++_sp & 255u) == 0u) { if (xb_ld(&(bar)[XB_TMO])) break; if (_sp > XB_SPIN_CAP) { atomicAdd(&(bar)[XB_TMO], 1u); break; } } } } while (0)

struct XcdBarrier {
    unsigned* bar; unsigned x;
    volatile LAS unsigned* st;
};

__device__ __forceinline__ XcdBarrier xcd_barrier_post(unsigned* bar, volatile LAS unsigned* st) {
    XcdBarrier b; b.bar = bar; b.x = xb_xcc_id(); b.st = st;
    if (threadIdx.x == 0) (void)xb_add(&bar[XB_XCNT(b.x)], 1u);
    return b;
}
__device__ __forceinline__ void xcd_barrier_complete(unsigned* bar, unsigned x, unsigned& nloc, unsigned& nx) {
    const unsigned G = gridDim.x * gridDim.y * gridDim.z;
    unsigned sum, cnt, mine, sp = 0u;
    for (;;) {
        sum = 0u; cnt = 0u; mine = 0u;
#pragma unroll
        for (unsigned j = 0; j < 16; ++j) { const unsigned c = xb_ld(&bar[XB_XCNT(j)]); sum += c; cnt += (c > 0u) ? 1u : 0u; mine = (j == x) ? c : mine; }
        if (sum == G) break;
        __builtin_amdgcn_s_sleep(1);
        if ((++sp & 255u) == 0u) { if (xb_ld(&bar[XB_TMO])) break; if (sp > XB_SPIN_CAP) { atomicAdd(&bar[XB_TMO], 1u); break; } }
    }
    nloc = mine > 0u ? mine : 1u; nx = cnt > 0u ? cnt : 1u;
}

__device__ __forceinline__ void xcd_barrier(const XcdBarrier& b) {
    asm volatile("s_waitcnt vmcnt(0)" ::: "memory");
    __syncthreads();
    if (threadIdx.x == 0) {
        unsigned* bar = b.bar;
        __builtin_amdgcn_s_waitcnt(0);
        unsigned nloc = b.st[0], nx = b.st[1];
        if (nloc == 0u) { xcd_barrier_complete(bar, b.x, nloc, nx); b.st[0] = nloc; b.st[1] = nx; }
        const unsigned old = xb_add(&bar[XB_XSUB(b.x)], 1u);
        const unsigned gen = old / nloc;
        if (old + 1u == (gen + 1u) * nloc) {
            __builtin_amdgcn_fence(__ATOMIC_RELEASE, "agent");
            asm volatile("s_waitcnt vmcnt(0)" ::: "memory");
            const unsigned og = xb_add(&bar[XB_TOP], 1u);
            const unsigned tg = og / nx;
            if (og + 1u == (tg + 1u) * nx) xb_add(&bar[XB_TOPGEN], 1u);
            else XB_SPIN(xb_ld(&bar[XB_TOPGEN]) == tg, bar);
            __builtin_amdgcn_fence(__ATOMIC_ACQUIRE, "agent");
            xb_add(&bar[XB_XGEN(b.x)], 1u);
            asm volatile("s_waitcnt vmcnt(0)" ::: "memory");
        } else {
            XB_SPIN(xb_ld(&bar[XB_XGEN(b.x)]) == gen, bar);
            __builtin_amdgcn_fence(__ATOMIC_ACQUIRE, "agent");
            asm volatile("s_waitcnt vmcnt(0)" ::: "memory");
        }
    }
    __syncthreads();
}

constexpr int CI_IN = 16 * 96, CI_OUT = 16 * 32, CI_G = 16 * 88, CI_D = 44 * 32, CI_PG = 16 * 32, CI_PP = 4 * 32, CI_L = CI_IN + CI_OUT + 2 * CI_G + CI_D + CI_PG + CI_PP;
struct ConvD { const float* W; const float* gain; bf16_t* WT; int K, N, kind, k0, n0; };
__device__ __forceinline__ ConvD conv_decode(int it) {
    const int L = it / CI_L; int r = it % CI_L; ConvD d;
    if (r < CI_IN) { d.W = ARG(9) + (size_t)L * DM * NQKV; d.gain = ARG(8) + L * DM; d.WT = (bf16_t*)WPTR(L, W_IN); d.K = DM; d.N = NQKV; d.kind = 0; }
    else if ((r -= CI_IN) < CI_OUT) { d.W = ARG(13) + (size_t)L * DM * DM; d.gain = nullptr; d.WT = (bf16_t*)WPTR(L, W_OUT); d.K = DM; d.N = DM; d.kind = 0; }
    else if ((r -= CI_OUT) < CI_G) { d.W = ARG(15) + (size_t)L * DM * DFF; d.gain = ARG(14) + L * DM; d.WT = (bf16_t*)WPTR(L, W_GU); d.K = DM; d.N = DFF; d.kind = 1; }
    else if ((r -= CI_G) < CI_G) { d.W = ARG(16) + (size_t)L * DM * DFF; d.gain = ARG(14) + L * DM; d.WT = (bf16_t*)WPTR(L, W_GU); d.K = DM; d.N = DFF; d.kind = 2; }
    else if ((r -= CI_G) < CI_D) { d.W = ARG(17) + (size_t)L * DFF * DM; d.gain = nullptr; d.WT = (bf16_t*)WPTR(L, W_DOWN); d.K = DFF; d.N = DM; d.kind = 0; }
    else if ((r -= CI_D) < CI_PG) { d.W = ARG(19) + (size_t)L * DM * DM; d.gain = ARG(18) + L * DM; d.WT = (bf16_t*)WPTR(L, W_PG); d.K = DM; d.N = DM; d.kind = 0; }
    else { r -= CI_PG; d.W = ARG(20) + (size_t)L * PLED * DM; d.gain = nullptr; d.WT = (bf16_t*)WPTR(L, W_PP); d.K = PLED; d.N = DM; d.kind = 0; }
    const int nblk = d.N / 32; d.k0 = 64 * (r / nblk); d.n0 = 32 * (r % nblk);
    return d;
}
__device__ __forceinline__ void conv_load(const ConvD& d, float (&v)[32], f32x4 (&g)[2], int lane) {
    const float* p = d.W + (size_t)(d.k0 + (lane >> 5)) * d.N + d.n0 + (lane & 31);
#pragma unroll
    for (int i = 0; i < 32; ++i) v[i] = p[(size_t)(2 * i) * d.N];
    if (d.gain) { g[0] = *(const f32x4*)(d.gain + d.k0 + 8 * (lane & 7)); g[1] = *(const f32x4*)(d.gain + d.k0 + 8 * (lane & 7) + 4); }
    else { g[0] = (f32x4){1.f, 1.f, 1.f, 1.f}; g[1] = g[0]; }
}
__device__ __forceinline__ void conv_proc(const ConvD& d, const float (&v)[32], const f32x4 (&g)[2], LAS float* scr, int lane) {
#pragma unroll
    for (int i = 0; i < 32; ++i) scr[(2 * i + (lane >> 5)) * 33 + (lane & 31)] = v[i];
    asm volatile("s_waitcnt lgkmcnt(0)" ::: "memory");
    const int c = lane & 7;
#pragma unroll
    for (int j = 0; j < 4; ++j) { const int n = (lane >> 3) + 8 * j; const LAS float* s = scr + (8 * c) * 33 + n;
        u32x4 o; o.x = pk2(s[0 * 33] * g[0][0], s[1 * 33] * g[0][1]); o.y = pk2(s[2 * 33] * g[0][2], s[3 * 33] * g[0][3]);
        o.z = pk2(s[4 * 33] * g[1][0], s[5 * 33] * g[1][1]); o.w = pk2(s[6 * 33] * g[1][2], s[7 * 33] * g[1][3]);
        const int gn = d.n0 + n; const int drow = d.kind == 0 ? gn : ((gn >> 7) * 256 + (gn & 127) + (d.kind == 2 ? 128 : 0));
        *(u32x4*)(d.WT + (size_t)drow * d.K + d.k0 + 8 * c) = o; }
    asm volatile("s_waitcnt lgkmcnt(0)" ::: "memory");
}

#ifdef NO_SGEMM
#define SG(...)
#else
#define SG(...) __VA_ARGS__
#endif
#ifndef GP1
#define GP1(...) __VA_ARGS__
#endif
#ifndef GP2
#define GP2(...) __VA_ARGS__
#endif
#ifndef GP3
#define GP3(...) __VA_ARGS__
#endif
#ifndef GP4
#define GP4(...) __VA_ARGS__
#endif
#ifndef GP5
#define GP5(...) __VA_ARGS__
#endif
#ifndef GP6
#define GP6(...) __VA_ARGS__
#endif
#ifdef NO_SGEMM
#define SG(...)
#else
#define SG(...) __VA_ARGS__
#endif
#ifndef GP1
#define GP1(...) __VA_ARGS__
#endif
#ifndef GP2
#define GP2(...) __VA_ARGS__
#endif
#ifndef GP3
#define GP3(...) __VA_ARGS__
#endif
#ifndef GP4
#define GP4(...) __VA_ARGS__
#endif
#ifndef GP5
#define GP5(...) __VA_ARGS__
#endif
#ifndef GP6
#define GP6(...) __VA_ARGS__
#endif
struct Args { const float* in[22]; float* out; unsigned char* ws; };

#ifndef PROBE_SEL
#define PROBE_SEL -1
#endif
#if PROBE_SEL >= 0
#define TSTAMP(cat) do { if (blockIdx.x == 0 && fresh_tid() == 0) { const unsigned long long t_ = __builtin_amdgcn_s_memrealtime(); unsigned long long* tsb = WS_PTR(unsigned long long, WS_CTL + 4096); \
    tsb[16 + (cat)] += t_ - tsb[0]; tsb[0] = t_; } } while (0)
#else
#define TSTAMP(cat) do {} while (0)
#endif
__global__ void __launch_bounds__(NTHREADS, 2) hymba_fwd(Args args) {
    extern __shared__ __attribute__((aligned(16))) unsigned char lds_raw[];
    cg::grid_group grid = cg::this_grid();
    LAS unsigned char* lds = (LAS unsigned char*)lds_raw;
    const int G = gridDim.x;

    { const int tid0 = fresh_tid();
      if (blockIdx.x == 0) for (int i = tid0; i < XCD_BAR_WORDS; i += NTHREADS) WS_PTR(unsigned, WS_BAR)[i] = 0u;
      if (tid0 < 2) ((LAS unsigned*)(lds + 131072))[tid0] = 0u; }
    grid.sync();
    (void)xcd_barrier_post(WS_PTR(unsigned, WS_BAR), (volatile LAS unsigned*)(lds + 131072));
#define GSYNC() do { XcdBarrier xb_; xb_.bar = WS_PTR(unsigned, WS_BAR); xb_.x = xb_xcc_id(); xb_.st = (volatile LAS unsigned*)(lds + 131072); xcd_barrier(xb_); } while (0)
#if PROBE_SEL >= 0
    if (blockIdx.x == 0 && fresh_tid() == 0) { unsigned long long* tsb = WS_PTR(unsigned long long, WS_CTL + 4096); for (int i = 0; i < 48; ++i) tsb[i] = 0; tsb[0] = __builtin_amdgcn_s_memrealtime(); }
#endif
    {
        const int tid = fresh_tid(), lane = tid & 63, wave = __builtin_amdgcn_readfirstlane(tid >> 6);
        const int gw = blockIdx.x * NWAVES + wave, NGW = G * NWAVES;
        { float* ssb = SSB; for (int i = blockIdx.x * NTHREADS + tid; i < 6 * MT; i += G * NTHREADS) ssb[MT + i] = 0.f;
          if (blockIdx.x == 0 && tid < 16) WS_PTR(unsigned, WS_CTL)[tid] = 0u;
          }
        LAS float* scr = (LAS float*)(lds + wave * 8704);
        { constexpr int NIT = NLAYER * CI_L; int it = gw;
          float vA[32], vB[32]; f32x4 gA[2], gB[2]; ConvD dA, dB;
          if (it < NIT) { dA = conv_decode(it); conv_load(dA, vA, gA, lane); }
          while (it < NIT) {
            const int itn = it + NGW;
            if (itn < NIT) { dB = conv_decode(itn); conv_load(dB, vB, gB, lane); }
            conv_proc(dA, vA, gA, scr, lane);
            if (itn >= NIT) break;
            it = itn + NGW;
            if (it < NIT) { dA = conv_decode(it); conv_load(dA, vA, gA, lane); }
            conv_proc(dB, vB, gB, scr, lane);
          } }
        { const float* pp = ARG(2); const float* ps = ARG(3); bf16_t* PB = PB_;
          for (int it0 = 4 * gw; it0 < NLAYER * MT; it0 += 4 * NGW) {
            f32x4 v[4];
#pragma unroll
            for (int rr = 0; rr < 4; ++rr) { const int it = it0 + rr, L = it / MT, row = it % MT;
                const float* src = row < MP ? pp + ((size_t)L * MP + row) * PLED : ps + ((size_t)L * MS + (row - MP)) * PLED;
                v[rr] = *((const f32x4*)src + lane); }
#pragma unroll
            for (int rr = 0; rr < 4; ++rr) { u32x2 w; w.x = pk2(v[rr][0], v[rr][1]); w.y = pk2(v[rr][2], v[rr][3]); *((u32x2*)(PB + (size_t)(it0 + rr) * PLED) + lane) = w; }
          } }
        { const float* x_p = ARG(0); const float* x_s = ARG(1); bf16_t* XB = XN_; float* ssb = SSB;
          for (int row0 = 2 * gw; row0 < MT; row0 += 2 * NGW) {
            f32x4 v[2][4];
#pragma unroll
            for (int rr = 0; rr < 2; ++rr) { const int row = row0 + rr; const float* src = row < MP ? x_p + (size_t)row * DM : x_s + (size_t)(row - MP) * DM;
#pragma unroll
                for (int j = 0; j < 4; ++j) v[rr][j] = *((const f32x4*)src + lane + 64 * j); }
#pragma unroll
            for (int rr = 0; rr < 2; ++rr) { float s2 = 0.f;
#pragma unroll
                for (int j = 0; j < 4; ++j) { const f32x4 t = v[rr][j]; s2 += (t[0] * t[0] + t[1] * t[1]) + (t[2] * t[2] + t[3] * t[3]);
                    u32x2 w; w.x = pk2(t[0], t[1]); w.y = pk2(t[2], t[3]); *((u32x2*)(XB + (size_t)(row0 + rr) * DM) + lane + 64 * j) = w; }
                s2 = wave_sum(s2);
                if (lane == 0) ssb[row0 + rr] = s2; }
          } }
    }
    TSTAMP(0); GSYNC(); TSTAMP(8);

    for (int L = 0; L < NLAYER; ++L) {
#define SS_MIX (SSB + (size_t)(3 * L) * MT)
#define SS_FFN (SSB + (size_t)(3 * L + 1) * MT)
#define SS_PLE (SSB + (size_t)(3 * L + 2) * MT)
#define SS_NEXT (SSB + (size_t)(3 * L + 3) * MT)
        { EpiArgs q{}; q.ss_in = SS_MIX; q.o0 = QKV_;
          q.f_sbk = ARG_OUT + O_SBK_P + (size_t)L * MP * HW; q.f_sbv = ARG_OUT + O_SBV_P + (size_t)L * MP * HW;
          q.f_cbk = ARG_OUT + O_CBK_P + (size_t)L * NBATCH * BANDL * HW; q.f_cbv = ARG_OUT + O_CBV_P + (size_t)L * NBATCH * BANDL * HW;
          pg8::Gemm g{XN_, WPTR(L, W_IN), MP, NQKV, DM}; pg8::StaticOrder S; S.init(MP, NQKV, G, (int)blockIdx.x);
          Epi<EP_QKV> E{q};
          GP1(pg8::gemm_phase<Epi<EP_QKV>, pg8::StaticOrder, true, true>(lds, g, S, E);) TSTAMP(1); }
        { EpiArgs q{}; q.ss_in = SS_MIX; q.o0 = QKV_;
          q.s_sbk = ARG_OUT + O_SBK_S + (size_t)L * MS * HW; q.s_sbv = ARG_OUT + O_SBV_S + (size_t)L * MS * HW;
          q.s_cbk = ARG_OUT + O_CBK_S + (size_t)L * MS * HW; q.s_cbv = ARG_OUT + O_CBV_S + (size_t)L * MS * HW;
          SG(sgemm<EP_QKV, DM>(lds, XN_ + (size_t)MP * DM, WPTR(L, W_IN), NQKV / 32, q);) TSTAMP(7); }
        GSYNC(); TSTAMP(8);
        { AttnArgs A{}; A.L = L;
#ifndef NO_ATTN
          attn_phase(A, lds);
#endif
          TSTAMP(2); }
        GSYNC(); TSTAMP(2);
        { EpiArgs q{}; q.XB = XB_; q.xbase = XN_; q.ss_out = SS_FFN;
          pg8::Gemm g{MIX_, WPTR(L, W_OUT), MP, DM, DM}; pg8::StaticOrder S; S.init(MP, DM, G, (int)blockIdx.x);
          Epi<EP_RES> E{q};
          GP2(pg8::gemm_phase<Epi<EP_RES>, pg8::StaticOrder, true, true>(lds, g, S, E);) TSTAMP(3); }
        { EpiArgs q{}; q.XB = XB_; q.xbase = XN_; q.ss_out = SS_FFN;
          SG(sgemm<EP_RES, DM>(lds, MIX_ + (size_t)MP * DM, WPTR(L, W_OUT), DM / 32, q);) TSTAMP(7); }
        GSYNC(); TSTAMP(8);
        { EpiArgs q{}; q.ss_in = SS_FFN; q.o0 = HB_;
          pg8::Gemm g{XB_, WPTR(L, W_GU), MP, 2 * DFF, DM}; pg8::StaticOrder S; S.init(MP, 2 * DFF, G, (int)blockIdx.x);
          Epi<EP_GU> E{q};
          GP4(pg8::gemm_phase<Epi<EP_GU>, pg8::StaticOrder, true, true>(lds, g, S, E);) TSTAMP(4);
          SG(sgemm<EP_GU, DM>(lds, XB_ + (size_t)MP * DM, WPTR(L, W_GU), DFF / 32, q);) TSTAMP(7); }
        { EpiArgs q2{}; q2.o0 = PBUF_;
          int kp = PLED; asm volatile("" : "+s"(kp));
          const int Gh = G >> 1;
          if ((int)blockIdx.x >= Gh) {
            pg8::Gemm g2{PB_ + (size_t)L * MT * PLED, WPTR(L, W_PP), MP, DM, kp}; pg8::StaticOrder S; S.init(MP, DM, G - Gh, (int)blockIdx.x - Gh);
            Epi<EP_P> E2{q2};
            GP3(pg8::gemm_phase<Epi<EP_P>, pg8::StaticOrder, true, true>(lds, g2, S, E2);) TSTAMP(10);
          }
          SG(sgemm<EP_P, PLED>(lds, PB_ + ((size_t)L * MT + MP) * PLED, WPTR(L, W_PP), DM / 32, q2);) TSTAMP(7); }
        GSYNC(); TSTAMP(8);
        { EpiArgs q{}; q.XB = XB_; q.xbase = XB_; q.ss_out = SS_PLE;
          pg8::Gemm g{HB_, WPTR(L, W_DOWN), MP, DM, DFF}; pg8::StaticOrder S; S.init(MP, DM, G, (int)blockIdx.x);
          Epi<EP_RES> E{q};
          GP5(pg8::gemm_phase<Epi<EP_RES>, pg8::StaticOrder, true, true>(lds, g, S, E);) TSTAMP(5);
          SG(sgemm<EP_RES, DFF>(lds, HB_ + (size_t)MP * DFF, WPTR(L, W_DOWN), DM / 32, q);) TSTAMP(7); }
        GSYNC(); TSTAMP(8);
        { EpiArgs q{}; q.XB = XN_  ; q.P = PBUF_; q.xbase = XB_; q.ss_in = SS_PLE; q.ss_out = SS_NEXT;
          pg8::Gemm g{XB_, WPTR(L, W_PG), MP, DM, DM}; pg8::StaticOrder S; S.init(MP, DM, G, (int)blockIdx.x);
          Epi<EP_PLE> E{q};
          GP6(pg8::gemm_phase<Epi<EP_PLE>, pg8::StaticOrder, true, true>(lds, g, S, E);) TSTAMP(6);
          SG(sgemm<EP_PLE, DM>(lds, XB_ + (size_t)MP * DM, WPTR(L, W_PG), DM / 32, q);) TSTAMP(7); }
        GSYNC(); TSTAMP(8);
    }
    {
        const int tid = fresh_tid(), lane = tid & 63, wave = __builtin_amdgcn_readfirstlane(tid >> 6);
        const int gw = blockIdx.x * NWAVES + wave, NGW = G * NWAVES;
        const float* ssf = SSB + (size_t)(3 * NLAYER) * MT; const float* gf = ARG(21); const bf16_t* XN = XN_; float* out = ARG_OUT;
        for (int row0 = 2 * gw; row0 < MT; row0 += 2 * NGW) {
            u32x2 xv[2][4];
#pragma unroll
            for (int rr = 0; rr < 2; ++rr)
#pragma unroll
                for (int j = 0; j < 4; ++j) xv[rr][j] = *((const u32x2*)(XN + (size_t)(row0 + rr) * DM) + lane + 64 * j);
#pragma unroll
            for (int rr = 0; rr < 2; ++rr) { const int row = row0 + rr; const float rs = rstd_of(ssf[row]);
                float* dst = row < MP ? out + O_YP + (size_t)row * DM : out + O_YS + (size_t)(row - MP) * DM;
#pragma unroll
                for (int j = 0; j < 4; ++j) { const f32x4 gv = *((const f32x4*)gf + lane + 64 * j); const u32x2 w = xv[rr][j];
                    const f32x4 v = {bf_lo(w.x), bf_hi(w.x), bf_lo(w.y), bf_hi(w.y)};
                    __builtin_nontemporal_store(v * rs * gv, (f32x4*)dst + lane + 64 * j); } }
        }
    }
#if PROBE_SEL >= 0
    TSTAMP(11); grid.sync();
    if (blockIdx.x == 0 && fresh_tid() == 0) { const unsigned long long* tsb = WS_PTR(unsigned long long, WS_CTL + 4096); float* o = ARG_OUT + O_YS; unsigned long long tv = 0; if (PROBE_SEL == 20) tv = tsb[16+1] + tsb[16+3] + tsb[16+10] + tsb[16+4] + tsb[16+5] + tsb[16+6]; else if (PROBE_SEL == 21) tv = tsb[16+0] + tsb[16+11]; else if (PROBE_SEL < 16) tv = tsb[16 + PROBE_SEL]; o[0] += (float)tv * 2.5e-5f; }
#endif
}

extern "C" void kernel_launch(void* const* d_in, const int* in_sizes, int n_in, void* d_out, int out_size, void* d_ws, size_t ws_size, hipStream_t stream) {
    static int grid = 0;
    if (grid == 0) {
        int dev = 0, cus = 0, per_cu = 0;
        hipGetDevice(&dev);
        hipDeviceGetAttribute(&cus, hipDeviceAttributeMultiprocessorCount, dev);
        hipFuncSetAttribute((const void*)hymba_fwd, hipFuncAttributeMaxDynamicSharedMemorySize, LDS_BYTES);
        hipOccupancyMaxActiveBlocksPerMultiprocessor(&per_cu, (const void*)hymba_fwd, NTHREADS, LDS_BYTES);
        if (per_cu < 1) per_cu = 1;
        grid = cus * per_cu;
        if (n_in != 22 || ws_size < WS_END) { fprintf(stderr, "kernel_launch: unexpected n_in %d / ws_size %zu\n", n_in, ws_size); }
    }
    Args a{};
    for (int i = 0; i < 22; ++i) a.in[i] = (const float*)d_in[i];
    a.out = (float*)d_out; a.ws = (unsigned char*)d_ws;
    void* kargs[] = {&a};
    hipError_t e = hipLaunchCooperativeKernel((const void*)hymba_fwd, dim3(grid), dim3(NTHREADS), kargs, LDS_BYTES, stream);
    if (e != hipSuccess) fprintf(stderr, "cooperative launch failed: %s (grid %d)\n", hipGetErrorString(e), grid);
}
```

```cpp
#include <hip/hip_runtime.h>
#include <hip/hip_cooperative_groups.h>
#include <cstdio>
#include <cstdint>
namespace cg = cooperative_groups;
__device__ __forceinline__ int fresh_tid() { int t = threadIdx.x; asm volatile("" : "+v"(t)); return t; }
namespace pg8 {
#define PG8_LAS __attribute__((address_space(3)))
typedef unsigned short bf16_t;
typedef short bf16x8 __attribute__((ext_vector_type(8)));
typedef float f32x4 __attribute__((ext_vector_type(4)));
typedef unsigned u32x4 __attribute__((ext_vector_type(4)));
constexpr int BM = 256, BK = 64, HALF = 128, HTB = HALF * BK * 2  , STAGE_BYTES = 8 * HTB, NXCD = 8, WGM = 8;

__host__ __device__ __forceinline__ int lds_byte(int r, int c) { const int st = (r >> 4) * 2 + (c >> 5), rr = r & 15, cc = c & 31, ob = rr * 64 + cc * 2; return st * 1024 + (ob ^ (((ob >> 9) & 1) << 5)); }
__host__ __device__ __forceinline__ void stage_rc(int b, int& R, int& C) { const int st = b / 1024, sb = b % 1024, swz = sb ^ (((sb >> 9) & 1) << 5); R = (st >> 1) * 16 + swz / 64; C = (st & 1) * 32 + (swz % 64) / 2; }
__host__ __device__ __forceinline__ int perm32(int rho) { const int n = rho >> 4, i = rho & 15; return 8 * (i >> 2) + 4 * n + (i & 3); }

struct Unit { int pm, pn; };
struct Gemm { const bf16_t* A; const bf16_t* Bt; int M, N, K; };

struct StaticOrder {
    int nM, nN, nwg, G, c;
    __host__ __device__ void init(int M, int N, int G_, int c_) { nM = M / BM; nN = N / BM; nwg = nM * nN; G = G_; c = c_; }
    __host__ __device__ bool next(int i, Unit& u) const {
        const long L = (long)i * G + c; if (L >= nwg) return false;
        int wgid = (int)L; { const int q = nwg / NXCD, r = nwg % NXCD, xcd = wgid % NXCD, off = wgid / NXCD; wgid = (xcd < r ? xcd * (q + 1) : r * (q + 1) + (xcd - r) * q) + off; }
        const int nig = WGM * nN, gid = wgid / nig, fm = gid * WGM, gsz = (nM - fm) < WGM ? (nM - fm) : WGM;
        u.pm = fm + ((wgid % nig) % gsz); u.pn = (wgid % nig) / gsz; return true;
    }
    __device__ __forceinline__ void a_ready(const Unit&) const {}
    __device__ __forceinline__ void done(const Unit&) const {}
};

template <class Epi, class Sched, bool ALIGN_EPI = false, bool SP2 = false>
__device__ __forceinline__ void gemm_phase(PG8_LAS unsigned char* lds, const Gemm g, const Sched& S, const Epi& E) {
    const int tid = fresh_tid(), wid = __builtin_amdgcn_readfirstlane(tid >> 6), lane = tid & 63, wr = wid >> 2, wc = wid & 3, fr = lane & 15, fq = lane >> 4;
    const int K = g.K, nt = K / BK;
    unsigned voffA[2], voffB[2];
#pragma unroll
    for (int i = 0; i < 2; ++i) { int R, C; stage_rc(tid * 16 + i * 8192, R, C); const int Rb = Epi::PERM ? ((R & ~31) + perm32(R & 31)) : R;
        voffA[i] = (unsigned)(R * K + C) * 2u; voffB[i] = (unsigned)(Rb * K + C) * 2u; }
    const size_t kstep = (size_t)(BK * 2);
    const size_t hstep = (size_t)HALF * K * 2;
    const size_t tstep = 2 * hstep;
    const unsigned ldsw = (unsigned)wid * 1024u;
    const int aoff = lds_byte(wr * 64 + fr, fq * 8), boff = lds_byte(wc * 32 + fr, fq * 8);
#define PG8_SA(b, h) (((b) * 2 + (h)) * HTB)
#define PG8_SB(b, h) ((4 + (b) * 2 + (h)) * HTB)
#define PG8_STAGE(bufoff, gbase, voff) do { _Pragma("unroll") for (int _i = 0; _i < 2; ++_i) \
        __builtin_amdgcn_global_load_lds((const unsigned*)((const char*)(gbase) + (voff)[_i]), (PG8_LAS unsigned*)(lds + (bufoff) + ldsw + _i * 8192), 16, 0, 0); } while (0)
#define PG8_LDA(dst, b, h) do { _Pragma("unroll") for (int m = 0; m < 4; ++m) _Pragma("unroll") for (int k = 0; k < 2; ++k) dst[m][k] = *(const PG8_LAS bf16x8*)(lds + PG8_SA(b, h) + aoff + m * 2048 + k * 1024); } while (0)
#define PG8_LDB(dst, b, h) do { _Pragma("unroll") for (int n = 0; n < 2; ++n) _Pragma("unroll") for (int k = 0; k < 2; ++k) dst[n][k] = *(const PG8_LAS bf16x8*)(lds + PG8_SB(b, h) + boff + n * 2048 + k * 1024); } while (0)
#define PG8_MMA(ai, bj, At, Bt) do { __builtin_amdgcn_s_setprio(1); _Pragma("unroll") for (int m = 0; m < 4; ++m) _Pragma("unroll") for (int n = 0; n < 2; ++n) _Pragma("unroll") for (int k = 0; k < 2; ++k) \
        acc[ai][bj][m][n] = __builtin_amdgcn_mfma_f32_16x16x32_bf16(Bt[n][k], At[m][k], acc[ai][bj][m][n], 0, 0, 0); __builtin_amdgcn_s_setprio(0); } while (0)
#define PG8_WAIT_V(n) asm volatile("s_waitcnt vmcnt(" #n ")" ::: "memory")
#define PG8_WAIT_L(n) asm volatile("s_waitcnt lgkmcnt(" #n ")" ::: "memory")
#define PG8_BAR __builtin_amdgcn_s_barrier()
#define PG8_SCHED __builtin_amdgcn_sched_barrier(0)
    Unit cur, nxt; int ui = 0;
    if (!S.next(0, cur)) return;
    f32x4 acc[2][2][4][2];
#pragma unroll
    for (int a = 0; a < 2; ++a)
#pragma unroll
        for (int b = 0; b < 2; ++b)
#pragma unroll
            for (int m = 0; m < 4; ++m)
#pragma unroll
                for (int n = 0; n < 2; ++n) acc[a][b][m][n] = (f32x4){0.f, 0.f, 0.f, 0.f};
    bf16x8 At[4][2], B0[2][2], B1[2][2];
    const char* cA = (const char*)g.A + (size_t)cur.pm * tstep; const char* cB = (const char*)g.Bt + (size_t)cur.pn * tstep;
    S.a_ready(cur);
    if constexpr (SP2) {
        PG8_STAGE(PG8_SB(0, 0), cB, voffB); PG8_STAGE(PG8_SB(0, 1), cB + hstep, voffB); PG8_STAGE(PG8_SA(0, 0), cA, voffA); PG8_STAGE(PG8_SA(0, 1), cA + hstep, voffA);
        if (wr == 1) PG8_BAR;
        PG8_WAIT_V(2); PG8_BAR;
        PG8_STAGE(PG8_SB(1, 0), cB + kstep, voffB); PG8_STAGE(PG8_SA(1, 0), cA + kstep, voffA); PG8_STAGE(PG8_SB(1, 1), cB + hstep + kstep, voffB);
        PG8_WAIT_V(6); PG8_BAR;
    } else {
        PG8_STAGE(PG8_SB(0, 0), cB, voffB); PG8_STAGE(PG8_SA(0, 0), cA, voffA); PG8_STAGE(PG8_SB(0, 1), cB + hstep, voffB); PG8_STAGE(PG8_SA(0, 1), cA + hstep, voffA);
        if (wr == 1) PG8_BAR;
        PG8_WAIT_V(4); PG8_BAR;
        PG8_STAGE(PG8_SB(1, 0), cB + kstep, voffB); PG8_STAGE(PG8_SA(1, 0), cA + kstep, voffA); PG8_STAGE(PG8_SB(1, 1), cB + hstep + kstep, voffB);
        PG8_WAIT_V(6); PG8_BAR;
    }
    for (;;) {
        const bool has_next = S.next(ui + 1, nxt);
        const char* nA = has_next ? (const char*)g.A + (size_t)nxt.pm * tstep : cA; const char* nB = has_next ? (const char*)g.Bt + (size_t)nxt.pn * tstep : cB;
        for (int t = 0; t < nt; t += 2) {
            const bool last = (t == nt - 2);
            const char* a1 = cA + (size_t)(t + 1) * kstep;
            const char* a2 = last ? nA : cA + (size_t)(t + 2) * kstep; const char* b2 = last ? nB : cB + (size_t)(t + 2) * kstep;
            const char* a3 = a2 + kstep; const char* b3 = b2 + kstep;
            if (last && has_next) S.a_ready(nxt);
            if constexpr (SP2) {
            PG8_LDB(B0, 0, 0); PG8_LDB(B1, 0, 1); PG8_SCHED; PG8_LDA(At, 0, 0); PG8_STAGE(PG8_SA(1, 1), a1 + hstep, voffA);
            PG8_WAIT_V(8); PG8_WAIT_L(0); PG8_BAR; PG8_MMA(0, 0, At, B0); PG8_MMA(0, 1, At, B1); PG8_BAR; PG8_SCHED;
            PG8_LDA(At, 0, 1); PG8_STAGE(PG8_SB(0, 0), b2, voffB); PG8_STAGE(PG8_SB(0, 1), b2 + hstep, voffB); PG8_STAGE(PG8_SA(0, 0), a2, voffA);
            PG8_WAIT_V(8); PG8_WAIT_L(0); PG8_BAR; PG8_MMA(1, 0, At, B0); PG8_MMA(1, 1, At, B1); PG8_BAR; PG8_SCHED;
            PG8_LDB(B0, 1, 0); PG8_LDB(B1, 1, 1); PG8_SCHED; PG8_LDA(At, 1, 0); PG8_STAGE(PG8_SA(0, 1), a2 + hstep, voffA);
            PG8_WAIT_V(8); PG8_WAIT_L(0); PG8_BAR; PG8_MMA(0, 0, At, B0); PG8_MMA(0, 1, At, B1); PG8_BAR; PG8_SCHED;
            PG8_LDA(At, 1, 1); PG8_STAGE(PG8_SB(1, 0), b3, voffB); PG8_STAGE(PG8_SB(1, 1), b3 + hstep, voffB); PG8_STAGE(PG8_SA(1, 0), a3, voffA);
            PG8_WAIT_V(8); PG8_WAIT_L(0); PG8_BAR; PG8_MMA(1, 0, At, B0); PG8_MMA(1, 1, At, B1); PG8_BAR; PG8_SCHED;
            } else {
            PG8_LDB(B0, 0, 0); PG8_SCHED; PG8_LDA(At, 0, 0); PG8_STAGE(PG8_SA(1, 1), a1 + hstep, voffA);
            PG8_WAIT_L(8); PG8_BAR; PG8_WAIT_L(0); PG8_MMA(0, 0, At, B0); PG8_BAR; PG8_SCHED;
            PG8_LDB(B1, 0, 1); PG8_STAGE(PG8_SB(0, 0), b2, voffB);
            PG8_BAR; PG8_WAIT_L(0); PG8_MMA(0, 1, At, B1); PG8_BAR;
            PG8_LDA(At, 0, 1); PG8_STAGE(PG8_SA(0, 0), a2, voffA);
            PG8_BAR; PG8_WAIT_L(0); PG8_MMA(1, 0, At, B0); PG8_BAR; PG8_SCHED;
            PG8_STAGE(PG8_SB(0, 1), b2 + hstep, voffB);
            PG8_WAIT_V(6); PG8_BAR; PG8_MMA(1, 1, At, B1); PG8_BAR;
            PG8_LDB(B0, 1, 0); PG8_SCHED; PG8_LDA(At, 1, 0); PG8_STAGE(PG8_SA(0, 1), a2 + hstep, voffA);
            PG8_WAIT_L(8); PG8_BAR; PG8_WAIT_L(0); PG8_MMA(0, 0, At, B0); PG8_BAR; PG8_SCHED;
            PG8_LDB(B1, 1, 1); PG8_STAGE(PG8_SB(1, 0), b3, voffB);
            PG8_BAR; PG8_WAIT_L(0); PG8_MMA(0, 1, At, B1); PG8_BAR;
            PG8_LDA(At, 1, 1); PG8_STAGE(PG8_SA(1, 0), a3, voffA);
            PG8_BAR; PG8_WAIT_L(0); PG8_MMA(1, 0, At, B0); PG8_BAR; PG8_SCHED;
            PG8_STAGE(PG8_SB(1, 1), b3 + hstep, voffB);
            PG8_WAIT_V(6); PG8_BAR; PG8_MMA(1, 1, At, B1); PG8_BAR;
            }
        }
        if constexpr (ALIGN_EPI) { if (wr == 0) PG8_BAR; }
        if constexpr (!Epi::AFTER_DRAIN) { E(acc, cur, wr, wc, fr, fq); S.done(cur); }
        if (!has_next) break;
#pragma unroll
        for (int a = 0; a < 2; ++a)
#pragma unroll
            for (int b = 0; b < 2; ++b)
#pragma unroll
                for (int m = 0; m < 4; ++m)
#pragma unroll
                    for (int n = 0; n < 2; ++n) acc[a][b][m][n] = (f32x4){0.f, 0.f, 0.f, 0.f};
        cur = nxt; cA = nA; cB = nB; ++ui;
        if constexpr (ALIGN_EPI) { if (wr == 1) PG8_BAR; }
    }
    PG8_WAIT_V(0);
    if constexpr (!ALIGN_EPI) { if (wr == 0) PG8_BAR; }
    PG8_BAR;
    if constexpr (Epi::AFTER_DRAIN) { E.fused(acc, cur, wr, wc, fr, fq, lds, wid, lane); S.done(cur); }
#undef PG8_SA
#undef PG8_SB
#undef PG8_STAGE
#undef PG8_LDA
#undef PG8_LDB
#undef PG8_MMA
#undef PG8_WAIT_V
#undef PG8_WAIT_L
#undef PG8_BAR
#undef PG8_SCHED
}
}

#define LAS __attribute__((address_space(3)))
using pg8::bf16_t; using pg8::bf16x8; using pg8::f32x4; using pg8::u32x4;
typedef short s16x4 __attribute__((ext_vector_type(4)));
typedef float f32x16 __attribute__((ext_vector_type(16)));
typedef unsigned u32x2 __attribute__((ext_vector_type(2)));
typedef float f32x2_t __attribute__((ext_vector_type(2)));
typedef __bf16 bf16x2_t __attribute__((ext_vector_type(2)));

constexpr int DM = 1024, SEQ = 2048, NBATCH = 8, MP = NBATCH * SEQ, DSEQ = 16, MS = NBATCH * DSEQ, MT = MP + MS;
constexpr int DFF = 2816, NQKV = 3072, PLED = 256, NLAYER = 2, PAST = 2048, BANDL = 512, HW = 512;
constexpr float EPS = 1e-6f, LOG2E = 1.4426950408889634f, QSCALE = 0.125f * LOG2E;
#ifndef SB_EARLY
#define SB_EARLY 1
#endif
constexpr float SB_THR = 7.5e-37f;

constexpr size_t MiB = 1u << 20;
constexpr size_t WS_CTL = 0, WS_SS = 64 * 1024;
constexpr size_t WS_W = 2 * MiB, W_LSTRIDE = 28 * MiB, W_IN = 0, W_OUT = 6 * MiB, W_GU = 8 * MiB, W_DOWN = 19 * MiB, W_PG = 25 * MiB, W_PP = 27 * MiB;
constexpr size_t WS_PB = 58 * MiB, WS_X = 76 * MiB  , WS_XB = 142 * MiB, WS_QKV = 176 * MiB, WS_MIX = 274 * MiB, WS_P = 308 * MiB, WS_END = 342 * MiB;
constexpr int LDS_BYTES = 131072 + 1024;
constexpr size_t WS_BAR = 8192;
constexpr int NWAVES = 8, NTHREADS = 512;

constexpr size_t O_YP = 0, O_YS = (size_t)MP * DM, O_SBK_P = O_YS + (size_t)MS * DM, O_SBV_P = O_SBK_P + (size_t)NLAYER * MP * HW,
                 O_CBK_P = O_SBV_P + (size_t)NLAYER * MP * HW, O_CBV_P = O_CBK_P + (size_t)NLAYER * NBATCH * BANDL * HW,
                 O_SBK_S = O_CBV_P + (size_t)NLAYER * NBATCH * BANDL * HW, O_SBV_S = O_SBK_S + (size_t)NLAYER * MS * HW,
                 O_CBK_S = O_SBV_S + (size_t)NLAYER * MS * HW, O_CBV_S = O_CBK_S + (size_t)NLAYER * MS * HW;

__device__ __forceinline__ unsigned pk2(float lo, float hi) { f32x2_t v = {lo, hi}; bf16x2_t b = __builtin_convertvector(v, bf16x2_t); return __builtin_bit_cast(unsigned, b); }
__device__ __forceinline__ float bf_lo(unsigned w) { return __uint_as_float(w << 16); }
__device__ __forceinline__ float bf_hi(unsigned w) { return __uint_as_float(w & 0xffff0000u); }
__device__ __forceinline__ float partner32(float v) {
    auto rr = __builtin_amdgcn_permlane32_swap(__float_as_uint(v), __float_as_uint(v), false, false);
    return (threadIdx.x & 32) ? __uint_as_float(rr[0]) : __uint_as_float(rr[1]);
}
__device__ __forceinline__ float wave_sum(float v) {
#pragma unroll
    for (int o = 1; o < 64; o <<= 1) v += __shfl_xor(v, o);
    return v;
}
__device__ __forceinline__ float rstd_of(float ss) { return rsqrtf(ss * (1.0f / DM) + EPS); }

template <int I> __device__ __forceinline__ const float* argp() {
    unsigned long long v; const void* ka = (const void*)__builtin_amdgcn_kernarg_segment_ptr();
    asm volatile("s_load_dwordx2 %0, %1, %2\n\ts_waitcnt lgkmcnt(0)" : "=s"(v) : "s"(ka), "i"(I * 8) : "memory");
    return (const float*)(const __attribute__((address_space(1))) float*)v;
}
#define ARG(i) argp<i>()
#define ARG_OUT ((float*)argp<22>())
#define ARG_WS ((unsigned char*)argp<23>())
#define WS_PTR(T, off) ((T*)(ARG_WS + (off)))
#define SSB WS_PTR(float, WS_SS)
#define PB_ WS_PTR(bf16_t, WS_PB)
#define XN_ WS_PTR(bf16_t, WS_X)
#define XB_ WS_PTR(bf16_t, WS_XB)
#define QKV_ WS_PTR(bf16_t, WS_QKV)
#define HB_ WS_PTR(bf16_t, WS_QKV)
#define MIX_ WS_PTR(bf16_t, WS_MIX)
#define PBUF_ WS_PTR(bf16_t, WS_P)
#define WPTR(L, off) ((const bf16_t*)(ARG_WS + WS_W + (size_t)(L) * W_LSTRIDE + (off)))

enum { EP_QKV = 0, EP_RES = 1, EP_GU = 2, EP_P = 3, EP_PLE = 4 };
struct EpiArgs {
    const float* ss_in; float* ss_out;
    const bf16_t* xbase;
    bf16_t* XB; bf16_t* o0; const bf16_t* P;
    float *f_sbk, *f_sbv, *f_cbk, *f_cbv;
    float *s_sbk, *s_sbv, *s_cbk, *s_cbv;
};
template <int MODE> struct Epi {
    static constexpr bool PERM = false, AFTER_DRAIN = false;
    EpiArgs a;
    __device__ __forceinline__ void operator()(const f32x4 (&acc)[2][2][4][2], const pg8::Unit& u, int wr, int wc, int fr, int fq) const {
        if constexpr (MODE == EP_QKV) {
            const int part = u.pn >> 1, cb = (u.pn & 1) * 256 + wc * 32 + 4 * fq;
            bf16_t* ob = a.o0 + (size_t)part * ((size_t)MT * HW);
            float* fo = part == 1 ? a.f_sbk : part == 2 ? a.f_sbv : part == 4 ? a.f_cbk : part == 5 ? a.f_cbv : nullptr;
            const bool band = part >= 4; const float qs = (part == 0 || part == 3) ? QSCALE : 1.f;
#pragma unroll
            for (int ai = 0; ai < 2; ++ai)
#pragma unroll
                for (int m = 0; m < 4; ++m) {
                    const int row = u.pm * 256 + ai * 128 + wr * 64 + m * 16 + fr;
                    const float rs = rstd_of(a.ss_in[row]) * qs;
                    const int t = row & (SEQ - 1);
                    float* frow = nullptr;
                    if (fo) { if (!band) frow = fo + (size_t)row * HW; else if (t >= SEQ - BANDL) frow = fo + ((size_t)(row >> 11) * BANDL + (t - (SEQ - BANDL))) * HW; }
#pragma unroll
                    for (int bj = 0; bj < 2; ++bj)
#pragma unroll
                        for (int n = 0; n < 2; ++n) {
                            const int col = cb + bj * 128 + n * 16; const f32x4 v = acc[ai][bj][m][n] * rs;
                            u32x2 w; w.x = pk2(v[0], v[1]); w.y = pk2(v[2], v[3]);
                            *(u32x2*)(ob + (size_t)row * HW + col) = w;
                            if (frow) __builtin_nontemporal_store(v, (f32x4*)(frow + col));
                        }
                }
        } else if constexpr (MODE == EP_RES || MODE == EP_PLE) {
#pragma unroll
            for (int ai = 0; ai < 2; ++ai)
#pragma unroll
                for (int m = 0; m < 4; ++m) {
                    const int row = u.pm * 256 + ai * 128 + wr * 64 + m * 16 + fr;
                    float rs = 0.f; if constexpr (MODE == EP_PLE) rs = rstd_of(a.ss_in[row]) * (-LOG2E);
                    float s = 0.f;
#pragma unroll
                    for (int bj = 0; bj < 2; ++bj)
#pragma unroll
                        for (int n = 0; n < 2; ++n) {
                            const size_t off = (size_t)row * DM + u.pn * 256 + bj * 128 + wc * 32 + n * 16 + 4 * fq;
                            const u32x2 xw = *(const u32x2*)(a.xbase + off); f32x4 x = {bf_lo(xw.x), bf_hi(xw.x), bf_lo(xw.y), bf_hi(xw.y)}; const f32x4 c = acc[ai][bj][m][n];
                            if constexpr (MODE == EP_RES) x += c;
                            else { const u32x2 pw = *(const u32x2*)(a.P + off);
                                   x[0] += bf_lo(pw.x) * __builtin_amdgcn_rcpf(1.f + __builtin_amdgcn_exp2f(c[0] * rs));
                                   x[1] += bf_hi(pw.x) * __builtin_amdgcn_rcpf(1.f + __builtin_amdgcn_exp2f(c[1] * rs));
                                   x[2] += bf_lo(pw.y) * __builtin_amdgcn_rcpf(1.f + __builtin_amdgcn_exp2f(c[2] * rs));
                                   x[3] += bf_hi(pw.y) * __builtin_amdgcn_rcpf(1.f + __builtin_amdgcn_exp2f(c[3] * rs)); }
                            u32x2 w; w.x = pk2(x[0], x[1]); w.y = pk2(x[2], x[3]); *(u32x2*)(a.XB + off) = w;
                            s += (x[0] * x[0] + x[1] * x[1]) + (x[2] * x[2] + x[3] * x[3]);
                        }
                    s += __shfl_xor(s, 16); s += __shfl_xor(s, 32);
                    if (fq == 0) unsafeAtomicAdd(a.ss_out + row, s);
                }
        } else if constexpr (MODE == EP_GU) {
#pragma unroll
            for (int ai = 0; ai < 2; ++ai)
#pragma unroll
                for (int m = 0; m < 4; ++m) {
                    const int row = u.pm * 256 + ai * 128 + wr * 64 + m * 16 + fr;
                    const float rs = rstd_of(a.ss_in[row]);
#pragma unroll
                    for (int n = 0; n < 2; ++n) {
                        const int col = u.pn * 128 + wc * 32 + n * 16 + 4 * fq;
                        const f32x4 g = acc[ai][0][m][n] * rs, up = acc[ai][1][m][n] * rs; float h[4];
#pragma unroll
                        for (int e = 0; e < 4; ++e) h[e] = g[e] * up[e] * __builtin_amdgcn_rcpf(1.f + __builtin_amdgcn_exp2f(-LOG2E * g[e]));
                        u32x2 w; w.x = pk2(h[0], h[1]); w.y = pk2(h[2], h[3]);
                        *(u32x2*)(a.o0 + (size_t)row * DFF + col) = w;
                    }
                }
        } else {
#pragma unroll
            for (int ai = 0; ai < 2; ++ai)
#pragma unroll
                for (int m = 0; m < 4; ++m) {
                    const int row = u.pm * 256 + ai * 128 + wr * 64 + m * 16 + fr;
#pragma unroll
                    for (int bj = 0; bj < 2; ++bj)
#pragma unroll
                        for (int n = 0; n < 2; ++n) {
                            const size_t off = (size_t)row * DM + u.pn * 256 + bj * 128 + wc * 32 + n * 16 + 4 * fq; const f32x4 v = acc[ai][bj][m][n];
                            u32x2 w; w.x = pk2(v[0], v[1]); w.y = pk2(v[2], v[3]); *(u32x2*)(a.o0 + off) = w;
                        }
                }
        }
    }
};

template <int MODE, int K>
__device__ __forceinline__ void sgemm(LAS unsigned char* lds, const bf16_t* A, const bf16_t* Bt, int ncol32, const EpiArgs& a) {
    const int tid = fresh_tid(), lane = tid & 63, wave = __builtin_amdgcn_readfirstlane(tid >> 6), r = lane & 31, hh = lane >> 5;
    LAS float* red = (LAS float*)lds;
    constexpr int K8 = K >> 3, NK = K8 / 16, UB = NK > 11 ? 11 : NK;
    static_assert(NK % UB == 0, "sgemm: K split");
    const int G = gridDim.x, nunits = 4 * ncol32;
    for (int j = G - 1 - (int)blockIdx.x; j < nunits; j += G) {
        const int rb = j & 3, c0 = 32 * (j >> 2);
        const int brow0 = (MODE == EP_GU) ? ((c0 >> 7) * 256 + (c0 & 127)) : c0;
        const bf16_t* ap = A + (size_t)(32 * rb + r) * K + wave * K8 + 8 * hh;
        const bf16_t* bp = Bt + (size_t)(brow0 + r) * K + wave * K8 + 8 * hh;
        f32x16 acc0 = {}, acc1 = {};
#pragma unroll 1
        for (int kb = 0; kb < NK; kb += UB) {
            bf16x8 af[UB], bf[UB], bf2[MODE == EP_GU ? UB : 1];
#pragma unroll
            for (int i = 0; i < UB; ++i) { af[i] = *(const bf16x8*)(ap + (kb + i) * 16); bf[i] = *(const bf16x8*)(bp + (kb + i) * 16);
                if constexpr (MODE == EP_GU) bf2[i] = *(const bf16x8*)(bp + (size_t)128 * K + (kb + i) * 16); }
#pragma unroll
            for (int i = 0; i < UB; ++i) { acc0 = __builtin_amdgcn_mfma_f32_32x32x16_bf16(af[i], bf[i], acc0, 0, 0, 0);
                if constexpr (MODE == EP_GU) acc1 = __builtin_amdgcn_mfma_f32_32x32x16_bf16(af[i], bf2[i], acc1, 0, 0, 0); }
        }
#pragma unroll
        for (int i = 0; i < 16; ++i) { red[(wave * 16 + i) * 64 + lane] = acc0[i]; if constexpr (MODE == EP_GU) red[8192 + (wave * 16 + i) * 64 + lane] = acc1[i]; }
        __syncthreads();
        const int col = c0 + r;
#pragma unroll
        for (int ii = 0; ii < 2; ++ii) {
            const int i = 2 * wave + ii;
            float v0 = 0.f, v1 = 0.f;
#pragma unroll
            for (int w = 0; w < 8; ++w) { v0 += red[(w * 16 + i) * 64 + lane]; if constexpr (MODE == EP_GU) v1 += red[8192 + (w * 16 + i) * 64 + lane]; }
            const int rs_ = 32 * rb + (i & 3) + 8 * (i >> 2) + 4 * hh, row = MP + rs_;
            if constexpr (MODE == EP_QKV) {
                const int part = c0 >> 9, cc = col & 511;
                const float v = v0 * rstd_of(a.ss_in[row]);
                const float qs = (part == 0 || part == 3) ? QSCALE : 1.f;
                (a.o0 + (size_t)part * ((size_t)MT * HW))[(size_t)row * HW + cc] = (bf16_t)(pk2(v * qs, 0.f) & 0xffffu);
                float* fo = part == 1 ? a.s_sbk : part == 2 ? a.s_sbv : part == 4 ? a.s_cbk : part == 5 ? a.s_cbv : nullptr;
                if (fo) fo[(size_t)rs_ * HW + cc] = v;
            } else if constexpr (MODE == EP_RES || MODE == EP_PLE) {
                const size_t off = (size_t)row * DM + col;
                float x = __uint_as_float((unsigned)a.xbase[off] << 16);
                if constexpr (MODE == EP_RES) x += v0;
                else { const float pv = __uint_as_float((unsigned)a.P[off] << 16); x += pv * __builtin_amdgcn_rcpf(1.f + __builtin_amdgcn_exp2f(-LOG2E * v0 * rstd_of(a.ss_in[row]))); }
                a.XB[off] = (bf16_t)(pk2(x, 0.f) & 0xffffu);
                float s = x * x;
                s += __shfl_xor(s, 1); s += __shfl_xor(s, 2); s += __shfl_xor(s, 4); s += __shfl_xor(s, 8); s += __shfl_xor(s, 16);
                if (r == 0) unsafeAtomicAdd(a.ss_out + row, s);
            } else if constexpr (MODE == EP_GU) {
                const float rs = rstd_of(a.ss_in[row]); const float g = v0 * rs, up = v1 * rs;
                const float h = g * up * __builtin_amdgcn_rcpf(1.f + __builtin_amdgcn_exp2f(-LOG2E * g));
                a.o0[(size_t)row * DFF + col] = (bf16_t)(pk2(h, 0.f) & 0xffffu);
            } else {
                a.o0[(size_t)row * DM + col] = (bf16_t)(pk2(v0, 0.f) & 0xffffu);
            }
        }
        __syncthreads();
    }
}
struct AttnArgs { int L; };
constexpr int AW_V = 0, AW_ST = 4096, AW_BIAS = 8704, AW_BYTES = 10240, ST_PITCH = 144;

template <bool F32> __device__ __forceinline__ void ld_k(bf16x8 (&kf)[4], const void* base, size_t off) {
    if constexpr (!F32) { const bf16_t* p = (const bf16_t*)base + off;
#pragma unroll
        for (int kk = 0; kk < 4; ++kk) kf[kk] = *(const bf16x8*)(p + 8 * kk);
    } else { const float* p = (const float*)base + off;
#pragma unroll
        for (int kk = 0; kk < 4; ++kk) { const f32x4 x = *(const f32x4*)(p + 8 * kk), y = *(const f32x4*)(p + 8 * kk + 4);
            u32x4 w; w.x = pk2(x[0], x[1]); w.y = pk2(x[2], x[3]); w.z = pk2(y[0], y[1]); w.w = pk2(y[2], y[3]); kf[kk] = __builtin_bit_cast(bf16x8, w); }
    }
}
template <bool F32> __device__ __forceinline__ void ld_v(u32x4 (&vr)[4], const void* base, size_t row0, int nvalid, int h, int lane) {
#pragma unroll
    for (int i = 0; i < 4; ++i) { int key = 8 * i + (lane >> 3); key = key < nvalid ? key : nvalid - 1;
        const size_t off = (row0 + key) * HW + h * 64 + (lane & 7) * 8;
        if constexpr (!F32) vr[i] = *(const u32x4*)((const bf16_t*)base + off);
        else { const float* p = (const float*)base + off; const f32x4 x = *(const f32x4*)p, y = *(const f32x4*)(p + 4);
            u32x4 w; w.x = pk2(x[0], x[1]); w.y = pk2(x[2], x[3]); w.z = pk2(y[0], y[1]); w.w = pk2(y[2], y[3]); vr[i] = w; }
    }
}
__device__ __forceinline__ void st_v(LAS unsigned char* vl, const u32x4 (&vr)[4], int lane) {
#pragma unroll
    for (int i = 0; i < 4; ++i) { const int key = 8 * i + (lane >> 3); *(LAS u32x4*)(vl + key * 128 + (((lane & 7) * 16) ^ (((key >> 1) & 1) << 6))) = vr[i]; }
}
typedef short v4i16_t __attribute__((ext_vector_type(4)));
__device__ __forceinline__ s16x4 vtr(LAS unsigned char* p) { return __builtin_bit_cast(s16x4, __builtin_amdgcn_ds_read_tr16_b64_v4i16((LAS v4i16_t*)p)); }
__device__ __forceinline__ void pv_block(f32x16 (&o)[2], LAS unsigned char* vl, const bf16x8 (&pf)[2], int lane) {
    const int q = (lane & 15) >> 2, p = lane & 3, c16 = (lane >> 4) & 1, hh = lane >> 5;
    const int va0 = (4 * hh + q) * 128 + ((32 * c16 + 8 * p) ^ ((q >> 1) << 6));
#pragma unroll
    for (int db = 0; db < 2; ++db)
#pragma unroll
        for (int s = 0; s < 2; ++s) {
            const s16x4 lo = vtr(vl + (va0 ^ (db * 64)) + s * 2048), hi = vtr(vl + (va0 ^ (db * 64)) + s * 2048 + 1024);
            const bf16x8 vf = {lo[0], lo[1], lo[2], lo[3], hi[0], hi[1], hi[2], hi[3]};
            o[db] = __builtin_amdgcn_mfma_f32_32x32x16_bf16(vf, pf[s], o[db], 0, 0, 0);
        }
}
__device__ __forceinline__ f32x16 qk_block(const bf16x8 (&kf)[4], const bf16x8 (&qf)[4]) {
    f32x16 S = {};
#pragma unroll
    for (int kk = 0; kk < 4; ++kk) S = __builtin_amdgcn_mfma_f32_32x32x16_bf16(kf[kk], qf[kk], S, 0, 0, 0);
    return S;
}
__device__ __forceinline__ void sb_block(const f32x16& S, LAS unsigned char* vl, int tq, int keypos0, float& carry, f32x16 (&o)[2], int lane) {
    const int hh = lane >> 5;
    float kp_[16], be[16];
#pragma unroll
    for (int r = 0; r < 16; ++r) {
        const int kp = keypos0 + (r & 3) + 8 * (r >> 2) + 4 * hh; const bool valid = kp < tq;
        const float z = __builtin_amdgcn_fmed3f(S[r], -126.f, 100.f);
        const float t = __builtin_amdgcn_exp2f(z), k = __builtin_amdgcn_rcpf(1.f + t);
        kp_[r] = valid ? k : 1.f; be[r] = valid ? t * k : 0.f;
    }
    float T[4], Tp[4], U[4];
#pragma unroll
    for (int g = 0; g < 4; ++g) { T[g] = (kp_[4 * g] * kp_[4 * g + 1]) * (kp_[4 * g + 2] * kp_[4 * g + 3]); Tp[g] = partner32(T[g]); U[g] = T[g] * Tp[g]; }
    float R[4]; R[3] = 1.f; R[2] = U[3]; R[1] = U[3] * U[2]; R[0] = R[1] * U[1];
    const float tot = R[0] * U[0];
    float w[16];
#pragma unroll
    for (int g = 0; g < 4; ++g) {
        const float b3 = carry * R[g] * (hh == 0 ? Tp[g] : 1.f);
        const float b2 = b3 * kp_[4 * g + 3], b1 = b2 * kp_[4 * g + 2], b0 = b1 * kp_[4 * g + 1];
        w[4 * g + 3] = be[4 * g + 3] * b3; w[4 * g + 2] = be[4 * g + 2] * b2; w[4 * g + 1] = be[4 * g + 1] * b1; w[4 * g + 0] = be[4 * g + 0] * b0;
    }
    carry *= tot;
    bf16x8 pf[2];
#pragma unroll
    for (int s = 0; s < 2; ++s) { u32x4 pw; pw.x = pk2(w[8 * s], w[8 * s + 1]); pw.y = pk2(w[8 * s + 2], w[8 * s + 3]); pw.z = pk2(w[8 * s + 4], w[8 * s + 5]); pw.w = pk2(w[8 * s + 6], w[8 * s + 7]); pf[s] = __builtin_bit_cast(bf16x8, pw); }
    pv_block(o, vl, pf, lane);
}
__device__ __forceinline__ void cb_block(const f32x16& S, bool cbias, LAS unsigned char* vl, const LAS float* bl, int tq, int keypos0, int nvalid, float& m, float& l, f32x16 (&o)[2], int lane) {
    const int hh = lane >> 5;
    float s[16]; float bm = -INFINITY;
    if (cbias) {
        const float cb = bl[256];
#pragma unroll
        for (int r = 0; r < 16; ++r) { s[r] = S[r] + cb; bm = fmaxf(bm, s[r]); }
    } else {
#pragma unroll
        for (int r = 0; r < 16; ++r) {
            const int kr = (r & 3) + 8 * (r >> 2) + 4 * hh; int d = tq - (keypos0 + kr); d = d < -128 ? -128 : (d > 128 ? 128 : d);
            s[r] = (kr < nvalid) ? S[r] + bl[d + 128] : -INFINITY; bm = fmaxf(bm, s[r]);
        }
    }
    bm = fmaxf(bm, partner32(bm));
    if (__any(bm > m + 8.f)) {
        const float mn = fmaxf(m, bm), f = __builtin_amdgcn_exp2f(m - mn); m = mn; l *= f;
#pragma unroll
        for (int db = 0; db < 2; ++db)
#pragma unroll
            for (int r = 0; r < 16; ++r) o[db][r] *= f;
    }
    float w[16], ls = 0.f;
#pragma unroll
    for (int r = 0; r < 16; ++r) { w[r] = __builtin_amdgcn_exp2f(s[r] - m); ls += w[r]; }
    l += ls;
    bf16x8 pf[2];
#pragma unroll
    for (int s2 = 0; s2 < 2; ++s2) { u32x4 pw; pw.x = pk2(w[8 * s2], w[8 * s2 + 1]); pw.y = pk2(w[8 * s2 + 2], w[8 * s2 + 3]); pw.z = pk2(w[8 * s2 + 4], w[8 * s2 + 5]); pw.w = pk2(w[8 * s2 + 6], w[8 * s2 + 7]); pf[s2] = __builtin_bit_cast(bf16x8, pw); }
    pv_block(o, vl, pf, lane);
}
__device__ __forceinline__ void attn_store(f32x16 (&o)[2], float scale, const float* gain, bf16_t* mix, size_t row0, int col0, int nrows, LAS unsigned char* wl, int lane) {
    const int r = lane & 31, hh = lane >> 5;
    f32x4 gvs[2][4];
#pragma unroll
    for (int db = 0; db < 2; ++db)
#pragma unroll
        for (int g = 0; g < 4; ++g) gvs[db][g] = *(const f32x4*)(gain + 32 * db + 8 * g + 4 * hh);
    float ssq = 0.f;
#pragma unroll
    for (int db = 0; db < 2; ++db)
#pragma unroll
        for (int i = 0; i < 16; ++i) { o[db][i] *= scale; ssq += o[db][i] * o[db][i]; }
    ssq += partner32(ssq);
    const float rstd = rsqrtf(ssq * (1.0f / 64.0f) + EPS);
    LAS unsigned char* st = wl + AW_ST;
#pragma unroll
    for (int db = 0; db < 2; ++db)
#pragma unroll
        for (int g = 0; g < 4; ++g) { const int d0 = 32 * db + 8 * g + 4 * hh; const f32x4 gv = gvs[db][g];
            u32x2 w; w.x = pk2(o[db][4 * g] * rstd * gv[0], o[db][4 * g + 1] * rstd * gv[1]); w.y = pk2(o[db][4 * g + 2] * rstd * gv[2], o[db][4 * g + 3] * rstd * gv[3]);
            *(LAS u32x2*)(st + r * ST_PITCH + d0 * 2) = w; }
#pragma unroll
    for (int i = 0; i < 4; ++i) { const int row = 8 * i + (lane >> 3), ch = lane & 7; const u32x4 v = *(const LAS u32x4*)(st + row * ST_PITCH + ch * 16);
        if (row < nrows) *(u32x4*)(mix + (row0 + row) * DM + col0 + ch * 8) = v; }
}

template <bool F32> __device__ __forceinline__ void sb_loop(const void* kbase, const void* vbase, size_t rowbase, int jhi, int h, const bf16x8 (&qf)[4], int tq, float& carry, f32x16 (&o)[2], LAS unsigned char* wl, int lane) {
    const int r = lane & 31, hh = lane >> 5;
    bf16x8 kA[4], kB[4]; u32x4 vA[4], vB[4];
#define SB_LD(KF, VN, jj) do { ld_k<F32>(KF, kbase, (rowbase + 32 * (jj) + r) * HW + h * 64 + 32 * hh); ld_v<F32>(VN, vbase, rowbase + 32 * (jj), 32, h, lane); } while (0)
    SB_LD(kA, vA, jhi); if (jhi >= 1) SB_LD(kB, vB, jhi - 1);
    for (int j = jhi; j >= 0; j -= 2) {
        { const f32x16 S = qk_block(kA, qf); st_v(wl + AW_V, vA, lane); if (j >= 2) SB_LD(kA, vA, j - 2);
          sb_block(S, wl + AW_V, tq, 32 * j, carry, o, lane); }
#if SB_EARLY
        if (__all(carry < SB_THR)) break;
#endif
        if (j < 1) break;
        { const f32x16 S = qk_block(kB, qf); st_v(wl + AW_V, vB, lane); if (j >= 3) SB_LD(kB, vB, j - 3);
          sb_block(S, wl + AW_V, tq, 32 * (j - 1), carry, o, lane); }
#if SB_EARLY
        if (__all(carry < SB_THR)) break;
#endif
    }
#undef SB_LD
}
template <bool SAMPLE> __device__ __forceinline__ void sb_unit(const AttnArgs& A, int b, int h, int qb, LAS unsigned char* wl, int lane) {
    const int r = lane & 31, hh = lane >> 5;
    const bf16_t* Qa = QKV_; const bf16_t* Ka = Qa + (size_t)1 * MT * HW; const bf16_t* Va = Qa + (size_t)2 * MT * HW;
    int tq; size_t qrow;
    if (SAMPLE) { tq = PAST + (r & 15); qrow = (size_t)MP + b * DSEQ + (r & 15); } else { tq = 32 * qb + r; qrow = (size_t)b * SEQ + tq; }
    bf16x8 qf[4]; ld_k<false>(qf, Qa, qrow * HW + h * 64 + 32 * hh);
    float carry = 1.f; f32x16 o[2]; o[0] = f32x16{}; o[1] = f32x16{};
    if (SAMPLE) {
        bf16x8 kf[4]; u32x4 vr[4]; const size_t row0 = (size_t)MP + b * DSEQ;
        ld_k<false>(kf, Ka, (row0 + (r & 15)) * HW + h * 64 + 32 * hh); ld_v<false>(vr, Va, row0, DSEQ, h, lane); st_v(wl + AW_V, vr, lane);
        { const f32x16 S = qk_block(kf, qf); sb_block(S, wl + AW_V, tq, PAST, carry, o, lane); }
        sb_loop<true>(ARG(4) + (size_t)A.L * NBATCH * PAST * HW, ARG(5) + (size_t)A.L * NBATCH * PAST * HW, (size_t)b * PAST, PAST / 32 - 1, h, qf, tq, carry, o, wl, lane);
        attn_store(o, 1.f, ARG(11) + A.L * HW + h * 64, MIX_, row0, h * 64, DSEQ, wl, lane);
    } else {
        sb_loop<false>(Ka, Va, (size_t)b * SEQ, qb, h, qf, tq, carry, o, wl, lane);
        attn_store(o, 1.f, ARG(11) + A.L * HW + h * 64, MIX_, (size_t)b * SEQ + 32 * qb, h * 64, 32, wl, lane);
    }
}
template <bool F32> __device__ __forceinline__ void cb_loop(const void* kbase, const void* vbase, size_t rowbase, int jlo, int jhi, int pos0, int h, const bf16x8 (&qf)[4], int tq, float& m, float& l, f32x16 (&o)[2], LAS unsigned char* wl, int lane) {
    const int r = lane & 31, hh = lane >> 5;
    bf16x8 kA[4], kB[4]; u32x4 vA[4], vB[4];
    const int tqmin = tq - r;
#define CB_LD(KF, VN, jj) do { ld_k<F32>(KF, kbase, (rowbase + 32 * (jj) + r) * HW + h * 64 + 32 * hh); ld_v<F32>(VN, vbase, rowbase + 32 * (jj), 32, h, lane); } while (0)
    CB_LD(kA, vA, jlo); if (jlo + 1 <= jhi) CB_LD(kB, vB, jlo + 1);
    for (int j = jlo; j <= jhi; j += 2) {
        { const f32x16 S = qk_block(kA, qf); st_v(wl + AW_V, vA, lane); if (j + 2 <= jhi) CB_LD(kA, vA, j + 2);
          const bool cbias = __builtin_amdgcn_readfirstlane(pos0 + 32 * j + 31 + 128 <= tqmin);
          cb_block(S, cbias, wl + AW_V, (const LAS float*)(wl + AW_BIAS), tq, pos0 + 32 * j, 32, m, l, o, lane); }
        if (j + 1 > jhi) break;
        { const f32x16 S = qk_block(kB, qf); st_v(wl + AW_V, vB, lane); if (j + 3 <= jhi) CB_LD(kB, vB, j + 3);
          const bool cbias = __builtin_amdgcn_readfirstlane(pos0 + 32 * (j + 1) + 31 + 128 <= tqmin);
          cb_block(S, cbias, wl + AW_V, (const LAS float*)(wl + AW_BIAS), tq, pos0 + 32 * (j + 1), 32, m, l, o, lane); }
    }
#undef CB_LD
}
template <bool SAMPLE> __device__ __forceinline__ void cb_unit(const AttnArgs& A, int b, int h, int qb, LAS unsigned char* wl, int lane) {
    const int r = lane & 31, hh = lane >> 5;
    const bf16_t* Qb = QKV_ + (size_t)3 * MT * HW; const bf16_t* Kb = Qb + (size_t)1 * MT * HW; const bf16_t* Vb = Qb + (size_t)2 * MT * HW;
    LAS float* bl = (LAS float*)(wl + AW_BIAS);
    { const float* relp = ARG(10) + (size_t)A.L * 257 * 8 + h; float bv[5];
#pragma unroll
      for (int i = 0; i < 5; ++i) { const int idx = lane + 64 * i; bv[i] = relp[(idx < 257 ? idx : 256) * 8]; }
#pragma unroll
      for (int i = 0; i < 5; ++i) { const int idx = lane + 64 * i; if (idx < 257) bl[idx] = bv[i] * LOG2E; } }
    int tq; size_t qrow;
    if (SAMPLE) { tq = PAST + (r & 15); qrow = (size_t)MP + b * DSEQ + (r & 15); } else { tq = 32 * qb + r; qrow = (size_t)b * SEQ + tq; }
    bf16x8 qf[4]; ld_k<false>(qf, Qb, qrow * HW + h * 64 + 32 * hh);
    float m = -INFINITY, l = 0.f; f32x16 o[2]; o[0] = f32x16{}; o[1] = f32x16{};
    if (SAMPLE) {
        cb_loop<true>(ARG(6) + (size_t)A.L * NBATCH * BANDL * HW, ARG(7) + (size_t)A.L * NBATCH * BANDL * HW, (size_t)b * BANDL, 0, BANDL / 32 - 1, PAST - BANDL, h, qf, tq, m, l, o, wl, lane);
        bf16x8 kf[4]; u32x4 vr[4]; const size_t row0 = (size_t)MP + b * DSEQ;
        ld_k<false>(kf, Kb, (row0 + (r & 15)) * HW + h * 64 + 32 * hh); ld_v<false>(vr, Vb, row0, DSEQ, h, lane); st_v(wl + AW_V, vr, lane);
        { const f32x16 S = qk_block(kf, qf); cb_block(S, false, wl + AW_V, bl, tq, PAST, DSEQ, m, l, o, lane); }
        l += partner32(l);
        attn_store(o, 1.0f / l, ARG(12) + A.L * HW + h * 64, MIX_, row0, HW + h * 64, DSEQ, wl, lane);
    } else {
        const int c = qb >> 1, clo = c - 8 < 0 ? 0 : c - 8;
        cb_loop<false>(Kb, Vb, (size_t)b * SEQ, 2 * clo, 2 * c + 1, 0, h, qf, tq, m, l, o, wl, lane);
        l += partner32(l);
        attn_store(o, 1.0f / l, ARG(12) + A.L * HW + h * 64, MIX_, (size_t)b * SEQ + 32 * qb, HW + h * 64, 32, wl, lane);
    }
}
__device__ __forceinline__ void cb_unit_p64(const AttnArgs& A, int b, int h, int c, LAS unsigned char* wl, int lane) {
    const int r = lane & 31, hh = lane >> 5;
    const bf16_t* Qb = QKV_ + (size_t)3 * MT * HW; const bf16_t* Kb = Qb + (size_t)1 * MT * HW; const bf16_t* Vb = Qb + (size_t)2 * MT * HW;
    LAS float* bl = (LAS float*)(wl + AW_BIAS);
    { const float* relp = ARG(10) + (size_t)A.L * 257 * 8 + h; float bv[5];
#pragma unroll
      for (int i = 0; i < 5; ++i) { const int idx = lane + 64 * i; bv[i] = relp[(idx < 257 ? idx : 256) * 8]; }
#pragma unroll
      for (int i = 0; i < 5; ++i) { const int idx = lane + 64 * i; if (idx < 257) bl[idx] = bv[i] * LOG2E; } }
    const int tq0 = 64 * c + r, tq1 = tq0 + 32; const size_t rowbase = (size_t)b * SEQ;
    bf16x8 qf0[4], qf1[4];
    ld_k<false>(qf0, Qb, (rowbase + tq0) * HW + h * 64 + 32 * hh); ld_k<false>(qf1, Qb, (rowbase + tq1) * HW + h * 64 + 32 * hh);
    float m0 = -INFINITY, l0 = 0.f, m1 = -INFINITY, l1 = 0.f;
    f32x16 o0[2], o1[2]; o0[0] = f32x16{}; o0[1] = f32x16{}; o1[0] = f32x16{}; o1[1] = f32x16{};
    const int clo = c - 8 < 0 ? 0 : c - 8, jlo = 2 * clo, jhi = 2 * c + 1;
    bf16x8 kf[4]; u32x4 vn[4];
    ld_k<false>(kf, Kb, (rowbase + 32 * jlo + r) * HW + h * 64 + 32 * hh); ld_v<false>(vn, Vb, rowbase + 32 * jlo, 32, h, lane);
    for (int j = jlo; j <= jhi; ++j) {
        const f32x16 S0 = qk_block(kf, qf0), S1 = qk_block(kf, qf1);
        st_v(wl + AW_V, vn, lane);
        if (j < jhi) { ld_k<false>(kf, Kb, (rowbase + 32 * (j + 1) + r) * HW + h * 64 + 32 * hh); ld_v<false>(vn, Vb, rowbase + 32 * (j + 1), 32, h, lane); }
        const bool cbias = (32 * j + 31 + 128 <= 64 * c);
        cb_block(S0, cbias, wl + AW_V, bl, tq0, 32 * j, 32, m0, l0, o0, lane);
        cb_block(S1, cbias, wl + AW_V, bl, tq1, 32 * j, 32, m1, l1, o1, lane);
    }
    l0 += partner32(l0); l1 += partner32(l1);
    attn_store(o0, 1.0f / l0, ARG(12) + A.L * HW + h * 64, MIX_, rowbase + 64 * c, HW + h * 64, 32, wl, lane);
    attn_store(o1, 1.0f / l1, ARG(12) + A.L * HW + h * 64, MIX_, rowbase + 64 * c + 32, HW + h * 64, 32, wl, lane);
}
constexpr int AU_ITEMS = 2048;
__device__ __forceinline__ void attn_phase(const AttnArgs& A, LAS unsigned char* lds) {
    const int tid_ = fresh_tid(), lane = tid_ & 63, wave = __builtin_amdgcn_readfirstlane(tid_ >> 6);
    LAS unsigned char* wl = lds + wave * AW_BYTES;
#pragma unroll 1
    for (int cu = (int)blockIdx.x * NWAVES + wave; cu < AU_ITEMS; cu += (int)gridDim.x * NWAVES) {
        const int bh = cu >> 5, p = cu & 31;
        cb_unit_p64(A, bh >> 3, bh & 7, 31 - p, wl, lane);
#pragma unroll 1
        for (int t = 0; t < 2; ++t) sb_unit<false>(A, bh >> 3, bh & 7, 63 - 2 * p - t, wl, lane);
        if (p >= 28) { const int li = bh * 4 + (p - 28);
            if (li < 64) sb_unit<true>(A, li >> 3, li & 7, 0, wl, lane);
            else if (li < 128) cb_unit<true>(A, (li - 64) >> 3, (li - 64) & 7, 0, wl, lane); }
    }
}
typedef unsigned gu32_plain;
#define XB_TMO      128
#define XB_XCNT(j)  (256  + 64 * (j))
#define XB_XSUB(j)  (1280 + 64 * (j))
#define XB_XGEN(j)  (2304 + 64 * (j))
#define XB_TOP      3328
#define XB_TOPGEN   3392
#define XCD_BAR_WORDS 3456
#define XB_SPIN_CAP (1u << 18)

__device__ __forceinline__ unsigned xb_ld(unsigned* p)              { return __hip_atomic_load(p, __ATOMIC_RELAXED, __HIP_MEMORY_SCOPE_AGENT); }
__device__ __forceinline__ unsigned xb_add(unsigned* p, unsigned v) { return __hip_atomic_fetch_add(p, v, __ATOMIC_RELAXED, __HIP_MEMORY_SCOPE_AGENT); }
__device__ __forceinline__ unsigned xb_xcc_id() { return (unsigned)__builtin_amdgcn_s_getreg((3 << 11) | 20) & 0xFu; }
#define XB_SPIN(cond, bar) do { unsigned _sp = 0; while (cond) { __builtin_amdgcn_s_sleep(1); \
    if ((++_sp & 255u) == 0u) { if (xb_ld(&(bar)[XB_TMO])) break; if (_sp > XB_SPIN_CAP) { atomicAdd(&(bar)[XB_TMO], 1u); break; } } } } while (0)

struct XcdBarrier {
    unsigned* bar; unsigned x;
    volatile LAS unsigned* st;
};

__device__ __forceinline__ XcdBarrier xcd_barrier_post(unsigned* bar, volatile LAS unsigned* st) {
    XcdBarrier b; b.bar = bar; b.x = xb_xcc_id(); b.st = st;
    if (threadIdx.x == 0) (void)xb_add(&bar[XB_XCNT(b.x)], 1u);
    return b;
}
__device__ __forceinline__ void xcd_barrier_complete(unsigned* bar, unsigned x, unsigned& nloc, unsigned& nx) {
    const unsigned G = gridDim.x * gridDim.y * gridDim.z;
    unsigned sum, cnt, mine, sp = 0u;
    for (;;) {
        sum = 0u; cnt = 0u; mine = 0u;
#pragma unroll
        for (unsigned j = 0; j < 16; ++j) { const unsigned c = xb_ld(&bar[XB_XCNT(j)]); sum += c; cnt += (c > 0u) ? 1u : 0u; mine = (j == x) ? c : mine; }
        if (sum == G) break;
        __builtin_amdgcn_s_sleep(1);
        if ((++sp & 255u) == 0u) { if (xb_ld(&bar[XB_TMO])) break; if (sp > XB_SPIN_CAP) { atomicAdd(&bar[XB_TMO], 1u); break; } }
    }
    nloc = mine > 0u ? mine : 1u; nx = cnt > 0u ? cnt : 1u;
}

__device__ __forceinline__ void xcd_barrier(const XcdBarrier& b) {
    asm volatile("s_waitcnt vmcnt(0)" ::: "memory");
    __syncthreads();
    if (threadIdx.x == 0) {
        unsigned* bar = b.bar;
        __builtin_amdgcn_s_waitcnt(0);
        unsigned nloc = b.st[0], nx = b.st[1];
        if (nloc == 0u) { xcd_barrier_complete(bar, b.x, nloc, nx); b.st[0] = nloc; b.st[1] = nx; }
        const unsigned old = xb_add(&bar[XB_XSUB(b.x)], 1u);
        const unsigned gen = old / nloc;
        if (old + 1u == (gen + 1u) * nloc) {
            __builtin_amdgcn_fence(__ATOMIC_RELEASE, "agent");
            asm volatile("s_waitcnt vmcnt(0)" ::: "memory");
            const unsigned og = xb_add(&bar[XB_TOP], 1u);
            const unsigned tg = og / nx;
            if (og + 1u == (tg + 1u) * nx) xb_add(&bar[XB_TOPGEN], 1u);
            else XB_SPIN(xb_ld(&bar[XB_TOPGEN]) == tg, bar);
            __builtin_amdgcn_fence(__ATOMIC_ACQUIRE, "agent");
            xb_add(&bar[XB_XGEN(b.x)], 1u);
            asm volatile("s_waitcnt vmcnt(0)" ::: "memory");
        } else {
            XB_SPIN(xb_ld(&bar[XB_XGEN(b.x)]) == gen, bar);
            __builtin_amdgcn_fence(__ATOMIC_ACQUIRE, "agent");
            asm volatile("s_waitcnt vmcnt(0)" ::: "memory");
        }
    }
    __syncthreads();
}

constexpr int CI_IN = 16 * 96, CI_OUT = 16 * 32, CI_G = 16 * 88, CI_D = 44 * 32, CI_PG = 16 * 32, CI_PP = 4 * 32, CI_L = CI_IN + CI_OUT + 2 * CI_G + CI_D + CI_PG + CI_PP;
struct ConvD { const float* W; const float* gain; bf16_t* WT; int K, N, kind, k0, n0; };
__device__ __forceinline__ ConvD conv_decode(int it) {
    const int L = it / CI_L; int r = it % CI_L; ConvD d;
    if (r < CI_IN) { d.W = ARG(9) + (size_t)L * DM * NQKV; d.gain = ARG(8) + L * DM; d.WT = (bf16_t*)WPTR(L, W_IN); d.K = DM; d.N = NQKV; d.kind = 0; }
    else if ((r -= CI_IN) < CI_OUT) { d.W = ARG(13) + (size_t)L * DM * DM; d.gain = nullptr; d.WT = (bf16_t*)WPTR(L, W_OUT); d.K = DM; d.N = DM; d.kind = 0; }
    else if ((r -= CI_OUT) < CI_G) { d.W = ARG(15) + (size_t)L * DM * DFF; d.gain = ARG(14) + L * DM; d.WT = (bf16_t*)WPTR(L, W_GU); d.K = DM; d.N = DFF; d.kind = 1; }
    else if ((r -= CI_G) < CI_G) { d.W = ARG(16) + (size_t)L * DM * DFF; d.gain = ARG(14) + L * DM; d.WT = (bf16_t*)WPTR(L, W_GU); d.K = DM; d.N = DFF; d.kind = 2; }
    else if ((r -= CI_G) < CI_D) { d.W = ARG(17) + (size_t)L * DFF * DM; d.gain = nullptr; d.WT = (bf16_t*)WPTR(L, W_DOWN); d.K = DFF; d.N = DM; d.kind = 0; }
    else if ((r -= CI_D) < CI_PG) { d.W = ARG(19) + (size_t)L * DM * DM; d.gain = ARG(18) + L * DM; d.WT = (bf16_t*)WPTR(L, W_PG); d.K = DM; d.N = DM; d.kind = 0; }
    else { r -= CI_PG; d.W = ARG(20) + (size_t)L * PLED * DM; d.gain = nullptr; d.WT = (bf16_t*)WPTR(L, W_PP); d.K = PLED; d.N = DM; d.kind = 0; }
    const int nblk = d.N / 32; d.k0 = 64 * (r / nblk); d.n0 = 32 * (r % nblk);
    return d;
}
__device__ __forceinline__ void conv_load(const ConvD& d, float (&v)[32], f32x4 (&g)[2], int lane) {
    const float* p = d.W + (size_t)(d.k0 + (lane >> 5)) * d.N + d.n0 + (lane & 31);
#pragma unroll
    for (int i = 0; i < 32; ++i) v[i] = p[(size_t)(2 * i) * d.N];
    if (d.gain) { g[0] = *(const f32x4*)(d.gain + d.k0 + 8 * (lane & 7)); g[1] = *(const f32x4*)(d.gain + d.k0 + 8 * (lane & 7) + 4); }
    else { g[0] = (f32x4){1.f, 1.f, 1.f, 1.f}; g[1] = g[0]; }
}
__device__ __forceinline__ void conv_proc(const ConvD& d, const float (&v)[32], const f32x4 (&g)[2], LAS float* scr, int lane) {
#pragma unroll
    for (int i = 0; i < 32; ++i) scr[(2 * i + (lane >> 5)) * 33 + (lane & 31)] = v[i];
    asm volatile("s_waitcnt lgkmcnt(0)" ::: "memory");
    const int c = lane & 7;
#pragma unroll
    for (int j = 0; j < 4; ++j) { const int n = (lane >> 3) + 8 * j; const LAS float* s = scr + (8 * c) * 33 + n;
        u32x4 o; o.x = pk2(s[0 * 33] * g[0][0], s[1 * 33] * g[0][1]); o.y = pk2(s[2 * 33] * g[0][2], s[3 * 33] * g[0][3]);
        o.z = pk2(s[4 * 33] * g[1][0], s[5 * 33] * g[1][1]); o.w = pk2(s[6 * 33] * g[1][2], s[7 * 33] * g[1][3]);
        const int gn = d.n0 + n; const int drow = d.kind == 0 ? gn : ((gn >> 7) * 256 + (gn & 127) + (d.kind == 2 ? 128 : 0));
        *(u32x4*)(d.WT + (size_t)drow * d.K + d.k0 + 8 * c) = o; }
    asm volatile("s_waitcnt lgkmcnt(0)" ::: "memory");
}

#ifdef NO_SGEMM
#define SG(...)
#else
#define SG(...) __VA_ARGS__
#endif
#ifndef GP1
#define GP1(...) __VA_ARGS__
#endif
#ifndef GP2
#define GP2(...) __VA_ARGS__
#endif
#ifndef GP3
#define GP3(...) __VA_ARGS__
#endif
#ifndef GP4
#define GP4(...) __VA_ARGS__
#endif
#ifndef GP5
#define GP5(...) __VA_ARGS__
#endif
#ifndef GP6
#define GP6(...) __VA_ARGS__
#endif
#ifdef NO_SGEMM
#define SG(...)
#else
#define SG(...) __VA_ARGS__
#endif
#ifndef GP1
#define GP1(...) __VA_ARGS__
#endif
#ifndef GP2
#define GP2(...) __VA_ARGS__
#endif
#ifndef GP3
#define GP3(...) __VA_ARGS__
#endif
#ifndef GP4
#define GP4(...) __VA_ARGS__
#endif
#ifndef GP5
#define GP5(...) __VA_ARGS__
#endif
#ifndef GP6
#define GP6(...) __VA_ARGS__
#endif
struct Args { const float* in[22]; float* out; unsigned char* ws; };

#ifndef PROBE_SEL
#define PROBE_SEL -1
#endif
#if PROBE_SEL >= 0
#define TSTAMP(cat) do { if (blockIdx.x == 0 && fresh_tid() == 0) { const unsigned long long t_ = __builtin_amdgcn_s_memrealtime(); unsigned long long* tsb = WS_PTR(unsigned long long, WS_CTL + 4096); \
    tsb[16 + (cat)] += t_ - tsb[0]; tsb[0] = t_; } } while (0)
#else
#define TSTAMP(cat) do {} while (0)
#endif
__global__ void __launch_bounds__(NTHREADS, 2) hymba_fwd(Args args) {
    extern __shared__ __attribute__((aligned(16))) unsigned char lds_raw[];
    cg::grid_group grid = cg::this_grid();
    LAS unsigned char* lds = (LAS unsigned char*)lds_raw;
    const int G = gridDim.x;

    { const int tid0 = fresh_tid();
      if (blockIdx.x == 0) for (int i = tid0; i < XCD_BAR_WORDS; i += NTHREADS) WS_PTR(unsigned, WS_BAR)[i] = 0u;
      if (tid0 < 2) ((LAS unsigned*)(lds + 131072))[tid0] = 0u; }
    grid.sync();
    (void)xcd_barrier_post(WS_PTR(unsigned, WS_BAR), (volatile LAS unsigned*)(lds + 131072));
#define GSYNC() do { XcdBarrier xb_; xb_.bar = WS_PTR(unsigned, WS_BAR); xb_.x = xb_xcc_id(); xb_.st = (volatile LAS unsigned*)(lds + 131072); xcd_barrier(xb_); } while (0)
#if PROBE_SEL >= 0
    if (blockIdx.x == 0 && fresh_tid() == 0) { unsigned long long* tsb = WS_PTR(unsigned long long, WS_CTL + 4096); for (int i = 0; i < 48; ++i) tsb[i] = 0; tsb[0] = __builtin_amdgcn_s_memrealtime(); }
#endif
    {
        const int tid = fresh_tid(), lane = tid & 63, wave = __builtin_amdgcn_readfirstlane(tid >> 6);
        const int gw = blockIdx.x * NWAVES + wave, NGW = G * NWAVES;
        { float* ssb = SSB; for (int i = blockIdx.x * NTHREADS + tid; i < 6 * MT; i += G * NTHREADS) ssb[MT + i] = 0.f;
          if (blockIdx.x == 0 && tid < 16) WS_PTR(unsigned, WS_CTL)[tid] = 0u;
          }
        LAS float* scr = (LAS float*)(lds + wave * 8704);
        { constexpr int NIT = NLAYER * CI_L; int it = gw;
          float vA[32], vB[32]; f32x4 gA[2], gB[2]; ConvD dA, dB;
          if (it < NIT) { dA = conv_decode(it); conv_load(dA, vA, gA, lane); }
          while (it < NIT) {
            const int itn = it + NGW;
            if (itn < NIT) { dB = conv_decode(itn); conv_load(dB, vB, gB, lane); }
            conv_proc(dA, vA, gA, scr, lane);
            if (itn >= NIT) break;
            it = itn + NGW;
            if (it < NIT) { dA = conv_decode(it); conv_load(dA, vA, gA, lane); }
            conv_proc(dB, vB, gB, scr, lane);
          } }
        { const float* pp = ARG(2); const float* ps = ARG(3); bf16_t* PB = PB_;
          for (int it0 = 4 * gw; it0 < NLAYER * MT; it0 += 4 * NGW) {
            f32x4 v[4];
#pragma unroll
            for (int rr = 0; rr < 4; ++rr) { const int it = it0 + rr, L = it / MT, row = it % MT;
                const float* src = row < MP ? pp + ((size_t)L * MP + row) * PLED : ps + ((size_t)L * MS + (row - MP)) * PLED;
                v[rr] = *((const f32x4*)src + lane); }
#pragma unroll
            for (int rr = 0; rr < 4; ++rr) { u32x2 w; w.x = pk2(v[rr][0], v[rr][1]); w.y = pk2(v[rr][2], v[rr][3]); *((u32x2*)(PB + (size_t)(it0 + rr) * PLED) + lane) = w; }
          } }
        { const float* x_p = ARG(0); const float* x_s = ARG(1); bf16_t* XB = XN_; float* ssb = SSB;
          for (int row0 = 2 * gw; row0 < MT; row0 += 2 * NGW) {
            f32x4 v[2][4];
#pragma unroll
            for (int rr = 0; rr < 2; ++rr) { const int row = row0 + rr; const float* src = row < MP ? x_p + (size_t)row * DM : x_s + (size_t)(row - MP) * DM;
#pragma unroll
                for (int j = 0; j < 4; ++j) v[rr][j] = *((const f32x4*)src + lane + 64 * j); }
#pragma unroll
            for (int rr = 0; rr < 2; ++rr) { float s2 = 0.f;
#pragma unroll
                for (int j = 0; j < 4; ++j) { const f32x4 t = v[rr][j]; s2 += (t[0] * t[0] + t[1] * t[1]) + (t[2] * t[2] + t[3] * t[3]);
                    u32x2 w; w.x = pk2(t[0], t[1]); w.y = pk2(t[2], t[3]); *((u32x2*)(XB + (size_t)(row0 + rr) * DM) + lane + 64 * j) = w; }
                s2 = wave_sum(s2);
                if (lane == 0) ssb[row0 + rr] = s2; }
          } }
    }
    TSTAMP(0); GSYNC(); TSTAMP(8);

    for (int L = 0; L < NLAYER; ++L) {
#define SS_MIX (SSB + (size_t)(3 * L) * MT)
#define SS_FFN (SSB + (size_t)(3 * L + 1) * MT)
#define SS_PLE (SSB + (size_t)(3 * L + 2) * MT)
#define SS_NEXT (SSB + (size_t)(3 * L + 3) * MT)
        { EpiArgs q{}; q.ss_in = SS_MIX; q.o0 = QKV_;
          q.f_sbk = ARG_OUT + O_SBK_P + (size_t)L * MP * HW; q.f_sbv = ARG_OUT + O_SBV_P + (size_t)L * MP * HW;
          q.f_cbk = ARG_OUT + O_CBK_P + (size_t)L * NBATCH * BANDL * HW; q.f_cbv = ARG_OUT + O_CBV_P + (size_t)L * NBATCH * BANDL * HW;
          pg8::Gemm g{XN_, WPTR(L, W_IN), MP, NQKV, DM}; pg8::StaticOrder S; S.init(MP, NQKV, G, (int)blockIdx.x);
          Epi<EP_QKV> E{q};
          GP1(pg8::gemm_phase<Epi<EP_QKV>, pg8::StaticOrder, true, true>(lds, g, S, E);) TSTAMP(1); }
        { EpiArgs q{}; q.ss_in = SS_MIX; q.o0 = QKV_;
          q.s_sbk = ARG_OUT + O_SBK_S + (size_t)L * MS * HW; q.s_sbv = ARG_OUT + O_SBV_S + (size_t)L * MS * HW;
          q.s_cbk = ARG_OUT + O_CBK_S + (size_t)L * MS * HW; q.s_cbv = ARG_OUT + O_CBV_S + (size_t)L * MS * HW;
          SG(sgemm<EP_QKV, DM>(lds, XN_ + (size_t)MP * DM, WPTR(L, W_IN), NQKV / 32, q);) TSTAMP(7); }
        GSYNC(); TSTAMP(8);
        { AttnArgs A{}; A.L = L;
#ifndef NO_ATTN
          attn_phase(A, lds);
#endif
          TSTAMP(2); }
        GSYNC(); TSTAMP(2);
        { EpiArgs q{}; q.XB = XB_; q.xbase = XN_; q.ss_out = SS_FFN;
          pg8::Gemm g{MIX_, WPTR(L, W_OUT), MP, DM, DM}; pg8::StaticOrder S; S.init(MP, DM, G, (int)blockIdx.x);
          Epi<EP_RES> E{q};
          GP2(pg8::gemm_phase<Epi<EP_RES>, pg8::StaticOrder, true, true>(lds, g, S, E);) TSTAMP(3); }
        { EpiArgs q{}; q.XB = XB_; q.xbase = XN_; q.ss_out = SS_FFN;
          SG(sgemm<EP_RES, DM>(lds, MIX_ + (size_t)MP * DM, WPTR(L, W_OUT), DM / 32, q);) TSTAMP(7); }
        GSYNC(); TSTAMP(8);
        { EpiArgs q{}; q.ss_in = SS_FFN; q.o0 = HB_;
          pg8::Gemm g{XB_, WPTR(L, W_GU), MP, 2 * DFF, DM}; pg8::StaticOrder S; S.init(MP, 2 * DFF, G, (int)blockIdx.x);
          Epi<EP_GU> E{q};
          GP4(pg8::gemm_phase<Epi<EP_GU>, pg8::StaticOrder, true, true>(lds, g, S, E);) TSTAMP(4);
          SG(sgemm<EP_GU, DM>(lds, XB_ + (size_t)MP * DM, WPTR(L, W_GU), DFF / 32, q);) TSTAMP(7); }
        { EpiArgs q2{}; q2.o0 = PBUF_;
          int kp = PLED; asm volatile("" : "+s"(kp));
          const int Gh = G >> 1;
          if ((int)blockIdx.x >= Gh) {
            pg8::Gemm g2{PB_ + (size_t)L * MT * PLED, WPTR(L, W_PP), MP, DM, kp}; pg8::StaticOrder S; S.init(MP, DM, G - Gh, (int)blockIdx.x - Gh);
            Epi<EP_P> E2{q2};
            GP3(pg8::gemm_phase<Epi<EP_P>, pg8::StaticOrder, true, true>(lds, g2, S, E2);) TSTAMP(10);
          }
          SG(sgemm<EP_P, PLED>(lds, PB_ + ((size_t)L * MT + MP) * PLED, WPTR(L, W_PP), DM / 32, q2);) TSTAMP(7); }
        GSYNC(); TSTAMP(8);
        { EpiArgs q{}; q.XB = XB_; q.xbase = XB_; q.ss_out = SS_PLE;
          pg8::Gemm g{HB_, WPTR(L, W_DOWN), MP, DM, DFF}; pg8::StaticOrder S; S.init(MP, DM, G, (int)blockIdx.x);
          Epi<EP_RES> E{q};
          GP5(pg8::gemm_phase<Epi<EP_RES>, pg8::StaticOrder, true, true>(lds, g, S, E);) TSTAMP(5);
          SG(sgemm<EP_RES, DFF>(lds, HB_ + (size_t)MP * DFF, WPTR(L, W_DOWN), DM / 32, q);) TSTAMP(7); }
        GSYNC(); TSTAMP(8);
        { EpiArgs q{}; q.XB = XN_  ; q.P = PBUF_; q.xbase = XB_; q.ss_in = SS_PLE; q.ss_out = SS_NEXT;
          pg8::Gemm g{XB_, WPTR(L, W_PG), MP, DM, DM}; pg8::StaticOrder S; S.init(MP, DM, G, (int)blockIdx.x);
          Epi<EP_PLE> E{q};
          GP6(pg8::gemm_phase<Epi<EP_PLE>, pg8::StaticOrder, true, true>(lds, g, S, E);) TSTAMP(6);
          SG(sgemm<EP_PLE, DM>(lds, XB_ + (size_t)MP * DM, WPTR(L, W_PG), DM / 32, q);) TSTAMP(7); }
        GSYNC(); TSTAMP(8);
    }
    {
        const int tid = fresh_tid(), lane = tid & 63, wave = __builtin_amdgcn_readfirstlane(tid >> 6);
        const int gw = blockIdx.x * NWAVES + wave, NGW = G * NWAVES;
        const float* ssf = SSB + (size_t)(3 * NLAYER) * MT; const float* gf = ARG(21); const bf16_t* XN = XN_; float* out = ARG_OUT;
        for (int row0 = 2 * gw; row0 < MT; row0 += 2 * NGW) {
            u32x2 xv[2][4];
#pragma unroll
            for (int rr = 0; rr < 2; ++rr)
#pragma unroll
                for (int j = 0; j < 4; ++j) xv[rr][j] = *((const u32x2*)(XN + (size_t)(row0 + rr) * DM) + lane + 64 * j);
#pragma unroll
            for (int rr = 0; rr < 2; ++rr) { const int row = row0 + rr; const float rs = rstd_of(ssf[row]);
                float* dst = row < MP ? out + O_YP + (size_t)row * DM : out + O_YS + (size_t)(row - MP) * DM;
#pragma unroll
                for (int j = 0; j < 4; ++j) { const f32x4 gv = *((const f32x4*)gf + lane + 64 * j); const u32x2 w = xv[rr][j];
                    const f32x4 v = {bf_lo(w.x), bf_hi(w.x), bf_lo(w.y), bf_hi(w.y)};
                    __builtin_nontemporal_store(v * rs * gv, (f32x4*)dst + lane + 64 * j); } }
        }
    }
#if PROBE_SEL >= 0
    TSTAMP(11); grid.sync();
    if (blockIdx.x == 0 && fresh_tid() == 0) { const unsigned long long* tsb = WS_PTR(unsigned long long, WS_CTL + 4096); float* o = ARG_OUT + O_YS; unsigned long long tv = 0; if (PROBE_SEL == 20) tv = tsb[16+1] + tsb[16+3] + tsb[16+10] + tsb[16+4] + tsb[16+5] + tsb[16+6]; else if (PROBE_SEL == 21) tv = tsb[16+0] + tsb[16+11]; else if (PROBE_SEL < 16) tv = tsb[16 + PROBE_SEL]; o[0] += (float)tv * 2.5e-5f; }
#endif
}

extern "C" void kernel_launch(void* const* d_in, const int* in_sizes, int n_in, void* d_out, int out_size, void* d_ws, size_t ws_size, hipStream_t stream) {
    static int grid = 0;
    if (grid == 0) {
        int dev = 0, cus = 0, per_cu = 0;
        hipGetDevice(&dev);
        hipDeviceGetAttribute(&cus, hipDeviceAttributeMultiprocessorCount, dev);
        hipFuncSetAttribute((const void*)hymba_fwd, hipFuncAttributeMaxDynamicSharedMemorySize, LDS_BYTES);
        hipOccupancyMaxActiveBlocksPerMultiprocessor(&per_cu, (const void*)hymba_fwd, NTHREADS, LDS_BYTES);
        if (per_cu < 1) per_cu = 1;
        grid = cus * per_cu;
        if (n_in != 22 || ws_size < WS_END) { fprintf(stderr, "kernel_launch: unexpected n_in %d / ws_size %zu\n", n_in, ws_size); }
    }
    Args a{};
    for (int i = 0; i < 22; ++i) a.in[i] = (const float*)d_in[i];
    a.out = (float*)d_out; a.ws = (unsigned char*)d_ws;
    void* kargs[] = {&a};
    hipError_t e = hipLaunchCooperativeKernel((const void*)hymba_fwd, dim3(grid), dim3(NTHREADS), kargs, LDS_BYTES, stream);
    if (e != hipSuccess) fprintf(stderr, "cooperative launch failed: %s (grid %d)\n", hipGetErrorString(e), grid);
}
```

```cpp
#include <hip/hip_runtime.h>
#include <hip/hip_cooperative_groups.h>
#include <cstdio>
#include <cstdint>
namespace cg = cooperative_groups;
__device__ __forceinline__ int fresh_tid() { int t = threadIdx.x; asm volatile("" : "+v"(t)); return t; }
namespace pg8 {
#define PG8_LAS __attribute__((address_space(3)))
typedef unsigned short bf16_t;
typedef short bf16x8 __attribute__((ext_vector_type(8)));
typedef float f32x4 __attribute__((ext_vector_type(4)));
typedef unsigned u32x4 __attribute__((ext_vector_type(4)));
constexpr int BM = 256, BK = 64, HALF = 128, HTB = HALF * BK * 2  , STAGE_BYTES = 8 * HTB, NXCD = 8, WGM = 8;

__host__ __device__ __forceinline__ int lds_byte(int r, int c) { const int st = (r >> 4) * 2 + (c >> 5), rr = r & 15, cc = c & 31, ob = rr * 64 + cc * 2; return st * 1024 + (ob ^ (((ob >> 9) & 1) << 5)); }
__host__ __device__ __forceinline__ void stage_rc(int b, int& R, int& C) { const int st = b / 1024, sb = b % 1024, swz = sb ^ (((sb >> 9) & 1) << 5); R = (st >> 1) * 16 + swz / 64; C = (st & 1) * 32 + (swz % 64) / 2; }
__host__ __device__ __forceinline__ int perm32(int rho) { const int n = rho >> 4, i = rho & 15; return 8 * (i >> 2) + 4 * n + (i & 3); }

struct Unit { int pm, pn; };
struct Gemm { const bf16_t* A; const bf16_t* Bt; int M, N, K; };

struct StaticOrder {
    int nM, nN, nwg, G, c;
    __host__ __device__ void init(int M, int N, int G_, int c_) { nM = M / BM; nN = N / BM; nwg = nM * nN; G = G_; c = c_; }
    __host__ __device__ bool next(int i, Unit& u) const {
        const long L = (long)i * G + c; if (L >= nwg) return false;
        int wgid = (int)L; { const int q = nwg / NXCD, r = nwg % NXCD, xcd = wgid % NXCD, off = wgid / NXCD; wgid = (xcd < r ? xcd * (q + 1) : r * (q + 1) + (xcd - r) * q) + off; }
        const int nig = WGM * nN, gid = wgid / nig, fm = gid * WGM, gsz = (nM - fm) < WGM ? (nM - fm) : WGM;
        u.pm = fm + ((wgid % nig) % gsz); u.pn = (wgid % nig) / gsz; return true;
    }
    __device__ __forceinline__ void a_ready(const Unit&) const {}
    __device__ __forceinline__ void done(const Unit&) const {}
};

template <class Epi, class Sched, bool ALIGN_EPI = false, bool SP2 = false>
__device__ __forceinline__ void gemm_phase(PG8_LAS unsigned char* lds, const Gemm g, const Sched& S, const Epi& E) {
    const int tid = fresh_tid(), wid = __builtin_amdgcn_readfirstlane(tid >> 6), lane = tid & 63, wr = wid >> 2, wc = wid & 3, fr = lane & 15, fq = lane >> 4;
    const int K = g.K, nt = K / BK;
    unsigned voffA[2], voffB[2];
#pragma unroll
    for (int i = 0; i < 2; ++i) { int R, C; stage_rc(tid * 16 + i * 8192, R, C); const int Rb = Epi::PERM ? ((R & ~31) + perm32(R & 31)) : R;
        voffA[i] = (unsigned)(R * K + C) * 2u; voffB[i] = (unsigned)(Rb * K + C) * 2u; }
    const size_t kstep = (size_t)(BK * 2);
    const size_t hstep = (size_t)HALF * K * 2;
    const size_t tstep = 2 * hstep;
    const unsigned ldsw = (unsigned)wid * 1024u;
    const int aoff = lds_byte(wr * 64 + fr, fq * 8), boff = lds_byte(wc * 32 + fr, fq * 8);
#define PG8_SA(b, h) (((b) * 2 + (h)) * HTB)
#define PG8_SB(b, h) ((4 + (b) * 2 + (h)) * HTB)
#define PG8_STAGE(bufoff, gbase, voff) do { _Pragma("unroll") for (int _i = 0; _i < 2; ++_i) \
        __builtin_amdgcn_global_load_lds((const unsigned*)((const char*)(gbase) + (voff)[_i]), (PG8_LAS unsigned*)(lds + (bufoff) + ldsw + _i * 8192), 16, 0, 0); } while (0)
#define PG8_LDA(dst, b, h) do { _Pragma("unroll") for (int m = 0; m < 4; ++m) _Pragma("unroll") for (int k = 0; k < 2; ++k) dst[m][k] = *(const PG8_LAS bf16x8*)(lds + PG8_SA(b, h) + aoff + m * 2048 + k * 1024); } while (0)
#define PG8_LDB(dst, b, h) do { _Pragma("unroll") for (int n = 0; n < 2; ++n) _Pragma("unroll") for (int k = 0; k < 2; ++k) dst[n][k] = *(const PG8_LAS bf16x8*)(lds + PG8_SB(b, h) + boff + n * 2048 + k * 1024); } while (0)
#define PG8_MMA(ai, bj, At, Bt) do { __builtin_amdgcn_s_setprio(1); _Pragma("unroll") for (int m = 0; m < 4; ++m) _Pragma("unroll") for (int n = 0; n < 2; ++n) _Pragma("unroll") for (int k = 0; k < 2; ++k) \
        acc[ai][bj][m][n] = __builtin_amdgcn_mfma_f32_16x16x32_bf16(Bt[n][k], At[m][k], acc[ai][bj][m][n], 0, 0, 0); __builtin_amdgcn_s_setprio(0); } while (0)
#define PG8_WAIT_V(n) asm volatile("s_waitcnt vmcnt(" #n ")" ::: "memory")
#define PG8_WAIT_L(n) asm volatile("s_waitcnt lgkmcnt(" #n ")" ::: "memory")
#define PG8_BAR __builtin_amdgcn_s_barrier()
#define PG8_SCHED __builtin_amdgcn_sched_barrier(0)
    Unit cur, nxt; int ui = 0;
    if (!S.next(0, cur)) return;
    f32x4 acc[2][2][4][2];
#pragma unroll
    for (int a = 0; a < 2; ++a)
#pragma unroll
        for (int b = 0; b < 2; ++b)
#pragma unroll
            for (int m = 0; m < 4; ++m)
#pragma unroll
                for (int n = 0; n < 2; ++n) acc[a][b][m][n] = (f32x4){0.f, 0.f, 0.f, 0.f};
    bf16x8 At[4][2], B0[2][2], B1[2][2];
    const char* cA = (const char*)g.A + (size_t)cur.pm * tstep; const char* cB = (const char*)g.Bt + (size_t)cur.pn * tstep;
    S.a_ready(cur);
    if constexpr (SP2) {
        PG8_STAGE(PG8_SB(0, 0), cB, voffB); PG8_STAGE(PG8_SB(0, 1), cB + hstep, voffB); PG8_STAGE(PG8_SA(0, 0), cA, voffA); PG8_STAGE(PG8_SA(0, 1), cA + hstep, voffA);
        if (wr == 1) PG8_BAR;
        PG8_WAIT_V(2); PG8_BAR;
        PG8_STAGE(PG8_SB(1, 0), cB + kstep, voffB); PG8_STAGE(PG8_SA(1, 0), cA + kstep, voffA); PG8_STAGE(PG8_SB(1, 1), cB + hstep + kstep, voffB);
        PG8_WAIT_V(6); PG8_BAR;
    } else {
        PG8_STAGE(PG8_SB(0, 0), cB, voffB); PG8_STAGE(PG8_SA(0, 0), cA, voffA); PG8_STAGE(PG8_SB(0, 1), cB + hstep, voffB); PG8_STAGE(PG8_SA(0, 1), cA + hstep, voffA);
        if (wr == 1) PG8_BAR;
        PG8_WAIT_V(4); PG8_BAR;
        PG8_STAGE(PG8_SB(1, 0), cB + kstep, voffB); PG8_STAGE(PG8_SA(1, 0), cA + kstep, voffA); PG8_STAGE(PG8_SB(1, 1), cB + hstep + kstep, voffB);
        PG8_WAIT_V(6); PG8_BAR;
    }
    for (;;) {
        const bool has_next = S.next(ui + 1, nxt);
        const char* nA = has_next ? (const char*)g.A + (size_t)nxt.pm * tstep : cA; const char* nB = has_next ? (const char*)g.Bt + (size_t)nxt.pn * tstep : cB;
        for (int t = 0; t < nt; t += 2) {
            const bool last = (t == nt - 2);
            const char* a1 = cA + (size_t)(t + 1) * kstep;
            const char* a2 = last ? nA : cA + (size_t)(t + 2) * kstep; const char* b2 = last ? nB : cB + (size_t)(t + 2) * kstep;
            const char* a3 = a2 + kstep; const char* b3 = b2 + kstep;
            if (last && has_next) S.a_ready(nxt);
            if constexpr (SP2) {
            PG8_LDB(B0, 0, 0); PG8_LDB(B1, 0, 1); PG8_SCHED; PG8_LDA(At, 0, 0); PG8_STAGE(PG8_SA(1, 1), a1 + hstep, voffA);
            PG8_WAIT_V(8); PG8_WAIT_L(0); PG8_BAR; PG8_MMA(0, 0, At, B0); PG8_MMA(0, 1, At, B1); PG8_BAR; PG8_SCHED;
            PG8_LDA(At, 0, 1); PG8_STAGE(PG8_SB(0, 0), b2, voffB); PG8_STAGE(PG8_SB(0, 1), b2 + hstep, voffB); PG8_STAGE(PG8_SA(0, 0), a2, voffA);
            PG8_WAIT_V(8); PG8_WAIT_L(0); PG8_BAR; PG8_MMA(1, 0, At, B0); PG8_MMA(1, 1, At, B1); PG8_BAR; PG8_SCHED;
            PG8_LDB(B0, 1, 0); PG8_LDB(B1, 1, 1); PG8_SCHED; PG8_LDA(At, 1, 0); PG8_STAGE(PG8_SA(0, 1), a2 + hstep, voffA);
            PG8_WAIT_V(8); PG8_WAIT_L(0); PG8_BAR; PG8_MMA(0, 0, At, B0); PG8_MMA(0, 1, At, B1); PG8_BAR; PG8_SCHED;
            PG8_LDA(At, 1, 1); PG8_STAGE(PG8_SB(1, 0), b3, voffB); PG8_STAGE(PG8_SB(1, 1), b3 + hstep, voffB); PG8_STAGE(PG8_SA(1, 0), a3, voffA);
            PG8_WAIT_V(8); PG8_WAIT_L(0); PG8_BAR; PG8_MMA(1, 0, At, B0); PG8_MMA(1, 1, At, B1); PG8_BAR; PG8_SCHED;
            } else {
            PG8_LDB(B0, 0, 0); PG8_SCHED; PG8_LDA(At, 0, 0); PG8_STAGE(PG8_SA(1, 1), a1 + hstep, voffA);
            PG8_WAIT_L(8); PG8_BAR; PG8_WAIT_L(0); PG8_MMA(0, 0, At, B0); PG8_BAR; PG8_SCHED;
            PG8_LDB(B1, 0, 1); PG8_STAGE(PG8_SB(0, 0), b2, voffB);
            PG8_BAR; PG8_WAIT_L(0); PG8_MMA(0, 1, At, B1); PG8_BAR;
            PG8_LDA(At, 0, 1); PG8_STAGE(PG8_SA(0, 0), a2, voffA);
            PG8_BAR; PG8_WAIT_L(0); PG8_MMA(1, 0, At, B0); PG8_BAR; PG8_SCHED;
            PG8_STAGE(PG8_SB(0, 1), b2 + hstep, voffB);
            PG8_WAIT_V(6); PG8_BAR; PG8_MMA(1, 1, At, B1); PG8_BAR;
            PG8_LDB(B0, 1, 0); PG8_SCHED; PG8_LDA(At, 1, 0); PG8_STAGE(PG8_SA(0, 1), a2 + hstep, voffA);
            PG8_WAIT_L(8); PG8_BAR; PG8_WAIT_L(0); PG8_MMA(0, 0, At, B0); PG8_BAR; PG8_SCHED;
            PG8_LDB(B1, 1, 1); PG8_STAGE(PG8_SB(1, 0), b3, voffB);
            PG8_BAR; PG8_WAIT_L(0); PG8_MMA(0, 1, At, B1); PG8_BAR;
            PG8_LDA(At, 1, 1); PG8_STAGE(PG8_SA(1, 0), a3, voffA);
            PG8_BAR; PG8_WAIT_L(0); PG8_MMA(1, 0, At, B0); PG8_BAR; PG8_SCHED;
            PG8_STAGE(PG8_SB(1, 1), b3 + hstep, voffB);
            PG8_WAIT_V(6); PG8_BAR; PG8_MMA(1, 1, At, B1); PG8_BAR;
            }
        }
        if constexpr (ALIGN_EPI) { if (wr == 0) PG8_BAR; }
        if constexpr (!Epi::AFTER_DRAIN) { E(acc, cur, wr, wc, fr, fq); S.done(cur); }
        if (!has_next) break;
#pragma unroll
        for (int a = 0; a < 2; ++a)
#pragma unroll
            for (int b = 0; b < 2; ++b)
#pragma unroll
                for (int m = 0; m < 4; ++m)
#pragma unroll
                    for (int n = 0; n < 2; ++n) acc[a][b][m][n] = (f32x4){0.f, 0.f, 0.f, 0.f};
        cur = nxt; cA = nA; cB = nB; ++ui;
        if constexpr (ALIGN_EPI) { if (wr == 1) PG8_BAR; }
    }
    PG8_WAIT_V(0);
    if constexpr (!ALIGN_EPI) { if (wr == 0) PG8_BAR; }
    PG8_BAR;
    if constexpr (Epi::AFTER_DRAIN) { E.fused(acc, cur, wr, wc, fr, fq, lds, wid, lane); S.done(cur); }
#undef PG8_SA
#undef PG8_SB
#undef PG8_STAGE
#undef PG8_LDA
#undef PG8_LDB
#undef PG8_MMA
#undef PG8_WAIT_V
#undef PG8_WAIT_L
#undef PG8_BAR
#undef PG8_SCHED
}
}

#define LAS __attribute__((address_space(3)))
using pg8::bf16_t; using pg8::bf16x8; using pg8::f32x4; using pg8::u32x4;
typedef short s16x4 __attribute__((ext_vector_type(4)));
typedef float f32x16 __attribute__((ext_vector_type(16)));
typedef unsigned u32x2 __attribute__((ext_vector_type(2)));
typedef float f32x2_t __attribute__((ext_vector_type(2)));
typedef __bf16 bf16x2_t __attribute__((ext_vector_type(2)));

constexpr int DM = 1024, SEQ = 2048, NBATCH = 8, MP = NBATCH * SEQ, DSEQ = 16, MS = NBATCH * DSEQ, MT = MP + MS;
constexpr int DFF = 2816, NQKV = 3072, PLED = 256, NLAYER = 2, PAST = 2048, BANDL = 512, HW = 512;
constexpr float EPS = 1e-6f, LOG2E = 1.4426950408889634f, QSCALE = 0.125f * LOG2E;
#ifndef SB_EARLY
#define SB_EARLY 1
#endif
constexpr float SB_THR = 7.5e-37f;

constexpr size_t MiB = 1u << 20;
constexpr size_t WS_CTL = 0, WS_SS = 64 * 1024;
constexpr size_t WS_W = 2 * MiB, W_LSTRIDE = 28 * MiB, W_IN = 0, W_OUT = 6 * MiB, W_GU = 8 * MiB, W_DOWN = 19 * MiB, W_PG = 25 * MiB, W_PP = 27 * MiB;
constexpr size_t WS_PB = 58 * MiB, WS_X = 76 * MiB  , WS_XB = 142 * MiB, WS_QKV = 176 * MiB, WS_MIX = 274 * MiB, WS_P = 308 * MiB, WS_END = 342 * MiB;
constexpr int LDS_BYTES = 131072 + 1024;
constexpr size_t WS_BAR = 8192;
constexpr int NWAVES = 8, NTHREADS = 512;

constexpr size_t O_YP = 0, O_YS = (size_t)MP * DM, O_SBK_P = O_YS + (size_t)MS * DM, O_SBV_P = O_SBK_P + (size_t)NLAYER * MP * HW,
                 O_CBK_P = O_SBV_P + (size_t)NLAYER * MP * HW, O_CBV_P = O_CBK_P + (size_t)NLAYER * NBATCH * BANDL * HW,
                 O_SBK_S = O_CBV_P + (size_t)NLAYER * NBATCH * BANDL * HW, O_SBV_S = O_SBK_S + (size_t)NLAYER * MS * HW,
                 O_CBK_S = O_SBV_S + (size_t)NLAYER * MS * HW, O_CBV_S = O_CBK_S + (size_t)NLAYER * MS * HW;

__device__ __forceinline__ unsigned pk2(float lo, float hi) { f32x2_t v = {lo, hi}; bf16x2_t b = __builtin_convertvector(v, bf16x2_t); return __builtin_bit_cast(unsigned, b); }
__device__ __forceinline__ float bf_lo(unsigned w) { return __uint_as_float(w << 16); }
__device__ __forceinline__ float bf_hi(unsigned w) { return __uint_as_float(w & 0xffff0000u); }
__device__ __forceinline__ float partner32(float v) {
    auto rr = __builtin_amdgcn_permlane32_swap(__float_as_uint(v), __float_as_uint(v), false, false);
    return (threadIdx.x & 32) ? __uint_as_float(rr[0]) : __uint_as_float(rr[1]);
}
__device__ __forceinline__ float wave_sum(float v) {
#pragma unroll
    for (int o = 1; o < 64; o <<= 1) v += __shfl_xor(v, o);
    return v;
}
__device__ __forceinline__ float rstd_of(float ss) { return rsqrtf(ss * (1.0f / DM) + EPS); }

template <int I> __device__ __forceinline__ const float* argp() {
    unsigned long long v; const void* ka = (const void*)__builtin_amdgcn_kernarg_segment_ptr();
    asm volatile("s_load_dwordx2 %0, %1, %2\n\ts_waitcnt lgkmcnt(0)" : "=s"(v) : "s"(ka), "i"(I * 8) : "memory");
    return (const float*)(const __attribute__((address_space(1))) float*)v;
}
#define ARG(i) argp<i>()
#define ARG_OUT ((float*)argp<22>())
#define ARG_WS ((unsigned char*)argp<23>())
#define WS_PTR(T, off) ((T*)(ARG_WS + (off)))
#define SSB WS_PTR(float, WS_SS)
#define PB_ WS_PTR(bf16_t, WS_PB)
#define XN_ WS_PTR(bf16_t, WS_X)
#define XB_ WS_PTR(bf16_t, WS_XB)
#define QKV_ WS_PTR(bf16_t, WS_QKV)
#define HB_ WS_PTR(bf16_t, WS_QKV)
#define MIX_ WS_PTR(bf16_t, WS_MIX)
#define PBUF_ WS_PTR(bf16_t, WS_P)
#define WPTR(L, off) ((const bf16_t*)(ARG_WS + WS_W + (size_t)(L) * W_LSTRIDE + (off)))

enum { EP_QKV = 0, EP_RES = 1, EP_GU = 2, EP_P = 3, EP_PLE = 4 };
struct EpiArgs {
    const float* ss_in; float* ss_out;
    const bf16_t* xbase;
    bf16_t* XB; bf16_t* o0; const bf16_t* P;
    float *f_sbk, *f_sbv, *f_cbk, *f_cbv;
    float *s_sbk, *s_sbv, *s_cbk, *s_cbv;
};
template <int MODE> struct Epi {
    static constexpr bool PERM = false, AFTER_DRAIN = false;
    EpiArgs a;
    __device__ __forceinline__ void operator()(const f32x4 (&acc)[2][2][4][2], const pg8::Unit& u, int wr, int wc, int fr, int fq) const {
        if constexpr (MODE == EP_QKV) {
            const int part = u.pn >> 1, cb = (u.pn & 1) * 256 + wc * 32 + 4 * fq;
            bf16_t* ob = a.o0 + (size_t)part * ((size_t)MT * HW);
            float* fo = part == 1 ? a.f_sbk : part == 2 ? a.f_sbv : part == 4 ? a.f_cbk : part == 5 ? a.f_cbv : nullptr;
            const bool band = part >= 4; const float qs = (part == 0 || part == 3) ? QSCALE : 1.f;
#pragma unroll
            for (int ai = 0; ai < 2; ++ai)
#pragma unroll
                for (int m = 0; m < 4; ++m) {
                    const int row = u.pm * 256 + ai * 128 + wr * 64 + m * 16 + fr;
                    const float rs = rstd_of(a.ss_in[row]) * qs;
                    const int t = row & (SEQ - 1);
                    float* frow = nullptr;
                    if (fo) { if (!band) frow = fo + (size_t)row * HW; else if (t >= SEQ - BANDL) frow = fo + ((size_t)(row >> 11) * BANDL + (t - (SEQ - BANDL))) * HW; }
#pragma unroll
                    for (int bj = 0; bj < 2; ++bj)
#pragma unroll
                        for (int n = 0; n < 2; ++n) {
                            const int col = cb + bj * 128 + n * 16; const f32x4 v = acc[ai][bj][m][n] * rs;
                            u32x2 w; w.x = pk2(v[0], v[1]); w.y = pk2(v[2], v[3]);
                            *(u32x2*)(ob + (size_t)row * HW + col) = w;
                            if (frow) __builtin_nontemporal_store(v, (f32x4*)(frow + col));
                        }
                }
        } else if constexpr (MODE == EP_RES || MODE == EP_PLE) {
#pragma unroll
            for (int ai = 0; ai < 2; ++ai)
#pragma unroll
                for (int m = 0; m < 4; ++m) {
                    const int row = u.pm * 256 + ai * 128 + wr * 64 + m * 16 + fr;
                    float rs = 0.f; if constexpr (MODE == EP_PLE) rs = rstd_of(a.ss_in[row]) * (-LOG2E);
                    float s = 0.f;
#pragma unroll
                    for (int bj = 0; bj < 2; ++bj)
#pragma unroll
                        for (int n = 0; n < 2; ++n) {
                            const size_t off = (size_t)row * DM + u.pn * 256 + bj * 128 + wc * 32 + n * 16 + 4 * fq;
                            const u32x2 xw = *(const u32x2*)(a.xbase + off); f32x4 x = {bf_lo(xw.x), bf_hi(xw.x), bf_lo(xw.y), bf_hi(xw.y)}; const f32x4 c = acc[ai][bj][m][n];
                            if constexpr (MODE == EP_RES) x += c;
                            else { const u32x2 pw = *(const u32x2*)(a.P + off);
                                   x[0] += bf_lo(pw.x) * __builtin_amdgcn_rcpf(1.f + __builtin_amdgcn_exp2f(c[0] * rs));
                                   x[1] += bf_hi(pw.x) * __builtin_amdgcn_rcpf(1.f + __builtin_amdgcn_exp2f(c[1] * rs));
                                   x[2] += bf_lo(pw.y) * __builtin_amdgcn_rcpf(1.f + __builtin_amdgcn_exp2f(c[2] * rs));
                                   x[3] += bf_hi(pw.y) * __builtin_amdgcn_rcpf(1.f + __builtin_amdgcn_exp2f(c[3] * rs)); }
                            u32x2 w; w.x = pk2(x[0], x[1]); w.y = pk2(x[2], x[3]); *(u32x2*)(a.XB + off) = w;
                            s += (x[0] * x[0] + x[1] * x[1]) + (x[2] * x[2] + x[3] * x[3]);
                        }
                    s += __shfl_xor(s, 16); s += __shfl_xor(s, 32);
                    if (fq == 0) unsafeAtomicAdd(a.ss_out + row, s);
                }
        } else if constexpr (MODE == EP_GU) {
#pragma unroll
            for (int ai = 0; ai < 2; ++ai)
#pragma unroll
                for (int m = 0; m < 4; ++m) {
                    const int row = u.pm * 256 + ai * 128 + wr * 64 + m * 16 + fr;
                    const float rs = rstd_of(a.ss_in[row]);
#pragma unroll
                    for (int n = 0; n < 2; ++n) {
                        const int col = u.pn * 128 + wc * 32 + n * 16 + 4 * fq;
                        const f32x4 g = acc[ai][0][m][n] * rs, up = acc[ai][1][m][n] * rs; float h[4];
#pragma unroll
                        for (int e = 0; e < 4; ++e) h[e] = g[e] * up[e] * __builtin_amdgcn_rcpf(1.f + __builtin_amdgcn_exp2f(-LOG2E * g[e]));
                        u32x2 w; w.x = pk2(h[0], h[1]); w.y = pk2(h[2], h[3]);
                        *(u32x2*)(a.o0 + (size_t)row * DFF + col) = w;
                    }
                }
        } else {
#pragma unroll
            for (int ai = 0; ai < 2; ++ai)
#pragma unroll
                for (int m = 0; m < 4; ++m) {
                    const int row = u.pm * 256 + ai * 128 + wr * 64 + m * 16 + fr;
#pragma unroll
                    for (int bj = 0; bj < 2; ++bj)
#pragma unroll
                        for (int n = 0; n < 2; ++n) {
                            const size_t off = (size_t)row * DM + u.pn * 256 + bj * 128 + wc * 32 + n * 16 + 4 * fq; const f32x4 v = acc[ai][bj][m][n];
                            u32x2 w; w.x = pk2(v[0], v[1]); w.y = pk2(v[2], v[3]); *(u32x2*)(a.o0 + off) = w;
                        }
                }
        }
    }
};

template <int MODE, int K>
__device__ __forceinline__ void sgemm(LAS unsigned char* lds, const bf16_t* A, const bf16_t* Bt, int ncol32, const EpiArgs& a) {
    const int tid = fresh_tid(), lane = tid & 63, wave = __builtin_amdgcn_readfirstlane(tid >> 6), r = lane & 31, hh = lane >> 5;
    LAS float* red = (LAS float*)lds;
    constexpr int K8 = K >> 3, NK = K8 / 16, UB = NK > 11 ? 11 : NK;
    static_assert(NK % UB == 0, "sgemm: K split");
    const int G = gridDim.x, nunits = 4 * ncol32;
    for (int j = G - 1 - (int)blockIdx.x; j < nunits; j += G) {
        const int rb = j & 3, c0 = 32 * (j >> 2);
        const int brow0 = (MODE == EP_GU) ? ((c0 >> 7) * 256 + (c0 & 127)) : c0;
        const bf16_t* ap = A + (size_t)(32 * rb + r) * K + wave * K8 + 8 * hh;
        const bf16_t* bp = Bt + (size_t)(brow0 + r) * K + wave * K8 + 8 * hh;
        f32x16 acc0 = {}, acc1 = {};
#pragma unroll 1
        for (int kb = 0; kb < NK; kb += UB) {
            bf16x8 af[UB], bf[UB], bf2[MODE == EP_GU ? UB : 1];
#pragma unroll
            for (int i = 0; i < UB; ++i) { af[i] = *(const bf16x8*)(ap + (kb + i) * 16); bf[i] = *(const bf16x8*)(bp + (kb + i) * 16);
                if constexpr (MODE == EP_GU) bf2[i] = *(const bf16x8*)(bp + (size_t)128 * K + (kb + i) * 16); }
#pragma unroll
            for (int i = 0; i < UB; ++i) { acc0 = __builtin_amdgcn_mfma_f32_32x32x16_bf16(af[i], bf[i], acc0, 0, 0, 0);
                if constexpr (MODE == EP_GU) acc1 = __builtin_amdgcn_mfma_f32_32x32x16_bf16(af[i], bf2[i], acc1, 0, 0, 0); }
        }
#pragma unroll
        for (int i = 0; i < 16; ++i) { red[(wave * 16 + i) * 64 + lane] = acc0[i]; if constexpr (MODE == EP_GU) red[8192 + (wave * 16 + i) * 64 + lane] = acc1[i]; }
        __syncthreads();
        const int col = c0 + r;
#pragma unroll
        for (int ii = 0; ii < 2; ++ii) {
            const int i = 2 * wave + ii;
            float v0 = 0.f, v1 = 0.f;
#pragma unroll
            for (int w = 0; w < 8; ++w) { v0 += red[(w * 16 + i) * 64 + lane]; if constexpr (MODE == EP_GU) v1 += red[8192 + (w * 16 + i) * 64 + lane]; }
            const int rs_ = 32 * rb + (i & 3) + 8 * (i >> 2) + 4 * hh, row = MP + rs_;
            if constexpr (MODE == EP_QKV) {
                const int part = c0 >> 9, cc = col & 511;
                const float v = v0 * rstd_of(a.ss_in[row]);
                const float qs = (part == 0 || part == 3) ? QSCALE : 1.f;
                (a.o0 + (size_t)part * ((size_t)MT * HW))[(size_t)row * HW + cc] = (bf16_t)(pk2(v * qs, 0.f) & 0xffffu);
                float* fo = part == 1 ? a.s_sbk : part == 2 ? a.s_sbv : part == 4 ? a.s_cbk : part == 5 ? a.s_cbv : nullptr;
                if (fo) fo[(size_t)rs_ * HW + cc] = v;
            } else if constexpr (MODE == EP_RES || MODE == EP_PLE) {
                const size_t off = (size_t)row * DM + col;
                float x = __uint_as_float((unsigned)a.xbase[off] << 16);
                if constexpr (MODE == EP_RES) x += v0;
                else { const float pv = __uint_as_float((unsigned)a.P[off] << 16); x += pv * __builtin_amdgcn_rcpf(1.f + __builtin_amdgcn_exp2f(-LOG2E * v0 * rstd_of(a.ss_in[row]))); }
                a.XB[off] = (bf16_t)(pk2(x, 0.f) & 0xffffu);
                float s = x * x;
                s += __shfl_xor(s, 1); s += __shfl_xor(s, 2); s += __shfl_xor(s, 4); s += __shfl_xor(s, 8); s += __shfl_xor(s, 16);
                if (r == 0) unsafeAtomicAdd(a.ss_out + row, s);
            } else if constexpr (MODE == EP_GU) {
                const float rs = rstd_of(a.ss_in[row]); const float g = v0 * rs, up = v1 * rs;
                const float h = g * up * __builtin_amdgcn_rcpf(1.f + __builtin_amdgcn_exp2f(-LOG2E * g));
                a.o0[(size_t)row * DFF + col] = (bf16_t)(pk2(h, 0.f) & 0xffffu);
            } else {
                a.o0[(size_t)row * DM + col] = (bf16_t)(pk2(v0, 0.f) & 0xffffu);
            }
        }
        __syncthreads();
    }
}
struct AttnArgs { int L; };
constexpr int AW_V = 0, AW_ST = 4096, AW_BIAS = 8704, AW_BYTES = 10240, ST_PITCH = 144;

template <bool F32> __device__ __forceinline__ void ld_k(bf16x8 (&kf)[4], const void* base, size_t off) {
    if constexpr (!F32) { const bf16_t* p = (const bf16_t*)base + off;
#pragma unroll
        for (int kk = 0; kk < 4; ++kk) kf[kk] = *(const bf16x8*)(p + 8 * kk);
    } else { const float* p = (const float*)base + off;
#pragma unroll
        for (int kk = 0; kk < 4; ++kk) { const f32x4 x = *(const f32x4*)(p + 8 * kk), y = *(const f32x4*)(p + 8 * kk + 4);
            u32x4 w; w.x = pk2(x[0], x[1]); w.y = pk2(x[2], x[3]); w.z = pk2(y[0], y[1]); w.w = pk2(y[2], y[3]); kf[kk] = __builtin_bit_cast(bf16x8, w); }
    }
}
template <bool F32> __device__ __forceinline__ void ld_v(u32x4 (&vr)[4], const void* base, size_t row0, int nvalid, int h, int lane) {
#pragma unroll
    for (int i = 0; i < 4; ++i) { int key = 8 * i + (lane >> 3); key = key < nvalid ? key : nvalid - 1;
        const size_t off = (row0 + key) * HW + h * 64 + (lane & 7) * 8;
        if constexpr (!F32) vr[i] = *(const u32x4*)((const bf16_t*)base + off);
        else { const float* p = (const float*)base + off; const f32x4 x = *(const f32x4*)p, y = *(const f32x4*)(p + 4);
            u32x4 w; w.x = pk2(x[0], x[1]); w.y = pk2(x[2], x[3]); w.z = pk2(y[0], y[1]); w.w = pk2(y[2], y[3]); vr[i] = w; }
    }
}
__device__ __forceinline__ void st_v(LAS unsigned char* vl, const u32x4 (&vr)[4], int lane) {
#pragma unroll
    for (int i = 0; i < 4; ++i) { const int key = 8 * i + (lane >> 3); *(LAS u32x4*)(vl + key * 128 + (((lane & 7) * 16) ^ (((key >> 1) & 1) << 6))) = vr[i]; }
}
typedef short v4i16_t __attribute__((ext_vector_type(4)));
__device__ __forceinline__ s16x4 vtr(LAS unsigned char* p) { return __builtin_bit_cast(s16x4, __builtin_amdgcn_ds_read_tr16_b64_v4i16((LAS v4i16_t*)p)); }
__device__ __forceinline__ void pv_block(f32x16 (&o)[2], LAS unsigned char* vl, const bf16x8 (&pf)[2], int lane) {
    const int q = (lane & 15) >> 2, p = lane & 3, c16 = (lane >> 4) & 1, hh = lane >> 5;
    const int va0 = (4 * hh + q) * 128 + ((32 * c16 + 8 * p) ^ ((q >> 1) << 6));
#pragma unroll
    for (int db = 0; db < 2; ++db)
#pragma unroll
        for (int s = 0; s < 2; ++s) {
            const s16x4 lo = vtr(vl + (va0 ^ (db * 64)) + s * 2048), hi = vtr(vl + (va0 ^ (db * 64)) + s * 2048 + 1024);
            const bf16x8 vf = {lo[0], lo[1], lo[2], lo[3], hi[0], hi[1], hi[2], hi[3]};
            o[db] = __builtin_amdgcn_mfma_f32_32x32x16_bf16(vf, pf[s], o[db], 0, 0, 0);
        }
}
__device__ __forceinline__ f32x16 qk_block(const bf16x8 (&kf)[4], const bf16x8 (&qf)[4]) {
    f32x16 S = {};
#pragma unroll
    for (int kk = 0; kk < 4; ++kk) S = __builtin_amdgcn_mfma_f32_32x32x16_bf16(kf[kk], qf[kk], S, 0, 0, 0);
    return S;
}
__device__ __forceinline__ void sb_block(const f32x16& S, LAS unsigned char* vl, int tq, int keypos0, float& carry, f32x16 (&o)[2], int lane) {
    const int hh = lane >> 5;
    float kp_[16], be[16];
#pragma unroll
    for (int r = 0; r < 16; ++r) {
        const int kp = keypos0 + (r & 3) + 8 * (r >> 2) + 4 * hh; const bool valid = kp < tq;
        const float z = __builtin_amdgcn_fmed3f(S[r], -126.f, 100.f);
        const float t = __builtin_amdgcn_exp2f(z), k = __builtin_amdgcn_rcpf(1.f + t);
        kp_[r] = valid ? k : 1.f; be[r] = valid ? t * k : 0.f;
    }
    float T[4], Tp[4], U[4];
#pragma unroll
    for (int g = 0; g < 4; ++g) { T[g] = (kp_[4 * g] * kp_[4 * g + 1]) * (kp_[4 * g + 2] * kp_[4 * g + 3]); Tp[g] = partner32(T[g]); U[g] = T[g] * Tp[g]; }
    float R[4]; R[3] = 1.f; R[2] = U[3]; R[1] = U[3] * U[2]; R[0] = R[1] * U[1];
    const float tot = R[0] * U[0];
    float w[16];
#pragma unroll
    for (int g = 0; g < 4; ++g) {
        const float b3 = carry * R[g] * (hh == 0 ? Tp[g] : 1.f);
        const float b2 = b3 * kp_[4 * g + 3], b1 = b2 * kp_[4 * g + 2], b0 = b1 * kp_[4 * g + 1];
        w[4 * g + 3] = be[4 * g + 3] * b3; w[4 * g + 2] = be[4 * g + 2] * b2; w[4 * g + 1] = be[4 * g + 1] * b1; w[4 * g + 0] = be[4 * g + 0] * b0;
    }
    carry *= tot;
    bf16x8 pf[2];
#pragma unroll
    for (int s = 0; s < 2; ++s) { u32x4 pw; pw.x = pk2(w[8 * s], w[8 * s + 1]); pw.y = pk2(w[8 * s + 2], w[8 * s + 3]); pw.z = pk2(w[8 * s + 4], w[8 * s + 5]); pw.w = pk2(w[8 * s + 6], w[8 * s + 7]); pf[s] = __builtin_bit_cast(bf16x8, pw); }
    pv_block(o, vl, pf, lane);
}
__device__ __forceinline__ void cb_block(const f32x16& S, bool cbias, LAS unsigned char* vl, const LAS float* bl, int tq, int keypos0, int nvalid, float& m, float& l, f32x16 (&o)[2], int lane) {
    const int hh = lane >> 5;
    float s[16]; float bm = -INFINITY;
    if (cbias) {
        const float cb = bl[256];
#pragma unroll
        for (int r = 0; r < 16; ++r) { s[r] = S[r] + cb; bm = fmaxf(bm, s[r]); }
    } else {
#pragma unroll
        for (int r = 0; r < 16; ++r) {
            const int kr = (r & 3) + 8 * (r >> 2) + 4 * hh; int d = tq - (keypos0 + kr); d = d < -128 ? -128 : (d > 128 ? 128 : d);
            s[r] = (kr < nvalid) ? S[r] + bl[d + 128] : -INFINITY; bm = fmaxf(bm, s[r]);
        }
    }
    bm = fmaxf(bm, partner32(bm));
    if (__any(bm > m + 8.f)) {
        const float mn = fmaxf(m, bm), f = __builtin_amdgcn_exp2f(m - mn); m = mn; l *= f;
#pragma unroll
        for (int db = 0; db < 2; ++db)
#pragma unroll
            for (int r = 0; r < 16; ++r) o[db][r] *= f;
    }
    float w[16], ls = 0.f;
#pragma unroll
    for (int r = 0; r < 16; ++r) { w[r] = __builtin_amdgcn_exp2f(s[r] - m); ls += w[r]; }
    l += ls;
    bf16x8 pf[2];
#pragma unroll
    for (int s2 = 0; s2 < 2; ++s2) { u32x4 pw; pw.x = pk2(w[8 * s2], w[8 * s2 + 1]); pw.y = pk2(w[8 * s2 + 2], w[8 * s2 + 3]); pw.z = pk2(w[8 * s2 + 4], w[8 * s2 + 5]); pw.w = pk2(w[8 * s2 + 6], w[8 * s2 + 7]); pf[s2] = __builtin_bit_cast(bf16x8, pw); }
    pv_block(o, vl, pf, lane);
}
__device__ __forceinline__ void attn_store(f32x16 (&o)[2], float scale, const float* gain, bf16_t* mix, size_t row0, int col0, int nrows, LAS unsigned char* wl, int lane) {
    const int r = lane & 31, hh = lane >> 5;
    f32x4 gvs[2][4];
#pragma unroll
    for (int db = 0; db < 2; ++db)
#pragma unroll
        for (int g = 0; g < 4; ++g) gvs[db][g] = *(const f32x4*)(gain + 32 * db + 8 * g + 4 * hh);
    float ssq = 0.f;
#pragma unroll
    for (int db = 0; db < 2; ++db)
#pragma unroll
        for (int i = 0; i < 16; ++i) { o[db][i] *= scale; ssq += o[db][i] * o[db][i]; }
    ssq += partner32(ssq);
    const float rstd = rsqrtf(ssq * (1.0f / 64.0f) + EPS);
    LAS unsigned char* st = wl + AW_ST;
#pragma unroll
    for (int db = 0; db < 2; ++db)
#pragma unroll
        for (int g = 0; g < 4; ++g) { const int d0 = 32 * db + 8 * g + 4 * hh; const f32x4 gv = gvs[db][g];
            u32x2 w; w.x = pk2(o[db][4 * g] * rstd * gv[0], o[db][4 * g + 1] * rstd * gv[1]); w.y = pk2(o[db][4 * g + 2] * rstd * gv[2], o[db][4 * g + 3] * rstd * gv[3]);
            *(LAS u32x2*)(st + r * ST_PITCH + d0 * 2) = w; }
#pragma unroll
    for (int i = 0; i < 4; ++i) { const int row = 8 * i + (lane >> 3), ch = lane & 7; const u32x4 v = *(const LAS u32x4*)(st + row * ST_PITCH + ch * 16);
        if (row < nrows) *(u32x4*)(mix + (row0 + row) * DM + col0 + ch * 8) = v; }
}

template <bool F32> __device__ __forceinline__ void sb_loop(const void* kbase, const void* vbase, size_t rowbase, int jhi, int h, const bf16x8 (&qf)[4], int tq, float& carry, f32x16 (&o)[2], LAS unsigned char* wl, int lane) {
    const int r = lane & 31, hh = lane >> 5;
    bf16x8 kA[4], kB[4]; u32x4 vA[4], vB[4];
#define SB_LD(KF, VN, jj) do { ld_k<F32>(KF, kbase, (rowbase + 32 * (jj) + r) * HW + h * 64 + 32 * hh); ld_v<F32>(VN, vbase, rowbase + 32 * (jj), 32, h, lane); } while (0)
    SB_LD(kA, vA, jhi); if (jhi >= 1) SB_LD(kB, vB, jhi - 1);
    for (int j = jhi; j >= 0; j -= 2) {
        { const f32x16 S = qk_block(kA, qf); st_v(wl + AW_V, vA, lane); if (j >= 2) SB_LD(kA, vA, j - 2);
          sb_block(S, wl + AW_V, tq, 32 * j, carry, o, lane); }
#if SB_EARLY
        if (__all(carry < SB_THR)) break;
#endif
        if (j < 1) break;
        { const f32x16 S = qk_block(kB, qf); st_v(wl + AW_V, vB, lane); if (j >= 3) SB_LD(kB, vB, j - 3);
          sb_block(S, wl + AW_V, tq, 32 * (j - 1), carry, o, lane); }
#if SB_EARLY
        if (__all(carry < SB_THR)) break;
#endif
    }
#undef SB_LD
}
template <bool SAMPLE> __device__ __forceinline__ void sb_unit(const AttnArgs& A, int b, int h, int qb, LAS unsigned char* wl, int lane) {
    const int r = lane & 31, hh = lane >> 5;
    const bf16_t* Qa = QKV_; const bf16_t* Ka = Qa + (size_t)1 * MT * HW; const bf16_t* Va = Qa + (size_t)2 * MT * HW;
    int tq; size_t qrow;
    if (SAMPLE) { tq = PAST + (r & 15); qrow = (size_t)MP + b * DSEQ + (r & 15); } else { tq = 32 * qb + r; qrow = (size_t)b * SEQ + tq; }
    bf16x8 qf[4]; ld_k<false>(qf, Qa, qrow * HW + h * 64 + 32 * hh);
    float carry = 1.f; f32x16 o[2]; o[0] = f32x16{}; o[1] = f32x16{};
    if (SAMPLE) {
        bf16x8 kf[4]; u32x4 vr[4]; const size_t row0 = (size_t)MP + b * DSEQ;
        ld_k<false>(kf, Ka, (row0 + (r & 15)) * HW + h * 64 + 32 * hh); ld_v<false>(vr, Va, row0, DSEQ, h, lane); st_v(wl + AW_V, vr, lane);
        { const f32x16 S = qk_block(kf, qf); sb_block(S, wl + AW_V, tq, PAST, carry, o, lane); }
        sb_loop<true>(ARG(4) + (size_t)A.L * NBATCH * PAST * HW, ARG(5) + (size_t)A.L * NBATCH * PAST * HW, (size_t)b * PAST, PAST / 32 - 1, h, qf, tq, carry, o, wl, lane);
        attn_store(o, 1.f, ARG(11) + A.L * HW + h * 64, MIX_, row0, h * 64, DSEQ, wl, lane);
    } else {
        sb_loop<false>(Ka, Va, (size_t)b * SEQ, qb, h, qf, tq, carry, o, wl, lane);
        attn_store(o, 1.f, ARG(11) + A.L * HW + h * 64, MIX_, (size_t)b * SEQ + 32 * qb, h * 64, 32, wl, lane);
    }
}
template <bool F32> __device__ __forceinline__ void cb_loop(const void* kbase, const void* vbase, size_t rowbase, int jlo, int jhi, int pos0, int h, const bf16x8 (&qf)[4], int tq, float& m, float& l, f32x16 (&o)[2], LAS unsigned char* wl, int lane) {
    const int r = lane & 31, hh = lane >> 5;
    bf16x8 kA[4], kB[4]; u32x4 vA[4], vB[4];
    const int tqmin = tq - r;
#define CB_LD(KF, VN, jj) do { ld_k<F32>(KF, kbase, (rowbase + 32 * (jj) + r) * HW + h * 64 + 32 * hh); ld_v<F32>(VN, vbase, rowbase + 32 * (jj), 32, h, lane); } while (0)
    CB_LD(kA, vA, jlo); if (jlo + 1 <= jhi) CB_LD(kB, vB, jlo + 1);
    for (int j = jlo; j <= jhi; j += 2) {
        { const f32x16 S = qk_block(kA, qf); st_v(wl + AW_V, vA, lane); if (j + 2 <= jhi) CB_LD(kA, vA, j + 2);
          const bool cbias = __builtin_amdgcn_readfirstlane(pos0 + 32 * j + 31 + 128 <= tqmin);
          cb_block(S, cbias, wl + AW_V, (const LAS float*)(wl + AW_BIAS), tq, pos0 + 32 * j, 32, m, l, o, lane); }
        if (j + 1 > jhi) break;
        { const f32x16 S = qk_block(kB, qf); st_v(wl + AW_V, vB, lane); if (j + 3 <= jhi) CB_LD(kB, vB, j + 3);
          const bool cbias = __builtin_amdgcn_readfirstlane(pos0 + 32 * (j + 1) + 31 + 128 <= tqmin);
          cb_block(S, cbias, wl + AW_V, (const LAS float*)(wl + AW_BIAS), tq, pos0 + 32 * (j + 1), 32, m, l, o, lane); }
    }
#undef CB_LD
}
template <bool SAMPLE> __device__ __forceinline__ void cb_unit(const AttnArgs& A, int b, int h, int qb, LAS unsigned char* wl, int lane) {
    const int r = lane & 31, hh = lane >> 5;
    const bf16_t* Qb = QKV_ + (size_t)3 * MT * HW; const bf16_t* Kb = Qb + (size_t)1 * MT * HW; const bf16_t* Vb = Qb + (size_t)2 * MT * HW;
    LAS float* bl = (LAS float*)(wl + AW_BIAS);
    { const float* relp = ARG(10) + (size_t)A.L * 257 * 8 + h; float bv[5];
#pragma unroll
      for (int i = 0; i < 5; ++i) { const int idx = lane + 64 * i; bv[i] = relp[(idx < 257 ? idx : 256) * 8]; }
#pragma unroll
      for (int i = 0; i < 5; ++i) { const int idx = lane + 64 * i; if (idx < 257) bl[idx] = bv[i] * LOG2E; } }
    int tq; size_t qrow;
    if (SAMPLE) { tq = PAST + (r & 15); qrow = (size_t)MP + b * DSEQ + (r & 15); } else { tq = 32 * qb + r; qrow = (size_t)b * SEQ + tq; }
    bf16x8 qf[4]; ld_k<false>(qf, Qb, qrow * HW + h * 64 + 32 * hh);
    float m = -INFINITY, l = 0.f; f32x16 o[2]; o[0] = f32x16{}; o[1] = f32x16{};
    if (SAMPLE) {
        cb_loop<true>(ARG(6) + (size_t)A.L * NBATCH * BANDL * HW, ARG(7) + (size_t)A.L * NBATCH * BANDL * HW, (size_t)b * BANDL, 0, BANDL / 32 - 1, PAST - BANDL, h, qf, tq, m, l, o, wl, lane);
        bf16x8 kf[4]; u32x4 vr[4]; const size_t row0 = (size_t)MP + b * DSEQ;
        ld_k<false>(kf, Kb, (row0 + (r & 15)) * HW + h * 64 + 32 * hh); ld_v<false>(vr, Vb, row0, DSEQ, h, lane); st_v(wl + AW_V, vr, lane);
        { const f32x16 S = qk_block(kf, qf); cb_block(S, false, wl + AW_V, bl, tq, PAST, DSEQ, m, l, o, lane); }
        l += partner32(l);
        attn_store(o, 1.0f / l, ARG(12) + A.L * HW + h * 64, MIX_, row0, HW + h * 64, DSEQ, wl, lane);
    } else {
        const int c = qb >> 1, clo = c - 8 < 0 ? 0 : c - 8;
        cb_loop<false>(Kb, Vb, (size_t)b * SEQ, 2 * clo, 2 * c + 1, 0, h, qf, tq, m, l, o, wl, lane);
        l += partner32(l);
        attn_store(o, 1.0f / l, ARG(12) + A.L * HW + h * 64, MIX_, (size_t)b * SEQ + 32 * qb, HW + h * 64, 32, wl, lane);
    }
}
__device__ __forceinline__ void cb_unit_p64(const AttnArgs& A, int b, int h, int c, LAS unsigned char* wl, int lane) {
    const int r = lane & 31, hh = lane >> 5;
    const bf16_t* Qb = QKV_ + (size_t)3 * MT * HW; const bf16_t* Kb = Qb + (size_t)1 * MT * HW; const bf16_t* Vb = Qb + (size_t)2 * MT * HW;
    LAS float* bl = (LAS float*)(wl + AW_BIAS);
    { const float* relp = ARG(10) + (size_t)A.L * 257 * 8 + h; float bv[5];
#pragma unroll
      for (int i = 0; i < 5; ++i) { const int idx = lane + 64 * i; bv[i] = relp[(idx < 257 ? idx : 256) * 8]; }
#pragma unroll
      for (int i = 0; i < 5; ++i) { const int idx = lane + 64 * i; if (idx < 257) bl[idx] = bv[i] * LOG2E; } }
    const int tq0 = 64 * c + r, tq1 = tq0 + 32; const size_t rowbase = (size_t)b * SEQ;
    bf16x8 qf0[4], qf1[4];
    ld_k<false>(qf0, Qb, (rowbase + tq0) * HW + h * 64 + 32 * hh); ld_k<false>(qf1, Qb, (rowbase + tq1) * HW + h * 64 + 32 * hh);
    float m0 = -INFINITY, l0 = 0.f, m1 = -INFINITY, l1 = 0.f;
    f32x16 o0[2], o1[2]; o0[0] = f32x16{}; o0[1] = f32x16{}; o1[0] = f32x16{}; o1[1] = f32x16{};
    const int clo = c - 8 < 0 ? 0 : c - 8, jlo = 2 * clo, jhi = 2 * c + 1;
    bf16x8 kf[4]; u32x4 vn[4];
    ld_k<false>(kf, Kb, (rowbase + 32 * jlo + r) * HW + h * 64 + 32 * hh); ld_v<false>(vn, Vb, rowbase + 32 * jlo, 32, h, lane);
    for (int j = jlo; j <= jhi; ++j) {
        const f32x16 S0 = qk_block(kf, qf0), S1 = qk_block(kf, qf1);
        st_v(wl + AW_V, vn, lane);
        if (j < jhi) { ld_k<false>(kf, Kb, (rowbase + 32 * (j + 1) + r) * HW + h * 64 + 32 * hh); ld_v<false>(vn, Vb, rowbase + 32 * (j + 1), 32, h, lane); }
        const bool cbias = (32 * j + 31 + 128 <= 64 * c);
        cb_block(S0, cbias, wl + AW_V, bl, tq0, 32 * j, 32, m0, l0, o0, lane);
        cb_block(S1, cbias, wl + AW_V, bl, tq1, 32 * j, 32, m1, l1, o1, lane);
    }
    l0 += partner32(l0); l1 += partner32(l1);
    attn_store(o0, 1.0f / l0, ARG(12) + A.L * HW + h * 64, MIX_, rowbase + 64 * c, HW + h * 64, 32, wl, lane);
    attn_store(o1, 1.0f / l1, ARG(12) + A.L * HW + h * 64, MIX_, rowbase + 64 * c + 32, HW + h * 64, 32, wl, lane);
}
constexpr int AU_ITEMS = 2048;
__device__ __forceinline__ void attn_phase(const AttnArgs& A, LAS unsigned char* lds) {
    const int tid_ = fresh_tid(), lane = tid_ & 63, wave = __builtin_amdgcn_readfirstlane(tid_ >> 6);
    LAS unsigned char* wl = lds + wave * AW_BYTES;
#pragma unroll 1
    for (int cu = (int)blockIdx.x * NWAVES + wave; cu < AU_ITEMS; cu += (int)gridDim.x * NWAVES) {
        const int blk = cu >> 3, kk_ = (blk >> 3) * 8 + (cu & 7);
        const int bh = (blk & 7) * 8 + (kk_ >> 5), p = kk_ & 31;
        cb_unit_p64(A, bh >> 3, bh & 7, 31 - p, wl, lane);
#pragma unroll 1
        for (int t = 0; t < 2; ++t) sb_unit<false>(A, bh >> 3, bh & 7, 63 - 2 * p - t, wl, lane);
        if (p >= 28) { const int li = bh * 4 + (p - 28);
            if (li < 64) sb_unit<true>(A, li >> 3, li & 7, 0, wl, lane);
            else if (li < 128) cb_unit<true>(A, (li - 64) >> 3, (li - 64) & 7, 0, wl, lane); }
    }
}
typedef unsigned gu32_plain;
#define XB_TMO      128
#define XB_XCNT(j)  (256  + 64 * (j))
#define XB_XSUB(j)  (1280 + 64 * (j))
#define XB_XGEN(j)  (2304 + 64 * (j))
#define XB_TOP      3328
#define XB_TOPGEN   3392
#define XCD_BAR_WORDS 3456
#define XB_SPIN_CAP (1u << 18)

__device__ __forceinline__ unsigned xb_ld(unsigned* p)              { return __hip_atomic_load(p, __ATOMIC_RELAXED, __HIP_MEMORY_SCOPE_AGENT); }
__device__ __forceinline__ unsigned xb_add(unsigned* p, unsigned v) { return __hip_atomic_fetch_add(p, v, __ATOMIC_RELAXED, __HIP_MEMORY_SCOPE_AGENT); }
__device__ __forceinline__ unsigned xb_xcc_id() { return (unsigned)__builtin_amdgcn_s_getreg((3 << 11) | 20) & 0xFu; }
#define XB_SPIN(cond, bar) do { unsigned _sp = 0; while (cond) { __builtin_amdgcn_s_sleep(1); \
    if ((++_sp & 255u) == 0u) { if (xb_ld(&(bar)[XB_TMO])) break; if (_sp > XB_SPIN_CAP) { atomicAdd(&(bar)[XB_TMO], 1u); break; } } } } while (0)

struct XcdBarrier {
    unsigned* bar; unsigned x;
    volatile LAS unsigned* st;
};

__device__ __forceinline__ XcdBarrier xcd_barrier_post(unsigned* bar, volatile LAS unsigned* st) {
    XcdBarrier b; b.bar = bar; b.x = xb_xcc_id(); b.st = st;
    if (threadIdx.x == 0) (void)xb_add(&bar[XB_XCNT(b.x)], 1u);
    return b;
}
__device__ __forceinline__ void xcd_barrier_complete(unsigned* bar, unsigned x, unsigned& nloc, unsigned& nx) {
    const unsigned G = gridDim.x * gridDim.y * gridDim.z;
    unsigned sum, cnt, mine, sp = 0u;
    for (;;) {
        sum = 0u; cnt = 0u; mine = 0u;
#pragma unroll
        for (unsigned j = 0; j < 16; ++j) { const unsigned c = xb_ld(&bar[XB_XCNT(j)]); sum += c; cnt += (c > 0u) ? 1u : 0u; mine = (j == x) ? c : mine; }
        if (sum == G) break;
        __builtin_amdgcn_s_sleep(1);
        if ((++sp & 255u) == 0u) { if (xb_ld(&bar[XB_TMO])) break; if (sp > XB_SPIN_CAP) { atomicAdd(&bar[XB_TMO], 1u); break; } }
    }
    nloc = mine > 0u ? mine : 1u; nx = cnt > 0u ? cnt : 1u;
}

__device__ __forceinline__ void xcd_barrier(const XcdBarrier& b) {
    asm volatile("s_waitcnt vmcnt(0)" ::: "memory");
    __syncthreads();
    if (threadIdx.x == 0) {
        unsigned* bar = b.bar;
        __builtin_amdgcn_s_waitcnt(0);
        unsigned nloc = b.st[0], nx = b.st[1];
        if (nloc == 0u) { xcd_barrier_complete(bar, b.x, nloc, nx); b.st[0] = nloc; b.st[1] = nx; }
        const unsigned old = xb_add(&bar[XB_XSUB(b.x)], 1u);
        const unsigned gen = old / nloc;
        if (old + 1u == (gen + 1u) * nloc) {
            __builtin_amdgcn_fence(__ATOMIC_RELEASE, "agent");
            asm volatile("s_waitcnt vmcnt(0)" ::: "memory");
            const unsigned og = xb_add(&bar[XB_TOP], 1u);
            const unsigned tg = og / nx;
            if (og + 1u == (tg + 1u) * nx) xb_add(&bar[XB_TOPGEN], 1u);
            else XB_SPIN(xb_ld(&bar[XB_TOPGEN]) == tg, bar);
            __builtin_amdgcn_fence(__ATOMIC_ACQUIRE, "agent");
            xb_add(&bar[XB_XGEN(b.x)], 1u);
            asm volatile("s_waitcnt vmcnt(0)" ::: "memory");
        } else {
            XB_SPIN(xb_ld(&bar[XB_XGEN(b.x)]) == gen, bar);
            __builtin_amdgcn_fence(__ATOMIC_ACQUIRE, "agent");
            asm volatile("s_waitcnt vmcnt(0)" ::: "memory");
        }
    }
    __syncthreads();
}

constexpr int CI_IN = 16 * 96, CI_OUT = 16 * 32, CI_G = 16 * 88, CI_D = 44 * 32, CI_PG = 16 * 32, CI_PP = 4 * 32, CI_L = CI_IN + CI_OUT + 2 * CI_G + CI_D + CI_PG + CI_PP;
struct ConvD { const float* W; const float* gain; bf16_t* WT; int K, N, kind, k0, n0; };
__device__ __forceinline__ ConvD conv_decode(int it) {
    const int L = it / CI_L; int r = it % CI_L; ConvD d;
    if (r < CI_IN) { d.W = ARG(9) + (size_t)L * DM * NQKV; d.gain = ARG(8) + L * DM; d.WT = (bf16_t*)WPTR(L, W_IN); d.K = DM; d.N = NQKV; d.kind = 0; }
    else if ((r -= CI_IN) < CI_OUT) { d.W = ARG(13) + (size_t)L * DM * DM; d.gain = nullptr; d.WT = (bf16_t*)WPTR(L, W_OUT); d.K = DM; d.N = DM; d.kind = 0; }
    else if ((r -= CI_OUT) < CI_G) { d.W = ARG(15) + (size_t)L * DM * DFF; d.gain = ARG(14) + L * DM; d.WT = (bf16_t*)WPTR(L, W_GU); d.K = DM; d.N = DFF; d.kind = 1; }
    else if ((r -= CI_G) < CI_G) { d.W = ARG(16) + (size_t)L * DM * DFF; d.gain = ARG(14) + L * DM; d.WT = (bf16_t*)WPTR(L, W_GU); d.K = DM; d.N = DFF; d.kind = 2; }
    else if ((r -= CI_G) < CI_D) { d.W = ARG(17) + (size_t)L * DFF * DM; d.gain = nullptr; d.WT = (bf16_t*)WPTR(L, W_DOWN); d.K = DFF; d.N = DM; d.kind = 0; }
    else if ((r -= CI_D) < CI_PG) { d.W = ARG(19) + (size_t)L * DM * DM; d.gain = ARG(18) + L * DM; d.WT = (bf16_t*)WPTR(L, W_PG); d.K = DM; d.N = DM; d.kind = 0; }
    else { r -= CI_PG; d.W = ARG(20) + (size_t)L * PLED * DM; d.gain = nullptr; d.WT = (bf16_t*)WPTR(L, W_PP); d.K = PLED; d.N = DM; d.kind = 0; }
    const int nblk = d.N / 32; d.k0 = 64 * (r / nblk); d.n0 = 32 * (r % nblk);
    return d;
}
__device__ __forceinline__ void conv_load(const ConvD& d, float (&v)[32], f32x4 (&g)[2], int lane) {
    const float* p = d.W + (size_t)(d.k0 + (lane >> 5)) * d.N + d.n0 + (lane & 31);
#pragma unroll
    for (int i = 0; i < 32; ++i) v[i] = p[(size_t)(2 * i) * d.N];
    if (d.gain) { g[0] = *(const f32x4*)(d.gain + d.k0 + 8 * (lane & 7)); g[1] = *(const f32x4*)(d.gain + d.k0 + 8 * (lane & 7) + 4); }
    else { g[0] = (f32x4){1.f, 1.f, 1.f, 1.f}; g[1] = g[0]; }
}
__device__ __forceinline__ void conv_proc(const ConvD& d, const float (&v)[32], const f32x4 (&g)[2], LAS float* scr, int lane) {
#pragma unroll
    for (int i = 0; i < 32; ++i) scr[(2 * i + (lane >> 5)) * 33 + (lane & 31)] = v[i];
    asm volatile("s_waitcnt lgkmcnt(0)" ::: "memory");
    const int c = lane & 7;
#pragma unroll
    for (int j = 0; j < 4; ++j) { const int n = (lane >> 3) + 8 * j; const LAS float* s = scr + (8 * c) * 33 + n;
        u32x4 o; o.x = pk2(s[0 * 33] * g[0][0], s[1 * 33] * g[0][1]); o.y = pk2(s[2 * 33] * g[0][2], s[3 * 33] * g[0][3]);
        o.z = pk2(s[4 * 33] * g[1][0], s[5 * 33] * g[1][1]); o.w = pk2(s[6 * 33] * g[1][2], s[7 * 33] * g[1][3]);
        const int gn = d.n0 + n; const int drow = d.kind == 0 ? gn : ((gn >> 7) * 256 + (gn & 127) + (d.kind == 2 ? 128 : 0));
        *(u32x4*)(d.WT + (size_t)drow * d.K + d.k0 + 8 * c) = o; }
    asm volatile("s_waitcnt lgkmcnt(0)" ::: "memory");
}

#ifdef NO_SGEMM
#define SG(...)
#else
#define SG(...) __VA_ARGS__
#endif
#ifndef GP1
#define GP1(...) __VA_ARGS__
#endif
#ifndef GP2
#define GP2(...) __VA_ARGS__
#endif
#ifndef GP3
#define GP3(...) __VA_ARGS__
#endif
#ifndef GP4
#define GP4(...) __VA_ARGS__
#endif
#ifndef GP5
#define GP5(...) __VA_ARGS__
#endif
#ifndef GP6
#define GP6(...) __VA_ARGS__
#endif
#ifdef NO_SGEMM
#define SG(...)
#else
#define SG(...) __VA_ARGS__
#endif
#ifndef GP1
#define GP1(...) __VA_ARGS__
#endif
#ifndef GP2
#define GP2(...) __VA_ARGS__
#endif
#ifndef GP3
#define GP3(...) __VA_ARGS__
#endif
#ifndef GP4
#define GP4(...) __VA_ARGS__
#endif
#ifndef GP5
#define GP5(...) __VA_ARGS__
#endif
#ifndef GP6
#define GP6(...) __VA_ARGS__
#endif
struct Args { const float* in[22]; float* out; unsigned char* ws; };

#ifndef PROBE_SEL
#define PROBE_SEL -1
#endif
#if PROBE_SEL >= 0
#define TSTAMP(cat) do { if (blockIdx.x == 0 && fresh_tid() == 0) { const unsigned long long t_ = __builtin_amdgcn_s_memrealtime(); unsigned long long* tsb = WS_PTR(unsigned long long, WS_CTL + 4096); \
    tsb[16 + (cat)] += t_ - tsb[0]; tsb[0] = t_; } } while (0)
#else
#define TSTAMP(cat) do {} while (0)
#endif
__global__ void __launch_bounds__(NTHREADS, 2) hymba_fwd(Args args) {
    extern __shared__ __attribute__((aligned(16))) unsigned char lds_raw[];
    cg::grid_group grid = cg::this_grid();
    LAS unsigned char* lds = (LAS unsigned char*)lds_raw;
    const int G = gridDim.x;

    { const int tid0 = fresh_tid();
      if (blockIdx.x == 0) for (int i = tid0; i < XCD_BAR_WORDS; i += NTHREADS) WS_PTR(unsigned, WS_BAR)[i] = 0u;
      if (tid0 < 2) ((LAS unsigned*)(lds + 131072))[tid0] = 0u; }
    grid.sync();
    (void)xcd_barrier_post(WS_PTR(unsigned, WS_BAR), (volatile LAS unsigned*)(lds + 131072));
#define GSYNC() do { XcdBarrier xb_; xb_.bar = WS_PTR(unsigned, WS_BAR); xb_.x = xb_xcc_id(); xb_.st = (volatile LAS unsigned*)(lds + 131072); xcd_barrier(xb_); } while (0)
#if PROBE_SEL >= 0
    if (blockIdx.x == 0 && fresh_tid() == 0) { unsigned long long* tsb = WS_PTR(unsigned long long, WS_CTL + 4096); for (int i = 0; i < 48; ++i) tsb[i] = 0; tsb[0] = __builtin_amdgcn_s_memrealtime(); }
#endif
    {
        const int tid = fresh_tid(), lane = tid & 63, wave = __builtin_amdgcn_readfirstlane(tid >> 6);
        const int gw = blockIdx.x * NWAVES + wave, NGW = G * NWAVES;
        { float* ssb = SSB; for (int i = blockIdx.x * NTHREADS + tid; i < 6 * MT; i += G * NTHREADS) ssb[MT + i] = 0.f;
          if (blockIdx.x == 0 && tid < 16) WS_PTR(unsigned, WS_CTL)[tid] = 0u;
          }
        LAS float* scr = (LAS float*)(lds + wave * 8704);
        { constexpr int NIT = NLAYER * CI_L; int it = gw;
          float vA[32], vB[32]; f32x4 gA[2], gB[2]; ConvD dA, dB;
          if (it < NIT) { dA = conv_decode(it); conv_load(dA, vA, gA, lane); }
          while (it < NIT) {
            const int itn = it + NGW;
            if (itn < NIT) { dB = conv_decode(itn); conv_load(dB, vB, gB, lane); }
            conv_proc(dA, vA, gA, scr, lane);
            if (itn >= NIT) break;
            it = itn + NGW;
            if (it < NIT) { dA = conv_decode(it); conv_load(dA, vA, gA, lane); }
            conv_proc(dB, vB, gB, scr, lane);
          } }
        { const float* pp = ARG(2); const float* ps = ARG(3); bf16_t* PB = PB_;
          for (int it0 = 4 * gw; it0 < NLAYER * MT; it0 += 4 * NGW) {
            f32x4 v[4];
#pragma unroll
            for (int rr = 0; rr < 4; ++rr) { const int it = it0 + rr, L = it / MT, row = it % MT;
                const float* src = row < MP ? pp + ((size_t)L * MP + row) * PLED : ps + ((size_t)L * MS + (row - MP)) * PLED;
                v[rr] = *((const f32x4*)src + lane); }
#pragma unroll
            for (int rr = 0; rr < 4; ++rr) { u32x2 w; w.x = pk2(v[rr][0], v[rr][1]); w.y = pk2(v[rr][2], v[rr][3]); *((u32x2*)(PB + (size_t)(it0 + rr) * PLED) + lane) = w; }
          } }
        { const float* x_p = ARG(0); const float* x_s = ARG(1); bf16_t* XB = XN_; float* ssb = SSB;
          for (int row0 = 2 * gw; row0 < MT; row0 += 2 * NGW) {
            f32x4 v[2][4];
#pragma unroll
            for (int rr = 0; rr < 2; ++rr) { const int row = row0 + rr; const float* src = row < MP ? x_p + (size_t)row * DM : x_s + (size_t)(row - MP) * DM;
#pragma unroll
                for (int j = 0; j < 4; ++j) v[rr][j] = *((const f32x4*)src + lane + 64 * j); }
#pragma unroll
            for (int rr = 0; rr < 2; ++rr) { float s2 = 0.f;
#pragma unroll
                for (int j = 0; j < 4; ++j) { const f32x4 t = v[rr][j]; s2 += (t[0] * t[0] + t[1] * t[1]) + (t[2] * t[2] + t[3] * t[3]);
                    u32x2 w; w.x = pk2(t[0], t[1]); w.y = pk2(t[2], t[3]); *((u32x2*)(XB + (size_t)(row0 + rr) * DM) + lane + 64 * j) = w; }
                s2 = wave_sum(s2);
                if (lane == 0) ssb[row0 + rr] = s2; }
          } }
    }
    TSTAMP(0); GSYNC(); TSTAMP(8);

    for (int L = 0; L < NLAYER; ++L) {
#define SS_MIX (SSB + (size_t)(3 * L) * MT)
#define SS_FFN (SSB + (size_t)(3 * L + 1) * MT)
#define SS_PLE (SSB + (size_t)(3 * L + 2) * MT)
#define SS_NEXT (SSB + (size_t)(3 * L + 3) * MT)
        { EpiArgs q{}; q.ss_in = SS_MIX; q.o0 = QKV_;
          q.f_sbk = ARG_OUT + O_SBK_P + (size_t)L * MP * HW; q.f_sbv = ARG_OUT + O_SBV_P + (size_t)L * MP * HW;
          q.f_cbk = ARG_OUT + O_CBK_P + (size_t)L * NBATCH * BANDL * HW; q.f_cbv = ARG_OUT + O_CBV_P + (size_t)L * NBATCH * BANDL * HW;
          pg8::Gemm g{XN_, WPTR(L, W_IN), MP, NQKV, DM}; pg8::StaticOrder S; S.init(MP, NQKV, G, (int)blockIdx.x);
          Epi<EP_QKV> E{q};
          GP1(pg8::gemm_phase<Epi<EP_QKV>, pg8::StaticOrder, true, true>(lds, g, S, E);) TSTAMP(1); }
        { EpiArgs q{}; q.ss_in = SS_MIX; q.o0 = QKV_;
          q.s_sbk = ARG_OUT + O_SBK_S + (size_t)L * MS * HW; q.s_sbv = ARG_OUT + O_SBV_S + (size_t)L * MS * HW;
          q.s_cbk = ARG_OUT + O_CBK_S + (size_t)L * MS * HW; q.s_cbv = ARG_OUT + O_CBV_S + (size_t)L * MS * HW;
          SG(sgemm<EP_QKV, DM>(lds, XN_ + (size_t)MP * DM, WPTR(L, W_IN), NQKV / 32, q);) TSTAMP(7); }
        GSYNC(); TSTAMP(8);
        { AttnArgs A{}; A.L = L;
#ifndef NO_ATTN
          attn_phase(A, lds);
#endif
          TSTAMP(2); }
        GSYNC(); TSTAMP(2);
        { EpiArgs q{}; q.XB = XB_; q.xbase = XN_; q.ss_out = SS_FFN;
          pg8::Gemm g{MIX_, WPTR(L, W_OUT), MP, DM, DM}; pg8::StaticOrder S; S.init(MP, DM, G, (int)blockIdx.x);
          Epi<EP_RES> E{q};
          GP2(pg8::gemm_phase<Epi<EP_RES>, pg8::StaticOrder, true, true>(lds, g, S, E);) TSTAMP(3); }
        { EpiArgs q{}; q.XB = XB_; q.xbase = XN_; q.ss_out = SS_FFN;
          SG(sgemm<EP_RES, DM>(lds, MIX_ + (size_t)MP * DM, WPTR(L, W_OUT), DM / 32, q);) TSTAMP(7); }
        GSYNC(); TSTAMP(8);
        { EpiArgs q{}; q.ss_in = SS_FFN; q.o0 = HB_;
          pg8::Gemm g{XB_, WPTR(L, W_GU), MP, 2 * DFF, DM}; pg8::StaticOrder S; S.init(MP, 2 * DFF, G, (int)blockIdx.x);
          Epi<EP_GU> E{q};
          GP4(pg8::gemm_phase<Epi<EP_GU>, pg8::StaticOrder, true, true>(lds, g, S, E);) TSTAMP(4);
          SG(sgemm<EP_GU, DM>(lds, XB_ + (size_t)MP * DM, WPTR(L, W_GU), DFF / 32, q);) TSTAMP(7); }
        { EpiArgs q2{}; q2.o0 = PBUF_;
          int kp = PLED; asm volatile("" : "+s"(kp));
          const int Gh = G >> 1;
          if ((int)blockIdx.x >= Gh) {
            pg8::Gemm g2{PB_ + (size_t)L * MT * PLED, WPTR(L, W_PP), MP, DM, kp}; pg8::StaticOrder S; S.init(MP, DM, G - Gh, (int)blockIdx.x - Gh);
            Epi<EP_P> E2{q2};
            GP3(pg8::gemm_phase<Epi<EP_P>, pg8::StaticOrder, true, true>(lds, g2, S, E2);) TSTAMP(10);
          }
          SG(sgemm<EP_P, PLED>(lds, PB_ + ((size_t)L * MT + MP) * PLED, WPTR(L, W_PP), DM / 32, q2);) TSTAMP(7); }
        GSYNC(); TSTAMP(8);
        { EpiArgs q{}; q.XB = XB_; q.xbase = XB_; q.ss_out = SS_PLE;
          pg8::Gemm g{HB_, WPTR(L, W_DOWN), MP, DM, DFF}; pg8::StaticOrder S; S.init(MP, DM, G, (int)blockIdx.x);
          Epi<EP_RES> E{q};
          GP5(pg8::gemm_phase<Epi<EP_RES>, pg8::StaticOrder, true, true>(lds, g, S, E);) TSTAMP(5);
          SG(sgemm<EP_RES, DFF>(lds, HB_ + (size_t)MP * DFF, WPTR(L, W_DOWN), DM / 32, q);) TSTAMP(7); }
        GSYNC(); TSTAMP(8);
        { EpiArgs q{}; q.XB = XN_  ; q.P = PBUF_; q.xbase = XB_; q.ss_in = SS_PLE; q.ss_out = SS_NEXT;
          pg8::Gemm g{XB_, WPTR(L, W_PG), MP, DM, DM}; pg8::StaticOrder S; S.init(MP, DM, G, (int)blockIdx.x);
          Epi<EP_PLE> E{q};
          GP6(pg8::gemm_phase<Epi<EP_PLE>, pg8::StaticOrder, true, true>(lds, g, S, E);) TSTAMP(6);
          SG(sgemm<EP_PLE, DM>(lds, XB_ + (size_t)MP * DM, WPTR(L, W_PG), DM / 32, q);) TSTAMP(7); }
        GSYNC(); TSTAMP(8);
    }
    {
        const int tid = fresh_tid(), lane = tid & 63, wave = __builtin_amdgcn_readfirstlane(tid >> 6);
        const int gw = blockIdx.x * NWAVES + wave, NGW = G * NWAVES;
        const float* ssf = SSB + (size_t)(3 * NLAYER) * MT; const float* gf = ARG(21); const bf16_t* XN = XN_; float* out = ARG_OUT;
        for (int row0 = 2 * gw; row0 < MT; row0 += 2 * NGW) {
            u32x2 xv[2][4];
#pragma unroll
            for (int rr = 0; rr < 2; ++rr)
#pragma unroll
                for (int j = 0; j < 4; ++j) xv[rr][j] = *((const u32x2*)(XN + (size_t)(row0 + rr) * DM) + lane + 64 * j);
#pragma unroll
            for (int rr = 0; rr < 2; ++rr) { const int row = row0 + rr; const float rs = rstd_of(ssf[row]);
                float* dst = row < MP ? out + O_YP + (size_t)row * DM : out + O_YS + (size_t)(row - MP) * DM;
#pragma unroll
                for (int j = 0; j < 4; ++j) { const f32x4 gv = *((const f32x4*)gf + lane + 64 * j); const u32x2 w = xv[rr][j];
                    const f32x4 v = {bf_lo(w.x), bf_hi(w.x), bf_lo(w.y), bf_hi(w.y)};
                    __builtin_nontemporal_store(v * rs * gv, (f32x4*)dst + lane + 64 * j); } }
        }
    }
#if PROBE_SEL >= 0
    TSTAMP(11); grid.sync();
    if (blockIdx.x == 0 && fresh_tid() == 0) { const unsigned long long* tsb = WS_PTR(unsigned long long, WS_CTL + 4096); float* o = ARG_OUT + O_YS; unsigned long long tv = 0; if (PROBE_SEL == 20) tv = tsb[16+1] + tsb[16+3] + tsb[16+10] + tsb[16+4] + tsb[16+5] + tsb[16+6]; else if (PROBE_SEL == 21) tv = tsb[16+0] + tsb[16+11]; else if (PROBE_SEL < 16) tv = tsb[16 + PROBE_SEL]; o[0] += (float)tv * 2.5e-5f; }
#endif
}

extern "C" void kernel_launch(void* const* d_in, const int* in_sizes, int n_in, void* d_out, int out_size, void* d_ws, size_t ws_size, hipStream_t stream) {
    static int grid = 0;
    if (grid == 0) {
        int dev = 0, cus = 0, per_cu = 0;
        hipGetDevice(&dev);
        hipDeviceGetAttribute(&cus, hipDeviceAttributeMultiprocessorCount, dev);
        hipFuncSetAttribute((const void*)hymba_fwd, hipFuncAttributeMaxDynamicSharedMemorySize, LDS_BYTES);
        hipOccupancyMaxActiveBlocksPerMultiprocessor(&per_cu, (const void*)hymba_fwd, NTHREADS, LDS_BYTES);
        if (per_cu < 1) per_cu = 1;
        grid = cus * per_cu;
        if (n_in != 22 || ws_size < WS_END) { fprintf(stderr, "kernel_launch: unexpected n_in %d / ws_size %zu\n", n_in, ws_size); }
    }
    Args a{};
    for (int i = 0; i < 22; ++i) a.in[i] = (const float*)d_in[i];
    a.out = (float*)d_out; a.ws = (unsigned char*)d_ws;
    void* kargs[] = {&a};
    hipError_t e = hipLaunchCooperativeKernel((const void*)hymba_fwd, dim3(grid), dim3(NTHREADS), kargs, LDS_BYTES, stream);
    if (e != hipSuccess) fprintf(stderr, "cooperative launch failed: %s (grid %d)\n", hipGetErrorString(e), grid);
}
```

```cpp
#include <hip/hip_runtime.h>
#include <hip/hip_cooperative_groups.h>
#include <cstdio>
#include <cstdint>
namespace cg = cooperative_groups;
__device__ __forceinline__ int fresh_tid() { int t = threadIdx.x; asm volatile("" : "+v"(t)); return t; }
namespace pg8 {
#define PG8_LAS __attribute__((address_space(3)))
typedef unsigned short bf16_t;
typedef short bf16x8 __attribute__((ext_vector_type(8)));
typedef float f32x4 __attribute__((ext_vector_type(4)));
typedef unsigned u32x4 __attribute__((ext_vector_type(4)));
constexpr int BM = 256, BK = 64, HALF = 128, HTB = HALF * BK * 2  , STAGE_BYTES = 8 * HTB, NXCD = 8, WGM = 8;

__host__ __device__ __forceinline__ int lds_byte(int r, int c) { const int st = (r >> 4) * 2 + (c >> 5), rr = r & 15, cc = c & 31, ob = rr * 64 + cc * 2; return st * 1024 + (ob ^ (((ob >> 9) & 1) << 5)); }
__host__ __device__ __forceinline__ void stage_rc(int b, int& R, int& C) { const int st = b / 1024, sb = b % 1024, swz = sb ^ (((sb >> 9) & 1) << 5); R = (st >> 1) * 16 + swz / 64; C = (st & 1) * 32 + (swz % 64) / 2; }
__host__ __device__ __forceinline__ int perm32(int rho) { const int n = rho >> 4, i = rho & 15; return 8 * (i >> 2) + 4 * n + (i & 3); }

struct Unit { int pm, pn; };
struct Gemm { const bf16_t* A; const bf16_t* Bt; int M, N, K; };

struct StaticOrder {
    int nM, nN, nwg, G, c;
    __host__ __device__ void init(int M, int N, int G_, int c_) { nM = M / BM; nN = N / BM; nwg = nM * nN; G = G_; c = c_; }
    __host__ __device__ bool next(int i, Unit& u) const {
        const long L = (long)i * G + c; if (L >= nwg) return false;
        int wgid = (int)L; { const int q = nwg / NXCD, r = nwg % NXCD, xcd = wgid % NXCD, off = wgid / NXCD; wgid = (xcd < r ? xcd * (q + 1) : r * (q + 1) + (xcd - r) * q) + off; }
        const int nig = WGM * nN, gid = wgid / nig, fm = gid * WGM, gsz = (nM - fm) < WGM ? (nM - fm) : WGM;
        u.pm = fm + ((wgid % nig) % gsz); u.pn = (wgid % nig) / gsz; return true;
    }
    __device__ __forceinline__ void a_ready(const Unit&) const {}
    __device__ __forceinline__ void done(const Unit&) const {}
};

template <class Epi, class Sched, bool ALIGN_EPI = false, bool SP2 = false>
__device__ __forceinline__ void gemm_phase(PG8_LAS unsigned char* lds, const Gemm g, const Sched& S, const Epi& E) {
    const int tid = fresh_tid(), wid = __builtin_amdgcn_readfirstlane(tid >> 6), lane = tid & 63, wr = wid >> 2, wc = wid & 3, fr = lane & 15, fq = lane >> 4;
    const int K = g.K, nt = K / BK;
    unsigned voffA[2], voffB[2];
#pragma unroll
    for (int i = 0; i < 2; ++i) { int R, C; stage_rc(tid * 16 + i * 8192, R, C); const int Rb = Epi::PERM ? ((R & ~31) + perm32(R & 31)) : R;
        voffA[i] = (unsigned)(R * K + C) * 2u; voffB[i] = (unsigned)(Rb * K + C) * 2u; }
    const size_t kstep = (size_t)(BK * 2);
    const size_t hstep = (size_t)HALF * K * 2;
    const size_t tstep = 2 * hstep;
    const unsigned ldsw = (unsigned)wid * 1024u;
    const int aoff = lds_byte(wr * 64 + fr, fq * 8), boff = lds_byte(wc * 32 + fr, fq * 8);
#define PG8_SA(b, h) (((b) * 2 + (h)) * HTB)
#define PG8_SB(b, h) ((4 + (b) * 2 + (h)) * HTB)
#define PG8_STAGE(bufoff, gbase, voff) do { _Pragma("unroll") for (int _i = 0; _i < 2; ++_i) \
        __builtin_amdgcn_global_load_lds((const unsigned*)((const char*)(gbase) + (voff)[_i]), (PG8_LAS unsigned*)(lds + (bufoff) + ldsw + _i * 8192), 16, 0, 0); } while (0)
#define PG8_LDA(dst, b, h) do { _Pragma("unroll") for (int m = 0; m < 4; ++m) _Pragma("unroll") for (int k = 0; k < 2; ++k) dst[m][k] = *(const PG8_LAS bf16x8*)(lds + PG8_SA(b, h) + aoff + m * 2048 + k * 1024); } while (0)
#define PG8_LDB(dst, b, h) do { _Pragma("unroll") for (int n = 0; n < 2; ++n) _Pragma("unroll") for (int k = 0; k < 2; ++k) dst[n][k] = *(const PG8_LAS bf16x8*)(lds + PG8_SB(b, h) + boff + n * 2048 + k * 1024); } while (0)
#define PG8_MMA(ai, bj, At, Bt) do { __builtin_amdgcn_s_setprio(1); _Pragma("unroll") for (int m = 0; m < 4; ++m) _Pragma("unroll") for (int n = 0; n < 2; ++n) _Pragma("unroll") for (int k = 0; k < 2; ++k) \
        acc[ai][bj][m][n] = __builtin_amdgcn_mfma_f32_16x16x32_bf16(Bt[n][k], At[m][k], acc[ai][bj][m][n], 0, 0, 0); __builtin_amdgcn_s_setprio(0); } while (0)
#define PG8_WAIT_V(n) asm volatile("s_waitcnt vmcnt(" #n ")" ::: "memory")
#define PG8_WAIT_L(n) asm volatile("s_waitcnt lgkmcnt(" #n ")" ::: "memory")
#define PG8_BAR __builtin_amdgcn_s_barrier()
#define PG8_SCHED __builtin_amdgcn_sched_barrier(0)
    Unit cur, nxt; int ui = 0;
    if (!S.next(0, cur)) return;
    f32x4 acc[2][2][4][2];
#pragma unroll
    for (int a = 0; a < 2; ++a)
#pragma unroll
        for (int b = 0; b < 2; ++b)
#pragma unroll
            for (int m = 0; m < 4; ++m)
#pragma unroll
                for (int n = 0; n < 2; ++n) acc[a][b][m][n] = (f32x4){0.f, 0.f, 0.f, 0.f};
    bf16x8 At[4][2], B0[2][2], B1[2][2];
    const char* cA = (const char*)g.A + (size_t)cur.pm * tstep; const char* cB = (const char*)g.Bt + (size_t)cur.pn * tstep;
    S.a_ready(cur);
    if constexpr (SP2) {
        PG8_STAGE(PG8_SB(0, 0), cB, voffB); PG8_STAGE(PG8_SB(0, 1), cB + hstep, voffB); PG8_STAGE(PG8_SA(0, 0), cA, voffA); PG8_STAGE(PG8_SA(0, 1), cA + hstep, voffA);
        if (wr == 1) PG8_BAR;
        PG8_WAIT_V(2); PG8_BAR;
        PG8_STAGE(PG8_SB(1, 0), cB + kstep, voffB); PG8_STAGE(PG8_SA(1, 0), cA + kstep, voffA); PG8_STAGE(PG8_SB(1, 1), cB + hstep + kstep, voffB);
        PG8_WAIT_V(6); PG8_BAR;
    } else {
        PG8_STAGE(PG8_SB(0, 0), cB, voffB); PG8_STAGE(PG8_SA(0, 0), cA, voffA); PG8_STAGE(PG8_SB(0, 1), cB + hstep, voffB); PG8_STAGE(PG8_SA(0, 1), cA + hstep, voffA);
        if (wr == 1) PG8_BAR;
        PG8_WAIT_V(4); PG8_BAR;
        PG8_STAGE(PG8_SB(1, 0), cB + kstep, voffB); PG8_STAGE(PG8_SA(1, 0), cA + kstep, voffA); PG8_STAGE(PG8_SB(1, 1), cB + hstep + kstep, voffB);
        PG8_WAIT_V(6); PG8_BAR;
    }
    for (;;) {
        const bool has_next = S.next(ui + 1, nxt);
        const char* nA = has_next ? (const char*)g.A + (size_t)nxt.pm * tstep : cA; const char* nB = has_next ? (const char*)g.Bt + (size_t)nxt.pn * tstep : cB;
        for (int t = 0; t < nt; t += 2) {
            const bool last = (t == nt - 2);
            const char* a1 = cA + (size_t)(t + 1) * kstep;
            const char* a2 = last ? nA : cA + (size_t)(t + 2) * kstep; const char* b2 = last ? nB : cB + (size_t)(t + 2) * kstep;
            const char* a3 = a2 + kstep; const char* b3 = b2 + kstep;
            if (last && has_next) S.a_ready(nxt);
            if constexpr (SP2) {
            PG8_LDB(B0, 0, 0); PG8_LDB(B1, 0, 1); PG8_SCHED; PG8_LDA(At, 0, 0); PG8_STAGE(PG8_SA(1, 1), a1 + hstep, voffA);
            PG8_WAIT_V(8); PG8_WAIT_L(0); PG8_BAR; PG8_MMA(0, 0, At, B0); PG8_MMA(0, 1, At, B1); PG8_BAR; PG8_SCHED;
            PG8_LDA(At, 0, 1); PG8_STAGE(PG8_SB(0, 0), b2, voffB); PG8_STAGE(PG8_SB(0, 1), b2 + hstep, voffB); PG8_STAGE(PG8_SA(0, 0), a2, voffA);
            PG8_WAIT_V(8); PG8_WAIT_L(0); PG8_BAR; PG8_MMA(1, 0, At, B0); PG8_MMA(1, 1, At, B1); PG8_BAR; PG8_SCHED;
            PG8_LDB(B0, 1, 0); PG8_LDB(B1, 1, 1); PG8_SCHED; PG8_LDA(At, 1, 0); PG8_STAGE(PG8_SA(0, 1), a2 + hstep, voffA);
            PG8_WAIT_V(8); PG8_WAIT_L(0); PG8_BAR; PG8_MMA(0, 0, At, B0); PG8_MMA(0, 1, At, B1); PG8_BAR; PG8_SCHED;
            PG8_LDA(At, 1, 1); PG8_STAGE(PG8_SB(1, 0), b3, voffB); PG8_STAGE(PG8_SB(1, 1), b3 + hstep, voffB); PG8_STAGE(PG8_SA(1, 0), a3, voffA);
            PG8_WAIT_V(8); PG8_WAIT_L(0); PG8_BAR; PG8_MMA(1, 0, At, B0); PG8_MMA(1, 1, At, B1); PG8_BAR; PG8_SCHED;
            } else {
            PG8_LDB(B0, 0, 0); PG8_SCHED; PG8_LDA(At, 0, 0); PG8_STAGE(PG8_SA(1, 1), a1 + hstep, voffA);
            PG8_WAIT_L(8); PG8_BAR; PG8_WAIT_L(0); PG8_MMA(0, 0, At, B0); PG8_BAR; PG8_SCHED;
            PG8_LDB(B1, 0, 1); PG8_STAGE(PG8_SB(0, 0), b2, voffB);
            PG8_BAR; PG8_WAIT_L(0); PG8_MMA(0, 1, At, B1); PG8_BAR;
            PG8_LDA(At, 0, 1); PG8_STAGE(PG8_SA(0, 0), a2, voffA);
            PG8_BAR; PG8_WAIT_L(0); PG8_MMA(1, 0, At, B0); PG8_BAR; PG8_SCHED;
            PG8_STAGE(PG8_SB(0, 1), b2 + hstep, voffB);
            PG8_WAIT_V(6); PG8_BAR; PG8_MMA(1, 1, At, B1); PG8_BAR;
            PG8_LDB(B0, 1, 0); PG8_SCHED; PG8_LDA(At, 1, 0); PG8_STAGE(PG8_SA(0, 1), a2 + hstep, voffA);
            PG8_WAIT_L(8); PG8_BAR; PG8_WAIT_L(0); PG8_MMA(0, 0, At, B0); PG8_BAR; PG8_SCHED;
            PG8_LDB(B1, 1, 1); PG8_STAGE(PG8_SB(1, 0), b3, voffB);
            PG8_BAR; PG8_WAIT_L(0); PG8_MMA(0, 1, At, B1); PG8_BAR;
            PG8_LDA(At, 1, 1); PG8_STAGE(PG8_SA(1, 0), a3, voffA);
            PG8_BAR; PG8_WAIT_L(0); PG8_MMA(1, 0, At, B0); PG8_BAR; PG8_SCHED;
            PG8_STAGE(PG8_SB(1, 1), b3 + hstep, voffB);
            PG8_WAIT_V(6); PG8_BAR; PG8_MMA(1, 1, At, B1); PG8_BAR;
            }
        }
        if constexpr (ALIGN_EPI) { if (wr == 0) PG8_BAR; }
        if constexpr (!Epi::AFTER_DRAIN) { E(acc, cur, wr, wc, fr, fq); S.done(cur); }
        if (!has_next) break;
#pragma unroll
        for (int a = 0; a < 2; ++a)
#pragma unroll
            for (int b = 0; b < 2; ++b)
#pragma unroll
                for (int m = 0; m < 4; ++m)
#pragma unroll
                    for (int n = 0; n < 2; ++n) acc[a][b][m][n] = (f32x4){0.f, 0.f, 0.f, 0.f};
        cur = nxt; cA = nA; cB = nB; ++ui;
        if constexpr (ALIGN_EPI) { if (wr == 1) PG8_BAR; }
    }
    PG8_WAIT_V(0);
    if constexpr (!ALIGN_EPI) { if (wr == 0) PG8_BAR; }
    PG8_BAR;
    if constexpr (Epi::AFTER_DRAIN) { E.fused(acc, cur, wr, wc, fr, fq, lds, wid, lane); S.done(cur); }
#undef PG8_SA
#undef PG8_SB
#undef PG8_STAGE
#undef PG8_LDA
#undef PG8_LDB
#undef PG8_MMA
#undef PG8_WAIT_V
#undef PG8_WAIT_L
#undef PG8_BAR
#undef PG8_SCHED
}
}

#define LAS __attribute__((address_space(3)))
using pg8::bf16_t; using pg8::bf16x8; using pg8::f32x4; using pg8::u32x4;
typedef short s16x4 __attribute__((ext_vector_type(4)));
typedef float f32x16 __attribute__((ext_vector_type(16)));
typedef unsigned u32x2 __attribute__((ext_vector_type(2)));
typedef float f32x2_t __attribute__((ext_vector_type(2)));
typedef __bf16 bf16x2_t __attribute__((ext_vector_type(2)));

constexpr int DM = 1024, SEQ = 2048, NBATCH = 8, MP = NBATCH * SEQ, DSEQ = 16, MS = NBATCH * DSEQ, MT = MP + MS;
constexpr int DFF = 2816, NQKV = 3072, PLED = 256, NLAYER = 2, PAST = 2048, BANDL = 512, HW = 512;
constexpr float EPS = 1e-6f, LOG2E = 1.4426950408889634f, QSCALE = 0.125f * LOG2E;
#ifndef SB_EARLY
#define SB_EARLY 1
#endif
constexpr float SB_THR = 7.5e-37f;

constexpr size_t MiB = 1u << 20;
constexpr size_t WS_CTL = 0, WS_SS = 64 * 1024;
constexpr size_t WS_W = 2 * MiB, W_LSTRIDE = 28 * MiB, W_IN = 0, W_OUT = 6 * MiB, W_GU = 8 * MiB, W_DOWN = 19 * MiB, W_PG = 25 * MiB, W_PP = 27 * MiB;
constexpr size_t WS_PB = 58 * MiB, WS_X = 76 * MiB  , WS_XB = 142 * MiB, WS_QKV = 176 * MiB, WS_MIX = 274 * MiB, WS_P = 308 * MiB, WS_END = 342 * MiB;
constexpr int LDS_BYTES = 131072 + 1024;
constexpr size_t WS_BAR = 8192;
constexpr int NWAVES = 8, NTHREADS = 512;

constexpr size_t O_YP = 0, O_YS = (size_t)MP * DM, O_SBK_P = O_YS + (size_t)MS * DM, O_SBV_P = O_SBK_P + (size_t)NLAYER * MP * HW,
                 O_CBK_P = O_SBV_P + (size_t)NLAYER * MP * HW, O_CBV_P = O_CBK_P + (size_t)NLAYER * NBATCH * BANDL * HW,
                 O_SBK_S = O_CBV_P + (size_t)NLAYER * NBATCH * BANDL * HW, O_SBV_S = O_SBK_S + (size_t)NLAYER * MS * HW,
                 O_CBK_S = O_SBV_S + (size_t)NLAYER * MS * HW, O_CBV_S = O_CBK_S + (size_t)NLAYER * MS * HW;

__device__ __forceinline__ unsigned pk2(float lo, float hi) { f32x2_t v = {lo, hi}; bf16x2_t b = __builtin_convertvector(v, bf16x2_t); return __builtin_bit_cast(unsigned, b); }
__device__ __forceinline__ float bf_lo(unsigned w) { return __uint_as_float(w << 16); }
__device__ __forceinline__ float bf_hi(unsigned w) { return __uint_as_float(w & 0xffff0000u); }
__device__ __forceinline__ float partner32(float v) {
    auto rr = __builtin_amdgcn_permlane32_swap(__float_as_uint(v), __float_as_uint(v), false, false);
    return (threadIdx.x & 32) ? __uint_as_float(rr[0]) : __uint_as_float(rr[1]);
}
__device__ __forceinline__ float wave_sum(float v) {
#pragma unroll
    for (int o = 1; o < 64; o <<= 1) v += __shfl_xor(v, o);
    return v;
}
__device__ __forceinline__ float rstd_of(float ss) { return rsqrtf(ss * (1.0f / DM) + EPS); }

template <int I> __device__ __forceinline__ const float* argp() {
    unsigned long long v; const void* ka = (const void*)__builtin_amdgcn_kernarg_segment_ptr();
    asm volatile("s_load_dwordx2 %0, %1, %2\n\ts_waitcnt lgkmcnt(0)" : "=s"(v) : "s"(ka), "i"(I * 8) : "memory");
    return (const float*)(const __attribute__((address_space(1))) float*)v;
}
#define ARG(i) argp<i>()
#define ARG_OUT ((float*)argp<22>())
#define ARG_WS ((unsigned char*)argp<23>())
#define WS_PTR(T, off) ((T*)(ARG_WS + (off)))
#define SSB WS_PTR(float, WS_SS)
#define PB_ WS_PTR(bf16_t, WS_PB)
#define XN_ WS_PTR(bf16_t, WS_X)
#define XB_ WS_PTR(bf16_t, WS_XB)
#define QKV_ WS_PTR(bf16_t, WS_QKV)
#define HB_ WS_PTR(bf16_t, WS_QKV)
#define MIX_ WS_PTR(bf16_t, WS_MIX)
#define PBUF_ WS_PTR(bf16_t, WS_P)
#define WPTR(L, off) ((const bf16_t*)(ARG_WS + WS_W + (size_t)(L) * W_LSTRIDE + (off)))

enum { EP_QKV = 0, EP_RES = 1, EP_GU = 2, EP_P = 3, EP_PLE = 4 };
struct EpiArgs {
    const float* ss_in; float* ss_out;
    const bf16_t* xbase;
    bf16_t* XB; bf16_t* o0; const bf16_t* P;
    float *f_sbk, *f_sbv, *f_cbk, *f_cbv;
    float *s_sbk, *s_sbv, *s_cbk, *s_cbv;
};
template <int MODE> struct Epi {
    static constexpr bool PERM = false, AFTER_DRAIN = false;
    EpiArgs a;
    __device__ __forceinline__ void operator()(const f32x4 (&acc)[2][2][4][2], const pg8::Unit& u, int wr, int wc, int fr, int fq) const {
        if constexpr (MODE == EP_QKV) {
            const int part = u.pn >> 1, cb = (u.pn & 1) * 256 + wc * 32 + 4 * fq;
            bf16_t* ob = a.o0 + (size_t)part * ((size_t)MT * HW);
            float* fo = part == 1 ? a.f_sbk : part == 2 ? a.f_sbv : part == 4 ? a.f_cbk : part == 5 ? a.f_cbv : nullptr;
            const bool band = part >= 4; const float qs = (part == 0 || part == 3) ? QSCALE : 1.f;
#pragma unroll
            for (int ai = 0; ai < 2; ++ai)
#pragma unroll
                for (int m = 0; m < 4; ++m) {
                    const int row = u.pm * 256 + ai * 128 + wr * 64 + m * 16 + fr;
                    const float rs = rstd_of(a.ss_in[row]) * qs;
                    const int t = row & (SEQ - 1);
                    float* frow = nullptr;
                    if (fo) { if (!band) frow = fo + (size_t)row * HW; else if (t >= SEQ - BANDL) frow = fo + ((size_t)(row >> 11) * BANDL + (t - (SEQ - BANDL))) * HW; }
#pragma unroll
                    for (int bj = 0; bj < 2; ++bj)
#pragma unroll
                        for (int n = 0; n < 2; ++n) {
                            const int col = cb + bj * 128 + n * 16; const f32x4 v = acc[ai][bj][m][n] * rs;
                            u32x2 w; w.x = pk2(v[0], v[1]); w.y = pk2(v[2], v[3]);
                            *(u32x2*)(ob + (size_t)row * HW + col) = w;
                            if (frow) __builtin_nontemporal_store(v, (f32x4*)(frow + col));
                        }
                }
        } else if constexpr (MODE == EP_RES || MODE == EP_PLE) {
#pragma unroll
            for (int ai = 0; ai < 2; ++ai)
#pragma unroll
                for (int m = 0; m < 4; ++m) {
                    const int row = u.pm * 256 + ai * 128 + wr * 64 + m * 16 + fr;
                    float rs = 0.f; if constexpr (MODE == EP_PLE) rs = rstd_of(a.ss_in[row]) * (-LOG2E);
                    float s = 0.f;
#pragma unroll
                    for (int bj = 0; bj < 2; ++bj)
#pragma unroll
                        for (int n = 0; n < 2; ++n) {
                            const size_t off = (size_t)row * DM + u.pn * 256 + bj * 128 + wc * 32 + n * 16 + 4 * fq;
                            const u32x2 xw = *(const u32x2*)(a.xbase + off); f32x4 x = {bf_lo(xw.x), bf_hi(xw.x), bf_lo(xw.y), bf_hi(xw.y)}; const f32x4 c = acc[ai][bj][m][n];
                            if constexpr (MODE == EP_RES) x += c;
                            else { const u32x2 pw = *(const u32x2*)(a.P + off);
                                   x[0] += bf_lo(pw.x) * __builtin_amdgcn_rcpf(1.f + __builtin_amdgcn_exp2f(c[0] * rs));
                                   x[1] += bf_hi(pw.x) * __builtin_amdgcn_rcpf(1.f + __builtin_amdgcn_exp2f(c[1] * rs));
                                   x[2] += bf_lo(pw.y) * __builtin_amdgcn_rcpf(1.f + __builtin_amdgcn_exp2f(c[2] * rs));
                                   x[3] += bf_hi(pw.y) * __builtin_amdgcn_rcpf(1.f + __builtin_amdgcn_exp2f(c[3] * rs)); }
                            u32x2 w; w.x = pk2(x[0], x[1]); w.y = pk2(x[2], x[3]); *(u32x2*)(a.XB + off) = w;
                            s += (x[0] * x[0] + x[1] * x[1]) + (x[2] * x[2] + x[3] * x[3]);
                        }
                    s += __shfl_xor(s, 16); s += __shfl_xor(s, 32);
                    if (fq == 0) unsafeAtomicAdd(a.ss_out + row, s);
                }
        } else if constexpr (MODE == EP_GU) {
#pragma unroll
            for (int ai = 0; ai < 2; ++ai)
#pragma unroll
                for (int m = 0; m < 4; ++m) {
                    const int row = u.pm * 256 + ai * 128 + wr * 64 + m * 16 + fr;
                    const float rs = rstd_of(a.ss_in[row]);
#pragma unroll
                    for (int n = 0; n < 2; ++n) {
                        const int col = u.pn * 128 + wc * 32 + n * 16 + 4 * fq;
                        const f32x4 g = acc[ai][0][m][n] * rs, up = acc[ai][1][m][n] * rs; float h[4];
#pragma unroll
                        for (int e = 0; e < 4; ++e) h[e] = g[e] * up[e] * __builtin_amdgcn_rcpf(1.f + __builtin_amdgcn_exp2f(-LOG2E * g[e]));
                        u32x2 w; w.x = pk2(h[0], h[1]); w.y = pk2(h[2], h[3]);
                        *(u32x2*)(a.o0 + (size_t)row * DFF + col) = w;
                    }
                }
        } else {
#pragma unroll
            for (int ai = 0; ai < 2; ++ai)
#pragma unroll
                for (int m = 0; m < 4; ++m) {
                    const int row = u.pm * 256 + ai * 128 + wr * 64 + m * 16 + fr;
#pragma unroll
                    for (int bj = 0; bj < 2; ++bj)
#pragma unroll
                        for (int n = 0; n < 2; ++n) {
                            const size_t off = (size_t)row * DM + u.pn * 256 + bj * 128 + wc * 32 + n * 16 + 4 * fq; const f32x4 v = acc[ai][bj][m][n];
                            u32x2 w; w.x = pk2(v[0], v[1]); w.y = pk2(v[2], v[3]); *(u32x2*)(a.o0 + off) = w;
                        }
                }
        }
    }
};

template <int MODE, int K>
__device__ __forceinline__ void sgemm(LAS unsigned char* lds, const bf16_t* A, const bf16_t* Bt, int ncol32, const EpiArgs& a) {
    const int tid = fresh_tid(), lane = tid & 63, wave = __builtin_amdgcn_readfirstlane(tid >> 6), r = lane & 31, hh = lane >> 5;
    LAS float* red = (LAS float*)lds;
    constexpr int K8 = K >> 3, NK = K8 / 16, UB = NK > 11 ? 11 : NK;
    static_assert(NK % UB == 0, "sgemm: K split");
    const int G = gridDim.x, nunits = 4 * ncol32;
    for (int j = G - 1 - (int)blockIdx.x; j < nunits; j += G) {
        const int rb = j & 3, c0 = 32 * (j >> 2);
        const int brow0 = (MODE == EP_GU) ? ((c0 >> 7) * 256 + (c0 & 127)) : c0;
        const bf16_t* ap = A + (size_t)(32 * rb + r) * K + wave * K8 + 8 * hh;
        const bf16_t* bp = Bt + (size_t)(brow0 + r) * K + wave * K8 + 8 * hh;
        f32x16 acc0 = {}, acc1 = {};
#pragma unroll 1
        for (int kb = 0; kb < NK; kb += UB) {
            bf16x8 af[UB], bf[UB], bf2[MODE == EP_GU ? UB : 1];
#pragma unroll
            for (int i = 0; i < UB; ++i) { af[i] = *(const bf16x8*)(ap + (kb + i) * 16); bf[i] = *(const bf16x8*)(bp + (kb + i) * 16);
                if constexpr (MODE == EP_GU) bf2[i] = *(const bf16x8*)(bp + (size_t)128 * K + (kb + i) * 16); }
#pragma unroll
            for (int i = 0; i < UB; ++i) { acc0 = __builtin_amdgcn_mfma_f32_32x32x16_bf16(af[i], bf[i], acc0, 0, 0, 0);
                if constexpr (MODE == EP_GU) acc1 = __builtin_amdgcn_mfma_f32_32x32x16_bf16(af[i], bf2[i], acc1, 0, 0, 0); }
        }
#pragma unroll
        for (int i = 0; i < 16; ++i) { red[(wave * 16 + i) * 64 + lane] = acc0[i]; if constexpr (MODE == EP_GU) red[8192 + (wave * 16 + i) * 64 + lane] = acc1[i]; }
        __syncthreads();
        const int col = c0 + r;
#pragma unroll
        for (int ii = 0; ii < 2; ++ii) {
            const int i = 2 * wave + ii;
            float v0 = 0.f, v1 = 0.f;
#pragma unroll
            for (int w = 0; w < 8; ++w) { v0 += red[(w * 16 + i) * 64 + lane]; if constexpr (MODE == EP_GU) v1 += red[8192 + (w * 16 + i) * 64 + lane]; }
            const int rs_ = 32 * rb + (i & 3) + 8 * (i >> 2) + 4 * hh, row = MP + rs_;
            if constexpr (MODE == EP_QKV) {
                const int part = c0 >> 9, cc = col & 511;
                const float v = v0 * rstd_of(a.ss_in[row]);
                const float qs = (part == 0 || part == 3) ? QSCALE : 1.f;
                (a.o0 + (size_t)part * ((size_t)MT * HW))[(size_t)row * HW + cc] = (bf16_t)(pk2(v * qs, 0.f) & 0xffffu);
                float* fo = part == 1 ? a.s_sbk : part == 2 ? a.s_sbv : part == 4 ? a.s_cbk : part == 5 ? a.s_cbv : nullptr;
                if (fo) fo[(size_t)rs_ * HW + cc] = v;
            } else if constexpr (MODE == EP_RES || MODE == EP_PLE) {
                const size_t off = (size_t)row * DM + col;
                float x = __uint_as_float((unsigned)a.xbase[off] << 16);
                if constexpr (MODE == EP_RES) x += v0;
                else { const float pv = __uint_as_float((unsigned)a.P[off] << 16); x += pv * __builtin_amdgcn_rcpf(1.f + __builtin_amdgcn_exp2f(-LOG2E * v0 * rstd_of(a.ss_in[row]))); }
                a.XB[off] = (bf16_t)(pk2(x, 0.f) & 0xffffu);
                float s = x * x;
                s += __shfl_xor(s, 1); s += __shfl_xor(s, 2); s += __shfl_xor(s, 4); s += __shfl_xor(s, 8); s += __shfl_xor(s, 16);
                if (r == 0) unsafeAtomicAdd(a.ss_out + row, s);
            } else if constexpr (MODE == EP_GU) {
                const float rs = rstd_of(a.ss_in[row]); const float g = v0 * rs, up = v1 * rs;
                const float h = g * up * __builtin_amdgcn_rcpf(1.f + __builtin_amdgcn_exp2f(-LOG2E * g));
                a.o0[(size_t)row * DFF + col] = (bf16_t)(pk2(h, 0.f) & 0xffffu);
            } else {
                a.o0[(size_t)row * DM + col] = (bf16_t)(pk2(v0, 0.f) & 0xffffu);
            }
        }
        __syncthreads();
    }
}
struct AttnArgs { int L; };
constexpr int AW_V = 0, AW_ST = 4096, AW_BIAS = 8704, AW_BYTES = 10240, ST_PITCH = 144;

template <bool F32> __device__ __forceinline__ void ld_k(bf16x8 (&kf)[4], const void* base, size_t off) {
    if constexpr (!F32) { const bf16_t* p = (const bf16_t*)base + off;
#pragma unroll
        for (int kk = 0; kk < 4; ++kk) kf[kk] = *(const bf16x8*)(p + 8 * kk);
    } else { const float* p = (const float*)base + off;
#pragma unroll
        for (int kk = 0; kk < 4; ++kk) { const f32x4 x = *(const f32x4*)(p + 8 * kk), y = *(const f32x4*)(p + 8 * kk + 4);
            u32x4 w; w.x = pk2(x[0], x[1]); w.y = pk2(x[2], x[3]); w.z = pk2(y[0], y[1]); w.w = pk2(y[2], y[3]); kf[kk] = __builtin_bit_cast(bf16x8, w); }
    }
}
template <bool F32> __device__ __forceinline__ void ld_v(u32x4 (&vr)[4], const void* base, size_t row0, int nvalid, int h, int lane) {
#pragma unroll
    for (int i = 0; i < 4; ++i) { int key = 8 * i + (lane >> 3); key = key < nvalid ? key : nvalid - 1;
        const size_t off = (row0 + key) * HW + h * 64 + (lane & 7) * 8;
        if constexpr (!F32) vr[i] = *(const u32x4*)((const bf16_t*)base + off);
        else { const float* p = (const float*)base + off; const f32x4 x = *(const f32x4*)p, y = *(const f32x4*)(p + 4);
            u32x4 w; w.x = pk2(x[0], x[1]); w.y = pk2(x[2], x[3]); w.z = pk2(y[0], y[1]); w.w = pk2(y[2], y[3]); vr[i] = w; }
    }
}
__device__ __forceinline__ void st_v(LAS unsigned char* vl, const u32x4 (&vr)[4], int lane) {
#pragma unroll
    for (int i = 0; i < 4; ++i) { const int key = 8 * i + (lane >> 3); *(LAS u32x4*)(vl + key * 128 + (((lane & 7) * 16) ^ (((key >> 1) & 1) << 6))) = vr[i]; }
}
typedef short v4i16_t __attribute__((ext_vector_type(4)));
__device__ __forceinline__ s16x4 vtr(LAS unsigned char* p) { return __builtin_bit_cast(s16x4, __builtin_amdgcn_ds_read_tr16_b64_v4i16((LAS v4i16_t*)p)); }
__device__ __forceinline__ void pv_block(f32x16 (&o)[2], LAS unsigned char* vl, const bf16x8 (&pf)[2], int lane) {
    const int q = (lane & 15) >> 2, p = lane & 3, c16 = (lane >> 4) & 1, hh = lane >> 5;
    const int va0 = (4 * hh + q) * 128 + ((32 * c16 + 8 * p) ^ ((q >> 1) << 6));
#pragma unroll
    for (int db = 0; db < 2; ++db)
#pragma unroll
        for (int s = 0; s < 2; ++s) {
            const s16x4 lo = vtr(vl + (va0 ^ (db * 64)) + s * 2048), hi = vtr(vl + (va0 ^ (db * 64)) + s * 2048 + 1024);
            const bf16x8 vf = {lo[0], lo[1], lo[2], lo[3], hi[0], hi[1], hi[2], hi[3]};
            o[db] = __builtin_amdgcn_mfma_f32_32x32x16_bf16(vf, pf[s], o[db], 0, 0, 0);
        }
}
__device__ __forceinline__ f32x16 qk_block(const bf16x8 (&kf)[4], const bf16x8 (&qf)[4]) {
    f32x16 S = {};
#pragma unroll
    for (int kk = 0; kk < 4; ++kk) S = __builtin_amdgcn_mfma_f32_32x32x16_bf16(kf[kk], qf[kk], S, 0, 0, 0);
    return S;
}
__device__ __forceinline__ void sb_block(const f32x16& S, LAS unsigned char* vl, int tq, int keypos0, float& carry, f32x16 (&o)[2], int lane) {
    const int hh = lane >> 5;
    float kp_[16], be[16];
#pragma unroll
    for (int r = 0; r < 16; ++r) {
        const int kp = keypos0 + (r & 3) + 8 * (r >> 2) + 4 * hh; const bool valid = kp < tq;
        const float z = __builtin_amdgcn_fmed3f(S[r], -126.f, 100.f);
        const float t = __builtin_amdgcn_exp2f(z), k = __builtin_amdgcn_rcpf(1.f + t);
        kp_[r] = valid ? k : 1.f; be[r] = valid ? t * k : 0.f;
    }
    float T[4], Tp[4], U[4];
#pragma unroll
    for (int g = 0; g < 4; ++g) { T[g] = (kp_[4 * g] * kp_[4 * g + 1]) * (kp_[4 * g + 2] * kp_[4 * g + 3]); Tp[g] = partner32(T[g]); U[g] = T[g] * Tp[g]; }
    float R[4]; R[3] = 1.f; R[2] = U[3]; R[1] = U[3] * U[2]; R[0] = R[1] * U[1];
    const float tot = R[0] * U[0];
    float w[16];
#pragma unroll
    for (int g = 0; g < 4; ++g) {
        const float b3 = carry * R[g] * (hh == 0 ? Tp[g] : 1.f);
        const float b2 = b3 * kp_[4 * g + 3], b1 = b2 * kp_[4 * g + 2], b0 = b1 * kp_[4 * g + 1];
        w[4 * g + 3] = be[4 * g + 3] * b3; w[4 * g + 2] = be[4 * g + 2] * b2; w[4 * g + 1] = be[4 * g + 1] * b1; w[4 * g + 0] = be[4 * g + 0] * b0;
    }
    carry *= tot;
    bf16x8 pf[2];
#pragma unroll
    for (int s = 0; s < 2; ++s) { u32x4 pw; pw.x = pk2(w[8 * s], w[8 * s + 1]); pw.y = pk2(w[8 * s + 2], w[8 * s + 3]); pw.z = pk2(w[8 * s + 4], w[8 * s + 5]); pw.w = pk2(w[8 * s + 6], w[8 * s + 7]); pf[s] = __builtin_bit_cast(bf16x8, pw); }
    pv_block(o, vl, pf, lane);
}
__device__ __forceinline__ void cb_block(const f32x16& S, bool cbias, LAS unsigned char* vl, const LAS float* bl, int tq, int keypos0, int nvalid, float& m, float& l, f32x16 (&o)[2], int lane) {
    const int hh = lane >> 5;
    float s[16]; float bm = -INFINITY;
    if (cbias) {
        const float cb = bl[256];
#pragma unroll
        for (int r = 0; r < 16; ++r) { s[r] = S[r] + cb; bm = fmaxf(bm, s[r]); }
    } else {
#pragma unroll
        for (int r = 0; r < 16; ++r) {
            const int kr = (r & 3) + 8 * (r >> 2) + 4 * hh; int d = tq - (keypos0 + kr); d = d < -128 ? -128 : (d > 128 ? 128 : d);
            s[r] = (kr < nvalid) ? S[r] + bl[d + 128] : -INFINITY; bm = fmaxf(bm, s[r]);
        }
    }
    bm = fmaxf(bm, partner32(bm));
    if (__any(bm > m + 8.f)) {
        const float mn = fmaxf(m, bm), f = __builtin_amdgcn_exp2f(m - mn); m = mn; l *= f;
#pragma unroll
        for (int db = 0; db < 2; ++db)
#pragma unroll
            for (int r = 0; r < 16; ++r) o[db][r] *= f;
    }
    float w[16], ls = 0.f;
#pragma unroll
    for (int r = 0; r < 16; ++r) { w[r] = __builtin_amdgcn_exp2f(s[r] - m); ls += w[r]; }
    l += ls;
    bf16x8 pf[2];
#pragma unroll
    for (int s2 = 0; s2 < 2; ++s2) { u32x4 pw; pw.x = pk2(w[8 * s2], w[8 * s2 + 1]); pw.y = pk2(w[8 * s2 + 2], w[8 * s2 + 3]); pw.z = pk2(w[8 * s2 + 4], w[8 * s2 + 5]); pw.w = pk2(w[8 * s2 + 6], w[8 * s2 + 7]); pf[s2] = __builtin_bit_cast(bf16x8, pw); }
    pv_block(o, vl, pf, lane);
}
__device__ __forceinline__ void attn_store(f32x16 (&o)[2], float scale, const float* gain, bf16_t* mix, size_t row0, int col0, int nrows, LAS unsigned char* wl, int lane) {
    const int r = lane & 31, hh = lane >> 5;
    f32x4 gvs[2][4];
#pragma unroll
    for (int db = 0; db < 2; ++db)
#pragma unroll
        for (int g = 0; g < 4; ++g) gvs[db][g] = *(const f32x4*)(gain + 32 * db + 8 * g + 4 * hh);
    float ssq = 0.f;
#pragma unroll
    for (int db = 0; db < 2; ++db)
#pragma unroll
        for (int i = 0; i < 16; ++i) { o[db][i] *= scale; ssq += o[db][i] * o[db][i]; }
    ssq += partner32(ssq);
    const float rstd = rsqrtf(ssq * (1.0f / 64.0f) + EPS);
    LAS unsigned char* st = wl + AW_ST;
#pragma unroll
    for (int db = 0; db < 2; ++db)
#pragma unroll
        for (int g = 0; g < 4; ++g) { const int d0 = 32 * db + 8 * g + 4 * hh; const f32x4 gv = gvs[db][g];
            u32x2 w; w.x = pk2(o[db][4 * g] * rstd * gv[0], o[db][4 * g + 1] * rstd * gv[1]); w.y = pk2(o[db][4 * g + 2] * rstd * gv[2], o[db][4 * g + 3] * rstd * gv[3]);
            *(LAS u32x2*)(st + r * ST_PITCH + d0 * 2) = w; }
#pragma unroll
    for (int i = 0; i < 4; ++i) { const int row = 8 * i + (lane >> 3), ch = lane & 7; const u32x4 v = *(const LAS u32x4*)(st + row * ST_PITCH + ch * 16);
        if (row < nrows) *(u32x4*)(mix + (row0 + row) * DM + col0 + ch * 8) = v; }
}

template <bool F32> __device__ __forceinline__ void sb_loop(const void* kbase, const void* vbase, size_t rowbase, int jhi, int h, const bf16x8 (&qf)[4], int tq, float& carry, f32x16 (&o)[2], LAS unsigned char* wl, int lane) {
    const int r = lane & 31, hh = lane >> 5;
    bf16x8 kA[4], kB[4]; u32x4 vA[4], vB[4];
#define SB_LD(KF, VN, jj) do { ld_k<F32>(KF, kbase, (rowbase + 32 * (jj) + r) * HW + h * 64 + 32 * hh); ld_v<F32>(VN, vbase, rowbase + 32 * (jj), 32, h, lane); } while (0)
    SB_LD(kA, vA, jhi); if (jhi >= 1) SB_LD(kB, vB, jhi - 1);
    for (int j = jhi; j >= 0; j -= 2) {
        { const f32x16 S = qk_block(kA, qf); st_v(wl + AW_V, vA, lane); if (j >= 2) SB_LD(kA, vA, j - 2);
          sb_block(S, wl + AW_V, tq, 32 * j, carry, o, lane); }
#if SB_EARLY
        if (__all(carry < SB_THR)) break;
#endif
        if (j < 1) break;
        { const f32x16 S = qk_block(kB, qf); st_v(wl + AW_V, vB, lane); if (j >= 3) SB_LD(kB, vB, j - 3);
          sb_block(S, wl + AW_V, tq, 32 * (j - 1), carry, o, lane); }
#if SB_EARLY
        if (__all(carry < SB_THR)) break;
#endif
    }
#undef SB_LD
}
template <bool SAMPLE> __device__ __forceinline__ void sb_unit(const AttnArgs& A, int b, int h, int qb, LAS unsigned char* wl, int lane) {
    const int r = lane & 31, hh = lane >> 5;
    const bf16_t* Qa = QKV_; const bf16_t* Ka = Qa + (size_t)1 * MT * HW; const bf16_t* Va = Qa + (size_t)2 * MT * HW;
    int tq; size_t qrow;
    if (SAMPLE) { tq = PAST + (r & 15); qrow = (size_t)MP + b * DSEQ + (r & 15); } else { tq = 32 * qb + r; qrow = (size_t)b * SEQ + tq; }
    bf16x8 qf[4]; ld_k<false>(qf, Qa, qrow * HW + h * 64 + 32 * hh);
    float carry = 1.f; f32x16 o[2]; o[0] = f32x16{}; o[1] = f32x16{};
    if (SAMPLE) {
        bf16x8 kf[4]; u32x4 vr[4]; const size_t row0 = (size_t)MP + b * DSEQ;
        ld_k<false>(kf, Ka, (row0 + (r & 15)) * HW + h * 64 + 32 * hh); ld_v<false>(vr, Va, row0, DSEQ, h, lane); st_v(wl + AW_V, vr, lane);
        { const f32x16 S = qk_block(kf, qf); sb_block(S, wl + AW_V, tq, PAST, carry, o, lane); }
        sb_loop<true>(ARG(4) + (size_t)A.L * NBATCH * PAST * HW, ARG(5) + (size_t)A.L * NBATCH * PAST * HW, (size_t)b * PAST, PAST / 32 - 1, h, qf, tq, carry, o, wl, lane);
        attn_store(o, 1.f, ARG(11) + A.L * HW + h * 64, MIX_, row0, h * 64, DSEQ, wl, lane);
    } else {
        sb_loop<false>(Ka, Va, (size_t)b * SEQ, qb, h, qf, tq, carry, o, wl, lane);
        attn_store(o, 1.f, ARG(11) + A.L * HW + h * 64, MIX_, (size_t)b * SEQ + 32 * qb, h * 64, 32, wl, lane);
    }
}
template <bool F32> __device__ __forceinline__ void cb_loop(const void* kbase, const void* vbase, size_t rowbase, int jlo, int jhi, int pos0, int h, const bf16x8 (&qf)[4], int tq, float& m, float& l, f32x16 (&o)[2], LAS unsigned char* wl, int lane) {
    const int r = lane & 31, hh = lane >> 5;
    bf16x8 kA[4], kB[4]; u32x4 vA[4], vB[4];
    const int tqmin = tq - r;
#define CB_LD(KF, VN, jj) do { ld_k<F32>(KF, kbase, (rowbase + 32 * (jj) + r) * HW + h * 64 + 32 * hh); ld_v<F32>(VN, vbase, rowbase + 32 * (jj), 32, h, lane); } while (0)
    CB_LD(kA, vA, jlo); if (jlo + 1 <= jhi) CB_LD(kB, vB, jlo + 1);
    for (int j = jlo; j <= jhi; j += 2) {
        { const f32x16 S = qk_block(kA, qf); st_v(wl + AW_V, vA, lane); if (j + 2 <= jhi) CB_LD(kA, vA, j + 2);
          const bool cbias = __builtin_amdgcn_readfirstlane(pos0 + 32 * j + 31 + 128 <= tqmin);
          cb_block(S, cbias, wl + AW_V, (const LAS float*)(wl + AW_BIAS), tq, pos0 + 32 * j, 32, m, l, o, lane); }
        if (j + 1 > jhi) break;
        { const f32x16 S = qk_block(kB, qf); st_v(wl + AW_V, vB, lane); if (j + 3 <= jhi) CB_LD(kB, vB, j + 3);
          const bool cbias = __builtin_amdgcn_readfirstlane(pos0 + 32 * (j + 1) + 31 + 128 <= tqmin);
          cb_block(S, cbias, wl + AW_V, (const LAS float*)(wl + AW_BIAS), tq, pos0 + 32 * (j + 1), 32, m, l, o, lane); }
    }
#undef CB_LD
}
template <bool SAMPLE> __device__ __forceinline__ void cb_unit(const AttnArgs& A, int b, int h, int qb, LAS unsigned char* wl, int lane) {
    const int r = lane & 31, hh = lane >> 5;
    const bf16_t* Qb = QKV_ + (size_t)3 * MT * HW; const bf16_t* Kb = Qb + (size_t)1 * MT * HW; const bf16_t* Vb = Qb + (size_t)2 * MT * HW;
    LAS float* bl = (LAS float*)(wl + AW_BIAS);
    { const float* relp = ARG(10) + (size_t)A.L * 257 * 8 + h; float bv[5];
#pragma unroll
      for (int i = 0; i < 5; ++i) { const int idx = lane + 64 * i; bv[i] = relp[(idx < 257 ? idx : 256) * 8]; }
#pragma unroll
      for (int i = 0; i < 5; ++i) { const int idx = lane + 64 * i; if (idx < 257) bl[idx] = bv[i] * LOG2E; } }
    int tq; size_t qrow;
    if (SAMPLE) { tq = PAST + (r & 15); qrow = (size_t)MP + b * DSEQ + (r & 15); } else { tq = 32 * qb + r; qrow = (size_t)b * SEQ + tq; }
    bf16x8 qf[4]; ld_k<false>(qf, Qb, qrow * HW + h * 64 + 32 * hh);
    float m = -INFINITY, l = 0.f; f32x16 o[2]; o[0] = f32x16{}; o[1] = f32x16{};
    if (SAMPLE) {
        cb_loop<true>(ARG(6) + (size_t)A.L * NBATCH * BANDL * HW, ARG(7) + (size_t)A.L * NBATCH * BANDL * HW, (size_t)b * BANDL, 0, BANDL / 32 - 1, PAST - BANDL, h, qf, tq, m, l, o, wl, lane);
        bf16x8 kf[4]; u32x4 vr[4]; const size_t row0 = (size_t)MP + b * DSEQ;
        ld_k<false>(kf, Kb, (row0 + (r & 15)) * HW + h * 64 + 32 * hh); ld_v<false>(vr, Vb, row0, DSEQ, h, lane); st_v(wl + AW_V, vr, lane);
        { const f32x16 S = qk_block(kf, qf); cb_block(S, false, wl + AW_V, bl, tq, PAST, DSEQ, m, l, o, lane); }
        l += partner32(l);
        attn_store(o, 1.0f / l, ARG(12) + A.L * HW + h * 64, MIX_, row0, HW + h * 64, DSEQ, wl, lane);
    } else {
        const int c = qb >> 1, clo = c - 8 < 0 ? 0 : c - 8;
        cb_loop<false>(Kb, Vb, (size_t)b * SEQ, 2 * clo, 2 * c + 1, 0, h, qf, tq, m, l, o, wl, lane);
        l += partner32(l);
        attn_store(o, 1.0f / l, ARG(12) + A.L * HW + h * 64, MIX_, (size_t)b * SEQ + 32 * qb, HW + h * 64, 32, wl, lane);
    }
}
__device__ __forceinline__ void sb_unit_p64(const AttnArgs& A, int b, int h, int m, LAS unsigned char* wl, int lane) {
    const int r = lane & 31, hh = lane >> 5;
    const bf16_t* Qa = QKV_; const bf16_t* Ka = Qa + (size_t)1 * MT * HW; const bf16_t* Va = Qa + (size_t)2 * MT * HW;
    const size_t rowbase = (size_t)b * SEQ;
    const int tq0 = 64 * m + r, tq1 = tq0 + 32;
    bf16x8 qf0[4];
    LAS unsigned char* q1p = wl + AW_ST + lane * 64;
    { bf16x8 qf1[4]; ld_k<false>(qf1, Qa, (rowbase + tq1) * HW + h * 64 + 32 * hh);
#pragma unroll
      for (int kk = 0; kk < 4; ++kk) *(LAS bf16x8*)(q1p + kk * 16) = qf1[kk]; }
    ld_k<false>(qf0, Qa, (rowbase + tq0) * HW + h * 64 + 32 * hh);
    float c0 = 1.f, c1 = 1.f; f32x16 o0[2], o1[2]; o0[0] = f32x16{}; o0[1] = f32x16{}; o1[0] = f32x16{}; o1[1] = f32x16{};
    bf16x8 kf[4]; u32x4 vn[4];
    int j = 2 * m + 1;
    ld_k<false>(kf, Ka, (rowbase + 32 * j + r) * HW + h * 64 + 32 * hh); ld_v<false>(vn, Va, rowbase + 32 * j, 32, h, lane);
    bool live0 = true, live1 = true;
    for (; j >= 0; --j) {
        const bool act0 = live0 && (j <= 2 * m);
        st_v(wl + AW_V, vn, lane);
        if (j > 0) ld_v<false>(vn, Va, rowbase + 32 * (j - 1), 32, h, lane);
        if (live1) { bf16x8 qf1[4];
#pragma unroll
            for (int kk = 0; kk < 4; ++kk) qf1[kk] = *(const LAS bf16x8*)(q1p + kk * 16);
            const f32x16 S1 = qk_block(kf, qf1); sb_block(S1, wl + AW_V, tq1, 32 * j, c1, o1, lane); if (__all(c1 < SB_THR)) live1 = false; }
        if (act0) { const f32x16 S0 = qk_block(kf, qf0);
            if (j > 0) ld_k<false>(kf, Ka, (rowbase + 32 * (j - 1) + r) * HW + h * 64 + 32 * hh);
            sb_block(S0, wl + AW_V, tq0, 32 * j, c0, o0, lane); if (__all(c0 < SB_THR)) live0 = false; }
        else if (j > 0) ld_k<false>(kf, Ka, (rowbase + 32 * (j - 1) + r) * HW + h * 64 + 32 * hh);
        if (!live0 && !live1) break;
    }
    attn_store(o0, 1.f, ARG(11) + A.L * HW + h * 64, MIX_, rowbase + 64 * m, h * 64, 32, wl, lane);
    attn_store(o1, 1.f, ARG(11) + A.L * HW + h * 64, MIX_, rowbase + 64 * m + 32, h * 64, 32, wl, lane);
}
__device__ __forceinline__ void cb_unit_p64(const AttnArgs& A, int b, int h, int c, LAS unsigned char* wl, int lane) {
    const int r = lane & 31, hh = lane >> 5;
    const bf16_t* Qb = QKV_ + (size_t)3 * MT * HW; const bf16_t* Kb = Qb + (size_t)1 * MT * HW; const bf16_t* Vb = Qb + (size_t)2 * MT * HW;
    LAS float* bl = (LAS float*)(wl + AW_BIAS);
    { const float* relp = ARG(10) + (size_t)A.L * 257 * 8 + h; float bv[5];
#pragma unroll
      for (int i = 0; i < 5; ++i) { const int idx = lane + 64 * i; bv[i] = relp[(idx < 257 ? idx : 256) * 8]; }
#pragma unroll
      for (int i = 0; i < 5; ++i) { const int idx = lane + 64 * i; if (idx < 257) bl[idx] = bv[i] * LOG2E; } }
    const int tq0 = 64 * c + r, tq1 = tq0 + 32; const size_t rowbase = (size_t)b * SEQ;
    bf16x8 qf0[4], qf1[4];
    ld_k<false>(qf0, Qb, (rowbase + tq0) * HW + h * 64 + 32 * hh); ld_k<false>(qf1, Qb, (rowbase + tq1) * HW + h * 64 + 32 * hh);
    float m0 = -INFINITY, l0 = 0.f, m1 = -INFINITY, l1 = 0.f;
    f32x16 o0[2], o1[2]; o0[0] = f32x16{}; o0[1] = f32x16{}; o1[0] = f32x16{}; o1[1] = f32x16{};
    const int clo = c - 8 < 0 ? 0 : c - 8, jlo = 2 * clo, jhi = 2 * c + 1;
    bf16x8 kf[4]; u32x4 vn[4];
    ld_k<false>(kf, Kb, (rowbase + 32 * jlo + r) * HW + h * 64 + 32 * hh); ld_v<false>(vn, Vb, rowbase + 32 * jlo, 32, h, lane);
    for (int j = jlo; j <= jhi; ++j) {
        const f32x16 S0 = qk_block(kf, qf0), S1 = qk_block(kf, qf1);
        st_v(wl + AW_V, vn, lane);
        if (j < jhi) { ld_k<false>(kf, Kb, (rowbase + 32 * (j + 1) + r) * HW + h * 64 + 32 * hh); ld_v<false>(vn, Vb, rowbase + 32 * (j + 1), 32, h, lane); }
        const bool cbias = (32 * j + 31 + 128 <= 64 * c);
        cb_block(S0, cbias, wl + AW_V, bl, tq0, 32 * j, 32, m0, l0, o0, lane);
        cb_block(S1, cbias, wl + AW_V, bl, tq1, 32 * j, 32, m1, l1, o1, lane);
    }
    l0 += partner32(l0); l1 += partner32(l1);
    attn_store(o0, 1.0f / l0, ARG(12) + A.L * HW + h * 64, MIX_, rowbase + 64 * c, HW + h * 64, 32, wl, lane);
    attn_store(o1, 1.0f / l1, ARG(12) + A.L * HW + h * 64, MIX_, rowbase + 64 * c + 32, HW + h * 64, 32, wl, lane);
}
constexpr int AU_ITEMS = 2048;
__device__ __forceinline__ void attn_phase(const AttnArgs& A, LAS unsigned char* lds) {
    const int tid_ = fresh_tid(), lane = tid_ & 63, wave = __builtin_amdgcn_readfirstlane(tid_ >> 6);
    LAS unsigned char* wl = lds + wave * AW_BYTES;
#pragma unroll 1
    for (int cu = (int)blockIdx.x * NWAVES + wave; cu < AU_ITEMS; cu += (int)gridDim.x * NWAVES) {
        const int blk = cu >> 3, kk_ = (blk >> 3) * 8 + (cu & 7);
        const int bh = (blk & 7) * 8 + (kk_ >> 5), p = kk_ & 31;
        cb_unit_p64(A, bh >> 3, bh & 7, 31 - p, wl, lane);
        sb_unit_p64(A, bh >> 3, bh & 7, 31 - p, wl, lane);
        if (p >= 28) { const int li = bh * 4 + (p - 28);
            if (li < 64) sb_unit<true>(A, li >> 3, li & 7, 0, wl, lane);
            else if (li < 128) cb_unit<true>(A, (li - 64) >> 3, (li - 64) & 7, 0, wl, lane); }
    }
}
typedef unsigned gu32_plain;
#define XB_TMO      128
#define XB_XCNT(j)  (256  + 64 * (j))
#define XB_XSUB(j)  (1280 + 64 * (j))
#define XB_XGEN(j)  (2304 + 64 * (j))
#define XB_TOP      3328
#define XB_TOPGEN   3392
#define XCD_BAR_WORDS 3456
#define XB_SPIN_CAP (1u << 18)

__device__ __forceinline__ unsigned xb_ld(unsigned* p)              { return __hip_atomic_load(p, __ATOMIC_RELAXED, __HIP_MEMORY_SCOPE_AGENT); }
__device__ __forceinline__ unsigned xb_add(unsigned* p, unsigned v) { return __hip_atomic_fetch_add(p, v, __ATOMIC_RELAXED, __HIP_MEMORY_SCOPE_AGENT); }
__device__ __forceinline__ unsigned xb_xcc_id() { return (unsigned)__builtin_amdgcn_s_getreg((3 << 11) | 20) & 0xFu; }
#define XB_SPIN(cond, bar) do { unsigned _sp = 0; while (cond) { __builtin_amdgcn_s_sleep(1); \
    if ((++_sp & 255u) == 0u) { if (xb_ld(&(bar)[XB_TMO])) break; if (_sp > XB_SPIN_CAP) { atomicAdd(&(bar)[XB_TMO], 1u); break; } } } } while (0)

struct XcdBarrier {
    unsigned* bar; unsigned x;
    volatile LAS unsigned* st;
};

__device__ __forceinline__ XcdBarrier xcd_barrier_post(unsigned* bar, volatile LAS unsigned* st) {
    XcdBarrier b; b.bar = bar; b.x = xb_xcc_id(); b.st = st;
    if (threadIdx.x == 0) (void)xb_add(&bar[XB_XCNT(b.x)], 1u);
    return b;
}
__device__ __forceinline__ void xcd_barrier_complete(unsigned* bar, unsigned x, unsigned& nloc, unsigned& nx) {
    const unsigned G = gridDim.x * gridDim.y * gridDim.z;
    unsigned sum, cnt, mine, sp = 0u;
    for (;;) {
        sum = 0u; cnt = 0u; mine = 0u;
#pragma unroll
        for (unsigned j = 0; j < 16; ++j) { const unsigned c = xb_ld(&bar[XB_XCNT(j)]); sum += c; cnt += (c > 0u) ? 1u : 0u; mine = (j == x) ? c : mine; }
        if (sum == G) break;
        __builtin_amdgcn_s_sleep(1);
        if ((++sp & 255u) == 0u) { if (xb_ld(&bar[XB_TMO])) break; if (sp > XB_SPIN_CAP) { atomicAdd(&bar[XB_TMO], 1u); break; } }
    }
    nloc = mine > 0u ? mine : 1u; nx = cnt > 0u ? cnt : 1u;
}

__device__ __forceinline__ void xcd_barrier(const XcdBarrier& b) {
    asm volatile("s_waitcnt vmcnt(0)" ::: "memory");
    __syncthreads();
    if (threadIdx.x == 0) {
        unsigned* bar = b.bar;
        __builtin_amdgcn_s_waitcnt(0);
        unsigned nloc = b.st[0], nx = b.st[1];
        if (nloc == 0u) { xcd_barrier_complete(bar, b.x, nloc, nx); b.st[0] = nloc; b.st[1] = nx; }
        const unsigned old = xb_add(&bar[XB_XSUB(b.x)], 1u);
        const unsigned gen = old / nloc;
        if (old + 1u == (gen + 1u) * nloc) {
            __builtin_amdgcn_fence(__ATOMIC_RELEASE, "agent");
            asm volatile("s_waitcnt vmcnt(0)" ::: "memory");
            const unsigned og = xb_add(&bar[XB_TOP], 1u);
            const unsigned tg = og / nx;
            if (og + 1u == (tg + 1u) * nx) xb_add(&bar[XB_TOPGEN], 1u);
            else XB_SPIN(xb_ld(&bar[XB_TOPGEN]) == tg, bar);
            __builtin_amdgcn_fence(__ATOMIC_ACQUIRE, "agent");
            xb_add(&bar[XB_XGEN(b.x)], 1u);
            asm volatile("s_waitcnt vmcnt(0)" ::: "memory");
        } else {
            XB_SPIN(xb_ld(&bar[XB_XGEN(b.x)]) == gen, bar);
            __builtin_amdgcn_fence(__ATOMIC_ACQUIRE, "agent");
            asm volatile("s_waitcnt vmcnt(0)" ::: "memory");
        }
    }
    __syncthreads();
}

constexpr int CI_IN = 16 * 96, CI_OUT = 16 * 32, CI_G = 16 * 88, CI_D = 44 * 32, CI_PG = 16 * 32, CI_PP = 4 * 32, CI_L = CI_IN + CI_OUT + 2 * CI_G + CI_D + CI_PG + CI_PP;
struct ConvD { const float* W; const float* gain; bf16_t* WT; int K, N, kind, k0, n0; };
__device__ __forceinline__ ConvD conv_decode(int it) {
    const int L = it / CI_L; int r = it % CI_L; ConvD d;
    if (r < CI_IN) { d.W = ARG(9) + (size_t)L * DM * NQKV; d.gain = ARG(8) + L * DM; d.WT = (bf16_t*)WPTR(L, W_IN); d.K = DM; d.N = NQKV; d.kind = 0; }
    else if ((r -= CI_IN) < CI_OUT) { d.W = ARG(13) + (size_t)L * DM * DM; d.gain = nullptr; d.WT = (bf16_t*)WPTR(L, W_OUT); d.K = DM; d.N = DM; d.kind = 0; }
    else if ((r -= CI_OUT) < CI_G) { d.W = ARG(15) + (size_t)L * DM * DFF; d.gain = ARG(14) + L * DM; d.WT = (bf16_t*)WPTR(L, W_GU); d.K = DM; d.N = DFF; d.kind = 1; }
    else if ((r -= CI_G) < CI_G) { d.W = ARG(16) + (size_t)L * DM * DFF; d.gain = ARG(14) + L * DM; d.WT = (bf16_t*)WPTR(L, W_GU); d.K = DM; d.N = DFF; d.kind = 2; }
    else if ((r -= CI_G) < CI_D) { d.W = ARG(17) + (size_t)L * DFF * DM; d.gain = nullptr; d.WT = (bf16_t*)WPTR(L, W_DOWN); d.K = DFF; d.N = DM; d.kind = 0; }
    else if ((r -= CI_D) < CI_PG) { d.W = ARG(19) + (size_t)L * DM * DM; d.gain = ARG(18) + L * DM; d.WT = (bf16_t*)WPTR(L, W_PG); d.K = DM; d.N = DM; d.kind = 0; }
    else { r -= CI_PG; d.W = ARG(20) + (size_t)L * PLED * DM; d.gain = nullptr; d.WT = (bf16_t*)WPTR(L, W_PP); d.K = PLED; d.N = DM; d.kind = 0; }
    const int nblk = d.N / 32; d.k0 = 64 * (r / nblk); d.n0 = 32 * (r % nblk);
    return d;
}
__device__ __forceinline__ void conv_load(const ConvD& d, float (&v)[32], f32x4 (&g)[2], int lane) {
    const float* p = d.W + (size_t)(d.k0 + (lane >> 5)) * d.N + d.n0 + (lane & 31);
#pragma unroll
    for (int i = 0; i < 32; ++i) v[i] = p[(size_t)(2 * i) * d.N];
    if (d.gain) { g[0] = *(const f32x4*)(d.gain + d.k0 + 8 * (lane & 7)); g[1] = *(const f32x4*)(d.gain + d.k0 + 8 * (lane & 7) + 4); }
    else { g[0] = (f32x4){1.f, 1.f, 1.f, 1.f}; g[1] = g[0]; }
}
__device__ __forceinline__ void conv_proc(const ConvD& d, const float (&v)[32], const f32x4 (&g)[2], LAS float* scr, int lane) {
#pragma unroll
    for (int i = 0; i < 32; ++i) scr[(2 * i + (lane >> 5)) * 33 + (lane & 31)] = v[i];
    asm volatile("s_waitcnt lgkmcnt(0)" ::: "memory");
    const int c = lane & 7;
#pragma unroll
    for (int j = 0; j < 4; ++j) { const int n = (lane >> 3) + 8 * j; const LAS float* s = scr + (8 * c) * 33 + n;
        u32x4 o; o.x = pk2(s[0 * 33] * g[0][0], s[1 * 33] * g[0][1]); o.y = pk2(s[2 * 33] * g[0][2], s[3 * 33] * g[0][3]);
        o.z = pk2(s[4 * 33] * g[1][0], s[5 * 33] * g[1][1]); o.w = pk2(s[6 * 33] * g[1][2], s[7 * 33] * g[1][3]);
        const int gn = d.n0 + n; const int drow = d.kind == 0 ? gn : ((gn >> 7) * 256 + (gn & 127) + (d.kind == 2 ? 128 : 0));
        *(u32x4*)(d.WT + (size_t)drow * d.K + d.k0 + 8 * c) = o; }
    asm volatile("s_waitcnt lgkmcnt(0)" ::: "memory");
}

#ifdef NO_SGEMM
#define SG(...)
#else
#define SG(...) __VA_ARGS__
#endif
#ifndef GP1
#define GP1(...) __VA_ARGS__
#endif
#ifndef GP2
#define GP2(...) __VA_ARGS__
#endif
#ifndef GP3
#define GP3(...) __VA_ARGS__
#endif
#ifndef GP4
#define GP4(...) __VA_ARGS__
#endif
#ifndef GP5
#define GP5(...) __VA_ARGS__
#endif
#ifndef GP6
#define GP6(...) __VA_ARGS__
#endif
#ifdef NO_SGEMM
#define SG(...)
#else
#define SG(...) __VA_ARGS__
#endif
#ifndef GP1
#define GP1(...) __VA_ARGS__
#endif
#ifndef GP2
#define GP2(...) __VA_ARGS__
#endif
#ifndef GP3
#define GP3(...) __VA_ARGS__
#endif
#ifndef GP4
#define GP4(...) __VA_ARGS__
#endif
#ifndef GP5
#define GP5(...) __VA_ARGS__
#endif
#ifndef GP6
#define GP6(...) __VA_ARGS__
#endif
struct Args { const float* in[22]; float* out; unsigned char* ws; };

#ifndef PROBE_SEL
#define PROBE_SEL -1
#endif
#if PROBE_SEL >= 0
#define TSTAMP(cat) do { if (blockIdx.x == 0 && fresh_tid() == 0) { const unsigned long long t_ = __builtin_amdgcn_s_memrealtime(); unsigned long long* tsb = WS_PTR(unsigned long long, WS_CTL + 4096); \
    tsb[16 + (cat)] += t_ - tsb[0]; tsb[0] = t_; } } while (0)
#else
#define TSTAMP(cat) do {} while (0)
#endif
__global__ void __launch_bounds__(NTHREADS, 2) hymba_fwd(Args args) {
    extern __shared__ __attribute__((aligned(16))) unsigned char lds_raw[];
    cg::grid_group grid = cg::this_grid();
    LAS unsigned char* lds = (LAS unsigned char*)lds_raw;
    const int G = gridDim.x;

    { const int tid0 = fresh_tid();
      if (blockIdx.x == 0) for (int i = tid0; i < XCD_BAR_WORDS; i += NTHREADS) WS_PTR(unsigned, WS_BAR)[i] = 0u;
      if (tid0 < 2) ((LAS unsigned*)(lds + 131072))[tid0] = 0u; }
    grid.sync();
    (void)xcd_barrier_post(WS_PTR(unsigned, WS_BAR), (volatile LAS unsigned*)(lds + 131072));
#define GSYNC() do { XcdBarrier xb_; xb_.bar = WS_PTR(unsigned, WS_BAR); xb_.x = xb_xcc_id(); xb_.st = (volatile LAS unsigned*)(lds + 131072); xcd_barrier(xb_); } while (0)
#if PROBE_SEL >= 0
    if (blockIdx.x == 0 && fresh_tid() == 0) { unsigned long long* tsb = WS_PTR(unsigned long long, WS_CTL + 4096); for (int i = 0; i < 48; ++i) tsb[i] = 0; tsb[0] = __builtin_amdgcn_s_memrealtime(); }
#endif
    {
        const int tid = fresh_tid(), lane = tid & 63, wave = __builtin_amdgcn_readfirstlane(tid >> 6);
        const int gw = blockIdx.x * NWAVES + wave, NGW = G * NWAVES;
        { float* ssb = SSB; for (int i = blockIdx.x * NTHREADS + tid; i < 6 * MT; i += G * NTHREADS) ssb[MT + i] = 0.f;
          if (blockIdx.x == 0 && tid < 16) WS_PTR(unsigned, WS_CTL)[tid] = 0u;
          }
        LAS float* scr = (LAS float*)(lds + wave * 8704);
        { constexpr int NIT = NLAYER * CI_L; int it = gw;
          float vA[32], vB[32]; f32x4 gA[2], gB[2]; ConvD dA, dB;
          if (it < NIT) { dA = conv_decode(it); conv_load(dA, vA, gA, lane); }
          while (it < NIT) {
            const int itn = it + NGW;
            if (itn < NIT) { dB = conv_decode(itn); conv_load(dB, vB, gB, lane); }
            conv_proc(dA, vA, gA, scr, lane);
            if (itn >= NIT) break;
            it = itn + NGW;
            if (it < NIT) { dA = conv_decode(it); conv_load(dA, vA, gA, lane); }
            conv_proc(dB, vB, gB, scr, lane);
          } }
        { const float* pp = ARG(2); const float* ps = ARG(3); bf16_t* PB = PB_;
          for (int it0 = 4 * gw; it0 < NLAYER * MT; it0 += 4 * NGW) {
            f32x4 v[4];
#pragma unroll
            for (int rr = 0; rr < 4; ++rr) { const int it = it0 + rr, L = it / MT, row = it % MT;
                const float* src = row < MP ? pp + ((size_t)L * MP + row) * PLED : ps + ((size_t)L * MS + (row - MP)) * PLED;
                v[rr] = *((const f32x4*)src + lane); }
#pragma unroll
            for (int rr = 0; rr < 4; ++rr) { u32x2 w; w.x = pk2(v[rr][0], v[rr][1]); w.y = pk2(v[rr][2], v[rr][3]); *((u32x2*)(PB + (size_t)(it0 + rr) * PLED) + lane) = w; }
          } }
        { const float* x_p = ARG(0); const float* x_s = ARG(1); bf16_t* XB = XN_; float* ssb = SSB;
          for (int row0 = 2 * gw; row0 < MT; row0 += 2 * NGW) {
            f32x4 v[2][4];
#pragma unroll
            for (int rr = 0; rr < 2; ++rr) { const int row = row0 + rr; const float* src = row < MP ? x_p + (size_t)row * DM : x_s + (size_t)(row - MP) * DM;
#pragma unroll
                for (int j = 0; j < 4; ++j) v[rr][j] = *((const f32x4*)src + lane + 64 * j); }
#pragma unroll
            for (int rr = 0; rr < 2; ++rr) { float s2 = 0.f;
#pragma unroll
                for (int j = 0; j < 4; ++j) { const f32x4 t = v[rr][j]; s2 += (t[0] * t[0] + t[1] * t[1]) + (t[2] * t[2] + t[3] * t[3]);
                    u32x2 w; w.x = pk2(t[0], t[1]); w.y = pk2(t[2], t[3]); *((u32x2*)(XB + (size_t)(row0 + rr) * DM) + lane + 64 * j) = w; }
                s2 = wave_sum(s2);
                if (lane == 0) ssb[row0 + rr] = s2; }
          } }
    }
    TSTAMP(0); GSYNC(); TSTAMP(8);

    for (int L = 0; L < NLAYER; ++L) {
#define SS_MIX (SSB + (size_t)(3 * L) * MT)
#define SS_FFN (SSB + (size_t)(3 * L + 1) * MT)
#define SS_PLE (SSB + (size_t)(3 * L + 2) * MT)
#define SS_NEXT (SSB + (size_t)(3 * L + 3) * MT)
        { EpiArgs q{}; q.ss_in = SS_MIX; q.o0 = QKV_;
          q.f_sbk = ARG_OUT + O_SBK_P + (size_t)L * MP * HW; q.f_sbv = ARG_OUT + O_SBV_P + (size_t)L * MP * HW;
          q.f_cbk = ARG_OUT + O_CBK_P + (size_t)L * NBATCH * BANDL * HW; q.f_cbv = ARG_OUT + O_CBV_P + (size_t)L * NBATCH * BANDL * HW;
          pg8::Gemm g{XN_, WPTR(L, W_IN), MP, NQKV, DM}; pg8::StaticOrder S; S.init(MP, NQKV, G, (int)blockIdx.x);
          Epi<EP_QKV> E{q};
          GP1(pg8::gemm_phase<Epi<EP_QKV>, pg8::StaticOrder, true, true>(lds, g, S, E);) TSTAMP(1); }
        { EpiArgs q{}; q.ss_in = SS_MIX; q.o0 = QKV_;
          q.s_sbk = ARG_OUT + O_SBK_S + (size_t)L * MS * HW; q.s_sbv = ARG_OUT + O_SBV_S + (size_t)L * MS * HW;
          q.s_cbk = ARG_OUT + O_CBK_S + (size_t)L * MS * HW; q.s_cbv = ARG_OUT + O_CBV_S + (size_t)L * MS * HW;
          SG(sgemm<EP_QKV, DM>(lds, XN_ + (size_t)MP * DM, WPTR(L, W_IN), NQKV / 32, q);) TSTAMP(7); }
        GSYNC(); TSTAMP(8);
        { AttnArgs A{}; A.L = L;
#ifndef NO_ATTN
          attn_phase(A, lds);
#endif
          TSTAMP(2); }
        GSYNC(); TSTAMP(2);
        { EpiArgs q{}; q.XB = XB_; q.xbase = XN_; q.ss_out = SS_FFN;
          pg8::Gemm g{MIX_, WPTR(L, W_OUT), MP, DM, DM}; pg8::StaticOrder S; S.init(MP, DM, G, (int)blockIdx.x);
          Epi<EP_RES> E{q};
          GP2(pg8::gemm_phase<Epi<EP_RES>, pg8::StaticOrder, true, true>(lds, g, S, E);) TSTAMP(3); }
        { EpiArgs q{}; q.XB = XB_; q.xbase = XN_; q.ss_out = SS_FFN;
          SG(sgemm<EP_RES, DM>(lds, MIX_ + (size_t)MP * DM, WPTR(L, W_OUT), DM / 32, q);) TSTAMP(7); }
        GSYNC(); TSTAMP(8);
        { EpiArgs q{}; q.ss_in = SS_FFN; q.o0 = HB_;
          pg8::Gemm g{XB_, WPTR(L, W_GU), MP, 2 * DFF, DM}; pg8::StaticOrder S; S.init(MP, 2 * DFF, G, (int)blockIdx.x);
          Epi<EP_GU> E{q};
          GP4(pg8::gemm_phase<Epi<EP_GU>, pg8::StaticOrder, true, true>(lds, g, S, E);) TSTAMP(4);
          SG(sgemm<EP_GU, DM>(lds, XB_ + (size_t)MP * DM, WPTR(L, W_GU), DFF / 32, q);) TSTAMP(7); }
        { EpiArgs q2{}; q2.o0 = PBUF_;
          int kp = PLED; asm volatile("" : "+s"(kp));
          const int Gh = G >> 1;
          if ((int)blockIdx.x >= Gh) {
            pg8::Gemm g2{PB_ + (size_t)L * MT * PLED, WPTR(L, W_PP), MP, DM, kp}; pg8::StaticOrder S; S.init(MP, DM, G - Gh, (int)blockIdx.x - Gh);
            Epi<EP_P> E2{q2};
            GP3(pg8::gemm_phase<Epi<EP_P>, pg8::StaticOrder, true, true>(lds, g2, S, E2);) TSTAMP(10);
          }
          SG(sgemm<EP_P, PLED>(lds, PB_ + ((size_t)L * MT + MP) * PLED, WPTR(L, W_PP), DM / 32, q2);) TSTAMP(7); }
        GSYNC(); TSTAMP(8);
        { EpiArgs q{}; q.XB = XB_; q.xbase = XB_; q.ss_out = SS_PLE;
          pg8::Gemm g{HB_, WPTR(L, W_DOWN), MP, DM, DFF}; pg8::StaticOrder S; S.init(MP, DM, G, (int)blockIdx.x);
          Epi<EP_RES> E{q};
          GP5(pg8::gemm_phase<Epi<EP_RES>, pg8::StaticOrder, true, true>(lds, g, S, E);) TSTAMP(5);
          SG(sgemm<EP_RES, DFF>(lds, HB_ + (size_t)MP * DFF, WPTR(L, W_DOWN), DM / 32, q);) TSTAMP(7); }
        GSYNC(); TSTAMP(8);
        { EpiArgs q{}; q.XB = XN_  ; q.P = PBUF_; q.xbase = XB_; q.ss_in = SS_PLE; q.ss_out = SS_NEXT;
          pg8::Gemm g{XB_, WPTR(L, W_PG), MP, DM, DM}; pg8::StaticOrder S; S.init(MP, DM, G, (int)blockIdx.x);
          Epi<EP_PLE> E{q};
          GP6(pg8::gemm_phase<Epi<EP_PLE>, pg8::StaticOrder, true, true>(lds, g, S, E);) TSTAMP(6);
          SG(sgemm<EP_PLE, DM>(lds, XB_ + (size_t)MP * DM, WPTR(L, W_PG), DM / 32, q);) TSTAMP(7); }
        GSYNC(); TSTAMP(8);
    }
    {
        const int tid = fresh_tid(), lane = tid & 63, wave = __builtin_amdgcn_readfirstlane(tid >> 6);
        const int gw = blockIdx.x * NWAVES + wave, NGW = G * NWAVES;
        const float* ssf = SSB + (size_t)(3 * NLAYER) * MT; const float* gf = ARG(21); const bf16_t* XN = XN_; float* out = ARG_OUT;
        for (int row0 = 2 * gw; row0 < MT; row0 += 2 * NGW) {
            u32x2 xv[2][4];
#pragma unroll
            for (int rr = 0; rr < 2; ++rr)
#pragma unroll
                for (int j = 0; j < 4; ++j) xv[rr][j] = *((const u32x2*)(XN + (size_t)(row0 + rr) * DM) + lane + 64 * j);
#pragma unroll
            for (int rr = 0; rr < 2; ++rr) { const int row = row0 + rr; const float rs = rstd_of(ssf[row]);
                float* dst = row < MP ? out + O_YP + (size_t)row * DM : out + O_YS + (size_t)(row - MP) * DM;
#pragma unroll
                for (int j = 0; j < 4; ++j) { const f32x4 gv = *((const f32x4*)gf + lane + 64 * j); const u32x2 w = xv[rr][j];
                    const f32x4 v = {bf_lo(w.x), bf_hi(w.x), bf_lo(w.y), bf_hi(w.y)};
                    __builtin_nontemporal_store(v * rs * gv, (f32x4*)dst + lane + 64 * j); } }
        }
    }
#if PROBE_SEL >= 0
    TSTAMP(11); grid.sync();
    if (blockIdx.x == 0 && fresh_tid() == 0) { const unsigned long long* tsb = WS_PTR(unsigned long long, WS_CTL + 4096); float* o = ARG_OUT + O_YS; unsigned long long tv = 0; if (PROBE_SEL == 20) tv = tsb[16+1] + tsb[16+3] + tsb[16+10] + tsb[16+4] + tsb[16+5] + tsb[16+6]; else if (PROBE_SEL == 21) tv = tsb[16+0] + tsb[16+11]; else if (PROBE_SEL < 16) tv = tsb[16 + PROBE_SEL]; o[0] += (float)tv * 2.5e-5f; }
#endif
}

extern "C" void kernel_launch(void* const* d_in, const int* in_sizes, int n_in, void* d_out, int out_size, void* d_ws, size_t ws_size, hipStream_t stream) {
    static int grid = 0;
    if (grid == 0) {
        int dev = 0, cus = 0, per_cu = 0;
        hipGetDevice(&dev);
        hipDeviceGetAttribute(&cus, hipDeviceAttributeMultiprocessorCount, dev);
        hipFuncSetAttribute((const void*)hymba_fwd, hipFuncAttributeMaxDynamicSharedMemorySize, LDS_BYTES);
        hipOccupancyMaxActiveBlocksPerMultiprocessor(&per_cu, (const void*)hymba_fwd, NTHREADS, LDS_BYTES);
        if (per_cu < 1) per_cu = 1;
        grid = cus * per_cu;
        if (n_in != 22 || ws_size < WS_END) { fprintf(stderr, "kernel_launch: unexpected n_in %d / ws_size %zu\n", n_in, ws_size); }
    }
    Args a{};
    for (int i = 0; i < 22; ++i) a.in[i] = (const float*)d_in[i];
    a.out = (float*)d_out; a.ws = (unsigned char*)d_ws;
    void* kargs[] = {&a};
    hipError_t e = hipLaunchCooperativeKernel((const void*)hymba_fwd, dim3(grid), dim3(NTHREADS), kargs, LDS_BYTES, stream);
    if (e != hipSuccess) fprintf(stderr, "cooperative launch failed: %s (grid %d)\n", hipGetErrorString(e), grid);
}
```

```cpp
#include <hip/hip_runtime.h>
#include <hip/hip_cooperative_groups.h>
#include <cstdio>
#include <cstdint>
namespace cg = cooperative_groups;
__device__ __forceinline__ int fresh_tid() { int t = threadIdx.x; asm volatile("" : "+v"(t)); return t; }
namespace pg8 {
#define PG8_LAS __attribute__((address_space(3)))
typedef unsigned short bf16_t;
typedef short bf16x8 __attribute__((ext_vector_type(8)));
typedef float f32x4 __attribute__((ext_vector_type(4)));
typedef unsigned u32x4 __attribute__((ext_vector_type(4)));
constexpr int BM = 256, BK = 64, HALF = 128, HTB = HALF * BK * 2  , STAGE_BYTES = 8 * HTB, NXCD = 8, WGM = 8;

__host__ __device__ __forceinline__ int lds_byte(int r, int c) { const int st = (r >> 4) * 2 + (c >> 5), rr = r & 15, cc = c & 31, ob = rr * 64 + cc * 2; return st * 1024 + (ob ^ (((ob >> 9) & 1) << 5)); }
__host__ __device__ __forceinline__ void stage_rc(int b, int& R, int& C) { const int st = b / 1024, sb = b % 1024, swz = sb ^ (((sb >> 9) & 1) << 5); R = (st >> 1) * 16 + swz / 64; C = (st & 1) * 32 + (swz % 64) / 2; }
__host__ __device__ __forceinline__ int perm32(int rho) { const int n = rho >> 4, i = rho & 15; return 8 * (i >> 2) + 4 * n + (i & 3); }

struct Unit { int pm, pn; };
struct Gemm { const bf16_t* A; const bf16_t* Bt; int M, N, K; };

struct StaticOrder {
    int nM, nN, nwg, G, c;
    __host__ __device__ void init(int M, int N, int G_, int c_) { nM = M / BM; nN = N / BM; nwg = nM * nN; G = G_; c = c_; }
    __host__ __device__ bool next(int i, Unit& u) const {
        const long L = (long)i * G + c; if (L >= nwg) return false;
        int wgid = (int)L; { const int q = nwg / NXCD, r = nwg % NXCD, xcd = wgid % NXCD, off = wgid / NXCD; wgid = (xcd < r ? xcd * (q + 1) : r * (q + 1) + (xcd - r) * q) + off; }
        const int nig = WGM * nN, gid = wgid / nig, fm = gid * WGM, gsz = (nM - fm) < WGM ? (nM - fm) : WGM;
        u.pm = fm + ((wgid % nig) % gsz); u.pn = (wgid % nig) / gsz; return true;
    }
    __device__ __forceinline__ void a_ready(const Unit&) const {}
    __device__ __forceinline__ void done(const Unit&) const {}
};

template <class Epi, class Sched, bool ALIGN_EPI = false, bool SP2 = false>
__device__ __forceinline__ void gemm_phase(PG8_LAS unsigned char* lds, const Gemm g, const Sched& S, const Epi& E) {
    const int tid = fresh_tid(), wid = __builtin_amdgcn_readfirstlane(tid >> 6), lane = tid & 63, wr = wid >> 2, wc = wid & 3, fr = lane & 15, fq = lane >> 4;
    const int K = g.K, nt = K / BK;
    unsigned voffA[2], voffB[2];
#pragma unroll
    for (int i = 0; i < 2; ++i) { int R, C; stage_rc(tid * 16 + i * 8192, R, C); const int Rb = Epi::PERM ? ((R & ~31) + perm32(R & 31)) : R;
        voffA[i] = (unsigned)(R * K + C) * 2u; voffB[i] = (unsigned)(Rb * K + C) * 2u; }
    const size_t kstep = (size_t)(BK * 2);
    const size_t hstep = (size_t)HALF * K * 2;
    const size_t tstep = 2 * hstep;
    const unsigned ldsw = (unsigned)wid * 1024u;
    const int aoff = lds_byte(wr * 64 + fr, fq * 8), boff = lds_byte(wc * 32 + fr, fq * 8);
#define PG8_SA(b, h) (((b) * 2 + (h)) * HTB)
#define PG8_SB(b, h) ((4 + (b) * 2 + (h)) * HTB)
#define PG8_STAGE(bufoff, gbase, voff) do { _Pragma("unroll") for (int _i = 0; _i < 2; ++_i) \
        __builtin_amdgcn_global_load_lds((const unsigned*)((const char*)(gbase) + (voff)[_i]), (PG8_LAS unsigned*)(lds + (bufoff) + ldsw + _i * 8192), 16, 0, 0); } while (0)
#define PG8_LDA(dst, b, h) do { _Pragma("unroll") for (int m = 0; m < 4; ++m) _Pragma("unroll") for (int k = 0; k < 2; ++k) dst[m][k] = *(const PG8_LAS bf16x8*)(lds + PG8_SA(b, h) + aoff + m * 2048 + k * 1024); } while (0)
#define PG8_LDB(dst, b, h) do { _Pragma("unroll") for (int n = 0; n < 2; ++n) _Pragma("unroll") for (int k = 0; k < 2; ++k) dst[n][k] = *(const PG8_LAS bf16x8*)(lds + PG8_SB(b, h) + boff + n * 2048 + k * 1024); } while (0)
#define PG8_MMA(ai, bj, At, Bt) do { __builtin_amdgcn_s_setprio(1); _Pragma("unroll") for (int m = 0; m < 4; ++m) _Pragma("unroll") for (int n = 0; n < 2; ++n) _Pragma("unroll") for (int k = 0; k < 2; ++k) \
        acc[ai][bj][m][n] = __builtin_amdgcn_mfma_f32_16x16x32_bf16(Bt[n][k], At[m][k], acc[ai][bj][m][n], 0, 0, 0); __builtin_amdgcn_s_setprio(0); } while (0)
#define PG8_WAIT_V(n) asm volatile("s_waitcnt vmcnt(" #n ")" ::: "memory")
#define PG8_WAIT_L(n) asm volatile("s_waitcnt lgkmcnt(" #n ")" ::: "memory")
#define PG8_BAR __builtin_amdgcn_s_barrier()
#define PG8_SCHED __builtin_amdgcn_sched_barrier(0)
    Unit cur, nxt; int ui = 0;
    if (!S.next(0, cur)) return;
    f32x4 acc[2][2][4][2];
#pragma unroll
    for (int a = 0; a < 2; ++a)
#pragma unroll
        for (int b = 0; b < 2; ++b)
#pragma unroll
            for (int m = 0; m < 4; ++m)
#pragma unroll
                for (int n = 0; n < 2; ++n) acc[a][b][m][n] = (f32x4){0.f, 0.f, 0.f, 0.f};
    bf16x8 At[4][2], B0[2][2], B1[2][2];
    const char* cA = (const char*)g.A + (size_t)cur.pm * tstep; const char* cB = (const char*)g.Bt + (size_t)cur.pn * tstep;
    S.a_ready(cur);
    if constexpr (SP2) {
        PG8_STAGE(PG8_SB(0, 0), cB, voffB); PG8_STAGE(PG8_SB(0, 1), cB + hstep, voffB); PG8_STAGE(PG8_SA(0, 0), cA, voffA); PG8_STAGE(PG8_SA(0, 1), cA + hstep, voffA);
        if (wr == 1) PG8_BAR;
        PG8_WAIT_V(2); PG8_BAR;
        PG8_STAGE(PG8_SB(1, 0), cB + kstep, voffB); PG8_STAGE(PG8_SA(1, 0), cA + kstep, voffA); PG8_STAGE(PG8_SB(1, 1), cB + hstep + kstep, voffB);
        PG8_WAIT_V(6); PG8_BAR;
    } else {
        PG8_STAGE(PG8_SB(0, 0), cB, voffB); PG8_STAGE(PG8_SA(0, 0), cA, voffA); PG8_STAGE(PG8_SB(0, 1), cB + hstep, voffB); PG8_STAGE(PG8_SA(0, 1), cA + hstep, voffA);
        if (wr == 1) PG8_BAR;
        PG8_WAIT_V(4); PG8_BAR;
        PG8_STAGE(PG8_SB(1, 0), cB + kstep, voffB); PG8_STAGE(PG8_SA(1, 0), cA + kstep, voffA); PG8_STAGE(PG8_SB(1, 1), cB + hstep + kstep, voffB);
        PG8_WAIT_V(6); PG8_BAR;
    }
    for (;;) {
        const bool has_next = S.next(ui + 1, nxt);
        const char* nA = has_next ? (const char*)g.A + (size_t)nxt.pm * tstep : cA; const char* nB = has_next ? (const char*)g.Bt + (size_t)nxt.pn * tstep : cB;
        for (int t = 0; t < nt; t += 2) {
            const bool last = (t == nt - 2);
            const char* a1 = cA + (size_t)(t + 1) * kstep;
            const char* a2 = last ? nA : cA + (size_t)(t + 2) * kstep; const char* b2 = last ? nB : cB + (size_t)(t + 2) * kstep;
            const char* a3 = a2 + kstep; const char* b3 = b2 + kstep;
            if (last && has_next) S.a_ready(nxt);
            if constexpr (SP2) {
            PG8_LDB(B0, 0, 0); PG8_LDB(B1, 0, 1); PG8_SCHED; PG8_LDA(At, 0, 0); PG8_STAGE(PG8_SA(1, 1), a1 + hstep, voffA);
            PG8_WAIT_V(8); PG8_WAIT_L(0); PG8_BAR; PG8_MMA(0, 0, At, B0); PG8_MMA(0, 1, At, B1); PG8_BAR; PG8_SCHED;
            PG8_LDA(At, 0, 1); PG8_STAGE(PG8_SB(0, 0), b2, voffB); PG8_STAGE(PG8_SB(0, 1), b2 + hstep, voffB); PG8_STAGE(PG8_SA(0, 0), a2, voffA);
            PG8_WAIT_V(8); PG8_WAIT_L(0); PG8_BAR; PG8_MMA(1, 0, At, B0); PG8_MMA(1, 1, At, B1); PG8_BAR; PG8_SCHED;
            PG8_LDB(B0, 1, 0); PG8_LDB(B1, 1, 1); PG8_SCHED; PG8_LDA(At, 1, 0); PG8_STAGE(PG8_SA(0, 1), a2 + hstep, voffA);
            PG8_WAIT_V(8); PG8_WAIT_L(0); PG8_BAR; PG8_MMA(0, 0, At, B0); PG8_MMA(0, 1, At, B1); PG8_BAR; PG8_SCHED;
            PG8_LDA(At, 1, 1); PG8_STAGE(PG8_SB(1, 0), b3, voffB); PG8_STAGE(PG8_SB(1, 1), b3 + hstep, voffB); PG8_STAGE(PG8_SA(1, 0), a3, voffA);
            PG8_WAIT_V(8); PG8_WAIT_L(0); PG8_BAR; PG8_MMA(1, 0, At, B0); PG8_MMA(1, 1, At, B1); PG8_BAR; PG8_SCHED;
            } else {
            PG8_LDB(B0, 0, 0); PG8_SCHED; PG8_LDA(At, 0, 0); PG8_STAGE(PG8_SA(1, 1), a1 + hstep, voffA);
            PG8_WAIT_L(8); PG8_BAR; PG8_WAIT_L(0); PG8_MMA(0, 0, At, B0); PG8_BAR; PG8_SCHED;
            PG8_LDB(B1, 0, 1); PG8_STAGE(PG8_SB(0, 0), b2, voffB);
            PG8_BAR; PG8_WAIT_L(0); PG8_MMA(0, 1, At, B1); PG8_BAR;
            PG8_LDA(At, 0, 1); PG8_STAGE(PG8_SA(0, 0), a2, voffA);
            PG8_BAR; PG8_WAIT_L(0); PG8_MMA(1, 0, At, B0); PG8_BAR; PG8_SCHED;
            PG8_STAGE(PG8_SB(0, 1), b2 + hstep, voffB);
            PG8_WAIT_V(6); PG8_BAR; PG8_MMA(1, 1, At, B1); PG8_BAR;
            PG8_LDB(B0, 1, 0); PG8_SCHED; PG8_LDA(At, 1, 0); PG8_STAGE(PG8_SA(0, 1), a2 + hstep, voffA);
            PG8_WAIT_L(8); PG8_BAR; PG8_WAIT_L(0); PG8_MMA(0, 0, At, B0); PG8_BAR; PG8_SCHED;
            PG8_LDB(B1, 1, 1); PG8_STAGE(PG8_SB(1, 0), b3, voffB);
            PG8_BAR; PG8_WAIT_L(0); PG8_MMA(0, 1, At, B1); PG8_BAR;
            PG8_LDA(At, 1, 1); PG8_STAGE(PG8_SA(1, 0), a3, voffA);
            PG8_BAR; PG8_WAIT_L(0); PG8_MMA(1, 0, At, B0); PG8_BAR; PG8_SCHED;
            PG8_STAGE(PG8_SB(1, 1), b3 + hstep, voffB);
            PG8_WAIT_V(6); PG8_BAR; PG8_MMA(1, 1, At, B1); PG8_BAR;
            }
        }
        if constexpr (ALIGN_EPI) { if (wr == 0) PG8_BAR; }
        if constexpr (!Epi::AFTER_DRAIN) { E(acc, cur, wr, wc, fr, fq); S.done(cur); }
        if (!has_next) break;
#pragma unroll
        for (int a = 0; a < 2; ++a)
#pragma unroll
            for (int b = 0; b < 2; ++b)
#pragma unroll
                for (int m = 0; m < 4; ++m)
#pragma unroll
                    for (int n = 0; n < 2; ++n) acc[a][b][m][n] = (f32x4){0.f, 0.f, 0.f, 0.f};
        cur = nxt; cA = nA; cB = nB; ++ui;
        if constexpr (ALIGN_EPI) { if (wr == 1) PG8_BAR; }
    }
    PG8_WAIT_V(0);
    if constexpr (!ALIGN_EPI) { if (wr == 0) PG8_BAR; }
    PG8_BAR;
    if constexpr (Epi::AFTER_DRAIN) { E.fused(acc, cur, wr, wc, fr, fq, lds, wid, lane); S.done(cur); }
#undef PG8_SA
#undef PG8_SB
#undef PG8_STAGE
#undef PG8_LDA
#undef PG8_LDB
#undef PG8_MMA
#undef PG8_WAIT_V
#undef PG8_WAIT_L
#undef PG8_BAR
#undef PG8_SCHED
}
}

#define LAS __attribute__((address_space(3)))
using pg8::bf16_t; using pg8::bf16x8; using pg8::f32x4; using pg8::u32x4;
typedef short s16x4 __attribute__((ext_vector_type(4)));
typedef float f32x16 __attribute__((ext_vector_type(16)));
typedef unsigned u32x2 __attribute__((ext_vector_type(2)));
typedef float f32x2_t __attribute__((ext_vector_type(2)));
typedef __bf16 bf16x2_t __attribute__((ext_vector_type(2)));

constexpr int DM = 1024, SEQ = 2048, NBATCH = 8, MP = NBATCH * SEQ, DSEQ = 16, MS = NBATCH * DSEQ, MT = MP + MS;
constexpr int DFF = 2816, NQKV = 3072, PLED = 256, NLAYER = 2, PAST = 2048, BANDL = 512, HW = 512;
constexpr float EPS = 1e-6f, LOG2E = 1.4426950408889634f, QSCALE = 0.125f * LOG2E;
#ifndef SB_EARLY
#define SB_EARLY 1
#endif
constexpr float SB_THR = 7.5e-37f;

constexpr size_t MiB = 1u << 20;
constexpr size_t WS_CTL = 0, WS_SS = 64 * 1024;
constexpr size_t WS_W = 2 * MiB, W_LSTRIDE = 28 * MiB, W_IN = 0, W_OUT = 6 * MiB, W_GU = 8 * MiB, W_DOWN = 19 * MiB, W_PG = 25 * MiB, W_PP = 27 * MiB;
constexpr size_t WS_PB = 58 * MiB, WS_X = 76 * MiB  , WS_XB = 142 * MiB, WS_QKV = 176 * MiB, WS_MIX = 274 * MiB, WS_P = 308 * MiB, WS_END = 342 * MiB;
constexpr int LDS_BYTES = 131072 + 1024;
constexpr size_t WS_BAR = 8192;
constexpr int NWAVES = 8, NTHREADS = 512;

constexpr size_t O_YP = 0, O_YS = (size_t)MP * DM, O_SBK_P = O_YS + (size_t)MS * DM, O_SBV_P = O_SBK_P + (size_t)NLAYER * MP * HW,
                 O_CBK_P = O_SBV_P + (size_t)NLAYER * MP * HW, O_CBV_P = O_CBK_P + (size_t)NLAYER * NBATCH * BANDL * HW,
                 O_SBK_S = O_CBV_P + (size_t)NLAYER * NBATCH * BANDL * HW, O_SBV_S = O_SBK_S + (size_t)NLAYER * MS * HW,
                 O_CBK_S = O_SBV_S + (size_t)NLAYER * MS * HW, O_CBV_S = O_CBK_S + (size_t)NLAYER * MS * HW;

__device__ __forceinline__ unsigned pk2(float lo, float hi) { f32x2_t v = {lo, hi}; bf16x2_t b = __builtin_convertvector(v, bf16x2_t); return __builtin_bit_cast(unsigned, b); }
__device__ __forceinline__ float bf_lo(unsigned w) { return __uint_as_float(w << 16); }
__device__ __forceinline__ float bf_hi(unsigned w) { return __uint_as_float(w & 0xffff0000u); }
__device__ __forceinline__ float partner32(float v) {
    auto rr = __builtin_amdgcn_permlane32_swap(__float_as_uint(v), __float_as_uint(v), false, false);
    return (threadIdx.x & 32) ? __uint_as_float(rr[0]) : __uint_as_float(rr[1]);
}
__device__ __forceinline__ float wave_sum(float v) {
#pragma unroll
    for (int o = 1; o < 64; o <<= 1) v += __shfl_xor(v, o);
    return v;
}
__device__ __forceinline__ float rstd_of(float ss) { return rsqrtf(ss * (1.0f / DM) + EPS); }

template <int I> __device__ __forceinline__ const float* argp() {
    unsigned long long v; const void* ka = (const void*)__builtin_amdgcn_kernarg_segment_ptr();
    asm volatile("s_load_dwordx2 %0, %1, %2\n\ts_waitcnt lgkmcnt(0)" : "=s"(v) : "s"(ka), "i"(I * 8) : "memory");
    return (const float*)(const __attribute__((address_space(1))) float*)v;
}
#define ARG(i) argp<i>()
#define ARG_OUT ((float*)argp<22>())
#define ARG_WS ((unsigned char*)argp<23>())
#define WS_PTR(T, off) ((T*)(ARG_WS + (off)))
#define SSB WS_PTR(float, WS_SS)
#define PB_ WS_PTR(bf16_t, WS_PB)
#define XN_ WS_PTR(bf16_t, WS_X)
#define XB_ WS_PTR(bf16_t, WS_XB)
#define QKV_ WS_PTR(bf16_t, WS_QKV)
#define HB_ WS_PTR(bf16_t, WS_QKV)
#define MIX_ WS_PTR(bf16_t, WS_MIX)
#define PBUF_ WS_PTR(bf16_t, WS_P)
#define WPTR(L, off) ((const bf16_t*)(ARG_WS + WS_W + (size_t)(L) * W_LSTRIDE + (off)))

enum { EP_QKV = 0, EP_RES = 1, EP_GU = 2, EP_P = 3, EP_PLE = 4 };
struct EpiArgs {
    const float* ss_in; float* ss_out;
    const bf16_t* xbase;
    bf16_t* XB; bf16_t* o0; const bf16_t* P;
    float *f_sbk, *f_sbv, *f_cbk, *f_cbv;
    float *s_sbk, *s_sbv, *s_cbk, *s_cbv;
};
template <int MODE> struct Epi {
    static constexpr bool PERM = false, AFTER_DRAIN = false;
    EpiArgs a;
    __device__ __forceinline__ void operator()(const f32x4 (&acc)[2][2][4][2], const pg8::Unit& u, int wr, int wc, int fr, int fq) const {
        if constexpr (MODE == EP_QKV) {
            const int part = u.pn >> 1, cb = (u.pn & 1) * 256 + wc * 32 + 4 * fq;
            bf16_t* ob = a.o0 + (size_t)part * ((size_t)MT * HW);
            float* fo = part == 1 ? a.f_sbk : part == 2 ? a.f_sbv : part == 4 ? a.f_cbk : part == 5 ? a.f_cbv : nullptr;
            const bool band = part >= 4; const float qs = (part == 0 || part == 3) ? QSCALE : 1.f;
#pragma unroll
            for (int ai = 0; ai < 2; ++ai)
#pragma unroll
                for (int m = 0; m < 4; ++m) {
                    const int row = u.pm * 256 + ai * 128 + wr * 64 + m * 16 + fr;
                    const float rs = rstd_of(a.ss_in[row]) * qs;
                    const int t = row & (SEQ - 1);
                    float* frow = nullptr;
                    if (fo) { if (!band) frow = fo + (size_t)row * HW; else if (t >= SEQ - BANDL) frow = fo + ((size_t)(row >> 11) * BANDL + (t - (SEQ - BANDL))) * HW; }
#pragma unroll
                    for (int bj = 0; bj < 2; ++bj)
#pragma unroll
                        for (int n = 0; n < 2; ++n) {
                            const int col = cb + bj * 128 + n * 16; const f32x4 v = acc[ai][bj][m][n] * rs;
                            u32x2 w; w.x = pk2(v[0], v[1]); w.y = pk2(v[2], v[3]);
                            *(u32x2*)(ob + (size_t)row * HW + col) = w;
                            if (frow) __builtin_nontemporal_store(v, (f32x4*)(frow + col));
                        }
                }
        } else if constexpr (MODE == EP_RES || MODE == EP_PLE) {
#pragma unroll
            for (int ai = 0; ai < 2; ++ai)
#pragma unroll
                for (int m = 0; m < 4; ++m) {
                    const int row = u.pm * 256 + ai * 128 + wr * 64 + m * 16 + fr;
                    float rs = 0.f; if constexpr (MODE == EP_PLE) rs = rstd_of(a.ss_in[row]) * (-LOG2E);
                    float s = 0.f;
#pragma unroll
                    for (int bj = 0; bj < 2; ++bj)
#pragma unroll
                        for (int n = 0; n < 2; ++n) {
                            const size_t off = (size_t)row * DM + u.pn * 256 + bj * 128 + wc * 32 + n * 16 + 4 * fq;
                            const u32x2 xw = *(const u32x2*)(a.xbase + off); f32x4 x = {bf_lo(xw.x), bf_hi(xw.x), bf_lo(xw.y), bf_hi(xw.y)}; const f32x4 c = acc[ai][bj][m][n];
                            if constexpr (MODE == EP_RES) x += c;
                            else { const u32x2 pw = *(const u32x2*)(a.P + off);
                                   x[0] += bf_lo(pw.x) * __builtin_amdgcn_rcpf(1.f + __builtin_amdgcn_exp2f(c[0] * rs));
                                   x[1] += bf_hi(pw.x) * __builtin_amdgcn_rcpf(1.f + __builtin_amdgcn_exp2f(c[1] * rs));
                                   x[2] += bf_lo(pw.y) * __builtin_amdgcn_rcpf(1.f + __builtin_amdgcn_exp2f(c[2] * rs));
                                   x[3] += bf_hi(pw.y) * __builtin_amdgcn_rcpf(1.f + __builtin_amdgcn_exp2f(c[3] * rs)); }
                            u32x2 w; w.x = pk2(x[0], x[1]); w.y = pk2(x[2], x[3]); *(u32x2*)(a.XB + off) = w;
                            s += (x[0] * x[0] + x[1] * x[1]) + (x[2] * x[2] + x[3] * x[3]);
                        }
                    s += __shfl_xor(s, 16); s += __shfl_xor(s, 32);
                    if (fq == 0) unsafeAtomicAdd(a.ss_out + row, s);
                }
        } else if constexpr (MODE == EP_GU) {
#pragma unroll
            for (int ai = 0; ai < 2; ++ai)
#pragma unroll
                for (int m = 0; m < 4; ++m) {
                    const int row = u.pm * 256 + ai * 128 + wr * 64 + m * 16 + fr;
                    const float rs = rstd_of(a.ss_in[row]);
#pragma unroll
                    for (int n = 0; n < 2; ++n) {
                        const int col = u.pn * 128 + wc * 32 + n * 16 + 4 * fq;
                        const f32x4 g = acc[ai][0][m][n] * rs, up = acc[ai][1][m][n] * rs; float h[4];
#pragma unroll
                        for (int e = 0; e < 4; ++e) h[e] = g[e] * up[e] * __builtin_amdgcn_rcpf(1.f + __builtin_amdgcn_exp2f(-LOG2E * g[e]));
                        u32x2 w; w.x = pk2(h[0], h[1]); w.y = pk2(h[2], h[3]);
                        *(u32x2*)(a.o0 + (size_t)row * DFF + col) = w;
                    }
                }
        } else {
#pragma unroll
            for (int ai = 0; ai < 2; ++ai)
#pragma unroll
                for (int m = 0; m < 4; ++m) {
                    const int row = u.pm * 256 + ai * 128 + wr * 64 + m * 16 + fr;
#pragma unroll
                    for (int bj = 0; bj < 2; ++bj)
#pragma unroll
                        for (int n = 0; n < 2; ++n) {
                            const size_t off = (size_t)row * DM + u.pn * 256 + bj * 128 + wc * 32 + n * 16 + 4 * fq; const f32x4 v = acc[ai][bj][m][n];
                            u32x2 w; w.x = pk2(v[0], v[1]); w.y = pk2(v[2], v[3]); *(u32x2*)(a.o0 + off) = w;
                        }
                }
        }
    }
};

template <int MODE, int K>
__device__ __forceinline__ void sgemm(LAS unsigned char* lds, const bf16_t* A, const bf16_t* Bt, int ncol32, const EpiArgs& a) {
    const int tid = fresh_tid(), lane = tid & 63, wave = __builtin_amdgcn_readfirstlane(tid >> 6), r = lane & 31, hh = lane >> 5;
    LAS float* red = (LAS float*)lds;
    constexpr int K8 = K >> 3, NK = K8 / 16, UB = NK > 11 ? 11 : NK;
    static_assert(NK % UB == 0, "sgemm: K split");
    const int G = gridDim.x, nunits = 4 * ncol32;
    for (int j = G - 1 - (int)blockIdx.x; j < nunits; j += G) {
        const int rb = j & 3, c0 = 32 * (j >> 2);
        const int brow0 = (MODE == EP_GU) ? ((c0 >> 7) * 256 + (c0 & 127)) : c0;
        const bf16_t* ap = A + (size_t)(32 * rb + r) * K + wave * K8 + 8 * hh;
        const bf16_t* bp = Bt + (size_t)(brow0 + r) * K + wave * K8 + 8 * hh;
        f32x16 acc0 = {}, acc1 = {};
#pragma unroll 1
        for (int kb = 0; kb < NK; kb += UB) {
            bf16x8 af[UB], bf[UB], bf2[MODE == EP_GU ? UB : 1];
#pragma unroll
            for (int i = 0; i < UB; ++i) { af[i] = *(const bf16x8*)(ap + (kb + i) * 16); bf[i] = *(const bf16x8*)(bp + (kb + i) * 16);
                if constexpr (MODE == EP_GU) bf2[i] = *(const bf16x8*)(bp + (size_t)128 * K + (kb + i) * 16); }
#pragma unroll
            for (int i = 0; i < UB; ++i) { acc0 = __builtin_amdgcn_mfma_f32_32x32x16_bf16(af[i], bf[i], acc0, 0, 0, 0);
                if constexpr (MODE == EP_GU) acc1 = __builtin_amdgcn_mfma_f32_32x32x16_bf16(af[i], bf2[i], acc1, 0, 0, 0); }
        }
#pragma unroll
        for (int i = 0; i < 16; ++i) { red[(wave * 16 + i) * 64 + lane] = acc0[i]; if constexpr (MODE == EP_GU) red[8192 + (wave * 16 + i) * 64 + lane] = acc1[i]; }
        __syncthreads();
        const int col = c0 + r;
#pragma unroll
        for (int ii = 0; ii < 2; ++ii) {
            const int i = 2 * wave + ii;
            float v0 = 0.f, v1 = 0.f;
#pragma unroll
            for (int w = 0; w < 8; ++w) { v0 += red[(w * 16 + i) * 64 + lane]; if constexpr (MODE == EP_GU) v1 += red[8192 + (w * 16 + i) * 64 + lane]; }
            const int rs_ = 32 * rb + (i & 3) + 8 * (i >> 2) + 4 * hh, row = MP + rs_;
            if constexpr (MODE == EP_QKV) {
                const int part = c0 >> 9, cc = col & 511;
                const float v = v0 * rstd_of(a.ss_in[row]);
                const float qs = (part == 0 || part == 3) ? QSCALE : 1.f;
                (a.o0 + (size_t)part * ((size_t)MT * HW))[(size_t)row * HW + cc] = (bf16_t)(pk2(v * qs, 0.f) & 0xffffu);
                float* fo = part == 1 ? a.s_sbk : part == 2 ? a.s_sbv : part == 4 ? a.s_cbk : part == 5 ? a.s_cbv : nullptr;
                if (fo) fo[(size_t)rs_ * HW + cc] = v;
            } else if constexpr (MODE == EP_RES || MODE == EP_PLE) {
                const size_t off = (size_t)row * DM + col;
                float x = __uint_as_float((unsigned)a.xbase[off] << 16);
                if constexpr (MODE == EP_RES) x += v0;
                else { const float pv = __uint_as_float((unsigned)a.P[off] << 16); x += pv * __builtin_amdgcn_rcpf(1.f + __builtin_amdgcn_exp2f(-LOG2E * v0 * rstd_of(a.ss_in[row]))); }
                a.XB[off] = (bf16_t)(pk2(x, 0.f) & 0xffffu);
                float s = x * x;
                s += __shfl_xor(s, 1); s += __shfl_xor(s, 2); s += __shfl_xor(s, 4); s += __shfl_xor(s, 8); s += __shfl_xor(s, 16);
                if (r == 0) unsafeAtomicAdd(a.ss_out + row, s);
            } else if constexpr (MODE == EP_GU) {
                const float rs = rstd_of(a.ss_in[row]); const float g = v0 * rs, up = v1 * rs;
                const float h = g * up * __builtin_amdgcn_rcpf(1.f + __builtin_amdgcn_exp2f(-LOG2E * g));
                a.o0[(size_t)row * DFF + col] = (bf16_t)(pk2(h, 0.f) & 0xffffu);
            } else {
                a.o0[(size_t)row * DM + col] = (bf16_t)(pk2(v0, 0.f) & 0xffffu);
            }
        }
        __syncthreads();
    }
}
struct AttnArgs { int L; };
constexpr int AW_V = 0, AW_ST = 4096, AW_BIAS = 8704, AW_BYTES = 10240, ST_PITCH = 144;

template <bool F32> __device__ __forceinline__ void ld_k(bf16x8 (&kf)[4], const void* base, size_t off) {
    if constexpr (!F32) { const bf16_t* p = (const bf16_t*)base + off;
#pragma unroll
        for (int kk = 0; kk < 4; ++kk) kf[kk] = *(const bf16x8*)(p + 8 * kk);
    } else { const float* p = (const float*)base + off;
#pragma unroll
        for (int kk = 0; kk < 4; ++kk) { const f32x4 x = *(const f32x4*)(p + 8 * kk), y = *(const f32x4*)(p + 8 * kk + 4);
            u32x4 w; w.x = pk2(x[0], x[1]); w.y = pk2(x[2], x[3]); w.z = pk2(y[0], y[1]); w.w = pk2(y[2], y[3]); kf[kk] = __builtin_bit_cast(bf16x8, w); }
    }
}
template <bool F32> __device__ __forceinline__ void ld_v(u32x4 (&vr)[4], const void* base, size_t row0, int nvalid, int h, int lane) {
#pragma unroll
    for (int i = 0; i < 4; ++i) { int key = 8 * i + (lane >> 3); key = key < nvalid ? key : nvalid - 1;
        const size_t off = (row0 + key) * HW + h * 64 + (lane & 7) * 8;
        if constexpr (!F32) vr[i] = *(const u32x4*)((const bf16_t*)base + off);
        else { const float* p = (const float*)base + off; const f32x4 x = *(const f32x4*)p, y = *(const f32x4*)(p + 4);
            u32x4 w; w.x = pk2(x[0], x[1]); w.y = pk2(x[2], x[3]); w.z = pk2(y[0], y[1]); w.w = pk2(y[2], y[3]); vr[i] = w; }
    }
}
__device__ __forceinline__ void st_v(LAS unsigned char* vl, const u32x4 (&vr)[4], int lane) {
#pragma unroll
    for (int i = 0; i < 4; ++i) { const int key = 8 * i + (lane >> 3); *(LAS u32x4*)(vl + key * 128 + (((lane & 7) * 16) ^ (((key >> 1) & 1) << 6))) = vr[i]; }
}
typedef short v4i16_t __attribute__((ext_vector_type(4)));
__device__ __forceinline__ s16x4 vtr(LAS unsigned char* p) { return __builtin_bit_cast(s16x4, __builtin_amdgcn_ds_read_tr16_b64_v4i16((LAS v4i16_t*)p)); }
__device__ __forceinline__ void pv_block(f32x16 (&o)[2], LAS unsigned char* vl, const bf16x8 (&pf)[2], int lane) {
    const int q = (lane & 15) >> 2, p = lane & 3, c16 = (lane >> 4) & 1, hh = lane >> 5;
    const int va0 = (4 * hh + q) * 128 + ((32 * c16 + 8 * p) ^ ((q >> 1) << 6));
#pragma unroll
    for (int db = 0; db < 2; ++db)
#pragma unroll
        for (int s = 0; s < 2; ++s) {
            const s16x4 lo = vtr(vl + (va0 ^ (db * 64)) + s * 2048), hi = vtr(vl + (va0 ^ (db * 64)) + s * 2048 + 1024);
            const bf16x8 vf = {lo[0], lo[1], lo[2], lo[3], hi[0], hi[1], hi[2], hi[3]};
            o[db] = __builtin_amdgcn_mfma_f32_32x32x16_bf16(vf, pf[s], o[db], 0, 0, 0);
        }
}
__device__ __forceinline__ f32x16 qk_block(const bf16x8 (&kf)[4], const bf16x8 (&qf)[4]) {
    f32x16 S = {};
#pragma unroll
    for (int kk = 0; kk < 4; ++kk) S = __builtin_amdgcn_mfma_f32_32x32x16_bf16(kf[kk], qf[kk], S, 0, 0, 0);
    return S;
}
__device__ __forceinline__ void sb_block(const f32x16& S, LAS unsigned char* vl, int tq, int keypos0, float& carry, f32x16 (&o)[2], int lane) {
    const int hh = lane >> 5;
    float kp_[16], be[16];
#pragma unroll
    for (int r = 0; r < 16; ++r) {
        const int kp = keypos0 + (r & 3) + 8 * (r >> 2) + 4 * hh; const bool valid = kp < tq;
        const float z = __builtin_amdgcn_fmed3f(S[r], -126.f, 100.f);
        const float t = __builtin_amdgcn_exp2f(z), k = __builtin_amdgcn_rcpf(1.f + t);
        kp_[r] = valid ? k : 1.f; be[r] = valid ? t * k : 0.f;
    }
    float T[4], Tp[4], U[4];
#pragma unroll
    for (int g = 0; g < 4; ++g) { T[g] = (kp_[4 * g] * kp_[4 * g + 1]) * (kp_[4 * g + 2] * kp_[4 * g + 3]); Tp[g] = partner32(T[g]); U[g] = T[g] * Tp[g]; }
    float R[4]; R[3] = 1.f; R[2] = U[3]; R[1] = U[3] * U[2]; R[0] = R[1] * U[1];
    const float tot = R[0] * U[0];
    float w[16];
#pragma unroll
    for (int g = 0; g < 4; ++g) {
        const float b3 = carry * R[g] * (hh == 0 ? Tp[g] : 1.f);
        const float b2 = b3 * kp_[4 * g + 3], b1 = b2 * kp_[4 * g + 2], b0 = b1 * kp_[4 * g + 1];
        w[4 * g + 3] = be[4 * g + 3] * b3; w[4 * g + 2] = be[4 * g + 2] * b2; w[4 * g + 1] = be[4 * g + 1] * b1; w[4 * g + 0] = be[4 * g + 0] * b0;
    }
    carry *= tot;
    bf16x8 pf[2];
#pragma unroll
    for (int s = 0; s < 2; ++s) { u32x4 pw; pw.x = pk2(w[8 * s], w[8 * s + 1]); pw.y = pk2(w[8 * s + 2], w[8 * s + 3]); pw.z = pk2(w[8 * s + 4], w[8 * s + 5]); pw.w = pk2(w[8 * s + 6], w[8 * s + 7]); pf[s] = __builtin_bit_cast(bf16x8, pw); }
    pv_block(o, vl, pf, lane);
}
__device__ __forceinline__ void cb_block(const f32x16& S, bool cbias, LAS unsigned char* vl, const LAS float* bl, int tq, int keypos0, int nvalid, float& m, float& l, f32x16 (&o)[2], int lane) {
    const int hh = lane >> 5;
    float s[16]; float bm = -INFINITY;
    if (cbias) {
        const float cb = bl[256];
#pragma unroll
        for (int r = 0; r < 16; ++r) { s[r] = S[r] + cb; bm = fmaxf(bm, s[r]); }
    } else {
#pragma unroll
        for (int r = 0; r < 16; ++r) {
            const int kr = (r & 3) + 8 * (r >> 2) + 4 * hh; int d = tq - (keypos0 + kr); d = d < -128 ? -128 : (d > 128 ? 128 : d);
            s[r] = (kr < nvalid) ? S[r] + bl[d + 128] : -INFINITY; bm = fmaxf(bm, s[r]);
        }
    }
    bm = fmaxf(bm, partner32(bm));
    if (__any(bm > m + 8.f)) {
        const float mn = fmaxf(m, bm), f = __builtin_amdgcn_exp2f(m - mn); m = mn; l *= f;
#pragma unroll
        for (int db = 0; db < 2; ++db)
#pragma unroll
            for (int r = 0; r < 16; ++r) o[db][r] *= f;
    }
    float w[16], ls = 0.f;
#pragma unroll
    for (int r = 0; r < 16; ++r) { w[r] = __builtin_amdgcn_exp2f(s[r] - m); ls += w[r]; }
    l += ls;
    bf16x8 pf[2];
#pragma unroll
    for (int s2 = 0; s2 < 2; ++s2) { u32x4 pw; pw.x = pk2(w[8 * s2], w[8 * s2 + 1]); pw.y = pk2(w[8 * s2 + 2], w[8 * s2 + 3]); pw.z = pk2(w[8 * s2 + 4], w[8 * s2 + 5]); pw.w = pk2(w[8 * s2 + 6], w[8 * s2 + 7]); pf[s2] = __builtin_bit_cast(bf16x8, pw); }
    pv_block(o, vl, pf, lane);
}
__device__ __forceinline__ void attn_store(f32x16 (&o)[2], float scale, const float* gain, bf16_t* mix, size_t row0, int col0, int nrows, LAS unsigned char* wl, int lane) {
    const int r = lane & 31, hh = lane >> 5;
    f32x4 gvs[2][4];
#pragma unroll
    for (int db = 0; db < 2; ++db)
#pragma unroll
        for (int g = 0; g < 4; ++g) gvs[db][g] = *(const f32x4*)(gain + 32 * db + 8 * g + 4 * hh);
    float ssq = 0.f;
#pragma unroll
    for (int db = 0; db < 2; ++db)
#pragma unroll
        for (int i = 0; i < 16; ++i) { o[db][i] *= scale; ssq += o[db][i] * o[db][i]; }
    ssq += partner32(ssq);
    const float rstd = rsqrtf(ssq * (1.0f / 64.0f) + EPS);
    LAS unsigned char* st = wl + AW_ST;
#pragma unroll
    for (int db = 0; db < 2; ++db)
#pragma unroll
        for (int g = 0; g < 4; ++g) { const int d0 = 32 * db + 8 * g + 4 * hh; const f32x4 gv = gvs[db][g];
            u32x2 w; w.x = pk2(o[db][4 * g] * rstd * gv[0], o[db][4 * g + 1] * rstd * gv[1]); w.y = pk2(o[db][4 * g + 2] * rstd * gv[2], o[db][4 * g + 3] * rstd * gv[3]);
            *(LAS u32x2*)(st + r * ST_PITCH + d0 * 2) = w; }
#pragma unroll
    for (int i = 0; i < 4; ++i) { const int row = 8 * i + (lane >> 3), ch = lane & 7; const u32x4 v = *(const LAS u32x4*)(st + row * ST_PITCH + ch * 16);
        if (row < nrows) *(u32x4*)(mix + (row0 + row) * DM + col0 + ch * 8) = v; }
}

template <bool F32> __device__ __forceinline__ void sb_loop(const void* kbase, const void* vbase, size_t rowbase, int jhi, int h, const bf16x8 (&qf)[4], int tq, float& carry, f32x16 (&o)[2], LAS unsigned char* wl, int lane) {
    const int r = lane & 31, hh = lane >> 5;
    bf16x8 kA[4], kB[4]; u32x4 vA[4], vB[4];
#define SB_LD(KF, VN, jj) do { ld_k<F32>(KF, kbase, (rowbase + 32 * (jj) + r) * HW + h * 64 + 32 * hh); ld_v<F32>(VN, vbase, rowbase + 32 * (jj), 32, h, lane); } while (0)
    SB_LD(kA, vA, jhi); if (jhi >= 1) SB_LD(kB, vB, jhi - 1);
    for (int j = jhi; j >= 0; j -= 2) {
        { const f32x16 S = qk_block(kA, qf); st_v(wl + AW_V, vA, lane); if (j >= 2) SB_LD(kA, vA, j - 2);
          sb_block(S, wl + AW_V, tq, 32 * j, carry, o, lane); }
#if SB_EARLY
        if (__all(carry < SB_THR)) break;
#endif
        if (j < 1) break;
        { const f32x16 S = qk_block(kB, qf); st_v(wl + AW_V, vB, lane); if (j >= 3) SB_LD(kB, vB, j - 3);
          sb_block(S, wl + AW_V, tq, 32 * (j - 1), carry, o, lane); }
#if SB_EARLY
        if (__all(carry < SB_THR)) break;
#endif
    }
#undef SB_LD
}
template <bool SAMPLE> __device__ __forceinline__ void sb_unit(const AttnArgs& A, int b, int h, int qb, LAS unsigned char* wl, int lane) {
    const int r = lane & 31, hh = lane >> 5;
    const bf16_t* Qa = QKV_; const bf16_t* Ka = Qa + (size_t)1 * MT * HW; const bf16_t* Va = Qa + (size_t)2 * MT * HW;
    int tq; size_t qrow;
    if (SAMPLE) { tq = PAST + (r & 15); qrow = (size_t)MP + b * DSEQ + (r & 15); } else { tq = 32 * qb + r; qrow = (size_t)b * SEQ + tq; }
    bf16x8 qf[4]; ld_k<false>(qf, Qa, qrow * HW + h * 64 + 32 * hh);
    float carry = 1.f; f32x16 o[2]; o[0] = f32x16{}; o[1] = f32x16{};
    if (SAMPLE) {
        bf16x8 kf[4]; u32x4 vr[4]; const size_t row0 = (size_t)MP + b * DSEQ;
        ld_k<false>(kf, Ka, (row0 + (r & 15)) * HW + h * 64 + 32 * hh); ld_v<false>(vr, Va, row0, DSEQ, h, lane); st_v(wl + AW_V, vr, lane);
        { const f32x16 S = qk_block(kf, qf); sb_block(S, wl + AW_V, tq, PAST, carry, o, lane); }
        sb_loop<true>(ARG(4) + (size_t)A.L * NBATCH * PAST * HW, ARG(5) + (size_t)A.L * NBATCH * PAST * HW, (size_t)b * PAST, PAST / 32 - 1, h, qf, tq, carry, o, wl, lane);
        attn_store(o, 1.f, ARG(11) + A.L * HW + h * 64, MIX_, row0, h * 64, DSEQ, wl, lane);
    } else {
        sb_loop<false>(Ka, Va, (size_t)b * SEQ, qb, h, qf, tq, carry, o, wl, lane);
        attn_store(o, 1.f, ARG(11) + A.L * HW + h * 64, MIX_, (size_t)b * SEQ + 32 * qb, h * 64, 32, wl, lane);
    }
}
template <bool F32> __device__ __forceinline__ void cb_loop(const void* kbase, const void* vbase, size_t rowbase, int jlo, int jhi, int pos0, int h, const bf16x8 (&qf)[4], int tq, float& m, float& l, f32x16 (&o)[2], LAS unsigned char* wl, int lane) {
    const int r = lane & 31, hh = lane >> 5;
    bf16x8 kA[4], kB[4]; u32x4 vA[4], vB[4];
    const int tqmin = tq - r;
#define CB_LD(KF, VN, jj) do { ld_k<F32>(KF, kbase, (rowbase + 32 * (jj) + r) * HW + h * 64 + 32 * hh); ld_v<F32>(VN, vbase, rowbase + 32 * (jj), 32, h, lane); } while (0)
    CB_LD(kA, vA, jlo); if (jlo + 1 <= jhi) CB_LD(kB, vB, jlo + 1);
    for (int j = jlo; j <= jhi; j += 2) {
        { const f32x16 S = qk_block(kA, qf); st_v(wl + AW_V, vA, lane); if (j + 2 <= jhi) CB_LD(kA, vA, j + 2);
          const bool cbias = __builtin_amdgcn_readfirstlane(pos0 + 32 * j + 31 + 128 <= tqmin);
          cb_block(S, cbias, wl + AW_V, (const LAS float*)(wl + AW_BIAS), tq, pos0 + 32 * j, 32, m, l, o, lane); }
        if (j + 1 > jhi) break;
        { const f32x16 S = qk_block(kB, qf); st_v(wl + AW_V, vB, lane); if (j + 3 <= jhi) CB_LD(kB, vB, j + 3);
          const bool cbias = __builtin_amdgcn_readfirstlane(pos0 + 32 * (j + 1) + 31 + 128 <= tqmin);
          cb_block(S, cbias, wl + AW_V, (const LAS float*)(wl + AW_BIAS), tq, pos0 + 32 * (j + 1), 32, m, l, o, lane); }
    }
#undef CB_LD
}
template <bool SAMPLE> __device__ __forceinline__ void cb_unit(const AttnArgs& A, int b, int h, int qb, LAS unsigned char* wl, int lane) {
    const int r = lane & 31, hh = lane >> 5;
    const bf16_t* Qb = QKV_ + (size_t)3 * MT * HW; const bf16_t* Kb = Qb + (size_t)1 * MT * HW; const bf16_t* Vb = Qb + (size_t)2 * MT * HW;
    LAS float* bl = (LAS float*)(wl + AW_BIAS);
    { const float* relp = ARG(10) + (size_t)A.L * 257 * 8 + h; float bv[5];
#pragma unroll
      for (int i = 0; i < 5; ++i) { const int idx = lane + 64 * i; bv[i] = relp[(idx < 257 ? idx : 256) * 8]; }
#pragma unroll
      for (int i = 0; i < 5; ++i) { const int idx = lane + 64 * i; if (idx < 257) bl[idx] = bv[i] * LOG2E; } }
    int tq; size_t qrow;
    if (SAMPLE) { tq = PAST + (r & 15); qrow = (size_t)MP + b * DSEQ + (r & 15); } else { tq = 32 * qb + r; qrow = (size_t)b * SEQ + tq; }
    bf16x8 qf[4]; ld_k<false>(qf, Qb, qrow * HW + h * 64 + 32 * hh);
    float m = -INFINITY, l = 0.f; f32x16 o[2]; o[0] = f32x16{}; o[1] = f32x16{};
    if (SAMPLE) {
        cb_loop<true>(ARG(6) + (size_t)A.L * NBATCH * BANDL * HW, ARG(7) + (size_t)A.L * NBATCH * BANDL * HW, (size_t)b * BANDL, 0, BANDL / 32 - 1, PAST - BANDL, h, qf, tq, m, l, o, wl, lane);
        bf16x8 kf[4]; u32x4 vr[4]; const size_t row0 = (size_t)MP + b * DSEQ;
        ld_k<false>(kf, Kb, (row0 + (r & 15)) * HW + h * 64 + 32 * hh); ld_v<false>(vr, Vb, row0, DSEQ, h, lane); st_v(wl + AW_V, vr, lane);
        { const f32x16 S = qk_block(kf, qf); cb_block(S, false, wl + AW_V, bl, tq, PAST, DSEQ, m, l, o, lane); }
        l += partner32(l);
        attn_store(o, 1.0f / l, ARG(12) + A.L * HW + h * 64, MIX_, row0, HW + h * 64, DSEQ, wl, lane);
    } else {
        const int c = qb >> 1, clo = c - 8 < 0 ? 0 : c - 8;
        cb_loop<false>(Kb, Vb, (size_t)b * SEQ, 2 * clo, 2 * c + 1, 0, h, qf, tq, m, l, o, wl, lane);
        l += partner32(l);
        attn_store(o, 1.0f / l, ARG(12) + A.L * HW + h * 64, MIX_, (size_t)b * SEQ + 32 * qb, HW + h * 64, 32, wl, lane);
    }
}
__device__ __forceinline__ void sb_unit_p64(const AttnArgs& A, int b, int h, int m, LAS unsigned char* wl, int lane) {
    const int r = lane & 31, hh = lane >> 5;
    const bf16_t* Qa = QKV_; const bf16_t* Ka = Qa + (size_t)1 * MT * HW; const bf16_t* Va = Qa + (size_t)2 * MT * HW;
    const size_t rowbase = (size_t)b * SEQ;
    const int tq0 = 64 * m + r, tq1 = tq0 + 32;
    bf16x8 qf0[4];
    LAS unsigned char* q1p = wl + AW_ST + lane * 64;
    { bf16x8 qf1[4]; ld_k<false>(qf1, Qa, (rowbase + tq1) * HW + h * 64 + 32 * hh);
#pragma unroll
      for (int kk = 0; kk < 4; ++kk) *(LAS bf16x8*)(q1p + kk * 16) = qf1[kk]; }
    ld_k<false>(qf0, Qa, (rowbase + tq0) * HW + h * 64 + 32 * hh);
    float c0 = 1.f, c1 = 1.f; f32x16 o0[2], o1[2]; o0[0] = f32x16{}; o0[1] = f32x16{}; o1[0] = f32x16{}; o1[1] = f32x16{};
    bf16x8 kf[4]; u32x4 vn[4];
    int j = 2 * m + 1;
    ld_k<false>(kf, Ka, (rowbase + 32 * j + r) * HW + h * 64 + 32 * hh); ld_v<false>(vn, Va, rowbase + 32 * j, 32, h, lane);
    bool live0 = true, live1 = true;
    for (; j >= 0; --j) {
        const bool act0 = live0 && (j <= 2 * m);
        st_v(wl + AW_V, vn, lane);
        if (j > 0) ld_v<false>(vn, Va, rowbase + 32 * (j - 1), 32, h, lane);
        if (live1) { bf16x8 qf1[4];
#pragma unroll
            for (int kk = 0; kk < 4; ++kk) qf1[kk] = *(const LAS bf16x8*)(q1p + kk * 16);
            const f32x16 S1 = qk_block(kf, qf1); sb_block(S1, wl + AW_V, tq1, 32 * j, c1, o1, lane); if (__all(c1 < SB_THR)) live1 = false; }
        if (act0) { const f32x16 S0 = qk_block(kf, qf0);
            if (j > 0) ld_k<false>(kf, Ka, (rowbase + 32 * (j - 1) + r) * HW + h * 64 + 32 * hh);
            sb_block(S0, wl + AW_V, tq0, 32 * j, c0, o0, lane); if (__all(c0 < SB_THR)) live0 = false; }
        else if (j > 0) ld_k<false>(kf, Ka, (rowbase + 32 * (j - 1) + r) * HW + h * 64 + 32 * hh);
        if (!live0 && !live1) break;
    }
    attn_store(o0, 1.f, ARG(11) + A.L * HW + h * 64, MIX_, rowbase + 64 * m, h * 64, 32, wl, lane);
    attn_store(o1, 1.f, ARG(11) + A.L * HW + h * 64, MIX_, rowbase + 64 * m + 32, h * 64, 32, wl, lane);
}
__device__ __forceinline__ void cb_unit_p64(const AttnArgs& A, int b, int h, int c, LAS unsigned char* wl, int lane) {
    const int r = lane & 31, hh = lane >> 5;
    const bf16_t* Qb = QKV_ + (size_t)3 * MT * HW; const bf16_t* Kb = Qb + (size_t)1 * MT * HW; const bf16_t* Vb = Qb + (size_t)2 * MT * HW;
    LAS float* bl = (LAS float*)(wl + AW_BIAS);
    { const float* relp = ARG(10) + (size_t)A.L * 257 * 8 + h; float bv[5];
#pragma unroll
      for (int i = 0; i < 5; ++i) { const int idx = lane + 64 * i; bv[i] = relp[(idx < 257 ? idx : 256) * 8]; }
#pragma unroll
      for (int i = 0; i < 5; ++i) { const int idx = lane + 64 * i; if (idx < 257) bl[idx] = bv[i] * LOG2E; } }
    const int tq0 = 64 * c + r, tq1 = tq0 + 32; const size_t rowbase = (size_t)b * SEQ;
    bf16x8 qf0[4], qf1[4];
    ld_k<false>(qf0, Qb, (rowbase + tq0) * HW + h * 64 + 32 * hh); ld_k<false>(qf1, Qb, (rowbase + tq1) * HW + h * 64 + 32 * hh);
    float m0 = -INFINITY, l0 = 0.f, m1 = -INFINITY, l1 = 0.f;
    f32x16 o0[2], o1[2]; o0[0] = f32x16{}; o0[1] = f32x16{}; o1[0] = f32x16{}; o1[1] = f32x16{};
    const int clo = c - 8 < 0 ? 0 : c - 8, jlo = 2 * clo, jhi = 2 * c + 1;
    bf16x8 kf[4]; u32x4 vn[4];
    ld_k<false>(kf, Kb, (rowbase + 32 * jlo + r) * HW + h * 64 + 32 * hh); ld_v<false>(vn, Vb, rowbase + 32 * jlo, 32, h, lane);
    for (int j = jlo; j <= jhi; ++j) {
        const f32x16 S0 = qk_block(kf, qf0), S1 = qk_block(kf, qf1);
        st_v(wl + AW_V, vn, lane);
        if (j < jhi) { ld_k<false>(kf, Kb, (rowbase + 32 * (j + 1) + r) * HW + h * 64 + 32 * hh); ld_v<false>(vn, Vb, rowbase + 32 * (j + 1), 32, h, lane); }
        const bool cbias = (32 * j + 31 + 128 <= 64 * c);
        cb_block(S0, cbias, wl + AW_V, bl, tq0, 32 * j, 32, m0, l0, o0, lane);
        cb_block(S1, cbias, wl + AW_V, bl, tq1, 32 * j, 32, m1, l1, o1, lane);
    }
    l0 += partner32(l0); l1 += partner32(l1);
    attn_store(o0, 1.0f / l0, ARG(12) + A.L * HW + h * 64, MIX_, rowbase + 64 * c, HW + h * 64, 32, wl, lane);
    attn_store(o1, 1.0f / l1, ARG(12) + A.L * HW + h * 64, MIX_, rowbase + 64 * c + 32, HW + h * 64, 32, wl, lane);
}
constexpr int AU_ITEMS = 2048;
__device__ __forceinline__ void attn_phase(const AttnArgs& A, LAS unsigned char* lds) {
    const int tid_ = fresh_tid(), lane = tid_ & 63, wave = __builtin_amdgcn_readfirstlane(tid_ >> 6);
    LAS unsigned char* wl = lds + wave * AW_BYTES;
#pragma unroll 1
    for (int cu = (int)blockIdx.x * NWAVES + wave; cu < AU_ITEMS; cu += (int)gridDim.x * NWAVES) {
        const int blk = cu >> 3, kk_ = (blk >> 3) * 8 + (cu & 7);
        const int bh = (blk & 7) * 8 + (kk_ >> 5), p = kk_ & 31;
        cb_unit_p64(A, bh >> 3, bh & 7, 31 - p, wl, lane);
        sb_unit_p64(A, bh >> 3, bh & 7, 31 - p, wl, lane);
        if (p >= 30) { const int li = bh * 2 + (p - 30); if (li < 64) cb_unit<true>(A, li >> 3, li & 7, 0, wl, lane); }
        else if (p >= 28) { const int li = bh * 2 + (p - 28); if (li < 64) sb_unit<true>(A, li >> 3, li & 7, 0, wl, lane); }
    }
}
typedef unsigned gu32_plain;
#define XB_TMO      128
#define XB_XCNT(j)  (256  + 64 * (j))
#define XB_XSUB(j)  (1280 + 64 * (j))
#define XB_XGEN(j)  (2304 + 64 * (j))
#define XB_TOP      3328
#define XB_TOPGEN   3392
#define XCD_BAR_WORDS 3456
#define XB_SPIN_CAP (1u << 18)

__device__ __forceinline__ unsigned xb_ld(unsigned* p)              { return __hip_atomic_load(p, __ATOMIC_RELAXED, __HIP_MEMORY_SCOPE_AGENT); }
__device__ __forceinline__ unsigned xb_add(unsigned* p, unsigned v) { return __hip_atomic_fetch_add(p, v, __ATOMIC_RELAXED, __HIP_MEMORY_SCOPE_AGENT); }
__device__ __forceinline__ unsigned xb_xcc_id() { return (unsigned)__builtin_amdgcn_s_getreg((3 << 11) | 20) & 0xFu; }
#define XB_SPIN(cond, bar) do { unsigned _sp = 0; while (cond) { __builtin_amdgcn_s_sleep(1); \
    if ((++_sp & 255u) == 0u) { if (xb_ld(&(bar)[XB_TMO])) break; if (_sp > XB_SPIN_CAP) { atomicAdd(&(bar)[XB_TMO], 1u); break; } } } } while (0)

struct XcdBarrier {
    unsigned* bar; unsigned x;
    volatile LAS unsigned* st;
};

__device__ __forceinline__ XcdBarrier xcd_barrier_post(unsigned* bar, volatile LAS unsigned* st) {
    XcdBarrier b; b.bar = bar; b.x = xb_xcc_id(); b.st = st;
    if (threadIdx.x == 0) (void)xb_add(&bar[XB_XCNT(b.x)], 1u);
    return b;
}
__device__ __forceinline__ void xcd_barrier_complete(unsigned* bar, unsigned x, unsigned& nloc, unsigned& nx) {
    const unsigned G = gridDim.x * gridDim.y * gridDim.z;
    unsigned sum, cnt, mine, sp = 0u;
    for (;;) {
        sum = 0u; cnt = 0u; mine = 0u;
#pragma unroll
        for (unsigned j = 0; j < 16; ++j) { const unsigned c = xb_ld(&bar[XB_XCNT(j)]); sum += c; cnt += (c > 0u) ? 1u : 0u; mine = (j == x) ? c : mine; }
        if (sum == G) break;
        __builtin_amdgcn_s_sleep(1);
        if ((++sp & 255u) == 0u) { if (xb_ld(&bar[XB_TMO])) break; if (sp > XB_SPIN_CAP) { atomicAdd(&bar[XB_TMO], 1u); break; } }
    }
    nloc = mine > 0u ? mine : 1u; nx = cnt > 0u ? cnt : 1u;
}

__device__ __forceinline__ void xcd_barrier(const XcdBarrier& b) {
    asm volatile("s_waitcnt vmcnt(0)" ::: "memory");
    __syncthreads();
    if (threadIdx.x == 0) {
        unsigned* bar = b.bar;
        __builtin_amdgcn_s_waitcnt(0);
        unsigned nloc = b.st[0], nx = b.st[1];
        if (nloc == 0u) { xcd_barrier_complete(bar, b.x, nloc, nx); b.st[0] = nloc; b.st[1] = nx; }
        const unsigned old = xb_add(&bar[XB_XSUB(b.x)], 1u);
        const unsigned gen = old / nloc;
        if (old + 1u == (gen + 1u) * nloc) {
            __builtin_amdgcn_fence(__ATOMIC_RELEASE, "agent");
            asm volatile("s_waitcnt vmcnt(0)" ::: "memory");
            const unsigned og = xb_add(&bar[XB_TOP], 1u);
            const unsigned tg = og / nx;
            if (og + 1u == (tg + 1u) * nx) xb_add(&bar[XB_TOPGEN], 1u);
            else XB_SPIN(xb_ld(&bar[XB_TOPGEN]) == tg, bar);
            __builtin_amdgcn_fence(__ATOMIC_ACQUIRE, "agent");
            xb_add(&bar[XB_XGEN(b.x)], 1u);
            asm volatile("s_waitcnt vmcnt(0)" ::: "memory");
        } else {
            XB_SPIN(xb_ld(&bar[XB_XGEN(b.x)]) == gen, bar);
            __builtin_amdgcn_fence(__ATOMIC_ACQUIRE, "agent");
            asm volatile("s_waitcnt vmcnt(0)" ::: "memory");
        }
    }
    __syncthreads();
}

constexpr int CI_IN = 16 * 96, CI_OUT = 16 * 32, CI_G = 16 * 88, CI_D = 44 * 32, CI_PG = 16 * 32, CI_PP = 4 * 32, CI_L = CI_IN + CI_OUT + 2 * CI_G + CI_D + CI_PG + CI_PP;
struct ConvD { const float* W; const float* gain; bf16_t* WT; int K, N, kind, k0, n0; };
__device__ __forceinline__ ConvD conv_decode(int it) {
    const int L = it / CI_L; int r = it % CI_L; ConvD d;
    if (r < CI_IN) { d.W = ARG(9) + (size_t)L * DM * NQKV; d.gain = ARG(8) + L * DM; d.WT = (bf16_t*)WPTR(L, W_IN); d.K = DM; d.N = NQKV; d.kind = 0; }
    else if ((r -= CI_IN) < CI_OUT) { d.W = ARG(13) + (size_t)L * DM * DM; d.gain = nullptr; d.WT = (bf16_t*)WPTR(L, W_OUT); d.K = DM; d.N = DM; d.kind = 0; }
    else if ((r -= CI_OUT) < CI_G) { d.W = ARG(15) + (size_t)L * DM * DFF; d.gain = ARG(14) + L * DM; d.WT = (bf16_t*)WPTR(L, W_GU); d.K = DM; d.N = DFF; d.kind = 1; }
    else if ((r -= CI_G) < CI_G) { d.W = ARG(16) + (size_t)L * DM * DFF; d.gain = ARG(14) + L * DM; d.WT = (bf16_t*)WPTR(L, W_GU); d.K = DM; d.N = DFF; d.kind = 2; }
    else if ((r -= CI_G) < CI_D) { d.W = ARG(17) + (size_t)L * DFF * DM; d.gain = nullptr; d.WT = (bf16_t*)WPTR(L, W_DOWN); d.K = DFF; d.N = DM; d.kind = 0; }
    else if ((r -= CI_D) < CI_PG) { d.W = ARG(19) + (size_t)L * DM * DM; d.gain = ARG(18) + L * DM; d.WT = (bf16_t*)WPTR(L, W_PG); d.K = DM; d.N = DM; d.kind = 0; }
    else { r -= CI_PG; d.W = ARG(20) + (size_t)L * PLED * DM; d.gain = nullptr; d.WT = (bf16_t*)WPTR(L, W_PP); d.K = PLED; d.N = DM; d.kind = 0; }
    const int nblk = d.N / 32; d.k0 = 64 * (r / nblk); d.n0 = 32 * (r % nblk);
    return d;
}
__device__ __forceinline__ void conv_load(const ConvD& d, float (&v)[32], f32x4 (&g)[2], int lane) {
    const float* p = d.W + (size_t)(d.k0 + (lane >> 5)) * d.N + d.n0 + (lane & 31);
#pragma unroll
    for (int i = 0; i < 32; ++i) v[i] = p[(size_t)(2 * i) * d.N];
    if (d.gain) { g[0] = *(const f32x4*)(d.gain + d.k0 + 8 * (lane & 7)); g[1] = *(const f32x4*)(d.gain + d.k0 + 8 * (lane & 7) + 4); }
    else { g[0] = (f32x4){1.f, 1.f, 1.f, 1.f}; g[1] = g[0]; }
}
__device__ __forceinline__ void conv_proc(const ConvD& d, const float (&v)[32], const f32x4 (&g)[2], LAS float* scr, int lane) {
#pragma unroll
    for (int i = 0; i < 32; ++i) scr[(2 * i + (lane >> 5)) * 33 + (lane & 31)] = v[i];
    asm volatile("s_waitcnt lgkmcnt(0)" ::: "memory");
    const int c = lane & 7;
#pragma unroll
    for (int j = 0; j < 4; ++j) { const int n = (lane >> 3) + 8 * j; const LAS float* s = scr + (8 * c) * 33 + n;
        u32x4 o; o.x = pk2(s[0 * 33] * g[0][0], s[1 * 33] * g[0][1]); o.y = pk2(s[2 * 33] * g[0][2], s[3 * 33] * g[0][3]);
        o.z = pk2(s[4 * 33] * g[1][0], s[5 * 33] * g[1][1]); o.w = pk2(s[6 * 33] * g[1][2], s[7 * 33] * g[1][3]);
        const int gn = d.n0 + n; const int drow = d.kind == 0 ? gn : ((gn >> 7) * 256 + (gn & 127) + (d.kind == 2 ? 128 : 0));
        *(u32x4*)(d.WT + (size_t)drow * d.K + d.k0 + 8 * c) = o; }
    asm volatile("s_waitcnt lgkmcnt(0)" ::: "memory");
}

#ifdef NO_SGEMM
#define SG(...)
#else
#define SG(...) __VA_ARGS__
#endif
#ifndef GP1
#define GP1(...) __VA_ARGS__
#endif
#ifndef GP2
#define GP2(...) __VA_ARGS__
#endif
#ifndef GP3
#define GP3(...) __VA_ARGS__
#endif
#ifndef GP4
#define GP4(...) __VA_ARGS__
#endif
#ifndef GP5
#define GP5(...) __VA_ARGS__
#endif
#ifndef GP6
#define GP6(...) __VA_ARGS__
#endif
#ifdef NO_SGEMM
#define SG(...)
#else
#define SG(...) __VA_ARGS__
#endif
#ifndef GP1
#define GP1(...) __VA_ARGS__
#endif
#ifndef GP2
#define GP2(...) __VA_ARGS__
#endif
#ifndef GP3
#define GP3(...) __VA_ARGS__
#endif
#ifndef GP4
#define GP4(...) __VA_ARGS__
#endif
#ifndef GP5
#define GP5(...) __VA_ARGS__
#endif
#ifndef GP6
#define GP6(...) __VA_ARGS__
#endif
struct Args { const float* in[22]; float* out; unsigned char* ws; };

#ifndef PROBE_SEL
#define PROBE_SEL -1
#endif
#if PROBE_SEL >= 0
#define TSTAMP(cat) do { if (blockIdx.x == 0 && fresh_tid() == 0) { const unsigned long long t_ = __builtin_amdgcn_s_memrealtime(); unsigned long long* tsb = WS_PTR(unsigned long long, WS_CTL + 4096); \
    tsb[16 + (cat)] += t_ - tsb[0]; tsb[0] = t_; } } while (0)
#else
#define TSTAMP(cat) do {} while (0)
#endif
__global__ void __launch_bounds__(NTHREADS, 2) hymba_fwd(Args args) {
    extern __shared__ __attribute__((aligned(16))) unsigned char lds_raw[];
    cg::grid_group grid = cg::this_grid();
    LAS unsigned char* lds = (LAS unsigned char*)lds_raw;
    const int G = gridDim.x;

    { const int tid0 = fresh_tid();
      if (blockIdx.x == 0) for (int i = tid0; i < XCD_BAR_WORDS; i += NTHREADS) WS_PTR(unsigned, WS_BAR)[i] = 0u;
      if (tid0 < 2) ((LAS unsigned*)(lds + 131072))[tid0] = 0u; }
    grid.sync();
    (void)xcd_barrier_post(WS_PTR(unsigned, WS_BAR), (volatile LAS unsigned*)(lds + 131072));
#define GSYNC() do { XcdBarrier xb_; xb_.bar = WS_PTR(unsigned, WS_BAR); xb_.x = xb_xcc_id(); xb_.st = (volatile LAS unsigned*)(lds + 131072); xcd_barrier(xb_); } while (0)
#if PROBE_SEL >= 0
    if (blockIdx.x == 0 && fresh_tid() == 0) { unsigned long long* tsb = WS_PTR(unsigned long long, WS_CTL + 4096); for (int i = 0; i < 48; ++i) tsb[i] = 0; tsb[0] = __builtin_amdgcn_s_memrealtime(); }
#endif
    {
        const int tid = fresh_tid(), lane = tid & 63, wave = __builtin_amdgcn_readfirstlane(tid >> 6);
        const int gw = blockIdx.x * NWAVES + wave, NGW = G * NWAVES;
        { float* ssb = SSB; for (int i = blockIdx.x * NTHREADS + tid; i < 6 * MT; i += G * NTHREADS) ssb[MT + i] = 0.f;
          if (blockIdx.x == 0 && tid < 16) WS_PTR(unsigned, WS_CTL)[tid] = 0u;
          }
        LAS float* scr = (LAS float*)(lds + wave * 8704);
        { constexpr int NIT = NLAYER * CI_L; int it = gw;
          float vA[32], vB[32]; f32x4 gA[2], gB[2]; ConvD dA, dB;
          if (it < NIT) { dA = conv_decode(it); conv_load(dA, vA, gA, lane); }
          while (it < NIT) {
            const int itn = it + NGW;
            if (itn < NIT) { dB = conv_decode(itn); conv_load(dB, vB, gB, lane); }
            conv_proc(dA, vA, gA, scr, lane);
            if (itn >= NIT) break;
            it = itn + NGW;
            if (it < NIT) { dA = conv_decode(it); conv_load(dA, vA, gA, lane); }
            conv_proc(dB, vB, gB, scr, lane);
          } }
        { const float* pp = ARG(2); const float* ps = ARG(3); bf16_t* PB = PB_;
          for (int it0 = 4 * gw; it0 < NLAYER * MT; it0 += 4 * NGW) {
            f32x4 v[4];
#pragma unroll
            for (int rr = 0; rr < 4; ++rr) { const int it = it0 + rr, L = it / MT, row = it % MT;
                const float* src = row < MP ? pp + ((size_t)L * MP + row) * PLED : ps + ((size_t)L * MS + (row - MP)) * PLED;
                v[rr] = *((const f32x4*)src + lane); }
#pragma unroll
            for (int rr = 0; rr < 4; ++rr) { u32x2 w; w.x = pk2(v[rr][0], v[rr][1]); w.y = pk2(v[rr][2], v[rr][3]); *((u32x2*)(PB + (size_t)(it0 + rr) * PLED) + lane) = w; }
          } }
        { const float* x_p = ARG(0); const float* x_s = ARG(1); bf16_t* XB = XN_; float* ssb = SSB;
          for (int row0 = 2 * gw; row0 < MT; row0 += 2 * NGW) {
            f32x4 v[2][4];
#pragma unroll
            for (int rr = 0; rr < 2; ++rr) { const int row = row0 + rr; const float* src = row < MP ? x_p + (size_t)row * DM : x_s + (size_t)(row - MP) * DM;
#pragma unroll
                for (int j = 0; j < 4; ++j) v[rr][j] = *((const f32x4*)src + lane + 64 * j); }
#pragma unroll
            for (int rr = 0; rr < 2; ++rr) { float s2 = 0.f;
#pragma unroll
                for (int j = 0; j < 4; ++j) { const f32x4 t = v[rr][j]; s2 += (t[0] * t[0] + t[1] * t[1]) + (t[2] * t[2] + t[3] * t[3]);
                    u32x2 w; w.x = pk2(t[0], t[1]); w.y = pk2(t[2], t[3]); *((u32x2*)(XB + (size_t)(row0 + rr) * DM) + lane + 64 * j) = w; }
                s2 = wave_sum(s2);
                if (lane == 0) ssb[row0 + rr] = s2; }
          } }
    }
    TSTAMP(0); GSYNC(); TSTAMP(8);

    for (int L = 0; L < NLAYER; ++L) {
#define SS_MIX (SSB + (size_t)(3 * L) * MT)
#define SS_FFN (SSB + (size_t)(3 * L + 1) * MT)
#define SS_PLE (SSB + (size_t)(3 * L + 2) * MT)
#define SS_NEXT (SSB + (size_t)(3 * L + 3) * MT)
        { EpiArgs q{}; q.ss_in = SS_MIX; q.o0 = QKV_;
          q.f_sbk = ARG_OUT + O_SBK_P + (size_t)L * MP * HW; q.f_sbv = ARG_OUT + O_SBV_P + (size_t)L * MP * HW;
          q.f_cbk = ARG_OUT + O_CBK_P + (size_t)L * NBATCH * BANDL * HW; q.f_cbv = ARG_OUT + O_CBV_P + (size_t)L * NBATCH * BANDL * HW;
          pg8::Gemm g{XN_, WPTR(L, W_IN), MP, NQKV, DM}; pg8::StaticOrder S; S.init(MP, NQKV, G, (int)blockIdx.x);
          Epi<EP_QKV> E{q};
          GP1(pg8::gemm_phase<Epi<EP_QKV>, pg8::StaticOrder, true, true>(lds, g, S, E);) TSTAMP(1); }
        { EpiArgs q{}; q.ss_in = SS_MIX; q.o0 = QKV_;
          q.s_sbk = ARG_OUT + O_SBK_S + (size_t)L * MS * HW; q.s_sbv = ARG_OUT + O_SBV_S + (size_t)L * MS * HW;
          q.s_cbk = ARG_OUT + O_CBK_S + (size_t)L * MS * HW; q.s_cbv = ARG_OUT + O_CBV_S + (size_t)L * MS * HW;
          SG(sgemm<EP_QKV, DM>(lds, XN_ + (size_t)MP * DM, WPTR(L, W_IN), NQKV / 32, q);) TSTAMP(7); }
        GSYNC(); TSTAMP(8);
        { AttnArgs A{}; A.L = L;
#ifndef NO_ATTN
          attn_phase(A, lds);
#endif
          TSTAMP(2); }
        GSYNC(); TSTAMP(2);
        { EpiArgs q{}; q.XB = XB_; q.xbase = XN_; q.ss_out = SS_FFN;
          pg8::Gemm g{MIX_, WPTR(L, W_OUT), MP, DM, DM}; pg8::StaticOrder S; S.init(MP, DM, G, (int)blockIdx.x);
          Epi<EP_RES> E{q};
          GP2(pg8::gemm_phase<Epi<EP_RES>, pg8::StaticOrder, true, true>(lds, g, S, E);) TSTAMP(3); }
        { EpiArgs q{}; q.XB = XB_; q.xbase = XN_; q.ss_out = SS_FFN;
          SG(sgemm<EP_RES, DM>(lds, MIX_ + (size_t)MP * DM, WPTR(L, W_OUT), DM / 32, q);) TSTAMP(7); }
        GSYNC(); TSTAMP(8);
        { EpiArgs q{}; q.ss_in = SS_FFN; q.o0 = HB_;
          pg8::Gemm g{XB_, WPTR(L, W_GU), MP, 2 * DFF, DM}; pg8::StaticOrder S; S.init(MP, 2 * DFF, G, (int)blockIdx.x);
          Epi<EP_GU> E{q};
          GP4(pg8::gemm_phase<Epi<EP_GU>, pg8::StaticOrder, true, true>(lds, g, S, E);) TSTAMP(4);
          SG(sgemm<EP_GU, DM>(lds, XB_ + (size_t)MP * DM, WPTR(L, W_GU), DFF / 32, q);) TSTAMP(7); }
        { EpiArgs q2{}; q2.o0 = PBUF_;
          int kp = PLED; asm volatile("" : "+s"(kp));
          const int Gh = G >> 1;
          if ((int)blockIdx.x >= Gh) {
            pg8::Gemm g2{PB_ + (size_t)L * MT * PLED, WPTR(L, W_PP), MP, DM, kp}; pg8::StaticOrder S; S.init(MP, DM, G - Gh, (int)blockIdx.x - Gh);
            Epi<EP_P> E2{q2};
            GP3(pg8::gemm_phase<Epi<EP_P>, pg8::StaticOrder, true, true>(lds, g2, S, E2);) TSTAMP(10);
          }
          SG(sgemm<EP_P, PLED>(lds, PB_ + ((size_t)L * MT + MP) * PLED, WPTR(L, W_PP), DM / 32, q2);) TSTAMP(7); }
        GSYNC(); TSTAMP(8);
        { EpiArgs q{}; q.XB = XB_; q.xbase = XB_; q.ss_out = SS_PLE;
          pg8::Gemm g{HB_, WPTR(L, W_DOWN), MP, DM, DFF}; pg8::StaticOrder S; S.init(MP, DM, G, (int)blockIdx.x);
          Epi<EP_RES> E{q};
          GP5(pg8::gemm_phase<Epi<EP_RES>, pg8::StaticOrder, true, true>(lds, g, S, E);) TSTAMP(5);
          SG(sgemm<EP_RES, DFF>(lds, HB_ + (size_t)MP * DFF, WPTR(L, W_DOWN), DM / 32, q);) TSTAMP(7); }
        GSYNC(); TSTAMP(8);
        { EpiArgs q{}; q.XB = XN_  ; q.P = PBUF_; q.xbase = XB_; q.ss_in = SS_PLE; q.ss_out = SS_NEXT;
          pg8::Gemm g{XB_, WPTR(L, W_PG), MP, DM, DM}; pg8::StaticOrder S; S.init(MP, DM, G, (int)blockIdx.x);
          Epi<EP_PLE> E{q};
          GP6(pg8::gemm_phase<Epi<EP_PLE>, pg8::StaticOrder, true, true>(lds, g, S, E);) TSTAMP(6);
          SG(sgemm<EP_PLE, DM>(lds, XB_ + (size_t)MP * DM, WPTR(L, W_PG), DM / 32, q);) TSTAMP(7); }
        GSYNC(); TSTAMP(8);
    }
    {
        const int tid = fresh_tid(), lane = tid & 63, wave = __builtin_amdgcn_readfirstlane(tid >> 6);
        const int gw = blockIdx.x * NWAVES + wave, NGW = G * NWAVES;
        const float* ssf = SSB + (size_t)(3 * NLAYER) * MT; const float* gf = ARG(21); const bf16_t* XN = XN_; float* out = ARG_OUT;
        for (int row0 = 2 * gw; row0 < MT; row0 += 2 * NGW) {
            u32x2 xv[2][4];
#pragma unroll
            for (int rr = 0; rr < 2; ++rr)
#pragma unroll
                for (int j = 0; j < 4; ++j) xv[rr][j] = *((const u32x2*)(XN + (size_t)(row0 + rr) * DM) + lane + 64 * j);
#pragma unroll
            for (int rr = 0; rr < 2; ++rr) { const int row = row0 + rr; const float rs = rstd_of(ssf[row]);
                float* dst = row < MP ? out + O_YP + (size_t)row * DM : out + O_YS + (size_t)(row - MP) * DM;
#pragma unroll
                for (int j = 0; j < 4; ++j) { const f32x4 gv = *((const f32x4*)gf + lane + 64 * j); const u32x2 w = xv[rr][j];
                    const f32x4 v = {bf_lo(w.x), bf_hi(w.x), bf_lo(w.y), bf_hi(w.y)};
                    __builtin_nontemporal_store(v * rs * gv, (f32x4*)dst + lane + 64 * j); } }
        }
    }
#if PROBE_SEL >= 0
    TSTAMP(11); grid.sync();
    if (blockIdx.x == 0 && fresh_tid() == 0) { const unsigned long long* tsb = WS_PTR(unsigned long long, WS_CTL + 4096); float* o = ARG_OUT + O_YS; unsigned long long tv = 0; if (PROBE_SEL == 20) tv = tsb[16+1] + tsb[16+3] + tsb[16+10] + tsb[16+4] + tsb[16+5] + tsb[16+6]; else if (PROBE_SEL == 21) tv = tsb[16+0] + tsb[16+11]; else if (PROBE_SEL < 16) tv = tsb[16 + PROBE_SEL]; o[0] += (float)tv * 2.5e-5f; }
#endif
}

extern "C" void kernel_launch(void* const* d_in, const int* in_sizes, int n_in, void* d_out, int out_size, void* d_ws, size_t ws_size, hipStream_t stream) {
    static int grid = 0;
    if (grid == 0) {
        int dev = 0, cus = 0, per_cu = 0;
        hipGetDevice(&dev);
        hipDeviceGetAttribute(&cus, hipDeviceAttributeMultiprocessorCount, dev);
        hipFuncSetAttribute((const void*)hymba_fwd, hipFuncAttributeMaxDynamicSharedMemorySize, LDS_BYTES);
        hipOccupancyMaxActiveBlocksPerMultiprocessor(&per_cu, (const void*)hymba_fwd, NTHREADS, LDS_BYTES);
        if (per_cu < 1) per_cu = 1;
        grid = cus * per_cu;
        if (n_in != 22 || ws_size < WS_END) { fprintf(stderr, "kernel_launch: unexpected n_in %d / ws_size %zu\n", n_in, ws_size); }
    }
    Args a{};
    for (int i = 0; i < 22; ++i) a.in[i] = (const float*)d_in[i];
    a.out = (float*)d_out; a.ws = (unsigned char*)d_ws;
    void* kargs[] = {&a};
    hipError_t e = hipLaunchCooperativeKernel((const void*)hymba_fwd, dim3(grid), dim3(NTHREADS), kargs, LDS_BYTES, stream);
    if (e != hipSuccess) fprintf(stderr, "cooperative launch failed: %s (grid %d)\n", hipGetErrorString(e), grid);
}
```

```cpp
#include <hip/hip_runtime.h>
#include <hip/hip_cooperative_groups.h>
#include <cstdio>
#include <cstdint>
namespace cg = cooperative_groups;
__device__ __forceinline__ int fresh_tid() { int t = threadIdx.x; asm volatile("" : "+v"(t)); return t; }
namespace pg8 {
#define PG8_LAS __attribute__((address_space(3)))
typedef unsigned short bf16_t;
typedef short bf16x8 __attribute__((ext_vector_type(8)));
typedef float f32x4 __attribute__((ext_vector_type(4)));
typedef unsigned u32x4 __attribute__((ext_vector_type(4)));
constexpr int BM = 256, BK = 64, HALF = 128, HTB = HALF * BK * 2  , STAGE_BYTES = 8 * HTB, NXCD = 8, WGM = 8;

__host__ __device__ __forceinline__ int lds_byte(int r, int c) { const int st = (r >> 4) * 2 + (c >> 5), rr = r & 15, cc = c & 31, ob = rr * 64 + cc * 2; return st * 1024 + (ob ^ (((ob >> 9) & 1) << 5)); }
__host__ __device__ __forceinline__ void stage_rc(int b, int& R, int& C) { const int st = b / 1024, sb = b % 1024, swz = sb ^ (((sb >> 9) & 1) << 5); R = (st >> 1) * 16 + swz / 64; C = (st & 1) * 32 + (swz % 64) / 2; }
__host__ __device__ __forceinline__ int perm32(int rho) { const int n = rho >> 4, i = rho & 15; return 8 * (i >> 2) + 4 * n + (i & 3); }

struct Unit { int pm, pn; };
struct Gemm { const bf16_t* A; const bf16_t* Bt; int M, N, K; };

struct StaticOrder {
    int nM, nN, nwg, G, c;
    __host__ __device__ void init(int M, int N, int G_, int c_) { nM = M / BM; nN = N / BM; nwg = nM * nN; G = G_; c = c_; }
    __host__ __device__ bool next(int i, Unit& u) const {
        const long L = (long)i * G + c; if (L >= nwg) return false;
        int wgid = (int)L; { const int q = nwg / NXCD, r = nwg % NXCD, xcd = wgid % NXCD, off = wgid / NXCD; wgid = (xcd < r ? xcd * (q + 1) : r * (q + 1) + (xcd - r) * q) + off; }
        const int nig = WGM * nN, gid = wgid / nig, fm = gid * WGM, gsz = (nM - fm) < WGM ? (nM - fm) : WGM;
        u.pm = fm + ((wgid % nig) % gsz); u.pn = (wgid % nig) / gsz; return true;
    }
    __device__ __forceinline__ void a_ready(const Unit&) const {}
    __device__ __forceinline__ void done(const Unit&) const {}
};

template <class Epi, class Sched, bool ALIGN_EPI = false, bool SP2 = false>
__device__ __forceinline__ void gemm_phase(PG8_LAS unsigned char* lds, const Gemm g, const Sched& S, const Epi& E) {
    const int tid = fresh_tid(), wid = __builtin_amdgcn_readfirstlane(tid >> 6), lane = tid & 63, wr = wid >> 2, wc = wid & 3, fr = lane & 15, fq = lane >> 4;
    const int K = g.K, nt = K / BK;
    unsigned voffA[2], voffB[2];
#pragma unroll
    for (int i = 0; i < 2; ++i) { int R, C; stage_rc(tid * 16 + i * 8192, R, C); const int Rb = Epi::PERM ? ((R & ~31) + perm32(R & 31)) : R;
        voffA[i] = (unsigned)(R * K + C) * 2u; voffB[i] = (unsigned)(Rb * K + C) * 2u; }
    const size_t kstep = (size_t)(BK * 2);
    const size_t hstep = (size_t)HALF * K * 2;
    const size_t tstep = 2 * hstep;
    const unsigned ldsw = (unsigned)wid * 1024u;
    const int aoff = lds_byte(wr * 64 + fr, fq * 8), boff = lds_byte(wc * 32 + fr, fq * 8);
#define PG8_SA(b, h) (((b) * 2 + (h)) * HTB)
#define PG8_SB(b, h) ((4 + (b) * 2 + (h)) * HTB)
#define PG8_STAGE(bufoff, gbase, voff) do { _Pragma("unroll") for (int _i = 0; _i < 2; ++_i) \
        __builtin_amdgcn_global_load_lds((const unsigned*)((const char*)(gbase) + (voff)[_i]), (PG8_LAS unsigned*)(lds + (bufoff) + ldsw + _i * 8192), 16, 0, 0); } while (0)
#define PG8_LDA(dst, b, h) do { _Pragma("unroll") for (int m = 0; m < 4; ++m) _Pragma("unroll") for (int k = 0; k < 2; ++k) dst[m][k] = *(const PG8_LAS bf16x8*)(lds + PG8_SA(b, h) + aoff + m * 2048 + k * 1024); } while (0)
#define PG8_LDB(dst, b, h) do { _Pragma("unroll") for (int n = 0; n < 2; ++n) _Pragma("unroll") for (int k = 0; k < 2; ++k) dst[n][k] = *(const PG8_LAS bf16x8*)(lds + PG8_SB(b, h) + boff + n * 2048 + k * 1024); } while (0)
#define PG8_MMA(ai, bj, At, Bt) do { __builtin_amdgcn_s_setprio(1); _Pragma("unroll") for (int m = 0; m < 4; ++m) _Pragma("unroll") for (int n = 0; n < 2; ++n) _Pragma("unroll") for (int k = 0; k < 2; ++k) \
        acc[ai][bj][m][n] = __builtin_amdgcn_mfma_f32_16x16x32_bf16(Bt[n][k], At[m][k], acc[ai][bj][m][n], 0, 0, 0); __builtin_amdgcn_s_setprio(0); } while (0)
#define PG8_WAIT_V(n) asm volatile("s_waitcnt vmcnt(" #n ")" ::: "memory")
#define PG8_WAIT_L(n) asm volatile("s_waitcnt lgkmcnt(" #n ")" ::: "memory")
#define PG8_BAR __builtin_amdgcn_s_barrier()
#define PG8_SCHED __builtin_amdgcn_sched_barrier(0)
    Unit cur, nxt; int ui = 0;
    if (!S.next(0, cur)) return;
    f32x4 acc[2][2][4][2];
#pragma unroll
    for (int a = 0; a < 2; ++a)
#pragma unroll
        for (int b = 0; b < 2; ++b)
#pragma unroll
            for (int m = 0; m < 4; ++m)
#pragma unroll
                for (int n = 0; n < 2; ++n) acc[a][b][m][n] = (f32x4){0.f, 0.f, 0.f, 0.f};
    bf16x8 At[4][2], B0[2][2], B1[2][2];
    const char* cA = (const char*)g.A + (size_t)cur.pm * tstep; const char* cB = (const char*)g.Bt + (size_t)cur.pn * tstep;
    S.a_ready(cur);
    if constexpr (SP2) {
        PG8_STAGE(PG8_SB(0, 0), cB, voffB); PG8_STAGE(PG8_SB(0, 1), cB + hstep, voffB); PG8_STAGE(PG8_SA(0, 0), cA, voffA); PG8_STAGE(PG8_SA(0, 1), cA + hstep, voffA);
        if (wr == 1) PG8_BAR;
        PG8_WAIT_V(2); PG8_BAR;
        PG8_STAGE(PG8_SB(1, 0), cB + kstep, voffB); PG8_STAGE(PG8_SA(1, 0), cA + kstep, voffA); PG8_STAGE(PG8_SB(1, 1), cB + hstep + kstep, voffB);
        PG8_WAIT_V(6); PG8_BAR;
    } else {
        PG8_STAGE(PG8_SB(0, 0), cB, voffB); PG8_STAGE(PG8_SA(0, 0), cA, voffA); PG8_STAGE(PG8_SB(0, 1), cB + hstep, voffB); PG8_STAGE(PG8_SA(0, 1), cA + hstep, voffA);
        if (wr == 1) PG8_BAR;
        PG8_WAIT_V(4); PG8_BAR;
        PG8_STAGE(PG8_SB(1, 0), cB + kstep, voffB); PG8_STAGE(PG8_SA(1, 0), cA + kstep, voffA); PG8_STAGE(PG8_SB(1, 1), cB + hstep + kstep, voffB);
        PG8_WAIT_V(6); PG8_BAR;
    }
    for (;;) {
        const bool has_next = S.next(ui + 1, nxt);
        const char* nA = has_next ? (const char*)g.A + (size_t)nxt.pm * tstep : cA; const char* nB = has_next ? (const char*)g.Bt + (size_t)nxt.pn * tstep : cB;
        for (int t = 0; t < nt; t += 2) {
            const bool last = (t == nt - 2);
            const char* a1 = cA + (size_t)(t + 1) * kstep;
            const char* a2 = last ? nA : cA + (size_t)(t + 2) * kstep; const char* b2 = last ? nB : cB + (size_t)(t + 2) * kstep;
            const char* a3 = a2 + kstep; const char* b3 = b2 + kstep;
            if (last && has_next) S.a_ready(nxt);
            if constexpr (SP2) {
            PG8_LDB(B0, 0, 0); PG8_LDB(B1, 0, 1); PG8_SCHED; PG8_LDA(At, 0, 0); PG8_STAGE(PG8_SA(1, 1), a1 + hstep, voffA);
            PG8_WAIT_V(8); PG8_WAIT_L(0); PG8_BAR; PG8_MMA(0, 0, At, B0); PG8_MMA(0, 1, At, B1); PG8_BAR; PG8_SCHED;
            PG8_LDA(At, 0, 1); PG8_STAGE(PG8_SB(0, 0), b2, voffB); PG8_STAGE(PG8_SB(0, 1), b2 + hstep, voffB); PG8_STAGE(PG8_SA(0, 0), a2, voffA);
            PG8_WAIT_V(8); PG8_WAIT_L(0); PG8_BAR; PG8_MMA(1, 0, At, B0); PG8_MMA(1, 1, At, B1); PG8_BAR; PG8_SCHED;
            PG8_LDB(B0, 1, 0); PG8_LDB(B1, 1, 1); PG8_SCHED; PG8_LDA(At, 1, 0); PG8_STAGE(PG8_SA(0, 1), a2 + hstep, voffA);
            PG8_WAIT_V(8); PG8_WAIT_L(0); PG8_BAR; PG8_MMA(0, 0, At, B0); PG8_MMA(0, 1, At, B1); PG8_BAR; PG8_SCHED;
            PG8_LDA(At, 1, 1); PG8_STAGE(PG8_SB(1, 0), b3, voffB); PG8_STAGE(PG8_SB(1, 1), b3 + hstep, voffB); PG8_STAGE(PG8_SA(1, 0), a3, voffA);
            PG8_WAIT_V(8); PG8_WAIT_L(0); PG8_BAR; PG8_MMA(1, 0, At, B0); PG8_MMA(1, 1, At, B1); PG8_BAR; PG8_SCHED;
            } else {
            PG8_LDB(B0, 0, 0); PG8_SCHED; PG8_LDA(At, 0, 0); PG8_STAGE(PG8_SA(1, 1), a1 + hstep, voffA);
            PG8_WAIT_L(8); PG8_BAR; PG8_WAIT_L(0); PG8_MMA(0, 0, At, B0); PG8_BAR; PG8_SCHED;
            PG8_LDB(B1, 0, 1); PG8_STAGE(PG8_SB(0, 0), b2, voffB);
            PG8_BAR; PG8_WAIT_L(0); PG8_MMA(0, 1, At, B1); PG8_BAR;
            PG8_LDA(At, 0, 1); PG8_STAGE(PG8_SA(0, 0), a2, voffA);
            PG8_BAR; PG8_WAIT_L(0); PG8_MMA(1, 0, At, B0); PG8_BAR; PG8_SCHED;
            PG8_STAGE(PG8_SB(0, 1), b2 + hstep, voffB);
            PG8_WAIT_V(6); PG8_BAR; PG8_MMA(1, 1, At, B1); PG8_BAR;
            PG8_LDB(B0, 1, 0); PG8_SCHED; PG8_LDA(At, 1, 0); PG8_STAGE(PG8_SA(0, 1), a2 + hstep, voffA);
            PG8_WAIT_L(8); PG8_BAR; PG8_WAIT_L(0); PG8_MMA(0, 0, At, B0); PG8_BAR; PG8_SCHED;
            PG8_LDB(B1, 1, 1); PG8_STAGE(PG8_SB(1, 0), b3, voffB);
            PG8_BAR; PG8_WAIT_L(0); PG8_MMA(0, 1, At, B1); PG8_BAR;
            PG8_LDA(At, 1, 1); PG8_STAGE(PG8_SA(1, 0), a3, voffA);
            PG8_BAR; PG8_WAIT_L(0); PG8_MMA(1, 0, At, B0); PG8_BAR; PG8_SCHED;
            PG8_STAGE(PG8_SB(1, 1), b3 + hstep, voffB);
            PG8_WAIT_V(6); PG8_BAR; PG8_MMA(1, 1, At, B1); PG8_BAR;
            }
        }
        if constexpr (ALIGN_EPI) { if (wr == 0) PG8_BAR; }
        if constexpr (!Epi::AFTER_DRAIN) { E(acc, cur, wr, wc, fr, fq); S.done(cur); }
        if (!has_next) break;
#pragma unroll
        for (int a = 0; a < 2; ++a)
#pragma unroll
            for (int b = 0; b < 2; ++b)
#pragma unroll
                for (int m = 0; m < 4; ++m)
#pragma unroll
                    for (int n = 0; n < 2; ++n) acc[a][b][m][n] = (f32x4){0.f, 0.f, 0.f, 0.f};
        cur = nxt; cA = nA; cB = nB; ++ui;
        if constexpr (ALIGN_EPI) { if (wr == 1) PG8_BAR; }
    }
    PG8_WAIT_V(0);
    if constexpr (!ALIGN_EPI) { if (wr == 0) PG8_BAR; }
    PG8_BAR;
    if constexpr (Epi::AFTER_DRAIN) { E.fused(acc, cur, wr, wc, fr, fq, lds, wid, lane); S.done(cur); }
#undef PG8_SA
#undef PG8_SB
#undef PG8_STAGE
#undef PG8_LDA
#undef PG8_LDB
#undef PG8_MMA
#undef PG8_WAIT_V
#undef PG8_WAIT_L
#undef PG8_BAR
#undef PG8_SCHED
}
}

#define LAS __attribute__((address_space(3)))
using pg8::bf16_t; using pg8::bf16x8; using pg8::f32x4; using pg8::u32x4;
typedef short s16x4 __attribute__((ext_vector_type(4)));
typedef float f32x16 __attribute__((ext_vector_type(16)));
typedef unsigned u32x2 __attribute__((ext_vector_type(2)));
typedef float f32x2_t __attribute__((ext_vector_type(2)));
typedef __bf16 bf16x2_t __attribute__((ext_vector_type(2)));

constexpr int DM = 1024, SEQ = 2048, NBATCH = 8, MP = NBATCH * SEQ, DSEQ = 16, MS = NBATCH * DSEQ, MT = MP + MS;
constexpr int DFF = 2816, NQKV = 3072, PLED = 256, NLAYER = 2, PAST = 2048, BANDL = 512, HW = 512;
constexpr float EPS = 1e-6f, LOG2E = 1.4426950408889634f, QSCALE = 0.125f * LOG2E;
#ifndef SB_EARLY
#define SB_EARLY 1
#endif
constexpr float SB_THR = 7.5e-37f;

constexpr size_t MiB = 1u << 20;
constexpr size_t WS_CTL = 0, WS_SS = 64 * 1024;
constexpr size_t WS_W = 2 * MiB, W_LSTRIDE = 28 * MiB, W_IN = 0, W_OUT = 6 * MiB, W_GU = 8 * MiB, W_DOWN = 19 * MiB, W_PG = 25 * MiB, W_PP = 27 * MiB;
constexpr size_t WS_PB = 58 * MiB, WS_X = 76 * MiB  , WS_XB = 142 * MiB, WS_QKV = 176 * MiB, WS_MIX = 274 * MiB, WS_P = 308 * MiB, WS_END = 342 * MiB;
constexpr int LDS_BYTES = 131072 + 1024;
constexpr size_t WS_BAR = 8192;
constexpr int NWAVES = 8, NTHREADS = 512;

constexpr size_t O_YP = 0, O_YS = (size_t)MP * DM, O_SBK_P = O_YS + (size_t)MS * DM, O_SBV_P = O_SBK_P + (size_t)NLAYER * MP * HW,
                 O_CBK_P = O_SBV_P + (size_t)NLAYER * MP * HW, O_CBV_P = O_CBK_P + (size_t)NLAYER * NBATCH * BANDL * HW,
                 O_SBK_S = O_CBV_P + (size_t)NLAYER * NBATCH * BANDL * HW, O_SBV_S = O_SBK_S + (size_t)NLAYER * MS * HW,
                 O_CBK_S = O_SBV_S + (size_t)NLAYER * MS * HW, O_CBV_S = O_CBK_S + (size_t)NLAYER * MS * HW;

__device__ __forceinline__ unsigned pk2(float lo, float hi) { f32x2_t v = {lo, hi}; bf16x2_t b = __builtin_convertvector(v, bf16x2_t); return __builtin_bit_cast(unsigned, b); }
__device__ __forceinline__ float bf_lo(unsigned w) { return __uint_as_float(w << 16); }
__device__ __forceinline__ float bf_hi(unsigned w) { return __uint_as_float(w & 0xffff0000u); }
__device__ __forceinline__ float partner32(float v) {
    auto rr = __builtin_amdgcn_permlane32_swap(__float_as_uint(v), __float_as_uint(v), false, false);
    return (threadIdx.x & 32) ? __uint_as_float(rr[0]) : __uint_as_float(rr[1]);
}
__device__ __forceinline__ float wave_sum(float v) {
#pragma unroll
    for (int o = 1; o < 64; o <<= 1) v += __shfl_xor(v, o);
    return v;
}
__device__ __forceinline__ float rstd_of(float ss) { return rsqrtf(ss * (1.0f / DM) + EPS); }

template <int I> __device__ __forceinline__ const float* argp() {
    unsigned long long v; const void* ka = (const void*)__builtin_amdgcn_kernarg_segment_ptr();
    asm volatile("s_load_dwordx2 %0, %1, %2\n\ts_waitcnt lgkmcnt(0)" : "=s"(v) : "s"(ka), "i"(I * 8) : "memory");
    return (const float*)(const __attribute__((address_space(1))) float*)v;
}
#define ARG(i) argp<i>()
#define ARG_OUT ((float*)argp<22>())
#define ARG_WS ((unsigned char*)argp<23>())
#define WS_PTR(T, off) ((T*)(ARG_WS + (off)))
#define SSB WS_PTR(float, WS_SS)
#define PB_ WS_PTR(bf16_t, WS_PB)
#define XN_ WS_PTR(bf16_t, WS_X)
#define XB_ WS_PTR(bf16_t, WS_XB)
#define QKV_ WS_PTR(bf16_t, WS_QKV)
#define HB_ WS_PTR(bf16_t, WS_QKV)
#define MIX_ WS_PTR(bf16_t, WS_MIX)
#define PBUF_ WS_PTR(bf16_t, WS_P)
#define WPTR(L, off) ((const bf16_t*)(ARG_WS + WS_W + (size_t)(L) * W_LSTRIDE + (off)))

enum { EP_QKV = 0, EP_RES = 1, EP_GU = 2, EP_P = 3, EP_PLE = 4 };
struct EpiArgs {
    const float* ss_in; float* ss_out;
    const bf16_t* xbase;
    bf16_t* XB; bf16_t* o0; const bf16_t* P;
    float *f_sbk, *f_sbv, *f_cbk, *f_cbv;
    float *s_sbk, *s_sbv, *s_cbk, *s_cbv;
};
template <int MODE> struct Epi {
    static constexpr bool PERM = false, AFTER_DRAIN = false;
    EpiArgs a;
    __device__ __forceinline__ void operator()(const f32x4 (&acc)[2][2][4][2], const pg8::Unit& u, int wr, int wc, int fr, int fq) const {
        if constexpr (MODE == EP_QKV) {
            const int part = u.pn >> 1, cb = (u.pn & 1) * 256 + wc * 32 + 4 * fq;
            bf16_t* ob = a.o0 + (size_t)part * ((size_t)MT * HW);
            float* fo = part == 1 ? a.f_sbk : part == 2 ? a.f_sbv : part == 4 ? a.f_cbk : part == 5 ? a.f_cbv : nullptr;
            const bool band = part >= 4; const float qs = (part == 0 || part == 3) ? QSCALE : 1.f;
#pragma unroll
            for (int ai = 0; ai < 2; ++ai)
#pragma unroll
                for (int m = 0; m < 4; ++m) {
                    const int row = u.pm * 256 + ai * 128 + wr * 64 + m * 16 + fr;
                    const float rs = rstd_of(a.ss_in[row]) * qs;
                    const int t = row & (SEQ - 1);
                    float* frow = nullptr;
                    if (fo) { if (!band) frow = fo + (size_t)row * HW; else if (t >= SEQ - BANDL) frow = fo + ((size_t)(row >> 11) * BANDL + (t - (SEQ - BANDL))) * HW; }
#pragma unroll
                    for (int bj = 0; bj < 2; ++bj)
#pragma unroll
                        for (int n = 0; n < 2; ++n) {
                            const int col = cb + bj * 128 + n * 16; const f32x4 v = acc[ai][bj][m][n] * rs;
                            u32x2 w; w.x = pk2(v[0], v[1]); w.y = pk2(v[2], v[3]);
                            *(u32x2*)(ob + (size_t)row * HW + col) = w;
                            if (frow) __builtin_nontemporal_store(v, (f32x4*)(frow + col));
                        }
                }
        } else if constexpr (MODE == EP_RES || MODE == EP_PLE) {
#pragma unroll
            for (int ai = 0; ai < 2; ++ai)
#pragma unroll
                for (int m = 0; m < 4; ++m) {
                    const int row = u.pm * 256 + ai * 128 + wr * 64 + m * 16 + fr;
                    float rs = 0.f; if constexpr (MODE == EP_PLE) rs = rstd_of(a.ss_in[row]) * (-LOG2E);
                    float s = 0.f;
#pragma unroll
                    for (int bj = 0; bj < 2; ++bj)
#pragma unroll
                        for (int n = 0; n < 2; ++n) {
                            const size_t off = (size_t)row * DM + u.pn * 256 + bj * 128 + wc * 32 + n * 16 + 4 * fq;
                            const u32x2 xw = *(const u32x2*)(a.xbase + off); f32x4 x = {bf_lo(xw.x), bf_hi(xw.x), bf_lo(xw.y), bf_hi(xw.y)}; const f32x4 c = acc[ai][bj][m][n];
                            if constexpr (MODE == EP_RES) x += c;
                            else { const u32x2 pw = *(const u32x2*)(a.P + off);
                                   x[0] += bf_lo(pw.x) * __builtin_amdgcn_rcpf(1.f + __builtin_amdgcn_exp2f(c[0] * rs));
                                   x[1] += bf_hi(pw.x) * __builtin_amdgcn_rcpf(1.f + __builtin_amdgcn_exp2f(c[1] * rs));
                                   x[2] += bf_lo(pw.y) * __builtin_amdgcn_rcpf(1.f + __builtin_amdgcn_exp2f(c[2] * rs));
                                   x[3] += bf_hi(pw.y) * __builtin_amdgcn_rcpf(1.f + __builtin_amdgcn_exp2f(c[3] * rs)); }
                            u32x2 w; w.x = pk2(x[0], x[1]); w.y = pk2(x[2], x[3]); *(u32x2*)(a.XB + off) = w;
                            s += (x[0] * x[0] + x[1] * x[1]) + (x[2] * x[2] + x[3] * x[3]);
                        }
                    s += __shfl_xor(s, 16); s += __shfl_xor(s, 32);
                    if (fq == 0) unsafeAtomicAdd(a.ss_out + row, s);
                }
        } else if constexpr (MODE == EP_GU) {
#pragma unroll
            for (int ai = 0; ai < 2; ++ai)
#pragma unroll
                for (int m = 0; m < 4; ++m) {
                    const int row = u.pm * 256 + ai * 128 + wr * 64 + m * 16 + fr;
                    const float rs = rstd_of(a.ss_in[row]);
#pragma unroll
                    for (int n = 0; n < 2; ++n) {
                        const int col = u.pn * 128 + wc * 32 + n * 16 + 4 * fq;
                        const f32x4 g = acc[ai][0][m][n] * rs, up = acc[ai][1][m][n] * rs; float h[4];
#pragma unroll
                        for (int e = 0; e < 4; ++e) h[e] = g[e] * up[e] * __builtin_amdgcn_rcpf(1.f + __builtin_amdgcn_exp2f(-LOG2E * g[e]));
                        u32x2 w; w.x = pk2(h[0], h[1]); w.y = pk2(h[2], h[3]);
                        *(u32x2*)(a.o0 + (size_t)row * DFF + col) = w;
                    }
                }
        } else {
#pragma unroll
            for (int ai = 0; ai < 2; ++ai)
#pragma unroll
                for (int m = 0; m < 4; ++m) {
                    const int row = u.pm * 256 + ai * 128 + wr * 64 + m * 16 + fr;
#pragma unroll
                    for (int bj = 0; bj < 2; ++bj)
#pragma unroll
                        for (int n = 0; n < 2; ++n) {
                            const size_t off = (size_t)row * DM + u.pn * 256 + bj * 128 + wc * 32 + n * 16 + 4 * fq; const f32x4 v = acc[ai][bj][m][n];
                            u32x2 w; w.x = pk2(v[0], v[1]); w.y = pk2(v[2], v[3]); *(u32x2*)(a.o0 + off) = w;
                        }
                }
        }
    }
};

template <int MODE, int K>
__device__ __forceinline__ void sgemm(LAS unsigned char* lds, const bf16_t* A, const bf16_t* Bt, int ncol32, const EpiArgs& a) {
    const int tid = fresh_tid(), lane = tid & 63, wave = __builtin_amdgcn_readfirstlane(tid >> 6), r = lane & 31, hh = lane >> 5;
    LAS float* red = (LAS float*)lds;
    constexpr int K8 = K >> 3, NK = K8 / 16, UB = NK > 11 ? 11 : NK;
    static_assert(NK % UB == 0, "sgemm: K split");
    const int G = gridDim.x, nunits = 4 * ncol32;
    for (int j = G - 1 - (int)blockIdx.x; j < nunits; j += G) {
        const int rb = j & 3, c0 = (MODE == EP_QKV ? 64 : 32) * (j >> 2);
        const int brow0 = (MODE == EP_GU) ? ((c0 >> 7) * 256 + (c0 & 127)) : c0;
        const bf16_t* ap = A + (size_t)(32 * rb + r) * K + wave * K8 + 8 * hh;
        const bf16_t* bp = Bt + (size_t)(brow0 + r) * K + wave * K8 + 8 * hh;
        f32x16 acc0 = {}, acc1 = {};
#pragma unroll 1
        for (int kb = 0; kb < NK; kb += UB) {
            bf16x8 af[UB], bf[UB], bf2[(MODE == EP_GU || MODE == EP_QKV) ? UB : 1];
#pragma unroll
            for (int i = 0; i < UB; ++i) { af[i] = *(const bf16x8*)(ap + (kb + i) * 16); bf[i] = *(const bf16x8*)(bp + (kb + i) * 16);
                if constexpr (MODE == EP_GU) bf2[i] = *(const bf16x8*)(bp + (size_t)128 * K + (kb + i) * 16);
                if constexpr (MODE == EP_QKV) bf2[i] = *(const bf16x8*)(bp + (size_t)32 * K + (kb + i) * 16); }
#pragma unroll
            for (int i = 0; i < UB; ++i) { acc0 = __builtin_amdgcn_mfma_f32_32x32x16_bf16(af[i], bf[i], acc0, 0, 0, 0);
                if constexpr (MODE == EP_GU || MODE == EP_QKV) acc1 = __builtin_amdgcn_mfma_f32_32x32x16_bf16(af[i], bf2[i], acc1, 0, 0, 0); }
        }
#pragma unroll
        for (int i = 0; i < 16; ++i) { red[(wave * 16 + i) * 64 + lane] = acc0[i]; if constexpr (MODE == EP_GU || MODE == EP_QKV) red[8192 + (wave * 16 + i) * 64 + lane] = acc1[i]; }
        __syncthreads();
        const int col = c0 + r;
#pragma unroll
        for (int ii = 0; ii < 2; ++ii) {
            const int i = 2 * wave + ii;
            float v0 = 0.f, v1 = 0.f;
#pragma unroll
            for (int w = 0; w < 8; ++w) { v0 += red[(w * 16 + i) * 64 + lane]; if constexpr (MODE == EP_GU || MODE == EP_QKV) v1 += red[8192 + (w * 16 + i) * 64 + lane]; }
            const int rs_ = 32 * rb + (i & 3) + 8 * (i >> 2) + 4 * hh, row = MP + rs_;
            if constexpr (MODE == EP_QKV) {
                const int part = c0 >> 9, cc = col & 511;
                const float rs = rstd_of(a.ss_in[row]); const float va = v0 * rs, vb = v1 * rs;
                const float qs = (part == 0 || part == 3) ? QSCALE : 1.f;
                bf16_t* ob = a.o0 + (size_t)part * ((size_t)MT * HW) + (size_t)row * HW + cc;
                ob[0] = (bf16_t)(pk2(va * qs, 0.f) & 0xffffu); ob[32] = (bf16_t)(pk2(vb * qs, 0.f) & 0xffffu);
                float* fo = part == 1 ? a.s_sbk : part == 2 ? a.s_sbv : part == 4 ? a.s_cbk : part == 5 ? a.s_cbv : nullptr;
                if (fo) { fo[(size_t)rs_ * HW + cc] = va; fo[(size_t)rs_ * HW + cc + 32] = vb; }
            } else if constexpr (MODE == EP_RES || MODE == EP_PLE) {
                const size_t off = (size_t)row * DM + col;
                float x = __uint_as_float((unsigned)a.xbase[off] << 16);
                if constexpr (MODE == EP_RES) x += v0;
                else { const float pv = __uint_as_float((unsigned)a.P[off] << 16); x += pv * __builtin_amdgcn_rcpf(1.f + __builtin_amdgcn_exp2f(-LOG2E * v0 * rstd_of(a.ss_in[row]))); }
                a.XB[off] = (bf16_t)(pk2(x, 0.f) & 0xffffu);
                float s = x * x;
                s += __shfl_xor(s, 1); s += __shfl_xor(s, 2); s += __shfl_xor(s, 4); s += __shfl_xor(s, 8); s += __shfl_xor(s, 16);
                if (r == 0) unsafeAtomicAdd(a.ss_out + row, s);
            } else if constexpr (MODE == EP_GU) {
                const float rs = rstd_of(a.ss_in[row]); const float g = v0 * rs, up = v1 * rs;
                const float h = g * up * __builtin_amdgcn_rcpf(1.f + __builtin_amdgcn_exp2f(-LOG2E * g));
                a.o0[(size_t)row * DFF + col] = (bf16_t)(pk2(h, 0.f) & 0xffffu);
            } else {
                a.o0[(size_t)row * DM + col] = (bf16_t)(pk2(v0, 0.f) & 0xffffu);
            }
        }
        __syncthreads();
    }
}
struct AttnArgs { int L; };
constexpr int AW_V = 0, AW_ST = 4096, AW_BIAS = 8704, AW_BYTES = 10240, ST_PITCH = 144;

template <bool F32> __device__ __forceinline__ void ld_k(bf16x8 (&kf)[4], const void* base, size_t off) {
    if constexpr (!F32) { const bf16_t* p = (const bf16_t*)base + off;
#pragma unroll
        for (int kk = 0; kk < 4; ++kk) kf[kk] = *(const bf16x8*)(p + 8 * kk);
    } else { const float* p = (const float*)base + off;
#pragma unroll
        for (int kk = 0; kk < 4; ++kk) { const f32x4 x = *(const f32x4*)(p + 8 * kk), y = *(const f32x4*)(p + 8 * kk + 4);
            u32x4 w; w.x = pk2(x[0], x[1]); w.y = pk2(x[2], x[3]); w.z = pk2(y[0], y[1]); w.w = pk2(y[2], y[3]); kf[kk] = __builtin_bit_cast(bf16x8, w); }
    }
}
template <bool F32> __device__ __forceinline__ void ld_v(u32x4 (&vr)[4], const void* base, size_t row0, int nvalid, int h, int lane) {
#pragma unroll
    for (int i = 0; i < 4; ++i) { int key = 8 * i + (lane >> 3); key = key < nvalid ? key : nvalid - 1;
        const size_t off = (row0 + key) * HW + h * 64 + (lane & 7) * 8;
        if constexpr (!F32) vr[i] = *(const u32x4*)((const bf16_t*)base + off);
        else { const float* p = (const float*)base + off; const f32x4 x = *(const f32x4*)p, y = *(const f32x4*)(p + 4);
            u32x4 w; w.x = pk2(x[0], x[1]); w.y = pk2(x[2], x[3]); w.z = pk2(y[0], y[1]); w.w = pk2(y[2], y[3]); vr[i] = w; }
    }
}
__device__ __forceinline__ void st_v(LAS unsigned char* vl, const u32x4 (&vr)[4], int lane) {
#pragma unroll
    for (int i = 0; i < 4; ++i) { const int key = 8 * i + (lane >> 3); *(LAS u32x4*)(vl + key * 128 + (((lane & 7) * 16) ^ (((key >> 1) & 1) << 6))) = vr[i]; }
}
typedef short v4i16_t __attribute__((ext_vector_type(4)));
__device__ __forceinline__ s16x4 vtr(LAS unsigned char* p) { return __builtin_bit_cast(s16x4, __builtin_amdgcn_ds_read_tr16_b64_v4i16((LAS v4i16_t*)p)); }
__device__ __forceinline__ void pv_block(f32x16 (&o)[2], LAS unsigned char* vl, const bf16x8 (&pf)[2], int lane) {
    const int q = (lane & 15) >> 2, p = lane & 3, c16 = (lane >> 4) & 1, hh = lane >> 5;
    const int va0 = (4 * hh + q) * 128 + ((32 * c16 + 8 * p) ^ ((q >> 1) << 6));
#pragma unroll
    for (int db = 0; db < 2; ++db)
#pragma unroll
        for (int s = 0; s < 2; ++s) {
            const s16x4 lo = vtr(vl + (va0 ^ (db * 64)) + s * 2048), hi = vtr(vl + (va0 ^ (db * 64)) + s * 2048 + 1024);
            const bf16x8 vf = {lo[0], lo[1], lo[2], lo[3], hi[0], hi[1], hi[2], hi[3]};
            o[db] = __builtin_amdgcn_mfma_f32_32x32x16_bf16(vf, pf[s], o[db], 0, 0, 0);
        }
}
__device__ __forceinline__ f32x16 qk_block(const bf16x8 (&kf)[4], const bf16x8 (&qf)[4]) {
    f32x16 S = {};
#pragma unroll
    for (int kk = 0; kk < 4; ++kk) S = __builtin_amdgcn_mfma_f32_32x32x16_bf16(kf[kk], qf[kk], S, 0, 0, 0);
    return S;
}
__device__ __forceinline__ void sb_block(const f32x16& S, LAS unsigned char* vl, int tq, int keypos0, float& carry, f32x16 (&o)[2], int lane) {
    const int hh = lane >> 5;
    float kp_[16], be[16];
#pragma unroll
    for (int r = 0; r < 16; ++r) {
        const int kp = keypos0 + (r & 3) + 8 * (r >> 2) + 4 * hh; const bool valid = kp < tq;
        const float z = __builtin_amdgcn_fmed3f(S[r], -126.f, 100.f);
        const float t = __builtin_amdgcn_exp2f(z), k = __builtin_amdgcn_rcpf(1.f + t);
        kp_[r] = valid ? k : 1.f; be[r] = valid ? t * k : 0.f;
    }
    float T[4], Tp[4], U[4];
#pragma unroll
    for (int g = 0; g < 4; ++g) { T[g] = (kp_[4 * g] * kp_[4 * g + 1]) * (kp_[4 * g + 2] * kp_[4 * g + 3]); Tp[g] = partner32(T[g]); U[g] = T[g] * Tp[g]; }
    float R[4]; R[3] = 1.f; R[2] = U[3]; R[1] = U[3] * U[2]; R[0] = R[1] * U[1];
    const float tot = R[0] * U[0];
    float w[16];
#pragma unroll
    for (int g = 0; g < 4; ++g) {
        const float b3 = carry * R[g] * (hh == 0 ? Tp[g] : 1.f);
        const float b2 = b3 * kp_[4 * g + 3], b1 = b2 * kp_[4 * g + 2], b0 = b1 * kp_[4 * g + 1];
        w[4 * g + 3] = be[4 * g + 3] * b3; w[4 * g + 2] = be[4 * g + 2] * b2; w[4 * g + 1] = be[4 * g + 1] * b1; w[4 * g + 0] = be[4 * g + 0] * b0;
    }
    carry *= tot;
    bf16x8 pf[2];
#pragma unroll
    for (int s = 0; s < 2; ++s) { u32x4 pw; pw.x = pk2(w[8 * s], w[8 * s + 1]); pw.y = pk2(w[8 * s + 2], w[8 * s + 3]); pw.z = pk2(w[8 * s + 4], w[8 * s + 5]); pw.w = pk2(w[8 * s + 6], w[8 * s + 7]); pf[s] = __builtin_bit_cast(bf16x8, pw); }
    pv_block(o, vl, pf, lane);
}
__device__ __forceinline__ void cb_block(const f32x16& S, bool cbias, LAS unsigned char* vl, const LAS float* bl, int tq, int keypos0, int nvalid, float& m, float& l, f32x16 (&o)[2], int lane) {
    const int hh = lane >> 5;
    float s[16]; float bm = -INFINITY;
    if (cbias) {
        const float cb = bl[256];
#pragma unroll
        for (int r = 0; r < 16; ++r) { s[r] = S[r] + cb; bm = fmaxf(bm, s[r]); }
    } else {
#pragma unroll
        for (int r = 0; r < 16; ++r) {
            const int kr = (r & 3) + 8 * (r >> 2) + 4 * hh; int d = tq - (keypos0 + kr); d = d < -128 ? -128 : (d > 128 ? 128 : d);
            s[r] = (kr < nvalid) ? S[r] + bl[d + 128] : -INFINITY; bm = fmaxf(bm, s[r]);
        }
    }
    bm = fmaxf(bm, partner32(bm));
    if (__any(bm > m + 8.f)) {
        const float mn = fmaxf(m, bm), f = __builtin_amdgcn_exp2f(m - mn); m = mn; l *= f;
#pragma unroll
        for (int db = 0; db < 2; ++db)
#pragma unroll
            for (int r = 0; r < 16; ++r) o[db][r] *= f;
    }
    float w[16], ls = 0.f;
#pragma unroll
    for (int r = 0; r < 16; ++r) { w[r] = __builtin_amdgcn_exp2f(s[r] - m); ls += w[r]; }
    l += ls;
    bf16x8 pf[2];
#pragma unroll
    for (int s2 = 0; s2 < 2; ++s2) { u32x4 pw; pw.x = pk2(w[8 * s2], w[8 * s2 + 1]); pw.y = pk2(w[8 * s2 + 2], w[8 * s2 + 3]); pw.z = pk2(w[8 * s2 + 4], w[8 * s2 + 5]); pw.w = pk2(w[8 * s2 + 6], w[8 * s2 + 7]); pf[s2] = __builtin_bit_cast(bf16x8, pw); }
    pv_block(o, vl, pf, lane);
}
__device__ __forceinline__ void attn_store(f32x16 (&o)[2], float scale, const float* gain, bf16_t* mix, size_t row0, int col0, int nrows, LAS unsigned char* wl, int lane) {
    const int r = lane & 31, hh = lane >> 5;
    f32x4 gvs[2][4];
#pragma unroll
    for (int db = 0; db < 2; ++db)
#pragma unroll
        for (int g = 0; g < 4; ++g) gvs[db][g] = *(const f32x4*)(gain + 32 * db + 8 * g + 4 * hh);
    float ssq = 0.f;
#pragma unroll
    for (int db = 0; db < 2; ++db)
#pragma unroll
        for (int i = 0; i < 16; ++i) { o[db][i] *= scale; ssq += o[db][i] * o[db][i]; }
    ssq += partner32(ssq);
    const float rstd = rsqrtf(ssq * (1.0f / 64.0f) + EPS);
    LAS unsigned char* st = wl + AW_ST;
#pragma unroll
    for (int db = 0; db < 2; ++db)
#pragma unroll
        for (int g = 0; g < 4; ++g) { const int d0 = 32 * db + 8 * g + 4 * hh; const f32x4 gv = gvs[db][g];
            u32x2 w; w.x = pk2(o[db][4 * g] * rstd * gv[0], o[db][4 * g + 1] * rstd * gv[1]); w.y = pk2(o[db][4 * g + 2] * rstd * gv[2], o[db][4 * g + 3] * rstd * gv[3]);
            *(LAS u32x2*)(st + r * ST_PITCH + d0 * 2) = w; }
#pragma unroll
    for (int i = 0; i < 4; ++i) { const int row = 8 * i + (lane >> 3), ch = lane & 7; const u32x4 v = *(const LAS u32x4*)(st + row * ST_PITCH + ch * 16);
        if (row < nrows) *(u32x4*)(mix + (row0 + row) * DM + col0 + ch * 8) = v; }
}

template <bool F32> __device__ __forceinline__ void sb_loop(const void* kbase, const void* vbase, size_t rowbase, int jhi, int h, const bf16x8 (&qf)[4], int tq, float& carry, f32x16 (&o)[2], LAS unsigned char* wl, int lane) {
    const int r = lane & 31, hh = lane >> 5;
    bf16x8 kA[4], kB[4]; u32x4 vA[4], vB[4];
#define SB_LD(KF, VN, jj) do { ld_k<F32>(KF, kbase, (rowbase + 32 * (jj) + r) * HW + h * 64 + 32 * hh); ld_v<F32>(VN, vbase, rowbase + 32 * (jj), 32, h, lane); } while (0)
    SB_LD(kA, vA, jhi); if (jhi >= 1) SB_LD(kB, vB, jhi - 1);
    for (int j = jhi; j >= 0; j -= 2) {
        { const f32x16 S = qk_block(kA, qf); st_v(wl + AW_V, vA, lane); if (j >= 2) SB_LD(kA, vA, j - 2);
          sb_block(S, wl + AW_V, tq, 32 * j, carry, o, lane); }
#if SB_EARLY
        if (__all(carry < SB_THR)) break;
#endif
        if (j < 1) break;
        { const f32x16 S = qk_block(kB, qf); st_v(wl + AW_V, vB, lane); if (j >= 3) SB_LD(kB, vB, j - 3);
          sb_block(S, wl + AW_V, tq, 32 * (j - 1), carry, o, lane); }
#if SB_EARLY
        if (__all(carry < SB_THR)) break;
#endif
    }
#undef SB_LD
}
template <bool SAMPLE> __device__ __forceinline__ void sb_unit(const AttnArgs& A, int b, int h, int qb, LAS unsigned char* wl, int lane) {
    const int r = lane & 31, hh = lane >> 5;
    const bf16_t* Qa = QKV_; const bf16_t* Ka = Qa + (size_t)1 * MT * HW; const bf16_t* Va = Qa + (size_t)2 * MT * HW;
    int tq; size_t qrow;
    if (SAMPLE) { tq = PAST + (r & 15); qrow = (size_t)MP + b * DSEQ + (r & 15); } else { tq = 32 * qb + r; qrow = (size_t)b * SEQ + tq; }
    bf16x8 qf[4]; ld_k<false>(qf, Qa, qrow * HW + h * 64 + 32 * hh);
    float carry = 1.f; f32x16 o[2]; o[0] = f32x16{}; o[1] = f32x16{};
    if (SAMPLE) {
        bf16x8 kf[4]; u32x4 vr[4]; const size_t row0 = (size_t)MP + b * DSEQ;
        ld_k<false>(kf, Ka, (row0 + (r & 15)) * HW + h * 64 + 32 * hh); ld_v<false>(vr, Va, row0, DSEQ, h, lane); st_v(wl + AW_V, vr, lane);
        { const f32x16 S = qk_block(kf, qf); sb_block(S, wl + AW_V, tq, PAST, carry, o, lane); }
        sb_loop<true>(ARG(4) + (size_t)A.L * NBATCH * PAST * HW, ARG(5) + (size_t)A.L * NBATCH * PAST * HW, (size_t)b * PAST, PAST / 32 - 1, h, qf, tq, carry, o, wl, lane);
        attn_store(o, 1.f, ARG(11) + A.L * HW + h * 64, MIX_, row0, h * 64, DSEQ, wl, lane);
    } else {
        sb_loop<false>(Ka, Va, (size_t)b * SEQ, qb, h, qf, tq, carry, o, wl, lane);
        attn_store(o, 1.f, ARG(11) + A.L * HW + h * 64, MIX_, (size_t)b * SEQ + 32 * qb, h * 64, 32, wl, lane);
    }
}
template <bool F32> __device__ __forceinline__ void cb_loop(const void* kbase, const void* vbase, size_t rowbase, int jlo, int jhi, int pos0, int h, const bf16x8 (&qf)[4], int tq, float& m, float& l, f32x16 (&o)[2], LAS unsigned char* wl, int lane) {
    const int r = lane & 31, hh = lane >> 5;
    bf16x8 kA[4], kB[4]; u32x4 vA[4], vB[4];
    const int tqmin = tq - r;
#define CB_LD(KF, VN, jj) do { ld_k<F32>(KF, kbase, (rowbase + 32 * (jj) + r) * HW + h * 64 + 32 * hh); ld_v<F32>(VN, vbase, rowbase + 32 * (jj), 32, h, lane); } while (0)
    CB_LD(kA, vA, jlo); if (jlo + 1 <= jhi) CB_LD(kB, vB, jlo + 1);
    for (int j = jlo; j <= jhi; j += 2) {
        { const f32x16 S = qk_block(kA, qf); st_v(wl + AW_V, vA, lane); if (j + 2 <= jhi) CB_LD(kA, vA, j + 2);
          const bool cbias = __builtin_amdgcn_readfirstlane(pos0 + 32 * j + 31 + 128 <= tqmin);
          cb_block(S, cbias, wl + AW_V, (const LAS float*)(wl + AW_BIAS), tq, pos0 + 32 * j, 32, m, l, o, lane); }
        if (j + 1 > jhi) break;
        { const f32x16 S = qk_block(kB, qf); st_v(wl + AW_V, vB, lane); if (j + 3 <= jhi) CB_LD(kB, vB, j + 3);
          const bool cbias = __builtin_amdgcn_readfirstlane(pos0 + 32 * (j + 1) + 31 + 128 <= tqmin);
          cb_block(S, cbias, wl + AW_V, (const LAS float*)(wl + AW_BIAS), tq, pos0 + 32 * (j + 1), 32, m, l, o, lane); }
    }
#undef CB_LD
}
template <bool SAMPLE> __device__ __forceinline__ void cb_unit(const AttnArgs& A, int b, int h, int qb, LAS unsigned char* wl, int lane) {
    const int r = lane & 31, hh = lane >> 5;
    const bf16_t* Qb = QKV_ + (size_t)3 * MT * HW; const bf16_t* Kb = Qb + (size_t)1 * MT * HW; const bf16_t* Vb = Qb + (size_t)2 * MT * HW;
    LAS float* bl = (LAS float*)(wl + AW_BIAS);
    { const float* relp = ARG(10) + (size_t)A.L * 257 * 8 + h; float bv[5];
#pragma unroll
      for (int i = 0; i < 5; ++i) { const int idx = lane + 64 * i; bv[i] = relp[(idx < 257 ? idx : 256) * 8]; }
#pragma unroll
      for (int i = 0; i < 5; ++i) { const int idx = lane + 64 * i; if (idx < 257) bl[idx] = bv[i] * LOG2E; } }
    int tq; size_t qrow;
    if (SAMPLE) { tq = PAST + (r & 15); qrow = (size_t)MP + b * DSEQ + (r & 15); } else { tq = 32 * qb + r; qrow = (size_t)b * SEQ + tq; }
    bf16x8 qf[4]; ld_k<false>(qf, Qb, qrow * HW + h * 64 + 32 * hh);
    float m = -INFINITY, l = 0.f; f32x16 o[2]; o[0] = f32x16{}; o[1] = f32x16{};
    if (SAMPLE) {
        cb_loop<true>(ARG(6) + (size_t)A.L * NBATCH * BANDL * HW, ARG(7) + (size_t)A.L * NBATCH * BANDL * HW, (size_t)b * BANDL, 0, BANDL / 32 - 1, PAST - BANDL, h, qf, tq, m, l, o, wl, lane);
        bf16x8 kf[4]; u32x4 vr[4]; const size_t row0 = (size_t)MP + b * DSEQ;
        ld_k<false>(kf, Kb, (row0 + (r & 15)) * HW + h * 64 + 32 * hh); ld_v<false>(vr, Vb, row0, DSEQ, h, lane); st_v(wl + AW_V, vr, lane);
        { const f32x16 S = qk_block(kf, qf); cb_block(S, false, wl + AW_V, bl, tq, PAST, DSEQ, m, l, o, lane); }
        l += partner32(l);
        attn_store(o, 1.0f / l, ARG(12) + A.L * HW + h * 64, MIX_, row0, HW + h * 64, DSEQ, wl, lane);
    } else {
        const int c = qb >> 1, clo = c - 8 < 0 ? 0 : c - 8;
        cb_loop<false>(Kb, Vb, (size_t)b * SEQ, 2 * clo, 2 * c + 1, 0, h, qf, tq, m, l, o, wl, lane);
        l += partner32(l);
        attn_store(o, 1.0f / l, ARG(12) + A.L * HW + h * 64, MIX_, (size_t)b * SEQ + 32 * qb, HW + h * 64, 32, wl, lane);
    }
}
__device__ __forceinline__ void sb_unit_p64(const AttnArgs& A, int b, int h, int m, LAS unsigned char* wl, int lane) {
    const int r = lane & 31, hh = lane >> 5;
    const bf16_t* Qa = QKV_; const bf16_t* Ka = Qa + (size_t)1 * MT * HW; const bf16_t* Va = Qa + (size_t)2 * MT * HW;
    const size_t rowbase = (size_t)b * SEQ;
    const int tq0 = 64 * m + r, tq1 = tq0 + 32;
    bf16x8 qf0[4];
    LAS unsigned char* q1p = wl + AW_ST + lane * 64;
    { bf16x8 qf1[4]; ld_k<false>(qf1, Qa, (rowbase + tq1) * HW + h * 64 + 32 * hh);
#pragma unroll
      for (int kk = 0; kk < 4; ++kk) *(LAS bf16x8*)(q1p + kk * 16) = qf1[kk]; }
    ld_k<false>(qf0, Qa, (rowbase + tq0) * HW + h * 64 + 32 * hh);
    float c0 = 1.f, c1 = 1.f; f32x16 o0[2], o1[2]; o0[0] = f32x16{}; o0[1] = f32x16{}; o1[0] = f32x16{}; o1[1] = f32x16{};
    bf16x8 kf[4]; u32x4 vn[4];
    int j = 2 * m + 1;
    ld_k<false>(kf, Ka, (rowbase + 32 * j + r) * HW + h * 64 + 32 * hh); ld_v<false>(vn, Va, rowbase + 32 * j, 32, h, lane);
    bool live0 = true, live1 = true;
    for (; j >= 0; --j) {
        const bool act0 = live0 && (j <= 2 * m);
        st_v(wl + AW_V, vn, lane);
        if (j > 0) ld_v<false>(vn, Va, rowbase + 32 * (j - 1), 32, h, lane);
        if (live1) { bf16x8 qf1[4];
#pragma unroll
            for (int kk = 0; kk < 4; ++kk) qf1[kk] = *(const LAS bf16x8*)(q1p + kk * 16);
            const f32x16 S1 = qk_block(kf, qf1); sb_block(S1, wl + AW_V, tq1, 32 * j, c1, o1, lane); if (__all(c1 < SB_THR)) live1 = false; }
        if (act0) { const f32x16 S0 = qk_block(kf, qf0);
            if (j > 0) ld_k<false>(kf, Ka, (rowbase + 32 * (j - 1) + r) * HW + h * 64 + 32 * hh);
            sb_block(S0, wl + AW_V, tq0, 32 * j, c0, o0, lane); if (__all(c0 < SB_THR)) live0 = false; }
        else if (j > 0) ld_k<false>(kf, Ka, (rowbase + 32 * (j - 1) + r) * HW + h * 64 + 32 * hh);
        if (!live0 && !live1) break;
    }
    attn_store(o0, 1.f, ARG(11) + A.L * HW + h * 64, MIX_, rowbase + 64 * m, h * 64, 32, wl, lane);
    attn_store(o1, 1.f, ARG(11) + A.L * HW + h * 64, MIX_, rowbase + 64 * m + 32, h * 64, 32, wl, lane);
}
__device__ __forceinline__ void cb_unit_p64(const AttnArgs& A, int b, int h, int c, LAS unsigned char* wl, int lane) {
    const int r = lane & 31, hh = lane >> 5;
    const bf16_t* Qb = QKV_ + (size_t)3 * MT * HW; const bf16_t* Kb = Qb + (size_t)1 * MT * HW; const bf16_t* Vb = Qb + (size_t)2 * MT * HW;
    LAS float* bl = (LAS float*)(wl + AW_BIAS);
    { const float* relp = ARG(10) + (size_t)A.L * 257 * 8 + h; float bv[5];
#pragma unroll
      for (int i = 0; i < 5; ++i) { const int idx = lane + 64 * i; bv[i] = relp[(idx < 257 ? idx : 256) * 8]; }
#pragma unroll
      for (int i = 0; i < 5; ++i) { const int idx = lane + 64 * i; if (idx < 257) bl[idx] = bv[i] * LOG2E; } }
    const int tq0 = 64 * c + r, tq1 = tq0 + 32; const size_t rowbase = (size_t)b * SEQ;
    bf16x8 qf0[4], qf1[4];
    ld_k<false>(qf0, Qb, (rowbase + tq0) * HW + h * 64 + 32 * hh); ld_k<false>(qf1, Qb, (rowbase + tq1) * HW + h * 64 + 32 * hh);
    float m0 = -INFINITY, l0 = 0.f, m1 = -INFINITY, l1 = 0.f;
    f32x16 o0[2], o1[2]; o0[0] = f32x16{}; o0[1] = f32x16{}; o1[0] = f32x16{}; o1[1] = f32x16{};
    const int clo = c - 8 < 0 ? 0 : c - 8, jlo = 2 * clo, jhi = 2 * c + 1;
    bf16x8 kf[4]; u32x4 vn[4];
    ld_k<false>(kf, Kb, (rowbase + 32 * jlo + r) * HW + h * 64 + 32 * hh); ld_v<false>(vn, Vb, rowbase + 32 * jlo, 32, h, lane);
    for (int j = jlo; j <= jhi; ++j) {
        const f32x16 S0 = qk_block(kf, qf0), S1 = qk_block(kf, qf1);
        st_v(wl + AW_V, vn, lane);
        if (j < jhi) { ld_k<false>(kf, Kb, (rowbase + 32 * (j + 1) + r) * HW + h * 64 + 32 * hh); ld_v<false>(vn, Vb, rowbase + 32 * (j + 1), 32, h, lane); }
        const bool cbias = (32 * j + 31 + 128 <= 64 * c);
        cb_block(S0, cbias, wl + AW_V, bl, tq0, 32 * j, 32, m0, l0, o0, lane);
        cb_block(S1, cbias, wl + AW_V, bl, tq1, 32 * j, 32, m1, l1, o1, lane);
    }
    l0 += partner32(l0); l1 += partner32(l1);
    attn_store(o0, 1.0f / l0, ARG(12) + A.L * HW + h * 64, MIX_, rowbase + 64 * c, HW + h * 64, 32, wl, lane);
    attn_store(o1, 1.0f / l1, ARG(12) + A.L * HW + h * 64, MIX_, rowbase + 64 * c + 32, HW + h * 64, 32, wl, lane);
}
constexpr int AU_ITEMS = 2048;
__device__ __forceinline__ void attn_phase(const AttnArgs& A, LAS unsigned char* lds) {
    const int tid_ = fresh_tid(), lane = tid_ & 63, wave = __builtin_amdgcn_readfirstlane(tid_ >> 6);
    LAS unsigned char* wl = lds + wave * AW_BYTES;
#pragma unroll 1
    for (int cu = (int)blockIdx.x * NWAVES + wave; cu < AU_ITEMS; cu += (int)gridDim.x * NWAVES) {
        const int blk = cu >> 3, kk_ = (blk >> 3) * 8 + (cu & 7);
        const int bh = (blk & 7) * 8 + (kk_ >> 5), p = kk_ & 31;
        cb_unit_p64(A, bh >> 3, bh & 7, 31 - p, wl, lane);
        sb_unit_p64(A, bh >> 3, bh & 7, 31 - p, wl, lane);
        if (p >= 30) { const int li = bh * 2 + (p - 30); if (li < 64) cb_unit<true>(A, li >> 3, li & 7, 0, wl, lane); }
        else if (p >= 28) { const int li = bh * 2 + (p - 28); if (li < 64) sb_unit<true>(A, li >> 3, li & 7, 0, wl, lane); }
    }
}
typedef unsigned gu32_plain;
#define XB_TMO      128
#define XB_XCNT(j)  (256  + 64 * (j))
#define XB_XSUB(j)  (1280 + 64 * (j))
#define XB_XGEN(j)  (2304 + 64 * (j))
#define XB_TOP      3328
#define XB_TOPGEN   3392
#define XCD_BAR_WORDS 3456
#define XB_SPIN_CAP (1u << 18)

__device__ __forceinline__ unsigned xb_ld(unsigned* p)              { return __hip_atomic_load(p, __ATOMIC_RELAXED, __HIP_MEMORY_SCOPE_AGENT); }
__device__ __forceinline__ unsigned xb_add(unsigned* p, unsigned v) { return __hip_atomic_fetch_add(p, v, __ATOMIC_RELAXED, __HIP_MEMORY_SCOPE_AGENT); }
__device__ __forceinline__ unsigned xb_xcc_id() { return (unsigned)__builtin_amdgcn_s_getreg((3 << 11) | 20) & 0xFu; }
#define XB_SPIN(cond, bar) do { unsigned _sp = 0; while (cond) { __builtin_amdgcn_s_sleep(1); \
    if ((++_sp & 255u) == 0u) { if (xb_ld(&(bar)[XB_TMO])) break; if (_sp > XB_SPIN_CAP) { atomicAdd(&(bar)[XB_TMO], 1u); break; } } } } while (0)

struct XcdBarrier {
    unsigned* bar; unsigned x;
    volatile LAS unsigned* st;
};

__device__ __forceinline__ XcdBarrier xcd_barrier_post(unsigned* bar, volatile LAS unsigned* st) {
    XcdBarrier b; b.bar = bar; b.x = xb_xcc_id(); b.st = st;
    if (threadIdx.x == 0) (void)xb_add(&bar[XB_XCNT(b.x)], 1u);
    return b;
}
__device__ __forceinline__ void xcd_barrier_complete(unsigned* bar, unsigned x, unsigned& nloc, unsigned& nx) {
    const unsigned G = gridDim.x * gridDim.y * gridDim.z;
    unsigned sum, cnt, mine, sp = 0u;
    for (;;) {
        sum = 0u; cnt = 0u; mine = 0u;
#pragma unroll
        for (unsigned j = 0; j < 16; ++j) { const unsigned c = xb_ld(&bar[XB_XCNT(j)]); sum += c; cnt += (c > 0u) ? 1u : 0u; mine = (j == x) ? c : mine; }
        if (sum == G) break;
        __builtin_amdgcn_s_sleep(1);
        if ((++sp & 255u) == 0u) { if (xb_ld(&bar[XB_TMO])) break; if (sp > XB_SPIN_CAP) { atomicAdd(&bar[XB_TMO], 1u); break; } }
    }
    nloc = mine > 0u ? mine : 1u; nx = cnt > 0u ? cnt : 1u;
}

__device__ __forceinline__ void xcd_barrier(const XcdBarrier& b) {
    asm volatile("s_waitcnt vmcnt(0)" ::: "memory");
    __syncthreads();
    if (threadIdx.x == 0) {
        unsigned* bar = b.bar;
        __builtin_amdgcn_s_waitcnt(0);
        unsigned nloc = b.st[0], nx = b.st[1];
        if (nloc == 0u) { xcd_barrier_complete(bar, b.x, nloc, nx); b.st[0] = nloc; b.st[1] = nx; }
        const unsigned old = xb_add(&bar[XB_XSUB(b.x)], 1u);
        const unsigned gen = old / nloc;
        if (old + 1u == (gen + 1u) * nloc) {
            __builtin_amdgcn_fence(__ATOMIC_RELEASE, "agent");
            asm volatile("s_waitcnt vmcnt(0)" ::: "memory");
            const unsigned og = xb_add(&bar[XB_TOP], 1u);
            const unsigned tg = og / nx;
            if (og + 1u == (tg + 1u) * nx) xb_add(&bar[XB_TOPGEN], 1u);
            else XB_SPIN(xb_ld(&bar[XB_TOPGEN]) == tg, bar);
            __builtin_amdgcn_fence(__ATOMIC_ACQUIRE, "agent");
            xb_add(&bar[XB_XGEN(b.x)], 1u);
            asm volatile("s_waitcnt vmcnt(0)" ::: "memory");
        } else {
            XB_SPIN(xb_ld(&bar[XB_XGEN(b.x)]) == gen, bar);
            __builtin_amdgcn_fence(__ATOMIC_ACQUIRE, "agent");
            asm volatile("s_waitcnt vmcnt(0)" ::: "memory");
        }
    }
    __syncthreads();
}

constexpr int CI_IN = 16 * 96, CI_OUT = 16 * 32, CI_G = 16 * 88, CI_D = 44 * 32, CI_PG = 16 * 32, CI_PP = 4 * 32, CI_L = CI_IN + CI_OUT + 2 * CI_G + CI_D + CI_PG + CI_PP;
struct ConvD { const float* W; const float* gain; bf16_t* WT; int K, N, kind, k0, n0; };
__device__ __forceinline__ ConvD conv_decode(int it) {
    const int L = it / CI_L; int r = it % CI_L; ConvD d;
    if (r < CI_IN) { d.W = ARG(9) + (size_t)L * DM * NQKV; d.gain = ARG(8) + L * DM; d.WT = (bf16_t*)WPTR(L, W_IN); d.K = DM; d.N = NQKV; d.kind = 0; }
    else if ((r -= CI_IN) < CI_OUT) { d.W = ARG(13) + (size_t)L * DM * DM; d.gain = nullptr; d.WT = (bf16_t*)WPTR(L, W_OUT); d.K = DM; d.N = DM; d.kind = 0; }
    else if ((r -= CI_OUT) < CI_G) { d.W = ARG(15) + (size_t)L * DM * DFF; d.gain = ARG(14) + L * DM; d.WT = (bf16_t*)WPTR(L, W_GU); d.K = DM; d.N = DFF; d.kind = 1; }
    else if ((r -= CI_G) < CI_G) { d.W = ARG(16) + (size_t)L * DM * DFF; d.gain = ARG(14) + L * DM; d.WT = (bf16_t*)WPTR(L, W_GU); d.K = DM; d.N = DFF; d.kind = 2; }
    else if ((r -= CI_G) < CI_D) { d.W = ARG(17) + (size_t)L * DFF * DM; d.gain = nullptr; d.WT = (bf16_t*)WPTR(L, W_DOWN); d.K = DFF; d.N = DM; d.kind = 0; }
    else if ((r -= CI_D) < CI_PG) { d.W = ARG(19) + (size_t)L * DM * DM; d.gain = ARG(18) + L * DM; d.WT = (bf16_t*)WPTR(L, W_PG); d.K = DM; d.N = DM; d.kind = 0; }
    else { r -= CI_PG; d.W = ARG(20) + (size_t)L * PLED * DM; d.gain = nullptr; d.WT = (bf16_t*)WPTR(L, W_PP); d.K = PLED; d.N = DM; d.kind = 0; }
    const int nblk = d.N / 32; d.k0 = 64 * (r / nblk); d.n0 = 32 * (r % nblk);
    return d;
}
__device__ __forceinline__ void conv_load(const ConvD& d, float (&v)[32], f32x4 (&g)[2], int lane) {
    const float* p = d.W + (size_t)(d.k0 + (lane >> 5)) * d.N + d.n0 + (lane & 31);
#pragma unroll
    for (int i = 0; i < 32; ++i) v[i] = p[(size_t)(2 * i) * d.N];
    if (d.gain) { g[0] = *(const f32x4*)(d.gain + d.k0 + 8 * (lane & 7)); g[1] = *(const f32x4*)(d.gain + d.k0 + 8 * (lane & 7) + 4); }
    else { g[0] = (f32x4){1.f, 1.f, 1.f, 1.f}; g[1] = g[0]; }
}
__device__ __forceinline__ void conv_proc(const ConvD& d, const float (&v)[32], const f32x4 (&g)[2], LAS float* scr, int lane) {
#pragma unroll
    for (int i = 0; i < 32; ++i) scr[(2 * i + (lane >> 5)) * 33 + (lane & 31)] = v[i];
    asm volatile("s_waitcnt lgkmcnt(0)" ::: "memory");
    const int c = lane & 7;
#pragma unroll
    for (int j = 0; j < 4; ++j) { const int n = (lane >> 3) + 8 * j; const LAS float* s = scr + (8 * c) * 33 + n;
        u32x4 o; o.x = pk2(s[0 * 33] * g[0][0], s[1 * 33] * g[0][1]); o.y = pk2(s[2 * 33] * g[0][2], s[3 * 33] * g[0][3]);
        o.z = pk2(s[4 * 33] * g[1][0], s[5 * 33] * g[1][1]); o.w = pk2(s[6 * 33] * g[1][2], s[7 * 33] * g[1][3]);
        const int gn = d.n0 + n; const int drow = d.kind == 0 ? gn : ((gn >> 7) * 256 + (gn & 127) + (d.kind == 2 ? 128 : 0));
        *(u32x4*)(d.WT + (size_t)drow * d.K + d.k0 + 8 * c) = o; }
    asm volatile("s_waitcnt lgkmcnt(0)" ::: "memory");
}

#ifdef NO_SGEMM
#define SG(...)
#else
#define SG(...) __VA_ARGS__
#endif
#ifndef GP1
#define GP1(...) __VA_ARGS__
#endif
#ifndef GP2
#define GP2(...) __VA_ARGS__
#endif
#ifndef GP3
#define GP3(...) __VA_ARGS__
#endif
#ifndef GP4
#define GP4(...) __VA_ARGS__
#endif
#ifndef GP5
#define GP5(...) __VA_ARGS__
#endif
#ifndef GP6
#define GP6(...) __VA_ARGS__
#endif
#ifdef NO_SGEMM
#define SG(...)
#else
#define SG(...) __VA_ARGS__
#endif
#ifndef GP1
#define GP1(...) __VA_ARGS__
#endif
#ifndef GP2
#define GP2(...) __VA_ARGS__
#endif
#ifndef GP3
#define GP3(...) __VA_ARGS__
#endif
#ifndef GP4
#define GP4(...) __VA_ARGS__
#endif
#ifndef GP5
#define GP5(...) __VA_ARGS__
#endif
#ifndef GP6
#define GP6(...) __VA_ARGS__
#endif
struct Args { const float* in[22]; float* out; unsigned char* ws; };

#ifndef PROBE_SEL
#define PROBE_SEL -1
#endif
#if PROBE_SEL >= 0
#define TSTAMP(cat) do { if (blockIdx.x == 0 && fresh_tid() == 0) { const unsigned long long t_ = __builtin_amdgcn_s_memrealtime(); unsigned long long* tsb = WS_PTR(unsigned long long, WS_CTL + 4096); \
    tsb[16 + (cat)] += t_ - tsb[0]; tsb[0] = t_; } } while (0)
#else
#define TSTAMP(cat) do {} while (0)
#endif
__global__ void __launch_bounds__(NTHREADS, 2) hymba_fwd(Args args) {
    extern __shared__ __attribute__((aligned(16))) unsigned char lds_raw[];
    cg::grid_group grid = cg::this_grid();
    LAS unsigned char* lds = (LAS unsigned char*)lds_raw;
    const int G = gridDim.x;

    { const int tid0 = fresh_tid();
      if (blockIdx.x == 0) for (int i = tid0; i < XCD_BAR_WORDS; i += NTHREADS) WS_PTR(unsigned, WS_BAR)[i] = 0u;
      if (tid0 < 2) ((LAS unsigned*)(lds + 131072))[tid0] = 0u; }
    grid.sync();
    (void)xcd_barrier_post(WS_PTR(unsigned, WS_BAR), (volatile LAS unsigned*)(lds + 131072));
#define GSYNC() do { XcdBarrier xb_; xb_.bar = WS_PTR(unsigned, WS_BAR); xb_.x = xb_xcc_id(); xb_.st = (volatile LAS unsigned*)(lds + 131072); xcd_barrier(xb_); } while (0)
#if PROBE_SEL >= 0
    if (blockIdx.x == 0 && fresh_tid() == 0) { unsigned long long* tsb = WS_PTR(unsigned long long, WS_CTL + 4096); for (int i = 0; i < 48; ++i) tsb[i] = 0; tsb[0] = __builtin_amdgcn_s_memrealtime(); }
#endif
    {
        const int tid = fresh_tid(), lane = tid & 63, wave = __builtin_amdgcn_readfirstlane(tid >> 6);
        const int gw = blockIdx.x * NWAVES + wave, NGW = G * NWAVES;
        { float* ssb = SSB; for (int i = blockIdx.x * NTHREADS + tid; i < 6 * MT; i += G * NTHREADS) ssb[MT + i] = 0.f;
          if (blockIdx.x == 0 && tid < 16) WS_PTR(unsigned, WS_CTL)[tid] = 0u;
          }
        LAS float* scr = (LAS float*)(lds + wave * 8704);
        { constexpr int NIT = NLAYER * CI_L; int it = gw;
          float vA[32], vB[32]; f32x4 gA[2], gB[2]; ConvD dA, dB;
          if (it < NIT) { dA = conv_decode(it); conv_load(dA, vA, gA, lane); }
          while (it < NIT) {
            const int itn = it + NGW;
            if (itn < NIT) { dB = conv_decode(itn); conv_load(dB, vB, gB, lane); }
            conv_proc(dA, vA, gA, scr, lane);
            if (itn >= NIT) break;
            it = itn + NGW;
            if (it < NIT) { dA = conv_decode(it); conv_load(dA, vA, gA, lane); }
            conv_proc(dB, vB, gB, scr, lane);
          } }
        { const float* pp = ARG(2); const float* ps = ARG(3); bf16_t* PB = PB_;
          for (int it0 = 4 * gw; it0 < NLAYER * MT; it0 += 4 * NGW) {
            f32x4 v[4];
#pragma unroll
            for (int rr = 0; rr < 4; ++rr) { const int it = it0 + rr, L = it / MT, row = it % MT;
                const float* src = row < MP ? pp + ((size_t)L * MP + row) * PLED : ps + ((size_t)L * MS + (row - MP)) * PLED;
                v[rr] = *((const f32x4*)src + lane); }
#pragma unroll
            for (int rr = 0; rr < 4; ++rr) { u32x2 w; w.x = pk2(v[rr][0], v[rr][1]); w.y = pk2(v[rr][2], v[rr][3]); *((u32x2*)(PB + (size_t)(it0 + rr) * PLED) + lane) = w; }
          } }
        { const float* x_p = ARG(0); const float* x_s = ARG(1); bf16_t* XB = XN_; float* ssb = SSB;
          for (int row0 = 2 * gw; row0 < MT; row0 += 2 * NGW) {
            f32x4 v[2][4];
#pragma unroll
            for (int rr = 0; rr < 2; ++rr) { const int row = row0 + rr; const float* src = row < MP ? x_p + (size_t)row * DM : x_s + (size_t)(row - MP) * DM;
#pragma unroll
                for (int j = 0; j < 4; ++j) v[rr][j] = *((const f32x4*)src + lane + 64 * j); }
#pragma unroll
            for (int rr = 0; rr < 2; ++rr) { float s2 = 0.f;
#pragma unroll
                for (int j = 0; j < 4; ++j) { const f32x4 t = v[rr][j]; s2 += (t[0] * t[0] + t[1] * t[1]) + (t[2] * t[2] + t[3] * t[3]);
                    u32x2 w; w.x = pk2(t[0], t[1]); w.y = pk2(t[2], t[3]); *((u32x2*)(XB + (size_t)(row0 + rr) * DM) + lane + 64 * j) = w; }
                s2 = wave_sum(s2);
                if (lane == 0) ssb[row0 + rr] = s2; }
          } }
    }
    TSTAMP(0); GSYNC(); TSTAMP(8);

    for (int L = 0; L < NLAYER; ++L) {
#define SS_MIX (SSB + (size_t)(3 * L) * MT)
#define SS_FFN (SSB + (size_t)(3 * L + 1) * MT)
#define SS_PLE (SSB + (size_t)(3 * L + 2) * MT)
#define SS_NEXT (SSB + (size_t)(3 * L + 3) * MT)
        { EpiArgs q{}; q.ss_in = SS_MIX; q.o0 = QKV_;
          q.f_sbk = ARG_OUT + O_SBK_P + (size_t)L * MP * HW; q.f_sbv = ARG_OUT + O_SBV_P + (size_t)L * MP * HW;
          q.f_cbk = ARG_OUT + O_CBK_P + (size_t)L * NBATCH * BANDL * HW; q.f_cbv = ARG_OUT + O_CBV_P + (size_t)L * NBATCH * BANDL * HW;
          pg8::Gemm g{XN_, WPTR(L, W_IN), MP, NQKV, DM}; pg8::StaticOrder S; S.init(MP, NQKV, G, (int)blockIdx.x);
          Epi<EP_QKV> E{q};
          GP1(pg8::gemm_phase<Epi<EP_QKV>, pg8::StaticOrder, true, true>(lds, g, S, E);) TSTAMP(1); }
        { EpiArgs q{}; q.ss_in = SS_MIX; q.o0 = QKV_;
          q.s_sbk = ARG_OUT + O_SBK_S + (size_t)L * MS * HW; q.s_sbv = ARG_OUT + O_SBV_S + (size_t)L * MS * HW;
          q.s_cbk = ARG_OUT + O_CBK_S + (size_t)L * MS * HW; q.s_cbv = ARG_OUT + O_CBV_S + (size_t)L * MS * HW;
          SG(sgemm<EP_QKV, DM>(lds, XN_ + (size_t)MP * DM, WPTR(L, W_IN), NQKV / 64, q);) TSTAMP(7); }
        GSYNC(); TSTAMP(8);
        { AttnArgs A{}; A.L = L;
#ifndef NO_ATTN
          attn_phase(A, lds);
#endif
          TSTAMP(2); }
        GSYNC(); TSTAMP(2);
        { EpiArgs q{}; q.XB = XB_; q.xbase = XN_; q.ss_out = SS_FFN;
          pg8::Gemm g{MIX_, WPTR(L, W_OUT), MP, DM, DM}; pg8::StaticOrder S; S.init(MP, DM, G, (int)blockIdx.x);
          Epi<EP_RES> E{q};
          GP2(pg8::gemm_phase<Epi<EP_RES>, pg8::StaticOrder, true, true>(lds, g, S, E);) TSTAMP(3); }
        { EpiArgs q{}; q.XB = XB_; q.xbase = XN_; q.ss_out = SS_FFN;
          SG(sgemm<EP_RES, DM>(lds, MIX_ + (size_t)MP * DM, WPTR(L, W_OUT), DM / 32, q);) TSTAMP(7); }
        GSYNC(); TSTAMP(8);
        { EpiArgs q{}; q.ss_in = SS_FFN; q.o0 = HB_;
          pg8::Gemm g{XB_, WPTR(L, W_GU), MP, 2 * DFF, DM}; pg8::StaticOrder S; S.init(MP, 2 * DFF, G, (int)blockIdx.x);
          Epi<EP_GU> E{q};
          GP4(pg8::gemm_phase<Epi<EP_GU>, pg8::StaticOrder, true, true>(lds, g, S, E);) TSTAMP(4);
          SG(sgemm<EP_GU, DM>(lds, XB_ + (size_t)MP * DM, WPTR(L, W_GU), DFF / 32, q);) TSTAMP(7); }
        { EpiArgs q2{}; q2.o0 = PBUF_;
          int kp = PLED; asm volatile("" : "+s"(kp));
          const int Gh = G >> 1;
          if ((int)blockIdx.x >= Gh) {
            pg8::Gemm g2{PB_ + (size_t)L * MT * PLED, WPTR(L, W_PP), MP, DM, kp}; pg8::StaticOrder S; S.init(MP, DM, G - Gh, (int)blockIdx.x - Gh);
            Epi<EP_P> E2{q2};
            GP3(pg8::gemm_phase<Epi<EP_P>, pg8::StaticOrder, true, true>(lds, g2, S, E2);) TSTAMP(10);
          }
          SG(sgemm<EP_P, PLED>(lds, PB_ + ((size_t)L * MT + MP) * PLED, WPTR(L, W_PP), DM / 32, q2);) TSTAMP(7); }
        GSYNC(); TSTAMP(8);
        { EpiArgs q{}; q.XB = XB_; q.xbase = XB_; q.ss_out = SS_PLE;
          pg8::Gemm g{HB_, WPTR(L, W_DOWN), MP, DM, DFF}; pg8::StaticOrder S; S.init(MP, DM, G, (int)blockIdx.x);
          Epi<EP_RES> E{q};
          GP5(pg8::gemm_phase<Epi<EP_RES>, pg8::StaticOrder, true, true>(lds, g, S, E);) TSTAMP(5);
          SG(sgemm<EP_RES, DFF>(lds, HB_ + (size_t)MP * DFF, WPTR(L, W_DOWN), DM / 32, q);) TSTAMP(7); }
        GSYNC(); TSTAMP(8);
        { EpiArgs q{}; q.XB = XN_  ; q.P = PBUF_; q.xbase = XB_; q.ss_in = SS_PLE; q.ss_out = SS_NEXT;
          pg8::Gemm g{XB_, WPTR(L, W_PG), MP, DM, DM}; pg8::StaticOrder S; S.init(MP, DM, G, (int)blockIdx.x);
          Epi<EP_PLE> E{q};
          GP6(pg8::gemm_phase<Epi<EP_PLE>, pg8::StaticOrder, true, true>(lds, g, S, E);) TSTAMP(6);
          SG(sgemm<EP_PLE, DM>(lds, XB_ + (size_t)MP * DM, WPTR(L, W_PG), DM / 32, q);) TSTAMP(7); }
        GSYNC(); TSTAMP(8);
    }
    {
        const int tid = fresh_tid(), lane = tid & 63, wave = __builtin_amdgcn_readfirstlane(tid >> 6);
        const int gw = blockIdx.x * NWAVES + wave, NGW = G * NWAVES;
        const float* ssf = SSB + (size_t)(3 * NLAYER) * MT; const float* gf = ARG(21); const bf16_t* XN = XN_; float* out = ARG_OUT;
        for (int row0 = 2 * gw; row0 < MT; row0 += 2 * NGW) {
            u32x2 xv[2][4];
#pragma unroll
            for (int rr = 0; rr < 2; ++rr)
#pragma unroll
                for (int j = 0; j < 4; ++j) xv[rr][j] = *((const u32x2*)(XN + (size_t)(row0 + rr) * DM) + lane + 64 * j);
#pragma unroll
            for (int rr = 0; rr < 2; ++rr) { const int row = row0 + rr; const float rs = rstd_of(ssf[row]);
                float* dst = row < MP ? out + O_YP + (size_t)row * DM : out + O_YS + (size_t)(row - MP) * DM;
#pragma unroll
                for (int j = 0; j < 4; ++j) { const f32x4 gv = *((const f32x4*)gf + lane + 64 * j); const u32x2 w = xv[rr][j];
                    const f32x4 v = {bf_lo(w.x), bf_hi(w.x), bf_lo(w.y), bf_hi(w.y)};
                    __builtin_nontemporal_store(v * rs * gv, (f32x4*)dst + lane + 64 * j); } }
        }
    }
#if PROBE_SEL >= 0
    TSTAMP(11); grid.sync();
    if (blockIdx.x == 0 && fresh_tid() == 0) { const unsigned long long* tsb = WS_PTR(unsigned long long, WS_CTL + 4096); float* o = ARG_OUT + O_YS; unsigned long long tv = 0; if (PROBE_SEL == 20) tv = tsb[16+1] + tsb[16+3] + tsb[16+10] + tsb[16+4] + tsb[16+5] + tsb[16+6]; else if (PROBE_SEL == 21) tv = tsb[16+0] + tsb[16+11]; else if (PROBE_SEL < 16) tv = tsb[16 + PROBE_SEL]; o[0] += (float)tv * 2.5e-5f; }
#endif
}

extern "C" void kernel_launch(void* const* d_in, const int* in_sizes, int n_in, void* d_out, int out_size, void* d_ws, size_t ws_size, hipStream_t stream) {
    static int grid = 0;
    if (grid == 0) {
        int dev = 0, cus = 0, per_cu = 0;
        hipGetDevice(&dev);
        hipDeviceGetAttribute(&cus, hipDeviceAttributeMultiprocessorCount, dev);
        hipFuncSetAttribute((const void*)hymba_fwd, hipFuncAttributeMaxDynamicSharedMemorySize, LDS_BYTES);
        hipOccupancyMaxActiveBlocksPerMultiprocessor(&per_cu, (const void*)hymba_fwd, NTHREADS, LDS_BYTES);
        if (per_cu < 1) per_cu = 1;
        grid = cus * per_cu;
        if (n_in != 22 || ws_size < WS_END) { fprintf(stderr, "kernel_launch: unexpected n_in %d / ws_size %zu\n", n_in, ws_size); }
    }
    Args a{};
    for (int i = 0; i < 22; ++i) a.in[i] = (const float*)d_in[i];
    a.out = (float*)d_out; a.ws = (unsigned char*)d_ws;
    void* kargs[] = {&a};
    hipError_t e = hipLaunchCooperativeKernel((const void*)hymba_fwd, dim3(grid), dim3(NTHREADS), kargs, LDS_BYTES, stream);
    if (e != hipSuccess) fprintf(stderr, "cooperative launch failed: %s (grid %d)\n", hipGetErrorString(e), grid);
}
```

```cpp
#include <hip/hip_runtime.h>
#include <hip/hip_cooperative_groups.h>
#include <cstdio>
#include <cstdint>
namespace cg = cooperative_groups;
__device__ __forceinline__ int fresh_tid() { int t = threadIdx.x; asm volatile("" : "+v"(t)); return t; }
namespace pg8 {
#define PG8_LAS __attribute__((address_space(3)))
typedef unsigned short bf16_t;
typedef short bf16x8 __attribute__((ext_vector_type(8)));
typedef float f32x4 __attribute__((ext_vector_type(4)));
typedef unsigned u32x4 __attribute__((ext_vector_type(4)));
constexpr int BM = 256, BK = 64, HALF = 128, HTB = HALF * BK * 2  , STAGE_BYTES = 8 * HTB, NXCD = 8, WGM = 8;

__host__ __device__ __forceinline__ int lds_byte(int r, int c) { const int st = (r >> 4) * 2 + (c >> 5), rr = r & 15, cc = c & 31, ob = rr * 64 + cc * 2; return st * 1024 + (ob ^ (((ob >> 9) & 1) << 5)); }
__host__ __device__ __forceinline__ void stage_rc(int b, int& R, int& C) { const int st = b / 1024, sb = b % 1024, swz = sb ^ (((sb >> 9) & 1) << 5); R = (st >> 1) * 16 + swz / 64; C = (st & 1) * 32 + (swz % 64) / 2; }
__host__ __device__ __forceinline__ int perm32(int rho) { const int n = rho >> 4, i = rho & 15; return 8 * (i >> 2) + 4 * n + (i & 3); }

struct Unit { int pm, pn; };
struct Gemm { const bf16_t* A; const bf16_t* Bt; int M, N, K; };

struct StaticOrder {
    int nM, nN, nwg, G, c;
    __host__ __device__ void init(int M, int N, int G_, int c_) { nM = M / BM; nN = N / BM; nwg = nM * nN; G = G_; c = c_; }
    __host__ __device__ bool next(int i, Unit& u) const {
        const long L = (long)i * G + c; if (L >= nwg) return false;
        int wgid = (int)L; { const int q = nwg / NXCD, r = nwg % NXCD, xcd = wgid % NXCD, off = wgid / NXCD; wgid = (xcd < r ? xcd * (q + 1) : r * (q + 1) + (xcd - r) * q) + off; }
        const int nig = WGM * nN, gid = wgid / nig, fm = gid * WGM, gsz = (nM - fm) < WGM ? (nM - fm) : WGM;
        u.pm = fm + ((wgid % nig) % gsz); u.pn = (wgid % nig) / gsz; return true;
    }
    __device__ __forceinline__ void a_ready(const Unit&) const {}
    __device__ __forceinline__ void done(const Unit&) const {}
};

template <class Epi, class Sched, bool ALIGN_EPI = false, bool SP2 = false>
__device__ __forceinline__ void gemm_phase(PG8_LAS unsigned char* lds, const Gemm g, const Sched& S, const Epi& E) {
    const int tid = fresh_tid(), wid = __builtin_amdgcn_readfirstlane(tid >> 6), lane = tid & 63, wr = wid >> 2, wc = wid & 3, fr = lane & 15, fq = lane >> 4;
    const int K = g.K, nt = K / BK;
    unsigned voffA[2], voffB[2];
#pragma unroll
    for (int i = 0; i < 2; ++i) { int R, C; stage_rc(tid * 16 + i * 8192, R, C); const int Rb = Epi::PERM ? ((R & ~31) + perm32(R & 31)) : R;
        voffA[i] = (unsigned)(R * K + C) * 2u; voffB[i] = (unsigned)(Rb * K + C) * 2u; }
    const size_t kstep = (size_t)(BK * 2);
    const size_t hstep = (size_t)HALF * K * 2;
    const size_t tstep = 2 * hstep;
    const unsigned ldsw = (unsigned)wid * 1024u;
    const int aoff = lds_byte(wr * 64 + fr, fq * 8), boff = lds_byte(wc * 32 + fr, fq * 8);
#define PG8_SA(b, h) (((b) * 2 + (h)) * HTB)
#define PG8_SB(b, h) ((4 + (b) * 2 + (h)) * HTB)
#define PG8_STAGE(bufoff, gbase, voff) do { _Pragma("unroll") for (int _i = 0; _i < 2; ++_i) \
        __builtin_amdgcn_global_load_lds((const unsigned*)((const char*)(gbase) + (voff)[_i]), (PG8_LAS unsigned*)(lds + (bufoff) + ldsw + _i * 8192), 16, 0, 0); } while (0)
#define PG8_LDA(dst, b, h) do { _Pragma("unroll") for (int m = 0; m < 4; ++m) _Pragma("unroll") for (int k = 0; k < 2; ++k) dst[m][k] = *(const PG8_LAS bf16x8*)(lds + PG8_SA(b, h) + aoff + m * 2048 + k * 1024); } while (0)
#define PG8_LDB(dst, b, h) do { _Pragma("unroll") for (int n = 0; n < 2; ++n) _Pragma("unroll") for (int k = 0; k < 2; ++k) dst[n][k] = *(const PG8_LAS bf16x8*)(lds + PG8_SB(b, h) + boff + n * 2048 + k * 1024); } while (0)
#define PG8_MMA(ai, bj, At, Bt) do { __builtin_amdgcn_s_setprio(1); _Pragma("unroll") for (int m = 0; m < 4; ++m) _Pragma("unroll") for (int n = 0; n < 2; ++n) _Pragma("unroll") for (int k = 0; k < 2; ++k) \
        acc[ai][bj][m][n] = __builtin_amdgcn_mfma_f32_16x16x32_bf16(Bt[n][k], At[m][k], acc[ai][bj][m][n], 0, 0, 0); __builtin_amdgcn_s_setprio(0); } while (0)
#define PG8_WAIT_V(n) asm volatile("s_waitcnt vmcnt(" #n ")" ::: "memory")
#define PG8_WAIT_L(n) asm volatile("s_waitcnt lgkmcnt(" #n ")" ::: "memory")
#define PG8_BAR __builtin_amdgcn_s_barrier()
#define PG8_SCHED __builtin_amdgcn_sched_barrier(0)
    Unit cur, nxt; int ui = 0;
    if (!S.next(0, cur)) return;
    f32x4 acc[2][2][4][2];
#pragma unroll
    for (int a = 0; a < 2; ++a)
#pragma unroll
        for (int b = 0; b < 2; ++b)
#pragma unroll
            for (int m = 0; m < 4; ++m)
#pragma unroll
                for (int n = 0; n < 2; ++n) acc[a][b][m][n] = (f32x4){0.f, 0.f, 0.f, 0.f};
    bf16x8 At[4][2], B0[2][2], B1[2][2];
    const char* cA = (const char*)g.A + (size_t)cur.pm * tstep; const char* cB = (const char*)g.Bt + (size_t)cur.pn * tstep;
    S.a_ready(cur);
    if constexpr (SP2) {
        PG8_STAGE(PG8_SB(0, 0), cB, voffB); PG8_STAGE(PG8_SB(0, 1), cB + hstep, voffB); PG8_STAGE(PG8_SA(0, 0), cA, voffA); PG8_STAGE(PG8_SA(0, 1), cA + hstep, voffA);
        if (wr == 1) PG8_BAR;
        PG8_WAIT_V(2); PG8_BAR;
        PG8_STAGE(PG8_SB(1, 0), cB + kstep, voffB); PG8_STAGE(PG8_SA(1, 0), cA + kstep, voffA); PG8_STAGE(PG8_SB(1, 1), cB + hstep + kstep, voffB);
        PG8_WAIT_V(6); PG8_BAR;
    } else {
        PG8_STAGE(PG8_SB(0, 0), cB, voffB); PG8_STAGE(PG8_SA(0, 0), cA, voffA); PG8_STAGE(PG8_SB(0, 1), cB + hstep, voffB); PG8_STAGE(PG8_SA(0, 1), cA + hstep, voffA);
        if (wr == 1) PG8_BAR;
        PG8_WAIT_V(4); PG8_BAR;
        PG8_STAGE(PG8_SB(1, 0), cB + kstep, voffB); PG8_STAGE(PG8_SA(1, 0), cA + kstep, voffA); PG8_STAGE(PG8_SB(1, 1), cB + hstep + kstep, voffB);
        PG8_WAIT_V(6); PG8_BAR;
    }
    for (;;) {
        const bool has_next = S.next(ui + 1, nxt);
        const char* nA = has_next ? (const char*)g.A + (size_t)nxt.pm * tstep : cA; const char* nB = has_next ? (const char*)g.Bt + (size_t)nxt.pn * tstep : cB;
        for (int t = 0; t < nt; t += 2) {
            const bool last = (t == nt - 2);
            const char* a1 = cA + (size_t)(t + 1) * kstep;
            const char* a2 = last ? nA : cA + (size_t)(t + 2) * kstep; const char* b2 = last ? nB : cB + (size_t)(t + 2) * kstep;
            const char* a3 = a2 + kstep; const char* b3 = b2 + kstep;
            if (last && has_next) S.a_ready(nxt);
            if constexpr (SP2) {
            PG8_LDB(B0, 0, 0); PG8_LDB(B1, 0, 1); PG8_SCHED; PG8_LDA(At, 0, 0); PG8_STAGE(PG8_SA(1, 1), a1 + hstep, voffA);
            PG8_WAIT_V(8); PG8_WAIT_L(0); PG8_BAR; PG8_MMA(0, 0, At, B0); PG8_MMA(0, 1, At, B1); PG8_BAR; PG8_SCHED;
            PG8_LDA(At, 0, 1); PG8_STAGE(PG8_SB(0, 0), b2, voffB); PG8_STAGE(PG8_SB(0, 1), b2 + hstep, voffB); PG8_STAGE(PG8_SA(0, 0), a2, voffA);
            PG8_WAIT_V(8); PG8_WAIT_L(0); PG8_BAR; PG8_MMA(1, 0, At, B0); PG8_MMA(1, 1, At, B1); PG8_BAR; PG8_SCHED;
            PG8_LDB(B0, 1, 0); PG8_LDB(B1, 1, 1); PG8_SCHED; PG8_LDA(At, 1, 0); PG8_STAGE(PG8_SA(0, 1), a2 + hstep, voffA);
            PG8_WAIT_V(8); PG8_WAIT_L(0); PG8_BAR; PG8_MMA(0, 0, At, B0); PG8_MMA(0, 1, At, B1); PG8_BAR; PG8_SCHED;
            PG8_LDA(At, 1, 1); PG8_STAGE(PG8_SB(1, 0), b3, voffB); PG8_STAGE(PG8_SB(1, 1), b3 + hstep, voffB); PG8_STAGE(PG8_SA(1, 0), a3, voffA);
            PG8_WAIT_V(8); PG8_WAIT_L(0); PG8_BAR; PG8_MMA(1, 0, At, B0); PG8_MMA(1, 1, At, B1); PG8_BAR; PG8_SCHED;
            } else {
            PG8_LDB(B0, 0, 0); PG8_SCHED; PG8_LDA(At, 0, 0); PG8_STAGE(PG8_SA(1, 1), a1 + hstep, voffA);
            PG8_WAIT_L(8); PG8_BAR; PG8_WAIT_L(0); PG8_MMA(0, 0, At, B0); PG8_BAR; PG8_SCHED;
            PG8_LDB(B1, 0, 1); PG8_STAGE(PG8_SB(0, 0), b2, voffB);
            PG8_BAR; PG8_WAIT_L(0); PG8_MMA(0, 1, At, B1); PG8_BAR;
            PG8_LDA(At, 0, 1); PG8_STAGE(PG8_SA(0, 0), a2, voffA);
            PG8_BAR; PG8_WAIT_L(0); PG8_MMA(1, 0, At, B0); PG8_BAR; PG8_SCHED;
            PG8_STAGE(PG8_SB(0, 1), b2 + hstep, voffB);
            PG8_WAIT_V(6); PG8_BAR; PG8_MMA(1, 1, At, B1); PG8_BAR;
            PG8_LDB(B0, 1, 0); PG8_SCHED; PG8_LDA(At, 1, 0); PG8_STAGE(PG8_SA(0, 1), a2 + hstep, voffA);
            PG8_WAIT_L(8); PG8_BAR; PG8_WAIT_L(0); PG8_MMA(0, 0, At, B0); PG8_BAR; PG8_SCHED;
            PG8_LDB(B1, 1, 1); PG8_STAGE(PG8_SB(1, 0), b3, voffB);
            PG8_BAR; PG8_WAIT_L(0); PG8_MMA(0, 1, At, B1); PG8_BAR;
            PG8_LDA(At, 1, 1); PG8_STAGE(PG8_SA(1, 0), a3, voffA);
            PG8_BAR; PG8_WAIT_L(0); PG8_MMA(1, 0, At, B0); PG8_BAR; PG8_SCHED;
            PG8_STAGE(PG8_SB(1, 1), b3 + hstep, voffB);
            PG8_WAIT_V(6); PG8_BAR; PG8_MMA(1, 1, At, B1); PG8_BAR;
            }
        }
        if constexpr (ALIGN_EPI) { if (wr == 0) PG8_BAR; }
        if constexpr (!Epi::AFTER_DRAIN) { E(acc, cur, wr, wc, fr, fq); S.done(cur); }
        if (!has_next) break;
#pragma unroll
        for (int a = 0; a < 2; ++a)
#pragma unroll
            for (int b = 0; b < 2; ++b)
#pragma unroll
                for (int m = 0; m < 4; ++m)
#pragma unroll
                    for (int n = 0; n < 2; ++n) acc[a][b][m][n] = (f32x4){0.f, 0.f, 0.f, 0.f};
        cur = nxt; cA = nA; cB = nB; ++ui;
        if constexpr (ALIGN_EPI) { if (wr == 1) PG8_BAR; }
    }
    PG8_WAIT_V(0);
    if constexpr (!ALIGN_EPI) { if (wr == 0) PG8_BAR; }
    PG8_BAR;
    if constexpr (Epi::AFTER_DRAIN) { E.fused(acc, cur, wr, wc, fr, fq, lds, wid, lane); S.done(cur); }
#undef PG8_SA
#undef PG8_SB
#undef PG8_STAGE
#undef PG8_LDA
#undef PG8_LDB
#undef PG8_MMA
#undef PG8_WAIT_V
#undef PG8_WAIT_L
#undef PG8_BAR
#undef PG8_SCHED
}
}

#define LAS __attribute__((address_space(3)))
using pg8::bf16_t; using pg8::bf16x8; using pg8::f32x4; using pg8::u32x4;
typedef short s16x4 __attribute__((ext_vector_type(4)));
typedef float f32x16 __attribute__((ext_vector_type(16)));
typedef unsigned u32x2 __attribute__((ext_vector_type(2)));
typedef float f32x2_t __attribute__((ext_vector_type(2)));
typedef __bf16 bf16x2_t __attribute__((ext_vector_type(2)));

constexpr int DM = 1024, SEQ = 2048, NBATCH = 8, MP = NBATCH * SEQ, DSEQ = 16, MS = NBATCH * DSEQ, MT = MP + MS;
constexpr int DFF = 2816, NQKV = 3072, PLED = 256, NLAYER = 2, PAST = 2048, BANDL = 512, HW = 512;
constexpr float EPS = 1e-6f, LOG2E = 1.4426950408889634f, QSCALE = 0.125f * LOG2E;
#ifndef SB_EARLY
#define SB_EARLY 1
#endif
constexpr float SB_THR = 7.5e-37f;

constexpr size_t MiB = 1u << 20;
constexpr size_t WS_CTL = 0, WS_SS = 64 * 1024;
constexpr size_t WS_W = 2 * MiB, W_LSTRIDE = 28 * MiB, W_IN = 0, W_OUT = 6 * MiB, W_GU = 8 * MiB, W_DOWN = 19 * MiB, W_PG = 25 * MiB, W_PP = 27 * MiB;
constexpr size_t WS_PB = 58 * MiB, WS_X = 76 * MiB  , WS_XB = 142 * MiB, WS_QKV = 176 * MiB, WS_MIX = 274 * MiB, WS_P = 308 * MiB, WS_END = 342 * MiB;
constexpr int LDS_BYTES = 131072 + 1024;
constexpr size_t WS_BAR = 8192;
constexpr int NWAVES = 8, NTHREADS = 512;

constexpr size_t O_YP = 0, O_YS = (size_t)MP * DM, O_SBK_P = O_YS + (size_t)MS * DM, O_SBV_P = O_SBK_P + (size_t)NLAYER * MP * HW,
                 O_CBK_P = O_SBV_P + (size_t)NLAYER * MP * HW, O_CBV_P = O_CBK_P + (size_t)NLAYER * NBATCH * BANDL * HW,
                 O_SBK_S = O_CBV_P + (size_t)NLAYER * NBATCH * BANDL * HW, O_SBV_S = O_SBK_S + (size_t)NLAYER * MS * HW,
                 O_CBK_S = O_SBV_S + (size_t)NLAYER * MS * HW, O_CBV_S = O_CBK_S + (size_t)NLAYER * MS * HW;

__device__ __forceinline__ unsigned pk2(float lo, float hi) { f32x2_t v = {lo, hi}; bf16x2_t b = __builtin_convertvector(v, bf16x2_t); return __builtin_bit_cast(unsigned, b); }
__device__ __forceinline__ float bf_lo(unsigned w) { return __uint_as_float(w << 16); }
__device__ __forceinline__ float bf_hi(unsigned w) { return __uint_as_float(w & 0xffff0000u); }
__device__ __forceinline__ float partner32(float v) {
    auto rr = __builtin_amdgcn_permlane32_swap(__float_as_uint(v), __float_as_uint(v), false, false);
    return (threadIdx.x & 32) ? __uint_as_float(rr[0]) : __uint_as_float(rr[1]);
}
__device__ __forceinline__ float wave_sum(float v) {
#pragma unroll
    for (int o = 1; o < 64; o <<= 1) v += __shfl_xor(v, o);
    return v;
}
__device__ __forceinline__ float rstd_of(float ss) { return rsqrtf(ss * (1.0f / DM) + EPS); }

template <int I> __device__ __forceinline__ const float* argp() {
    unsigned long long v; const void* ka = (const void*)__builtin_amdgcn_kernarg_segment_ptr();
    asm volatile("s_load_dwordx2 %0, %1, %2\n\ts_waitcnt lgkmcnt(0)" : "=s"(v) : "s"(ka), "i"(I * 8) : "memory");
    return (const float*)(const __attribute__((address_space(1))) float*)v;
}
#define ARG(i) argp<i>()
#define ARG_OUT ((float*)argp<22>())
#define ARG_WS ((unsigned char*)argp<23>())
#define WS_PTR(T, off) ((T*)(ARG_WS + (off)))
#define SSB WS_PTR(float, WS_SS)
#define PB_ WS_PTR(bf16_t, WS_PB)
#define XN_ WS_PTR(bf16_t, WS_X)
#define XB_ WS_PTR(bf16_t, WS_XB)
#define QKV_ WS_PTR(bf16_t, WS_QKV)
#define HB_ WS_PTR(bf16_t, WS_QKV)
#define MIX_ WS_PTR(bf16_t, WS_MIX)
#define PBUF_ WS_PTR(bf16_t, WS_P)
#define WPTR(L, off) ((const bf16_t*)(ARG_WS + WS_W + (size_t)(L) * W_LSTRIDE + (off)))

enum { EP_QKV = 0, EP_RES = 1, EP_GU = 2, EP_P = 3, EP_PLE = 4 };
struct EpiArgs {
    const float* ss_in; float* ss_out;
    const bf16_t* xbase;
    bf16_t* XB; bf16_t* o0; const bf16_t* P;
    float *f_sbk, *f_sbv, *f_cbk, *f_cbv;
    float *s_sbk, *s_sbv, *s_cbk, *s_cbv;
};
template <int MODE> struct Epi {
    static constexpr bool PERM = false, AFTER_DRAIN = false;
    EpiArgs a;
    __device__ __forceinline__ void operator()(const f32x4 (&acc)[2][2][4][2], const pg8::Unit& u, int wr, int wc, int fr, int fq) const {
        if constexpr (MODE == EP_QKV) {
            const int part = u.pn >> 1, cb = (u.pn & 1) * 256 + wc * 32 + 4 * fq;
            bf16_t* ob = a.o0 + (size_t)part * ((size_t)MT * HW);
            float* fo = part == 1 ? a.f_sbk : part == 2 ? a.f_sbv : part == 4 ? a.f_cbk : part == 5 ? a.f_cbv : nullptr;
            const bool band = part >= 4; const float qs = (part == 0 || part == 3) ? QSCALE : 1.f;
#pragma unroll
            for (int ai = 0; ai < 2; ++ai)
#pragma unroll
                for (int m = 0; m < 4; ++m) {
                    const int row = u.pm * 256 + ai * 128 + wr * 64 + m * 16 + fr;
                    const float rs = rstd_of(a.ss_in[row]) * qs;
                    const int t = row & (SEQ - 1);
                    float* frow = nullptr;
                    if (fo) { if (!band) frow = fo + (size_t)row * HW; else if (t >= SEQ - BANDL) frow = fo + ((size_t)(row >> 11) * BANDL + (t - (SEQ - BANDL))) * HW; }
#pragma unroll
                    for (int bj = 0; bj < 2; ++bj)
#pragma unroll
                        for (int n = 0; n < 2; ++n) {
                            const int col = cb + bj * 128 + n * 16; const f32x4 v = acc[ai][bj][m][n] * rs;
                            u32x2 w; w.x = pk2(v[0], v[1]); w.y = pk2(v[2], v[3]);
                            *(u32x2*)(ob + (size_t)row * HW + col) = w;
                            if (frow) __builtin_nontemporal_store(v, (f32x4*)(frow + col));
                        }
                }
        } else if constexpr (MODE == EP_RES || MODE == EP_PLE) {
#pragma unroll
            for (int ai = 0; ai < 2; ++ai)
#pragma unroll
                for (int m = 0; m < 4; ++m) {
                    const int row = u.pm * 256 + ai * 128 + wr * 64 + m * 16 + fr;
                    float rs = 0.f; if constexpr (MODE == EP_PLE) rs = rstd_of(a.ss_in[row]) * (-LOG2E);
                    float s = 0.f;
#pragma unroll
                    for (int bj = 0; bj < 2; ++bj)
#pragma unroll
                        for (int n = 0; n < 2; ++n) {
                            const size_t off = (size_t)row * DM + u.pn * 256 + bj * 128 + wc * 32 + n * 16 + 4 * fq;
                            const u32x2 xw = *(const u32x2*)(a.xbase + off); f32x4 x = {bf_lo(xw.x), bf_hi(xw.x), bf_lo(xw.y), bf_hi(xw.y)}; const f32x4 c = acc[ai][bj][m][n];
                            if constexpr (MODE == EP_RES) x += c;
                            else { const u32x2 pw = *(const u32x2*)(a.P + off);
                                   x[0] += bf_lo(pw.x) * __builtin_amdgcn_rcpf(1.f + __builtin_amdgcn_exp2f(c[0] * rs));
                                   x[1] += bf_hi(pw.x) * __builtin_amdgcn_rcpf(1.f + __builtin_amdgcn_exp2f(c[1] * rs));
                                   x[2] += bf_lo(pw.y) * __builtin_amdgcn_rcpf(1.f + __builtin_amdgcn_exp2f(c[2] * rs));
                                   x[3] += bf_hi(pw.y) * __builtin_amdgcn_rcpf(1.f + __builtin_amdgcn_exp2f(c[3] * rs)); }
                            u32x2 w; w.x = pk2(x[0], x[1]); w.y = pk2(x[2], x[3]); *(u32x2*)(a.XB + off) = w;
                            s += (x[0] * x[0] + x[1] * x[1]) + (x[2] * x[2] + x[3] * x[3]);
                        }
                    s += __shfl_xor(s, 16); s += __shfl_xor(s, 32);
                    if (fq == 0) unsafeAtomicAdd(a.ss_out + row, s);
                }
        } else if constexpr (MODE == EP_GU) {
#pragma unroll
            for (int ai = 0; ai < 2; ++ai)
#pragma unroll
                for (int m = 0; m < 4; ++m) {
                    const int row = u.pm * 256 + ai * 128 + wr * 64 + m * 16 + fr;
                    const float rs = rstd_of(a.ss_in[row]);
#pragma unroll
                    for (int n = 0; n < 2; ++n) {
                        const int col = u.pn * 128 + wc * 32 + n * 16 + 4 * fq;
                        const f32x4 g = acc[ai][0][m][n] * rs, up = acc[ai][1][m][n] * rs; float h[4];
#pragma unroll
                        for (int e = 0; e < 4; ++e) h[e] = g[e] * up[e] * __builtin_amdgcn_rcpf(1.f + __builtin_amdgcn_exp2f(-LOG2E * g[e]));
                        u32x2 w; w.x = pk2(h[0], h[1]); w.y = pk2(h[2], h[3]);
                        *(u32x2*)(a.o0 + (size_t)row * DFF + col) = w;
                    }
                }
        } else {
#pragma unroll
            for (int ai = 0; ai < 2; ++ai)
#pragma unroll
                for (int m = 0; m < 4; ++m) {
                    const int row = u.pm * 256 + ai * 128 + wr * 64 + m * 16 + fr;
#pragma unroll
                    for (int bj = 0; bj < 2; ++bj)
#pragma unroll
                        for (int n = 0; n < 2; ++n) {
                            const size_t off = (size_t)row * DM + u.pn * 256 + bj * 128 + wc * 32 + n * 16 + 4 * fq; const f32x4 v = acc[ai][bj][m][n];
                            u32x2 w; w.x = pk2(v[0], v[1]); w.y = pk2(v[2], v[3]); *(u32x2*)(a.o0 + off) = w;
                        }
                }
        }
    }
};

template <int MODE, int K>
__device__ __forceinline__ void sgemm(LAS unsigned char* lds, const bf16_t* A, const bf16_t* Bt, int ncol32, const EpiArgs& a, int jfirst = -1, int jstride = 0) {
    const int tid = fresh_tid(), lane = tid & 63, wave = __builtin_amdgcn_readfirstlane(tid >> 6), r = lane & 31, hh = lane >> 5;
    LAS float* red = (LAS float*)lds;
    constexpr int K8 = K >> 3, NK = K8 / 16, UB = NK > 11 ? 11 : NK;
    static_assert(NK % UB == 0, "sgemm: K split");
    const int G = gridDim.x, nunits = 4 * ncol32;
    if (jfirst < 0) { jfirst = G - 1 - (int)blockIdx.x; jstride = G; }
    for (int j = jfirst; j < nunits; j += jstride) {
        const int rb = j & 3, c0 = (MODE == EP_QKV ? 64 : 32) * (j >> 2);
        const int brow0 = (MODE == EP_GU) ? ((c0 >> 7) * 256 + (c0 & 127)) : c0;
        const bf16_t* ap = A + (size_t)(32 * rb + r) * K + wave * K8 + 8 * hh;
        const bf16_t* bp = Bt + (size_t)(brow0 + r) * K + wave * K8 + 8 * hh;
        f32x16 acc0 = {}, acc1 = {};
#pragma unroll 1
        for (int kb = 0; kb < NK; kb += UB) {
            bf16x8 af[UB], bf[UB], bf2[(MODE == EP_GU || MODE == EP_QKV) ? UB : 1];
#pragma unroll
            for (int i = 0; i < UB; ++i) { af[i] = *(const bf16x8*)(ap + (kb + i) * 16); bf[i] = *(const bf16x8*)(bp + (kb + i) * 16);
                if constexpr (MODE == EP_GU) bf2[i] = *(const bf16x8*)(bp + (size_t)128 * K + (kb + i) * 16);
                if constexpr (MODE == EP_QKV) bf2[i] = *(const bf16x8*)(bp + (size_t)32 * K + (kb + i) * 16); }
#pragma unroll
            for (int i = 0; i < UB; ++i) { acc0 = __builtin_amdgcn_mfma_f32_32x32x16_bf16(af[i], bf[i], acc0, 0, 0, 0);
                if constexpr (MODE == EP_GU || MODE == EP_QKV) acc1 = __builtin_amdgcn_mfma_f32_32x32x16_bf16(af[i], bf2[i], acc1, 0, 0, 0); }
        }
#pragma unroll
        for (int i = 0; i < 16; ++i) { red[(wave * 16 + i) * 64 + lane] = acc0[i]; if constexpr (MODE == EP_GU || MODE == EP_QKV) red[8192 + (wave * 16 + i) * 64 + lane] = acc1[i]; }
        __syncthreads();
        const int col = c0 + r;
#pragma unroll
        for (int ii = 0; ii < 2; ++ii) {
            const int i = 2 * wave + ii;
            float v0 = 0.f, v1 = 0.f;
#pragma unroll
            for (int w = 0; w < 8; ++w) { v0 += red[(w * 16 + i) * 64 + lane]; if constexpr (MODE == EP_GU || MODE == EP_QKV) v1 += red[8192 + (w * 16 + i) * 64 + lane]; }
            const int rs_ = 32 * rb + (i & 3) + 8 * (i >> 2) + 4 * hh, row = MP + rs_;
            if constexpr (MODE == EP_QKV) {
                const int part = c0 >> 9, cc = col & 511;
                const float rs = rstd_of(a.ss_in[row]); const float va = v0 * rs, vb = v1 * rs;
                const float qs = (part == 0 || part == 3) ? QSCALE : 1.f;
                bf16_t* ob = a.o0 + (size_t)part * ((size_t)MT * HW) + (size_t)row * HW + cc;
                ob[0] = (bf16_t)(pk2(va * qs, 0.f) & 0xffffu); ob[32] = (bf16_t)(pk2(vb * qs, 0.f) & 0xffffu);
                float* fo = part == 1 ? a.s_sbk : part == 2 ? a.s_sbv : part == 4 ? a.s_cbk : part == 5 ? a.s_cbv : nullptr;
                if (fo) { fo[(size_t)rs_ * HW + cc] = va; fo[(size_t)rs_ * HW + cc + 32] = vb; }
            } else if constexpr (MODE == EP_RES || MODE == EP_PLE) {
                const size_t off = (size_t)row * DM + col;
                float x = __uint_as_float((unsigned)a.xbase[off] << 16);
                if constexpr (MODE == EP_RES) x += v0;
                else { const float pv = __uint_as_float((unsigned)a.P[off] << 16); x += pv * __builtin_amdgcn_rcpf(1.f + __builtin_amdgcn_exp2f(-LOG2E * v0 * rstd_of(a.ss_in[row]))); }
                a.XB[off] = (bf16_t)(pk2(x, 0.f) & 0xffffu);
                float s = x * x;
                s += __shfl_xor(s, 1); s += __shfl_xor(s, 2); s += __shfl_xor(s, 4); s += __shfl_xor(s, 8); s += __shfl_xor(s, 16);
                if (r == 0) unsafeAtomicAdd(a.ss_out + row, s);
            } else if constexpr (MODE == EP_GU) {
                const float rs = rstd_of(a.ss_in[row]); const float g = v0 * rs, up = v1 * rs;
                const float h = g * up * __builtin_amdgcn_rcpf(1.f + __builtin_amdgcn_exp2f(-LOG2E * g));
                a.o0[(size_t)row * DFF + col] = (bf16_t)(pk2(h, 0.f) & 0xffffu);
            } else {
                a.o0[(size_t)row * DM + col] = (bf16_t)(pk2(v0, 0.f) & 0xffffu);
            }
        }
        __syncthreads();
    }
}
struct AttnArgs { int L; };
constexpr int AW_V = 0, AW_ST = 4096, AW_BIAS = 8704, AW_BYTES = 10240, ST_PITCH = 144;

template <bool F32> __device__ __forceinline__ void ld_k(bf16x8 (&kf)[4], const void* base, size_t off) {
    if constexpr (!F32) { const bf16_t* p = (const bf16_t*)base + off;
#pragma unroll
        for (int kk = 0; kk < 4; ++kk) kf[kk] = *(const bf16x8*)(p + 8 * kk);
    } else { const float* p = (const float*)base + off;
#pragma unroll
        for (int kk = 0; kk < 4; ++kk) { const f32x4 x = *(const f32x4*)(p + 8 * kk), y = *(const f32x4*)(p + 8 * kk + 4);
            u32x4 w; w.x = pk2(x[0], x[1]); w.y = pk2(x[2], x[3]); w.z = pk2(y[0], y[1]); w.w = pk2(y[2], y[3]); kf[kk] = __builtin_bit_cast(bf16x8, w); }
    }
}
template <bool F32> __device__ __forceinline__ void ld_v(u32x4 (&vr)[4], const void* base, size_t row0, int nvalid, int h, int lane) {
#pragma unroll
    for (int i = 0; i < 4; ++i) { int key = 8 * i + (lane >> 3); key = key < nvalid ? key : nvalid - 1;
        const size_t off = (row0 + key) * HW + h * 64 + (lane & 7) * 8;
        if constexpr (!F32) vr[i] = *(const u32x4*)((const bf16_t*)base + off);
        else { const float* p = (const float*)base + off; const f32x4 x = *(const f32x4*)p, y = *(const f32x4*)(p + 4);
            u32x4 w; w.x = pk2(x[0], x[1]); w.y = pk2(x[2], x[3]); w.z = pk2(y[0], y[1]); w.w = pk2(y[2], y[3]); vr[i] = w; }
    }
}
__device__ __forceinline__ void st_v(LAS unsigned char* vl, const u32x4 (&vr)[4], int lane) {
#pragma unroll
    for (int i = 0; i < 4; ++i) { const int key = 8 * i + (lane >> 3); *(LAS u32x4*)(vl + key * 128 + (((lane & 7) * 16) ^ (((key >> 1) & 1) << 6))) = vr[i]; }
}
typedef short v4i16_t __attribute__((ext_vector_type(4)));
__device__ __forceinline__ s16x4 vtr(LAS unsigned char* p) { return __builtin_bit_cast(s16x4, __builtin_amdgcn_ds_read_tr16_b64_v4i16((LAS v4i16_t*)p)); }
__device__ __forceinline__ void pv_block(f32x16 (&o)[2], LAS unsigned char* vl, const bf16x8 (&pf)[2], int lane) {
    const int q = (lane & 15) >> 2, p = lane & 3, c16 = (lane >> 4) & 1, hh = lane >> 5;
    const int va0 = (4 * hh + q) * 128 + ((32 * c16 + 8 * p) ^ ((q >> 1) << 6));
#pragma unroll
    for (int db = 0; db < 2; ++db)
#pragma unroll
        for (int s = 0; s < 2; ++s) {
            const s16x4 lo = vtr(vl + (va0 ^ (db * 64)) + s * 2048), hi = vtr(vl + (va0 ^ (db * 64)) + s * 2048 + 1024);
            const bf16x8 vf = {lo[0], lo[1], lo[2], lo[3], hi[0], hi[1], hi[2], hi[3]};
            o[db] = __builtin_amdgcn_mfma_f32_32x32x16_bf16(vf, pf[s], o[db], 0, 0, 0);
        }
}
__device__ __forceinline__ f32x16 qk_block(const bf16x8 (&kf)[4], const bf16x8 (&qf)[4]) {
    f32x16 S = {};
#pragma unroll
    for (int kk = 0; kk < 4; ++kk) S = __builtin_amdgcn_mfma_f32_32x32x16_bf16(kf[kk], qf[kk], S, 0, 0, 0);
    return S;
}
__device__ __forceinline__ void sb_block(const f32x16& S, LAS unsigned char* vl, int tq, int keypos0, float& carry, f32x16 (&o)[2], int lane) {
    const int hh = lane >> 5;
    float kp_[16], be[16];
#pragma unroll
    for (int r = 0; r < 16; ++r) {
        const int kp = keypos0 + (r & 3) + 8 * (r >> 2) + 4 * hh; const bool valid = kp < tq;
        const float z = __builtin_amdgcn_fmed3f(S[r], -126.f, 100.f);
        const float t = __builtin_amdgcn_exp2f(z), k = __builtin_amdgcn_rcpf(1.f + t);
        kp_[r] = valid ? k : 1.f; be[r] = valid ? t * k : 0.f;
    }
    float T[4], Tp[4], U[4];
#pragma unroll
    for (int g = 0; g < 4; ++g) { T[g] = (kp_[4 * g] * kp_[4 * g + 1]) * (kp_[4 * g + 2] * kp_[4 * g + 3]); Tp[g] = partner32(T[g]); U[g] = T[g] * Tp[g]; }
    float R[4]; R[3] = 1.f; R[2] = U[3]; R[1] = U[3] * U[2]; R[0] = R[1] * U[1];
    const float tot = R[0] * U[0];
    float w[16];
#pragma unroll
    for (int g = 0; g < 4; ++g) {
        const float b3 = carry * R[g] * (hh == 0 ? Tp[g] : 1.f);
        const float b2 = b3 * kp_[4 * g + 3], b1 = b2 * kp_[4 * g + 2], b0 = b1 * kp_[4 * g + 1];
        w[4 * g + 3] = be[4 * g + 3] * b3; w[4 * g + 2] = be[4 * g + 2] * b2; w[4 * g + 1] = be[4 * g + 1] * b1; w[4 * g + 0] = be[4 * g + 0] * b0;
    }
    carry *= tot;
    bf16x8 pf[2];
#pragma unroll
    for (int s = 0; s < 2; ++s) { u32x4 pw; pw.x = pk2(w[8 * s], w[8 * s + 1]); pw.y = pk2(w[8 * s + 2], w[8 * s + 3]); pw.z = pk2(w[8 * s + 4], w[8 * s + 5]); pw.w = pk2(w[8 * s + 6], w[8 * s + 7]); pf[s] = __builtin_bit_cast(bf16x8, pw); }
    pv_block(o, vl, pf, lane);
}
__device__ __forceinline__ void cb_block(const f32x16& S, bool cbias, LAS unsigned char* vl, const LAS float* bl, int tq, int keypos0, int nvalid, float& m, float& l, f32x16 (&o)[2], int lane) {
    const int hh = lane >> 5;
    float s[16]; float bm = -INFINITY;
    if (cbias) {
        const float cb = bl[256];
#pragma unroll
        for (int r = 0; r < 16; ++r) { s[r] = S[r] + cb; bm = fmaxf(bm, s[r]); }
    } else {
#pragma unroll
        for (int r = 0; r < 16; ++r) {
            const int kr = (r & 3) + 8 * (r >> 2) + 4 * hh; int d = tq - (keypos0 + kr); d = d < -128 ? -128 : (d > 128 ? 128 : d);
            s[r] = (kr < nvalid) ? S[r] + bl[d + 128] : -INFINITY; bm = fmaxf(bm, s[r]);
        }
    }
    bm = fmaxf(bm, partner32(bm));
    if (__any(bm > m + 8.f)) {
        const float mn = fmaxf(m, bm), f = __builtin_amdgcn_exp2f(m - mn); m = mn; l *= f;
#pragma unroll
        for (int db = 0; db < 2; ++db)
#pragma unroll
            for (int r = 0; r < 16; ++r) o[db][r] *= f;
    }
    float w[16], ls = 0.f;
#pragma unroll
    for (int r = 0; r < 16; ++r) { w[r] = __builtin_amdgcn_exp2f(s[r] - m); ls += w[r]; }
    l += ls;
    bf16x8 pf[2];
#pragma unroll
    for (int s2 = 0; s2 < 2; ++s2) { u32x4 pw; pw.x = pk2(w[8 * s2], w[8 * s2 + 1]); pw.y = pk2(w[8 * s2 + 2], w[8 * s2 + 3]); pw.z = pk2(w[8 * s2 + 4], w[8 * s2 + 5]); pw.w = pk2(w[8 * s2 + 6], w[8 * s2 + 7]); pf[s2] = __builtin_bit_cast(bf16x8, pw); }
    pv_block(o, vl, pf, lane);
}
__device__ __forceinline__ void attn_store(f32x16 (&o)[2], float scale, const float* gain, bf16_t* mix, size_t row0, int col0, int nrows, LAS unsigned char* wl, int lane) {
    const int r = lane & 31, hh = lane >> 5;
    f32x4 gvs[2][4];
#pragma unroll
    for (int db = 0; db < 2; ++db)
#pragma unroll
        for (int g = 0; g < 4; ++g) gvs[db][g] = *(const f32x4*)(gain + 32 * db + 8 * g + 4 * hh);
    float ssq = 0.f;
#pragma unroll
    for (int db = 0; db < 2; ++db)
#pragma unroll
        for (int i = 0; i < 16; ++i) { o[db][i] *= scale; ssq += o[db][i] * o[db][i]; }
    ssq += partner32(ssq);
    const float rstd = rsqrtf(ssq * (1.0f / 64.0f) + EPS);
    LAS unsigned char* st = wl + AW_ST;
#pragma unroll
    for (int db = 0; db < 2; ++db)
#pragma unroll
        for (int g = 0; g < 4; ++g) { const int d0 = 32 * db + 8 * g + 4 * hh; const f32x4 gv = gvs[db][g];
            u32x2 w; w.x = pk2(o[db][4 * g] * rstd * gv[0], o[db][4 * g + 1] * rstd * gv[1]); w.y = pk2(o[db][4 * g + 2] * rstd * gv[2], o[db][4 * g + 3] * rstd * gv[3]);
            *(LAS u32x2*)(st + r * ST_PITCH + d0 * 2) = w; }
#pragma unroll
    for (int i = 0; i < 4; ++i) { const int row = 8 * i + (lane >> 3), ch = lane & 7; const u32x4 v = *(const LAS u32x4*)(st + row * ST_PITCH + ch * 16);
        if (row < nrows) *(u32x4*)(mix + (row0 + row) * DM + col0 + ch * 8) = v; }
}

template <bool F32> __device__ __forceinline__ void sb_loop(const void* kbase, const void* vbase, size_t rowbase, int jhi, int h, const bf16x8 (&qf)[4], int tq, float& carry, f32x16 (&o)[2], LAS unsigned char* wl, int lane) {
    const int r = lane & 31, hh = lane >> 5;
    bf16x8 kA[4], kB[4]; u32x4 vA[4], vB[4];
#define SB_LD(KF, VN, jj) do { ld_k<F32>(KF, kbase, (rowbase + 32 * (jj) + r) * HW + h * 64 + 32 * hh); ld_v<F32>(VN, vbase, rowbase + 32 * (jj), 32, h, lane); } while (0)
    SB_LD(kA, vA, jhi); if (jhi >= 1) SB_LD(kB, vB, jhi - 1);
    for (int j = jhi; j >= 0; j -= 2) {
        { const f32x16 S = qk_block(kA, qf); st_v(wl + AW_V, vA, lane); if (j >= 2) SB_LD(kA, vA, j - 2);
          sb_block(S, wl + AW_V, tq, 32 * j, carry, o, lane); }
#if SB_EARLY
        if (__all(carry < SB_THR)) break;
#endif
        if (j < 1) break;
        { const f32x16 S = qk_block(kB, qf); st_v(wl + AW_V, vB, lane); if (j >= 3) SB_LD(kB, vB, j - 3);
          sb_block(S, wl + AW_V, tq, 32 * (j - 1), carry, o, lane); }
#if SB_EARLY
        if (__all(carry < SB_THR)) break;
#endif
    }
#undef SB_LD
}
template <bool SAMPLE> __device__ __forceinline__ void sb_unit(const AttnArgs& A, int b, int h, int qb, LAS unsigned char* wl, int lane) {
    const int r = lane & 31, hh = lane >> 5;
    const bf16_t* Qa = QKV_; const bf16_t* Ka = Qa + (size_t)1 * MT * HW; const bf16_t* Va = Qa + (size_t)2 * MT * HW;
    int tq; size_t qrow;
    if (SAMPLE) { tq = PAST + (r & 15); qrow = (size_t)MP + b * DSEQ + (r & 15); } else { tq = 32 * qb + r; qrow = (size_t)b * SEQ + tq; }
    bf16x8 qf[4]; ld_k<false>(qf, Qa, qrow * HW + h * 64 + 32 * hh);
    float carry = 1.f; f32x16 o[2]; o[0] = f32x16{}; o[1] = f32x16{};
    if (SAMPLE) {
        bf16x8 kf[4]; u32x4 vr[4]; const size_t row0 = (size_t)MP + b * DSEQ;
        ld_k<false>(kf, Ka, (row0 + (r & 15)) * HW + h * 64 + 32 * hh); ld_v<false>(vr, Va, row0, DSEQ, h, lane); st_v(wl + AW_V, vr, lane);
        { const f32x16 S = qk_block(kf, qf); sb_block(S, wl + AW_V, tq, PAST, carry, o, lane); }
        sb_loop<true>(ARG(4) + (size_t)A.L * NBATCH * PAST * HW, ARG(5) + (size_t)A.L * NBATCH * PAST * HW, (size_t)b * PAST, PAST / 32 - 1, h, qf, tq, carry, o, wl, lane);
        attn_store(o, 1.f, ARG(11) + A.L * HW + h * 64, MIX_, row0, h * 64, DSEQ, wl, lane);
    } else {
        sb_loop<false>(Ka, Va, (size_t)b * SEQ, qb, h, qf, tq, carry, o, wl, lane);
        attn_store(o, 1.f, ARG(11) + A.L * HW + h * 64, MIX_, (size_t)b * SEQ + 32 * qb, h * 64, 32, wl, lane);
    }
}
template <bool F32> __device__ __forceinline__ void cb_loop(const void* kbase, const void* vbase, size_t rowbase, int jlo, int jhi, int pos0, int h, const bf16x8 (&qf)[4], int tq, float& m, float& l, f32x16 (&o)[2], LAS unsigned char* wl, int lane) {
    const int r = lane & 31, hh = lane >> 5;
    bf16x8 kA[4], kB[4]; u32x4 vA[4], vB[4];
    const int tqmin = tq - r;
#define CB_LD(KF, VN, jj) do { ld_k<F32>(KF, kbase, (rowbase + 32 * (jj) + r) * HW + h * 64 + 32 * hh); ld_v<F32>(VN, vbase, rowbase + 32 * (jj), 32, h, lane); } while (0)
    CB_LD(kA, vA, jlo); if (jlo + 1 <= jhi) CB_LD(kB, vB, jlo + 1);
    for (int j = jlo; j <= jhi; j += 2) {
        { const f32x16 S = qk_block(kA, qf); st_v(wl + AW_V, vA, lane); if (j + 2 <= jhi) CB_LD(kA, vA, j + 2);
          const bool cbias = __builtin_amdgcn_readfirstlane(pos0 + 32 * j + 31 + 128 <= tqmin);
          cb_block(S, cbias, wl + AW_V, (const LAS float*)(wl + AW_BIAS), tq, pos0 + 32 * j, 32, m, l, o, lane); }
        if (j + 1 > jhi) break;
        { const f32x16 S = qk_block(kB, qf); st_v(wl + AW_V, vB, lane); if (j + 3 <= jhi) CB_LD(kB, vB, j + 3);
          const bool cbias = __builtin_amdgcn_readfirstlane(pos0 + 32 * (j + 1) + 31 + 128 <= tqmin);
          cb_block(S, cbias, wl + AW_V, (const LAS float*)(wl + AW_BIAS), tq, pos0 + 32 * (j + 1), 32, m, l, o, lane); }
    }
#undef CB_LD
}
template <bool SAMPLE> __device__ __forceinline__ void cb_unit(const AttnArgs& A, int b, int h, int qb, LAS unsigned char* wl, int lane) {
    const int r = lane & 31, hh = lane >> 5;
    const bf16_t* Qb = QKV_ + (size_t)3 * MT * HW; const bf16_t* Kb = Qb + (size_t)1 * MT * HW; const bf16_t* Vb = Qb + (size_t)2 * MT * HW;
    LAS float* bl = (LAS float*)(wl + AW_BIAS);
    { const float* relp = ARG(10) + (size_t)A.L * 257 * 8 + h; float bv[5];
#pragma unroll
      for (int i = 0; i < 5; ++i) { const int idx = lane + 64 * i; bv[i] = relp[(idx < 257 ? idx : 256) * 8]; }
#pragma unroll
      for (int i = 0; i < 5; ++i) { const int idx = lane + 64 * i; if (idx < 257) bl[idx] = bv[i] * LOG2E; } }
    int tq; size_t qrow;
    if (SAMPLE) { tq = PAST + (r & 15); qrow = (size_t)MP + b * DSEQ + (r & 15); } else { tq = 32 * qb + r; qrow = (size_t)b * SEQ + tq; }
    bf16x8 qf[4]; ld_k<false>(qf, Qb, qrow * HW + h * 64 + 32 * hh);
    float m = -INFINITY, l = 0.f; f32x16 o[2]; o[0] = f32x16{}; o[1] = f32x16{};
    if (SAMPLE) {
        cb_loop<true>(ARG(6) + (size_t)A.L * NBATCH * BANDL * HW, ARG(7) + (size_t)A.L * NBATCH * BANDL * HW, (size_t)b * BANDL, 0, BANDL / 32 - 1, PAST - BANDL, h, qf, tq, m, l, o, wl, lane);
        bf16x8 kf[4]; u32x4 vr[4]; const size_t row0 = (size_t)MP + b * DSEQ;
        ld_k<false>(kf, Kb, (row0 + (r & 15)) * HW + h * 64 + 32 * hh); ld_v<false>(vr, Vb, row0, DSEQ, h, lane); st_v(wl + AW_V, vr, lane);
        { const f32x16 S = qk_block(kf, qf); cb_block(S, false, wl + AW_V, bl, tq, PAST, DSEQ, m, l, o, lane); }
        l += partner32(l);
        attn_store(o, 1.0f / l, ARG(12) + A.L * HW + h * 64, MIX_, row0, HW + h * 64, DSEQ, wl, lane);
    } else {
        const int c = qb >> 1, clo = c - 8 < 0 ? 0 : c - 8;
        cb_loop<false>(Kb, Vb, (size_t)b * SEQ, 2 * clo, 2 * c + 1, 0, h, qf, tq, m, l, o, wl, lane);
        l += partner32(l);
        attn_store(o, 1.0f / l, ARG(12) + A.L * HW + h * 64, MIX_, (size_t)b * SEQ + 32 * qb, HW + h * 64, 32, wl, lane);
    }
}
__device__ __forceinline__ void sb_unit_p64(const AttnArgs& A, int b, int h, int m, LAS unsigned char* wl, int lane) {
    const int r = lane & 31, hh = lane >> 5;
    const bf16_t* Qa = QKV_; const bf16_t* Ka = Qa + (size_t)1 * MT * HW; const bf16_t* Va = Qa + (size_t)2 * MT * HW;
    const size_t rowbase = (size_t)b * SEQ;
    const int tq0 = 64 * m + r, tq1 = tq0 + 32;
    bf16x8 qf0[4];
    LAS unsigned char* q1p = wl + AW_ST + lane * 64;
    { bf16x8 qf1[4]; ld_k<false>(qf1, Qa, (rowbase + tq1) * HW + h * 64 + 32 * hh);
#pragma unroll
      for (int kk = 0; kk < 4; ++kk) *(LAS bf16x8*)(q1p + kk * 16) = qf1[kk]; }
    ld_k<false>(qf0, Qa, (rowbase + tq0) * HW + h * 64 + 32 * hh);
    float c0 = 1.f, c1 = 1.f; f32x16 o0[2], o1[2]; o0[0] = f32x16{}; o0[1] = f32x16{}; o1[0] = f32x16{}; o1[1] = f32x16{};
    bf16x8 kf[4]; u32x4 vn[4];
    int j = 2 * m + 1;
    ld_k<false>(kf, Ka, (rowbase + 32 * j + r) * HW + h * 64 + 32 * hh); ld_v<false>(vn, Va, rowbase + 32 * j, 32, h, lane);
    bool live0 = true, live1 = true;
    for (; j >= 0; --j) {
        const bool act0 = live0 && (j <= 2 * m);
        st_v(wl + AW_V, vn, lane);
        if (j > 0) ld_v<false>(vn, Va, rowbase + 32 * (j - 1), 32, h, lane);
        if (live1) { bf16x8 qf1[4];
#pragma unroll
            for (int kk = 0; kk < 4; ++kk) qf1[kk] = *(const LAS bf16x8*)(q1p + kk * 16);
            const f32x16 S1 = qk_block(kf, qf1); sb_block(S1, wl + AW_V, tq1, 32 * j, c1, o1, lane); if (__all(c1 < SB_THR)) live1 = false; }
        if (act0) { const f32x16 S0 = qk_block(kf, qf0);
            if (j > 0) ld_k<false>(kf, Ka, (rowbase + 32 * (j - 1) + r) * HW + h * 64 + 32 * hh);
            sb_block(S0, wl + AW_V, tq0, 32 * j, c0, o0, lane); if (__all(c0 < SB_THR)) live0 = false; }
        else if (j > 0) ld_k<false>(kf, Ka, (rowbase + 32 * (j - 1) + r) * HW + h * 64 + 32 * hh);
        if (!live0 && !live1) break;
    }
    attn_store(o0, 1.f, ARG(11) + A.L * HW + h * 64, MIX_, rowbase + 64 * m, h * 64, 32, wl, lane);
    attn_store(o1, 1.f, ARG(11) + A.L * HW + h * 64, MIX_, rowbase + 64 * m + 32, h * 64, 32, wl, lane);
}
__device__ __forceinline__ void cb_unit_p64(const AttnArgs& A, int b, int h, int c, LAS unsigned char* wl, int lane) {
    const int r = lane & 31, hh = lane >> 5;
    const bf16_t* Qb = QKV_ + (size_t)3 * MT * HW; const bf16_t* Kb = Qb + (size_t)1 * MT * HW; const bf16_t* Vb = Qb + (size_t)2 * MT * HW;
    LAS float* bl = (LAS float*)(wl + AW_BIAS);
    { const float* relp = ARG(10) + (size_t)A.L * 257 * 8 + h; float bv[5];
#pragma unroll
      for (int i = 0; i < 5; ++i) { const int idx = lane + 64 * i; bv[i] = relp[(idx < 257 ? idx : 256) * 8]; }
#pragma unroll
      for (int i = 0; i < 5; ++i) { const int idx = lane + 64 * i; if (idx < 257) bl[idx] = bv[i] * LOG2E; } }
    const int tq0 = 64 * c + r, tq1 = tq0 + 32; const size_t rowbase = (size_t)b * SEQ;
    bf16x8 qf0[4], qf1[4];
    ld_k<false>(qf0, Qb, (rowbase + tq0) * HW + h * 64 + 32 * hh); ld_k<false>(qf1, Qb, (rowbase + tq1) * HW + h * 64 + 32 * hh);
    float m0 = -INFINITY, l0 = 0.f, m1 = -INFINITY, l1 = 0.f;
    f32x16 o0[2], o1[2]; o0[0] = f32x16{}; o0[1] = f32x16{}; o1[0] = f32x16{}; o1[1] = f32x16{};
    const int clo = c - 8 < 0 ? 0 : c - 8, jlo = 2 * clo, jhi = 2 * c + 1;
    bf16x8 kf[4]; u32x4 vn[4];
    ld_k<false>(kf, Kb, (rowbase + 32 * jlo + r) * HW + h * 64 + 32 * hh); ld_v<false>(vn, Vb, rowbase + 32 * jlo, 32, h, lane);
    for (int j = jlo; j <= jhi; ++j) {
        const f32x16 S0 = qk_block(kf, qf0), S1 = qk_block(kf, qf1);
        st_v(wl + AW_V, vn, lane);
        if (j < jhi) { ld_k<false>(kf, Kb, (rowbase + 32 * (j + 1) + r) * HW + h * 64 + 32 * hh); ld_v<false>(vn, Vb, rowbase + 32 * (j + 1), 32, h, lane); }
        const bool cbias = (32 * j + 31 + 128 <= 64 * c);
        cb_block(S0, cbias, wl + AW_V, bl, tq0, 32 * j, 32, m0, l0, o0, lane);
        cb_block(S1, cbias, wl + AW_V, bl, tq1, 32 * j, 32, m1, l1, o1, lane);
    }
    l0 += partner32(l0); l1 += partner32(l1);
    attn_store(o0, 1.0f / l0, ARG(12) + A.L * HW + h * 64, MIX_, rowbase + 64 * c, HW + h * 64, 32, wl, lane);
    attn_store(o1, 1.0f / l1, ARG(12) + A.L * HW + h * 64, MIX_, rowbase + 64 * c + 32, HW + h * 64, 32, wl, lane);
}
constexpr int AU_ITEMS = 2048;
__device__ __forceinline__ void attn_phase(const AttnArgs& A, LAS unsigned char* lds) {
    const int tid_ = fresh_tid(), lane = tid_ & 63, wave = __builtin_amdgcn_readfirstlane(tid_ >> 6);
    LAS unsigned char* wl = lds + wave * AW_BYTES;
#pragma unroll 1
    for (int cu = (int)blockIdx.x * NWAVES + wave; cu < AU_ITEMS; cu += (int)gridDim.x * NWAVES) {
        const int blk = cu >> 3, kk_ = (blk >> 3) * 8 + (cu & 7);
        const int bh = (blk & 7) * 8 + (kk_ >> 5), p = kk_ & 31;
        cb_unit_p64(A, bh >> 3, bh & 7, 31 - p, wl, lane);
        sb_unit_p64(A, bh >> 3, bh & 7, 31 - p, wl, lane);
        if (p >= 30) { const int li = bh * 2 + (p - 30); if (li < 64) cb_unit<true>(A, li >> 3, li & 7, 0, wl, lane); }
        else if (p >= 28) { const int li = bh * 2 + (p - 28); if (li < 64) sb_unit<true>(A, li >> 3, li & 7, 0, wl, lane); }
    }
}
typedef unsigned gu32_plain;
#define XB_TMO      128
#define XB_XCNT(j)  (256  + 64 * (j))
#define XB_XSUB(j)  (1280 + 64 * (j))
#define XB_XGEN(j)  (2304 + 64 * (j))
#define XB_TOP      3328
#define XB_TOPGEN   3392
#define XCD_BAR_WORDS 3456
#define XB_SPIN_CAP (1u << 18)

__device__ __forceinline__ unsigned xb_ld(unsigned* p)              { return __hip_atomic_load(p, __ATOMIC_RELAXED, __HIP_MEMORY_SCOPE_AGENT); }
__device__ __forceinline__ unsigned xb_add(unsigned* p, unsigned v) { return __hip_atomic_fetch_add(p, v, __ATOMIC_RELAXED, __HIP_MEMORY_SCOPE_AGENT); }
__device__ __forceinline__ unsigned xb_xcc_id() { return (unsigned)__builtin_amdgcn_s_getreg((3 << 11) | 20) & 0xFu; }
#define XB_SPIN(cond, bar) do { unsigned _sp = 0; while (cond) { __builtin_amdgcn_s_sleep(1); \
    if ((++_sp & 255u) == 0u) { if (xb_ld(&(bar)[XB_TMO])) break; if (_sp > XB_SPIN_CAP) { atomicAdd(&(bar)[XB_TMO], 1u); break; } } } } while (0)

struct XcdBarrier {
    unsigned* bar; unsigned x;
    volatile LAS unsigned* st;
};

__device__ __forceinline__ XcdBarrier xcd_barrier_post(unsigned* bar, volatile LAS unsigned* st) {
    XcdBarrier b; b.bar = bar; b.x = xb_xcc_id(); b.st = st;
    if (threadIdx.x == 0) (void)xb_add(&bar[XB_XCNT(b.x)], 1u);
    return b;
}
__device__ __forceinline__ void xcd_barrier_complete(unsigned* bar, unsigned x, unsigned& nloc, unsigned& nx) {
    const unsigned G = gridDim.x * gridDim.y * gridDim.z;
    unsigned sum, cnt, mine, sp = 0u;
    for (;;) {
        sum = 0u; cnt = 0u; mine = 0u;
#pragma unroll
        for (unsigned j = 0; j < 16; ++j) { const unsigned c = xb_ld(&bar[XB_XCNT(j)]); sum += c; cnt += (c > 0u) ? 1u : 0u; mine = (j == x) ? c : mine; }
        if (sum == G) break;
        __builtin_amdgcn_s_sleep(1);
        if ((++sp & 255u) == 0u) { if (xb_ld(&bar[XB_TMO])) break; if (sp > XB_SPIN_CAP) { atomicAdd(&bar[XB_TMO], 1u); break; } }
    }
    nloc = mine > 0u ? mine : 1u; nx = cnt > 0u ? cnt : 1u;
}

__device__ __forceinline__ void xcd_barrier(const XcdBarrier& b) {
    asm volatile("s_waitcnt vmcnt(0)" ::: "memory");
    __syncthreads();
    if (threadIdx.x == 0) {
        unsigned* bar = b.bar;
        __builtin_amdgcn_s_waitcnt(0);
        unsigned nloc = b.st[0], nx = b.st[1];
        if (nloc == 0u) { xcd_barrier_complete(bar, b.x, nloc, nx); b.st[0] = nloc; b.st[1] = nx; }
        const unsigned old = xb_add(&bar[XB_XSUB(b.x)], 1u);
        const unsigned gen = old / nloc;
        if (old + 1u == (gen + 1u) * nloc) {
            __builtin_amdgcn_fence(__ATOMIC_RELEASE, "agent");
            asm volatile("s_waitcnt vmcnt(0)" ::: "memory");
            const unsigned og = xb_add(&bar[XB_TOP], 1u);
            const unsigned tg = og / nx;
            if (og + 1u == (tg + 1u) * nx) xb_add(&bar[XB_TOPGEN], 1u);
            else XB_SPIN(xb_ld(&bar[XB_TOPGEN]) == tg, bar);
            __builtin_amdgcn_fence(__ATOMIC_ACQUIRE, "agent");
            xb_add(&bar[XB_XGEN(b.x)], 1u);
            asm volatile("s_waitcnt vmcnt(0)" ::: "memory");
        } else {
            XB_SPIN(xb_ld(&bar[XB_XGEN(b.x)]) == gen, bar);
            __builtin_amdgcn_fence(__ATOMIC_ACQUIRE, "agent");
            asm volatile("s_waitcnt vmcnt(0)" ::: "memory");
        }
    }
    __syncthreads();
}

constexpr int CI_IN = 16 * 96, CI_OUT = 16 * 32, CI_G = 16 * 88, CI_D = 44 * 32, CI_PG = 16 * 32, CI_PP = 4 * 32, CI_L = CI_IN + CI_OUT + 2 * CI_G + CI_D + CI_PG + CI_PP;
struct ConvD { const float* W; const float* gain; bf16_t* WT; int K, N, kind, k0, n0; };
__device__ __forceinline__ ConvD conv_decode(int it) {
    const int L = it / CI_L; int r = it % CI_L; ConvD d;
    if (r < CI_IN) { d.W = ARG(9) + (size_t)L * DM * NQKV; d.gain = ARG(8) + L * DM; d.WT = (bf16_t*)WPTR(L, W_IN); d.K = DM; d.N = NQKV; d.kind = 0; }
    else if ((r -= CI_IN) < CI_OUT) { d.W = ARG(13) + (size_t)L * DM * DM; d.gain = nullptr; d.WT = (bf16_t*)WPTR(L, W_OUT); d.K = DM; d.N = DM; d.kind = 0; }
    else if ((r -= CI_OUT) < CI_G) { d.W = ARG(15) + (size_t)L * DM * DFF; d.gain = ARG(14) + L * DM; d.WT = (bf16_t*)WPTR(L, W_GU); d.K = DM; d.N = DFF; d.kind = 1; }
    else if ((r -= CI_G) < CI_G) { d.W = ARG(16) + (size_t)L * DM * DFF; d.gain = ARG(14) + L * DM; d.WT = (bf16_t*)WPTR(L, W_GU); d.K = DM; d.N = DFF; d.kind = 2; }
    else if ((r -= CI_G) < CI_D) { d.W = ARG(17) + (size_t)L * DFF * DM; d.gain = nullptr; d.WT = (bf16_t*)WPTR(L, W_DOWN); d.K = DFF; d.N = DM; d.kind = 0; }
    else if ((r -= CI_D) < CI_PG) { d.W = ARG(19) + (size_t)L * DM * DM; d.gain = ARG(18) + L * DM; d.WT = (bf16_t*)WPTR(L, W_PG); d.K = DM; d.N = DM; d.kind = 0; }
    else { r -= CI_PG; d.W = ARG(20) + (size_t)L * PLED * DM; d.gain = nullptr; d.WT = (bf16_t*)WPTR(L, W_PP); d.K = PLED; d.N = DM; d.kind = 0; }
    const int nblk = d.N / 32; d.k0 = 64 * (r / nblk); d.n0 = 32 * (r % nblk);
    return d;
}
__device__ __forceinline__ void conv_load(const ConvD& d, float (&v)[32], f32x4 (&g)[2], int lane) {
    const float* p = d.W + (size_t)(d.k0 + (lane >> 5)) * d.N + d.n0 + (lane & 31);
#pragma unroll
    for (int i = 0; i < 32; ++i) v[i] = p[(size_t)(2 * i) * d.N];
    if (d.gain) { g[0] = *(const f32x4*)(d.gain + d.k0 + 8 * (lane & 7)); g[1] = *(const f32x4*)(d.gain + d.k0 + 8 * (lane & 7) + 4); }
    else { g[0] = (f32x4){1.f, 1.f, 1.f, 1.f}; g[1] = g[0]; }
}
__device__ __forceinline__ void conv_proc(const ConvD& d, const float (&v)[32], const f32x4 (&g)[2], LAS float* scr, int lane) {
#pragma unroll
    for (int i = 0; i < 32; ++i) scr[(2 * i + (lane >> 5)) * 33 + (lane & 31)] = v[i];
    asm volatile("s_waitcnt lgkmcnt(0)" ::: "memory");
    const int c = lane & 7;
#pragma unroll
    for (int j = 0; j < 4; ++j) { const int n = (lane >> 3) + 8 * j; const LAS float* s = scr + (8 * c) * 33 + n;
        u32x4 o; o.x = pk2(s[0 * 33] * g[0][0], s[1 * 33] * g[0][1]); o.y = pk2(s[2 * 33] * g[0][2], s[3 * 33] * g[0][3]);
        o.z = pk2(s[4 * 33] * g[1][0], s[5 * 33] * g[1][1]); o.w = pk2(s[6 * 33] * g[1][2], s[7 * 33] * g[1][3]);
        const int gn = d.n0 + n; const int drow = d.kind == 0 ? gn : ((gn >> 7) * 256 + (gn & 127) + (d.kind == 2 ? 128 : 0));
        *(u32x4*)(d.WT + (size_t)drow * d.K + d.k0 + 8 * c) = o; }
    asm volatile("s_waitcnt lgkmcnt(0)" ::: "memory");
}

#ifdef NO_SGEMM
#define SG(...)
#else
#define SG(...) __VA_ARGS__
#endif
#ifndef GP1
#define GP1(...) __VA_ARGS__
#endif
#ifndef GP2
#define GP2(...) __VA_ARGS__
#endif
#ifndef GP3
#define GP3(...) __VA_ARGS__
#endif
#ifndef GP4
#define GP4(...) __VA_ARGS__
#endif
#ifndef GP5
#define GP5(...) __VA_ARGS__
#endif
#ifndef GP6
#define GP6(...) __VA_ARGS__
#endif
#ifdef NO_SGEMM
#define SG(...)
#else
#define SG(...) __VA_ARGS__
#endif
#ifndef GP1
#define GP1(...) __VA_ARGS__
#endif
#ifndef GP2
#define GP2(...) __VA_ARGS__
#endif
#ifndef GP3
#define GP3(...) __VA_ARGS__
#endif
#ifndef GP4
#define GP4(...) __VA_ARGS__
#endif
#ifndef GP5
#define GP5(...) __VA_ARGS__
#endif
#ifndef GP6
#define GP6(...) __VA_ARGS__
#endif
struct Args { const float* in[22]; float* out; unsigned char* ws; };

#ifndef PROBE_SEL
#define PROBE_SEL -1
#endif
#if PROBE_SEL >= 0
#define TSTAMP(cat) do { if (blockIdx.x == 0 && fresh_tid() == 0) { const unsigned long long t_ = __builtin_amdgcn_s_memrealtime(); unsigned long long* tsb = WS_PTR(unsigned long long, WS_CTL + 4096); \
    tsb[16 + (cat)] += t_ - tsb[0]; tsb[0] = t_; } } while (0)
#else
#define TSTAMP(cat) do {} while (0)
#endif
__global__ void __launch_bounds__(NTHREADS, 2) hymba_fwd(Args args) {
    extern __shared__ __attribute__((aligned(16))) unsigned char lds_raw[];
    cg::grid_group grid = cg::this_grid();
    LAS unsigned char* lds = (LAS unsigned char*)lds_raw;
    const int G = gridDim.x;

    { const int tid0 = fresh_tid();
      if (blockIdx.x == 0) for (int i = tid0; i < XCD_BAR_WORDS; i += NTHREADS) WS_PTR(unsigned, WS_BAR)[i] = 0u;
      if (tid0 < 2) ((LAS unsigned*)(lds + 131072))[tid0] = 0u; }
    grid.sync();
    (void)xcd_barrier_post(WS_PTR(unsigned, WS_BAR), (volatile LAS unsigned*)(lds + 131072));
#define GSYNC() do { XcdBarrier xb_; xb_.bar = WS_PTR(unsigned, WS_BAR); xb_.x = xb_xcc_id(); xb_.st = (volatile LAS unsigned*)(lds + 131072); xcd_barrier(xb_); } while (0)
#if PROBE_SEL >= 0
    if (blockIdx.x == 0 && fresh_tid() == 0) { unsigned long long* tsb = WS_PTR(unsigned long long, WS_CTL + 4096); for (int i = 0; i < 48; ++i) tsb[i] = 0; tsb[0] = __builtin_amdgcn_s_memrealtime(); }
#endif
    {
        const int tid = fresh_tid(), lane = tid & 63, wave = __builtin_amdgcn_readfirstlane(tid >> 6);
        const int gw = blockIdx.x * NWAVES + wave, NGW = G * NWAVES;
        { float* ssb = SSB; for (int i = blockIdx.x * NTHREADS + tid; i < 6 * MT; i += G * NTHREADS) ssb[MT + i] = 0.f;
          if (blockIdx.x == 0 && tid < 16) WS_PTR(unsigned, WS_CTL)[tid] = 0u;
          }
        LAS float* scr = (LAS float*)(lds + wave * 8704);
        { constexpr int NIT = NLAYER * CI_L; int it = gw;
          float vA[32], vB[32]; f32x4 gA[2], gB[2]; ConvD dA, dB;
          if (it < NIT) { dA = conv_decode(it); conv_load(dA, vA, gA, lane); }
          while (it < NIT) {
            const int itn = it + NGW;
            if (itn < NIT) { dB = conv_decode(itn); conv_load(dB, vB, gB, lane); }
            conv_proc(dA, vA, gA, scr, lane);
            if (itn >= NIT) break;
            it = itn + NGW;
            if (it < NIT) { dA = conv_decode(it); conv_load(dA, vA, gA, lane); }
            conv_proc(dB, vB, gB, scr, lane);
          } }
        { const float* pp = ARG(2); const float* ps = ARG(3); bf16_t* PB = PB_;
          for (int it0 = 4 * gw; it0 < NLAYER * MT; it0 += 4 * NGW) {
            f32x4 v[4];
#pragma unroll
            for (int rr = 0; rr < 4; ++rr) { const int it = it0 + rr, L = it / MT, row = it % MT;
                const float* src = row < MP ? pp + ((size_t)L * MP + row) * PLED : ps + ((size_t)L * MS + (row - MP)) * PLED;
                v[rr] = *((const f32x4*)src + lane); }
#pragma unroll
            for (int rr = 0; rr < 4; ++rr) { u32x2 w; w.x = pk2(v[rr][0], v[rr][1]); w.y = pk2(v[rr][2], v[rr][3]); *((u32x2*)(PB + (size_t)(it0 + rr) * PLED) + lane) = w; }
          } }
        { const float* x_p = ARG(0); const float* x_s = ARG(1); bf16_t* XB = XN_; float* ssb = SSB;
          for (int row0 = 2 * gw; row0 < MT; row0 += 2 * NGW) {
            f32x4 v[2][4];
#pragma unroll
            for (int rr = 0; rr < 2; ++rr) { const int row = row0 + rr; const float* src = row < MP ? x_p + (size_t)row * DM : x_s + (size_t)(row - MP) * DM;
#pragma unroll
                for (int j = 0; j < 4; ++j) v[rr][j] = *((const f32x4*)src + lane + 64 * j); }
#pragma unroll
            for (int rr = 0; rr < 2; ++rr) { float s2 = 0.f;
#pragma unroll
                for (int j = 0; j < 4; ++j) { const f32x4 t = v[rr][j]; s2 += (t[0] * t[0] + t[1] * t[1]) + (t[2] * t[2] + t[3] * t[3]);
                    u32x2 w; w.x = pk2(t[0], t[1]); w.y = pk2(t[2], t[3]); *((u32x2*)(XB + (size_t)(row0 + rr) * DM) + lane + 64 * j) = w; }
                s2 = wave_sum(s2);
                if (lane == 0) ssb[row0 + rr] = s2; }
          } }
    }
    TSTAMP(0); GSYNC(); TSTAMP(8);

#define P_HALF(half) do { if ((int)blockIdx.x < (G >> 1)) { EpiArgs q2{}; q2.o0 = PBUF_ + (size_t)(half) * (MP / 2) * DM; \
            int kp = PLED; asm volatile("" : "+s"(kp)); \
            pg8::Gemm g2{PB_ + ((size_t)L * MT + (size_t)(half) * (MP / 2)) * PLED, WPTR(L, W_PP), MP / 2, DM, kp}; pg8::StaticOrder S2; S2.init(MP / 2, DM, G >> 1, (int)blockIdx.x); \
            Epi<EP_P> E2{q2}; \
            GP3(pg8::gemm_phase<Epi<EP_P>, pg8::StaticOrder, true, true>(lds, g2, S2, E2);) TSTAMP(10); } } while (0)
    for (int L = 0; L < NLAYER; ++L) {
#define SS_MIX (SSB + (size_t)(3 * L) * MT)
#define SS_FFN (SSB + (size_t)(3 * L + 1) * MT)
#define SS_PLE (SSB + (size_t)(3 * L + 2) * MT)
#define SS_NEXT (SSB + (size_t)(3 * L + 3) * MT)
        { EpiArgs q{}; q.ss_in = SS_MIX; q.o0 = QKV_;
          q.f_sbk = ARG_OUT + O_SBK_P + (size_t)L * MP * HW; q.f_sbv = ARG_OUT + O_SBV_P + (size_t)L * MP * HW;
          q.f_cbk = ARG_OUT + O_CBK_P + (size_t)L * NBATCH * BANDL * HW; q.f_cbv = ARG_OUT + O_CBV_P + (size_t)L * NBATCH * BANDL * HW;
          pg8::Gemm g{XN_, WPTR(L, W_IN), MP, NQKV, DM}; pg8::StaticOrder S; S.init(MP, NQKV, G, (int)blockIdx.x);
          Epi<EP_QKV> E{q};
          GP1(pg8::gemm_phase<Epi<EP_QKV>, pg8::StaticOrder, true, true>(lds, g, S, E);) TSTAMP(1); }
        { EpiArgs q{}; q.ss_in = SS_MIX; q.o0 = QKV_;
          q.s_sbk = ARG_OUT + O_SBK_S + (size_t)L * MS * HW; q.s_sbv = ARG_OUT + O_SBV_S + (size_t)L * MS * HW;
          q.s_cbk = ARG_OUT + O_CBK_S + (size_t)L * MS * HW; q.s_cbv = ARG_OUT + O_CBV_S + (size_t)L * MS * HW;
          SG(sgemm<EP_QKV, DM>(lds, XN_ + (size_t)MP * DM, WPTR(L, W_IN), NQKV / 64, q);) TSTAMP(7); }
        GSYNC(); TSTAMP(8);
        { AttnArgs A{}; A.L = L;
#ifndef NO_ATTN
          attn_phase(A, lds);
#endif
          TSTAMP(2); }
        GSYNC(); TSTAMP(2);
        { EpiArgs q{}; q.XB = XB_; q.xbase = XN_; q.ss_out = SS_FFN;
          pg8::Gemm g{MIX_, WPTR(L, W_OUT), MP, DM, DM}; pg8::StaticOrder S; S.init(MP, DM, G, (int)blockIdx.x);
          Epi<EP_RES> E{q};
          GP2(pg8::gemm_phase<Epi<EP_RES>, pg8::StaticOrder, true, true>(lds, g, S, E);) TSTAMP(3); }
        { EpiArgs q{}; q.XB = XB_; q.xbase = XN_; q.ss_out = SS_FFN;
          SG(sgemm<EP_RES, DM>(lds, MIX_ + (size_t)MP * DM, WPTR(L, W_OUT), DM / 32, q);) TSTAMP(7); }
        P_HALF(0);
        GSYNC(); TSTAMP(8);
        { EpiArgs q{}; q.ss_in = SS_FFN; q.o0 = HB_;
          pg8::Gemm g{XB_, WPTR(L, W_GU), MP, 2 * DFF, DM}; pg8::StaticOrder S; S.init(MP, 2 * DFF, G, (int)blockIdx.x);
          Epi<EP_GU> E{q};
          GP4(pg8::gemm_phase<Epi<EP_GU>, pg8::StaticOrder, true, true>(lds, g, S, E);) TSTAMP(4);
          SG(sgemm<EP_GU, DM>(lds, XB_ + (size_t)MP * DM, WPTR(L, W_GU), DFF / 32, q, ((int)blockIdx.x >= (G >> 1)) ? G - 1 - (int)blockIdx.x : (1 << 30), G >> 1);) TSTAMP(7); }
        { EpiArgs q2{}; q2.o0 = PBUF_;
          SG(sgemm<EP_P, PLED>(lds, PB_ + ((size_t)L * MT + MP) * PLED, WPTR(L, W_PP), DM / 32, q2);) TSTAMP(7); }
        GSYNC(); TSTAMP(8);
        { EpiArgs q{}; q.XB = XB_; q.xbase = XB_; q.ss_out = SS_PLE;
          pg8::Gemm g{HB_, WPTR(L, W_DOWN), MP, DM, DFF}; pg8::StaticOrder S; S.init(MP, DM, G, (int)blockIdx.x);
          Epi<EP_RES> E{q};
          GP5(pg8::gemm_phase<Epi<EP_RES>, pg8::StaticOrder, true, true>(lds, g, S, E);) TSTAMP(5);
          SG(sgemm<EP_RES, DFF>(lds, HB_ + (size_t)MP * DFF, WPTR(L, W_DOWN), DM / 32, q);) TSTAMP(7); }
        P_HALF(1);
        GSYNC(); TSTAMP(8);
        { EpiArgs q{}; q.XB = XN_  ; q.P = PBUF_; q.xbase = XB_; q.ss_in = SS_PLE; q.ss_out = SS_NEXT;
          pg8::Gemm g{XB_, WPTR(L, W_PG), MP, DM, DM}; pg8::StaticOrder S; S.init(MP, DM, G, (int)blockIdx.x);
          Epi<EP_PLE> E{q};
          GP6(pg8::gemm_phase<Epi<EP_PLE>, pg8::StaticOrder, true, true>(lds, g, S, E);) TSTAMP(6);
          SG(sgemm<EP_PLE, DM>(lds, XB_ + (size_t)MP * DM, WPTR(L, W_PG), DM / 32, q);) TSTAMP(7); }
        GSYNC(); TSTAMP(8);
    }
    {
        const int tid = fresh_tid(), lane = tid & 63, wave = __builtin_amdgcn_readfirstlane(tid >> 6);
        const int gw = blockIdx.x * NWAVES + wave, NGW = G * NWAVES;
        const float* ssf = SSB + (size_t)(3 * NLAYER) * MT; const float* gf = ARG(21); const bf16_t* XN = XN_; float* out = ARG_OUT;
        for (int row0 = 2 * gw; row0 < MT; row0 += 2 * NGW) {
            u32x2 xv[2][4];
#pragma unroll
            for (int rr = 0; rr < 2; ++rr)
#pragma unroll
                for (int j = 0; j < 4; ++j) xv[rr][j] = *((const u32x2*)(XN + (size_t)(row0 + rr) * DM) + lane + 64 * j);
#pragma unroll
            for (int rr = 0; rr < 2; ++rr) { const int row = row0 + rr; const float rs = rstd_of(ssf[row]);
                float* dst = row < MP ? out + O_YP + (size_t)row * DM : out + O_YS + (size_t)(row - MP) * DM;
#pragma unroll
                for (int j = 0; j < 4; ++j) { const f32x4 gv = *((const f32x4*)gf + lane + 64 * j); const u32x2 w = xv[rr][j];
                    const f32x4 v = {bf_lo(w.x), bf_hi(w.x), bf_lo(w.y), bf_hi(w.y)};
                    __builtin_nontemporal_store(v * rs * gv, (f32x4*)dst + lane + 64 * j); } }
        }
    }
#if PROBE_SEL >= 0
    TSTAMP(11); grid.sync();
    if (blockIdx.x == 0 && fresh_tid() == 0) { const unsigned long long* tsb = WS_PTR(unsigned long long, WS_CTL + 4096); float* o = ARG_OUT + O_YS; unsigned long long tv = 0; if (PROBE_SEL == 20) tv = tsb[16+1] + tsb[16+3] + tsb[16+10] + tsb[16+4] + tsb[16+5] + tsb[16+6]; else if (PROBE_SEL == 21) tv = tsb[16+0] + tsb[16+11]; else if (PROBE_SEL < 16) tv = tsb[16 + PROBE_SEL]; o[0] += (float)tv * 2.5e-5f; }
#endif
}

extern "C" void kernel_launch(void* const* d_in, const int* in_sizes, int n_in, void* d_out, int out_size, void* d_ws, size_t ws_size, hipStream_t stream) {
    static int grid = 0;
    if (grid == 0) {
        int dev = 0, cus = 0, per_cu = 0;
        hipGetDevice(&dev);
        hipDeviceGetAttribute(&cus, hipDeviceAttributeMultiprocessorCount, dev);
        hipFuncSetAttribute((const void*)hymba_fwd, hipFuncAttributeMaxDynamicSharedMemorySize, LDS_BYTES);
        hipOccupancyMaxActiveBlocksPerMultiprocessor(&per_cu, (const void*)hymba_fwd, NTHREADS, LDS_BYTES);
        if (per_cu < 1) per_cu = 1;
        grid = cus * per_cu;
        if (n_in != 22 || ws_size < WS_END) { fprintf(stderr, "kernel_launch: unexpected n_in %d / ws_size %zu\n", n_in, ws_size); }
    }
    Args a{};
    for (int i = 0; i < 22; ++i) a.in[i] = (const float*)d_in[i];
    a.out = (float*)d_out; a.ws = (unsigned char*)d_ws;
    void* kargs[] = {&a};
    hipError_t e = hipLaunchCooperativeKernel((const void*)hymba_fwd, dim3(grid), dim3(NTHREADS), kargs, LDS_BYTES, stream);
    if (e != hipSuccess) fprintf(stderr, "cooperative launch failed: %s (grid %d)\n", hipGetErrorString(e), grid);
}
```
